# Optimizing an MI355X kernel written in HIP

```python
import math
import jax
import jax.numpy as jnp
from jax import lax
import numpy as np

D_MODEL = 1024
BATCH = 8
SEQ = 2048
DEPTH = 4

CTX_LEN = 256
GRID_W = 64
HEAD_DIM = 64
Q_BLOCK = 128
ROPE_BASE = 10000.0
EPS = 1e-6
NEG_INF = -1e30

WIN = 128
A_HEADS = 8
A_KV_HEADS = 2
A_GROUP = A_HEADS // A_KV_HEADS
B_HEADS = 4
B_NOPE = 64
B_ROPE = 32
B_V = 64
B_Q_RANK = 256
B_KV_RANK = 128
C_HEADS = 4
C_DH = 32
C_V = 2 * C_DH

A_WIDTH = A_HEADS * HEAD_DIM
B_WIDTH = B_HEADS * B_V
C_WIDTH = C_HEADS * C_V
MIX_WIDTH = A_WIDTH + B_WIDTH + C_WIDTH

IN_SPLITS = (A_HEADS * HEAD_DIM, A_KV_HEADS * HEAD_DIM, A_KV_HEADS * HEAD_DIM,
             B_Q_RANK, B_KV_RANK, B_ROPE,
             C_HEADS * 2 * C_DH, C_HEADS * 2 * C_DH, C_HEADS * C_V)
IN_WIDTH = sum(IN_SPLITS)

N_EXPERTS = 16
EC_FACTOR = 2
D_EXPERT = 512

kernel_name = "hybrid_parallel_heads_diffusion_block"


def rmsnorm(x, g):
    xf = x.astype(jnp.float32)
    xf = xf * lax.rsqrt(jnp.mean(xf * xf, axis=-1, keepdims=True) + EPS)
    return xf.astype(x.dtype) * g


def modulate(h, shift, scale):
    return h * (1.0 + scale) + shift


def split_cols(p):
    offs = np.cumsum(IN_SPLITS)[:-1].tolist()
    return jnp.split(p, offs, axis=-1)


def axial_rope(T, rot_dim):
    rows = T // GRID_W
    row = jnp.repeat(jnp.arange(rows), GRID_W)
    col = jnp.tile(jnp.arange(GRID_W), rows)
    n_f = rot_dim // 4
    inv = ROPE_BASE ** (-jnp.arange(n_f, dtype=jnp.float32) / n_f)
    ang = jnp.stack([row[:, None] * inv, col[:, None] * inv], axis=1)
    return jnp.cos(ang), jnp.sin(ang)


def apply_rope(x, cos, sin):
    shape = x.shape
    n_f = shape[-1] // 4
    xr = x.reshape(*shape[:-1], 2, 2, n_f)
    x0, x1 = xr[..., 0, :], xr[..., 1, :]
    bshape = (shape[1],) + (1,) * (x.ndim - 3) + (2, n_f)
    cos = cos.reshape(bshape).astype(x.dtype)
    sin = sin.reshape(bshape).astype(x.dtype)
    return jnp.stack([x0 * cos - x1 * sin, x1 * cos + x0 * sin], axis=-2).reshape(shape)


def map_query_blocks(fn, qs):
    B, T = qs[0].shape[:2]
    nb = T // Q_BLOCK
    blocks = tuple(jnp.moveaxis(a.reshape(B, nb, Q_BLOCK, *a.shape[2:]), 1, 0) for a in qs)
    out = lax.map(fn, blocks)
    return jnp.moveaxis(out, 0, 1).reshape(B, T, *out.shape[3:])


def window_gqa_mixer(qa, ka, va, qa_c, ka_c, va_c, sink, rope, need_ctx):
    B, T = qa.shape[:2]
    L = ka_c.shape[1]
    nb = T // WIN
    scale = HEAD_DIM ** -0.5
    q = apply_rope(qa.reshape(B, T, A_HEADS, HEAD_DIM), *rope)
    k = apply_rope(ka.reshape(B, T, A_KV_HEADS, HEAD_DIM), *rope)
    v = va.reshape(B, T, A_KV_HEADS, HEAD_DIM)
    kc = ka_c.reshape(B, L, A_KV_HEADS, HEAD_DIM)
    vc = va_c.reshape(B, L, A_KV_HEADS, HEAD_DIM)
    sink_f = sink.astype(jnp.float32)

    qb = q.reshape(B, nb, WIN, A_KV_HEADS, A_GROUP, HEAD_DIM)

    def band(a):
        ap = jnp.pad(a, ((0, 0), (WIN, WIN), (0, 0), (0, 0))).reshape(B, nb + 2, WIN, A_KV_HEADS, HEAD_DIM)
        return jnp.concatenate([ap[:, :-2], ap[:, 1:-1], ap[:, 2:]], axis=2)

    kb, vb = band(k), band(v)
    qi = jnp.arange(WIN)[:, None]
    kj = jnp.arange(3 * WIN)[None, :]
    kpos = jnp.arange(nb)[:, None, None] * WIN - WIN + kj
    valid = (kj >= qi) & (kj <= qi + 2 * WIN) & (kpos >= 0) & (kpos < T)
    s_loc = jnp.einsum('bnqhgd,bnkhd->bhgnqk', qb, kb).astype(jnp.float32) * scale
    s_loc = jnp.where(valid, s_loc, NEG_INF)
    s_ctx = jnp.einsum('bnqhgd,bkhd->bhgnqk', qb, kc).astype(jnp.float32) * scale
    s_sink = jnp.broadcast_to(sink_f.reshape(1, A_KV_HEADS, A_GROUP, 1, 1, 1), s_ctx.shape[:-1] + (1,))
    p = jax.nn.softmax(jnp.concatenate([s_loc, s_ctx, s_sink], axis=-1), axis=-1).astype(v.dtype)
    o = (jnp.einsum('bhgnqk,bnkhd->bnqhgd', p[..., :3 * WIN], vb)
         + jnp.einsum('bhgnqk,bkhd->bnqhgd', p[..., 3 * WIN:3 * WIN + L], vc))
    o = o.reshape(B, T, A_WIDTH)

    o_c = None
    if need_ctx:
        qcg = qa_c.reshape(B, L, A_KV_HEADS, A_GROUP, HEAD_DIM)
        s = jnp.einsum('bqhgd,bkhd->bhgqk', qcg, kc).astype(jnp.float32) * scale
        s_sink_c = jnp.broadcast_to(sink_f.reshape(1, A_KV_HEADS, A_GROUP, 1, 1), s.shape[:-1] + (1,))
        pc = jax.nn.softmax(jnp.concatenate([s, s_sink_c], axis=-1), axis=-1)[..., :L].astype(vc.dtype)
        o_c = jnp.einsum('bhgqk,bkhd->bqhgd', pc, vc).reshape(B, L, A_WIDTH)
    return o, o_c


def mla_attend(qn, qr, kn, kr, v):
    s = (jnp.einsum('bqhd,bkhd->bhqk', qn, kn) + jnp.einsum('bqhr,bkr->bhqk', qr, kr)).astype(jnp.float32)
    p = jax.nn.softmax(s * (B_NOPE + B_ROPE) ** -0.5, axis=-1).astype(v.dtype)
    return jnp.einsum('bhqk,bkhd->bqhd', p, v)


def mla_mixer(cq, ckv, kr, cq_c, ckv_c, kr_c, q_norm, w_uq, kv_norm, w_ukv, rope, need_ctx):
    def project(cq_, ckv_, kr_, rope_):
        B_, N = cq_.shape[:2]
        q = (rmsnorm(cq_, q_norm) @ w_uq).reshape(B_, N, B_HEADS, B_NOPE + B_ROPE)
        kv = (rmsnorm(ckv_, kv_norm) @ w_ukv).reshape(B_, N, B_HEADS, B_NOPE + B_V)
        qn, qr = q[..., :B_NOPE], q[..., B_NOPE:]
        kn, v = kv[..., :B_NOPE], kv[..., B_NOPE:]
        if rope_ is not None:
            qr = apply_rope(qr, *rope_)
            kr_ = apply_rope(kr_, *rope_)
        return qn, qr, kn, kr_, v

    B, T = cq.shape[:2]
    qn, qr, kn, krl, v = project(cq, ckv, kr, rope)
    qn_c, qr_c, kn_c, kr_cc, v_c = project(cq_c, ckv_c, kr_c, None)
    kn_all = jnp.concatenate([kn, kn_c], axis=1)
    kr_all = jnp.concatenate([krl, kr_cc], axis=1)
    v_all = jnp.concatenate([v, v_c], axis=1)
    o = map_query_blocks(lambda a: mla_attend(a[0], a[1], kn_all, kr_all, v_all), (qn, qr))
    o = o.reshape(B, T, B_WIDTH)
    o_c = None
    if need_ctx:
        o_c = mla_attend(qn_c, qr_c, kn_c, kr_cc, v_c).reshape(B, -1, B_WIDTH)
    return o, o_c


def diff_attend(q, k, v, lam):
    s = jnp.einsum('bqhmd,bkhmd->bhmqk', q, k).astype(jnp.float32) * C_DH ** -0.5
    p = jax.nn.softmax(s, axis=-1)
    a = p[:, :, 0] - lam * p[:, :, 1]
    return jnp.einsum('bhqk,bkhd->bqhd', a.astype(v.dtype), v)


def diff_mixer(qd, kd, vd, qd_c, kd_c, vd_c, lam_q1, lam_k1, lam_q2, lam_k2, sub_norm, lam_init, rope, need_ctx):
    B, T = qd.shape[:2]
    L = qd_c.shape[1]
    lam = (jnp.exp(jnp.sum((lam_q1 * lam_k1).astype(jnp.float32)))
           - jnp.exp(jnp.sum((lam_q2 * lam_k2).astype(jnp.float32))) + lam_init)
    q = apply_rope(qd.reshape(B, T, C_HEADS, 2, C_DH), *rope)
    k = apply_rope(kd.reshape(B, T, C_HEADS, 2, C_DH), *rope)
    v = vd.reshape(B, T, C_HEADS, C_V)
    qc = qd_c.reshape(B, L, C_HEADS, 2, C_DH)
    kc = kd_c.reshape(B, L, C_HEADS, 2, C_DH)
    vc = vd_c.reshape(B, L, C_HEADS, C_V)
    k_all = jnp.concatenate([k, kc], axis=1)
    v_all = jnp.concatenate([v, vc], axis=1)
    o = map_query_blocks(lambda a: diff_attend(a[0], k_all, v_all, lam), (q,))
    o = (rmsnorm(o, sub_norm) * (1.0 - lam_init)).reshape(B, T, C_WIDTH)
    o_c = None
    if need_ctx:
        o_c = (rmsnorm(diff_attend(qc, kc, vc, lam), sub_norm) * (1.0 - lam_init)).reshape(B, L, C_WIDTH)
    return o, o_c


def expert_choice_ffn(h, w_router, w_gate, w_up, w_down):
    B, N, D = h.shape
    cap = EC_FACTOR * N // N_EXPERTS
    aff = jax.nn.softmax((h @ w_router).astype(jnp.float32), axis=-1)
    gate_val, tok = lax.top_k(jnp.swapaxes(aff, 1, 2), cap)
    xg = jax.vmap(lambda hb, ib: hb[ib])(h, tok)
    hid = jax.nn.silu(jnp.einsum('becd,edf->becf', xg, w_gate)) * jnp.einsum('becd,edf->becf', xg, w_up)
    y = jnp.einsum('becf,efd->becd', hid, w_down) * gate_val[..., None].astype(h.dtype)
    return jax.vmap(lambda ib, yb: jnp.zeros((N, D), yb.dtype).at[ib.reshape(-1)].add(yb.reshape(-1, D)))(tok, y)


def setup_inputs(seed: int = 0) -> dict:
    key = jax.random.key(seed)
    ks = jax.random.split(key, 25)

    def nrm(k, shape, s):
        return jax.random.normal(k, shape, jnp.float32) * s

    def gain(k, shape):
        return 1.0 + nrm(k, shape, 0.02)

    return {
        "x": nrm(ks[0], (BATCH, SEQ, D_MODEL), 1.0),
        "c": nrm(ks[1], (BATCH, D_MODEL), 1.0),
        "ctx": nrm(ks[2], (BATCH, CTX_LEN, D_MODEL), 1.0),
        "c_ctx": nrm(ks[3], (D_MODEL,), 1.0),
        "norm1": gain(ks[4], (DEPTH, D_MODEL)),
        "norm2": gain(ks[5], (DEPTH, D_MODEL)),
        "w_ada": nrm(ks[6], (DEPTH, D_MODEL, 6 * D_MODEL), 0.5 * D_MODEL ** -0.5),
        "b_ada": nrm(ks[7], (DEPTH, 6 * D_MODEL), 0.02),
        "w_in": nrm(ks[8], (DEPTH, D_MODEL, IN_WIDTH), D_MODEL ** -0.5),
        "sink": nrm(ks[9], (DEPTH, A_HEADS), 0.5),
        "mla_q_norm": gain(ks[10], (DEPTH, B_Q_RANK)),
        "w_uq": nrm(ks[11], (DEPTH, B_Q_RANK, B_HEADS * (B_NOPE + B_ROPE)), B_Q_RANK ** -0.5),
        "mla_kv_norm": gain(ks[12], (DEPTH, B_KV_RANK)),
        "w_ukv": nrm(ks[13], (DEPTH, B_KV_RANK, B_HEADS * (B_NOPE + B_V)), B_KV_RANK ** -0.5),
        "lam_q1": nrm(ks[14], (DEPTH, C_DH), 0.1),
        "lam_k1": nrm(ks[15], (DEPTH, C_DH), 0.1),
        "lam_q2": nrm(ks[16], (DEPTH, C_DH), 0.1),
        "lam_k2": nrm(ks[17], (DEPTH, C_DH), 0.1),
        "diff_norm": gain(ks[18], (DEPTH, C_V)),
        "w_out": nrm(ks[19], (DEPTH, MIX_WIDTH, D_MODEL), MIX_WIDTH ** -0.5),
        "w_router": nrm(ks[20], (DEPTH, D_MODEL, N_EXPERTS), D_MODEL ** -0.5),
        "w_gate": nrm(ks[21], (DEPTH, N_EXPERTS, D_MODEL, D_EXPERT), D_MODEL ** -0.5),
        "w_up": nrm(ks[22], (DEPTH, N_EXPERTS, D_MODEL, D_EXPERT), D_MODEL ** -0.5),
        "w_down": nrm(ks[23], (DEPTH, N_EXPERTS, D_EXPERT, D_MODEL), D_EXPERT ** -0.5),
        "final_norm": gain(ks[24], (D_MODEL,)),
    }


def reference(x, c, ctx, c_ctx, norm1, norm2, w_ada, b_ada, w_in, sink, mla_q_norm, w_uq, mla_kv_norm, w_ukv,
              lam_q1, lam_k1, lam_q2, lam_k2, diff_norm, w_out, w_router, w_gate, w_up, w_down, final_norm):
    T = x.shape[1]
    rope_a = axial_rope(T, HEAD_DIM)
    rope_bc = axial_rope(T, B_ROPE)
    xc = ctx
    for l in range(DEPTH):
        need_ctx = l < DEPTH - 1
        mod = jax.nn.silu(c) @ w_ada[l] + b_ada[l]
        mod_c = jax.nn.silu(c_ctx) @ w_ada[l] + b_ada[l]
        sh1, sc1, g1, sh2, sc2, g2 = jnp.split(mod[:, None, :], 6, axis=-1)
        csh1, csc1, cg1, csh2, csc2, cg2 = jnp.split(mod_c, 6, axis=-1)

        p = modulate(rmsnorm(x, norm1[l]), sh1, sc1) @ w_in[l]
        pc = modulate(rmsnorm(xc, norm1[l]), csh1, csc1) @ w_in[l]
        qa, ka, va, cq, ckv, kr, qd, kd, vd = split_cols(p)
        qa_c, ka_c, va_c, cq_c, ckv_c, kr_c, qd_c, kd_c, vd_c = split_cols(pc)
        oa, oa_c = window_gqa_mixer(qa, ka, va, qa_c, ka_c, va_c, sink[l], rope_a, need_ctx)
        ob, ob_c = mla_mixer(cq, ckv, kr, cq_c, ckv_c, kr_c, mla_q_norm[l], w_uq[l], mla_kv_norm[l], w_ukv[l],
                             rope_bc, need_ctx)
        lam_init = 0.8 - 0.6 * math.exp(-0.3 * l)
        od, od_c = diff_mixer(qd, kd, vd, qd_c, kd_c, vd_c, lam_q1[l], lam_k1[l], lam_q2[l], lam_k2[l],
                              diff_norm[l], lam_init, rope_bc, need_ctx)
        x = x + g1 * (jnp.concatenate([oa, ob, od], axis=-1) @ w_out[l])

        x = x + g2 * expert_choice_ffn(modulate(rmsnorm(x, norm2[l]), sh2, sc2),
                                       w_router[l], w_gate[l], w_up[l], w_down[l])
        if need_ctx:
            xc = xc + cg1 * (jnp.concatenate([oa_c, ob_c, od_c], axis=-1) @ w_out[l])
            xc = xc + cg2 * expert_choice_ffn(modulate(rmsnorm(xc, norm2[l]), csh2, csc2),
                                              w_router[l], w_gate[l], w_up[l], w_down[l])
    return rmsnorm(x, final_norm)
```

```cpp
#include <hip/hip_runtime.h>
#include <stdint.h>
#include <string.h>

typedef unsigned short bf16;
typedef unsigned u32x4 __attribute__((ext_vector_type(4)));
typedef float f32x4 __attribute__((ext_vector_type(4)));

constexpr int D = 1024, NB = 8, T = 2048, LC = 256, DEPTH = 4;
constexpr int RL = NB * T, RC = NB * LC, R = RL + RC;
constexpr int INW = 1952, LDP = 2048;
constexpr int NE = 16, DE = 512;
constexpr int CAPL = 256, CAPC = 32;
constexpr int SLOTS_E = NB * CAPL + NB * CAPC;
constexpr int SLOTS = NE * SLOTS_E;
constexpr float EPS = 1e-6f;
constexpr int P_AQ = 0, P_AK = 512, P_AV = 640, P_CQ = 768, P_CKV = 1024, P_KR = 1152, P_DQ = 1184, P_DK = 1440, P_DV = 1696;

constexpr size_t MiB = 1u << 20;
constexpr size_t WS_CTL = 0;
constexpr size_t WS_MOD = 1 * MiB;
constexpr size_t WS_ROPE = 2 * MiB;
constexpr size_t WS_RS = 3 * MiB;
constexpr size_t WS_AFF = 4 * MiB;
constexpr size_t WS_INV = 6 * MiB;
constexpr size_t WS_STOK = 8 * MiB;
constexpr size_t WS_SGATE = 9 * MiB;
constexpr size_t WS_X = 10 * MiB;
constexpr size_t WS_ACT = 82 * MiB;
constexpr size_t WS_P = 118 * MiB;
constexpr size_t WS_Y = WS_P;
constexpr size_t WS_QM = 190 * MiB;
constexpr size_t WS_KVM = 204 * MiB;
constexpr size_t WS_O = 222 * MiB;
constexpr size_t WS_HID = WS_O;
constexpr size_t WS_W = 258 * MiB;
constexpr size_t W_IN = 0;
constexpr size_t W_UQ = W_IN + (size_t)LDP * D;
constexpr size_t W_UKV = W_UQ + 384 * 256;
constexpr size_t W_OUT = W_UKV + 512 * 128;
constexpr size_t W_GU = W_OUT + (size_t)D * D;
constexpr size_t W_DN = W_GU + (size_t)NE * 1024 * 1024;
constexpr size_t W_LAYER = W_DN + (size_t)NE * 1024 * 512;
constexpr size_t WS_END = WS_W + (size_t)DEPTH * W_LAYER * 2;

__device__ __forceinline__ unsigned f2bf(float f) { unsigned u = __builtin_bit_cast(unsigned, f); return (u + 0x7fffu + ((u >> 16) & 1u)) >> 16; }
__device__ __forceinline__ float bf2f(unsigned h) { return __builtin_bit_cast(float, h << 16); }
__device__ __forceinline__ float wave_sum(float v) {
#pragma unroll
    for (int o = 1; o < 64; o <<= 1) v += __shfl_xor(v, o);
    return v;
}
__device__ __forceinline__ float siluf(float v) { return v / (1.f + __expf(-v)); }

__global__ void __launch_bounds__(256) k_copy_x(const float* __restrict__ x, const float* __restrict__ ctx, float* __restrict__ X) {
    const size_t n4 = (size_t)R * D / 4, nl4 = (size_t)RL * D / 4;
    for (size_t i = (size_t)blockIdx.x * 256 + threadIdx.x; i < n4; i += (size_t)gridDim.x * 256) {
        f32x4 v = i < nl4 ? ((const f32x4*)x)[i] : ((const f32x4*)ctx)[i - nl4];
        ((f32x4*)X)[i] = v;
    }
}
__global__ void __launch_bounds__(256) k_rope_tab(float* __restrict__ tab) {
    const int i = blockIdx.x * 256 + threadIdx.x;
    if (i >= T * 48) return;
    const int t = i / 48, j = i % 48;
    int axis, f, nf;
    if (j < 32) { axis = j >> 4; f = j & 15; nf = 16; } else { axis = (j - 32) >> 3; f = (j - 32) & 7; nf = 8; }
    const float inv = exp2f(-(float)f / (float)nf * 13.287712379549449f);
    const float pos = (float)(axis == 0 ? (t >> 6) : (t & 63));
    const float ang = pos * inv;
    const float c = cosf(ang), s = sinf(ang);
    float* cosA = tab; float* sinA = tab + T * 32; float* cosB = tab + T * 64; float* sinB = tab + T * 64 + T * 16;
    if (j < 32) { cosA[t * 32 + j] = c; sinA[t * 32 + j] = s; } else { cosB[t * 16 + j - 32] = c; sinB[t * 16 + j - 32] = s; }
}
__global__ void __launch_bounds__(256) k_mod(const float* __restrict__ c, const float* __restrict__ c_ctx, const float* __restrict__ w_ada, const float* __restrict__ b_ada, float* __restrict__ MOD) {
    __shared__ float s[9 * 1024];
    const int l = blockIdx.y, j = blockIdx.x * 256 + threadIdx.x;
    for (int i = threadIdx.x; i < 9 * 1024; i += 256) { const float v = i < 8 * 1024 ? c[i] : c_ctx[i - 8 * 1024]; s[i] = siluf(v); }
    __syncthreads();
    float acc[9];
#pragma unroll
    for (int r = 0; r < 9; ++r) acc[r] = 0.f;
    const float* w = w_ada + (size_t)l * D * 6144 + j;
    for (int k = 0; k < D; ++k) { const float wv = w[(size_t)k * 6144];
#pragma unroll
        for (int r = 0; r < 9; ++r) acc[r] += s[r * 1024 + k] * wv; }
    const float bv = b_ada[l * 6144 + j];
#pragma unroll
    for (int r = 0; r < 9; ++r) MOD[((size_t)l * 9 + r) * 6144 + j] = acc[r] + bv;
}

enum { WK_IN = 0, WK_UQ = 1, WK_ID = 2, WK_GU = 3 };
__device__ __forceinline__ int rot64(int dp) { const int p = dp >> 1, half = dp & 1, axis = p >> 4, f = p & 15; return axis * 32 + half * 16 + f; }
__device__ __forceinline__ int rot32(int dp) { const int p = dp >> 1, half = dp & 1, axis = p >> 3, f = p & 7; return axis * 16 + half * 8 + f; }
__device__ __forceinline__ int src_col(int kind, int n) {
    if (kind == WK_IN) {
        if (n >= INW) return -1;
        if (n < P_AV) return (n & ~63) + rot64(n & 63);
        if ((n >= P_KR && n < P_DV)) return (n & ~31) + rot32(n & 31);
        return n;
    }
    if (kind == WK_UQ) { const int h = n / 96, j = n % 96; return j < 64 ? n : h * 96 + 64 + rot32(j - 64); }
    return n;
}
struct PrepW { const float* W; const float* W2; const float* kscale; bf16* Wt; size_t sstride, dstride; int K, N, Nd, kind, nbatch, pad; };
__global__ void __launch_bounds__(256) k_prep_w(PrepW a) {
    __shared__ float scr_all[4][64 * 33];
    const int wave = threadIdx.x >> 6, lane = threadIdx.x & 63;
    float* scr = scr_all[wave];
    const int nblk = a.Nd / 32, kblk = a.K / 64, per = nblk * kblk, total = per * a.nbatch;
    for (int it = blockIdx.x * 4 + wave; it < total; it += gridDim.x * 4) {
        const int bi = it / per, r = it % per, kb = r / nblk, nb = r % nblk, k0 = kb * 64, n0 = nb * 32;
        const int nd = n0 + (lane & 31);
        const float* Wsrc = a.W + (size_t)bi * a.sstride; int sc;
        if (a.kind == WK_GU) { const int f = (nd >> 3) * 4 + (nd & 3); sc = f; if (nd & 4) Wsrc = a.W2 + (size_t)bi * a.sstride; }
        else sc = src_col(a.kind, nd);
#pragma unroll 8
        for (int i = 0; i < 32; ++i) { const int kk = 2 * i + (lane >> 5);
            float v = sc >= 0 ? Wsrc[(size_t)(k0 + kk) * a.N + sc] : 0.f;
            if (a.kscale) v *= a.kscale[k0 + kk];
            scr[kk * 33 + (lane & 31)] = v; }
        asm volatile("s_waitcnt lgkmcnt(0)" ::: "memory");
        const int c = lane & 7;
        bf16* Wt = a.Wt + (size_t)bi * a.dstride;
#pragma unroll
        for (int j = 0; j < 4; ++j) { const int n = (lane >> 3) + 8 * j; const float* s = scr + (8 * c) * 33 + n;
            u32x4 o; o.x = f2bf(s[0]) | (f2bf(s[33]) << 16); o.y = f2bf(s[66]) | (f2bf(s[99]) << 16); o.z = f2bf(s[132]) | (f2bf(s[165]) << 16); o.w = f2bf(s[198]) | (f2bf(s[231]) << 16);
            *(u32x4*)(Wt + (size_t)(n0 + n) * a.K + k0 + 8 * c) = o; }
        asm volatile("s_waitcnt lgkmcnt(0)" ::: "memory");
    }
}

struct NormArgs { float* X; const float* MOD; const float* gain; bf16* ACT; const int* INV; const bf16* Y; float* out; int l, mode, nrows, combine_rows; };
__global__ void __launch_bounds__(256) k_norm(NormArgs a) {
    const int lane = threadIdx.x & 63, gw = blockIdx.x * 4 + (threadIdx.x >> 6), ngw = gridDim.x * 4;
    for (int r = gw; r < a.nrows; r += ngw) {
        const int mb = r < RL ? r / T : 8;
        float* xr = a.X + (size_t)r * D;
        f32x4 v[4];
#pragma unroll
        for (int j = 0; j < 4; ++j) v[j] = ((const f32x4*)xr)[lane + 64 * j];
        if (a.mode != 1 && a.l > 0 && r < a.combine_rows) {
            const float* g2 = a.MOD + ((size_t)(a.l - 1) * 9 + mb) * 6144 + 5120;
            f32x4 s[4];
#pragma unroll
            for (int j = 0; j < 4; ++j) s[j] = (f32x4){0.f, 0.f, 0.f, 0.f};
            for (int e = 0; e < NE; ++e) { const int sl = a.INV[(size_t)r * NE + e];
                if (sl >= 0) { const bf16* yr = a.Y + (size_t)sl * D;
#pragma unroll
                    for (int j = 0; j < 4; ++j) { const uint2 w = ((const uint2*)yr)[lane + 64 * j];
                        s[j].x += bf2f(w.x & 0xffff); s[j].y += bf2f(w.x >> 16); s[j].z += bf2f(w.y & 0xffff); s[j].w += bf2f(w.y >> 16); } } }
#pragma unroll
            for (int j = 0; j < 4; ++j) { const f32x4 g = ((const f32x4*)g2)[lane + 64 * j]; v[j] += g * s[j]; ((f32x4*)xr)[lane + 64 * j] = v[j]; }
        }
        float ss = 0.f;
#pragma unroll
        for (int j = 0; j < 4; ++j) ss += (v[j].x * v[j].x + v[j].y * v[j].y) + (v[j].z * v[j].z + v[j].w * v[j].w);
        const float rs = 1.0f / sqrtf(wave_sum(ss) * (1.f / D) + EPS);
        if (a.mode == 2) {
#pragma unroll
            for (int j = 0; j < 4; ++j) { const f32x4 g = ((const f32x4*)a.gain)[lane + 64 * j]; ((f32x4*)(a.out + (size_t)r * D))[lane + 64 * j] = v[j] * rs * g; }
        } else {
            const float* md = a.MOD + ((size_t)a.l * 9 + mb) * 6144 + (a.mode == 0 ? 0 : 3072);
#pragma unroll
            for (int j = 0; j < 4; ++j) { const f32x4 g = ((const f32x4*)(a.gain + (size_t)a.l * D))[lane + 64 * j];
                const f32x4 sh = ((const f32x4*)md)[lane + 64 * j], sc = ((const f32x4*)(md + 1024))[lane + 64 * j];
                const f32x4 h = v[j] * rs * g * (sc + 1.0f) + sh;
                uint2 w; w.x = f2bf(h.x) | (f2bf(h.y) << 16); w.y = f2bf(h.z) | (f2bf(h.w) << 16);
                ((uint2*)(a.ACT + (size_t)r * D))[lane + 64 * j] = w; }
        }
    }
}

enum { EP_INPROJ = 0, EP_UPQ = 1, EP_UPKV = 2, EP_OUT = 3, EP_GU = 4, EP_DOWN = 5 };
struct GemmArgs { const bf16* A; const bf16* Bt; const int* gather; size_t b_estride; bf16* Cb; float* X; const float* MOD; const float* rope; const float* RS; const float* sgate;
                  int lda, K, M, N, rows_per_e, ldc, l, pad; };
template <int EP> __global__ void __launch_bounds__(256) k_gemm(GemmArgs a) {
    constexpr int NACC = (EP == EP_GU) ? 2 : 1;
    __shared__ float As[32][65], Bs[NACC][32][65];
    const int tid = threadIdx.x, tx = tid & 15, ty = tid >> 4;
    const int m0 = blockIdx.y * 64, n0 = blockIdx.x * 64;
    const int e = a.rows_per_e ? m0 / a.rows_per_e : 0;
    const bf16* Bt = a.Bt + (size_t)e * a.b_estride;
    float acc[NACC][4][4];
#pragma unroll
    for (int q = 0; q < NACC; ++q)
#pragma unroll
        for (int i = 0; i < 4; ++i)
#pragma unroll
            for (int j = 0; j < 4; ++j) acc[q][i][j] = 0.f;
    const int lr = tid >> 2, lk = (tid & 3) * 8;
    const int arow = a.gather ? a.gather[m0 + lr] : m0 + lr;
    const bf16* ap = a.A + (size_t)arow * a.lda + lk;
    int brow0 = n0 + lr, brow1 = 0;
    if (EP == EP_GU) { const int f = n0 + lr; brow0 = 8 * (f >> 2) + (f & 3); brow1 = brow0 + 4; }
    const bf16* bp0 = Bt + (size_t)brow0 * a.K + lk; const bf16* bp1 = Bt + (size_t)brow1 * a.K + lk;
    for (int k0 = 0; k0 < a.K; k0 += 32) {
        const u32x4 av = *(const u32x4*)(ap + k0), bv = *(const u32x4*)(bp0 + k0);
        u32x4 bv1; if (EP == EP_GU) bv1 = *(const u32x4*)(bp1 + k0);
        __syncthreads();
#pragma unroll
        for (int i = 0; i < 4; ++i) { As[lk + 2 * i][lr] = bf2f(av[i] & 0xffff); As[lk + 2 * i + 1][lr] = bf2f(av[i] >> 16);
            Bs[0][lk + 2 * i][lr] = bf2f(bv[i] & 0xffff); Bs[0][lk + 2 * i + 1][lr] = bf2f(bv[i] >> 16);
            if (EP == EP_GU) { Bs[NACC - 1][lk + 2 * i][lr] = bf2f(bv1[i] & 0xffff); Bs[NACC - 1][lk + 2 * i + 1][lr] = bf2f(bv1[i] >> 16); } }
        __syncthreads();
#pragma unroll 8
        for (int k = 0; k < 32; ++k) { float av4[4], bv4[NACC][4];
#pragma unroll
            for (int i = 0; i < 4; ++i) { av4[i] = As[k][ty * 4 + i];
#pragma unroll
                for (int q = 0; q < NACC; ++q) bv4[q][i] = Bs[q][k][tx * 4 + i]; }
#pragma unroll
            for (int q = 0; q < NACC; ++q)
#pragma unroll
                for (int i = 0; i < 4; ++i)
#pragma unroll
                    for (int j = 0; j < 4; ++j) acc[q][i][j] += av4[i] * bv4[q][j]; }
    }
#pragma unroll
    for (int i = 0; i < 4; ++i) {
        const int m = m0 + ty * 4 + i, n = n0 + tx * 4;
        float v[4];
#pragma unroll
        for (int j = 0; j < 4; ++j) v[j] = acc[0][i][j];
        if (EP == EP_INPROJ || EP == EP_UPQ) {
            if (EP == EP_UPQ) { const float rs = a.RS[(size_t)m * 2];
#pragma unroll
                for (int j = 0; j < 4; ++j) v[j] *= rs; }
            if (m < RL) {
                const int t = m % T; const float* cs = nullptr; const float* sn = nullptr; int p = 0;
                if (EP == EP_INPROJ) {
                    if (n < P_AV) { cs = a.rope + t * 32; sn = a.rope + T * 32 + t * 32; p = (n & 63) >> 1; }
                    else if (n >= P_KR && n < P_DV) { cs = a.rope + T * 64 + t * 16; sn = a.rope + T * 64 + T * 16 + t * 16; p = (n & 31) >> 1; }
                } else { const int j96 = n % 96; if (j96 >= 64) { cs = a.rope + T * 64 + t * 16; sn = a.rope + T * 64 + T * 16 + t * 16; p = (j96 - 64) >> 1; } }
                if (cs) {
#pragma unroll
                    for (int q = 0; q < 2; ++q) { const float c = cs[p + q], s = sn[p + q], x0 = v[2 * q], x1 = v[2 * q + 1]; v[2 * q] = x0 * c - x1 * s; v[2 * q + 1] = x1 * c + x0 * s; }
                }
            }
            uint2 w; w.x = f2bf(v[0]) | (f2bf(v[1]) << 16); w.y = f2bf(v[2]) | (f2bf(v[3]) << 16);
            *(uint2*)(a.Cb + (size_t)m * a.ldc + n) = w;
        } else if (EP == EP_UPKV) {
            const float rs = a.RS[(size_t)m * 2 + 1];
            uint2 w; w.x = f2bf(v[0] * rs) | (f2bf(v[1] * rs) << 16); w.y = f2bf(v[2] * rs) | (f2bf(v[3] * rs) << 16);
            *(uint2*)(a.Cb + (size_t)m * a.ldc + n) = w;
        } else if (EP == EP_OUT) {
            const int mb = m < RL ? m / T : 8;
            const f32x4 g = *(const f32x4*)(a.MOD + ((size_t)a.l * 9 + mb) * 6144 + 2048 + n);
            f32x4* xp = (f32x4*)(a.X + (size_t)m * D + n); f32x4 xv = *xp;
            xv.x += g.x * v[0]; xv.y += g.y * v[1]; xv.z += g.z * v[2]; xv.w += g.w * v[3]; *xp = xv;
        } else if (EP == EP_GU) {
            float h[4];
#pragma unroll
            for (int j = 0; j < 4; ++j) h[j] = siluf(v[j]) * acc[NACC - 1][i][j];
            uint2 w; w.x = f2bf(h[0]) | (f2bf(h[1]) << 16); w.y = f2bf(h[2]) | (f2bf(h[3]) << 16);
            *(uint2*)(a.Cb + (size_t)m * a.ldc + n) = w;
        } else if (EP == EP_DOWN) {
            const float gt = a.sgate[m];
            uint2 w; w.x = f2bf(v[0] * gt) | (f2bf(v[1] * gt) << 16); w.y = f2bf(v[2] * gt) | (f2bf(v[3] * gt) << 16);
            *(uint2*)(a.Cb + (size_t)m * a.ldc + n) = w;
        }
    }
}

__global__ void __launch_bounds__(256) k_rs(const bf16* __restrict__ P, float* __restrict__ RS) {
    const int lane = threadIdx.x & 63, r = blockIdx.x * 4 + (threadIdx.x >> 6);
    if (r >= R) return;
    const bf16* pr = P + (size_t)r * LDP;
    const uint2 a = ((const uint2*)(pr + P_CQ))[lane]; const unsigned b = ((const unsigned*)(pr + P_CKV))[lane];
    float s0 = bf2f(a.x & 0xffff) * bf2f(a.x & 0xffff) + bf2f(a.x >> 16) * bf2f(a.x >> 16) + bf2f(a.y & 0xffff) * bf2f(a.y & 0xffff) + bf2f(a.y >> 16) * bf2f(a.y >> 16);
    float s1 = bf2f(b & 0xffff) * bf2f(b & 0xffff) + bf2f(b >> 16) * bf2f(b >> 16);
    s0 = wave_sum(s0); s1 = wave_sum(s1);
    if (lane == 0) { RS[(size_t)r * 2] = 1.0f / sqrtf(s0 * (1.f / 256.f) + EPS); RS[(size_t)r * 2 + 1] = 1.0f / sqrtf(s1 * (1.f / 128.f) + EPS); }
}

template <int N> __device__ __forceinline__ void ld_bf(const bf16* p, float (&d)[N]) {
#pragma unroll
    for (int i = 0; i < N / 8; ++i) { const u32x4 w = ((const u32x4*)p)[i];
#pragma unroll
        for (int j = 0; j < 4; ++j) { d[8 * i + 2 * j] = bf2f(w[j] & 0xffff); d[8 * i + 2 * j + 1] = bf2f(w[j] >> 16); } }
}
template <int N, int QO, int QN> __device__ __forceinline__ float dot_bf(const bf16* p, const float (&q)[QN]) {
    float s = 0.f;
#pragma unroll
    for (int i = 0; i < N / 8; ++i) { const u32x4 w = ((const u32x4*)p)[i];
#pragma unroll
        for (int j = 0; j < 4; ++j) s += q[QO + 8 * i + 2 * j] * bf2f(w[j] & 0xffff) + q[QO + 8 * i + 2 * j + 1] * bf2f(w[j] >> 16); }
    return s;
}
struct Soft { float m, l; float o[64]; };
template <int D1, int D2> __device__ __forceinline__ void attend(Soft& S, const float (&q)[D1 + D2], const bf16* K1, int ld1, const bf16* K2, int ld2, const bf16* V, int ldv, int r0, int cnt, float scale) {
    for (int r = r0; r < r0 + cnt; ++r) {
        float s = dot_bf<D1, 0, D1 + D2>(K1 + (size_t)r * ld1, q);
        if constexpr (D2 > 0) s += dot_bf<D2, D1, D1 + D2>(K2 + (size_t)r * ld2, q);
        s *= scale;
        const float mn = fmaxf(S.m, s), al = __expf(S.m - mn), p = __expf(s - mn);
        S.m = mn; S.l = S.l * al + p;
        const bf16* vr = V + (size_t)r * ldv;
#pragma unroll
        for (int i = 0; i < 8; ++i) { const u32x4 w = ((const u32x4*)vr)[i];
#pragma unroll
            for (int j = 0; j < 4; ++j) { S.o[8 * i + 2 * j] = S.o[8 * i + 2 * j] * al + p * bf2f(w[j] & 0xffff); S.o[8 * i + 2 * j + 1] = S.o[8 * i + 2 * j + 1] * al + p * bf2f(w[j] >> 16); } }
    }
}
__device__ __forceinline__ void soft_init(Soft& S) { S.m = -1e30f; S.l = 0.f;
#pragma unroll
    for (int d = 0; d < 64; ++d) S.o[d] = 0.f; }
__device__ __forceinline__ void store64(bf16* dst, const float (&o)[64], float sc) {
#pragma unroll
    for (int i = 0; i < 8; ++i) { u32x4 w;
#pragma unroll
        for (int j = 0; j < 4; ++j) w[j] = f2bf(o[8 * i + 2 * j] * sc) | (f2bf(o[8 * i + 2 * j + 1] * sc) << 16);
        ((u32x4*)dst)[i] = w; }
}
struct AttnArgs { const bf16* P; const bf16* QM; const bf16* KVM; bf16* O; const float* sink; const float* lq1; const float* lk1; const float* lq2; const float* lk2; const float* dnorm; int l, nrows; };
__global__ void __launch_bounds__(256) k_attn(AttnArgs a) {
    const int r = blockIdx.x * 256 + threadIdx.x, job = blockIdx.y;
    if (r >= a.nrows) return;
    const bool lat = r < RL; const int b = lat ? r / T : (r - RL) / LC; const int t = lat ? r % T : 0;
    const int cr0 = RL + b * LC;
    const bf16* P = a.P;
    if (job < 8) {
        const int h = job, kvh = h >> 2; float q[64]; ld_bf<64>(P + (size_t)r * LDP + P_AQ + h * 64, q);
        Soft S; soft_init(S);
        const bf16* K = P + P_AK + kvh * 64; const bf16* V = P + P_AV + kvh * 64;
        if (lat) { const int j0 = t - 128 < 0 ? 0 : t - 128, j1 = t + 128 > T - 1 ? T - 1 : t + 128;
            attend<64, 0>(S, q, K, LDP, nullptr, 0, V, LDP, b * T + j0, j1 - j0 + 1, 0.125f); }
        attend<64, 0>(S, q, K, LDP, nullptr, 0, V, LDP, cr0, LC, 0.125f);
        const float sk = a.sink[a.l * 8 + h]; const float mn = fmaxf(S.m, sk); const float al = __expf(S.m - mn);
        const float l = S.l * al + __expf(sk - mn);
        store64(a.O + (size_t)r * D + h * 64, S.o, al / l);
    } else if (job < 12) {
        const int h = job - 8; float q[96]; ld_bf<96>(a.QM + (size_t)r * 384 + h * 96, q);
        Soft S; soft_init(S);
        const bf16* K1 = a.KVM + h * 128; const bf16* K2 = P + P_KR; const bf16* V = a.KVM + h * 128 + 64;
        const float sc = 0.10206207261596577f;
        if (lat) attend<64, 32>(S, q, K1, 512, K2, LDP, V, 512, b * T, T, sc);
        attend<64, 32>(S, q, K1, 512, K2, LDP, V, 512, cr0, LC, sc);
        store64(a.O + (size_t)r * D + 512 + h * 64, S.o, 1.f / S.l);
    } else {
        const int h = job - 12; const float sc = 0.17677669529663687f;
        float s1 = 0.f, s2 = 0.f;
        for (int i = 0; i < 32; ++i) { s1 += a.lq1[a.l * 32 + i] * a.lk1[a.l * 32 + i]; s2 += a.lq2[a.l * 32 + i] * a.lk2[a.l * 32 + i]; }
        const float lam_init = 0.8f - 0.6f * expf(-0.3f * (float)a.l);
        const float lam = expf(s1) - expf(s2) + lam_init;
        float o0[64];
        { float q[32]; ld_bf<32>(P + (size_t)r * LDP + P_DQ + h * 64, q);
          Soft S; soft_init(S); const bf16* K = P + P_DK + h * 64; const bf16* V = P + P_DV + h * 64;
          if (lat) attend<32, 0>(S, q, K, LDP, nullptr, 0, V, LDP, b * T, T, sc);
          attend<32, 0>(S, q, K, LDP, nullptr, 0, V, LDP, cr0, LC, sc);
          const float il = 1.f / S.l;
#pragma unroll
          for (int d = 0; d < 64; ++d) o0[d] = S.o[d] * il; }
        { float q[32]; ld_bf<32>(P + (size_t)r * LDP + P_DQ + h * 64 + 32, q);
          Soft S; soft_init(S); const bf16* K = P + P_DK + h * 64 + 32; const bf16* V = P + P_DV + h * 64;
          if (lat) attend<32, 0>(S, q, K, LDP, nullptr, 0, V, LDP, b * T, T, sc);
          attend<32, 0>(S, q, K, LDP, nullptr, 0, V, LDP, cr0, LC, sc);
          const float il = lam / S.l;
#pragma unroll
          for (int d = 0; d < 64; ++d) o0[d] -= S.o[d] * il; }
        float ss = 0.f;
#pragma unroll
        for (int d = 0; d < 64; ++d) ss += o0[d] * o0[d];
        const float rs = (1.f - lam_init) / sqrtf(ss * (1.f / 64.f) + EPS);
#pragma unroll
        for (int d = 0; d < 64; ++d) o0[d] *= a.dnorm[a.l * 64 + d];
        store64(a.O + (size_t)r * D + 768 + h * 64, o0, rs);
    }
}

__global__ void __launch_bounds__(256) k_router(const bf16* __restrict__ H, const float* __restrict__ wr, float* __restrict__ AFF, int nrows) {
    const int lane = threadIdx.x & 63, r = blockIdx.x * 4 + (threadIdx.x >> 6);
    if (r >= nrows) return;
    float acc[NE];
#pragma unroll
    for (int e = 0; e < NE; ++e) acc[e] = 0.f;
    for (int j = 0; j < 16; ++j) { const int k = lane + 64 * j; const float hv = bf2f(H[(size_t)r * D + k]);
#pragma unroll
        for (int q = 0; q < 4; ++q) { const f32x4 w = ((const f32x4*)(wr + (size_t)k * NE))[q]; acc[4 * q] += hv * w.x; acc[4 * q + 1] += hv * w.y; acc[4 * q + 2] += hv * w.z; acc[4 * q + 3] += hv * w.w; } }
    float mx = -1e30f;
#pragma unroll
    for (int e = 0; e < NE; ++e) { acc[e] = wave_sum(acc[e]); mx = fmaxf(mx, acc[e]); }
    float sum = 0.f;
#pragma unroll
    for (int e = 0; e < NE; ++e) { acc[e] = __expf(acc[e] - mx); sum += acc[e]; }
    if (lane < NE) { float v = 0.f;
#pragma unroll
        for (int e = 0; e < NE; ++e) if (lane == e) v = acc[e];
        AFF[(size_t)r * NE + lane] = v / sum; }
}
__global__ void __launch_bounds__(256) k_topk(const float* __restrict__ AFF, int* __restrict__ INV, int* __restrict__ STOK, float* __restrict__ SGATE) {
    __shared__ float av[T];
    const int set = blockIdx.x, e = blockIdx.y; const bool lat = set < 8; const int b = lat ? set : set - 8;
    const int n = lat ? T : LC, cap = lat ? CAPL : CAPC, row0 = lat ? b * T : RL + b * LC, slot0 = e * SLOTS_E + (lat ? b * CAPL : NB * CAPL + b * CAPC);
    for (int i = threadIdx.x; i < n; i += 256) av[i] = AFF[(size_t)(row0 + i) * NE + e];
    __syncthreads();
    for (int i = threadIdx.x; i < n; i += 256) { const float a = av[i]; int rank = 0;
        for (int j = 0; j < n; ++j) { const float c = av[j]; rank += (c > a || (c == a && j < i)) ? 1 : 0; }
        if (rank < cap) { STOK[slot0 + rank] = row0 + i; SGATE[slot0 + rank] = a; INV[(size_t)(row0 + i) * NE + e] = slot0 + rank; }
        else INV[(size_t)(row0 + i) * NE + e] = -1; }
}

template <int EP> static void launch_gemm(hipStream_t s, GemmArgs a) { k_gemm<EP><<<dim3(a.N / 64, a.M / 64), 256, 0, s>>>(a); }
static void launch_prep(hipStream_t s, int grid, const float* W, const float* W2, const float* kscale, bf16* Wt, int K, int N, int Nd, int kind, int nbatch, size_t sstride, size_t dstride) {
    PrepW p; memset(&p, 0, sizeof p);
    p.W = W; p.W2 = W2; p.kscale = kscale; p.Wt = Wt; p.K = K; p.N = N; p.Nd = Nd; p.kind = kind; p.nbatch = nbatch; p.sstride = sstride; p.dstride = dstride;
    k_prep_w<<<grid, 256, 0, s>>>(p);
}

extern "C" void kernel_launch(void* const* d_in, const int* in_sizes, int n_in, void* d_out, int out_size, void* d_ws, size_t ws_size, hipStream_t stream) {
    if (n_in != 25 || ws_size < WS_END) return;
    const float* x = (const float*)d_in[0]; const float* c = (const float*)d_in[1]; const float* ctx = (const float*)d_in[2]; const float* c_ctx = (const float*)d_in[3];
    const float* norm1 = (const float*)d_in[4]; const float* norm2 = (const float*)d_in[5]; const float* w_ada = (const float*)d_in[6]; const float* b_ada = (const float*)d_in[7];
    const float* w_in = (const float*)d_in[8]; const float* sink = (const float*)d_in[9]; const float* mla_q_norm = (const float*)d_in[10]; const float* w_uq = (const float*)d_in[11];
    const float* mla_kv_norm = (const float*)d_in[12]; const float* w_ukv = (const float*)d_in[13]; const float* lq1 = (const float*)d_in[14]; const float* lk1 = (const float*)d_in[15];
    const float* lq2 = (const float*)d_in[16]; const float* lk2 = (const float*)d_in[17]; const float* diff_norm = (const float*)d_in[18]; const float* w_out = (const float*)d_in[19];
    const float* w_router = (const float*)d_in[20]; const float* w_gate = (const float*)d_in[21]; const float* w_up = (const float*)d_in[22]; const float* w_down = (const float*)d_in[23];
    const float* final_norm = (const float*)d_in[24];
    char* ws = (char*)d_ws;
    float* MOD = (float*)(ws + WS_MOD); float* ROPE = (float*)(ws + WS_ROPE); float* RS = (float*)(ws + WS_RS); float* AFF = (float*)(ws + WS_AFF);
    int* INV = (int*)(ws + WS_INV); int* STOK = (int*)(ws + WS_STOK); float* SGATE = (float*)(ws + WS_SGATE); float* X = (float*)(ws + WS_X);
    bf16* ACT = (bf16*)(ws + WS_ACT); bf16* P = (bf16*)(ws + WS_P); bf16* Y = (bf16*)(ws + WS_Y); bf16* QM = (bf16*)(ws + WS_QM); bf16* KVM = (bf16*)(ws + WS_KVM);
    bf16* O = (bf16*)(ws + WS_O); bf16* HID = (bf16*)(ws + WS_HID); bf16* WB = (bf16*)(ws + WS_W);

    k_copy_x<<<2048, 256, 0, stream>>>(x, ctx, X);
    k_rope_tab<<<(T * 48 + 255) / 256, 256, 0, stream>>>(ROPE);
    k_mod<<<dim3(6144 / 256, DEPTH), 256, 0, stream>>>(c, c_ctx, w_ada, b_ada, MOD);
    for (int l = 0; l < DEPTH; ++l) {
        bf16* wl = WB + (size_t)l * W_LAYER;
        launch_prep(stream, 512, w_in + (size_t)l * D * INW, nullptr, nullptr, wl + W_IN, D, INW, LDP, WK_IN, 1, 0, 0);
        launch_prep(stream, 64, w_uq + (size_t)l * 256 * 384, nullptr, mla_q_norm + l * 256, wl + W_UQ, 256, 384, 384, WK_UQ, 1, 0, 0);
        launch_prep(stream, 64, w_ukv + (size_t)l * 128 * 512, nullptr, mla_kv_norm + l * 128, wl + W_UKV, 128, 512, 512, WK_ID, 1, 0, 0);
        launch_prep(stream, 512, w_out + (size_t)l * D * D, nullptr, nullptr, wl + W_OUT, D, D, D, WK_ID, 1, 0, 0);
        launch_prep(stream, 2048, w_gate + (size_t)l * NE * D * DE, w_up + (size_t)l * NE * D * DE, nullptr, wl + W_GU, D, DE, 1024, WK_GU, NE, (size_t)D * DE, (size_t)1024 * 1024);
        launch_prep(stream, 2048, w_down + (size_t)l * NE * DE * D, nullptr, nullptr, wl + W_DN, DE, D, D, WK_ID, NE, (size_t)DE * D, (size_t)D * DE);
    }
    for (int l = 0; l < DEPTH; ++l) {
        const bool need_ctx = l < DEPTH - 1;
        const bf16* wl = WB + (size_t)l * W_LAYER;
        const int rows_mix = need_ctx ? R : RL;
        { NormArgs a{X, MOD, norm1, ACT, INV, Y, nullptr, l, 0, R, R}; k_norm<<<2048, 256, 0, stream>>>(a); }
        { GemmArgs a; memset(&a, 0, sizeof a); a.A = ACT; a.lda = D; a.Bt = wl + W_IN; a.K = D; a.M = R; a.N = LDP; a.Cb = P; a.ldc = LDP; a.rope = ROPE; a.l = l; launch_gemm<EP_INPROJ>(stream, a); }
        k_rs<<<R / 4, 256, 0, stream>>>(P, RS);
        { GemmArgs a; memset(&a, 0, sizeof a); a.A = P + P_CQ; a.lda = LDP; a.Bt = wl + W_UQ; a.K = 256; a.M = R; a.N = 384; a.Cb = QM; a.ldc = 384; a.rope = ROPE; a.RS = RS; a.l = l; launch_gemm<EP_UPQ>(stream, a); }
        { GemmArgs a; memset(&a, 0, sizeof a); a.A = P + P_CKV; a.lda = LDP; a.Bt = wl + W_UKV; a.K = 128; a.M = R; a.N = 512; a.Cb = KVM; a.ldc = 512; a.RS = RS; a.l = l; launch_gemm<EP_UPKV>(stream, a); }
        { AttnArgs a{P, QM, KVM, O, sink, lq1, lk1, lq2, lk2, diff_norm, l, rows_mix}; k_attn<<<dim3(rows_mix / 256, 16), 256, 0, stream>>>(a); }
        { GemmArgs a; memset(&a, 0, sizeof a); a.A = O; a.lda = D; a.Bt = wl + W_OUT; a.K = D; a.M = rows_mix; a.N = D; a.X = X; a.MOD = MOD; a.l = l; launch_gemm<EP_OUT>(stream, a); }
        { NormArgs a{X, MOD, norm2, ACT, INV, Y, nullptr, l, 1, rows_mix, 0}; k_norm<<<2048, 256, 0, stream>>>(a); }
        k_router<<<rows_mix / 4, 256, 0, stream>>>(ACT, w_router + (size_t)l * D * NE, AFF, rows_mix);
        k_topk<<<dim3(need_ctx ? 16 : 8, NE), 256, 0, stream>>>(AFF, INV, STOK, SGATE);
        { GemmArgs a; memset(&a, 0, sizeof a); a.A = ACT; a.lda = D; a.Bt = wl + W_GU; a.K = D; a.M = SLOTS; a.N = DE; a.gather = STOK; a.b_estride = (size_t)1024 * 1024; a.rows_per_e = SLOTS_E; a.Cb = HID; a.ldc = DE; launch_gemm<EP_GU>(stream, a); }
        { GemmArgs a; memset(&a, 0, sizeof a); a.A = HID; a.lda = DE; a.Bt = wl + W_DN; a.K = DE; a.M = SLOTS; a.N = D; a.b_estride = (size_t)D * DE; a.rows_per_e = SLOTS_E; a.Cb = Y; a.ldc = D; a.sgate = SGATE; launch_gemm<EP_DOWN>(stream, a); }
    }
    { NormArgs a{X, MOD, final_norm, nullptr, INV, Y, (float*)d_out, DEPTH, 2, RL, RL}; k_norm<<<2048, 256, 0, stream>>>(a); }
}
```

```cpp
#include <hip/hip_runtime.h>
#include <stdint.h>
#include <string.h>
#include <stdio.h>

typedef unsigned short bf16;
typedef unsigned u32x4 __attribute__((ext_vector_type(4)));
typedef unsigned u32x2 __attribute__((ext_vector_type(2)));
typedef float f32x4 __attribute__((ext_vector_type(4)));
typedef float f32x16 __attribute__((ext_vector_type(16)));
typedef short bf16x8 __attribute__((ext_vector_type(8)));
#define LAS __attribute__((address_space(3)))
#define GAS __attribute__((address_space(1)))

constexpr int D = 1024, NB = 8, T = 2048, LC = 256, DEPTH = 4;
constexpr int RL = NB * T, RC = NB * LC, R = RL + RC;
constexpr int INW = 1952, LDP = 2048;
constexpr int NE = 16, DE = 512;
constexpr int CAPL = 256, CAPC = 32;
constexpr int SLOTS_E = NB * CAPL + NB * CAPC;
constexpr int SLOTS = NE * SLOTS_E;
constexpr float EPS = 1e-6f;
constexpr int P_AQ = 0, P_AK = 512, P_AV = 640, P_CQ = 768, P_CKV = 1024, P_KR = 1152, P_DQ = 1184, P_DK = 1440, P_DV = 1696;
constexpr int LDM = 1024;
constexpr int UPK = 384;

constexpr size_t MiB = 1u << 20;
constexpr size_t WS_CTL = 0;
constexpr size_t CTL_ZERO_BYTES = 256 * 1024;
constexpr size_t WS_MOD = 1 * MiB;
constexpr size_t WS_ROPE = 2 * MiB;
constexpr size_t WS_RSQ = 3 * MiB;
constexpr size_t WS_AFF = 4 * MiB;
constexpr size_t WS_INV = 6 * MiB;
constexpr size_t WS_STOK = 8 * MiB;
constexpr size_t WS_SGATE = 9 * MiB;
constexpr size_t WS_X = 10 * MiB;
constexpr size_t WS_ACT = 82 * MiB;
constexpr size_t WS_P = 118 * MiB;
constexpr size_t WS_Y = WS_P;
constexpr size_t WS_QKVM = 190 * MiB;
constexpr size_t WS_O = 226 * MiB;
constexpr size_t WS_HID = WS_O;
constexpr size_t WS_W = 262 * MiB;
constexpr size_t W_IN = 0;
constexpr size_t W_UP = W_IN + (size_t)LDP * D;
constexpr size_t W_OUT = W_UP + (size_t)1024 * UPK;
constexpr size_t W_GU = W_OUT + (size_t)D * D;
constexpr size_t W_DN = W_GU + (size_t)NE * 1024 * 1024;
constexpr size_t W_LAYER = W_DN + (size_t)NE * 1024 * 512;
constexpr size_t WS_END = WS_W + (size_t)DEPTH * W_LAYER * 2;

__device__ __forceinline__ unsigned f2bf(float f) { unsigned u = __builtin_bit_cast(unsigned, f); return (u + 0x7fffu + ((u >> 16) & 1u)) >> 16; }
__device__ __forceinline__ float bf2f(unsigned h) { return __builtin_bit_cast(float, h << 16); }
__device__ __forceinline__ unsigned pk2(float lo, float hi) { return f2bf(lo) | (f2bf(hi) << 16); }
__device__ __forceinline__ float wave_sum(float v) {
#pragma unroll
    for (int o = 1; o < 64; o <<= 1) v += __shfl_xor(v, o);
    return v;
}
__device__ __forceinline__ float siluf(float v) { return v / (1.f + __expf(-v)); }
#define LDS_WAIT() asm volatile("s_waitcnt lgkmcnt(0)" ::: "memory")
#define VM_WAIT() asm volatile("s_waitcnt vmcnt(0)" ::: "memory")

struct Args {
    const float* in[25]; float* out; unsigned char* ws; int ph_lo, ph_hi, li, pad;
};

namespace pg8 {
constexpr int BM = 256, BK = 64, HALF = 128, HTB = HALF * BK * 2  , STAGE_BYTES = 8 * HTB;
__host__ __device__ __forceinline__ int lds_byte(int r, int c) { const int st = (r >> 4) * 2 + (c >> 5), rr = r & 15, cc = c & 31, ob = rr * 64 + cc * 2; return st * 1024 + (ob ^ (((ob >> 9) & 1) << 5)); }
__host__ __device__ __forceinline__ void stage_rc(int b, int& R, int& C) { const int st = b / 1024, sb = b % 1024, swz = sb ^ (((sb >> 9) & 1) << 5); R = (st >> 1) * 16 + swz / 64; C = (st & 1) * 32 + (swz % 64) / 2; }
__host__ __device__ __forceinline__ int perm32(int rho) { const int n = rho >> 4, i = rho & 15; return 8 * (i >> 2) + 4 * n + (i & 3); }

struct Unit { int arow0, orow0, col0, e; };
struct Gemm { const bf16* A; const bf16* Bt; const int* gather; size_t b_estride; int lda, K; };

template <bool GATHER, class Epi, class Sched>
__device__ __forceinline__ void gemm_phase(LAS unsigned char* lds, const int tid, const Gemm g, const Sched& S, const Epi& E) {
    const int wid = __builtin_amdgcn_readfirstlane(tid >> 6), lane = tid & 63, wr = wid >> 2, wc = wid & 3, fr = lane & 15, fq = lane >> 4;
    const int K = g.K, nt = K / BK;
    unsigned voffA[2], voffB[2]; int sR[2];
#pragma unroll
    for (int i = 0; i < 2; ++i) { int C_; stage_rc(tid * 16 + i * 8192, sR[i], C_); const int Rb = (sR[i] & ~31) + perm32(sR[i] & 31);
        voffA[i] = GATHER ? (unsigned)C_ * 2u : (unsigned)(sR[i] * g.lda + C_) * 2u; voffB[i] = (unsigned)(Rb * K + C_) * 2u; }
    const unsigned lda2 = (unsigned)g.lda * 2u;
    const unsigned hstepA = (unsigned)HALF * g.lda * 2u;
    const unsigned kstep = (unsigned)(BK * 2);
    const unsigned hstepB = (unsigned)HALF * K * 2u;
    const __amdgpu_buffer_rsrc_t rsA = __builtin_amdgcn_make_buffer_rsrc((void*)g.A, 0, 0x7fffffff, 0x00020000);
    const __amdgpu_buffer_rsrc_t rsB = __builtin_amdgcn_make_buffer_rsrc((void*)g.Bt, 0, 0x7fffffff, 0x00020000);
    const unsigned ldsw = (unsigned)wid * 1024u;
    const int aoff = lds_byte(wr * 64 + fr, fq * 8), boff = lds_byte(wc * 32 + fr, fq * 8);
#define PG8_SA(b, h) (((b) * 2 + (h)) * HTB)
#define PG8_SB(b, h) ((4 + (b) * 2 + (h)) * HTB)
#define PG8_STAGE2(bufoff, rsrc, v0, v1, soff) do { \
        __builtin_amdgcn_raw_ptr_buffer_load_lds(rsrc, (LAS unsigned*)(lds + (bufoff) + ldsw), 16, (int)(v0), (int)(soff), 0, 0); \
        __builtin_amdgcn_raw_ptr_buffer_load_lds(rsrc, (LAS unsigned*)(lds + (bufoff) + ldsw + 8192), 16, (int)(v1), (int)(soff), 0, 0); } while (0)
#define PG8_STAGEB(bufoff, soff) PG8_STAGE2(bufoff, rsB, voffB[0], voffB[1], soff)
#define PG8_STAGEA(bufoff, ubase, r0, r1, h, koff) do { if constexpr (GATHER) { \
        PG8_STAGE2(bufoff, rsA, (((r0) >> (16 * (h))) & 0xffffu) * lda2 + voffA[0], (((r1) >> (16 * (h))) & 0xffffu) * lda2 + voffA[1], (koff)); } \
        else { PG8_STAGE2(bufoff, rsA, voffA[0], voffA[1], (ubase) + (h) * hstepA + (koff)); } } while (0)
#define PG8_LDA(dst, b, h) do { _Pragma("unroll") for (int m = 0; m < 4; ++m) _Pragma("unroll") for (int k = 0; k < 2; ++k) dst[m][k] = *(const LAS bf16x8*)(lds + PG8_SA(b, h) + aoff + m * 2048 + k * 1024); } while (0)
#define PG8_LDB(dst, b, h) do { _Pragma("unroll") for (int n = 0; n < 2; ++n) _Pragma("unroll") for (int k = 0; k < 2; ++k) dst[n][k] = *(const LAS bf16x8*)(lds + PG8_SB(b, h) + boff + n * 2048 + k * 1024); } while (0)
#define PG8_MMA(ai, bj, At, Bt) do { __builtin_amdgcn_s_setprio(1); _Pragma("unroll") for (int m = 0; m < 4; ++m) _Pragma("unroll") for (int n = 0; n < 2; ++n) _Pragma("unroll") for (int k = 0; k < 2; ++k) \
        acc[ai][bj][m][n] = __builtin_amdgcn_mfma_f32_16x16x32_bf16(Bt[n][k], At[m][k], acc[ai][bj][m][n], 0, 0, 0); __builtin_amdgcn_s_setprio(0); } while (0)
#define PG8_WAIT_V(n) asm volatile("s_waitcnt vmcnt(" #n ")" ::: "memory")
#define PG8_WAIT_L(n) asm volatile("s_waitcnt lgkmcnt(" #n ")" ::: "memory")
#define PG8_BAR __builtin_amdgcn_s_barrier()
#define PG8_SCHED __builtin_amdgcn_sched_barrier(0)
#define PG8_ROWS(dst, u) do { if constexpr (GATHER) { _Pragma("unroll") for (int i = 0; i < 2; ++i) { \
        const unsigned a_ = (unsigned)g.gather[(u).arow0 + sR[i]], b_ = (unsigned)g.gather[(u).arow0 + HALF + sR[i]]; dst[i] = a_ | (b_ << 16); } \
        asm volatile("" : "+v"(dst[0]), "+v"(dst[1])); } } while (0)
    Unit cur, nxt; int ui = 0;
    if (!S.next(0, cur)) return;
    f32x4 acc[2][2][4][2];
#pragma unroll
    for (int a = 0; a < 2; ++a)
#pragma unroll
        for (int b = 0; b < 2; ++b)
#pragma unroll
            for (int m = 0; m < 4; ++m)
#pragma unroll
                for (int n = 0; n < 2; ++n) acc[a][b][m][n] = (f32x4){0.f, 0.f, 0.f, 0.f};
    bf16x8 At[4][2], B0[2][2], B1[2][2];
    unsigned rp[2] = {0u, 0u}, rn[2] = {0u, 0u};
    PG8_ROWS(rp, cur);
    unsigned cA = (unsigned)cur.arow0 * lda2;
    unsigned cB = (unsigned)(((size_t)cur.e * g.b_estride + (size_t)cur.col0 * K) * 2);
    PG8_STAGEB(PG8_SB(0, 0), cB); PG8_STAGEB(PG8_SB(0, 1), cB + hstepB); PG8_STAGEA(PG8_SA(0, 0), cA, rp[0], rp[1], 0, 0); PG8_STAGEA(PG8_SA(0, 1), cA, rp[0], rp[1], 1, 0);
    if (wr == 1) PG8_BAR;
    PG8_WAIT_V(2); PG8_BAR;
    PG8_STAGEB(PG8_SB(1, 0), cB + kstep); PG8_STAGEA(PG8_SA(1, 0), cA, rp[0], rp[1], 0, kstep); PG8_STAGEB(PG8_SB(1, 1), cB + hstepB + kstep);
    PG8_WAIT_V(6); PG8_BAR;
    for (;;) {
        const bool has_next = S.next(ui + 1, nxt);
        if (has_next) { PG8_ROWS(rn, nxt); } else { rn[0] = rp[0]; rn[1] = rp[1]; }
        const unsigned nA = has_next ? (unsigned)nxt.arow0 * lda2 : cA;
        const unsigned nB = has_next ? (unsigned)(((size_t)nxt.e * g.b_estride + (size_t)nxt.col0 * K) * 2) : cB;
#pragma unroll 1
        for (int t = 0; t < nt; t += 2) {
            const bool last = (t == nt - 2);
            const unsigned k1 = (unsigned)(t + 1) * kstep, k2 = last ? 0u : (unsigned)(t + 2) * kstep, k3 = k2 + kstep;
            const unsigned u2 = last ? nA : cA; const unsigned b2 = last ? nB : cB + (unsigned)(t + 2) * kstep; const unsigned b3 = b2 + kstep;
            const unsigned q0 = last ? rn[0] : rp[0], q1 = last ? rn[1] : rp[1];
            PG8_LDB(B0, 0, 0); PG8_LDB(B1, 0, 1); PG8_SCHED; PG8_LDA(At, 0, 0); PG8_STAGEA(PG8_SA(1, 1), cA, rp[0], rp[1], 1, k1);
            PG8_WAIT_V(8); PG8_WAIT_L(0); PG8_BAR; PG8_MMA(0, 0, At, B0); PG8_MMA(0, 1, At, B1); PG8_BAR; PG8_SCHED;
            PG8_LDA(At, 0, 1); PG8_STAGEB(PG8_SB(0, 0), b2); PG8_STAGEB(PG8_SB(0, 1), b2 + hstepB); PG8_STAGEA(PG8_SA(0, 0), u2, q0, q1, 0, k2);
            PG8_WAIT_V(8); PG8_WAIT_L(0); PG8_BAR; PG8_MMA(1, 0, At, B0); PG8_MMA(1, 1, At, B1); PG8_BAR; PG8_SCHED;
            PG8_LDB(B0, 1, 0); PG8_LDB(B1, 1, 1); PG8_SCHED; PG8_LDA(At, 1, 0); PG8_STAGEA(PG8_SA(0, 1), u2, q0, q1, 1, k2);
            PG8_WAIT_V(8); PG8_WAIT_L(0); PG8_BAR; PG8_MMA(0, 0, At, B0); PG8_MMA(0, 1, At, B1); PG8_BAR; PG8_SCHED;
            PG8_LDA(At, 1, 1); PG8_STAGEB(PG8_SB(1, 0), b3); PG8_STAGEB(PG8_SB(1, 1), b3 + hstepB); PG8_STAGEA(PG8_SA(1, 0), u2, q0, q1, 0, k3);
            PG8_WAIT_V(8); PG8_WAIT_L(0); PG8_BAR; PG8_MMA(1, 0, At, B0); PG8_MMA(1, 1, At, B1); PG8_BAR; PG8_SCHED;
        }
        if (wr == 0) PG8_BAR;
        E(acc, cur, wr, wc, fr, fq);
        if (!has_next) break;
#pragma unroll
        for (int a = 0; a < 2; ++a)
#pragma unroll
            for (int b = 0; b < 2; ++b)
#pragma unroll
                for (int m = 0; m < 4; ++m)
#pragma unroll
                    for (int n = 0; n < 2; ++n) acc[a][b][m][n] = (f32x4){0.f, 0.f, 0.f, 0.f};
        cur = nxt; cB = nB; cA = nA; ++ui; rp[0] = rn[0]; rp[1] = rn[1];
        if (wr == 1) PG8_BAR;
    }
    PG8_WAIT_V(0);
    PG8_BAR;
#undef PG8_SA
#undef PG8_SB
#undef PG8_STAGE2
#undef PG8_STAGEB
#undef PG8_LDA
#undef PG8_LDB
#undef PG8_MMA
#undef PG8_WAIT_V
#undef PG8_WAIT_L
#undef PG8_BAR
#undef PG8_SCHED
#undef PG8_ROWS
#undef PG8_STAGEA
}
}

struct OrderRows {
    int x, j, gpx, rpx, nN;
    __device__ __forceinline__ bool next(int i, pg8::Unit& u) const {
        const int q = i * gpx + j; if (q >= rpx * nN) return false;
        const int pm = x * rpx + q / nN, pn = q % nN; u.arow0 = pm * 256; u.orow0 = pm * 256; u.col0 = pn * 256; u.e = 0; return true; }
};
struct OrderMoe {
    int x, j, gpx, nME, nN;
    __device__ __forceinline__ bool next(int i, pg8::Unit& u) const {
        const int q = i * gpx + j, per = nME * nN; if (q >= 2 * per) return false;
        const int e = 2 * x + q / per, rem = q % per, pmE = rem / nN, pn = rem % nN;
        u.arow0 = e * SLOTS_E + pmE * 256; u.orow0 = u.arow0; u.col0 = pn * 256; u.e = e; return true; }
};

typedef float f32x4e __attribute__((ext_vector_type(4)));
#define EPI_ROWS(ai, m) (u.orow0 + (ai) * 128 + wr * 64 + (m) * 16 + fr)
#define EPI_COL0(bj) (u.col0 + (bj) * 128 + wc * 32 + 8 * fq)
__device__ __forceinline__ void rope8(f32x4& v0, f32x4& v1, const float* cs, const float* sn) {
    const f32x4 c = *(const f32x4*)cs, s = *(const f32x4*)sn;
    f32x4 a = v0, b = v1;
    v0.x = a.x * c.x - a.y * s.x; v0.y = a.y * c.x + a.x * s.x; v0.z = a.z * c.y - a.w * s.y; v0.w = a.w * c.y + a.z * s.y;
    v1.x = b.x * c.z - b.y * s.z; v1.y = b.y * c.z + b.x * s.z; v1.z = b.z * c.w - b.w * s.w; v1.w = b.w * c.w + b.z * s.w;
}
__device__ __forceinline__ u32x4 pack8(const f32x4 v0, const f32x4 v1) { u32x4 w; w.x = pk2(v0.x, v0.y); w.y = pk2(v0.z, v0.w); w.z = pk2(v1.x, v1.y); w.w = pk2(v1.z, v1.w); return w; }

struct EpiInProj {
    bf16* P; const float* rope; float* RSQ;
    __device__ __forceinline__ void operator()(const f32x4 (&acc)[2][2][4][2], const pg8::Unit& u, int wr, int wc, int fr, int fq) const {
        const bool lat = u.orow0 < RL;
#pragma unroll
        for (int bj = 0; bj < 2; ++bj) {
            const int c0 = EPI_COL0(bj);
            const bool secA = c0 < P_AV, secB = c0 >= P_KR && c0 < P_DV;
            const int which = (c0 >= P_CQ && c0 < P_CKV) ? 0 : ((c0 >= P_CKV && c0 < P_KR) ? 1 : -1);
            const int p0 = secA ? ((c0 & 63) >> 1) : ((c0 & 31) >> 1);
#pragma unroll
            for (int ai = 0; ai < 2; ++ai)
#pragma unroll
                for (int m = 0; m < 4; ++m) {
                    const int row = EPI_ROWS(ai, m);
                    f32x4 v0 = acc[ai][bj][m][0], v1 = acc[ai][bj][m][1];
                    if (lat && (secA || secB)) { const int t = row & (T - 1);
                        const float* cs = secA ? rope + t * 32 + p0 : rope + T * 64 + t * 16 + p0;
                        const float* sn = secA ? rope + T * 32 + t * 32 + p0 : rope + T * 64 + T * 16 + t * 16 + p0;
                        rope8(v0, v1, cs, sn); }
                    if (which >= 0) { float s = (v0.x * v0.x + v0.y * v0.y) + (v0.z * v0.z + v0.w * v0.w) + (v1.x * v1.x + v1.y * v1.y) + (v1.z * v1.z + v1.w * v1.w);
                        s += __shfl_xor(s, 16); s += __shfl_xor(s, 32);
                        if (fq == 0) atomicAdd(RSQ + (size_t)row * 2 + which, s); }
                    *(u32x4*)(P + (size_t)row * LDP + c0) = pack8(v0, v1);
                }
        }
    }
};
struct EpiUp {
    bf16* QKVM; const float* rope; const float* RSQ;
    __device__ __forceinline__ void operator()(const f32x4 (&acc)[2][2][4][2], const pg8::Unit& u, int wr, int wc, int fr, int fq) const {
        const bool isq = u.col0 < 512; const bool lat = u.orow0 < RL;
        const float* rq = RSQ + (isq ? 0 : 1); const float inv = isq ? (1.f / 256.f) : (1.f / 128.f);
        const int cw = u.col0 + wc * 32 + 8 * fq;
        int j0 = cw; j0 -= j0 >= 192 ? 192 : 0; j0 -= j0 >= 96 ? 96 : 0;
        int j1 = j0 + 32; j1 -= j1 >= 96 ? 96 : 0;
        const bool rot0 = lat && isq && cw < 384 && j0 >= 64, rot1 = lat && isq && cw + 128 < 384 && j1 >= 64;
        const float* tb = rope + T * 64;
#pragma unroll
        for (int ai = 0; ai < 2; ++ai)
#pragma unroll
            for (int m = 0; m < 4; ++m) {
                const int row = EPI_ROWS(ai, m);
                const float rs = __builtin_amdgcn_rsqf(rq[(size_t)row * 2] * inv + EPS);
                const int t = row & (T - 1);
                bf16* dst = QKVM + (size_t)row * LDM + cw;
                { f32x4 v0 = acc[ai][0][m][0] * rs, v1 = acc[ai][0][m][1] * rs;
                  if (rot0) rope8(v0, v1, tb + t * 16 + ((j0 - 64) >> 1), tb + T * 16 + t * 16 + ((j0 - 64) >> 1));
                  *(u32x4*)dst = pack8(v0, v1); }
                { f32x4 v0 = acc[ai][1][m][0] * rs, v1 = acc[ai][1][m][1] * rs;
                  if (rot1) rope8(v0, v1, tb + t * 16 + ((j1 - 64) >> 1), tb + T * 16 + t * 16 + ((j1 - 64) >> 1));
                  *(u32x4*)(dst + 128) = pack8(v0, v1); }
            }
    }
};
struct EpiOut {
    float* X; const float* MODl;
    __device__ __forceinline__ void operator()(const f32x4 (&acc)[2][2][4][2], const pg8::Unit& u, int wr, int wc, int fr, int fq) const {
        const int mb = u.orow0 < RL ? u.orow0 / T : 8;
        const float* g1 = MODl + (size_t)mb * 6144 + 2048;
#pragma unroll
        for (int bj = 0; bj < 2; ++bj) {
            const int c0 = EPI_COL0(bj);
            const f32x4 ga = *(const f32x4*)(g1 + c0), gb = *(const f32x4*)(g1 + c0 + 4);
#pragma unroll
            for (int ai = 0; ai < 2; ++ai)
#pragma unroll
                for (int m = 0; m < 4; ++m) {
                    float* xp = X + (size_t)EPI_ROWS(ai, m) * D + c0;
                    f32x4 xa = *(const f32x4*)xp, xb = *(const f32x4*)(xp + 4);
                    xa += ga * acc[ai][bj][m][0]; xb += gb * acc[ai][bj][m][1];
                    *(f32x4*)xp = xa; *(f32x4*)(xp + 4) = xb;
                }
        }
    }
};
struct EpiGU {
    bf16* HID;
    __device__ __forceinline__ void operator()(const f32x4 (&acc)[2][2][4][2], const pg8::Unit& u, int wr, int wc, int fr, int fq) const {
#pragma unroll
        for (int bj = 0; bj < 2; ++bj) {
            const int hc = EPI_COL0(bj) >> 1;
#pragma unroll
            for (int ai = 0; ai < 2; ++ai)
#pragma unroll
                for (int m = 0; m < 4; ++m) {
                    const f32x4 g = acc[ai][bj][m][0], up = acc[ai][bj][m][1];
                    u32x2 w; w.x = pk2(siluf(g.x) * up.x, siluf(g.y) * up.y); w.y = pk2(siluf(g.z) * up.z, siluf(g.w) * up.w);
                    *(u32x2*)(HID + (size_t)EPI_ROWS(ai, m) * DE + hc) = w;
                }
        }
    }
};
struct EpiDown {
    bf16* Y; const float* SGATE;
    __device__ __forceinline__ void operator()(const f32x4 (&acc)[2][2][4][2], const pg8::Unit& u, int wr, int wc, int fr, int fq) const {
#pragma unroll
        for (int ai = 0; ai < 2; ++ai)
#pragma unroll
            for (int m = 0; m < 4; ++m) {
                const int row = EPI_ROWS(ai, m); const float gt = SGATE[row];
#pragma unroll
                for (int bj = 0; bj < 2; ++bj)
                    *(u32x4*)(Y + (size_t)row * D + EPI_COL0(bj)) = pack8(acc[ai][bj][m][0] * gt, acc[ai][bj][m][1] * gt);
            }
    }
};

constexpr int NWAVES = 8;
constexpr int RING_BYTES = 131072;
constexpr int LDSCTL_OFF = RING_BYTES, MISC_OFF = LDSCTL_OFF + 320;
constexpr int LDS_BYTES = 147456;
constexpr int CW_BAR = 4096;
typedef GAS unsigned gu32;

#define XB_TMO      128
#define XB_XCNT(j)  (256  + 64 * (j))
#define XB_XSUB(j)  (1280 + 64 * (j))
#define XB_XGEN(j)  (2304 + 64 * (j))
#define XB_TOP      3328
#define XB_TOPGEN   3392
#define XCD_BAR_WORDS 3456
#define XB_SPIN_CAP (1u << 18)
__device__ __forceinline__ unsigned xb_ld(unsigned* p)              { return __hip_atomic_load(p, __ATOMIC_RELAXED, __HIP_MEMORY_SCOPE_AGENT); }
__device__ __forceinline__ unsigned xb_add(unsigned* p, unsigned v) { return __hip_atomic_fetch_add(p, v, __ATOMIC_RELAXED, __HIP_MEMORY_SCOPE_AGENT); }
__device__ __forceinline__ unsigned xb_xcc_id() { return (unsigned)__builtin_amdgcn_s_getreg((3 << 11) | 20) & 0xFu; }
#define XB_SPIN(cond, bar) do { unsigned _sp = 0; while (cond) { __builtin_amdgcn_s_sleep(1); \
    if ((++_sp & 255u) == 0u) { if (xb_ld(&(bar)[XB_TMO])) break; if (_sp > XB_SPIN_CAP) { atomicAdd(&(bar)[XB_TMO], 1u); break; } } } } while (0)
struct XcdBarrier { unsigned* bar; unsigned x; volatile LAS unsigned* st; };
__device__ __forceinline__ XcdBarrier xcd_barrier_post(unsigned* bar, volatile LAS unsigned* st) {
    XcdBarrier b; b.bar = bar; b.x = xb_xcc_id(); b.st = st;
    if (threadIdx.x == 0) (void)xb_add(&bar[XB_XCNT(b.x)], 1u);
    return b;
}
__device__ __forceinline__ void xcd_barrier_complete(unsigned* bar, unsigned x, unsigned& nloc, unsigned& nx) {
    const unsigned G = gridDim.x * gridDim.y * gridDim.z;
    unsigned sum, cnt, mine, sp = 0u;
    for (;;) {
        sum = 0u; cnt = 0u; mine = 0u;
#pragma unroll
        for (unsigned j = 0; j < 16; ++j) { const unsigned c = xb_ld(&bar[XB_XCNT(j)]); sum += c; cnt += (c > 0u) ? 1u : 0u; mine = (j == x) ? c : mine; }
        if (sum == G) break;
        __builtin_amdgcn_s_sleep(1);
        if ((++sp & 255u) == 0u) { if (xb_ld(&bar[XB_TMO])) break; if (sp > XB_SPIN_CAP) { atomicAdd(&bar[XB_TMO], 1u); break; } }
    }
    nloc = mine > 0u ? mine : 1u; nx = cnt > 0u ? cnt : 1u;
}
__device__ __forceinline__ void xcd_barrier(const XcdBarrier& b, const int tid) {
    asm volatile("s_waitcnt vmcnt(0)" ::: "memory");
    __syncthreads();
    if (tid == 0) {
        unsigned* bar = b.bar;
        __builtin_amdgcn_s_waitcnt(0);
        unsigned nloc = b.st[0], nx = b.st[1];
        if (nloc == 0u) { xcd_barrier_complete(bar, b.x, nloc, nx); b.st[0] = nloc; b.st[1] = nx; }
        const unsigned old = xb_add(&bar[XB_XSUB(b.x)], 1u);
        const unsigned gen = old / nloc;
        if (old + 1u == (gen + 1u) * nloc) {
            __builtin_amdgcn_fence(__ATOMIC_RELEASE, "agent");
            asm volatile("s_waitcnt vmcnt(0)" ::: "memory");
            const unsigned og = xb_add(&bar[XB_TOP], 1u);
            const unsigned tg = og / nx;
            if (og + 1u == (tg + 1u) * nx) xb_add(&bar[XB_TOPGEN], 1u);
            else XB_SPIN(xb_ld(&bar[XB_TOPGEN]) == tg, bar);
            __builtin_amdgcn_fence(__ATOMIC_ACQUIRE, "agent");
            xb_add(&bar[XB_XGEN(b.x)], 1u);
            asm volatile("s_waitcnt vmcnt(0)" ::: "memory");
        } else {
            XB_SPIN(xb_ld(&bar[XB_XGEN(b.x)]) == gen, bar);
            __builtin_amdgcn_fence(__ATOMIC_ACQUIRE, "agent");
            asm volatile("s_waitcnt vmcnt(0)" ::: "memory");
        }
    }
    __syncthreads();
}

struct Frame { LAS unsigned char* lds; int tid, lane, wave, bid, G; const float* const* in; float* out; unsigned char* ws; };
#define IN_(k) (F.in[(k)])
#define F_x IN_(0)
#define F_c IN_(1)
#define F_ctx IN_(2)
#define F_c_ctx IN_(3)
#define F_norm1 IN_(4)
#define F_norm2 IN_(5)
#define F_w_ada IN_(6)
#define F_b_ada IN_(7)
#define F_w_in IN_(8)
#define F_sink IN_(9)
#define F_mla_q_norm IN_(10)
#define F_w_uq IN_(11)
#define F_mla_kv_norm IN_(12)
#define F_w_ukv IN_(13)
#define F_lq1 IN_(14)
#define F_lk1 IN_(15)
#define F_lq2 IN_(16)
#define F_lk2 IN_(17)
#define F_diff_norm IN_(18)
#define F_w_out IN_(19)
#define F_w_router IN_(20)
#define F_w_gate IN_(21)
#define F_w_up IN_(22)
#define F_w_down IN_(23)
#define F_final_norm IN_(24)
#define F_MOD ((float*)(F.ws + WS_MOD))
#define F_ROPE ((float*)(F.ws + WS_ROPE))
#define F_RSQ ((float*)(F.ws + WS_RSQ))
#define F_AFF ((float*)(F.ws + WS_AFF))
#define F_INV ((int*)(F.ws + WS_INV))
#define F_STOK ((int*)(F.ws + WS_STOK))
#define F_SGATE ((float*)(F.ws + WS_SGATE))
#define F_X ((float*)(F.ws + WS_X))
#define F_ACT ((bf16*)(F.ws + WS_ACT))
#define F_P ((bf16*)(F.ws + WS_P))
#define F_Y ((bf16*)(F.ws + WS_Y))
#define F_QKVM ((bf16*)(F.ws + WS_QKVM))
#define F_O ((bf16*)(F.ws + WS_O))
#define F_HID ((bf16*)(F.ws + WS_HID))
#define F_WB ((bf16*)(F.ws + WS_W))

__device__ __forceinline__ int rot64(int dp) { const int p = dp >> 1, half = dp & 1, axis = p >> 4, f = p & 15; return axis * 32 + half * 16 + f; }
__device__ __forceinline__ int rot32(int dp) { const int p = dp >> 1, half = dp & 1, axis = p >> 3, f = p & 7; return axis * 16 + half * 8 + f; }
__device__ __forceinline__ int src_col_in(int n) {
    if (n >= INW) return -1;
    if (n < P_AV) return (n & ~63) + rot64(n & 63);
    if (n >= P_KR && n < P_DV) return (n & ~31) + rot32(n & 31);
    return n;
}
__device__ __forceinline__ void prep_tile(const float* src, int N, int k0, const float* kscale, bf16* dst, int ldd, LAS float* scr, int lane) {
    float v[32];
#pragma unroll
    for (int i = 0; i < 32; ++i) { const int kk = 2 * i + (lane >> 5); v[i] = src ? src[(size_t)(k0 + kk) * N] : 0.f; }
    if (kscale) {
#pragma unroll
        for (int i = 0; i < 32; ++i) v[i] *= kscale[k0 + 2 * i + (lane >> 5)]; }
#pragma unroll
    for (int i = 0; i < 32; ++i) scr[(2 * i + (lane >> 5)) * 33 + (lane & 31)] = v[i];
    LDS_WAIT();
    const int c = lane & 7;
#pragma unroll
    for (int j = 0; j < 4; ++j) { const int n = (lane >> 3) + 8 * j; const LAS float* s = scr + (8 * c) * 33 + n;
        u32x4 o; o.x = pk2(s[0], s[33]); o.y = pk2(s[66], s[99]); o.z = pk2(s[132], s[165]); o.w = pk2(s[198], s[231]);
        *(u32x4*)(dst + (size_t)n * ldd + 8 * c) = o; }
    LDS_WAIT();
}
constexpr int PI_IN = 16 * 64, PI_UP = 6 * 32, PI_OUT = 16 * 32, PI_GU = NE * 16 * 32, PI_DN = NE * 8 * 32, PI_LAYER = PI_IN + PI_UP + PI_OUT + PI_GU + PI_DN;
__device__ __forceinline__ void p0_phase(Frame& F) {
    const int tid = F.tid, lane = F.lane, wave = F.wave;
    {
        LAS float* sl = (LAS float*)F.lds;
        LAS float* red = (LAS float*)(F.lds + 36864);
        for (int i = tid; i < 9 * 1024; i += 512) { const float v = i < 8 * 1024 ? F_c[i] : F_c_ctx[i - 8 * 1024]; sl[i] = siluf(v); }
        __syncthreads();
        for (int it = F.bid; it < DEPTH * 96; it += F.G) {
            const int l = it / 96, cg = it % 96, col = cg * 64 + lane;
            float acc[9];
#pragma unroll
            for (int r = 0; r < 9; ++r) acc[r] = 0.f;
            const float* w = F_w_ada + (size_t)l * D * 6144 + (size_t)(wave * 128) * 6144 + col;
#pragma unroll 16
            for (int k = 0; k < 128; ++k) { const float wv = w[(size_t)k * 6144];
#pragma unroll
                for (int r = 0; r < 9; ++r) acc[r] += sl[r * 1024 + wave * 128 + k] * wv; }
#pragma unroll
            for (int r = 0; r < 9; ++r) red[(wave * 9 + r) * 64 + lane] = acc[r];
            __syncthreads();
            for (int o = tid; o < 576; o += 512) { const int r = o >> 6, cc = o & 63; float s = 0.f;
#pragma unroll
                for (int w8 = 0; w8 < 8; ++w8) s += red[(w8 * 9 + r) * 64 + cc];
                F_MOD[((size_t)l * 9 + r) * 6144 + cg * 64 + cc] = s + F_b_ada[l * 6144 + cg * 64 + cc]; }
            __syncthreads();
        }
    }
    const int gw = F.bid * NWAVES + wave, NGW = F.G * NWAVES;
    { const size_t n4 = (size_t)R * D / 4, nl4 = (size_t)RL * D / 4;
      for (size_t i = (size_t)F.bid * 512 + tid; i < n4; i += (size_t)F.G * 512) { const f32x4 v = i < nl4 ? ((const f32x4*)F_x)[i] : ((const f32x4*)F_ctx)[i - nl4]; ((f32x4*)F_X)[i] = v; } }
    for (int i = F.bid * 512 + tid; i < T * 48; i += F.G * 512) {
        const int t = i / 48, j = i % 48; int axis, f, nf;
        if (j < 32) { axis = j >> 4; f = j & 15; nf = 16; } else { axis = (j - 32) >> 3; f = (j - 32) & 7; nf = 8; }
        const float inv = exp2f(-(float)f / (float)nf * 13.287712379549449f);
        const float ang = (float)(axis == 0 ? (t >> 6) : (t & 63)) * inv;
        const float cv = cosf(ang), sv = sinf(ang);
        if (j < 32) { F_ROPE[t * 32 + j] = cv; F_ROPE[T * 32 + t * 32 + j] = sv; } else { F_ROPE[T * 64 + t * 16 + j - 32] = cv; F_ROPE[T * 64 + T * 16 + t * 16 + j - 32] = sv; }
    }
    LAS float* scr = (LAS float*)(F.lds + 57344 + wave * 8448);
    for (int it = gw; it < DEPTH * PI_LAYER; it += NGW) {
        const int l = it / PI_LAYER; int r = it % PI_LAYER; bf16* wl = F_WB + (size_t)l * W_LAYER;
        const int nl = lane & 31;
        if (r < PI_IN) { const int kb = r / 64, nb = r % 64, n = nb * 32 + nl, sc = src_col_in(n);
            prep_tile(sc >= 0 ? F_w_in + (size_t)l * D * INW + sc : nullptr, INW, kb * 64, nullptr, wl + W_IN + (size_t)(nb * 32) * D + kb * 64, D, scr, lane); continue; } r -= PI_IN;
        if (r < PI_UP) { const int kb = r / 32, nb = r % 32, n = nb * 32 + nl, k0 = kb * 64; const float* src = nullptr; const float* ks = nullptr; int N = 384, ksrc = k0;
            if (n < 384 && k0 < 256) { const int h = n / 96, j = n % 96; const int sc = j < 64 ? n : h * 96 + 64 + rot32(j - 64); src = F_w_uq + (size_t)l * 256 * 384 + sc; ks = F_mla_q_norm + l * 256; N = 384; }
            else if (n >= 512 && k0 >= 256) { src = F_w_ukv + (size_t)l * 128 * 512 + (n - 512); ks = F_mla_kv_norm + l * 128; N = 512; ksrc = k0 - 256; }
            { float v[32];
#pragma unroll
              for (int i = 0; i < 32; ++i) { const int kk = 2 * i + (lane >> 5); v[i] = src ? src[(size_t)(ksrc + kk) * N] * ks[ksrc + kk] : 0.f; }
#pragma unroll
              for (int i = 0; i < 32; ++i) scr[(2 * i + (lane >> 5)) * 33 + (lane & 31)] = v[i];
              LDS_WAIT();
              const int c = lane & 7; bf16* dst = wl + W_UP + (size_t)(nb * 32) * UPK + k0;
#pragma unroll
              for (int j = 0; j < 4; ++j) { const int nn = (lane >> 3) + 8 * j; const LAS float* s = scr + (8 * c) * 33 + nn;
                  u32x4 o; o.x = pk2(s[0], s[33]); o.y = pk2(s[66], s[99]); o.z = pk2(s[132], s[165]); o.w = pk2(s[198], s[231]);
                  *(u32x4*)(dst + (size_t)nn * UPK + 8 * c) = o; }
              LDS_WAIT(); }
            continue; } r -= PI_UP;
        if (r < PI_OUT) { const int kb = r / 32, nb = r % 32;
            prep_tile(F_w_out + (size_t)l * D * D + nb * 32 + nl, D, kb * 64, nullptr, wl + W_OUT + (size_t)(nb * 32) * D + kb * 64, D, scr, lane); continue; } r -= PI_OUT;
        if (r < PI_GU) { const int e = r / 512, q = r % 512, kb = q / 32, nb = q % 32, n = nb * 32 + nl, f = (n >> 3) * 4 + (n & 3);
            const float* src = ((n & 4) ? F_w_up : F_w_gate) + ((size_t)l * NE + e) * D * DE + f;
            prep_tile(src, DE, kb * 64, nullptr, wl + W_GU + (size_t)e * 1024 * 1024 + (size_t)(nb * 32) * D + kb * 64, D, scr, lane); continue; } r -= PI_GU;
        { const int e = r / 256, q = r % 256, kb = q / 32, nb = q % 32;
            prep_tile(F_w_down + ((size_t)l * NE + e) * DE * D + nb * 32 + nl, D, kb * 64, nullptr, wl + W_DN + (size_t)e * 1024 * 512 + (size_t)(nb * 32) * DE + kb * 64, DE, scr, lane); }
    }
}

__device__ __forceinline__ void norm_phase(Frame& F, int l, int mode, int nrows) {
    const int lane = F.lane, gw = F.bid * NWAVES + F.wave, NGW = F.G * NWAVES;
    LAS float* wrT = (LAS float*)F.lds;
    if (mode == 1) {
        const float* wr = F_w_router + (size_t)l * D * NE;
        for (int i = F.tid; i < D * NE; i += 512) wrT[(i & 15) * 1028 + (i >> 4)] = wr[i];
        __syncthreads();
    }
    const float* gain = mode == 0 ? F_norm1 + (size_t)l * D : (mode == 1 ? F_norm2 + (size_t)l * D : F_final_norm);
    for (int r = gw; r < nrows; r += NGW) {
        const int mb = r < RL ? r / T : 8;
        float* xr = F_X + (size_t)r * D;
        f32x4 v[4];
#pragma unroll
        for (int j = 0; j < 4; ++j) v[j] = ((const f32x4*)xr)[lane + 64 * j];
        if (mode != 1 && l > 0) {
            const float* g2 = F_MOD + ((size_t)(l - 1) * 9 + mb) * 6144 + 5120;
            f32x4 s[4];
#pragma unroll
            for (int j = 0; j < 4; ++j) s[j] = (f32x4){0.f, 0.f, 0.f, 0.f};
            const int myinv = lane < NE ? F_INV[(size_t)r * NE + lane] : -1;
            for (int e = 0; e < NE; ++e) { const int sl = __shfl(myinv, e);
                if (sl >= 0) { const bf16* yr = F_Y + (size_t)sl * D;
#pragma unroll
                    for (int j = 0; j < 4; ++j) { const u32x2 w = ((const u32x2*)yr)[lane + 64 * j];
                        s[j].x += bf2f(w.x & 0xffff); s[j].y += bf2f(w.x >> 16); s[j].z += bf2f(w.y & 0xffff); s[j].w += bf2f(w.y >> 16); } } }
#pragma unroll
            for (int j = 0; j < 4; ++j) { const f32x4 g = ((const f32x4*)g2)[lane + 64 * j]; v[j] += g * s[j]; ((f32x4*)xr)[lane + 64 * j] = v[j]; }
        }
        if (mode == 0 && lane < 2) F_RSQ[(size_t)r * 2 + lane] = 0.f;
        float ss = 0.f;
#pragma unroll
        for (int j = 0; j < 4; ++j) ss += (v[j].x * v[j].x + v[j].y * v[j].y) + (v[j].z * v[j].z + v[j].w * v[j].w);
        const float rs = 1.0f / sqrtf(wave_sum(ss) * (1.f / D) + EPS);
        if (mode == 2) {
#pragma unroll
            for (int j = 0; j < 4; ++j) { const f32x4 g = ((const f32x4*)gain)[lane + 64 * j]; ((f32x4*)(F.out + (size_t)r * D))[lane + 64 * j] = v[j] * rs * g; }
        } else {
            const float* md = F_MOD + ((size_t)l * 9 + mb) * 6144 + (mode == 0 ? 0 : 3072);
#pragma unroll
            for (int j = 0; j < 4; ++j) { const f32x4 g = ((const f32x4*)gain)[lane + 64 * j];
                const f32x4 sh = ((const f32x4*)md)[lane + 64 * j], sc = ((const f32x4*)(md + 1024))[lane + 64 * j];
                v[j] = v[j] * rs * g * (sc + 1.0f) + sh;
                u32x2 w; w.x = pk2(v[j].x, v[j].y); w.y = pk2(v[j].z, v[j].w);
                ((u32x2*)(F_ACT + (size_t)r * D))[lane + 64 * j] = w; }
            if (mode == 1) {
                float mine = -1e30f;
#pragma unroll 2
                for (int e = 0; e < NE; ++e) { float a = 0.f;
#pragma unroll
                    for (int j = 0; j < 4; ++j) { const f32x4 w = *(const LAS f32x4*)(wrT + e * 1028 + 256 * j + 4 * lane); a += (v[j].x * w.x + v[j].y * w.y) + (v[j].z * w.z + v[j].w * w.w); }
                    a = wave_sum(a); mine = lane == e ? a : mine; }
                float mx = mine;
#pragma unroll
                for (int o = 1; o < 16; o <<= 1) mx = fmaxf(mx, __shfl_xor(mx, o));
                const float ex = __expf(mine - mx); float sum = ex;
#pragma unroll
                for (int o = 1; o < 16; o <<= 1) sum += __shfl_xor(sum, o);
                if (lane < NE) F_AFF[(size_t)r * NE + lane] = ex / sum;
            }
        }
    }
}

__device__ __forceinline__ void topk_phase(Frame& F, int nsets) {
    LAS unsigned* cnt = (LAS unsigned*)F.lds;
    const int tid = F.tid, lane = F.lane, wave = F.wave;
    for (int it = F.bid; it < nsets * NE; it += F.G) {
        const int set = it / NE, e = it % NE; const bool lat = set < 8; const int b = lat ? set : set - 8;
        const int n = lat ? T : LC, cap = lat ? CAPL : CAPC, row0 = lat ? b * T : RL + b * LC, slot0 = e * SLOTS_E + (lat ? b * CAPL : NB * CAPL + b * CAPC);
        unsigned v[4];
#pragma unroll
        for (int q = 0; q < 4; ++q) { const int idx = 4 * tid + q; v[q] = idx < n ? __builtin_bit_cast(unsigned, F_AFF[(size_t)(row0 + idx) * NE + e]) : 0u; }
        unsigned prefix = 0u; int par = 0;
        for (int bit = 30; bit >= 0; --bit) {
            const unsigned cand = prefix | (1u << bit);
            unsigned c = 0;
#pragma unroll
            for (int q = 0; q < 4; ++q) c += (unsigned)__popcll(__ballot(v[q] >= cand));
            if (lane == 0) cnt[par * 8 + wave] = c;
            __syncthreads();
            unsigned tot = 0;
#pragma unroll
            for (int w = 0; w < 8; ++w) tot += cnt[par * 8 + w];
            if (tot >= (unsigned)cap) prefix = cand;
            par ^= 1;
        }
        unsigned g4 = 0, e4 = 0;
#pragma unroll
        for (int q = 0; q < 4; ++q) { g4 += v[q] > prefix ? 1u : 0u; e4 += v[q] == prefix ? 1u : 0u; }
        unsigned pk = g4 | (e4 << 16), inc = pk;
#pragma unroll
        for (int o = 1; o < 64; o <<= 1) { const unsigned t = __shfl_up(inc, o); if (lane >= o) inc += t; }
        __syncthreads();
        if (lane == 63) cnt[16 + wave] = inc;
        __syncthreads();
        unsigned base = 0, total = 0;
#pragma unroll
        for (int w = 0; w < 8; ++w) { const unsigned t = cnt[16 + w]; total += t; if (w < wave) base += t; }
        const unsigned excl = base + inc - pk;
        unsigned gpre = excl & 0xffffu, epre = excl >> 16; const unsigned need = (unsigned)cap - (total & 0xffffu);
#pragma unroll
        for (int q = 0; q < 4; ++q) { const int idx = 4 * tid + q;
            if (idx < n) { const bool isg = v[q] > prefix, ise = v[q] == prefix; const bool sel = isg || (ise && epre < need);
                const int slot = slot0 + (int)(gpre + (epre < need ? epre : need));
                if (sel) { F_STOK[slot] = row0 + idx; F_SGATE[slot] = __builtin_bit_cast(float, v[q]); }
                F_INV[(size_t)(row0 + idx) * NE + e] = sel ? slot : -1;
                gpre += isg ? 1u : 0u; epre += ise ? 1u : 0u; } }
        __syncthreads();
    }
}

template <int N> __device__ __forceinline__ void ld_bf(const bf16* p, float (&d)[N]) {
#pragma unroll
    for (int i = 0; i < N / 8; ++i) { const u32x4 w = ((const u32x4*)p)[i];
#pragma unroll
        for (int j = 0; j < 4; ++j) { d[8 * i + 2 * j] = bf2f(w[j] & 0xffff); d[8 * i + 2 * j + 1] = bf2f(w[j] >> 16); } }
}
template <int N, int QO, int QN> __device__ __forceinline__ float dot_bf(const bf16* p, const float (&q)[QN]) {
    float s = 0.f;
#pragma unroll
    for (int i = 0; i < N / 8; ++i) { const u32x4 w = ((const u32x4*)p)[i];
#pragma unroll
        for (int j = 0; j < 4; ++j) s += q[QO + 8 * i + 2 * j] * bf2f(w[j] & 0xffff) + q[QO + 8 * i + 2 * j + 1] * bf2f(w[j] >> 16); }
    return s;
}
struct Soft { float m, l; float o[64]; };
template <int D1, int D2> __device__ __forceinline__ void attend(Soft& S, const float (&q)[D1 + D2], const bf16* K1, int ld1, const bf16* K2, int ld2, const bf16* V, int ldv, int r0, int cnt, float scale) {
    for (int r = r0; r < r0 + cnt; ++r) {
        float s = dot_bf<D1, 0, D1 + D2>(K1 + (size_t)r * ld1, q);
        if constexpr (D2 > 0) s += dot_bf<D2, D1, D1 + D2>(K2 + (size_t)r * ld2, q);
        s *= scale;
        const float mn = fmaxf(S.m, s), al = __expf(S.m - mn), p = __expf(s - mn);
        S.m = mn; S.l = S.l * al + p;
        const bf16* vr = V + (size_t)r * ldv;
#pragma unroll
        for (int i = 0; i < 8; ++i) { const u32x4 w = ((const u32x4*)vr)[i];
#pragma unroll
            for (int j = 0; j < 4; ++j) { S.o[8 * i + 2 * j] = S.o[8 * i + 2 * j] * al + p * bf2f(w[j] & 0xffff); S.o[8 * i + 2 * j + 1] = S.o[8 * i + 2 * j + 1] * al + p * bf2f(w[j] >> 16); } }
    }
}
__device__ __forceinline__ void soft_init(Soft& S) { S.m = -1e30f; S.l = 0.f;
#pragma unroll
    for (int d = 0; d < 64; ++d) S.o[d] = 0.f; }
__device__ __forceinline__ void store64(bf16* dst, const float (&o)[64], float sc) {
#pragma unroll
    for (int i = 0; i < 8; ++i) { u32x4 w;
#pragma unroll
        for (int j = 0; j < 4; ++j) w[j] = f2bf(o[8 * i + 2 * j] * sc) | (f2bf(o[8 * i + 2 * j + 1] * sc) << 16);
        ((u32x4*)dst)[i] = w; }
}
struct AttnArgs { const bf16* P; const bf16* QM; const bf16* KVM; bf16* O; const float* sink; const float* lq1; const float* lk1; const float* lq2; const float* lk2; const float* dnorm; int l, nrows; };
__global__ void __launch_bounds__(256) k_attn(AttnArgs a) {
    const int r = blockIdx.x * 256 + threadIdx.x, job = blockIdx.y;
    if (r >= a.nrows) return;
    const bool lat = r < RL; const int b = lat ? r / T : (r - RL) / LC; const int t = lat ? r % T : 0;
    const int cr0 = RL + b * LC;
    const bf16* P = a.P;
    if (job < 8) {
        const int h = job, kvh = h >> 2; float q[64]; ld_bf<64>(P + (size_t)r * LDP + P_AQ + h * 64, q);
        Soft S; soft_init(S);
        const bf16* K = P + P_AK + kvh * 64; const bf16* V = P + P_AV + kvh * 64;
        if (lat) { const int j0 = t - 128 < 0 ? 0 : t - 128, j1 = t + 128 > T - 1 ? T - 1 : t + 128;
            attend<64, 0>(S, q, K, LDP, nullptr, 0, V, LDP, b * T + j0, j1 - j0 + 1, 0.125f); }
        attend<64, 0>(S, q, K, LDP, nullptr, 0, V, LDP, cr0, LC, 0.125f);
        const float sk = a.sink[a.l * 8 + h]; const float mn = fmaxf(S.m, sk); const float al = __expf(S.m - mn);
        const float l = S.l * al + __expf(sk - mn);
        store64(a.O + (size_t)r * D + h * 64, S.o, al / l);
    } else if (job < 12) {
        const int h = job - 8; float q[96]; ld_bf<96>(a.QM + (size_t)r * 1024 + h * 96, q);
        Soft S; soft_init(S);
        const bf16* K1 = a.KVM + h * 128; const bf16* K2 = P + P_KR; const bf16* V = a.KVM + h * 128 + 64;
        const float sc = 0.10206207261596577f;
        if (lat) attend<64, 32>(S, q, K1, 1024, K2, LDP, V, 1024, b * T, T, sc);
        attend<64, 32>(S, q, K1, 1024, K2, LDP, V, 1024, cr0, LC, sc);
        store64(a.O + (size_t)r * D + 512 + h * 64, S.o, 1.f / S.l);
    } else {
        const int h = job - 12; const float sc = 0.17677669529663687f;
        float s1 = 0.f, s2 = 0.f;
        for (int i = 0; i < 32; ++i) { s1 += a.lq1[a.l * 32 + i] * a.lk1[a.l * 32 + i]; s2 += a.lq2[a.l * 32 + i] * a.lk2[a.l * 32 + i]; }
        const float lam_init = 0.8f - 0.6f * expf(-0.3f * (float)a.l);
        const float lam = expf(s1) - expf(s2) + lam_init;
        float o0[64];
        { float q[32]; ld_bf<32>(P + (size_t)r * LDP + P_DQ + h * 64, q);
          Soft S; soft_init(S); const bf16* K = P + P_DK + h * 64; const bf16* V = P + P_DV + h * 64;
          if (lat) attend<32, 0>(S, q, K, LDP, nullptr, 0, V, LDP, b * T, T, sc);
          attend<32, 0>(S, q, K, LDP, nullptr, 0, V, LDP, cr0, LC, sc);
          const float il = 1.f / S.l;
#pragma unroll
          for (int d = 0; d < 64; ++d) o0[d] = S.o[d] * il; }
        { float q[32]; ld_bf<32>(P + (size_t)r * LDP + P_DQ + h * 64 + 32, q);
          Soft S; soft_init(S); const bf16* K = P + P_DK + h * 64 + 32; const bf16* V = P + P_DV + h * 64;
          if (lat) attend<32, 0>(S, q, K, LDP, nullptr, 0, V, LDP, b * T, T, sc);
          attend<32, 0>(S, q, K, LDP, nullptr, 0, V, LDP, cr0, LC, sc);
          const float il = lam / S.l;
#pragma unroll
          for (int d = 0; d < 64; ++d) o0[d] -= S.o[d] * il; }
        float ss = 0.f;
#pragma unroll
        for (int d = 0; d < 64; ++d) ss += o0[d] * o0[d];
        const float rs = (1.f - lam_init) / sqrtf(ss * (1.f / 64.f) + EPS);
#pragma unroll
        for (int d = 0; d < 64; ++d) o0[d] *= a.dnorm[a.l * 64 + d];
        store64(a.O + (size_t)r * D + 768 + h * 64, o0, rs);
    }
}


enum { PH_P0 = 0, PH_L0 = 1, PH_PER_LAYER = 9, PH_FINAL = PH_L0 + DEPTH * PH_PER_LAYER, NPH = PH_FINAL + 1 };
enum { SP_NORM1 = 0, SP_INPROJ = 1, SP_UP = 2, SP_ATTN = 3, SP_OUT = 4, SP_NORM2 = 5, SP_TOPK = 6, SP_MOE1 = 7, SP_MOE2 = 8 };

#ifndef PHMASK
#define PHMASK 0x3ff
#endif
#define PHON(b) ((PHMASK >> (b)) & 1)
__global__ void __launch_bounds__(NWAVES * 64, 2) mk(Args args) {
    extern __shared__ __attribute__((aligned(16))) unsigned char lds_raw[];
    Frame F;
    F.lds = (LAS unsigned char*)lds_raw;
    F.tid = threadIdx.x; F.lane = F.tid & 63; F.wave = __builtin_amdgcn_readfirstlane(F.tid >> 6); F.bid = blockIdx.x; F.G = gridDim.x;
    const int wave_s = F.wave;
    F.in = (const float* const*)args.in; F.out = args.out; F.ws = args.ws;
    volatile LAS unsigned* MISC = (volatile LAS unsigned*)(F.lds + MISC_OFF);
    for (int u = F.tid; u < (LDS_BYTES - LDSCTL_OFF) / 4; u += NWAVES * 64) ((LAS unsigned*)(F.lds + LDSCTL_OFF))[u] = 0u;
    __syncthreads();
    XcdBarrier bar = xcd_barrier_post((unsigned*)(args.ws + WS_CTL) + CW_BAR + args.li * XCD_BAR_WORDS, MISC + 8);
    const int gx = F.bid & 7, gj = F.bid >> 3, gpx = F.G >> 3;
    for (int ph = args.ph_lo; ph < args.ph_hi; ++ph) {
        { unsigned char* w_ = args.ws; asm volatile("" : "+s"(w_)); F.ws = w_; int z_ = 0; asm volatile("" : "+s"(z_)); F.in = (const float* const*)args.in + z_;
          int l_ = (int)__builtin_amdgcn_mbcnt_hi(~0u, __builtin_amdgcn_mbcnt_lo(~0u, 0u)); asm volatile("" : "+v"(l_)); int w_s = wave_s; asm volatile("" : "+s"(w_s)); F.lane = l_; F.wave = w_s; F.tid = w_s * 64 + l_; }
        if (ph == PH_P0) { if (PHON(9)) p0_phase(F); }
        else if (ph == PH_FINAL) { if (PHON(0)) norm_phase(F, DEPTH, 2, RL); }
        else {
            const int l = (ph - PH_L0) / PH_PER_LAYER, sp = (ph - PH_L0) % PH_PER_LAYER;
            const bool need_ctx = l < DEPTH - 1; const int rows_mix = need_ctx ? R : RL;
            const bf16* wl = F_WB + (size_t)l * W_LAYER;
            if (sp == SP_NORM1) { if (PHON(0)) norm_phase(F, l, 0, R); }
            else if (sp == SP_INPROJ && PHON(1)) {
                pg8::Gemm g{F_ACT, wl + W_IN, nullptr, 0, D, D}; OrderRows S{gx, gj, gpx, R / 256 / 8, LDP / 256};
                EpiInProj E{F_P, F_ROPE, F_RSQ};
                pg8::gemm_phase<false>(F.lds, F.tid, g, S, E);
            } else if (sp == SP_UP && PHON(2)) {
                pg8::Gemm g{F_P + P_CQ, wl + W_UP, nullptr, 0, LDP, UPK}; OrderRows S{gx, gj, gpx, R / 256 / 8, 4};
                EpiUp E{F_QKVM, F_ROPE, F_RSQ};
                pg8::gemm_phase<false>(F.lds, F.tid, g, S, E);
            } else if (sp == SP_OUT && PHON(4)) {
                pg8::Gemm g{F_O, wl + W_OUT, nullptr, 0, D, D}; OrderRows S{gx, gj, gpx, rows_mix / 256 / 8, 4};
                EpiOut E{F_X, F_MOD + (size_t)l * 9 * 6144};
                pg8::gemm_phase<false>(F.lds, F.tid, g, S, E);
            } else if (sp == SP_NORM2) { if (PHON(5)) norm_phase(F, l, 1, rows_mix); }
            else if (sp == SP_TOPK) { if (PHON(6)) topk_phase(F, need_ctx ? 16 : 8); }
            else if (sp == SP_MOE1 && PHON(7)) {
                pg8::Gemm g{F_ACT, wl + W_GU, F_STOK, (size_t)1024 * 1024, D, D}; OrderMoe S{gx, gj, gpx, need_ctx ? 9 : 8, 4};
                EpiGU E{F_HID};
                pg8::gemm_phase<true>(F.lds, F.tid, g, S, E);
            } else if (sp == SP_MOE2 && PHON(8)) {
                pg8::Gemm g{F_HID, wl + W_DN, nullptr, (size_t)1024 * 512, DE, DE}; OrderMoe S{gx, gj, gpx, need_ctx ? 9 : 8, 4};
                EpiDown E{F_Y, F_SGATE};
                pg8::gemm_phase<false>(F.lds, F.tid, g, S, E);
            }
        }
        if (ph + 1 < args.ph_hi) xcd_barrier(bar, F.tid);
    }
}

extern "C" void kernel_launch(void* const* d_in, const int* in_sizes, int n_in, void* d_out, int out_size, void* d_ws, size_t ws_size, hipStream_t stream) {
    static int grid = 0;
    if (grid == 0) {
        if (n_in != 25 || ws_size < WS_END || out_size != RL * D) { fprintf(stderr, "kernel_launch: unexpected shapes (n_in %d, ws %zu < %zu, out %d)\n", n_in, ws_size, (size_t)WS_END, out_size); grid = -1; return; }
        int dev = 0, cus = 0, per_cu = 0;
        if (hipGetDevice(&dev) != hipSuccess || hipDeviceGetAttribute(&cus, hipDeviceAttributeMultiprocessorCount, dev) != hipSuccess) { grid = -1; return; }
        if (hipFuncSetAttribute((const void*)mk, hipFuncAttributeMaxDynamicSharedMemorySize, LDS_BYTES) != hipSuccess) { fprintf(stderr, "kernel_launch: hipFuncSetAttribute failed\n"); grid = -1; return; }
        if (hipOccupancyMaxActiveBlocksPerMultiprocessor(&per_cu, (const void*)mk, NWAVES * 64, LDS_BYTES) != hipSuccess || per_cu < 1) { fprintf(stderr, "kernel_launch: occupancy query says %d\n", per_cu); }
        (void)hipGetLastError();
        grid = cus;
        if (grid % 8 != 0) { fprintf(stderr, "kernel_launch: %d CUs, expected a multiple of 8\n", grid); grid = -1; return; }
    }
    if (grid < 0) return;
    (void)hipMemsetAsync((char*)d_ws + WS_CTL, 0, CTL_ZERO_BYTES, stream);
    Args a; memset(&a, 0, sizeof a);
    for (int i = 0; i < 25; ++i) a.in[i] = (const float*)d_in[i];
    a.out = (float*)d_out; a.ws = (unsigned char*)d_ws;
    char* ws = (char*)d_ws;
    int li = 0;
    auto run = [&](int lo, int hi) { a.ph_lo = lo; a.ph_hi = hi; a.li = li++; hipLaunchKernelGGL(mk, dim3(grid), dim3(NWAVES * 64), LDS_BYTES, stream, a); };
    int lo = 0;
    for (int l = 0; l < DEPTH; ++l) {
        const int pa = PH_L0 + l * PH_PER_LAYER + SP_ATTN;
        run(lo, pa);
        const int rows_mix = l < DEPTH - 1 ? R : RL;
        AttnArgs aa; memset(&aa, 0, sizeof aa);
        aa.P = (const bf16*)(ws + WS_P); aa.QM = (const bf16*)(ws + WS_QKVM); aa.KVM = (const bf16*)(ws + WS_QKVM) + 512; aa.O = (bf16*)(ws + WS_O);
        aa.sink = (const float*)d_in[9]; aa.lq1 = (const float*)d_in[14]; aa.lk1 = (const float*)d_in[15]; aa.lq2 = (const float*)d_in[16]; aa.lk2 = (const float*)d_in[17]; aa.dnorm = (const float*)d_in[18];
        aa.l = l; aa.nrows = rows_mix;
        k_attn<<<dim3(rows_mix / 256, 16), 256, 0, stream>>>(aa);
        lo = pa + 1;
    }
    run(lo, NPH);
}
```

```cpp
#include <hip/hip_runtime.h>
#include <stdint.h>
#include <string.h>
#include <stdio.h>

typedef unsigned short bf16;
typedef unsigned u32x4 __attribute__((ext_vector_type(4)));
typedef unsigned u32x2 __attribute__((ext_vector_type(2)));
typedef float f32x4 __attribute__((ext_vector_type(4)));
typedef float f32x16 __attribute__((ext_vector_type(16)));
typedef short bf16x8 __attribute__((ext_vector_type(8)));
#define LAS __attribute__((address_space(3)))
#define GAS __attribute__((address_space(1)))

constexpr int D = 1024, NB = 8, T = 2048, LC = 256, DEPTH = 4;
constexpr int RL = NB * T, RC = NB * LC, R = RL + RC;
constexpr int INW = 1952, LDP = 2048;
constexpr int NE = 16, DE = 512;
constexpr int CAPL = 256, CAPC = 32;
constexpr int SLOTS_E = NB * CAPL + NB * CAPC;
constexpr int SLOTS = NE * SLOTS_E;
constexpr float EPS = 1e-6f;
constexpr int P_AQ = 0, P_AK = 512, P_AV = 640, P_CQ = 768, P_CKV = 1024, P_KR = 1152, P_DQ = 1184, P_DK = 1440, P_DV = 1696;
constexpr int LDM = 1024;
constexpr int UPK = 384;

constexpr size_t MiB = 1u << 20;
constexpr size_t WS_CTL = 0;
constexpr size_t CTL_ZERO_BYTES = 256 * 1024;
constexpr size_t WS_MOD = 1 * MiB;
constexpr size_t WS_ROPE = 2 * MiB;
constexpr size_t WS_RSQ = 3 * MiB;
constexpr size_t WS_AFF = 4 * MiB;
constexpr size_t WS_INV = 6 * MiB;
constexpr size_t WS_STOK = 8 * MiB;
constexpr size_t WS_SGATE = 9 * MiB;
constexpr size_t WS_X = 10 * MiB;
constexpr size_t WS_ACT = 82 * MiB;
constexpr size_t WS_P = 118 * MiB;
constexpr size_t WS_Y = WS_P;
constexpr size_t WS_QKVM = 190 * MiB;
constexpr size_t WS_O = 226 * MiB;
constexpr size_t WS_HID = WS_O;
constexpr size_t WS_W = 262 * MiB;
constexpr size_t W_IN = 0;
constexpr size_t W_UP = W_IN + (size_t)LDP * D;
constexpr size_t W_OUT = W_UP + (size_t)1024 * UPK;
constexpr size_t W_GU = W_OUT + (size_t)D * D;
constexpr size_t W_DN = W_GU + (size_t)NE * 1024 * 1024;
constexpr size_t W_LAYER = W_DN + (size_t)NE * 1024 * 512;
constexpr size_t WS_END = WS_W + (size_t)DEPTH * W_LAYER * 2;

__device__ __forceinline__ unsigned f2bf(float f) { unsigned u = __builtin_bit_cast(unsigned, f); return (u + 0x7fffu + ((u >> 16) & 1u)) >> 16; }
__device__ __forceinline__ float bf2f(unsigned h) { return __builtin_bit_cast(float, h << 16); }
__device__ __forceinline__ unsigned pk2(float lo, float hi) { return f2bf(lo) | (f2bf(hi) << 16); }
__device__ __forceinline__ float wave_sum(float v) {
#pragma unroll
    for (int o = 1; o < 64; o <<= 1) v += __shfl_xor(v, o);
    return v;
}
__device__ __forceinline__ float siluf(float v) { return v / (1.f + __expf(-v)); }
#define LDS_WAIT() asm volatile("s_waitcnt lgkmcnt(0)" ::: "memory")
#define VM_WAIT() asm volatile("s_waitcnt vmcnt(0)" ::: "memory")

struct Args {
    const float* in[25]; float* out; unsigned char* ws; int ph_lo, ph_hi, li, pad;
};

namespace pg8 {
constexpr int BM = 256, BK = 64, HALF = 128, HTB = HALF * BK * 2  , STAGE_BYTES = 8 * HTB;
__host__ __device__ __forceinline__ int lds_byte(int r, int c) { const int st = (r >> 4) * 2 + (c >> 5), rr = r & 15, cc = c & 31, ob = rr * 64 + cc * 2; return st * 1024 + (ob ^ (((ob >> 9) & 1) << 5)); }
__host__ __device__ __forceinline__ void stage_rc(int b, int& R, int& C) { const int st = b / 1024, sb = b % 1024, swz = sb ^ (((sb >> 9) & 1) << 5); R = (st >> 1) * 16 + swz / 64; C = (st & 1) * 32 + (swz % 64) / 2; }
__host__ __device__ __forceinline__ int perm32(int rho) { const int n = rho >> 4, i = rho & 15; return 8 * (i >> 2) + 4 * n + (i & 3); }

struct Unit { int arow0, orow0, col0, e; };
struct Gemm { const bf16* A; const bf16* Bt; const int* gather; size_t b_estride; int lda, K; };

template <bool GATHER, class Epi, class Sched>
__device__ __forceinline__ void gemm_phase(LAS unsigned char* lds, const int tid, const Gemm g, const Sched& S, const Epi& E) {
    const int wid = __builtin_amdgcn_readfirstlane(tid >> 6), lane = tid & 63, wr = wid >> 2, wc = wid & 3, fr = lane & 15, fq = lane >> 4;
    const int K = g.K, nt = K / BK;
    unsigned voffA[2], voffB[2]; int sR[2];
#pragma unroll
    for (int i = 0; i < 2; ++i) { int C_; stage_rc(tid * 16 + i * 8192, sR[i], C_); const int Rb = (sR[i] & ~31) + perm32(sR[i] & 31);
        voffA[i] = GATHER ? (unsigned)C_ * 2u : (unsigned)(sR[i] * g.lda + C_) * 2u; voffB[i] = (unsigned)(Rb * K + C_) * 2u; }
    const unsigned lda2 = (unsigned)g.lda * 2u;
    const unsigned hstepA = (unsigned)HALF * g.lda * 2u;
    const unsigned kstep = (unsigned)(BK * 2);
    const unsigned hstepB = (unsigned)HALF * K * 2u;
    const __amdgpu_buffer_rsrc_t rsA = __builtin_amdgcn_make_buffer_rsrc((void*)g.A, 0, 0x7fffffff, 0x00020000);
    const __amdgpu_buffer_rsrc_t rsB = __builtin_amdgcn_make_buffer_rsrc((void*)g.Bt, 0, 0x7fffffff, 0x00020000);
    const unsigned ldsw = (unsigned)wid * 1024u;
    const int aoff = lds_byte(wr * 64 + fr, fq * 8), boff = lds_byte(wc * 32 + fr, fq * 8);
#define PG8_SA(b, h) (((b) * 2 + (h)) * HTB)
#define PG8_SB(b, h) ((4 + (b) * 2 + (h)) * HTB)
#define PG8_STAGE2(bufoff, rsrc, v0, v1, soff) do { \
        __builtin_amdgcn_raw_ptr_buffer_load_lds(rsrc, (LAS unsigned*)(lds + (bufoff) + ldsw), 16, (int)(v0), (int)(soff), 0, 0); \
        __builtin_amdgcn_raw_ptr_buffer_load_lds(rsrc, (LAS unsigned*)(lds + (bufoff) + ldsw + 8192), 16, (int)(v1), (int)(soff), 0, 0); } while (0)
#define PG8_STAGEB(bufoff, soff) PG8_STAGE2(bufoff, rsB, voffB[0], voffB[1], soff)
#define PG8_STAGEA(bufoff, ubase, r0, r1, h, koff) do { if constexpr (GATHER) { \
        PG8_STAGE2(bufoff, rsA, (((r0) >> (16 * (h))) & 0xffffu) * lda2 + voffA[0], (((r1) >> (16 * (h))) & 0xffffu) * lda2 + voffA[1], (koff)); } \
        else { PG8_STAGE2(bufoff, rsA, voffA[0], voffA[1], (ubase) + (h) * hstepA + (koff)); } } while (0)
#define PG8_LDA(dst, b, h) do { _Pragma("unroll") for (int m = 0; m < 4; ++m) _Pragma("unroll") for (int k = 0; k < 2; ++k) dst[m][k] = *(const LAS bf16x8*)(lds + PG8_SA(b, h) + aoff + m * 2048 + k * 1024); } while (0)
#define PG8_LDB(dst, b, h) do { _Pragma("unroll") for (int n = 0; n < 2; ++n) _Pragma("unroll") for (int k = 0; k < 2; ++k) dst[n][k] = *(const LAS bf16x8*)(lds + PG8_SB(b, h) + boff + n * 2048 + k * 1024); } while (0)
#define PG8_MMA(ai, bj, At, Bt) do { __builtin_amdgcn_s_setprio(1); _Pragma("unroll") for (int m = 0; m < 4; ++m) _Pragma("unroll") for (int n = 0; n < 2; ++n) _Pragma("unroll") for (int k = 0; k < 2; ++k) \
        acc[ai][bj][m][n] = __builtin_amdgcn_mfma_f32_16x16x32_bf16(Bt[n][k], At[m][k], acc[ai][bj][m][n], 0, 0, 0); __builtin_amdgcn_s_setprio(0); } while (0)
#define PG8_WAIT_V(n) asm volatile("s_waitcnt vmcnt(" #n ")" ::: "memory")
#define PG8_WAIT_L(n) asm volatile("s_waitcnt lgkmcnt(" #n ")" ::: "memory")
#define PG8_BAR __builtin_amdgcn_s_barrier()
#define PG8_SCHED __builtin_amdgcn_sched_barrier(0)
#define PG8_ROWS(dst, u) do { if constexpr (GATHER) { _Pragma("unroll") for (int i = 0; i < 2; ++i) { \
        const unsigned a_ = (unsigned)g.gather[(u).arow0 + sR[i]], b_ = (unsigned)g.gather[(u).arow0 + HALF + sR[i]]; dst[i] = a_ | (b_ << 16); } \
        asm volatile("" : "+v"(dst[0]), "+v"(dst[1])); } } while (0)
    Unit cur, nxt; int ui = 0;
    if (!S.next(0, cur)) return;
    f32x4 acc[2][2][4][2];
#pragma unroll
    for (int a = 0; a < 2; ++a)
#pragma unroll
        for (int b = 0; b < 2; ++b)
#pragma unroll
            for (int m = 0; m < 4; ++m)
#pragma unroll
                for (int n = 0; n < 2; ++n) acc[a][b][m][n] = (f32x4){0.f, 0.f, 0.f, 0.f};
    bf16x8 At[4][2], B0[2][2], B1[2][2];
    unsigned rp[2] = {0u, 0u}, rn[2] = {0u, 0u};
    PG8_ROWS(rp, cur);
    unsigned cA = (unsigned)cur.arow0 * lda2;
    unsigned cB = (unsigned)(((size_t)cur.e * g.b_estride + (size_t)cur.col0 * K) * 2);
    PG8_STAGEB(PG8_SB(0, 0), cB); PG8_STAGEB(PG8_SB(0, 1), cB + hstepB); PG8_STAGEA(PG8_SA(0, 0), cA, rp[0], rp[1], 0, 0); PG8_STAGEA(PG8_SA(0, 1), cA, rp[0], rp[1], 1, 0);
    if (wr == 1) PG8_BAR;
    PG8_WAIT_V(2); PG8_BAR;
    PG8_STAGEB(PG8_SB(1, 0), cB + kstep); PG8_STAGEA(PG8_SA(1, 0), cA, rp[0], rp[1], 0, kstep); PG8_STAGEB(PG8_SB(1, 1), cB + hstepB + kstep);
    PG8_WAIT_V(6); PG8_BAR;
    for (;;) {
        const bool has_next = S.next(ui + 1, nxt);
        if (has_next) { PG8_ROWS(rn, nxt); } else { rn[0] = rp[0]; rn[1] = rp[1]; }
        const unsigned nA = has_next ? (unsigned)nxt.arow0 * lda2 : cA;
        const unsigned nB = has_next ? (unsigned)(((size_t)nxt.e * g.b_estride + (size_t)nxt.col0 * K) * 2) : cB;
#pragma unroll 1
        for (int t = 0; t < nt; t += 2) {
            const bool last = (t == nt - 2);
            const unsigned k1 = (unsigned)(t + 1) * kstep, k2 = last ? 0u : (unsigned)(t + 2) * kstep, k3 = k2 + kstep;
            const unsigned u2 = last ? nA : cA; const unsigned b2 = last ? nB : cB + (unsigned)(t + 2) * kstep; const unsigned b3 = b2 + kstep;
            const unsigned q0 = last ? rn[0] : rp[0], q1 = last ? rn[1] : rp[1];
            PG8_LDB(B0, 0, 0); PG8_LDB(B1, 0, 1); PG8_SCHED; PG8_LDA(At, 0, 0); PG8_STAGEA(PG8_SA(1, 1), cA, rp[0], rp[1], 1, k1);
            PG8_WAIT_V(8); PG8_WAIT_L(0); PG8_BAR; PG8_MMA(0, 0, At, B0); PG8_MMA(0, 1, At, B1); PG8_BAR; PG8_SCHED;
            PG8_LDA(At, 0, 1); PG8_STAGEB(PG8_SB(0, 0), b2); PG8_STAGEB(PG8_SB(0, 1), b2 + hstepB); PG8_STAGEA(PG8_SA(0, 0), u2, q0, q1, 0, k2);
            PG8_WAIT_V(8); PG8_WAIT_L(0); PG8_BAR; PG8_MMA(1, 0, At, B0); PG8_MMA(1, 1, At, B1); PG8_BAR; PG8_SCHED;
            PG8_LDB(B0, 1, 0); PG8_LDB(B1, 1, 1); PG8_SCHED; PG8_LDA(At, 1, 0); PG8_STAGEA(PG8_SA(0, 1), u2, q0, q1, 1, k2);
            PG8_WAIT_V(8); PG8_WAIT_L(0); PG8_BAR; PG8_MMA(0, 0, At, B0); PG8_MMA(0, 1, At, B1); PG8_BAR; PG8_SCHED;
            PG8_LDA(At, 1, 1); PG8_STAGEB(PG8_SB(1, 0), b3); PG8_STAGEB(PG8_SB(1, 1), b3 + hstepB); PG8_STAGEA(PG8_SA(1, 0), u2, q0, q1, 0, k3);
            PG8_WAIT_V(8); PG8_WAIT_L(0); PG8_BAR; PG8_MMA(1, 0, At, B0); PG8_MMA(1, 1, At, B1); PG8_BAR; PG8_SCHED;
        }
        if (wr == 0) PG8_BAR;
        E(acc, cur, wr, wc, fr, fq);
        if (!has_next) break;
#pragma unroll
        for (int a = 0; a < 2; ++a)
#pragma unroll
            for (int b = 0; b < 2; ++b)
#pragma unroll
                for (int m = 0; m < 4; ++m)
#pragma unroll
                    for (int n = 0; n < 2; ++n) acc[a][b][m][n] = (f32x4){0.f, 0.f, 0.f, 0.f};
        cur = nxt; cB = nB; cA = nA; ++ui; rp[0] = rn[0]; rp[1] = rn[1];
        if (wr == 1) PG8_BAR;
    }
    PG8_WAIT_V(0);
    PG8_BAR;
#undef PG8_SA
#undef PG8_SB
#undef PG8_STAGE2
#undef PG8_STAGEB
#undef PG8_LDA
#undef PG8_LDB
#undef PG8_MMA
#undef PG8_WAIT_V
#undef PG8_WAIT_L
#undef PG8_BAR
#undef PG8_SCHED
#undef PG8_ROWS
#undef PG8_STAGEA
}
}

struct OrderRows {
    int x, j, gpx, rpx, nN;
    __device__ __forceinline__ bool next(int i, pg8::Unit& u) const {
        const int q = i * gpx + j; if (q >= rpx * nN) return false;
        const int pm = x * rpx + q / nN, pn = q % nN; u.arow0 = pm * 256; u.orow0 = pm * 256; u.col0 = pn * 256; u.e = 0; return true; }
};
struct OrderMoe {
    int x, j, gpx, nME, nN;
    __device__ __forceinline__ bool next(int i, pg8::Unit& u) const {
        const int q = i * gpx + j, per = nME * nN; if (q >= 2 * per) return false;
        const int e = 2 * x + q / per, rem = q % per, pmE = rem / nN, pn = rem % nN;
        u.arow0 = e * SLOTS_E + pmE * 256; u.orow0 = u.arow0; u.col0 = pn * 256; u.e = e; return true; }
};

typedef float f32x4e __attribute__((ext_vector_type(4)));
#define EPI_ROWS(ai, m) (u.orow0 + (ai) * 128 + wr * 64 + (m) * 16 + fr)
#define EPI_COL0(bj) (u.col0 + (bj) * 128 + wc * 32 + 8 * fq)
__device__ __forceinline__ void rope8(f32x4& v0, f32x4& v1, const float* cs, const float* sn) {
    const f32x4 c = *(const f32x4*)cs, s = *(const f32x4*)sn;
    f32x4 a = v0, b = v1;
    v0.x = a.x * c.x - a.y * s.x; v0.y = a.y * c.x + a.x * s.x; v0.z = a.z * c.y - a.w * s.y; v0.w = a.w * c.y + a.z * s.y;
    v1.x = b.x * c.z - b.y * s.z; v1.y = b.y * c.z + b.x * s.z; v1.z = b.z * c.w - b.w * s.w; v1.w = b.w * c.w + b.z * s.w;
}
__device__ __forceinline__ u32x4 pack8(const f32x4 v0, const f32x4 v1) { u32x4 w; w.x = pk2(v0.x, v0.y); w.y = pk2(v0.z, v0.w); w.z = pk2(v1.x, v1.y); w.w = pk2(v1.z, v1.w); return w; }

struct EpiInProj {
    bf16* P; const float* rope; float* RSQ;
    __device__ __forceinline__ void operator()(const f32x4 (&acc)[2][2][4][2], const pg8::Unit& u, int wr, int wc, int fr, int fq) const {
        const bool lat = u.orow0 < RL;
#pragma unroll
        for (int bj = 0; bj < 2; ++bj) {
            const int c0 = EPI_COL0(bj);
            const bool secA = c0 < P_AV, secB = c0 >= P_KR && c0 < P_DV;
            const int which = (c0 >= P_CQ && c0 < P_CKV) ? 0 : ((c0 >= P_CKV && c0 < P_KR) ? 1 : -1);
            const int p0 = secA ? ((c0 & 63) >> 1) : ((c0 & 31) >> 1);
#pragma unroll
            for (int ai = 0; ai < 2; ++ai)
#pragma unroll
                for (int m = 0; m < 4; ++m) {
                    const int row = EPI_ROWS(ai, m);
                    f32x4 v0 = acc[ai][bj][m][0], v1 = acc[ai][bj][m][1];
                    if (lat && (secA || secB)) { const int t = row & (T - 1);
                        const float* cs = secA ? rope + t * 32 + p0 : rope + T * 64 + t * 16 + p0;
                        const float* sn = secA ? rope + T * 32 + t * 32 + p0 : rope + T * 64 + T * 16 + t * 16 + p0;
                        rope8(v0, v1, cs, sn); }
                    if (which >= 0) { float s = (v0.x * v0.x + v0.y * v0.y) + (v0.z * v0.z + v0.w * v0.w) + (v1.x * v1.x + v1.y * v1.y) + (v1.z * v1.z + v1.w * v1.w);
                        s += __shfl_xor(s, 16); s += __shfl_xor(s, 32);
                        if (fq == 0) atomicAdd(RSQ + (size_t)row * 2 + which, s); }
                    *(u32x4*)(P + (size_t)row * LDP + c0) = pack8(v0, v1);
                }
        }
    }
};
struct EpiUp {
    bf16* QKVM; const float* rope; const float* RSQ;
    __device__ __forceinline__ void operator()(const f32x4 (&acc)[2][2][4][2], const pg8::Unit& u, int wr, int wc, int fr, int fq) const {
        const bool isq = u.col0 < 512; const bool lat = u.orow0 < RL;
        const float* rq = RSQ + (isq ? 0 : 1); const float inv = isq ? (1.f / 256.f) : (1.f / 128.f);
        const int cw = u.col0 + wc * 32 + 8 * fq;
        int j0 = cw; j0 -= j0 >= 192 ? 192 : 0; j0 -= j0 >= 96 ? 96 : 0;
        int j1 = j0 + 32; j1 -= j1 >= 96 ? 96 : 0;
        const bool rot0 = lat && isq && cw < 384 && j0 >= 64, rot1 = lat && isq && cw + 128 < 384 && j1 >= 64;
        const float* tb = rope + T * 64;
#pragma unroll
        for (int ai = 0; ai < 2; ++ai)
#pragma unroll
            for (int m = 0; m < 4; ++m) {
                const int row = EPI_ROWS(ai, m);
                const float rs = __builtin_amdgcn_rsqf(rq[(size_t)row * 2] * inv + EPS);
                const int t = row & (T - 1);
                bf16* dst = QKVM + (size_t)row * LDM + cw;
                { f32x4 v0 = acc[ai][0][m][0] * rs, v1 = acc[ai][0][m][1] * rs;
                  if (rot0) rope8(v0, v1, tb + t * 16 + ((j0 - 64) >> 1), tb + T * 16 + t * 16 + ((j0 - 64) >> 1));
                  *(u32x4*)dst = pack8(v0, v1); }
                { f32x4 v0 = acc[ai][1][m][0] * rs, v1 = acc[ai][1][m][1] * rs;
                  if (rot1) rope8(v0, v1, tb + t * 16 + ((j1 - 64) >> 1), tb + T * 16 + t * 16 + ((j1 - 64) >> 1));
                  *(u32x4*)(dst + 128) = pack8(v0, v1); }
            }
    }
};
struct EpiOut {
    float* X; const float* MODl;
    __device__ __forceinline__ void operator()(const f32x4 (&acc)[2][2][4][2], const pg8::Unit& u, int wr, int wc, int fr, int fq) const {
        const int mb = u.orow0 < RL ? u.orow0 / T : 8;
        const float* g1 = MODl + (size_t)mb * 6144 + 2048;
#pragma unroll
        for (int bj = 0; bj < 2; ++bj) {
            const int c0 = EPI_COL0(bj);
            const f32x4 ga = *(const f32x4*)(g1 + c0), gb = *(const f32x4*)(g1 + c0 + 4);
#pragma unroll
            for (int ai = 0; ai < 2; ++ai)
#pragma unroll
                for (int m = 0; m < 4; ++m) {
                    float* xp = X + (size_t)EPI_ROWS(ai, m) * D + c0;
                    f32x4 xa = *(const f32x4*)xp, xb = *(const f32x4*)(xp + 4);
                    xa += ga * acc[ai][bj][m][0]; xb += gb * acc[ai][bj][m][1];
                    *(f32x4*)xp = xa; *(f32x4*)(xp + 4) = xb;
                }
        }
    }
};
struct EpiGU {
    bf16* HID;
    __device__ __forceinline__ void operator()(const f32x4 (&acc)[2][2][4][2], const pg8::Unit& u, int wr, int wc, int fr, int fq) const {
#pragma unroll
        for (int bj = 0; bj < 2; ++bj) {
            const int hc = EPI_COL0(bj) >> 1;
#pragma unroll
            for (int ai = 0; ai < 2; ++ai)
#pragma unroll
                for (int m = 0; m < 4; ++m) {
                    const f32x4 g = acc[ai][bj][m][0], up = acc[ai][bj][m][1];
                    u32x2 w; w.x = pk2(siluf(g.x) * up.x, siluf(g.y) * up.y); w.y = pk2(siluf(g.z) * up.z, siluf(g.w) * up.w);
                    *(u32x2*)(HID + (size_t)EPI_ROWS(ai, m) * DE + hc) = w;
                }
        }
    }
};
struct EpiDown {
    bf16* Y; const float* SGATE;
    __device__ __forceinline__ void operator()(const f32x4 (&acc)[2][2][4][2], const pg8::Unit& u, int wr, int wc, int fr, int fq) const {
#pragma unroll
        for (int ai = 0; ai < 2; ++ai)
#pragma unroll
            for (int m = 0; m < 4; ++m) {
                const int row = EPI_ROWS(ai, m); const float gt = SGATE[row];
#pragma unroll
                for (int bj = 0; bj < 2; ++bj)
                    *(u32x4*)(Y + (size_t)row * D + EPI_COL0(bj)) = pack8(acc[ai][bj][m][0] * gt, acc[ai][bj][m][1] * gt);
            }
    }
};

constexpr int NWAVES = 8;
constexpr int RING_BYTES = 131072;
constexpr int LDSCTL_OFF = RING_BYTES, MISC_OFF = LDSCTL_OFF + 320;
constexpr int LDS_BYTES = 147456;
constexpr int CW_BAR = 4096;
typedef GAS unsigned gu32;

#define XB_TMO      128
#define XB_XCNT(j)  (256  + 64 * (j))
#define XB_XSUB(j)  (1280 + 64 * (j))
#define XB_XGEN(j)  (2304 + 64 * (j))
#define XB_TOP      3328
#define XB_TOPGEN   3392
#define XCD_BAR_WORDS 3456
#define XB_SPIN_CAP (1u << 18)
__device__ __forceinline__ unsigned xb_ld(unsigned* p)              { return __hip_atomic_load(p, __ATOMIC_RELAXED, __HIP_MEMORY_SCOPE_AGENT); }
__device__ __forceinline__ unsigned xb_add(unsigned* p, unsigned v) { return __hip_atomic_fetch_add(p, v, __ATOMIC_RELAXED, __HIP_MEMORY_SCOPE_AGENT); }
__device__ __forceinline__ unsigned xb_xcc_id() { return (unsigned)__builtin_amdgcn_s_getreg((3 << 11) | 20) & 0xFu; }
#define XB_SPIN(cond, bar) do { unsigned _sp = 0; while (cond) { __builtin_amdgcn_s_sleep(1); \
    if ((++_sp & 255u) == 0u) { if (xb_ld(&(bar)[XB_TMO])) break; if (_sp > XB_SPIN_CAP) { atomicAdd(&(bar)[XB_TMO], 1u); break; } } } } while (0)
struct XcdBarrier { unsigned* bar; unsigned x; volatile LAS unsigned* st; };
__device__ __forceinline__ XcdBarrier xcd_barrier_post(unsigned* bar, volatile LAS unsigned* st) {
    XcdBarrier b; b.bar = bar; b.x = xb_xcc_id(); b.st = st;
    if (threadIdx.x == 0) (void)xb_add(&bar[XB_XCNT(b.x)], 1u);
    return b;
}
__device__ __forceinline__ void xcd_barrier_complete(unsigned* bar, unsigned x, unsigned& nloc, unsigned& nx) {
    const unsigned G = gridDim.x * gridDim.y * gridDim.z;
    unsigned sum, cnt, mine, sp = 0u;
    for (;;) {
        sum = 0u; cnt = 0u; mine = 0u;
#pragma unroll
        for (unsigned j = 0; j < 16; ++j) { const unsigned c = xb_ld(&bar[XB_XCNT(j)]); sum += c; cnt += (c > 0u) ? 1u : 0u; mine = (j == x) ? c : mine; }
        if (sum == G) break;
        __builtin_amdgcn_s_sleep(1);
        if ((++sp & 255u) == 0u) { if (xb_ld(&bar[XB_TMO])) break; if (sp > XB_SPIN_CAP) { atomicAdd(&bar[XB_TMO], 1u); break; } }
    }
    nloc = mine > 0u ? mine : 1u; nx = cnt > 0u ? cnt : 1u;
}
__device__ __forceinline__ void xcd_barrier(const XcdBarrier& b, const int tid) {
    asm volatile("s_waitcnt vmcnt(0)" ::: "memory");
    __syncthreads();
    if (tid == 0) {
        unsigned* bar = b.bar;
        __builtin_amdgcn_s_waitcnt(0);
        unsigned nloc = b.st[0], nx = b.st[1];
        if (nloc == 0u) { xcd_barrier_complete(bar, b.x, nloc, nx); b.st[0] = nloc; b.st[1] = nx; }
        const unsigned old = xb_add(&bar[XB_XSUB(b.x)], 1u);
        const unsigned gen = old / nloc;
        if (old + 1u == (gen + 1u) * nloc) {
            __builtin_amdgcn_fence(__ATOMIC_RELEASE, "agent");
            asm volatile("s_waitcnt vmcnt(0)" ::: "memory");
            const unsigned og = xb_add(&bar[XB_TOP], 1u);
            const unsigned tg = og / nx;
            if (og + 1u == (tg + 1u) * nx) xb_add(&bar[XB_TOPGEN], 1u);
            else XB_SPIN(xb_ld(&bar[XB_TOPGEN]) == tg, bar);
            __builtin_amdgcn_fence(__ATOMIC_ACQUIRE, "agent");
            xb_add(&bar[XB_XGEN(b.x)], 1u);
            asm volatile("s_waitcnt vmcnt(0)" ::: "memory");
        } else {
            XB_SPIN(xb_ld(&bar[XB_XGEN(b.x)]) == gen, bar);
            __builtin_amdgcn_fence(__ATOMIC_ACQUIRE, "agent");
            asm volatile("s_waitcnt vmcnt(0)" ::: "memory");
        }
    }
    __syncthreads();
}

struct Frame { LAS unsigned char* lds; int tid, lane, wave, bid, G; const float* const* in; float* out; unsigned char* ws; };
#define IN_(k) (F.in[(k)])
#define F_x IN_(0)
#define F_c IN_(1)
#define F_ctx IN_(2)
#define F_c_ctx IN_(3)
#define F_norm1 IN_(4)
#define F_norm2 IN_(5)
#define F_w_ada IN_(6)
#define F_b_ada IN_(7)
#define F_w_in IN_(8)
#define F_sink IN_(9)
#define F_mla_q_norm IN_(10)
#define F_w_uq IN_(11)
#define F_mla_kv_norm IN_(12)
#define F_w_ukv IN_(13)
#define F_lq1 IN_(14)
#define F_lk1 IN_(15)
#define F_lq2 IN_(16)
#define F_lk2 IN_(17)
#define F_diff_norm IN_(18)
#define F_w_out IN_(19)
#define F_w_router IN_(20)
#define F_w_gate IN_(21)
#define F_w_up IN_(22)
#define F_w_down IN_(23)
#define F_final_norm IN_(24)
#define F_MOD ((float*)(F.ws + WS_MOD))
#define F_ROPE ((float*)(F.ws + WS_ROPE))
#define F_RSQ ((float*)(F.ws + WS_RSQ))
#define F_AFF ((float*)(F.ws + WS_AFF))
#define F_INV ((int*)(F.ws + WS_INV))
#define F_STOK ((int*)(F.ws + WS_STOK))
#define F_SGATE ((float*)(F.ws + WS_SGATE))
#define F_X ((float*)(F.ws + WS_X))
#define F_ACT ((bf16*)(F.ws + WS_ACT))
#define F_P ((bf16*)(F.ws + WS_P))
#define F_Y ((bf16*)(F.ws + WS_Y))
#define F_QKVM ((bf16*)(F.ws + WS_QKVM))
#define F_O ((bf16*)(F.ws + WS_O))
#define F_HID ((bf16*)(F.ws + WS_HID))
#define F_WB ((bf16*)(F.ws + WS_W))

__device__ __forceinline__ int rot64(int dp) { const int p = dp >> 1, half = dp & 1, axis = p >> 4, f = p & 15; return axis * 32 + half * 16 + f; }
__device__ __forceinline__ int rot32(int dp) { const int p = dp >> 1, half = dp & 1, axis = p >> 3, f = p & 7; return axis * 16 + half * 8 + f; }
__device__ __forceinline__ int src_col_in(int n) {
    if (n >= INW) return -1;
    if (n < P_AV) return (n & ~63) + rot64(n & 63);
    if (n >= P_KR && n < P_DV) return (n & ~31) + rot32(n & 31);
    return n;
}
__device__ __forceinline__ void prep_tile(const float* src, int N, int k0, const float* kscale, bf16* dst, int ldd, LAS float* scr, int lane) {
    float v[32];
#pragma unroll
    for (int i = 0; i < 32; ++i) { const int kk = 2 * i + (lane >> 5); v[i] = src ? src[(size_t)(k0 + kk) * N] : 0.f; }
    if (kscale) {
#pragma unroll
        for (int i = 0; i < 32; ++i) v[i] *= kscale[k0 + 2 * i + (lane >> 5)]; }
#pragma unroll
    for (int i = 0; i < 32; ++i) scr[(2 * i + (lane >> 5)) * 33 + (lane & 31)] = v[i];
    LDS_WAIT();
    const int c = lane & 7;
#pragma unroll
    for (int j = 0; j < 4; ++j) { const int n = (lane >> 3) + 8 * j; const LAS float* s = scr + (8 * c) * 33 + n;
        u32x4 o; o.x = pk2(s[0], s[33]); o.y = pk2(s[66], s[99]); o.z = pk2(s[132], s[165]); o.w = pk2(s[198], s[231]);
        *(u32x4*)(dst + (size_t)n * ldd + 8 * c) = o; }
    LDS_WAIT();
}
constexpr int PI_IN = 16 * 64, PI_UP = 6 * 32, PI_OUT = 16 * 32, PI_GU = NE * 16 * 32, PI_DN = NE * 8 * 32, PI_LAYER = PI_IN + PI_UP + PI_OUT + PI_GU + PI_DN;
__device__ __forceinline__ void p0_phase(Frame& F) {
    const int tid = F.tid, lane = F.lane, wave = F.wave;
    {
        LAS float* sl = (LAS float*)F.lds;
        LAS float* red = (LAS float*)(F.lds + 36864);
        for (int i = tid; i < 9 * 1024; i += 512) { const float v = i < 8 * 1024 ? F_c[i] : F_c_ctx[i - 8 * 1024]; sl[i] = siluf(v); }
        __syncthreads();
        for (int it = F.bid; it < DEPTH * 96; it += F.G) {
            const int l = it / 96, cg = it % 96, col = cg * 64 + lane;
            float acc[9];
#pragma unroll
            for (int r = 0; r < 9; ++r) acc[r] = 0.f;
            const float* w = F_w_ada + (size_t)l * D * 6144 + (size_t)(wave * 128) * 6144 + col;
#pragma unroll 16
            for (int k = 0; k < 128; ++k) { const float wv = w[(size_t)k * 6144];
#pragma unroll
                for (int r = 0; r < 9; ++r) acc[r] += sl[r * 1024 + wave * 128 + k] * wv; }
#pragma unroll
            for (int r = 0; r < 9; ++r) red[(wave * 9 + r) * 64 + lane] = acc[r];
            __syncthreads();
            for (int o = tid; o < 576; o += 512) { const int r = o >> 6, cc = o & 63; float s = 0.f;
#pragma unroll
                for (int w8 = 0; w8 < 8; ++w8) s += red[(w8 * 9 + r) * 64 + cc];
                F_MOD[((size_t)l * 9 + r) * 6144 + cg * 64 + cc] = s + F_b_ada[l * 6144 + cg * 64 + cc]; }
            __syncthreads();
        }
    }
    const int gw = F.bid * NWAVES + wave, NGW = F.G * NWAVES;
    { const size_t n4 = (size_t)R * D / 4, nl4 = (size_t)RL * D / 4;
      for (size_t i = (size_t)F.bid * 512 + tid; i < n4; i += (size_t)F.G * 512) { const f32x4 v = i < nl4 ? ((const f32x4*)F_x)[i] : ((const f32x4*)F_ctx)[i - nl4]; ((f32x4*)F_X)[i] = v; } }
    for (int i = F.bid * 512 + tid; i < T * 48; i += F.G * 512) {
        const int t = i / 48, j = i % 48; int axis, f, nf;
        if (j < 32) { axis = j >> 4; f = j & 15; nf = 16; } else { axis = (j - 32) >> 3; f = (j - 32) & 7; nf = 8; }
        const float inv = exp2f(-(float)f / (float)nf * 13.287712379549449f);
        const float ang = (float)(axis == 0 ? (t >> 6) : (t & 63)) * inv;
        const float cv = cosf(ang), sv = sinf(ang);
        if (j < 32) { F_ROPE[t * 32 + j] = cv; F_ROPE[T * 32 + t * 32 + j] = sv; } else { F_ROPE[T * 64 + t * 16 + j - 32] = cv; F_ROPE[T * 64 + T * 16 + t * 16 + j - 32] = sv; }
    }
    LAS float* scr = (LAS float*)(F.lds + 57344 + wave * 8448);
    for (int it = gw; it < DEPTH * PI_LAYER; it += NGW) {
        const int l = it / PI_LAYER; int r = it % PI_LAYER; bf16* wl = F_WB + (size_t)l * W_LAYER;
        const int nl = lane & 31;
        if (r < PI_IN) { const int kb = r / 64, nb = r % 64, n = nb * 32 + nl, sc = src_col_in(n);
            prep_tile(sc >= 0 ? F_w_in + (size_t)l * D * INW + sc : nullptr, INW, kb * 64, nullptr, wl + W_IN + (size_t)(nb * 32) * D + kb * 64, D, scr, lane); continue; } r -= PI_IN;
        if (r < PI_UP) { const int kb = r / 32, nb = r % 32, n = nb * 32 + nl, k0 = kb * 64; const float* src = nullptr; const float* ks = nullptr; int N = 384, ksrc = k0;
            if (n < 384 && k0 < 256) { const int h = n / 96, j = n % 96; const int sc = j < 64 ? n : h * 96 + 64 + rot32(j - 64); src = F_w_uq + (size_t)l * 256 * 384 + sc; ks = F_mla_q_norm + l * 256; N = 384; }
            else if (n >= 512 && k0 >= 256) { src = F_w_ukv + (size_t)l * 128 * 512 + (n - 512); ks = F_mla_kv_norm + l * 128; N = 512; ksrc = k0 - 256; }
            { float v[32];
#pragma unroll
              for (int i = 0; i < 32; ++i) { const int kk = 2 * i + (lane >> 5); v[i] = src ? src[(size_t)(ksrc + kk) * N] * ks[ksrc + kk] : 0.f; }
#pragma unroll
              for (int i = 0; i < 32; ++i) scr[(2 * i + (lane >> 5)) * 33 + (lane & 31)] = v[i];
              LDS_WAIT();
              const int c = lane & 7; bf16* dst = wl + W_UP + (size_t)(nb * 32) * UPK + k0;
#pragma unroll
              for (int j = 0; j < 4; ++j) { const int nn = (lane >> 3) + 8 * j; const LAS float* s = scr + (8 * c) * 33 + nn;
                  u32x4 o; o.x = pk2(s[0], s[33]); o.y = pk2(s[66], s[99]); o.z = pk2(s[132], s[165]); o.w = pk2(s[198], s[231]);
                  *(u32x4*)(dst + (size_t)nn * UPK + 8 * c) = o; }
              LDS_WAIT(); }
            continue; } r -= PI_UP;
        if (r < PI_OUT) { const int kb = r / 32, nb = r % 32;
            prep_tile(F_w_out + (size_t)l * D * D + nb * 32 + nl, D, kb * 64, nullptr, wl + W_OUT + (size_t)(nb * 32) * D + kb * 64, D, scr, lane); continue; } r -= PI_OUT;
        if (r < PI_GU) { const int e = r / 512, q = r % 512, kb = q / 32, nb = q % 32, n = nb * 32 + nl, f = (n >> 3) * 4 + (n & 3);
            const float* src = ((n & 4) ? F_w_up : F_w_gate) + ((size_t)l * NE + e) * D * DE + f;
            prep_tile(src, DE, kb * 64, nullptr, wl + W_GU + (size_t)e * 1024 * 1024 + (size_t)(nb * 32) * D + kb * 64, D, scr, lane); continue; } r -= PI_GU;
        { const int e = r / 256, q = r % 256, kb = q / 32, nb = q % 32;
            prep_tile(F_w_down + ((size_t)l * NE + e) * DE * D + nb * 32 + nl, D, kb * 64, nullptr, wl + W_DN + (size_t)e * 1024 * 512 + (size_t)(nb * 32) * DE + kb * 64, DE, scr, lane); }
    }
}

__device__ __forceinline__ void norm_phase(Frame& F, int l, int mode, int nrows) {
    const int lane = F.lane, gw = F.bid * NWAVES + F.wave, NGW = F.G * NWAVES;
    LAS float* wrT = (LAS float*)F.lds;
    if (mode == 1) {
        const float* wr = F_w_router + (size_t)l * D * NE;
        for (int i = F.tid; i < D * NE; i += 512) wrT[(i & 15) * 1028 + (i >> 4)] = wr[i];
        __syncthreads();
    }
    const float* gain = mode == 0 ? F_norm1 + (size_t)l * D : (mode == 1 ? F_norm2 + (size_t)l * D : F_final_norm);
    for (int r = gw; r < nrows; r += NGW) {
        const int mb = r < RL ? r / T : 8;
        float* xr = F_X + (size_t)r * D;
        f32x4 v[4];
#pragma unroll
        for (int j = 0; j < 4; ++j) v[j] = ((const f32x4*)xr)[lane + 64 * j];
        if (mode != 1 && l > 0) {
            const float* g2 = F_MOD + ((size_t)(l - 1) * 9 + mb) * 6144 + 5120;
            f32x4 s[4];
#pragma unroll
            for (int j = 0; j < 4; ++j) s[j] = (f32x4){0.f, 0.f, 0.f, 0.f};
            const int myinv = lane < NE ? F_INV[(size_t)r * NE + lane] : -1;
            for (int e = 0; e < NE; ++e) { const int sl = __shfl(myinv, e);
                if (sl >= 0) { const bf16* yr = F_Y + (size_t)sl * D;
#pragma unroll
                    for (int j = 0; j < 4; ++j) { const u32x2 w = ((const u32x2*)yr)[lane + 64 * j];
                        s[j].x += bf2f(w.x & 0xffff); s[j].y += bf2f(w.x >> 16); s[j].z += bf2f(w.y & 0xffff); s[j].w += bf2f(w.y >> 16); } } }
#pragma unroll
            for (int j = 0; j < 4; ++j) { const f32x4 g = ((const f32x4*)g2)[lane + 64 * j]; v[j] += g * s[j]; ((f32x4*)xr)[lane + 64 * j] = v[j]; }
        }
        if (mode == 0 && lane < 2) F_RSQ[(size_t)r * 2 + lane] = 0.f;
        float ss = 0.f;
#pragma unroll
        for (int j = 0; j < 4; ++j) ss += (v[j].x * v[j].x + v[j].y * v[j].y) + (v[j].z * v[j].z + v[j].w * v[j].w);
        const float rs = 1.0f / sqrtf(wave_sum(ss) * (1.f / D) + EPS);
        if (mode == 2) {
#pragma unroll
            for (int j = 0; j < 4; ++j) { const f32x4 g = ((const f32x4*)gain)[lane + 64 * j]; ((f32x4*)(F.out + (size_t)r * D))[lane + 64 * j] = v[j] * rs * g; }
        } else {
            const float* md = F_MOD + ((size_t)l * 9 + mb) * 6144 + (mode == 0 ? 0 : 3072);
#pragma unroll
            for (int j = 0; j < 4; ++j) { const f32x4 g = ((const f32x4*)gain)[lane + 64 * j];
                const f32x4 sh = ((const f32x4*)md)[lane + 64 * j], sc = ((const f32x4*)(md + 1024))[lane + 64 * j];
                v[j] = v[j] * rs * g * (sc + 1.0f) + sh;
                u32x2 w; w.x = pk2(v[j].x, v[j].y); w.y = pk2(v[j].z, v[j].w);
                ((u32x2*)(F_ACT + (size_t)r * D))[lane + 64 * j] = w; }
            if (mode == 1) {
                float mine = -1e30f;
#pragma unroll 2
                for (int e = 0; e < NE; ++e) { float a = 0.f;
#pragma unroll
                    for (int j = 0; j < 4; ++j) { const f32x4 w = *(const LAS f32x4*)(wrT + e * 1028 + 256 * j + 4 * lane); a += (v[j].x * w.x + v[j].y * w.y) + (v[j].z * w.z + v[j].w * w.w); }
                    a = wave_sum(a); mine = lane == e ? a : mine; }
                float mx = mine;
#pragma unroll
                for (int o = 1; o < 16; o <<= 1) mx = fmaxf(mx, __shfl_xor(mx, o));
                const float ex = __expf(mine - mx); float sum = ex;
#pragma unroll
                for (int o = 1; o < 16; o <<= 1) sum += __shfl_xor(sum, o);
                if (lane < NE) F_AFF[(size_t)r * NE + lane] = ex / sum;
            }
        }
    }
}

__device__ __forceinline__ void topk_phase(Frame& F, int nsets) {
    LAS unsigned* cnt = (LAS unsigned*)F.lds;
    const int tid = F.tid, lane = F.lane, wave = F.wave;
    for (int it = F.bid; it < nsets * NE; it += F.G) {
        const int set = it / NE, e = it % NE; const bool lat = set < 8; const int b = lat ? set : set - 8;
        const int n = lat ? T : LC, cap = lat ? CAPL : CAPC, row0 = lat ? b * T : RL + b * LC, slot0 = e * SLOTS_E + (lat ? b * CAPL : NB * CAPL + b * CAPC);
        unsigned v[4];
#pragma unroll
        for (int q = 0; q < 4; ++q) { const int idx = 4 * tid + q; v[q] = idx < n ? __builtin_bit_cast(unsigned, F_AFF[(size_t)(row0 + idx) * NE + e]) : 0u; }
        unsigned prefix = 0u; int par = 0;
        for (int bit = 30; bit >= 0; --bit) {
            const unsigned cand = prefix | (1u << bit);
            unsigned c = 0;
#pragma unroll
            for (int q = 0; q < 4; ++q) c += (unsigned)__popcll(__ballot(v[q] >= cand));
            if (lane == 0) cnt[par * 8 + wave] = c;
            __syncthreads();
            unsigned tot = 0;
#pragma unroll
            for (int w = 0; w < 8; ++w) tot += cnt[par * 8 + w];
            if (tot >= (unsigned)cap) prefix = cand;
            par ^= 1;
        }
        unsigned g4 = 0, e4 = 0;
#pragma unroll
        for (int q = 0; q < 4; ++q) { g4 += v[q] > prefix ? 1u : 0u; e4 += v[q] == prefix ? 1u : 0u; }
        unsigned pk = g4 | (e4 << 16), inc = pk;
#pragma unroll
        for (int o = 1; o < 64; o <<= 1) { const unsigned t = __shfl_up(inc, o); if (lane >= o) inc += t; }
        __syncthreads();
        if (lane == 63) cnt[16 + wave] = inc;
        __syncthreads();
        unsigned base = 0, total = 0;
#pragma unroll
        for (int w = 0; w < 8; ++w) { const unsigned t = cnt[16 + w]; total += t; if (w < wave) base += t; }
        const unsigned excl = base + inc - pk;
        unsigned gpre = excl & 0xffffu, epre = excl >> 16; const unsigned need = (unsigned)cap - (total & 0xffffu);
#pragma unroll
        for (int q = 0; q < 4; ++q) { const int idx = 4 * tid + q;
            if (idx < n) { const bool isg = v[q] > prefix, ise = v[q] == prefix; const bool sel = isg || (ise && epre < need);
                const int slot = slot0 + (int)(gpre + (epre < need ? epre : need));
                if (sel) { F_STOK[slot] = row0 + idx; F_SGATE[slot] = __builtin_bit_cast(float, v[q]); }
                F_INV[(size_t)(row0 + idx) * NE + e] = sel ? slot : -1;
                gpre += isg ? 1u : 0u; epre += ise ? 1u : 0u; } }
        __syncthreads();
    }
}

namespace att {
typedef short s16x4 __attribute__((ext_vector_type(4)));
typedef float f32x2_t __attribute__((ext_vector_type(2)));
typedef __bf16 bf16x2_t __attribute__((ext_vector_type(2)));
constexpr int L_K = 0, KBUF = 16384, L_V = 2 * KBUF, VBUF = 8192, L_WS = L_V + 2 * VBUF, L_OST = L_WS + 8 * 256, L_END = L_OST + 8 * 4096;
#define ATT_SBAR() __builtin_amdgcn_sched_barrier(0)
__device__ __forceinline__ int crow(int r, int hi) { return (r & 3) + 8 * (r >> 2) + 4 * hi; }
__device__ __forceinline__ unsigned cvtpk(float lo, float hi) { f32x2_t v = {lo, hi}; bf16x2_t b = __builtin_convertvector(v, bf16x2_t); return __builtin_bit_cast(unsigned, b); }
__device__ __forceinline__ int v_st(int k, int c) { const int kk = (k & ~0xC) | ((k & 4) << 1) | ((k & 8) >> 1); return ((kk >> 3) * 2 + (c >> 5)) * 512 + ((kk & 7) * 32 + (c & 31)) * 2; }
__device__ __forceinline__ int v_rd_base(int lane) { return ((lane & 3) << 3) | (((lane >> 2) & 3) << 6) | (((lane >> 4) & 1) << 5) | (((lane >> 5) & 1) << 8); }
template <int OFF> __device__ __forceinline__ s16x4 tr_read(int vb) { s16x4 r; asm volatile("ds_read_b64_tr_b16 %0, %1 offset:%2" : "=&v"(r) : "v"(vb), "i"(OFF) : "memory"); return r; }
template <int D0> __device__ __forceinline__ void pv_one(f32x16& od, int vb, bf16x8 pa0, bf16x8 pa1, bf16x8 pa2, bf16x8 pa3) {
    const s16x4 l0 = tr_read<D0 * 512 + 0 * 2048>(vb), h0 = tr_read<D0 * 512 + 0 * 2048 + 1024>(vb), l1 = tr_read<D0 * 512 + 1 * 2048>(vb), h1 = tr_read<D0 * 512 + 1 * 2048 + 1024>(vb);
    const s16x4 l2 = tr_read<D0 * 512 + 2 * 2048>(vb), h2 = tr_read<D0 * 512 + 2 * 2048 + 1024>(vb), l3 = tr_read<D0 * 512 + 3 * 2048>(vb), h3 = tr_read<D0 * 512 + 3 * 2048 + 1024>(vb);
    asm volatile("s_waitcnt lgkmcnt(0)" ::: "memory"); ATT_SBAR();
#define ATT_PK(L, H) (bf16x8){L[0], L[1], L[2], L[3], H[0], H[1], H[2], H[3]}
    od = __builtin_amdgcn_mfma_f32_32x32x16_bf16(pa0, ATT_PK(l0, h0), od, 0, 0, 0);
    od = __builtin_amdgcn_mfma_f32_32x32x16_bf16(pa1, ATT_PK(l1, h1), od, 0, 0, 0);
    od = __builtin_amdgcn_mfma_f32_32x32x16_bf16(pa2, ATT_PK(l2, h2), od, 0, 0, 0);
    od = __builtin_amdgcn_mfma_f32_32x32x16_bf16(pa3, ATT_PK(l3, h3), od, 0, 0, 0);
#undef ATT_PK
}
template <int NKS, int ROWB, int CB0> __device__ __forceinline__ void qkt(f32x16& p0, f32x16& p1, const LAS unsigned char* Kb, const bf16x8* qr, int r32, int hi) {
    p0 = f32x16{}; p1 = f32x16{};
#pragma unroll
    for (int d0 = 0; d0 < NKS; ++d0) { const int cb = CB0 + (d0 * 16 + hi * 8) * 2;
        const bf16x8 b0 = *(const LAS bf16x8*)(Kb + r32 * ROWB + (cb ^ ((r32 & 7) << 4)));
        const bf16x8 b1 = *(const LAS bf16x8*)(Kb + (32 + r32) * ROWB + (cb ^ ((r32 & 7) << 4)));
        p0 = __builtin_amdgcn_mfma_f32_32x32x16_bf16(b0, qr[d0], p0, 0, 0, 0);
        p1 = __builtin_amdgcn_mfma_f32_32x32x16_bf16(b1, qr[d0], p1, 0, 0, 0); }
}
__device__ __forceinline__ void softmax_tile(f32x16& p0, f32x16& p1, float& m_reg, float& l_reg, f32x16 (&o)[2], const float C, LAS float* al_l, int r32, int hi, bf16x8& pa0, bf16x8& pa1, bf16x8& pa2, bf16x8& pa3) {
    float pmax = p0[0];
#pragma unroll
    for (int r = 1; r < 16; ++r) pmax = fmaxf(pmax, p0[r]);
#pragma unroll
    for (int r = 0; r < 16; ++r) pmax = fmaxf(pmax, p1[r]);
    { auto rr = __builtin_amdgcn_permlane32_swap(__float_as_uint(pmax), __float_as_uint(pmax), false, false); pmax = fmaxf(__uint_as_float(rr[0]), __uint_as_float(rr[1])); }
    if (!__all(pmax <= m_reg)) {
        const float mn = fmaxf(m_reg, pmax), alpha = __builtin_amdgcn_exp2f((m_reg - mn) * C); m_reg = mn; l_reg *= alpha;
        if (hi == 0) al_l[r32] = alpha;
        asm volatile("s_waitcnt lgkmcnt(0)" ::: "memory");
#pragma unroll
        for (int r = 0; r < 16; ++r) { const float a = al_l[crow(r, hi)]; o[0][r] *= a; o[1][r] *= a; }
    }
    const float mnC = -m_reg * C;
#pragma unroll
    for (int r = 0; r < 16; ++r) { p0[r] = __builtin_amdgcn_exp2f(fmaf(p0[r], C, mnC)); p1[r] = __builtin_amdgcn_exp2f(fmaf(p1[r], C, mnC)); }
    float ps = 0.f;
#pragma unroll
    for (int r = 0; r < 16; ++r) ps += p0[r] + p1[r];
    { auto rr = __builtin_amdgcn_permlane32_swap(__float_as_uint(ps), __float_as_uint(ps), false, false); ps = __uint_as_float(rr[0]) + __uint_as_float(rr[1]); }
    l_reg += ps;
#define ATT_PK4(P, BASE, OUT) do { const unsigned a0 = cvtpk(P[BASE + 0], P[BASE + 1]), a1 = cvtpk(P[BASE + 2], P[BASE + 3]); \
    const unsigned b0 = cvtpk(P[BASE + 4], P[BASE + 5]), b1 = cvtpk(P[BASE + 6], P[BASE + 7]); \
    auto r0 = __builtin_amdgcn_permlane32_swap(a0, b0, false, false); auto r1 = __builtin_amdgcn_permlane32_swap(a1, b1, false, false); \
    u32x4 w = {r0[0], r1[0], r0[1], r1[1]}; OUT = __builtin_bit_cast(bf16x8, w); } while (0)
    ATT_PK4(p0, 0, pa0); ATT_PK4(p0, 8, pa1); ATT_PK4(p1, 0, pa2); ATT_PK4(p1, 8, pa3);
#undef ATT_PK4
}
struct Tensors { const bf16* P; const bf16* QKVM; bf16* O; const float* sink; const float* dnorm; float lam, lam_init; int l; };

template <int TYPE> __device__ __forceinline__ void unit(const Tensors& Tn, LAS unsigned char* lds, const int tid, const int b, const int h, const bool lat, const int q0) {
    constexpr int NKS = TYPE == 0 ? 4 : (TYPE == 1 ? 6 : 2);
    constexpr int ROWB = TYPE == 1 ? 256 : 128;
    constexpr float C = (TYPE == 0 ? 0.125f : (TYPE == 1 ? 0.10206207261596577f : 0.17677669529663687f)) * 1.4426950408889634f;
    const int lane = tid & 63, wid = __builtin_amdgcn_readfirstlane(tid >> 6), r32 = lane & 31, hi = lane >> 5;
    LAS float* wsf = (LAS float*)(lds + L_WS) + wid * 64;
    const int qrow0 = (lat ? b * T + q0 : RL + b * LC) + wid * 32;
    bf16x8 qr[TYPE == 2 ? 4 : NKS];
    { const bf16* qp = TYPE == 0 ? Tn.P + (size_t)(qrow0 + r32) * LDP + P_AQ + h * 64 : (TYPE == 1 ? Tn.QKVM + (size_t)(qrow0 + r32) * LDM + h * 96 : Tn.P + (size_t)(qrow0 + r32) * LDP + P_DQ + h * 64);
#pragma unroll
      for (int d0 = 0; d0 < (TYPE == 2 ? 4 : NKS); ++d0) qr[d0] = *(const bf16x8*)(qp + d0 * 16 + hi * 8); }
    const int kvh = h >> 2;
    const bf16* Kp = TYPE == 0 ? Tn.P + P_AK + kvh * 64 : (TYPE == 1 ? Tn.QKVM + 512 + h * 128 : Tn.P + P_DK + h * 64);
    const bf16* Vp = TYPE == 0 ? Tn.P + P_AV + kvh * 64 : (TYPE == 1 ? Tn.QKVM + 512 + h * 128 + 64 : Tn.P + P_DV + h * 64);
    constexpr int KPITCH = TYPE == 1 ? LDM : LDP;
    int kl0 = 0, nloc = 0;
    if (lat) { if (TYPE == 0) { kl0 = q0 - 128 < 0 ? 0 : q0 - 128; const int kl1 = q0 + 256 + 128 > T ? T : q0 + 256 + 128; nloc = (kl1 - kl0) >> 6; } else { kl0 = 0; nloc = T / 64; } }
    const int NT = 4 + nloc;
    const int crow0 = RL + b * LC, lrow0 = b * T + kl0;
#define ATT_TROW(i) ((i) < 4 ? crow0 + 64 * (i) : lrow0 + 64 * ((i) - 4))
    const int sr = tid >> 3, sc = tid & 7, sr2 = tid >> 2, sc2 = tid & 3;
    const int kst = sr * ROWB + ((sc * 16) ^ ((sr & 7) << 4)), kst2 = sr2 * ROWB + ((128 + sc2 * 16) ^ ((sr2 & 7) << 4)), vst = v_st(sr, sc * 8);
    u32x4 sk, sv, sk2;
#define ATT_SLOAD(i) do { const int g_ = ATT_TROW(i); sk = *(const u32x4*)(Kp + (size_t)(g_ + sr) * KPITCH + sc * 8); sv = *(const u32x4*)(Vp + (size_t)(g_ + sr) * KPITCH + sc * 8); \
        if (TYPE == 1) { if (tid < 256) sk2 = *(const u32x4*)(Tn.P + (size_t)(g_ + sr2) * LDP + P_KR + sc2 * 8); } } while (0)
#define ATT_SWRITE(bf) do { *(LAS u32x4*)(lds + L_K + (bf) * KBUF + kst) = sk; *(LAS u32x4*)(lds + L_V + (bf) * VBUF + vst) = sv; \
        if (TYPE == 1) { if (tid < 256) *(LAS u32x4*)(lds + L_K + (bf) * KBUF + kst2) = sk2; } } while (0)
    const int vb0 = (int)(uintptr_t)(lds + L_V) + v_rd_base(lane);
    float m0 = -1e30f, l0 = 0.f, m1 = -1e30f, l1 = 0.f; f32x16 oA[2] = {f32x16{}, f32x16{}}; f32x16 oB[2] = {f32x16{}, f32x16{}};
    const int qw = q0 + wid * 32, qpos = qw + r32;
    ATT_SLOAD(0); asm volatile("s_waitcnt vmcnt(0)" ::: "memory"); ATT_SWRITE(0); __syncthreads();
    for (int i = 0; i < NT; ++i) {
        const int bf = i & 1;
        if (i + 1 < NT) ATT_SLOAD(i + 1);
        const LAS unsigned char* Kb = lds + L_K + bf * KBUF; const int vb = vb0 + bf * VBUF;
        bool need = true; const int kt0 = kl0 + 64 * (i - 4);
        if (TYPE == 0 && i >= 4) need = (kt0 + 63 >= qw - 128) && (kt0 <= qw + 31 + 128);
        if (need) {
            f32x16 p0, p1; bf16x8 pa0, pa1, pa2, pa3;
            qkt<NKS, ROWB, 0>(p0, p1, Kb, qr, r32, hi);
            if (TYPE == 0 && i >= 4) {
#pragma unroll
                for (int r = 0; r < 16; ++r) { const int k0_ = kt0 + crow(r, hi) - qpos; if (k0_ < -128 || k0_ > 128) p0[r] = -1e30f; if (k0_ + 32 < -128 || k0_ + 32 > 128) p1[r] = -1e30f; }
            }
            softmax_tile(p0, p1, m0, l0, oA, C, wsf, r32, hi, pa0, pa1, pa2, pa3);
            pv_one<0>(oA[0], vb, pa0, pa1, pa2, pa3); pv_one<1>(oA[1], vb, pa0, pa1, pa2, pa3);
            if (TYPE == 2) {
                qkt<NKS, ROWB, 64>(p0, p1, Kb, qr + 2, r32, hi);
                softmax_tile(p0, p1, m1, l1, oB, C, wsf, r32, hi, pa0, pa1, pa2, pa3);
                pv_one<0>(oB[0], vb, pa0, pa1, pa2, pa3); pv_one<1>(oB[1], vb, pa0, pa1, pa2, pa3);
            }
        }
        if (i + 1 < NT) { asm volatile("s_waitcnt vmcnt(0)" ::: "memory"); ATT_SWRITE(bf ^ 1); }
        __syncthreads();
    }
    if (TYPE == 0) l0 += __builtin_amdgcn_exp2f(Tn.sink[Tn.l * 8 + h] * 1.4426950408889634f - m0 * C);
    if (hi == 0) { wsf[r32] = l0; if (TYPE == 2) wsf[32 + r32] = l1; }
    asm volatile("s_waitcnt lgkmcnt(0)" ::: "memory");
    LAS bf16* stg = (LAS bf16*)(lds + L_OST) + wid * 2048;
    if (TYPE != 2) {
#pragma unroll
        for (int r = 0; r < 16; ++r) { const float rl = __builtin_amdgcn_rcpf(wsf[crow(r, hi)]); const int orow = crow(r, hi);
            stg[orow * 64 + r32] = (bf16)f2bf(oA[0][r] * rl); stg[orow * 64 + 32 + r32] = (bf16)f2bf(oA[1][r] * rl); }
    } else {
        const float g0 = Tn.dnorm[Tn.l * 64 + r32], g1 = Tn.dnorm[Tn.l * 64 + 32 + r32];
#pragma unroll
        for (int r = 0; r < 16; ++r) { const float rl0 = __builtin_amdgcn_rcpf(wsf[crow(r, hi)]), rl1 = Tn.lam * __builtin_amdgcn_rcpf(wsf[32 + crow(r, hi)]);
            const float a0 = oA[0][r] * rl0 - oB[0][r] * rl1, a1 = oA[1][r] * rl0 - oB[1][r] * rl1;
            float ss = a0 * a0 + a1 * a1;
#pragma unroll
            for (int o_ = 1; o_ < 32; o_ <<= 1) ss += __shfl_xor(ss, o_);
            const float rs = (1.f - Tn.lam_init) * __builtin_amdgcn_rsqf(ss * (1.f / 64.f) + EPS); const int orow = crow(r, hi);
            stg[orow * 64 + r32] = (bf16)f2bf(a0 * rs * g0); stg[orow * 64 + 32 + r32] = (bf16)f2bf(a1 * rs * g1); }
    }
    asm volatile("s_waitcnt lgkmcnt(0)" ::: "memory");
    { bf16* Ow = Tn.O + (size_t)qrow0 * D + (TYPE == 0 ? h * 64 : (TYPE == 1 ? 512 + h * 64 : 768 + h * 64));
#pragma unroll
      for (int i = 0; i < 4; ++i) { const int row = i * 8 + (lane >> 3), ch = lane & 7; *(u32x4*)(Ow + (size_t)row * D + ch * 8) = *(const LAS u32x4*)(stg + row * 64 + ch * 8); } }
    __syncthreads();
#undef ATT_TROW
#undef ATT_SLOAD
#undef ATT_SWRITE
}
}

__device__ __forceinline__ void attn_phase(Frame& F, const int l, const bool need_ctx) {
    att::Tensors Tn; Tn.P = F_P; Tn.QKVM = F_QKVM; Tn.O = F_O; Tn.sink = F_sink; Tn.dnorm = F_diff_norm; Tn.l = l;
    { float s1 = 0.f, s2 = 0.f;
      if (F.lane < 32) { s1 = F_lq1[l * 32 + F.lane] * F_lk1[l * 32 + F.lane]; s2 = F_lq2[l * 32 + F.lane] * F_lk2[l * 32 + F.lane]; }
      s1 = wave_sum(s1); s2 = wave_sum(s2);
      Tn.lam_init = 0.8f - 0.6f * __expf(-0.3f * (float)l); Tn.lam = __expf(s1) - __expf(s2) + Tn.lam_init; }
    const int b = F.bid & 7, j = F.bid >> 3;
    if (F.G != 256) return;
    att::unit<2>(Tn, F.lds, F.tid, b, j >> 3, true, (j & 7) * 256);
    att::unit<1>(Tn, F.lds, F.tid, b, j >> 3, true, (j & 7) * 256);
    att::unit<0>(Tn, F.lds, F.tid, b, j >> 2, true, (j & 3) * 512);
    att::unit<0>(Tn, F.lds, F.tid, b, j >> 2, true, (j & 3) * 512 + 256);
    if (need_ctx && j < 16) {
        if (j < 8) att::unit<0>(Tn, F.lds, F.tid, b, j, false, 0);
        else if (j < 12) att::unit<1>(Tn, F.lds, F.tid, b, j - 8, false, 0);
        else att::unit<2>(Tn, F.lds, F.tid, b, j - 12, false, 0);
    }
}

enum { PH_P0 = 0, PH_L0 = 1, PH_PER_LAYER = 9, PH_FINAL = PH_L0 + DEPTH * PH_PER_LAYER, NPH = PH_FINAL + 1 };
enum { SP_NORM1 = 0, SP_INPROJ = 1, SP_UP = 2, SP_ATTN = 3, SP_OUT = 4, SP_NORM2 = 5, SP_TOPK = 6, SP_MOE1 = 7, SP_MOE2 = 8 };

#ifndef PHMASK
#define PHMASK 0x3ff
#endif
#define PHON(b) ((PHMASK >> (b)) & 1)
__global__ void __launch_bounds__(NWAVES * 64, 2) mk(Args args) {
    extern __shared__ __attribute__((aligned(16))) unsigned char lds_raw[];
    Frame F;
    F.lds = (LAS unsigned char*)lds_raw;
    F.tid = threadIdx.x; F.lane = F.tid & 63; F.wave = __builtin_amdgcn_readfirstlane(F.tid >> 6); F.bid = blockIdx.x; F.G = gridDim.x;
    const int wave_s = F.wave;
    F.in = (const float* const*)args.in; F.out = args.out; F.ws = args.ws;
    volatile LAS unsigned* MISC = (volatile LAS unsigned*)(F.lds + MISC_OFF);
    for (int u = F.tid; u < (LDS_BYTES - LDSCTL_OFF) / 4; u += NWAVES * 64) ((LAS unsigned*)(F.lds + LDSCTL_OFF))[u] = 0u;
    __syncthreads();
    XcdBarrier bar = xcd_barrier_post((unsigned*)(args.ws + WS_CTL) + CW_BAR + args.li * XCD_BAR_WORDS, MISC + 8);
    const int gx = F.bid & 7, gj = F.bid >> 3, gpx = F.G >> 3;
    for (int ph = args.ph_lo; ph < args.ph_hi; ++ph) {
        { unsigned char* w_ = args.ws; asm volatile("" : "+s"(w_)); F.ws = w_; int z_ = 0; asm volatile("" : "+s"(z_)); F.in = (const float* const*)args.in + z_;
          int l_ = (int)__builtin_amdgcn_mbcnt_hi(~0u, __builtin_amdgcn_mbcnt_lo(~0u, 0u)); asm volatile("" : "+v"(l_)); int w_s = wave_s; asm volatile("" : "+s"(w_s)); F.lane = l_; F.wave = w_s; F.tid = w_s * 64 + l_; }
        if (ph == PH_P0) { if (PHON(9)) p0_phase(F); }
        else if (ph == PH_FINAL) { if (PHON(0)) norm_phase(F, DEPTH, 2, RL); }
        else {
            const int l = (ph - PH_L0) / PH_PER_LAYER, sp = (ph - PH_L0) % PH_PER_LAYER;
            const bool need_ctx = l < DEPTH - 1; const int rows_mix = need_ctx ? R : RL;
            const bf16* wl = F_WB + (size_t)l * W_LAYER;
            if (sp == SP_NORM1) { if (PHON(0)) norm_phase(F, l, 0, R); }
            else if (sp == SP_INPROJ && PHON(1)) {
                pg8::Gemm g{F_ACT, wl + W_IN, nullptr, 0, D, D}; OrderRows S{gx, gj, gpx, R / 256 / 8, LDP / 256};
                EpiInProj E{F_P, F_ROPE, F_RSQ};
                pg8::gemm_phase<false>(F.lds, F.tid, g, S, E);
            } else if (sp == SP_UP && PHON(2)) {
                pg8::Gemm g{F_P + P_CQ, wl + W_UP, nullptr, 0, LDP, UPK}; OrderRows S{gx, gj, gpx, R / 256 / 8, 4};
                EpiUp E{F_QKVM, F_ROPE, F_RSQ};
                pg8::gemm_phase<false>(F.lds, F.tid, g, S, E);
            } else if (sp == SP_ATTN) { if (PHON(3)) attn_phase(F, l, need_ctx);
            } else if (sp == SP_OUT && PHON(4)) {
                pg8::Gemm g{F_O, wl + W_OUT, nullptr, 0, D, D}; OrderRows S{gx, gj, gpx, rows_mix / 256 / 8, 4};
                EpiOut E{F_X, F_MOD + (size_t)l * 9 * 6144};
                pg8::gemm_phase<false>(F.lds, F.tid, g, S, E);
            } else if (sp == SP_NORM2) { if (PHON(5)) norm_phase(F, l, 1, rows_mix); }
            else if (sp == SP_TOPK) { if (PHON(6)) topk_phase(F, need_ctx ? 16 : 8); }
            else if (sp == SP_MOE1 && PHON(7)) {
                pg8::Gemm g{F_ACT, wl + W_GU, F_STOK, (size_t)1024 * 1024, D, D}; OrderMoe S{gx, gj, gpx, need_ctx ? 9 : 8, 4};
                EpiGU E{F_HID};
                pg8::gemm_phase<true>(F.lds, F.tid, g, S, E);
            } else if (sp == SP_MOE2 && PHON(8)) {
                pg8::Gemm g{F_HID, wl + W_DN, nullptr, (size_t)1024 * 512, DE, DE}; OrderMoe S{gx, gj, gpx, need_ctx ? 9 : 8, 4};
                EpiDown E{F_Y, F_SGATE};
                pg8::gemm_phase<false>(F.lds, F.tid, g, S, E);
            }
        }
        if (ph + 1 < args.ph_hi) xcd_barrier(bar, F.tid);
    }
}

extern "C" void kernel_launch(void* const* d_in, const int* in_sizes, int n_in, void* d_out, int out_size, void* d_ws, size_t ws_size, hipStream_t stream) {
    static int grid = 0;
    if (grid == 0) {
        if (n_in != 25 || ws_size < WS_END || out_size != RL * D) { fprintf(stderr, "kernel_launch: unexpected shapes (n_in %d, ws %zu < %zu, out %d)\n", n_in, ws_size, (size_t)WS_END, out_size); grid = -1; return; }
        int dev = 0, cus = 0, per_cu = 0;
        if (hipGetDevice(&dev) != hipSuccess || hipDeviceGetAttribute(&cus, hipDeviceAttributeMultiprocessorCount, dev) != hipSuccess) { grid = -1; return; }
        if (hipFuncSetAttribute((const void*)mk, hipFuncAttributeMaxDynamicSharedMemorySize, LDS_BYTES) != hipSuccess) { fprintf(stderr, "kernel_launch: hipFuncSetAttribute failed\n"); grid = -1; return; }
        if (hipOccupancyMaxActiveBlocksPerMultiprocessor(&per_cu, (const void*)mk, NWAVES * 64, LDS_BYTES) != hipSuccess || per_cu < 1) { fprintf(stderr, "kernel_launch: occupancy query says %d\n", per_cu); }
        (void)hipGetLastError();
        grid = cus;
        if (grid % 8 != 0) { fprintf(stderr, "kernel_launch: %d CUs, expected a multiple of 8\n", grid); grid = -1; return; }
    }
    if (grid < 0) return;
    (void)hipMemsetAsync((char*)d_ws + WS_CTL, 0, CTL_ZERO_BYTES, stream);
    Args a; memset(&a, 0, sizeof a);
    for (int i = 0; i < 25; ++i) a.in[i] = (const float*)d_in[i];
    a.out = (float*)d_out; a.ws = (unsigned char*)d_ws;
    a.ph_lo = 0; a.ph_hi = NPH; a.li = 0;
    hipLaunchKernelGGL(mk, dim3(grid), dim3(NWAVES * 64), LDS_BYTES, stream, a);
}
```

```cpp
#include <hip/hip_runtime.h>
#include <stdint.h>
#include <string.h>
#include <stdio.h>

typedef unsigned short bf16;
typedef unsigned u32x4 __attribute__((ext_vector_type(4)));
typedef unsigned u32x2 __attribute__((ext_vector_type(2)));
typedef float f32x4 __attribute__((ext_vector_type(4)));
typedef float f32x16 __attribute__((ext_vector_type(16)));
typedef short bf16x8 __attribute__((ext_vector_type(8)));
#define LAS __attribute__((address_space(3)))
#define GAS __attribute__((address_space(1)))

constexpr int D = 1024, NB = 8, T = 2048, LC = 256, DEPTH = 4;
constexpr int RL = NB * T, RC = NB * LC, R = RL + RC;
constexpr int INW = 1952, LDP = 2048;
constexpr int NE = 16, DE = 512;
constexpr int CAPL = 256, CAPC = 32;
constexpr int SLOTS_E = NB * CAPL + NB * CAPC;
constexpr int SLOTS = NE * SLOTS_E;
constexpr float EPS = 1e-6f;
constexpr int P_AQ = 0, P_AK = 512, P_AV = 640, P_CQ = 768, P_CKV = 1024, P_KR = 1152, P_DQ = 1184, P_DK = 1440, P_DV = 1696;
constexpr int LDM = 1024;
constexpr int UPK = 384;

constexpr size_t MiB = 1u << 20;
constexpr size_t WS_CTL = 0;
constexpr size_t CTL_ZERO_BYTES = 256 * 1024;
constexpr size_t WS_MOD = 1 * MiB;
constexpr size_t WS_ROPE = 2 * MiB;
constexpr size_t WS_RSQ = 3 * MiB;
constexpr size_t WS_AFF = 4 * MiB;
constexpr size_t WS_INV = 6 * MiB;
constexpr size_t WS_STOK = 8 * MiB;
constexpr size_t WS_SGATE = 9 * MiB;
constexpr size_t WS_X = 10 * MiB;
constexpr size_t WS_ACT = 82 * MiB;
constexpr size_t WS_P = 118 * MiB;
constexpr size_t WS_Y = WS_P;
constexpr size_t WS_QKVM = 190 * MiB;
constexpr size_t WS_O = 226 * MiB;
constexpr size_t WS_HID = WS_O;
constexpr size_t WS_W = 262 * MiB;
constexpr size_t W_IN = 0;
constexpr size_t W_UP = W_IN + (size_t)LDP * D;
constexpr size_t W_OUT = W_UP + (size_t)1024 * UPK;
constexpr size_t W_GU = W_OUT + (size_t)D * D;
constexpr size_t W_DN = W_GU + (size_t)NE * 1024 * 1024;
constexpr size_t W_LAYER = W_DN + (size_t)NE * 1024 * 512;
constexpr size_t WS_END = WS_W + (size_t)DEPTH * W_LAYER * 2;

__device__ __forceinline__ unsigned f2bf(float f) { unsigned u = __builtin_bit_cast(unsigned, f); return (u + 0x7fffu + ((u >> 16) & 1u)) >> 16; }
__device__ __forceinline__ float bf2f(unsigned h) { return __builtin_bit_cast(float, h << 16); }
__device__ __forceinline__ unsigned pk2(float lo, float hi) { return f2bf(lo) | (f2bf(hi) << 16); }
__device__ __forceinline__ float shx(float v, int o, int lane) { return __builtin_bit_cast(float, __builtin_amdgcn_ds_bpermute((lane ^ o) << 2, __builtin_bit_cast(int, v))); }
__device__ __forceinline__ int shi(int v, int src) { return __builtin_amdgcn_ds_bpermute(src << 2, v); }
__device__ __forceinline__ float wave_sum(float v, int lane) {
#pragma unroll
    for (int o = 1; o < 64; o <<= 1) v += shx(v, o, lane);
    return v;
}
__device__ __forceinline__ float siluf(float v) { return v / (1.f + __expf(-v)); }
#define LDS_WAIT() asm volatile("s_waitcnt lgkmcnt(0)" ::: "memory")
#define VM_WAIT() asm volatile("s_waitcnt vmcnt(0)" ::: "memory")

struct Args {
    const float* in[25]; float* out; unsigned char* ws; int ph_lo, ph_hi, li, pad;
};

#ifndef PROBE_HOT
#define PROBE_HOT 0
#endif
#ifndef PROBE_NOLDS
#define PROBE_NOLDS 0
#endif
namespace pg8 {
constexpr int BM = 256, BK = 64, HALF = 128, HTB = HALF * BK * 2  , STAGE_BYTES = 8 * HTB;
__host__ __device__ __forceinline__ int lds_byte(int r, int c) { const int st = (r >> 4) * 2 + (c >> 5), rr = r & 15, cc = c & 31, ob = rr * 64 + cc * 2; return st * 1024 + (ob ^ (((ob >> 9) & 1) << 5)); }
__host__ __device__ __forceinline__ void stage_rc(int b, int& R, int& C) { const int st = b / 1024, sb = b % 1024, swz = sb ^ (((sb >> 9) & 1) << 5); R = (st >> 1) * 16 + swz / 64; C = (st & 1) * 32 + (swz % 64) / 2; }
__host__ __device__ __forceinline__ int perm32(int rho) { const int n = rho >> 4, i = rho & 15; return 8 * (i >> 2) + 4 * n + (i & 3); }

struct Unit { int arow0, orow0, col0, e, quad; };
struct Gemm { const bf16* A; const bf16* Bt; const int* gather; size_t b_estride; int lda, K; };

template <bool GATHER, int MF, class Epi, class Sched>
__device__ __forceinline__ void gemm_phase(LAS unsigned char* lds, const int tid, const Gemm g, const Sched& S, const Epi& E) {
    const int wid = __builtin_amdgcn_readfirstlane(tid >> 6), lane = tid & 63, wr = wid >> 2, wc = wid & 3, fr = lane & 15, fq = lane >> 4;
    constexpr int HR = 32 * MF;
    const int K = g.K, nt = K / BK;
    unsigned voffA[2], voffB[2]; int sR[2];
#pragma unroll
    for (int i = 0; i < 2; ++i) { int C_; stage_rc(tid * 16 + i * 8192, sR[i], C_); const int Rb = (sR[i] & ~31) + perm32(sR[i] & 31);
        voffA[i] = GATHER ? (unsigned)C_ * 2u : (unsigned)(sR[i] * g.lda + C_) * 2u; voffB[i] = (unsigned)(Rb * K + C_) * 2u; }
    const unsigned lda2 = (unsigned)g.lda * 2u;
    const unsigned hstepA = (unsigned)HR * g.lda * 2u;
    const unsigned kstep = (unsigned)(BK * 2);
    const int krot = (2 * S.rot) % nt;
#define PG8_KT(i) ((PROBE_HOT && hot_) ? 0u : (unsigned)(((i) + krot) >= nt ? (i) + krot - nt : (i) + krot) * kstep)
    const unsigned hstepB = (unsigned)HALF * K * 2u;
    const __amdgpu_buffer_rsrc_t rsA = __builtin_amdgcn_make_buffer_rsrc((void*)g.A, 0, 0x7fffffff, 0x00020000);
    const __amdgpu_buffer_rsrc_t rsB = __builtin_amdgcn_make_buffer_rsrc((void*)g.Bt, 0, 0x7fffffff, 0x00020000);
    const unsigned ldsw = (unsigned)wid * 1024u;
    const int aoff = lds_byte(wr * (16 * MF) + fr, fq * 8), boff = lds_byte(wc * 32 + fr, fq * 8);
#define PG8_SA(b, h) (((b) * 2 + (h)) * HTB)
#define PG8_SB(b, h) ((4 + (b) * 2 + (h)) * HTB)
#define PG8_STAGE2(bufoff, rsrc, v0, v1, soff) do { \
        __builtin_amdgcn_raw_ptr_buffer_load_lds(rsrc, (LAS unsigned*)(lds + (bufoff) + ldsw), 16, (int)(v0), (int)(soff), 0, 0); \
        __builtin_amdgcn_raw_ptr_buffer_load_lds(rsrc, (LAS unsigned*)(lds + (bufoff) + ldsw + 8192), 16, (int)(v1), (int)(soff), 0, 0); } while (0)
#define PG8_STAGEB(bufoff, soff) PG8_STAGE2(bufoff, rsB, voffB[0], voffB[1], soff)
#define PG8_STAGEA(bufoff, ubase, r0, r1, h, koff) do { if constexpr (GATHER) { \
        PG8_STAGE2(bufoff, rsA, (((r0) >> (16 * (h))) & 0xffffu) * lda2 + voffA[0], (((r1) >> (16 * (h))) & 0xffffu) * lda2 + voffA[1], (koff)); } \
        else { PG8_STAGE2(bufoff, rsA, voffA[0], voffA[1], (ubase) + (h) * hstepA + (koff)); } } while (0)
#define PG8_LDA(dst, b, h) do { if (PROBE_NOLDS && hot_) break; _Pragma("unroll") for (int m = 0; m < MF; ++m) _Pragma("unroll") for (int k = 0; k < 2; ++k) dst[m][k] = *(const LAS bf16x8*)(lds + PG8_SA(b, h) + aoff + m * 2048 + k * 1024); } while (0)
#define PG8_LDB(dst, b, h) do { if (PROBE_NOLDS && hot_) break; _Pragma("unroll") for (int n = 0; n < 2; ++n) _Pragma("unroll") for (int k = 0; k < 2; ++k) dst[n][k] = *(const LAS bf16x8*)(lds + PG8_SB(b, h) + boff + n * 2048 + k * 1024); } while (0)
#define PG8_MMA(ai, bj, At, Bt) do { __builtin_amdgcn_s_setprio(1); _Pragma("unroll") for (int m = 0; m < MF; ++m) _Pragma("unroll") for (int n = 0; n < 2; ++n) _Pragma("unroll") for (int k = 0; k < 2; ++k) \
        acc[ai][bj][m][n] = __builtin_amdgcn_mfma_f32_16x16x32_bf16(Bt[n][k], At[m][k], acc[ai][bj][m][n], 0, 0, 0); __builtin_amdgcn_s_setprio(0); } while (0)
#define PG8_WAIT_V(n) asm volatile("s_waitcnt vmcnt(" #n ")" ::: "memory")
#define PG8_WAIT_L(n) asm volatile("s_waitcnt lgkmcnt(" #n ")" ::: "memory")
#define PG8_BAR __builtin_amdgcn_s_barrier()
#define PG8_SCHED __builtin_amdgcn_sched_barrier(0)
#define PG8_ROWS(dst, u) do { if constexpr (GATHER) { _Pragma("unroll") for (int i = 0; i < 2; ++i) { \
        const int sr_ = sR[i] < HR ? sR[i] : sR[i] - 32;     \
        const unsigned a_ = (unsigned)g.gather[(u).arow0 + sr_], b_ = (unsigned)g.gather[(u).arow0 + ((u).quad ? 0 : HR) + sr_]; dst[i] = a_ | (b_ << 16); } \
        asm volatile("" : "+v"(dst[0]), "+v"(dst[1])); } } while (0)
    Unit cur, nxt; int ui = 0;
    if (!S.next(0, cur)) return;
    const bool hot_ = cur.quad == 2;
    f32x4 acc[2][2][MF][2];
#pragma unroll
    for (int a = 0; a < 2; ++a)
#pragma unroll
        for (int b = 0; b < 2; ++b)
#pragma unroll
            for (int m = 0; m < MF; ++m)
#pragma unroll
                for (int n = 0; n < 2; ++n) acc[a][b][m][n] = (f32x4){0.f, 0.f, 0.f, 0.f};
    bf16x8 At[MF][2], B0[2][2], B1[2][2];
    unsigned rp[2] = {0u, 0u}, rn[2] = {0u, 0u};
    PG8_ROWS(rp, cur);
    unsigned cA = (unsigned)cur.arow0 * lda2;
    unsigned cB = (unsigned)(((size_t)cur.e * g.b_estride + (size_t)cur.col0 * K) * 2);
    PG8_STAGEB(PG8_SB(0, 0), cB + PG8_KT(0)); PG8_STAGEB(PG8_SB(0, 1), cB + hstepB + PG8_KT(0)); PG8_STAGEA(PG8_SA(0, 0), cA, rp[0], rp[1], 0, PG8_KT(0)); PG8_STAGEA(PG8_SA(0, 1), cA, rp[0], rp[1], 1, PG8_KT(0));
    if (wr == 1) PG8_BAR;
    PG8_WAIT_V(2); PG8_BAR;
    PG8_STAGEB(PG8_SB(1, 0), cB + PG8_KT(1)); PG8_STAGEA(PG8_SA(1, 0), cA, rp[0], rp[1], 0, PG8_KT(1)); PG8_STAGEB(PG8_SB(1, 1), cB + hstepB + PG8_KT(1));
    PG8_WAIT_V(6); PG8_BAR;
    for (;;) {
        const bool has_next = S.next(ui + 1, nxt);
        if (has_next) { PG8_ROWS(rn, nxt); } else { rn[0] = rp[0]; rn[1] = rp[1]; }
        const unsigned nA = has_next ? (unsigned)nxt.arow0 * lda2 : cA;
        const unsigned nB = has_next ? (unsigned)(((size_t)nxt.e * g.b_estride + (size_t)nxt.col0 * K) * 2) : cB;
#pragma unroll 1
        for (int t = 0; t < nt; t += 2) {
            const bool last = (t == nt - 2);
            const unsigned k1 = PG8_KT(t + 1), k2 = last ? PG8_KT(0) : PG8_KT(t + 2), k3 = last ? PG8_KT(1) : PG8_KT(t + 3);
            const unsigned u2 = last ? nA : cA; const unsigned b2 = (last ? nB : cB) + k2; const unsigned b3 = (last ? nB : cB) + k3;
            const unsigned q0 = last ? rn[0] : rp[0], q1 = last ? rn[1] : rp[1];
            PG8_LDB(B0, 0, 0); PG8_LDB(B1, 0, 1); PG8_SCHED; PG8_LDA(At, 0, 0); PG8_STAGEA(PG8_SA(1, 1), cA, rp[0], rp[1], 1, k1);
            PG8_WAIT_V(8); PG8_WAIT_L(0); PG8_BAR; if (cur.quad < 2) PG8_MMA(0, 0, At, B0); if (!cur.quad) PG8_MMA(0, 1, At, B1); PG8_BAR; PG8_SCHED;
            PG8_LDA(At, 0, 1); PG8_STAGEB(PG8_SB(0, 0), b2); PG8_STAGEB(PG8_SB(0, 1), b2 + hstepB); PG8_STAGEA(PG8_SA(0, 0), u2, q0, q1, 0, k2);
            PG8_WAIT_V(8); PG8_WAIT_L(0); PG8_BAR; if (!cur.quad) { PG8_MMA(1, 0, At, B0); PG8_MMA(1, 1, At, B1); } PG8_BAR; PG8_SCHED;
            PG8_LDB(B0, 1, 0); PG8_LDB(B1, 1, 1); PG8_SCHED; PG8_LDA(At, 1, 0); PG8_STAGEA(PG8_SA(0, 1), u2, q0, q1, 1, k2);
            PG8_WAIT_V(8); PG8_WAIT_L(0); PG8_BAR; if (cur.quad < 2) PG8_MMA(0, 0, At, B0); if (!cur.quad) PG8_MMA(0, 1, At, B1); PG8_BAR; PG8_SCHED;
            PG8_LDA(At, 1, 1); PG8_STAGEB(PG8_SB(1, 0), b3); PG8_STAGEB(PG8_SB(1, 1), b3 + hstepB); PG8_STAGEA(PG8_SA(1, 0), u2, q0, q1, 0, k3);
            PG8_WAIT_V(8); PG8_WAIT_L(0); PG8_BAR; if (!cur.quad) { PG8_MMA(1, 0, At, B0); PG8_MMA(1, 1, At, B1); } PG8_BAR; PG8_SCHED;
        }
        if (wr == 0) PG8_BAR;
        E(acc, cur, wr, wc, fr, fq);
        if (!has_next) break;
#pragma unroll
        for (int a = 0; a < 2; ++a)
#pragma unroll
            for (int b = 0; b < 2; ++b)
#pragma unroll
                for (int m = 0; m < MF; ++m)
#pragma unroll
                    for (int n = 0; n < 2; ++n) acc[a][b][m][n] = (f32x4){0.f, 0.f, 0.f, 0.f};
        cur = nxt; cB = nB; cA = nA; ++ui; rp[0] = rn[0]; rp[1] = rn[1];
        if (wr == 1) PG8_BAR;
    }
    PG8_WAIT_V(0);
    PG8_BAR;
#undef PG8_SA
#undef PG8_SB
#undef PG8_STAGE2
#undef PG8_STAGEB
#undef PG8_LDA
#undef PG8_LDB
#undef PG8_MMA
#undef PG8_WAIT_V
#undef PG8_WAIT_L
#undef PG8_BAR
#undef PG8_SCHED
#undef PG8_KT
#undef PG8_ROWS
#undef PG8_STAGEA
}
}

#ifndef QUAD_SPLIT
#define QUAD_SPLIT 1
#endif
__device__ __forceinline__ bool deal(int i, int j, int gpx, int U, int& unit, int& quad) {
    const int q = i * gpx + j, nfull = (U / gpx) * gpx, left = U - nfull;
    if (q < nfull || left * 4 > gpx || !QUAD_SPLIT) { if (q >= U) return false; unit = q; quad = -1; return true; }
    const int s_ = q - nfull; if (s_ >= left * 4) return false; unit = nfull + (s_ >> 2); quad = s_ & 3; return true;
}
struct OrderRows {
    int x, j, gpx, rpx, nN, nomma, rot, TR;
    __device__ __forceinline__ bool next(int i, pg8::Unit& u) const {
        int q, quad; if (!deal(i, j, gpx, rpx * nN, q, quad)) return false;
        const int pm = x * rpx + q / nN, pn = q % nN; u.arow0 = pm * TR; u.col0 = pn * 256; u.e = 0; u.quad = quad >= 0;
        if (quad >= 0) { u.arow0 += (quad >> 1) * (TR / 2); u.col0 += (quad & 1) * 128; }
        if (nomma) u.quad = 2;
        u.orow0 = u.arow0; return true; }
};
struct OrderMoe {
    int x, j, gpx, nME, nN, rot, TR;
    __device__ __forceinline__ bool next(int i, pg8::Unit& u) const {
        int q, quad; const int per = nME * nN; if (!deal(i, j, gpx, 2 * per, q, quad)) return false;
        const int e = 2 * x + q / per, rem = q % per, pmE = rem / nN, pn = rem % nN;
        u.arow0 = e * SLOTS_E + pmE * TR; u.col0 = pn * 256; u.e = e; u.quad = quad >= 0;
        if (quad >= 0) { u.arow0 += (quad >> 1) * (TR / 2); u.col0 += (quad & 1) * 128; }
        u.orow0 = u.arow0; return true; }
};

constexpr float QS_A = 0.125f * 1.4426950408889634f, QS_B = 0.10206207261596577f * 1.4426950408889634f, QS_C = 0.17677669529663687f * 1.4426950408889634f;
typedef float f32x4e __attribute__((ext_vector_type(4)));
#define EPI_ROWS(ai, m) (u.orow0 + (ai) * (32 * MF) + wr * (16 * MF) + (m) * 16 + fr)
#define EPI_COL0(bj) (u.col0 + (bj) * 128 + wc * 32 + 8 * fq)
__device__ __forceinline__ void rope8(f32x4& v0, f32x4& v1, const float* cs, const float* sn) {
    const f32x4 c = *(const f32x4*)cs, s = *(const f32x4*)sn;
    f32x4 a = v0, b = v1;
    v0.x = a.x * c.x - a.y * s.x; v0.y = a.y * c.x + a.x * s.x; v0.z = a.z * c.y - a.w * s.y; v0.w = a.w * c.y + a.z * s.y;
    v1.x = b.x * c.z - b.y * s.z; v1.y = b.y * c.z + b.x * s.z; v1.z = b.z * c.w - b.w * s.w; v1.w = b.w * c.w + b.z * s.w;
}
__device__ __forceinline__ u32x4 pack8(const f32x4 v0, const f32x4 v1) { u32x4 w; w.x = pk2(v0.x, v0.y); w.y = pk2(v0.z, v0.w); w.z = pk2(v1.x, v1.y); w.w = pk2(v1.z, v1.w); return w; }

template <int MF> struct EpiInProj {
    bf16* P; const float* rope; float* RSQ;
    __device__ __forceinline__ void operator()(const f32x4 (&acc)[2][2][MF][2], const pg8::Unit& u, int wr, int wc, int fr, int fq) const {
#pragma unroll
        for (int bj = 0; bj < 2; ++bj) {
            if (u.quad && bj) continue;
            const int c0 = EPI_COL0(bj);
            const bool secA = c0 < P_AV, secB = c0 >= P_KR && c0 < P_DV;
            const int which = (c0 >= P_CQ && c0 < P_CKV) ? 0 : ((c0 >= P_CKV && c0 < P_KR) ? 1 : -1);
            const int p0 = secA ? ((c0 & 63) >> 1) : ((c0 & 31) >> 1);
            const float qs = c0 < P_AK ? QS_A : ((c0 >= P_DQ && c0 < P_DK) ? QS_C : 1.f);
#pragma unroll
            for (int ai = 0; ai < 2; ++ai)
#pragma unroll
                for (int m = 0; m < MF; ++m) {
                    if (u.quad && ai) continue;
                    const int row = EPI_ROWS(ai, m);
                    f32x4 v0 = acc[ai][bj][m][0] * qs, v1 = acc[ai][bj][m][1] * qs;
                    if (row < RL && (secA || secB)) { const int t = row & (T - 1);
                        const float* cs = secA ? rope + t * 32 + p0 : rope + T * 64 + t * 16 + p0;
                        const float* sn = secA ? rope + T * 32 + t * 32 + p0 : rope + T * 64 + T * 16 + t * 16 + p0;
                        rope8(v0, v1, cs, sn); }
                    if (which >= 0) { float s = (v0.x * v0.x + v0.y * v0.y) + (v0.z * v0.z + v0.w * v0.w) + (v1.x * v1.x + v1.y * v1.y) + (v1.z * v1.z + v1.w * v1.w);
                        { const int ln_ = fq * 16 + fr; s += shx(s, 16, ln_); s += shx(s, 32, ln_); }
                        if (fq == 0) RSQ[(size_t)row * 12 + ((c0 - P_CQ) >> 5)] = s; }
                    *(u32x4*)(P + (size_t)row * LDP + c0) = pack8(v0, v1);
                }
        }
    }
};
template <int MF> struct EpiUp {
    bf16* QKVM; const float* rope; const float* RSQ;
    __device__ __forceinline__ void operator()(const f32x4 (&acc)[2][2][MF][2], const pg8::Unit& u, int wr, int wc, int fr, int fq) const {
        const bool isq = u.col0 < 512;
        const float inv = isq ? (1.f / 256.f) : (1.f / 128.f);
        const int cw = u.col0 + wc * 32 + 8 * fq;
        int j0 = cw; j0 -= j0 >= 192 ? 192 : 0; j0 -= j0 >= 96 ? 96 : 0;
        int j1 = j0 + 32; j1 -= j1 >= 96 ? 96 : 0;
        const bool rot0 = isq && cw < 384 && j0 >= 64, rot1 = isq && cw + 128 < 384 && j1 >= 64;
        const float* tb = rope + T * 64;
#pragma unroll
        for (int ai = 0; ai < 2; ++ai)
#pragma unroll
            for (int m = 0; m < MF; ++m) {
                if (u.quad && ai) continue;
                const int row = EPI_ROWS(ai, m);
                const float* rq = RSQ + (size_t)row * 12; float sq;
                if (isq) { const f32x4 pa_ = *(const f32x4*)rq, pb_ = *(const f32x4*)(rq + 4); sq = ((pa_.x + pa_.y) + (pa_.z + pa_.w)) + ((pb_.x + pb_.y) + (pb_.z + pb_.w)); }
                else { const f32x4 pc_ = *(const f32x4*)(rq + 8); sq = (pc_.x + pc_.y) + (pc_.z + pc_.w); }
                const float rs = __builtin_amdgcn_rsqf(sq * inv + EPS) * (isq ? QS_B : 1.f);
                const int t = row & (T - 1);
                bf16* dst = QKVM + (size_t)row * LDM + cw;
                { f32x4 v0 = acc[ai][0][m][0] * rs, v1 = acc[ai][0][m][1] * rs;
                  if (rot0 && row < RL) rope8(v0, v1, tb + t * 16 + ((j0 - 64) >> 1), tb + T * 16 + t * 16 + ((j0 - 64) >> 1));
                  *(u32x4*)dst = pack8(v0, v1); }
                if (!u.quad) { f32x4 v0 = acc[ai][1][m][0] * rs, v1 = acc[ai][1][m][1] * rs;
                  if (rot1 && row < RL) rope8(v0, v1, tb + t * 16 + ((j1 - 64) >> 1), tb + T * 16 + t * 16 + ((j1 - 64) >> 1));
                  *(u32x4*)(dst + 128) = pack8(v0, v1); }
            }
    }
};
template <int MF> struct EpiOut {
    float* X; const float* MODl; float keep; const float* xlat; const float* xctx; int first;
    __device__ __forceinline__ void operator()(const f32x4 (&acc)[2][2][MF][2], const pg8::Unit& u, int wr, int wc, int fr, int fq) const {
        const float* xsrc = first ? (u.orow0 < RL ? xlat : xctx - (size_t)RL * D) : X;
#pragma unroll
        for (int ai = 0; ai < 2; ++ai)
#pragma unroll
            for (int m = 0; m < MF; ++m) {
                if (u.quad && ai) continue;
                const int row_ = EPI_ROWS(ai, m); const int mb = row_ < RL ? row_ >> 11 : 8;
                const float* g1 = MODl + (size_t)mb * 6144 + 2048;
#pragma unroll
                for (int bj = 0; bj < 2; ++bj) {
                    if (u.quad && bj) continue;
                    const int c0 = EPI_COL0(bj);
                    const f32x4 ga = *(const f32x4*)(g1 + c0) * keep, gb = *(const f32x4*)(g1 + c0 + 4) * keep;
                    float* xp = X + (size_t)row_ * D + c0; const float* xs = xsrc + (size_t)row_ * D + c0;
                    f32x4 xa = *(const f32x4*)xs, xb = *(const f32x4*)(xs + 4);
                    xa += ga * acc[ai][bj][m][0]; xb += gb * acc[ai][bj][m][1];
                    *(f32x4*)xp = xa; *(f32x4*)(xp + 4) = xb;
                }
            }
    }
};
template <int MF> struct EpiGU {
    bf16* HID;
    __device__ __forceinline__ void operator()(const f32x4 (&acc)[2][2][MF][2], const pg8::Unit& u, int wr, int wc, int fr, int fq) const {
#pragma unroll
        for (int bj = 0; bj < 2; ++bj) {
            if (u.quad && bj) continue;
            const int hc = EPI_COL0(bj) >> 1;
#pragma unroll
            for (int ai = 0; ai < 2; ++ai)
#pragma unroll
                for (int m = 0; m < MF; ++m) {
                    if (u.quad && ai) continue;
                    const f32x4 g = acc[ai][bj][m][0], up = acc[ai][bj][m][1];
                    u32x2 w; w.x = pk2(siluf(g.x) * up.x, siluf(g.y) * up.y); w.y = pk2(siluf(g.z) * up.z, siluf(g.w) * up.w);
                    *(u32x2*)(HID + (size_t)EPI_ROWS(ai, m) * DE + hc) = w;
                }
        }
    }
};
template <int MF> struct EpiDown {
    bf16* Y; const float* SGATE;
    __device__ __forceinline__ void operator()(const f32x4 (&acc)[2][2][MF][2], const pg8::Unit& u, int wr, int wc, int fr, int fq) const {
#pragma unroll
        for (int ai = 0; ai < 2; ++ai)
#pragma unroll
            for (int m = 0; m < MF; ++m) {
                if (u.quad && ai) continue;
                const int row = EPI_ROWS(ai, m); const float gt = SGATE[row];
#pragma unroll
                for (int bj = 0; bj < 2; ++bj)
                    if (!(u.quad && bj)) *(u32x4*)(Y + (size_t)row * D + EPI_COL0(bj)) = pack8(acc[ai][bj][m][0] * gt, acc[ai][bj][m][1] * gt);
            }
    }
};

constexpr int NWAVES = 8;
constexpr int RING_BYTES = 131072;
constexpr int LDSCTL_OFF = RING_BYTES, MISC_OFF = LDSCTL_OFF + 320;
constexpr int LDS_BYTES = 147456;
constexpr int CW_BAR = 4096;
typedef GAS unsigned gu32;

#define XB_TMO      128
#define XB_XCNT(j)  (256  + 64 * (j))
#define XB_XSUB(j)  (1280 + 64 * (j))
#define XB_XGEN(j)  (2304 + 64 * (j))
#define XB_TOP      3328
#define XB_TOPGEN   3392
#define XCD_BAR_WORDS 3456
#define XB_SPIN_CAP (1u << 18)
__device__ __forceinline__ unsigned xb_ld(unsigned* p)              { return __hip_atomic_load(p, __ATOMIC_RELAXED, __HIP_MEMORY_SCOPE_AGENT); }
__device__ __forceinline__ unsigned xb_add(unsigned* p, unsigned v) { return __hip_atomic_fetch_add(p, v, __ATOMIC_RELAXED, __HIP_MEMORY_SCOPE_AGENT); }
__device__ __forceinline__ unsigned xb_xcc_id() { return (unsigned)__builtin_amdgcn_s_getreg((3 << 11) | 20) & 0xFu; }
#define XB_SPIN(cond, bar) do { unsigned _sp = 0; while (cond) { __builtin_amdgcn_s_sleep(1); \
    if ((++_sp & 255u) == 0u) { if (xb_ld(&(bar)[XB_TMO])) break; if (_sp > XB_SPIN_CAP) { atomicAdd(&(bar)[XB_TMO], 1u); break; } } } } while (0)
struct XcdBarrier { unsigned* bar; unsigned x; volatile LAS unsigned* st; };
__device__ __forceinline__ XcdBarrier xcd_barrier_post(unsigned* bar, volatile LAS unsigned* st) {
    XcdBarrier b; b.bar = bar; b.x = xb_xcc_id(); b.st = st;
    if (threadIdx.x == 0) (void)xb_add(&bar[XB_XCNT(b.x)], 1u);
    return b;
}
__device__ __forceinline__ void xcd_barrier_complete(unsigned* bar, unsigned x, unsigned& nloc, unsigned& nx) {
    const unsigned G = gridDim.x * gridDim.y * gridDim.z;
    unsigned sum, cnt, mine, sp = 0u;
    for (;;) {
        sum = 0u; cnt = 0u; mine = 0u;
#pragma unroll
        for (unsigned j = 0; j < 16; ++j) { const unsigned c = xb_ld(&bar[XB_XCNT(j)]); sum += c; cnt += (c > 0u) ? 1u : 0u; mine = (j == x) ? c : mine; }
        if (sum == G) break;
        __builtin_amdgcn_s_sleep(1);
        if ((++sp & 255u) == 0u) { if (xb_ld(&bar[XB_TMO])) break; if (sp > XB_SPIN_CAP) { atomicAdd(&bar[XB_TMO], 1u); break; } }
    }
    nloc = mine > 0u ? mine : 1u; nx = cnt > 0u ? cnt : 1u;
}
__device__ __forceinline__ void xcd_barrier(const XcdBarrier& b, const int tid) {
    asm volatile("s_waitcnt vmcnt(0)" ::: "memory");
    __syncthreads();
    if (tid == 0) {
        unsigned* bar = b.bar;
        __builtin_amdgcn_s_waitcnt(0);
        unsigned nloc = b.st[0], nx = b.st[1];
        if (nloc == 0u) { xcd_barrier_complete(bar, b.x, nloc, nx); b.st[0] = nloc; b.st[1] = nx; }
        const unsigned old = xb_add(&bar[XB_XSUB(b.x)], 1u);
        const unsigned gen = old / nloc;
        if (old + 1u == (gen + 1u) * nloc) {
            __builtin_amdgcn_fence(__ATOMIC_RELEASE, "agent");
            asm volatile("s_waitcnt vmcnt(0)" ::: "memory");
            const unsigned og = xb_add(&bar[XB_TOP], 1u);
            const unsigned tg = og / nx;
            if (og + 1u == (tg + 1u) * nx) xb_add(&bar[XB_TOPGEN], 1u);
            else XB_SPIN(xb_ld(&bar[XB_TOPGEN]) == tg, bar);
            __builtin_amdgcn_fence(__ATOMIC_ACQUIRE, "agent");
            xb_add(&bar[XB_XGEN(b.x)], 1u);
            asm volatile("s_waitcnt vmcnt(0)" ::: "memory");
        } else {
            XB_SPIN(xb_ld(&bar[XB_XGEN(b.x)]) == gen, bar);
            __builtin_amdgcn_fence(__ATOMIC_ACQUIRE, "agent");
            asm volatile("s_waitcnt vmcnt(0)" ::: "memory");
        }
    }
    __syncthreads();
}

struct Frame { LAS unsigned char* lds; int tid, lane, wave, bid, G; const float* const* in; GAS float* out; GAS unsigned char* ws; };
#define IN_(k) ((const float*)(const GAS float*)F.in[(k)])
#define F_x IN_(0)
#define F_c IN_(1)
#define F_ctx IN_(2)
#define F_c_ctx IN_(3)
#define F_norm1 IN_(4)
#define F_norm2 IN_(5)
#define F_w_ada IN_(6)
#define F_b_ada IN_(7)
#define F_w_in IN_(8)
#define F_sink IN_(9)
#define F_mla_q_norm IN_(10)
#define F_w_uq IN_(11)
#define F_mla_kv_norm IN_(12)
#define F_w_ukv IN_(13)
#define F_lq1 IN_(14)
#define F_lk1 IN_(15)
#define F_lq2 IN_(16)
#define F_lk2 IN_(17)
#define F_diff_norm IN_(18)
#define F_w_out IN_(19)
#define F_w_router IN_(20)
#define F_w_gate IN_(21)
#define F_w_up IN_(22)
#define F_w_down IN_(23)
#define F_final_norm IN_(24)
#define F_MOD ((float*)(GAS float*)(F.ws + WS_MOD))
#define F_ROPE ((float*)(GAS float*)(F.ws + WS_ROPE))
#define F_RSQ ((float*)(GAS float*)(F.ws + WS_RSQ))
#define F_AFF ((float*)(GAS float*)(F.ws + WS_AFF))
#define F_INV ((int*)(GAS int*)(F.ws + WS_INV))
#define F_STOK ((int*)(GAS int*)(F.ws + WS_STOK))
#define F_SGATE ((float*)(GAS float*)(F.ws + WS_SGATE))
#define F_X ((float*)(GAS float*)(F.ws + WS_X))
#define F_ACT ((bf16*)(GAS bf16*)(F.ws + WS_ACT))
#define F_P ((bf16*)(GAS bf16*)(F.ws + WS_P))
#define F_Y ((bf16*)(GAS bf16*)(F.ws + WS_Y))
#define F_QKVM ((bf16*)(GAS bf16*)(F.ws + WS_QKVM))
#define F_O ((bf16*)(GAS bf16*)(F.ws + WS_O))
#define F_HID ((bf16*)(GAS bf16*)(F.ws + WS_HID))
#define F_WB ((bf16*)(GAS bf16*)(F.ws + WS_W))

__device__ __forceinline__ int rot64(int dp) { const int p = dp >> 1, half = dp & 1, axis = p >> 4, f = p & 15; return axis * 32 + half * 16 + f; }
__device__ __forceinline__ int rot32(int dp) { const int p = dp >> 1, half = dp & 1, axis = p >> 3, f = p & 7; return axis * 16 + half * 8 + f; }
__device__ __forceinline__ int src_col_in(int n) {
    if (n >= INW) return -1;
    if (n < P_AV) return (n & ~63) + rot64(n & 63);
    if (n >= P_KR && n < P_DV) return (n & ~31) + rot32(n & 31);
    return n;
}
__device__ __forceinline__ void prep_tile(const float* src, int N, int k0, const float* kscale, bf16* dst, int ldd, LAS float* scr, int lane) {
    float v[32];
#pragma unroll
    for (int i = 0; i < 32; ++i) { const int kk = 2 * i + (lane >> 5); v[i] = src ? src[(size_t)(k0 + kk) * N] : 0.f; }
    if (kscale) {
#pragma unroll
        for (int i = 0; i < 32; ++i) v[i] *= kscale[k0 + 2 * i + (lane >> 5)]; }
#pragma unroll
    for (int i = 0; i < 32; ++i) scr[(2 * i + (lane >> 5)) * 33 + (lane & 31)] = v[i];
    LDS_WAIT();
    const int c = lane & 7;
#pragma unroll
    for (int j = 0; j < 4; ++j) { const int n = (lane >> 3) + 8 * j; const LAS float* s = scr + (8 * c) * 33 + n;
        u32x4 o; o.x = pk2(s[0], s[33]); o.y = pk2(s[66], s[99]); o.z = pk2(s[132], s[165]); o.w = pk2(s[198], s[231]);
        *(u32x4*)(dst + (size_t)n * ldd + 8 * c) = o; }
    LDS_WAIT();
}
constexpr int PI_IN = 16 * 64, PI_UP = 6 * 32, PI_OUT = 16 * 32, PI_GU = NE * 16 * 32, PI_DN = NE * 8 * 32, PI_LAYER = PI_IN + PI_UP + PI_OUT + PI_GU + PI_DN;
#ifndef BG_PREP
#define BG_PREP 0
#endif
__device__ __forceinline__ void prep_layer(Frame& F, const int l, const int worker, const int nworkers) {
    const int lane = F.lane, wave = F.wave;
    LAS float* scr = (LAS float*)(F.lds + 57344 + wave * 8448);
    for (int it = worker; it < PI_LAYER; it += nworkers) {
        int r = it; bf16* wl = F_WB + (size_t)l * W_LAYER;
        const int nl = lane & 31;
        if (r < PI_IN) { const int kb = r / 64, nb = r % 64, n = nb * 32 + nl, sc = src_col_in(n);
            prep_tile(sc >= 0 ? F_w_in + (size_t)l * D * INW + sc : nullptr, INW, kb * 64, nullptr, wl + W_IN + (size_t)(nb * 32) * D + kb * 64, D, scr, lane); continue; } r -= PI_IN;
        if (r < PI_UP) { const int kb = r / 32, nb = r % 32, n = nb * 32 + nl, k0 = kb * 64; const float* src = nullptr; const float* ks = nullptr; int N = 384, ksrc = k0;
            if (n < 384 && k0 < 256) { const int h = n / 96, j = n % 96; const int sc = j < 64 ? n : h * 96 + 64 + rot32(j - 64); src = F_w_uq + (size_t)l * 256 * 384 + sc; ks = F_mla_q_norm + l * 256; N = 384; }
            else if (n >= 512 && k0 >= 256) { src = F_w_ukv + (size_t)l * 128 * 512 + (n - 512); ks = F_mla_kv_norm + l * 128; N = 512; ksrc = k0 - 256; }
            { float v[32];
#pragma unroll
              for (int i = 0; i < 32; ++i) { const int kk = 2 * i + (lane >> 5); v[i] = src ? src[(size_t)(ksrc + kk) * N] * ks[ksrc + kk] : 0.f; }
#pragma unroll
              for (int i = 0; i < 32; ++i) scr[(2 * i + (lane >> 5)) * 33 + (lane & 31)] = v[i];
              LDS_WAIT();
              const int c = lane & 7; bf16* dst = wl + W_UP + (size_t)(nb * 32) * UPK + k0;
#pragma unroll
              for (int j = 0; j < 4; ++j) { const int nn = (lane >> 3) + 8 * j; const LAS float* s = scr + (8 * c) * 33 + nn;
                  u32x4 o; o.x = pk2(s[0], s[33]); o.y = pk2(s[66], s[99]); o.z = pk2(s[132], s[165]); o.w = pk2(s[198], s[231]);
                  *(u32x4*)(dst + (size_t)nn * UPK + 8 * c) = o; }
              LDS_WAIT(); }
            continue; } r -= PI_UP;
        if (r < PI_OUT) { const int kb = r / 32, nb = r % 32;
            prep_tile(F_w_out + (size_t)l * D * D + nb * 32 + nl, D, kb * 64, nullptr, wl + W_OUT + (size_t)(nb * 32) * D + kb * 64, D, scr, lane); continue; } r -= PI_OUT;
        if (r < PI_GU) { const int e = r / 512, q = r % 512, kb = q / 32, nb = q % 32, n = nb * 32 + nl, f = (n >> 3) * 4 + (n & 3);
            const float* src = ((n & 4) ? F_w_up : F_w_gate) + ((size_t)l * NE + e) * D * DE + f;
            prep_tile(src, DE, kb * 64, nullptr, wl + W_GU + (size_t)e * 1024 * 1024 + (size_t)(nb * 32) * D + kb * 64, D, scr, lane); continue; } r -= PI_GU;
        { const int e = r / 256, q = r % 256, kb = q / 32, nb = q % 32;
            prep_tile(F_w_down + ((size_t)l * NE + e) * DE * D + nb * 32 + nl, D, kb * 64, nullptr, wl + W_DN + (size_t)e * 1024 * 512 + (size_t)(nb * 32) * DE + kb * 64, DE, scr, lane); }
    }
}

__device__ __forceinline__ void p0_phase(Frame& F) {
    const int tid = F.tid, lane = F.lane, wave = F.wave;
    {
        LAS float* sl = (LAS float*)F.lds;
        LAS float* red = (LAS float*)(F.lds + 36864);
        for (int i = tid; i < 9 * 1024; i += 512) { const float v = i < 8 * 1024 ? F_c[i] : F_c_ctx[i - 8 * 1024]; sl[i] = siluf(v); }
        __syncthreads();
        for (int it = F.bid; it < DEPTH * 96; it += F.G) {
            const int l = it / 96, cg = it % 96, col = cg * 64 + lane;
            float acc[9];
#pragma unroll
            for (int r = 0; r < 9; ++r) acc[r] = 0.f;
            const float* w = F_w_ada + (size_t)l * D * 6144 + (size_t)(wave * 128) * 6144 + col;
#pragma unroll 16
            for (int k = 0; k < 128; ++k) { const float wv = w[(size_t)k * 6144];
#pragma unroll
                for (int r = 0; r < 9; ++r) acc[r] += sl[r * 1024 + wave * 128 + k] * wv; }
#pragma unroll
            for (int r = 0; r < 9; ++r) red[(wave * 9 + r) * 64 + lane] = acc[r];
            __syncthreads();
            for (int o = tid; o < 576; o += 512) { const int r = o >> 6, cc = o & 63; float s = 0.f;
#pragma unroll
                for (int w8 = 0; w8 < 8; ++w8) s += red[(w8 * 9 + r) * 64 + cc];
                F_MOD[((size_t)l * 9 + r) * 6144 + cg * 64 + cc] = s + F_b_ada[l * 6144 + cg * 64 + cc]; }
            __syncthreads();
        }
    }
    const int gw = F.bid * NWAVES + wave, NGW = F.G * NWAVES;
    { const size_t n4 = (size_t)R * D / 4, nl4 = (size_t)RL * D / 4;
      for (size_t i = (size_t)F.bid * 512 + tid; i < n4; i += (size_t)F.G * 512) { const f32x4 v = i < nl4 ? ((const f32x4*)F_x)[i] : ((const f32x4*)F_ctx)[i - nl4]; ((f32x4*)F_X)[i] = v; } }
    for (int i = F.bid * 512 + tid; i < T * 48; i += F.G * 512) {
        const int t = i / 48, j = i % 48; int axis, f, nf;
        if (j < 32) { axis = j >> 4; f = j & 15; nf = 16; } else { axis = (j - 32) >> 3; f = (j - 32) & 7; nf = 8; }
        const float inv = exp2f(-(float)f / (float)nf * 13.287712379549449f);
        const float ang = (float)(axis == 0 ? (t >> 6) : (t & 63)) * inv;
        const float cv = cosf(ang), sv = sinf(ang);
        if (j < 32) { F_ROPE[t * 32 + j] = cv; F_ROPE[T * 32 + t * 32 + j] = sv; } else { F_ROPE[T * 64 + t * 16 + j - 32] = cv; F_ROPE[T * 64 + T * 16 + t * 16 + j - 32] = sv; }
    }
    for (int l = 0; l < (BG_PREP ? 1 : DEPTH); ++l) prep_layer(F, l, gw, NGW);
}

#ifndef PROBE_NOROUTER
#define PROBE_NOROUTER 0
#endif
#define half_swap_add(keepv, sendv, off) ((keepv) + shx((sendv), (off), lane))
__device__ __forceinline__ void norm_phase(Frame& F, int l, int mode, int nrows, const float keep) {
    const int lane = F.lane, gw = F.bid * NWAVES + F.wave, NGW = F.G * NWAVES;
    LAS float* wrT = (LAS float*)F.lds;
    if (mode == 1) {
        const float* wr = F_w_router + (size_t)l * D * NE;
        for (int i = F.tid; i < D * NE; i += 512) wrT[(i & 15) * 1028 + (i >> 4)] = wr[i];
        __syncthreads();
    }
    const float* gain = mode == 0 ? F_norm1 + (size_t)l * D : (mode == 1 ? F_norm2 + (size_t)l * D : F_final_norm);
    const bool comb = mode != 1 && l > 0;
    f32x4 vn[2][4];
#define NORM_LOAD(dst, rr0) do { _Pragma("unroll") for (int q = 0; q < 2; ++q) _Pragma("unroll") for (int j = 0; j < 4; ++j) dst[q][j] = ((const f32x4*)(F_X + (size_t)((rr0) + q) * D))[lane + 64 * j]; } while (0)
    if (gw * 2 < nrows) NORM_LOAD(vn, gw * 2);
    for (int r0 = gw * 2; r0 < nrows; r0 += NGW * 2) {
        const int mb = r0 < RL ? r0 / T : 8;
        f32x4 v[2][4];
#pragma unroll
        for (int q = 0; q < 2; ++q)
#pragma unroll
            for (int j = 0; j < 4; ++j) v[q][j] = vn[q][j];
        if (r0 + NGW * 2 < nrows) NORM_LOAD(vn, r0 + NGW * 2);
        if (comb) {
            const float* g2 = F_MOD + ((size_t)(l - 1) * 9 + mb) * 6144 + 5120;
            const int myinv = lane < 2 * NE ? F_INV[(size_t)r0 * NE + lane] : -1;
            f32x4 s[2][4];
#pragma unroll
            for (int q = 0; q < 2; ++q)
#pragma unroll
                for (int j = 0; j < 4; ++j) s[q][j] = (f32x4){0.f, 0.f, 0.f, 0.f};
            for (int e = 0; e < NE; ++e) {
#pragma unroll
                for (int q = 0; q < 2; ++q) { const int sl = shi(myinv, q * NE + e);
                    if (sl >= 0) { const bf16* yr = F_Y + (size_t)sl * D;
#pragma unroll
                        for (int j = 0; j < 4; ++j) { const u32x2 w = ((const u32x2*)yr)[lane + 64 * j];
                            s[q][j].x += bf2f(w.x & 0xffff); s[q][j].y += bf2f(w.x >> 16); s[q][j].z += bf2f(w.y & 0xffff); s[q][j].w += bf2f(w.y >> 16); } } } }
#pragma unroll
            for (int j = 0; j < 4; ++j) { const f32x4 g = ((const f32x4*)g2)[lane + 64 * j];
#pragma unroll
                for (int q = 0; q < 2; ++q) { v[q][j] += g * s[q][j] * keep; ((f32x4*)(F_X + (size_t)(r0 + q) * D))[lane + 64 * j] = v[q][j]; } }
        }
        float ss0 = 0.f, ss1 = 0.f;
#pragma unroll
        for (int j = 0; j < 4; ++j) { ss0 += (v[0][j].x * v[0][j].x + v[0][j].y * v[0][j].y) + (v[0][j].z * v[0][j].z + v[0][j].w * v[0][j].w);
                                      ss1 += (v[1][j].x * v[1][j].x + v[1][j].y * v[1][j].y) + (v[1][j].z * v[1][j].z + v[1][j].w * v[1][j].w); }
#pragma unroll
        for (int o = 1; o < 64; o <<= 1) { ss0 += shx(ss0, o, lane); ss1 += shx(ss1, o, lane); }
        const float rs[2] = {1.0f / sqrtf(ss0 * (1.f / D) + EPS), 1.0f / sqrtf(ss1 * (1.f / D) + EPS)};
        if (mode == 2) {
#pragma unroll
            for (int j = 0; j < 4; ++j) { const f32x4 g = ((const f32x4*)gain)[lane + 64 * j];
#pragma unroll
                for (int q = 0; q < 2; ++q) ((f32x4*)((float*)F.out + (size_t)(r0 + q) * D))[lane + 64 * j] = v[q][j] * rs[q] * g; }
        } else {
            const float* md = F_MOD + ((size_t)l * 9 + mb) * 6144 + (mode == 0 ? 0 : 3072);
#pragma unroll
            for (int j = 0; j < 4; ++j) { const f32x4 g = ((const f32x4*)gain)[lane + 64 * j];
                const f32x4 sh = ((const f32x4*)md)[lane + 64 * j], sc = ((const f32x4*)(md + 1024))[lane + 64 * j];
#pragma unroll
                for (int q = 0; q < 2; ++q) { v[q][j] = v[q][j] * rs[q] * g * (sc + 1.0f) + sh;
                    u32x2 w; w.x = pk2(v[q][j].x, v[q][j].y); w.y = pk2(v[q][j].z, v[q][j].w);
                    ((u32x2*)(F_ACT + (size_t)(r0 + q) * D))[lane + 64 * j] = w; } }
            if (mode == 1 && !(PROBE_NOROUTER && keep == 0.f)) {
                float a[2][NE];
#pragma unroll
                for (int e = 0; e < NE; ++e) { float a0 = 0.f, a1 = 0.f;
#pragma unroll
                    for (int j = 0; j < 4; ++j) { const f32x4 w = *(const LAS f32x4*)(wrT + e * 1028 + 256 * j + 4 * lane);
                        a0 += (v[0][j].x * w.x + v[0][j].y * w.y) + (v[0][j].z * w.z + v[0][j].w * w.w); a1 += (v[1][j].x * w.x + v[1][j].y * w.y) + (v[1][j].z * w.z + v[1][j].w * w.w); }
                    a[0][e] = a0; a[1][e] = a1; if ((e & 1) == 1) __builtin_amdgcn_sched_barrier(0); }
                float b16[NE];
#pragma unroll
                for (int e = 0; e < NE; ++e) { const bool up = lane >= 32; b16[e] = half_swap_add(up ? a[1][e] : a[0][e], up ? a[0][e] : a[1][e], 32); }
                float b8[8];
#pragma unroll
                for (int e = 0; e < 8; ++e) { const bool up = (lane & 16) != 0; b8[e] = half_swap_add(up ? b16[8 + e] : b16[e], up ? b16[e] : b16[8 + e], 16); }
                float b4[4];
#pragma unroll
                for (int e = 0; e < 4; ++e) { const bool up = (lane & 8) != 0; b4[e] = half_swap_add(up ? b8[4 + e] : b8[e], up ? b8[e] : b8[4 + e], 8); }
                float b2[2];
#pragma unroll
                for (int e = 0; e < 2; ++e) { const bool up = (lane & 4) != 0; b2[e] = half_swap_add(up ? b4[2 + e] : b4[e], up ? b4[e] : b4[2 + e], 4); }
                float lg; { const bool up = (lane & 2) != 0; lg = half_swap_add(up ? b2[1] : b2[0], up ? b2[0] : b2[1], 2); }
                lg += shx(lg, 1, lane);
                float mx = lg;
#pragma unroll
                for (int o = 2; o < 32; o <<= 1) mx = fmaxf(mx, shx(mx, o, lane));
                const float ex = __expf(lg - mx); float sum = ex;
#pragma unroll
                for (int o = 2; o < 32; o <<= 1) sum += shx(sum, o, lane);
                const int eidx = ((lane >> 4) & 1) * 8 + ((lane >> 3) & 1) * 4 + ((lane >> 2) & 1) * 2 + ((lane >> 1) & 1);
                if ((lane & 1) == 0) F_AFF[(size_t)(r0 + (lane >> 5)) * NE + eidx] = ex / sum;
            }
        }
    }
}

#undef NORM_LOAD
__device__ __forceinline__ void topk_phase(Frame& F, int nsets) {
    LAS unsigned* cnt = (LAS unsigned*)F.lds;
    const int tid = F.tid, lane = F.lane, wave = F.wave;
    for (int it = F.bid; it < nsets * NE; it += F.G) {
        const int set = it / NE, e = it % NE; const bool lat = set < 8; const int b = lat ? set : set - 8;
        const int n = lat ? T : LC, cap = lat ? CAPL : CAPC, row0 = lat ? b * T : RL + b * LC, slot0 = e * SLOTS_E + (lat ? b * CAPL : NB * CAPL + b * CAPC);
        unsigned v[4];
#pragma unroll
        for (int q = 0; q < 4; ++q) { const int idx = 4 * tid + q; v[q] = idx < n ? __builtin_bit_cast(unsigned, F_AFF[(size_t)(row0 + idx) * NE + e]) : 0u; }
        unsigned prefix = 0u; int par = 0;
        for (int bit = 30; bit >= 0; --bit) {
            const unsigned cand = prefix | (1u << bit);
            unsigned c = 0;
#pragma unroll
            for (int q = 0; q < 4; ++q) c += (unsigned)__popcll(__ballot(v[q] >= cand));
            if (lane == 0) cnt[par * 8 + wave] = c;
            __syncthreads();
            unsigned tot = 0;
#pragma unroll
            for (int w = 0; w < 8; ++w) tot += cnt[par * 8 + w];
            if (tot >= (unsigned)cap) prefix = cand;
            par ^= 1;
        }
        unsigned g4 = 0, e4 = 0;
#pragma unroll
        for (int q = 0; q < 4; ++q) { g4 += v[q] > prefix ? 1u : 0u; e4 += v[q] == prefix ? 1u : 0u; }
        unsigned pk = g4 | (e4 << 16), inc = pk;
#pragma unroll
        for (int o = 1; o < 64; o <<= 1) { const unsigned t = (unsigned)shi((int)inc, lane - o); if (lane >= o) inc += t; }
        __syncthreads();
        if (lane == 63) cnt[16 + wave] = inc;
        __syncthreads();
        unsigned base = 0, total = 0;
#pragma unroll
        for (int w = 0; w < 8; ++w) { const unsigned t = cnt[16 + w]; total += t; if (w < wave) base += t; }
        const unsigned excl = base + inc - pk;
        unsigned gpre = excl & 0xffffu, epre = excl >> 16; const unsigned need = (unsigned)cap - (total & 0xffffu);
#pragma unroll
        for (int q = 0; q < 4; ++q) { const int idx = 4 * tid + q;
            if (idx < n) { const bool isg = v[q] > prefix, ise = v[q] == prefix; const bool sel = isg || (ise && epre < need);
                const int slot = slot0 + (int)(gpre + (epre < need ? epre : need));
                if (sel) { F_STOK[slot] = row0 + idx; F_SGATE[slot] = __builtin_bit_cast(float, v[q]); }
                F_INV[(size_t)(row0 + idx) * NE + e] = sel ? slot : -1;
                gpre += isg ? 1u : 0u; epre += ise ? 1u : 0u; } }
        __syncthreads();
    }
}

#ifndef ATT_EXTRA
#define ATT_EXTRA 0
#define ATT_EXTRA_TYPE 0
#endif
#ifndef ATT_XVAR
#define ATT_XVAR 0
#endif
#ifndef ATT_XSTEPS
#define ATT_XSTEPS 4
#endif
namespace att {
typedef short s16x4 __attribute__((ext_vector_type(4)));
typedef float f32x2_t __attribute__((ext_vector_type(2)));
typedef __bf16 bf16x2_t __attribute__((ext_vector_type(2)));
constexpr int L_K = 0, KBUF = 16384, L_V = 2 * KBUF, VBUF = 8192, L_WS = L_V + 2 * VBUF, L_OST = L_WS + 8 * 256, L_END = L_OST + 8 * 4096;
#define ATT_SBAR() __builtin_amdgcn_sched_barrier(0)
#define ATT_SGB(mask, n) __builtin_amdgcn_sched_group_barrier(mask, n, 0)
__device__ __forceinline__ int crow(int r, int hi) { return (r & 3) + 8 * (r >> 2) + 4 * hi; }
__device__ __forceinline__ unsigned cvtpk(float lo, float hi) { f32x2_t v = {lo, hi}; bf16x2_t b = __builtin_convertvector(v, bf16x2_t); return __builtin_bit_cast(unsigned, b); }
__device__ __forceinline__ int v_st(int k, int c) { const int kk = k; return ((kk >> 3) * 2 + (c >> 5)) * 512 + ((kk & 7) * 32 + (c & 31)) * 2; }
__device__ __forceinline__ int v_rd_base(int lane) { return ((lane & 3) << 3) | (((lane >> 2) & 3) << 6) | (((lane >> 4) & 1) << 5) | (((lane >> 5) & 1) << 8); }
typedef short v4i16_t __attribute__((ext_vector_type(4)));
template <int OFF> __device__ __forceinline__ s16x4 tr_read(int vb) { return __builtin_bit_cast(s16x4, __builtin_amdgcn_ds_read_tr16_b64_v4i16((LAS v4i16_t*)(uintptr_t)(vb + OFF))); }
template <int D0> __device__ __forceinline__ void pv_one(f32x16& od, int vb, bf16x8 pa0, bf16x8 pa1, bf16x8 pa2, bf16x8 pa3) {
#define ATT_PK(L, H) (bf16x8){L[0], L[1], L[2], L[3], H[0], H[1], H[2], H[3]}
    const s16x4 l0 = tr_read<D0 * 512 + 0 * 2048>(vb), h0 = tr_read<D0 * 512 + 0 * 2048 + 1024>(vb), l1 = tr_read<D0 * 512 + 1 * 2048>(vb), h1 = tr_read<D0 * 512 + 1 * 2048 + 1024>(vb);
    const s16x4 l2 = tr_read<D0 * 512 + 2 * 2048>(vb), h2 = tr_read<D0 * 512 + 2 * 2048 + 1024>(vb), l3 = tr_read<D0 * 512 + 3 * 2048>(vb), h3 = tr_read<D0 * 512 + 3 * 2048 + 1024>(vb);
    od = __builtin_amdgcn_mfma_f32_32x32x16_bf16(pa0, ATT_PK(l0, h0), od, 0, 0, 0);
    od = __builtin_amdgcn_mfma_f32_32x32x16_bf16(pa1, ATT_PK(l1, h1), od, 0, 0, 0);
    od = __builtin_amdgcn_mfma_f32_32x32x16_bf16(pa2, ATT_PK(l2, h2), od, 0, 0, 0);
    od = __builtin_amdgcn_mfma_f32_32x32x16_bf16(pa3, ATT_PK(l3, h3), od, 0, 0, 0);
#undef ATT_PK
}
struct Tensors { const bf16* P; const bf16* QKVM; bf16* O; const float* sink; const float* dnorm; float lam, lam_init; int l; };

constexpr float THR = 8.f;
__device__ __forceinline__ float rowmax32(const f32x16& p0, const f32x16& p1) {
    float a = fmaxf(fmaxf(p0[0], p0[1]), p1[0]), b = fmaxf(fmaxf(p0[2], p0[3]), p1[1]); a = fmaxf(fmaxf(a, p1[2]), p1[3]);
#pragma unroll
    for (int r = 4; r < 16; r += 4) { a = fmaxf(fmaxf(a, p0[r]), p0[r + 1]); b = fmaxf(fmaxf(b, p0[r + 2]), p0[r + 3]); a = fmaxf(fmaxf(a, p1[r]), p1[r + 1]); b = fmaxf(fmaxf(b, p1[r + 2]), p1[r + 3]); }
    float m = fmaxf(a, b);
    auto rr = __builtin_amdgcn_permlane32_swap(__float_as_uint(m), __float_as_uint(m), false, false);
    return fmaxf(__uint_as_float(rr[0]), __uint_as_float(rr[1]));
}
__device__ __forceinline__ void partialSM(f32x16& p0, f32x16& p1, const float rm, float& mhat, f32x16& negm, float& alpha) {
    alpha = 1.f;
    if (__builtin_expect(__any(rm > THR), 0)) {
        const float dl = fmaxf(rm, 0.f); mhat += dl;
#pragma unroll
        for (int r = 0; r < 16; ++r) { p0[r] -= dl; p1[r] -= dl; }
#pragma unroll
        for (int r = 0; r < 16; ++r) negm[r] = -mhat;
        asm volatile("" : "+v"(negm));
        alpha = __builtin_amdgcn_exp2f(-dl);
    }
}
__device__ __forceinline__ void finishSM(f32x16& p0, f32x16& p1, const float alpha, float& l_reg, bf16x8& pa0, bf16x8& pa1, bf16x8& pa2, bf16x8& pa3) {
#pragma unroll
    for (int r = 0; r < 16; ++r) { p0[r] = __builtin_amdgcn_exp2f(p0[r]); p1[r] = __builtin_amdgcn_exp2f(p1[r]); }
    float ps = 0.f, pt = 0.f;
#pragma unroll
    for (int r = 0; r < 16; ++r) { ps += p0[r]; pt += p1[r]; }
    l_reg = l_reg * alpha + (ps + pt);
#define ATT_PK8(P, BASE, OUT) do { u32x4 w = {cvtpk(P[BASE + 0], P[BASE + 1]), cvtpk(P[BASE + 2], P[BASE + 3]), cvtpk(P[BASE + 4], P[BASE + 5]), cvtpk(P[BASE + 6], P[BASE + 7])}; OUT = __builtin_bit_cast(bf16x8, w); } while (0)
    ATT_PK8(p0, 0, pa0); ATT_PK8(p0, 8, pa1); ATT_PK8(p1, 0, pa2); ATT_PK8(p1, 8, pa3);
#undef ATT_PK8
}
template <int ROWB> __device__ __forceinline__ int kswz(int row, int cb) { return row * ROWB + (ROWB == 128 ? (cb ^ (((row >> 1) & 7) << 4)) : (cb ^ ((row & 15) << 4))); }
template <int NB, int ROWB, int CB0, int D00> __device__ __forceinline__ void kread(bf16x8 (&kf)[2 * NB], const LAS unsigned char* Kb, int r32, int hi) {
#pragma unroll
    for (int d = 0; d < NB; ++d) { const int cb = CB0 + ((D00 + d) * 16 + hi * 8) * 2;
        kf[2 * d] = *(const LAS bf16x8*)(Kb + kswz<ROWB>(r32, cb)); kf[2 * d + 1] = *(const LAS bf16x8*)(Kb + kswz<ROWB>(32 + r32, cb)); }
}
template <int NB, int D00> __device__ __forceinline__ void kmma(f32x16& p0, f32x16& p1, const bf16x8 (&kf)[2 * NB], const bf16x8* qr, const f32x16& negm) {
#pragma unroll
    for (int d = 0; d < NB; ++d) {
        if (D00 + d == 0) { p0 = __builtin_amdgcn_mfma_f32_32x32x16_bf16(kf[0], qr[0], negm, 0, 0, 0); p1 = __builtin_amdgcn_mfma_f32_32x32x16_bf16(kf[1], qr[0], negm, 0, 0, 0); }
        else { p0 = __builtin_amdgcn_mfma_f32_32x32x16_bf16(kf[2 * d], qr[D00 + d], p0, 0, 0, 0); p1 = __builtin_amdgcn_mfma_f32_32x32x16_bf16(kf[2 * d + 1], qr[D00 + d], p1, 0, 0, 0); } }
}
template <int NKS, int ROWB, int CB0> __device__ __forceinline__ void qkt2(f32x16& p0, f32x16& p1, const LAS unsigned char* Kb, const bf16x8* qr, const f32x16& negm, int r32, int hi) {
    constexpr int N1 = NKS > 4 ? 3 : NKS, N2 = NKS - N1;
    bf16x8 ka[2 * N1]; kread<N1, ROWB, CB0, 0>(ka, Kb, r32, hi);
    if constexpr (N2 > 0) { bf16x8 kb[2 * N2]; kread<N2, ROWB, CB0, N1>(kb, Kb, r32, hi);
        kmma<N1, 0>(p0, p1, ka, qr, negm); kmma<N2, N1>(p0, p1, kb, qr, negm); }
    else kmma<N1, 0>(p0, p1, ka, qr, negm);
}

template <int TYPE> struct Ring { static constexpr int KSLOT = TYPE == 1 ? 16384 : 8192, VSLOT = 8192, L_K = 0, L_V = 3 * KSLOT, L_WS = L_V + 4 * VSLOT, L_OST = L_WS + 2048; };
template <int TYPE, int CB0> __device__ __forceinline__ void flash_pass(const Tensors& Tn, LAS unsigned char* lds, const int tid, const int b, const int h, const bool lat, const int q0, const int var, const bf16x8* qr,
                                                                        f32x16 (&o)[2], float& l_out, float& m_out) {
    constexpr int NKS = TYPE == 0 ? 4 : (TYPE == 1 ? 6 : 2);
    constexpr int ROWB = TYPE == 1 ? 256 : 128;
    typedef Ring<TYPE> RG;
    const int lane = tid & 63, wid = __builtin_amdgcn_readfirstlane(tid >> 6), r32 = lane & 31, hi = lane >> 5;
    LAS float* al_l = (LAS float*)(lds + RG::L_WS) + wid * 64;
    const int kvh = h >> 2;
    const bf16* Kp = TYPE == 0 ? Tn.P + P_AK + kvh * 64 : (TYPE == 1 ? Tn.QKVM + 512 + h * 128 : Tn.P + P_DK + h * 64);
    const bf16* Vp = TYPE == 0 ? Tn.P + P_AV + kvh * 64 : (TYPE == 1 ? Tn.QKVM + 512 + h * 128 + 64 : Tn.P + P_DV + h * 64);
    constexpr int KPITCH = TYPE == 1 ? LDM : LDP;
    int kl0 = 0, nloc = 0;
    if (lat) { if (TYPE == 0) { kl0 = q0 - 128 < 0 ? 0 : q0 - 128; const int kl1 = q0 + 256 + 128 > T ? T : q0 + 256 + 128; nloc = (kl1 - kl0) >> 6; } else { kl0 = 0; nloc = T / 64; } }
    const int NT = 4 + nloc;
    const int crow0 = RL + b * LC, lrow0 = b * T + kl0;
#define ATT_TROW(i) ((var & 64) ? crow0 : ((i) < 4 ? crow0 + 64 * (i) : lrow0 + 64 * ((i) - 4)))
    const bf16* ksrc0; const bf16* ksrc1 = nullptr;
    if (TYPE != 1) { const int row = 8 * wid + (lane >> 3), c = (lane & 7) ^ ((row >> 1) & 7); ksrc0 = Kp + (size_t)row * KPITCH + c * 8; }
    else {
        { const int row = 8 * wid + (lane >> 4), c = (lane & 15) ^ (row & 15); ksrc0 = c < 8 ? Kp + (size_t)row * LDM + c * 8 : (c < 12 ? Tn.P + (size_t)row * LDP + P_KR + (c - 8) * 8 : Kp + (size_t)row * LDM); }
        { const int row = 8 * wid + 4 + (lane >> 4), c = (lane & 15) ^ (row & 15); ksrc1 = c < 8 ? Kp + (size_t)row * LDM + c * 8 : (c < 12 ? Tn.P + (size_t)row * LDP + P_KR + (c - 8) * 8 : Kp + (size_t)row * LDM); }
    }
    const bool k0p = TYPE == 1 && (((lane & 15) ^ ((8 * wid + (lane >> 4)) & 15)) >= 8) && (((lane & 15) ^ ((8 * wid + (lane >> 4)) & 15)) < 12);
    const bool k1p = TYPE == 1 && (((lane & 15) ^ ((8 * wid + 4 + (lane >> 4)) & 15)) >= 8) && (((lane & 15) ^ ((8 * wid + 4 + (lane >> 4)) & 15)) < 12);
    const bf16* vsrc = Vp + (size_t)(8 * wid + ((lane & 31) >> 2)) * KPITCH + (lane >> 5) * 32 + (lane & 3) * 8;
#define ATT_DMA_K(i, slot) do { if (var & 8) break; const int g_ = ATT_TROW((i) < NT ? (i) : NT - 1); \
        __builtin_amdgcn_global_load_lds((const unsigned*)(ksrc0 + (size_t)g_ * (k0p ? LDP : KPITCH)), (LAS unsigned*)(lds + RG::L_K + (slot) * RG::KSLOT + wid * (ROWB * 8)), 16, 0, 0); \
        if (TYPE == 1) __builtin_amdgcn_global_load_lds((const unsigned*)(ksrc1 + (size_t)g_ * (k1p ? LDP : KPITCH)), (LAS unsigned*)(lds + RG::L_K + (slot) * RG::KSLOT + wid * (ROWB * 8) + 1024), 16, 0, 0); } while (0)
#define ATT_DMA_V(i, slot) do { if (var & 8) break; const int g_ = ATT_TROW((i) < NT ? (i) : NT - 1); \
        __builtin_amdgcn_global_load_lds((const unsigned*)(vsrc + (size_t)g_ * KPITCH), (LAS unsigned*)(lds + RG::L_V + (slot) * RG::VSLOT + wid * 1024), 16, 0, 0); } while (0)
#define ATT_WAITBAR() do { if (var & 16) break; if (TYPE == 1) asm volatile("s_waitcnt vmcnt(3)" ::: "memory"); else asm volatile("s_waitcnt vmcnt(2)" ::: "memory"); __builtin_amdgcn_s_barrier(); asm volatile("" ::: "memory"); } while (0)
#define ATT_RESC(a) do { if (__any((a) < 1.f)) { if (hi == 0) al_l[r32] = (a); asm volatile("s_waitcnt lgkmcnt(0)" ::: "memory"); \
        _Pragma("unroll") for (int r = 0; r < 16; ++r) { const float f_ = al_l[crow(r, hi)]; o[0][r] *= f_; o[1][r] *= f_; } } } while (0)
    const int qpos = q0 + wid * 32 + r32;
#define ATT_MASK(P0, P1, i) do { if (TYPE == 0) { const int kt0_ = kl0 + 64 * ((i) - 4) - qpos, lo_ = (i) >= 4 ? -128 : -(1 << 28), hi_ = (i) >= 4 ? 128 : (1 << 28); \
        _Pragma("unroll") for (int r = 0; r < 16; ++r) { const int k0_ = kt0_ + crow(r, hi); P0[r] = (k0_ < lo_ || k0_ > hi_) ? -1e30f : P0[r]; P1[r] = (k0_ + 32 < lo_ || k0_ + 32 > hi_) ? -1e30f : P1[r]; } } } while (0)
    const int vb0 = (int)(uintptr_t)(lds + RG::L_V) + v_rd_base(lane);
    const LAS unsigned char* Kr = lds + RG::L_K;
    float mhat = 0.f, l_reg = 0.f; f32x16 negm = f32x16{};
    f32x16 pA0 = f32x16{}, pA1 = f32x16{}, pB0 = f32x16{}, pB1 = f32x16{}; float alA = 1.f, alB = 1.f; bf16x8 pa0 = bf16x8{}, pa1 = bf16x8{}, pa2 = bf16x8{}, pa3 = bf16x8{};
    int sp = 2, sc = 0;
#define ATT_ROT() do { const int t_ = sp; sp = sc; sc = (sc == 2 ? 0 : sc + 1); (void)t_; } while (0)
    const bool lag = wid >= 4;
    const int qw = q0 + wid * 32;
#define ATT_STEP(PC0, PC1, ALC, PP0, PP1, ALP, t) do { \
        ATT_DMA_K((t) + 2, sp); ATT_DMA_V((t) + 1, ((t) + 1) & 3); \
        if (var & 1) { PC0 = negm; PC1 = negm; } else qkt2<NKS, ROWB, CB0>(PC0, PC1, Kr + sc * RG::KSLOT, qr, negm, r32, hi); \
        if (!(var & 2)) finishSM(PP0, PP1, ALP, l_reg, pa0, pa1, pa2, pa3); ATT_MASK(PC0, PC1, t); \
        asm volatile("" : "+v"(pa0), "+v"(pa1), "+v"(pa2), "+v"(pa3), "+v"(l_reg), "+v"(PC0), "+v"(PC1));     \
        ATT_SGB(0x100, 2 * NKS); _Pragma("unroll") for (int g_ = 0; g_ < 2 * NKS; ++g_) { ATT_SGB(0x008, 1); ATT_SGB(0x400, (32 + 2 * NKS - 1) / (2 * NKS)); ATT_SGB(0x002, TYPE == 0 ? 14 : (TYPE == 1 ? 4 : 12)); } \
        if (lag) ATT_WAITBAR(); \
        if (!(var & 4)) { pv_one<0>(o[0], vb0 + (((t) - 1) & 3) * RG::VSLOT, pa0, pa1, pa2, pa3); pv_one<1>(o[1], vb0 + (((t) - 1) & 3) * RG::VSLOT, pa0, pa1, pa2, pa3); } \
        float rm_ = (var & 2) ? 0.f : rowmax32(PC0, PC1); if (var & 128) rm_ = fminf(rm_, 0.f); asm volatile("" : "+v"(rm_), "+v"(o[0]), "+v"(o[1])); \
        ATT_SGB(0x100, 16); _Pragma("unroll") for (int g_ = 0; g_ < 8; ++g_) { ATT_SGB(0x008, 1); ATT_SGB(0x002, 3); } \
        partialSM(PC0, PC1, rm_, mhat, negm, ALC); ATT_RESC(ALC); \
        if (!lag) ATT_WAITBAR(); ATT_ROT(); } while (0)
    ATT_DMA_K(0, 0); ATT_DMA_V(0, 0); ATT_DMA_K(1, 1);
    asm volatile("s_waitcnt vmcnt(0)" ::: "memory"); __builtin_amdgcn_s_barrier(); asm volatile("" ::: "memory");
    { ATT_DMA_K(2, 2); ATT_DMA_V(1, 1);
      qkt2<NKS, ROWB, CB0>(pA0, pA1, Kr, qr, negm, r32, hi);
      if (lag) ATT_WAITBAR();
      const float rm = rowmax32(pA0, pA1); mhat = rm;
      _Pragma("unroll") for (int r = 0; r < 16; ++r) { pA0[r] -= rm; pA1[r] -= rm; negm[r] = -rm; }
      asm volatile("" : "+v"(negm));
      if (!lag) ATT_WAITBAR(); ATT_ROT(); }
    for (int j = 1; j + 1 < ((var & 32) ? ATT_XSTEPS : NT); j += 2) {
        ATT_STEP(pB0, pB1, alB, pA0, pA1, alA, j);
        ATT_STEP(pA0, pA1, alA, pB0, pB1, alB, j + 1);
    }
    ATT_STEP(pB0, pB1, alB, pA0, pA1, alA, NT - 1);
    finishSM(pB0, pB1, alB, l_reg, pa0, pa1, pa2, pa3);
    pv_one<0>(o[0], vb0 + ((NT - 1) & 3) * RG::VSLOT, pa0, pa1, pa2, pa3); pv_one<1>(o[1], vb0 + ((NT - 1) & 3) * RG::VSLOT, pa0, pa1, pa2, pa3);
    asm volatile("s_waitcnt vmcnt(0)" ::: "memory"); __builtin_amdgcn_s_barrier(); asm volatile("" ::: "memory");
    { auto rr = __builtin_amdgcn_permlane32_swap(__float_as_uint(l_reg), __float_as_uint(l_reg), false, false); l_reg = __uint_as_float(rr[0]) + __uint_as_float(rr[1]); }
    l_out = l_reg; m_out = mhat;
#undef ATT_TROW
#undef ATT_DMA_K
#undef ATT_DMA_V
#undef ATT_WAITBAR
#undef ATT_RESC
#undef ATT_MASK
#undef ATT_ROT
#undef ATT_STEP
}

template <int TYPE> __device__ __forceinline__ void unit(const Tensors& Tn, LAS unsigned char* lds, const int tid, const int b, const int h, const bool lat, const int q0, const int var) {
    constexpr int NKS = TYPE == 0 ? 4 : (TYPE == 1 ? 6 : 2);
    const int lane = tid & 63, wid = __builtin_amdgcn_readfirstlane(tid >> 6), r32 = lane & 31, hi = lane >> 5;
    typedef Ring<TYPE> RG;
    LAS float* wsf = (LAS float*)(lds + RG::L_WS) + wid * 64;
    const int qrow0 = (lat ? b * T + q0 : RL + b * LC) + wid * 32;
    bf16x8 qr[TYPE == 2 ? 4 : NKS];
    { const bf16* qp = TYPE == 0 ? Tn.P + (size_t)(qrow0 + r32) * LDP + P_AQ + h * 64 : (TYPE == 1 ? Tn.QKVM + (size_t)(qrow0 + r32) * LDM + h * 96 : Tn.P + (size_t)(qrow0 + r32) * LDP + P_DQ + h * 64);
#pragma unroll
      for (int d0 = 0; d0 < (TYPE == 2 ? 4 : NKS); ++d0) qr[d0] = *(const bf16x8*)(qp + d0 * 16 + hi * 8); }
    f32x16 oA[2] = {f32x16{}, f32x16{}}; float l0, m0;
    flash_pass<TYPE, 0>(Tn, lds, tid, b, h, lat, q0, var, qr, oA, l0, m0);
    f32x16 oB[2] = {f32x16{}, f32x16{}}; float l1 = 1.f, m1 = 0.f;
    LAS float* stash = (LAS float*)(lds + RG::L_OST + wid * 8192);
    if (TYPE == 2) {
#pragma unroll
        for (int r = 0; r < 16; ++r) { stash[r * 64 + lane] = oA[0][r]; stash[(16 + r) * 64 + lane] = oA[1][r]; }
        flash_pass<TYPE, 64>(Tn, lds, tid, b, h, lat, q0, var, qr + 2, oB, l1, m1);
#pragma unroll
        for (int r = 0; r < 16; ++r) { oA[0][r] = stash[r * 64 + lane]; oA[1][r] = stash[(16 + r) * 64 + lane]; }
        asm volatile("s_waitcnt lgkmcnt(0)" ::: "memory");
    }
    if (TYPE == 0) l0 += __builtin_amdgcn_exp2f(Tn.sink[Tn.l * 8 + h] * 1.4426950408889634f - m0);
    if (hi == 0) { wsf[r32] = l0; if (TYPE == 2) wsf[32 + r32] = l1; }
    asm volatile("s_waitcnt lgkmcnt(0)" ::: "memory");
    LAS bf16* stg = (LAS bf16*)(lds + RG::L_OST + wid * (TYPE == 2 ? 8192 : 4096));
    if (TYPE != 2) {
#pragma unroll
        for (int r = 0; r < 16; ++r) { const float rl = __builtin_amdgcn_rcpf(wsf[crow(r, hi)]); const int orow = crow(r, hi);
            stg[orow * 64 + r32] = (bf16)f2bf(oA[0][r] * rl); stg[orow * 64 + 32 + r32] = (bf16)f2bf(oA[1][r] * rl); }
    } else {
        const float g0 = Tn.dnorm[Tn.l * 64 + r32], g1 = Tn.dnorm[Tn.l * 64 + 32 + r32];
#pragma unroll
        for (int r = 0; r < 16; ++r) { const float rl0 = __builtin_amdgcn_rcpf(wsf[crow(r, hi)]), rl1 = Tn.lam * __builtin_amdgcn_rcpf(wsf[32 + crow(r, hi)]);
            const float a0 = oA[0][r] * rl0 - oB[0][r] * rl1, a1 = oA[1][r] * rl0 - oB[1][r] * rl1;
            float ss = a0 * a0 + a1 * a1;
#pragma unroll
            for (int o_ = 1; o_ < 32; o_ <<= 1) ss += shx(ss, o_, lane);
            const float rs = (1.f - Tn.lam_init) * __builtin_amdgcn_rsqf(ss * (1.f / 64.f) + EPS); const int orow = crow(r, hi);
            stg[orow * 64 + r32] = (bf16)f2bf(a0 * rs * g0); stg[orow * 64 + 32 + r32] = (bf16)f2bf(a1 * rs * g1); }
    }
    asm volatile("s_waitcnt lgkmcnt(0)" ::: "memory");
    { bf16* Ow = Tn.O + (size_t)qrow0 * D + (TYPE == 0 ? h * 64 : (TYPE == 1 ? 512 + h * 64 : 768 + h * 64));
#pragma unroll
      for (int i = 0; i < 4; ++i) { const int row = i * 8 + (lane >> 3), ch = lane & 7; *(u32x4*)(Ow + (size_t)row * D + ch * 8) = *(const LAS u32x4*)(stg + row * 64 + ch * 8); } }
    asm volatile("s_waitcnt lgkmcnt(0)" ::: "memory"); __builtin_amdgcn_s_barrier(); asm volatile("" ::: "memory");
}
}

__device__ __forceinline__ void attn_phase(Frame& F, const int l, const bool need_ctx) {
    att::Tensors Tn; Tn.P = F_P; Tn.QKVM = F_QKVM; Tn.O = F_O; Tn.sink = F_sink; Tn.dnorm = F_diff_norm; Tn.l = l;
    { float s1 = 0.f, s2 = 0.f;
      if (F.lane < 32) { s1 = F_lq1[l * 32 + F.lane] * F_lk1[l * 32 + F.lane]; s2 = F_lq2[l * 32 + F.lane] * F_lk2[l * 32 + F.lane]; }
      s1 = wave_sum(s1, F.lane); s2 = wave_sum(s2, F.lane);
      int ll_ = l; asm volatile("" : "+s"(ll_));
      const float li_ = ll_ == 0 ? 0.200000000f : (ll_ == 1 ? 0.355509068f : (ll_ == 2 ? 0.470713018f : 0.556058204f));
      const float lm_ = __expf(s1) - __expf(s2) + li_;
      Tn.lam_init = li_; Tn.lam = __builtin_bit_cast(float, __builtin_amdgcn_readfirstlane(__builtin_bit_cast(int, lm_))); }
    const int b = F.bid & 7, j = F.bid >> 3;
    if (F.G != 256) return;
    const int nu = (need_ctx && j < 16) ? 5 : 4;
    for (int u = 0; u < nu + ATT_EXTRA; ++u) {
        int type, h, q0; bool lat = true; const int var = u >= nu ? ATT_XVAR : 0;
        if (u >= nu) { type = ATT_EXTRA_TYPE; h = (j >> 3); q0 = (j & 7) * 256; Tn.O = F_ACT; }
        else if (u == 0) { type = 2; h = j >> 3; q0 = (j & 7) * 256; }
        else if (u == 1) { type = 1; h = j >> 3; q0 = (j & 7) * 256; }
        else if (u < 4) { type = 0; h = j >> 2; q0 = (j & 3) * 512 + (u - 2) * 256; }
        else { lat = false; q0 = 0; if (j < 8) { type = 0; h = j; } else if (j < 12) { type = 1; h = j - 8; } else { type = 2; h = j - 12; } }
        int t_ = F.tid; asm volatile("" : "+v"(t_));
        if (type == 0) att::unit<0>(Tn, F.lds, t_, b, h, lat, q0, var);
        else if (type == 1) att::unit<1>(Tn, F.lds, t_, b, h, lat, q0, var);
        else att::unit<2>(Tn, F.lds, t_, b, h, lat, q0, var);
    }
}

enum { PH_P0 = 0, PH_L0 = 1, PH_PER_LAYER = 9, PH_FINAL = PH_L0 + DEPTH * PH_PER_LAYER, NPH = PH_FINAL + 1 };
enum { SP_NORM1 = 0, SP_INPROJ = 1, SP_UP = 2, SP_ATTN = 3, SP_OUT = 4, SP_NORM2 = 5, SP_TOPK = 6, SP_MOE1 = 7, SP_MOE2 = 8 };

#ifndef REPS_INIT
#define REPS_INIT {1, 1, 1, 1, 1, 1, 1, 1, 1}
#endif
#ifndef REP_P0
#define REP_P0 1
#endif
#ifndef REP_FINAL
#define REP_FINAL 1
#endif
#ifndef KROT_ON
#define KROT_ON 0
#endif
#ifndef PROBE_NOMMA
#define PROBE_NOMMA 0
#endif
#ifndef PHMASK
#define PHMASK 0x3ff
#endif
#define PHON(b) ((PHMASK >> (b)) & 1)
#define REPSEL(s) ((s) == 0 ? reps_sp[0] : (s) == 1 ? reps_sp[1] : (s) == 2 ? reps_sp[2] : (s) == 3 ? reps_sp[3] : (s) == 4 ? reps_sp[4] : (s) == 5 ? reps_sp[5] : (s) == 6 ? reps_sp[6] : (s) == 7 ? reps_sp[7] : reps_sp[8])
__global__ void __launch_bounds__(NWAVES * 64, 2) mk(Args args) {
    extern __shared__ __attribute__((aligned(16))) unsigned char lds_raw[];
    Frame F;
    F.lds = (LAS unsigned char*)lds_raw;
    F.tid = threadIdx.x; F.lane = F.tid & 63; F.wave = __builtin_amdgcn_readfirstlane(F.tid >> 6); F.bid = blockIdx.x; F.G = gridDim.x;
    const int wave_s = F.wave;
    F.in = (const float* const*)args.in; F.out = (GAS float*)args.out; F.ws = (GAS unsigned char*)args.ws;
    volatile LAS unsigned* MISC = (volatile LAS unsigned*)(F.lds + MISC_OFF);
    for (int u = F.tid; u < (LDS_BYTES - LDSCTL_OFF) / 4; u += NWAVES * 64) ((LAS unsigned*)(F.lds + LDSCTL_OFF))[u] = 0u;
    __syncthreads();
    XcdBarrier bar = xcd_barrier_post((unsigned*)(args.ws + WS_CTL) + CW_BAR + args.li * XCD_BAR_WORDS, MISC + 8);
    const int gx = F.bid & 7, gj = F.bid >> 3, gpx = F.G >> 3, krot = KROT_ON ? (gj & 7) + 3 * (gj >> 3) : 0;
    constexpr int reps_sp[9] = REPS_INIT;
    for (int ph = args.ph_lo; ph < args.ph_hi; ++ph) {
      const int nrep = ph == PH_P0 ? REP_P0 : (ph == PH_FINAL ? REP_FINAL : (REPSEL((ph - PH_L0) % PH_PER_LAYER)));
      for (int rep = 0; rep < nrep; ++rep) {
        const float keep = rep + 1 == nrep ? 1.f : 0.f;
        { unsigned char* w_ = args.ws; asm volatile("" : "+s"(w_)); F.ws = (GAS unsigned char*)w_; int z_ = 0; asm volatile("" : "+s"(z_)); F.in = (const float* const*)args.in + z_;
          int l_; asm volatile("v_mbcnt_lo_u32_b32 %0, -1, 0\n\tv_mbcnt_hi_u32_b32 %0, -1, %0" : "=v"(l_));
          int w_s = wave_s; asm volatile("" : "+s"(w_s)); F.lane = l_; F.wave = w_s; F.tid = w_s * 64 + l_; }
        if (ph == PH_P0) { if (PHON(9)) p0_phase(F); }
        else if (ph == PH_FINAL) { if (PHON(0)) norm_phase(F, DEPTH, 2, RL, keep); }
        else {
            const int l = (ph - PH_L0) / PH_PER_LAYER, sp = (ph - PH_L0) % PH_PER_LAYER;
            const bool need_ctx = l < DEPTH - 1; const int rows_mix = need_ctx ? R : RL;
            const bf16* wl = F_WB + (size_t)l * W_LAYER;
            if (sp == SP_NORM1) { if (PHON(0)) norm_phase(F, l, 0, R, keep); }
            else if (sp == SP_INPROJ && PHON(1)) {
                pg8::Gemm g{F_ACT, wl + W_IN, nullptr, 0, D, D}; OrderRows S{gx, gj, gpx, R / 192 / 8, LDP / 256, (PROBE_NOMMA && rep + 1 < nrep) ? 1 : 0, krot, 192};
                EpiInProj<3> E{F_P, F_ROPE, F_RSQ};
                pg8::gemm_phase<false, 3>(F.lds, F.tid, g, S, E);
                { const int nbusy = 8;
                  if (BG_PREP && l + 1 < DEPTH && rep + 1 == nrep && gj >= nbusy) prep_layer(F, l + 1, ((gx * (gpx - nbusy) + (gj - nbusy)) * NWAVES) + F.wave, 8 * (gpx - nbusy) * NWAVES); }
            } else if (sp == SP_UP && PHON(2)) {
                pg8::Gemm g{F_P + P_CQ, wl + W_UP, nullptr, 0, LDP, UPK}; OrderRows S{gx, gj, gpx, R / 192 / 8, 4, 0, krot, 192};
                EpiUp<3> E{F_QKVM, F_ROPE, F_RSQ};
                pg8::gemm_phase<false, 3>(F.lds, F.tid, g, S, E);
            } else if (sp == SP_ATTN) { if (PHON(3)) attn_phase(F, l, need_ctx);
            } else if (sp == SP_OUT && PHON(4)) {
                pg8::Gemm g{F_O, wl + W_OUT, nullptr, 0, D, D};
                if (need_ctx) { OrderRows S{gx, gj, gpx, R / 192 / 8, 4, 0, krot, 192}; EpiOut<3> E{F_X, F_MOD + (size_t)l * 9 * 6144, keep, F_x, F_ctx, 0}; pg8::gemm_phase<false, 3>(F.lds, F.tid, g, S, E); }
                else { OrderRows S{gx, gj, gpx, RL / 256 / 8, 4, 0, krot, 256}; EpiOut<4> E{F_X, F_MOD + (size_t)l * 9 * 6144, keep, F_x, F_ctx, 0}; pg8::gemm_phase<false, 4>(F.lds, F.tid, g, S, E); }
            } else if (sp == SP_NORM2) { if (PHON(5)) norm_phase(F, l, 1, rows_mix, keep); }
            else if (sp == SP_TOPK) { if (PHON(6)) topk_phase(F, need_ctx ? 16 : 8); }
            else if (sp == SP_MOE1 && PHON(7)) {
                pg8::Gemm g{F_ACT, wl + W_GU, F_STOK, (size_t)1024 * 1024, D, D};
                if (need_ctx) { OrderMoe S{gx, gj, gpx, 12, 4, krot, 192}; EpiGU<3> E{F_HID}; pg8::gemm_phase<true, 3>(F.lds, F.tid, g, S, E); }
                else { OrderMoe S{gx, gj, gpx, 8, 4, krot, 256}; EpiGU<4> E{F_HID}; pg8::gemm_phase<true, 4>(F.lds, F.tid, g, S, E); }
            } else if (sp == SP_MOE2 && PHON(8)) {
                pg8::Gemm g{F_HID, wl + W_DN, nullptr, (size_t)1024 * 512, DE, DE};
                if (need_ctx) { OrderMoe S{gx, gj, gpx, 12, 4, krot, 192}; EpiDown<3> E{F_Y, F_SGATE}; pg8::gemm_phase<false, 3>(F.lds, F.tid, g, S, E); }
                else { OrderMoe S{gx, gj, gpx, 8, 4, krot, 256}; EpiDown<4> E{F_Y, F_SGATE}; pg8::gemm_phase<false, 4>(F.lds, F.tid, g, S, E); }
            }
        }
        if (ph + 1 < args.ph_hi || rep + 1 < nrep) { xcd_barrier(bar, F.tid);
#ifdef EXTRA_BAR
            xcd_barrier(bar, F.tid);
#endif
        }
      }
    }
}

extern "C" void kernel_launch(void* const* d_in, const int* in_sizes, int n_in, void* d_out, int out_size, void* d_ws, size_t ws_size, hipStream_t stream) {
    static int grid = 0;
    if (grid == 0) {
        if (n_in != 25 || ws_size < WS_END || out_size != RL * D) { fprintf(stderr, "kernel_launch: unexpected shapes (n_in %d, ws %zu < %zu, out %d)\n", n_in, ws_size, (size_t)WS_END, out_size); grid = -1; return; }
        int dev = 0, cus = 0, per_cu = 0;
        if (hipGetDevice(&dev) != hipSuccess || hipDeviceGetAttribute(&cus, hipDeviceAttributeMultiprocessorCount, dev) != hipSuccess) { grid = -1; return; }
        if (hipFuncSetAttribute((const void*)mk, hipFuncAttributeMaxDynamicSharedMemorySize, LDS_BYTES) != hipSuccess) { fprintf(stderr, "kernel_launch: hipFuncSetAttribute failed\n"); grid = -1; return; }
        if (hipOccupancyMaxActiveBlocksPerMultiprocessor(&per_cu, (const void*)mk, NWAVES * 64, LDS_BYTES) != hipSuccess || per_cu < 1) { fprintf(stderr, "kernel_launch: occupancy query says %d\n", per_cu); }
        (void)hipGetLastError();
        grid = cus;
        if (grid % 8 != 0) { fprintf(stderr, "kernel_launch: %d CUs, expected a multiple of 8\n", grid); grid = -1; return; }
    }
    if (grid < 0) return;
    (void)hipMemsetAsync((char*)d_ws + WS_CTL, 0, CTL_ZERO_BYTES, stream);
    Args a; memset(&a, 0, sizeof a);
    for (int i = 0; i < 25; ++i) a.in[i] = (const float*)d_in[i];
    a.out = (float*)d_out; a.ws = (unsigned char*)d_ws;
    a.ph_lo = 0; a.ph_hi = NPH; a.li = 0;
    hipLaunchKernelGGL(mk, dim3(grid), dim3(NWAVES * 64), LDS_BYTES, stream, a);
}
```

```cpp
#include <hip/hip_runtime.h>
#include <stdint.h>
#include <string.h>
#include <stdio.h>

typedef unsigned short bf16;
typedef unsigned u32x4 __attribute__((ext_vector_type(4)));
typedef unsigned u32x2 __attribute__((ext_vector_type(2)));
typedef float f32x4 __attribute__((ext_vector_type(4)));
typedef float f32x16 __attribute__((ext_vector_type(16)));
typedef short bf16x8 __attribute__((ext_vector_type(8)));
#define LAS __attribute__((address_space(3)))
#define GAS __attribute__((address_space(1)))

constexpr int D = 1024, NB = 8, T = 2048, LC = 256, DEPTH = 4;
constexpr int RL = NB * T, RC = NB * LC, R = RL + RC;
constexpr int INW = 1952, LDP = 2048;
constexpr int NE = 16, DE = 512;
constexpr int CAPL = 256, CAPC = 32;
constexpr int SLOTS_E = NB * CAPL + NB * CAPC;
constexpr int SLOTS = NE * SLOTS_E;
constexpr float EPS = 1e-6f;
constexpr int P_AQ = 0, P_AK = 512, P_AV = 640, P_CQ = 768, P_CKV = 1024, P_KR = 1152, P_DQ = 1184, P_DK = 1440, P_DV = 1696;
constexpr int LDM = 1024;
constexpr int UPK = 384;

constexpr size_t MiB = 1u << 20;
constexpr size_t WS_CTL = 0;
constexpr size_t CTL_ZERO_BYTES = 256 * 1024;
constexpr size_t WS_MOD = 1 * MiB;
constexpr size_t WS_ROPE = 2 * MiB;
constexpr size_t WS_RSQ = 3 * MiB;
constexpr size_t WS_AFF = 4 * MiB;
constexpr size_t WS_INV = 6 * MiB;
constexpr size_t WS_STOK = 8 * MiB;
constexpr size_t WS_SGATE = 9 * MiB;
constexpr size_t WS_X = 10 * MiB;
constexpr size_t WS_ACT = 82 * MiB;
constexpr size_t WS_P = 118 * MiB;
constexpr size_t WS_Y = WS_P;
constexpr size_t WS_QKVM = 190 * MiB;
constexpr size_t WS_O = 226 * MiB;
constexpr size_t WS_HID = WS_O;
constexpr size_t WS_W = 262 * MiB;
constexpr size_t W_IN = 0;
constexpr size_t W_UP = W_IN + (size_t)LDP * D;
constexpr size_t W_OUT = W_UP + (size_t)1024 * UPK;
constexpr size_t W_GU = W_OUT + (size_t)D * D;
constexpr size_t W_DN = W_GU + (size_t)NE * 1024 * 1024;
constexpr size_t W_LAYER = W_DN + (size_t)NE * 1024 * 512;
constexpr size_t WS_END = WS_W + (size_t)DEPTH * W_LAYER * 2;

__device__ __forceinline__ unsigned f2bf(float f) { unsigned u = __builtin_bit_cast(unsigned, f); return (u + 0x7fffu + ((u >> 16) & 1u)) >> 16; }
__device__ __forceinline__ float bf2f(unsigned h) { return __builtin_bit_cast(float, h << 16); }
__device__ __forceinline__ unsigned pk2(float lo, float hi) { return f2bf(lo) | (f2bf(hi) << 16); }
__device__ __forceinline__ float shx(float v, int o, int lane) { return __builtin_bit_cast(float, __builtin_amdgcn_ds_bpermute((lane ^ o) << 2, __builtin_bit_cast(int, v))); }
__device__ __forceinline__ int shi(int v, int src) { return __builtin_amdgcn_ds_bpermute(src << 2, v); }
__device__ __forceinline__ float wave_sum(float v, int lane) {
#pragma unroll
    for (int o = 1; o < 64; o <<= 1) v += shx(v, o, lane);
    return v;
}
__device__ __forceinline__ float siluf(float v) { return v / (1.f + __expf(-v)); }
#define LDS_WAIT() asm volatile("s_waitcnt lgkmcnt(0)" ::: "memory")
#define VM_WAIT() asm volatile("s_waitcnt vmcnt(0)" ::: "memory")

struct Args {
    const float* in[25]; float* out; unsigned char* ws; int ph_lo, ph_hi, li, pad;
};

#ifndef PROBE_HOT
#define PROBE_HOT 0
#endif
#ifndef PROBE_NOLDS
#define PROBE_NOLDS 0
#endif
#ifndef GEMM_ASKIP
#define GEMM_ASKIP 0
#endif
namespace pg8 {
constexpr int BM = 256, BK = 64, HALF = 128, HTB = HALF * BK * 2  , STAGE_BYTES = 8 * HTB;
__host__ __device__ __forceinline__ int lds_byte(int r, int c) { const int st = (r >> 4) * 2 + (c >> 5), rr = r & 15, cc = c & 31, ob = rr * 64 + cc * 2; return st * 1024 + (ob ^ (((ob >> 9) & 1) << 5)); }
__host__ __device__ __forceinline__ void stage_rc(int b, int& R, int& C) { const int st = b / 1024, sb = b % 1024, swz = sb ^ (((sb >> 9) & 1) << 5); R = (st >> 1) * 16 + swz / 64; C = (st & 1) * 32 + (swz % 64) / 2; }
__host__ __device__ __forceinline__ int perm32(int rho) { const int n = rho >> 4, i = rho & 15; return 8 * (i >> 2) + 4 * n + (i & 3); }

struct Unit { int arow0, orow0, col0, e, quad; };
struct Gemm { const bf16* A; const bf16* Bt; const int* gather; size_t b_estride; int lda, K; };

template <bool GATHER, int MF, class Epi, class Sched>
__device__ __forceinline__ void gemm_phase(LAS unsigned char* lds, const int tid, const Gemm g, const Sched& S, const Epi& E) {
    const int wid = __builtin_amdgcn_readfirstlane(tid >> 6), lane = tid & 63, wr = wid >> 2, wc = wid & 3, fr = lane & 15, fq = lane >> 4;
    constexpr bool ASKIP = (MF == 3) && GEMM_ASKIP;
    constexpr int HR = 32 * MF;
    const int K = g.K, nt = K / BK;
    unsigned voffA[2], voffB[2]; int sR[2];
#pragma unroll
    for (int i = 0; i < 2; ++i) { int C_; stage_rc(tid * 16 + i * 8192, sR[i], C_); const int Rb = (sR[i] & ~31) + perm32(sR[i] & 31);
        voffA[i] = GATHER ? (unsigned)C_ * 2u : (unsigned)(sR[i] * g.lda + C_) * 2u; voffB[i] = (unsigned)(Rb * K + C_) * 2u; }
    const unsigned lda2 = (unsigned)g.lda * 2u;
    const unsigned hstepA = (unsigned)HR * g.lda * 2u;
    const unsigned kstep = (unsigned)(BK * 2);
    const int krot = (2 * S.rot) % nt;
#define PG8_KT(i) ((PROBE_HOT && hot_) ? 0u : (unsigned)(((i) + krot) >= nt ? (i) + krot - nt : (i) + krot) * kstep)
    const unsigned hstepB = (unsigned)HALF * K * 2u;
    const __amdgpu_buffer_rsrc_t rsA = __builtin_amdgcn_make_buffer_rsrc((void*)g.A, 0, 0x7fffffff, 0x00020000);
    const __amdgpu_buffer_rsrc_t rsB = __builtin_amdgcn_make_buffer_rsrc((void*)g.Bt, 0, 0x7fffffff, 0x00020000);
    const unsigned ldsw = (unsigned)wid * 1024u;
    const int aoff = lds_byte(wr * (16 * MF) + fr, fq * 8), boff = lds_byte(wc * 32 + fr, fq * 8);
#define PG8_SA(b, h) (((b) * 2 + (h)) * HTB)
#define PG8_SB(b, h) ((4 + (b) * 2 + (h)) * HTB)
#define PG8_STAGE2(bufoff, rsrc, v0, v1, soff) do { \
        __builtin_amdgcn_raw_ptr_buffer_load_lds(rsrc, (LAS unsigned*)(lds + (bufoff) + ldsw), 16, (int)(v0), (int)(soff), 0, 0); \
        __builtin_amdgcn_raw_ptr_buffer_load_lds(rsrc, (LAS unsigned*)(lds + (bufoff) + ldsw + 8192), 16, (int)(v1), (int)(soff), 0, 0); } while (0)
#define PG8_STAGEB(bufoff, soff) PG8_STAGE2(bufoff, rsB, voffB[0], voffB[1], soff)
#define PG8_STAGE1(bufoff, rsrc, v0, soff) __builtin_amdgcn_raw_ptr_buffer_load_lds(rsrc, (LAS unsigned*)(lds + (bufoff) + ldsw), 16, (int)(v0), (int)(soff), 0, 0)
#define PG8_STAGEA(bufoff, ubase, r0, r1, h, koff) do { if constexpr (GATHER) { \
        if (ASKIP && wr == 1) PG8_STAGE1(bufoff, rsA, (((r0) >> (16 * (h))) & 0xffffu) * lda2 + voffA[0], (koff)); \
        else PG8_STAGE2(bufoff, rsA, (((r0) >> (16 * (h))) & 0xffffu) * lda2 + voffA[0], (((r1) >> (16 * (h))) & 0xffffu) * lda2 + voffA[1], (koff)); } \
        else { if (ASKIP && wr == 1) PG8_STAGE1(bufoff, rsA, voffA[0], (ubase) + (h) * hstepA + (koff)); \
        else PG8_STAGE2(bufoff, rsA, voffA[0], voffA[1], (ubase) + (h) * hstepA + (koff)); } } while (0)
#define PG8_LDA(dst, b, h) do { if (PROBE_NOLDS && hot_) break; _Pragma("unroll") for (int m = 0; m < MF; ++m) _Pragma("unroll") for (int k = 0; k < 2; ++k) dst[m][k] = *(const LAS bf16x8*)(lds + PG8_SA(b, h) + aoff + m * 2048 + k * 1024); } while (0)
#define PG8_LDB(dst, b, h) do { if (PROBE_NOLDS && hot_) break; _Pragma("unroll") for (int n = 0; n < 2; ++n) _Pragma("unroll") for (int k = 0; k < 2; ++k) dst[n][k] = *(const LAS bf16x8*)(lds + PG8_SB(b, h) + boff + n * 2048 + k * 1024); } while (0)
#define PG8_MMA(ai, bj, At, Bt) do { __builtin_amdgcn_s_setprio(1); _Pragma("unroll") for (int m = 0; m < MF; ++m) _Pragma("unroll") for (int n = 0; n < 2; ++n) _Pragma("unroll") for (int k = 0; k < 2; ++k) \
        acc[ai][bj][m][n] = __builtin_amdgcn_mfma_f32_16x16x32_bf16(Bt[n][k], At[m][k], acc[ai][bj][m][n], 0, 0, 0); __builtin_amdgcn_s_setprio(0); } while (0)
#define PG8_WAIT_V(n) asm volatile("s_waitcnt vmcnt(" #n ")" ::: "memory")
#define PG8_WAIT_V2(n, nskip) do { if (ASKIP && wr == 1) PG8_WAIT_V(nskip); else PG8_WAIT_V(n); } while (0)
#define PG8_WAIT_L(n) asm volatile("s_waitcnt lgkmcnt(" #n ")" ::: "memory")
#define PG8_BAR __builtin_amdgcn_s_barrier()
#define PG8_SCHED __builtin_amdgcn_sched_barrier(0)
#define PG8_ROWS(dst, u) do { if constexpr (GATHER) { _Pragma("unroll") for (int i = 0; i < 2; ++i) { \
        const int sr_ = sR[i] < HR ? sR[i] : sR[i] - 32;     \
        const unsigned a_ = (unsigned)g.gather[(u).arow0 + sr_], b_ = (unsigned)g.gather[(u).arow0 + ((u).quad ? 0 : HR) + sr_]; dst[i] = a_ | (b_ << 16); } \
        asm volatile("" : "+v"(dst[0]), "+v"(dst[1])); } } while (0)
    Unit cur, nxt; int ui = 0;
    if (!S.next(0, cur)) return;
    const bool hot_ = cur.quad == 2;
    f32x4 acc[2][2][MF][2];
#pragma unroll
    for (int a = 0; a < 2; ++a)
#pragma unroll
        for (int b = 0; b < 2; ++b)
#pragma unroll
            for (int m = 0; m < MF; ++m)
#pragma unroll
                for (int n = 0; n < 2; ++n) acc[a][b][m][n] = (f32x4){0.f, 0.f, 0.f, 0.f};
    bf16x8 At[MF][2], B0[2][2], B1[2][2];
    unsigned rp[2] = {0u, 0u}, rn[2] = {0u, 0u};
    PG8_ROWS(rp, cur);
    unsigned cA = (unsigned)cur.arow0 * lda2;
    unsigned cB = (unsigned)(((size_t)cur.e * g.b_estride + (size_t)cur.col0 * K) * 2);
    PG8_STAGEB(PG8_SB(0, 0), cB + PG8_KT(0)); PG8_STAGEB(PG8_SB(0, 1), cB + hstepB + PG8_KT(0)); PG8_STAGEA(PG8_SA(0, 0), cA, rp[0], rp[1], 0, PG8_KT(0)); PG8_STAGEA(PG8_SA(0, 1), cA, rp[0], rp[1], 1, PG8_KT(0));
    if (wr == 1) PG8_BAR;
    PG8_WAIT_V2(2, 1); PG8_BAR;
    PG8_STAGEB(PG8_SB(1, 0), cB + PG8_KT(1)); PG8_STAGEA(PG8_SA(1, 0), cA, rp[0], rp[1], 0, PG8_KT(1)); PG8_STAGEB(PG8_SB(1, 1), cB + hstepB + PG8_KT(1));
    PG8_WAIT_V2(6, 5); PG8_BAR;
    for (;;) {
        const bool has_next = S.next(ui + 1, nxt);
        if (has_next) { PG8_ROWS(rn, nxt); } else { rn[0] = rp[0]; rn[1] = rp[1]; }
        const unsigned nA = has_next ? (unsigned)nxt.arow0 * lda2 : cA;
        const unsigned nB = has_next ? (unsigned)(((size_t)nxt.e * g.b_estride + (size_t)nxt.col0 * K) * 2) : cB;
#pragma unroll 1
        for (int t = 0; t < nt; t += 2) {
            const bool last = (t == nt - 2);
            const unsigned k1 = PG8_KT(t + 1), k2 = last ? PG8_KT(0) : PG8_KT(t + 2), k3 = last ? PG8_KT(1) : PG8_KT(t + 3);
            const unsigned u2 = last ? nA : cA; const unsigned b2 = (last ? nB : cB) + k2; const unsigned b3 = (last ? nB : cB) + k3;
            const unsigned q0 = last ? rn[0] : rp[0], q1 = last ? rn[1] : rp[1];
            PG8_LDB(B0, 0, 0); PG8_LDB(B1, 0, 1); PG8_SCHED; PG8_LDA(At, 0, 0); PG8_STAGEA(PG8_SA(1, 1), cA, rp[0], rp[1], 1, k1);
            PG8_WAIT_V2(8, 6); PG8_WAIT_L(0); PG8_BAR; if (cur.quad < 2) PG8_MMA(0, 0, At, B0); if (!cur.quad) PG8_MMA(0, 1, At, B1); PG8_BAR; PG8_SCHED;
            PG8_LDA(At, 0, 1); PG8_STAGEB(PG8_SB(0, 0), b2); PG8_STAGEB(PG8_SB(0, 1), b2 + hstepB); PG8_STAGEA(PG8_SA(0, 0), u2, q0, q1, 0, k2);
            PG8_WAIT_V2(8, 6); PG8_WAIT_L(0); PG8_BAR; if (!cur.quad) { PG8_MMA(1, 0, At, B0); PG8_MMA(1, 1, At, B1); } PG8_BAR; PG8_SCHED;
            PG8_LDB(B0, 1, 0); PG8_LDB(B1, 1, 1); PG8_SCHED; PG8_LDA(At, 1, 0); PG8_STAGEA(PG8_SA(0, 1), u2, q0, q1, 1, k2);
            PG8_WAIT_V2(8, 6); PG8_WAIT_L(0); PG8_BAR; if (cur.quad < 2) PG8_MMA(0, 0, At, B0); if (!cur.quad) PG8_MMA(0, 1, At, B1); PG8_BAR; PG8_SCHED;
            PG8_LDA(At, 1, 1); PG8_STAGEB(PG8_SB(1, 0), b3); PG8_STAGEB(PG8_SB(1, 1), b3 + hstepB); PG8_STAGEA(PG8_SA(1, 0), u2, q0, q1, 0, k3);
            PG8_WAIT_V2(8, 6); PG8_WAIT_L(0); PG8_BAR; if (!cur.quad) { PG8_MMA(1, 0, At, B0); PG8_MMA(1, 1, At, B1); } PG8_BAR; PG8_SCHED;
        }
        if (wr == 0) PG8_BAR;
        E(acc, cur, wr, wc, fr, fq);
        if (!has_next) break;
#pragma unroll
        for (int a = 0; a < 2; ++a)
#pragma unroll
            for (int b = 0; b < 2; ++b)
#pragma unroll
                for (int m = 0; m < MF; ++m)
#pragma unroll
                    for (int n = 0; n < 2; ++n) acc[a][b][m][n] = (f32x4){0.f, 0.f, 0.f, 0.f};
        cur = nxt; cB = nB; cA = nA; ++ui; rp[0] = rn[0]; rp[1] = rn[1];
        if (wr == 1) PG8_BAR;
    }
    PG8_WAIT_V(0);
    PG8_BAR;
#undef PG8_SA
#undef PG8_SB
#undef PG8_STAGE2
#undef PG8_STAGEB
#undef PG8_LDA
#undef PG8_LDB
#undef PG8_MMA
#undef PG8_WAIT_V
#undef PG8_WAIT_V2
#undef PG8_STAGE1
#undef PG8_WAIT_L
#undef PG8_BAR
#undef PG8_SCHED
#undef PG8_KT
#undef PG8_ROWS
#undef PG8_STAGEA
}
}

#ifndef QUAD_SPLIT
#define QUAD_SPLIT 1
#endif
__device__ __forceinline__ bool deal(int i, int j, int gpx, int U, int& unit, int& quad) {
    const int q = i * gpx + j, nfull = (U / gpx) * gpx, left = U - nfull;
    if (q < nfull || left * 4 > gpx || !QUAD_SPLIT) { if (q >= U) return false; unit = q; quad = -1; return true; }
    const int s_ = q - nfull; if (s_ >= left * 4) return false; unit = nfull + (s_ >> 2); quad = s_ & 3; return true;
}
struct OrderRows {
    int x, j, gpx, rpx, nN, nomma, rot, TR;
    __device__ __forceinline__ bool next(int i, pg8::Unit& u) const {
        int q, quad; if (!deal(i, j, gpx, rpx * nN, q, quad)) return false;
        const int pm = x * rpx + q / nN, pn = q % nN; u.arow0 = pm * TR; u.col0 = pn * 256; u.e = 0; u.quad = quad >= 0;
        if (quad >= 0) { u.arow0 += (quad >> 1) * (TR / 2); u.col0 += (quad & 1) * 128; }
        if (nomma) u.quad = 2;
        u.orow0 = u.arow0; return true; }
};
struct OrderMoe {
    int x, j, gpx, nME, nN, rot, TR;
    __device__ __forceinline__ bool next(int i, pg8::Unit& u) const {
        int q, quad; const int per = nME * nN; if (!deal(i, j, gpx, 2 * per, q, quad)) return false;
        const int e = 2 * x + q / per, rem = q % per, pmE = rem / nN, pn = rem % nN;
        u.arow0 = e * SLOTS_E + pmE * TR; u.col0 = pn * 256; u.e = e; u.quad = quad >= 0;
        if (quad >= 0) { u.arow0 += (quad >> 1) * (TR / 2); u.col0 += (quad & 1) * 128; }
        u.orow0 = u.arow0; return true; }
};

constexpr float QS_A = 0.125f * 1.4426950408889634f, QS_B = 0.10206207261596577f * 1.4426950408889634f, QS_C = 0.17677669529663687f * 1.4426950408889634f;
typedef float f32x4e __attribute__((ext_vector_type(4)));
#define EPI_ROWS(ai, m) (u.orow0 + (ai) * (32 * MF) + wr * (16 * MF) + (m) * 16 + fr)
#define EPI_COL0(bj) (u.col0 + (bj) * 128 + wc * 32 + 8 * fq)
__device__ __forceinline__ void rope8(f32x4& v0, f32x4& v1, const float* cs, const float* sn) {
    const f32x4 c = *(const f32x4*)cs, s = *(const f32x4*)sn;
    f32x4 a = v0, b = v1;
    v0.x = a.x * c.x - a.y * s.x; v0.y = a.y * c.x + a.x * s.x; v0.z = a.z * c.y - a.w * s.y; v0.w = a.w * c.y + a.z * s.y;
    v1.x = b.x * c.z - b.y * s.z; v1.y = b.y * c.z + b.x * s.z; v1.z = b.z * c.w - b.w * s.w; v1.w = b.w * c.w + b.z * s.w;
}
__device__ __forceinline__ u32x4 pack8(const f32x4 v0, const f32x4 v1) { u32x4 w; w.x = pk2(v0.x, v0.y); w.y = pk2(v0.z, v0.w); w.z = pk2(v1.x, v1.y); w.w = pk2(v1.z, v1.w); return w; }

template <int MF> struct EpiInProj {
    bf16* P; const float* rope; float* RSQ;
    __device__ __forceinline__ void operator()(const f32x4 (&acc)[2][2][MF][2], const pg8::Unit& u, int wr, int wc, int fr, int fq) const {
#pragma unroll
        for (int bj = 0; bj < 2; ++bj) {
            if (u.quad && bj) continue;
            const int c0 = EPI_COL0(bj);
            const bool secA = c0 < P_AV, secB = c0 >= P_KR && c0 < P_DV;
            const int which = (c0 >= P_CQ && c0 < P_CKV) ? 0 : ((c0 >= P_CKV && c0 < P_KR) ? 1 : -1);
            const int p0 = secA ? ((c0 & 63) >> 1) : ((c0 & 31) >> 1);
            const float qs = c0 < P_AK ? QS_A : ((c0 >= P_DQ && c0 < P_DK) ? QS_C : 1.f);
#pragma unroll
            for (int ai = 0; ai < 2; ++ai)
#pragma unroll
                for (int m = 0; m < MF; ++m) {
                    if (u.quad && ai) continue;
                    const int row = EPI_ROWS(ai, m);
                    f32x4 v0 = acc[ai][bj][m][0] * qs, v1 = acc[ai][bj][m][1] * qs;
                    if (row < RL && (secA || secB)) { const int t = row & (T - 1);
                        const float* cs = secA ? rope + t * 32 + p0 : rope + T * 64 + t * 16 + p0;
                        const float* sn = secA ? rope + T * 32 + t * 32 + p0 : rope + T * 64 + T * 16 + t * 16 + p0;
                        rope8(v0, v1, cs, sn); }
                    if (which >= 0) { float s = (v0.x * v0.x + v0.y * v0.y) + (v0.z * v0.z + v0.w * v0.w) + (v1.x * v1.x + v1.y * v1.y) + (v1.z * v1.z + v1.w * v1.w);
                        { const int ln_ = fq * 16 + fr; s += shx(s, 16, ln_); s += shx(s, 32, ln_); }
                        if (fq == 0) RSQ[(size_t)row * 12 + ((c0 - P_CQ) >> 5)] = s; }
                    *(u32x4*)(P + (size_t)row * LDP + c0) = pack8(v0, v1);
                }
        }
    }
};
template <int MF> struct EpiUp {
    bf16* QKVM; const float* rope; const float* RSQ;
    __device__ __forceinline__ void operator()(const f32x4 (&acc)[2][2][MF][2], const pg8::Unit& u, int wr, int wc, int fr, int fq) const {
        const bool isq = u.col0 < 512;
        const float inv = isq ? (1.f / 256.f) : (1.f / 128.f);
        const int cw = u.col0 + wc * 32 + 8 * fq;
        int j0 = cw; j0 -= j0 >= 192 ? 192 : 0; j0 -= j0 >= 96 ? 96 : 0;
        int j1 = j0 + 32; j1 -= j1 >= 96 ? 96 : 0;
        const bool rot0 = isq && cw < 384 && j0 >= 64, rot1 = isq && cw + 128 < 384 && j1 >= 64;
        const float* tb = rope + T * 64;
#pragma unroll
        for (int ai = 0; ai < 2; ++ai)
#pragma unroll
            for (int m = 0; m < MF; ++m) {
                if (u.quad && ai) continue;
                const int row = EPI_ROWS(ai, m);
                const float* rq = RSQ + (size_t)row * 12; float sq;
                if (isq) { const f32x4 pa_ = *(const f32x4*)rq, pb_ = *(const f32x4*)(rq + 4); sq = ((pa_.x + pa_.y) + (pa_.z + pa_.w)) + ((pb_.x + pb_.y) + (pb_.z + pb_.w)); }
                else { const f32x4 pc_ = *(const f32x4*)(rq + 8); sq = (pc_.x + pc_.y) + (pc_.z + pc_.w); }
                const float rs = __builtin_amdgcn_rsqf(sq * inv + EPS) * (isq ? QS_B : 1.f);
                const int t = row & (T - 1);
                bf16* dst = QKVM + (size_t)row * LDM + cw;
                { f32x4 v0 = acc[ai][0][m][0] * rs, v1 = acc[ai][0][m][1] * rs;
                  if (rot0 && row < RL) rope8(v0, v1, tb + t * 16 + ((j0 - 64) >> 1), tb + T * 16 + t * 16 + ((j0 - 64) >> 1));
                  *(u32x4*)dst = pack8(v0, v1); }
                if (!u.quad) { f32x4 v0 = acc[ai][1][m][0] * rs, v1 = acc[ai][1][m][1] * rs;
                  if (rot1 && row < RL) rope8(v0, v1, tb + t * 16 + ((j1 - 64) >> 1), tb + T * 16 + t * 16 + ((j1 - 64) >> 1));
                  *(u32x4*)(dst + 128) = pack8(v0, v1); }
            }
    }
};
template <int MF> struct EpiOut {
    float* X; const float* MODl; float keep; const float* xlat; const float* xctx; int first;
    __device__ __forceinline__ void operator()(const f32x4 (&acc)[2][2][MF][2], const pg8::Unit& u, int wr, int wc, int fr, int fq) const {
        const float* xsrc = first ? (u.orow0 < RL ? xlat : xctx - (size_t)RL * D) : X;
#pragma unroll
        for (int ai = 0; ai < 2; ++ai)
#pragma unroll
            for (int m = 0; m < MF; ++m) {
                if (u.quad && ai) continue;
                const int row_ = EPI_ROWS(ai, m); const int mb = row_ < RL ? row_ >> 11 : 8;
                const float* g1 = MODl + (size_t)mb * 6144 + 2048;
#pragma unroll
                for (int bj = 0; bj < 2; ++bj) {
                    if (u.quad && bj) continue;
                    const int c0 = EPI_COL0(bj);
                    const f32x4 ga = *(const f32x4*)(g1 + c0) * keep, gb = *(const f32x4*)(g1 + c0 + 4) * keep;
                    float* xp = X + (size_t)row_ * D + c0; const float* xs = xsrc + (size_t)row_ * D + c0;
                    f32x4 xa = *(const f32x4*)xs, xb = *(const f32x4*)(xs + 4);
                    xa += ga * acc[ai][bj][m][0]; xb += gb * acc[ai][bj][m][1];
                    *(f32x4*)xp = xa; *(f32x4*)(xp + 4) = xb;
                }
            }
    }
};
template <int MF> struct EpiGU {
    bf16* HID;
    __device__ __forceinline__ void operator()(const f32x4 (&acc)[2][2][MF][2], const pg8::Unit& u, int wr, int wc, int fr, int fq) const {
#pragma unroll
        for (int bj = 0; bj < 2; ++bj) {
            if (u.quad && bj) continue;
            const int hc = EPI_COL0(bj) >> 1;
#pragma unroll
            for (int ai = 0; ai < 2; ++ai)
#pragma unroll
                for (int m = 0; m < MF; ++m) {
                    if (u.quad && ai) continue;
                    const f32x4 g = acc[ai][bj][m][0], up = acc[ai][bj][m][1];
                    u32x2 w; w.x = pk2(siluf(g.x) * up.x, siluf(g.y) * up.y); w.y = pk2(siluf(g.z) * up.z, siluf(g.w) * up.w);
                    *(u32x2*)(HID + (size_t)EPI_ROWS(ai, m) * DE + hc) = w;
                }
        }
    }
};
template <int MF> struct EpiDown {
    bf16* Y; const float* SGATE;
    __device__ __forceinline__ void operator()(const f32x4 (&acc)[2][2][MF][2], const pg8::Unit& u, int wr, int wc, int fr, int fq) const {
#pragma unroll
        for (int ai = 0; ai < 2; ++ai)
#pragma unroll
            for (int m = 0; m < MF; ++m) {
                if (u.quad && ai) continue;
                const int row = EPI_ROWS(ai, m); const float gt = SGATE[row];
#pragma unroll
                for (int bj = 0; bj < 2; ++bj)
                    if (!(u.quad && bj)) *(u32x4*)(Y + (size_t)row * D + EPI_COL0(bj)) = pack8(acc[ai][bj][m][0] * gt, acc[ai][bj][m][1] * gt);
            }
    }
};

constexpr int NWAVES = 8;
constexpr int RING_BYTES = 131072;
constexpr int LDSCTL_OFF = RING_BYTES, MISC_OFF = LDSCTL_OFF + 320;
constexpr int LDS_BYTES = 147456;
constexpr int CW_BAR = 4096;
typedef GAS unsigned gu32;

#define XB_TMO      128
#define XB_XCNT(j)  (256  + 64 * (j))
#define XB_XSUB(j)  (1280 + 64 * (j))
#define XB_XGEN(j)  (2304 + 64 * (j))
#define XB_TOP      3328
#define XB_TOPGEN   3392
#define XCD_BAR_WORDS 3456
#define XB_SPIN_CAP (1u << 18)
__device__ __forceinline__ unsigned xb_ld(unsigned* p)              { return __hip_atomic_load(p, __ATOMIC_RELAXED, __HIP_MEMORY_SCOPE_AGENT); }
__device__ __forceinline__ unsigned xb_add(unsigned* p, unsigned v) { return __hip_atomic_fetch_add(p, v, __ATOMIC_RELAXED, __HIP_MEMORY_SCOPE_AGENT); }
__device__ __forceinline__ unsigned xb_xcc_id() { return (unsigned)__builtin_amdgcn_s_getreg((3 << 11) | 20) & 0xFu; }
#define XB_SPIN(cond, bar) do { unsigned _sp = 0; while (cond) { __builtin_amdgcn_s_sleep(1); \
    if ((++_sp & 255u) == 0u) { if (xb_ld(&(bar)[XB_TMO])) break; if (_sp > XB_SPIN_CAP) { atomicAdd(&(bar)[XB_TMO], 1u); break; } } } } while (0)
struct XcdBarrier { unsigned* bar; unsigned x; volatile LAS unsigned* st; };
__device__ __forceinline__ XcdBarrier xcd_barrier_post(unsigned* bar, volatile LAS unsigned* st) {
    XcdBarrier b; b.bar = bar; b.x = xb_xcc_id(); b.st = st;
    if (threadIdx.x == 0) (void)xb_add(&bar[XB_XCNT(b.x)], 1u);
    return b;
}
__device__ __forceinline__ void xcd_barrier_complete(unsigned* bar, unsigned x, unsigned& nloc, unsigned& nx) {
    const unsigned G = gridDim.x * gridDim.y * gridDim.z;
    unsigned sum, cnt, mine, sp = 0u;
    for (;;) {
        sum = 0u; cnt = 0u; mine = 0u;
#pragma unroll
        for (unsigned j = 0; j < 16; ++j) { const unsigned c = xb_ld(&bar[XB_XCNT(j)]); sum += c; cnt += (c > 0u) ? 1u : 0u; mine = (j == x) ? c : mine; }
        if (sum == G) break;
        __builtin_amdgcn_s_sleep(1);
        if ((++sp & 255u) == 0u) { if (xb_ld(&bar[XB_TMO])) break; if (sp > XB_SPIN_CAP) { atomicAdd(&bar[XB_TMO], 1u); break; } }
    }
    nloc = mine > 0u ? mine : 1u; nx = cnt > 0u ? cnt : 1u;
}
__device__ __forceinline__ void xcd_barrier(const XcdBarrier& b, const int tid) {
    asm volatile("s_waitcnt vmcnt(0)" ::: "memory");
    __syncthreads();
    if (tid == 0) {
        unsigned* bar = b.bar;
        __builtin_amdgcn_s_waitcnt(0);
        unsigned nloc = b.st[0], nx = b.st[1];
        if (nloc == 0u) { xcd_barrier_complete(bar, b.x, nloc, nx); b.st[0] = nloc; b.st[1] = nx; }
        const unsigned old = xb_add(&bar[XB_XSUB(b.x)], 1u);
        const unsigned gen = old / nloc;
        if (old + 1u == (gen + 1u) * nloc) {
            __builtin_amdgcn_fence(__ATOMIC_RELEASE, "agent");
            asm volatile("s_waitcnt vmcnt(0)" ::: "memory");
            const unsigned og = xb_add(&bar[XB_TOP], 1u);
            const unsigned tg = og / nx;
            if (og + 1u == (tg + 1u) * nx) xb_add(&bar[XB_TOPGEN], 1u);
            else XB_SPIN(xb_ld(&bar[XB_TOPGEN]) == tg, bar);
            __builtin_amdgcn_fence(__ATOMIC_ACQUIRE, "agent");
            xb_add(&bar[XB_XGEN(b.x)], 1u);
            asm volatile("s_waitcnt vmcnt(0)" ::: "memory");
        } else {
            XB_SPIN(xb_ld(&bar[XB_XGEN(b.x)]) == gen, bar);
            __builtin_amdgcn_fence(__ATOMIC_ACQUIRE, "agent");
            asm volatile("s_waitcnt vmcnt(0)" ::: "memory");
        }
    }
    __syncthreads();
}

struct Frame { LAS unsigned char* lds; int tid, lane, wave, bid, G; const float* const* in; GAS float* out; GAS unsigned char* ws; };
#define IN_(k) ((const float*)(const GAS float*)F.in[(k)])
#define F_x IN_(0)
#define F_c IN_(1)
#define F_ctx IN_(2)
#define F_c_ctx IN_(3)
#define F_norm1 IN_(4)
#define F_norm2 IN_(5)
#define F_w_ada IN_(6)
#define F_b_ada IN_(7)
#define F_w_in IN_(8)
#define F_sink IN_(9)
#define F_mla_q_norm IN_(10)
#define F_w_uq IN_(11)
#define F_mla_kv_norm IN_(12)
#define F_w_ukv IN_(13)
#define F_lq1 IN_(14)
#define F_lk1 IN_(15)
#define F_lq2 IN_(16)
#define F_lk2 IN_(17)
#define F_diff_norm IN_(18)
#define F_w_out IN_(19)
#define F_w_router IN_(20)
#define F_w_gate IN_(21)
#define F_w_up IN_(22)
#define F_w_down IN_(23)
#define F_final_norm IN_(24)
#define F_MOD ((float*)(GAS float*)(F.ws + WS_MOD))
#define F_ROPE ((float*)(GAS float*)(F.ws + WS_ROPE))
#define F_RSQ ((float*)(GAS float*)(F.ws + WS_RSQ))
#define F_AFF ((float*)(GAS float*)(F.ws + WS_AFF))
#define F_INV ((int*)(GAS int*)(F.ws + WS_INV))
#define F_STOK ((int*)(GAS int*)(F.ws + WS_STOK))
#define F_SGATE ((float*)(GAS float*)(F.ws + WS_SGATE))
#define F_X ((float*)(GAS float*)(F.ws + WS_X))
#define F_ACT ((bf16*)(GAS bf16*)(F.ws + WS_ACT))
#define F_P ((bf16*)(GAS bf16*)(F.ws + WS_P))
#define F_Y ((bf16*)(GAS bf16*)(F.ws + WS_Y))
#define F_QKVM ((bf16*)(GAS bf16*)(F.ws + WS_QKVM))
#define F_O ((bf16*)(GAS bf16*)(F.ws + WS_O))
#define F_HID ((bf16*)(GAS bf16*)(F.ws + WS_HID))
#define F_WB ((bf16*)(GAS bf16*)(F.ws + WS_W))

__device__ __forceinline__ int rot64(int dp) { const int p = dp >> 1, half = dp & 1, axis = p >> 4, f = p & 15; return axis * 32 + half * 16 + f; }
__device__ __forceinline__ int rot32(int dp) { const int p = dp >> 1, half = dp & 1, axis = p >> 3, f = p & 7; return axis * 16 + half * 8 + f; }
__device__ __forceinline__ int src_col_in(int n) {
    if (n >= INW) return -1;
    if (n < P_AV) return (n & ~63) + rot64(n & 63);
    if (n >= P_KR && n < P_DV) return (n & ~31) + rot32(n & 31);
    return n;
}
__device__ __forceinline__ void prep_tile(const float* src, int N, int k0, const float* kscale, bf16* dst, int ldd, LAS float* scr, int lane) {
    float v[32];
#pragma unroll
    for (int i = 0; i < 32; ++i) { const int kk = 2 * i + (lane >> 5); v[i] = src ? src[(size_t)(k0 + kk) * N] : 0.f; }
    if (kscale) {
#pragma unroll
        for (int i = 0; i < 32; ++i) v[i] *= kscale[k0 + 2 * i + (lane >> 5)]; }
#pragma unroll
    for (int i = 0; i < 32; ++i) scr[(2 * i + (lane >> 5)) * 33 + (lane & 31)] = v[i];
    LDS_WAIT();
    const int c = lane & 7;
#pragma unroll
    for (int j = 0; j < 4; ++j) { const int n = (lane >> 3) + 8 * j; const LAS float* s = scr + (8 * c) * 33 + n;
        u32x4 o; o.x = pk2(s[0], s[33]); o.y = pk2(s[66], s[99]); o.z = pk2(s[132], s[165]); o.w = pk2(s[198], s[231]);
        *(u32x4*)(dst + (size_t)n * ldd + 8 * c) = o; }
    LDS_WAIT();
}
constexpr int PI_IN = 16 * 64, PI_UP = 6 * 32, PI_OUT = 16 * 32, PI_GU = NE * 16 * 32, PI_DN = NE * 8 * 32, PI_LAYER = PI_IN + PI_UP + PI_OUT + PI_GU + PI_DN;
#ifndef BG_PREP
#define BG_PREP 0
#endif
__device__ __forceinline__ void prep_layer(Frame& F, const int l, const int worker, const int nworkers) {
    const int lane = F.lane, wave = F.wave;
    LAS float* scr = (LAS float*)(F.lds + 57344 + wave * 8448);
    for (int it = worker; it < PI_LAYER; it += nworkers) {
        int r = it; bf16* wl = F_WB + (size_t)l * W_LAYER;
        const int nl = lane & 31;
        if (r < PI_IN) { const int kb = r / 64, nb = r % 64, n = nb * 32 + nl, sc = src_col_in(n);
            prep_tile(sc >= 0 ? F_w_in + (size_t)l * D * INW + sc : nullptr, INW, kb * 64, nullptr, wl + W_IN + (size_t)(nb * 32) * D + kb * 64, D, scr, lane); continue; } r -= PI_IN;
        if (r < PI_UP) { const int kb = r / 32, nb = r % 32, n = nb * 32 + nl, k0 = kb * 64; const float* src = nullptr; const float* ks = nullptr; int N = 384, ksrc = k0;
            if (n < 384 && k0 < 256) { const int h = n / 96, j = n % 96; const int sc = j < 64 ? n : h * 96 + 64 + rot32(j - 64); src = F_w_uq + (size_t)l * 256 * 384 + sc; ks = F_mla_q_norm + l * 256; N = 384; }
            else if (n >= 512 && k0 >= 256) { src = F_w_ukv + (size_t)l * 128 * 512 + (n - 512); ks = F_mla_kv_norm + l * 128; N = 512; ksrc = k0 - 256; }
            { float v[32];
#pragma unroll
              for (int i = 0; i < 32; ++i) { const int kk = 2 * i + (lane >> 5); v[i] = src ? src[(size_t)(ksrc + kk) * N] * ks[ksrc + kk] : 0.f; }
#pragma unroll
              for (int i = 0; i < 32; ++i) scr[(2 * i + (lane >> 5)) * 33 + (lane & 31)] = v[i];
              LDS_WAIT();
              const int c = lane & 7; bf16* dst = wl + W_UP + (size_t)(nb * 32) * UPK + k0;
#pragma unroll
              for (int j = 0; j < 4; ++j) { const int nn = (lane >> 3) + 8 * j; const LAS float* s = scr + (8 * c) * 33 + nn;
                  u32x4 o; o.x = pk2(s[0], s[33]); o.y = pk2(s[66], s[99]); o.z = pk2(s[132], s[165]); o.w = pk2(s[198], s[231]);
                  *(u32x4*)(dst + (size_t)nn * UPK + 8 * c) = o; }
              LDS_WAIT(); }
            continue; } r -= PI_UP;
        if (r < PI_OUT) { const int kb = r / 32, nb = r % 32;
            prep_tile(F_w_out + (size_t)l * D * D + nb * 32 + nl, D, kb * 64, nullptr, wl + W_OUT + (size_t)(nb * 32) * D + kb * 64, D, scr, lane); continue; } r -= PI_OUT;
        if (r < PI_GU) { const int e = r / 512, q = r % 512, kb = q / 32, nb = q % 32, n = nb * 32 + nl, f = (n >> 3) * 4 + (n & 3);
            const float* src = ((n & 4) ? F_w_up : F_w_gate) + ((size_t)l * NE + e) * D * DE + f;
            prep_tile(src, DE, kb * 64, nullptr, wl + W_GU + (size_t)e * 1024 * 1024 + (size_t)(nb * 32) * D + kb * 64, D, scr, lane); continue; } r -= PI_GU;
        { const int e = r / 256, q = r % 256, kb = q / 32, nb = q % 32;
            prep_tile(F_w_down + ((size_t)l * NE + e) * DE * D + nb * 32 + nl, D, kb * 64, nullptr, wl + W_DN + (size_t)e * 1024 * 512 + (size_t)(nb * 32) * DE + kb * 64, DE, scr, lane); }
    }
}

__device__ __forceinline__ void p0_phase(Frame& F) {
    const int tid = F.tid, lane = F.lane, wave = F.wave;
    {
        LAS float* sl = (LAS float*)F.lds;
        LAS float* red = (LAS float*)(F.lds + 36864);
        for (int i = tid; i < 9 * 1024; i += 512) { const float v = i < 8 * 1024 ? F_c[i] : F_c_ctx[i - 8 * 1024]; sl[i] = siluf(v); }
        __syncthreads();
        for (int it = F.bid; it < DEPTH * 96; it += F.G) {
            const int l = it / 96, cg = it % 96, col = cg * 64 + lane;
            float acc[9];
#pragma unroll
            for (int r = 0; r < 9; ++r) acc[r] = 0.f;
            const float* w = F_w_ada + (size_t)l * D * 6144 + (size_t)(wave * 128) * 6144 + col;
#pragma unroll 16
            for (int k = 0; k < 128; ++k) { const float wv = w[(size_t)k * 6144];
#pragma unroll
                for (int r = 0; r < 9; ++r) acc[r] += sl[r * 1024 + wave * 128 + k] * wv; }
#pragma unroll
            for (int r = 0; r < 9; ++r) red[(wave * 9 + r) * 64 + lane] = acc[r];
            __syncthreads();
            for (int o = tid; o < 576; o += 512) { const int r = o >> 6, cc = o & 63; float s = 0.f;
#pragma unroll
                for (int w8 = 0; w8 < 8; ++w8) s += red[(w8 * 9 + r) * 64 + cc];
                F_MOD[((size_t)l * 9 + r) * 6144 + cg * 64 + cc] = s + F_b_ada[l * 6144 + cg * 64 + cc]; }
            __syncthreads();
        }
    }
    const int gw = F.bid * NWAVES + wave, NGW = F.G * NWAVES;
    { const size_t n4 = (size_t)R * D / 4, nl4 = (size_t)RL * D / 4;
      for (size_t i = (size_t)F.bid * 512 + tid; i < n4; i += (size_t)F.G * 512) { const f32x4 v = i < nl4 ? ((const f32x4*)F_x)[i] : ((const f32x4*)F_ctx)[i - nl4]; ((f32x4*)F_X)[i] = v; } }
    for (int i = F.bid * 512 + tid; i < T * 48; i += F.G * 512) {
        const int t = i / 48, j = i % 48; int axis, f, nf;
        if (j < 32) { axis = j >> 4; f = j & 15; nf = 16; } else { axis = (j - 32) >> 3; f = (j - 32) & 7; nf = 8; }
        const float inv = exp2f(-(float)f / (float)nf * 13.287712379549449f);
        const float ang = (float)(axis == 0 ? (t >> 6) : (t & 63)) * inv;
        const float cv = cosf(ang), sv = sinf(ang);
        if (j < 32) { F_ROPE[t * 32 + j] = cv; F_ROPE[T * 32 + t * 32 + j] = sv; } else { F_ROPE[T * 64 + t * 16 + j - 32] = cv; F_ROPE[T * 64 + T * 16 + t * 16 + j - 32] = sv; }
    }
    for (int l = 0; l < (BG_PREP ? 1 : DEPTH); ++l) prep_layer(F, l, gw, NGW);
}

#ifndef PROBE_NOROUTER
#define PROBE_NOROUTER 0
#endif
#define half_swap_add(keepv, sendv, off) ((keepv) + shx((sendv), (off), lane))
__device__ __forceinline__ void norm_phase(Frame& F, int l, int mode, int nrows, const float keep) {
    const int lane = F.lane, gw = F.bid * NWAVES + F.wave, NGW = F.G * NWAVES;
    LAS float* wrT = (LAS float*)F.lds;
    if (mode == 1) {
        const float* wr = F_w_router + (size_t)l * D * NE;
        for (int i = F.tid; i < D * NE; i += 512) wrT[(i & 15) * 1028 + (i >> 4)] = wr[i];
        __syncthreads();
    }
    const float* gain = mode == 0 ? F_norm1 + (size_t)l * D : (mode == 1 ? F_norm2 + (size_t)l * D : F_final_norm);
    const bool comb = mode != 1 && l > 0;
    f32x4 vn[2][4];
#define NORM_LOAD(dst, rr0) do { _Pragma("unroll") for (int q = 0; q < 2; ++q) _Pragma("unroll") for (int j = 0; j < 4; ++j) dst[q][j] = ((const f32x4*)(F_X + (size_t)((rr0) + q) * D))[lane + 64 * j]; } while (0)
    if (gw * 2 < nrows) NORM_LOAD(vn, gw * 2);
    for (int r0 = gw * 2; r0 < nrows; r0 += NGW * 2) {
        const int mb = r0 < RL ? r0 / T : 8;
        f32x4 v[2][4];
#pragma unroll
        for (int q = 0; q < 2; ++q)
#pragma unroll
            for (int j = 0; j < 4; ++j) v[q][j] = vn[q][j];
        if (r0 + NGW * 2 < nrows) NORM_LOAD(vn, r0 + NGW * 2);
        if (comb) {
            const float* g2 = F_MOD + ((size_t)(l - 1) * 9 + mb) * 6144 + 5120;
            const int myinv = lane < 2 * NE ? F_INV[(size_t)r0 * NE + lane] : -1;
            f32x4 s[2][4];
#pragma unroll
            for (int q = 0; q < 2; ++q)
#pragma unroll
                for (int j = 0; j < 4; ++j) s[q][j] = (f32x4){0.f, 0.f, 0.f, 0.f};
            for (int e = 0; e < NE; ++e) {
#pragma unroll
                for (int q = 0; q < 2; ++q) { const int sl = shi(myinv, q * NE + e);
                    if (sl >= 0) { const bf16* yr = F_Y + (size_t)sl * D;
#pragma unroll
                        for (int j = 0; j < 4; ++j) { const u32x2 w = ((const u32x2*)yr)[lane + 64 * j];
                            s[q][j].x += bf2f(w.x & 0xffff); s[q][j].y += bf2f(w.x >> 16); s[q][j].z += bf2f(w.y & 0xffff); s[q][j].w += bf2f(w.y >> 16); } } } }
#pragma unroll
            for (int j = 0; j < 4; ++j) { const f32x4 g = ((const f32x4*)g2)[lane + 64 * j];
#pragma unroll
                for (int q = 0; q < 2; ++q) { v[q][j] += g * s[q][j] * keep; ((f32x4*)(F_X + (size_t)(r0 + q) * D))[lane + 64 * j] = v[q][j]; } }
        }
        float ss0 = 0.f, ss1 = 0.f;
#pragma unroll
        for (int j = 0; j < 4; ++j) { ss0 += (v[0][j].x * v[0][j].x + v[0][j].y * v[0][j].y) + (v[0][j].z * v[0][j].z + v[0][j].w * v[0][j].w);
                                      ss1 += (v[1][j].x * v[1][j].x + v[1][j].y * v[1][j].y) + (v[1][j].z * v[1][j].z + v[1][j].w * v[1][j].w); }
#pragma unroll
        for (int o = 1; o < 64; o <<= 1) { ss0 += shx(ss0, o, lane); ss1 += shx(ss1, o, lane); }
        const float rs[2] = {1.0f / sqrtf(ss0 * (1.f / D) + EPS), 1.0f / sqrtf(ss1 * (1.f / D) + EPS)};
        if (mode == 2) {
#pragma unroll
            for (int j = 0; j < 4; ++j) { const f32x4 g = ((const f32x4*)gain)[lane + 64 * j];
#pragma unroll
                for (int q = 0; q < 2; ++q) ((f32x4*)((float*)F.out + (size_t)(r0 + q) * D))[lane + 64 * j] = v[q][j] * rs[q] * g; }
        } else {
            const float* md = F_MOD + ((size_t)l * 9 + mb) * 6144 + (mode == 0 ? 0 : 3072);
#pragma unroll
            for (int j = 0; j < 4; ++j) { const f32x4 g = ((const f32x4*)gain)[lane + 64 * j];
                const f32x4 sh = ((const f32x4*)md)[lane + 64 * j], sc = ((const f32x4*)(md + 1024))[lane + 64 * j];
#pragma unroll
                for (int q = 0; q < 2; ++q) { v[q][j] = v[q][j] * rs[q] * g * (sc + 1.0f) + sh;
                    u32x2 w; w.x = pk2(v[q][j].x, v[q][j].y); w.y = pk2(v[q][j].z, v[q][j].w);
                    ((u32x2*)(F_ACT + (size_t)(r0 + q) * D))[lane + 64 * j] = w; } }
            if (mode == 1 && !(PROBE_NOROUTER && keep == 0.f)) {
                float a[2][NE];
                typedef float f32x2r __attribute__((ext_vector_type(2)));
#pragma unroll
                for (int e = 0; e < NE; ++e) { f32x2r p0 = {0.f, 0.f}, p1 = {0.f, 0.f};
#pragma unroll
                    for (int j = 0; j < 4; ++j) { const f32x4 w = *(const LAS f32x4*)(wrT + e * 1028 + 256 * j + 4 * lane);
                        const f32x2r wl = {w.x, w.y}, wh = {w.z, w.w};
                        p0 = __builtin_elementwise_fma((f32x2r){v[0][j].x, v[0][j].y}, wl, p0); p0 = __builtin_elementwise_fma((f32x2r){v[0][j].z, v[0][j].w}, wh, p0);
                        p1 = __builtin_elementwise_fma((f32x2r){v[1][j].x, v[1][j].y}, wl, p1); p1 = __builtin_elementwise_fma((f32x2r){v[1][j].z, v[1][j].w}, wh, p1); }
                    a[0][e] = p0.x + p0.y; a[1][e] = p1.x + p1.y; if ((e & 1) == 1) __builtin_amdgcn_sched_barrier(0); }
                float b16[NE];
#pragma unroll
                for (int e = 0; e < NE; ++e) { const bool up = lane >= 32; b16[e] = half_swap_add(up ? a[1][e] : a[0][e], up ? a[0][e] : a[1][e], 32); }
                float b8[8];
#pragma unroll
                for (int e = 0; e < 8; ++e) { const bool up = (lane & 16) != 0; b8[e] = half_swap_add(up ? b16[8 + e] : b16[e], up ? b16[e] : b16[8 + e], 16); }
                float b4[4];
#pragma unroll
                for (int e = 0; e < 4; ++e) { const bool up = (lane & 8) != 0; b4[e] = half_swap_add(up ? b8[4 + e] : b8[e], up ? b8[e] : b8[4 + e], 8); }
                float b2[2];
#pragma unroll
                for (int e = 0; e < 2; ++e) { const bool up = (lane & 4) != 0; b2[e] = half_swap_add(up ? b4[2 + e] : b4[e], up ? b4[e] : b4[2 + e], 4); }
                float lg; { const bool up = (lane & 2) != 0; lg = half_swap_add(up ? b2[1] : b2[0], up ? b2[0] : b2[1], 2); }
                lg += shx(lg, 1, lane);
                float mx = lg;
#pragma unroll
                for (int o = 2; o < 32; o <<= 1) mx = fmaxf(mx, shx(mx, o, lane));
                const float ex = __expf(lg - mx); float sum = ex;
#pragma unroll
                for (int o = 2; o < 32; o <<= 1) sum += shx(sum, o, lane);
                const int eidx = ((lane >> 4) & 1) * 8 + ((lane >> 3) & 1) * 4 + ((lane >> 2) & 1) * 2 + ((lane >> 1) & 1);
                if ((lane & 1) == 0) F_AFF[(size_t)(r0 + (lane >> 5)) * NE + eidx] = ex / sum;
            }
        }
    }
}

#undef NORM_LOAD
__device__ __forceinline__ void topk_phase(Frame& F, int nsets) {
    LAS unsigned* cnt = (LAS unsigned*)F.lds;
    const int tid = F.tid, lane = F.lane, wave = F.wave;
    for (int it = F.bid; it < nsets * NE; it += F.G) {
        const int set = it / NE, e = it % NE; const bool lat = set < 8; const int b = lat ? set : set - 8;
        const int n = lat ? T : LC, cap = lat ? CAPL : CAPC, row0 = lat ? b * T : RL + b * LC, slot0 = e * SLOTS_E + (lat ? b * CAPL : NB * CAPL + b * CAPC);
        unsigned v[4];
#pragma unroll
        for (int q = 0; q < 4; ++q) { const int idx = 4 * tid + q; v[q] = idx < n ? __builtin_bit_cast(unsigned, F_AFF[(size_t)(row0 + idx) * NE + e]) : 0u; }
        unsigned prefix = 0u; int par = 0;
        for (int bit = 30; bit >= 0; --bit) {
            const unsigned cand = prefix | (1u << bit);
            unsigned c = 0;
#pragma unroll
            for (int q = 0; q < 4; ++q) c += (unsigned)__popcll(__ballot(v[q] >= cand));
            if (lane == 0) cnt[par * 8 + wave] = c;
            __syncthreads();
            unsigned tot = 0;
#pragma unroll
            for (int w = 0; w < 8; ++w) tot += cnt[par * 8 + w];
            if (tot >= (unsigned)cap) prefix = cand;
            par ^= 1;
        }
        unsigned g4 = 0, e4 = 0;
#pragma unroll
        for (int q = 0; q < 4; ++q) { g4 += v[q] > prefix ? 1u : 0u; e4 += v[q] == prefix ? 1u : 0u; }
        unsigned pk = g4 | (e4 << 16), inc = pk;
#pragma unroll
        for (int o = 1; o < 64; o <<= 1) { const unsigned t = (unsigned)shi((int)inc, lane - o); if (lane >= o) inc += t; }
        __syncthreads();
        if (lane == 63) cnt[16 + wave] = inc;
        __syncthreads();
        unsigned base = 0, total = 0;
#pragma unroll
        for (int w = 0; w < 8; ++w) { const unsigned t = cnt[16 + w]; total += t; if (w < wave) base += t; }
        const unsigned excl = base + inc - pk;
        unsigned gpre = excl & 0xffffu, epre = excl >> 16; const unsigned need = (unsigned)cap - (total & 0xffffu);
#pragma unroll
        for (int q = 0; q < 4; ++q) { const int idx = 4 * tid + q;
            if (idx < n) { const bool isg = v[q] > prefix, ise = v[q] == prefix; const bool sel = isg || (ise && epre < need);
                const int slot = slot0 + (int)(gpre + (epre < need ? epre : need));
                if (sel) { F_STOK[slot] = row0 + idx; F_SGATE[slot] = __builtin_bit_cast(float, v[q]); }
                F_INV[(size_t)(row0 + idx) * NE + e] = sel ? slot : -1;
                gpre += isg ? 1u : 0u; epre += ise ? 1u : 0u; } }
        __syncthreads();
    }
}

#ifndef ATT_EXTRA
#define ATT_EXTRA 0
#define ATT_EXTRA_TYPE 0
#endif
#ifndef ATT_LATE_DMA
#define ATT_LATE_DMA 0
#endif
#ifndef ATT_STAGGER
#define ATT_STAGGER 1
#endif
#ifndef ATT_XVAR
#define ATT_XVAR 0
#endif
#ifndef ATT_XSTEPS
#define ATT_XSTEPS 4
#endif
namespace att {
typedef short s16x4 __attribute__((ext_vector_type(4)));
typedef float f32x2_t __attribute__((ext_vector_type(2)));
typedef __bf16 bf16x2_t __attribute__((ext_vector_type(2)));
constexpr int L_K = 0, KBUF = 16384, L_V = 2 * KBUF, VBUF = 8192, L_WS = L_V + 2 * VBUF, L_OST = L_WS + 8 * 256, L_END = L_OST + 8 * 4096;
#define ATT_SBAR() __builtin_amdgcn_sched_barrier(0)
#define ATT_SGB(mask, n) __builtin_amdgcn_sched_group_barrier(mask, n, 0)
__device__ __forceinline__ int crow(int r, int hi) { return (r & 3) + 8 * (r >> 2) + 4 * hi; }
__device__ __forceinline__ unsigned cvtpk(float lo, float hi) { f32x2_t v = {lo, hi}; bf16x2_t b = __builtin_convertvector(v, bf16x2_t); return __builtin_bit_cast(unsigned, b); }
__device__ __forceinline__ int v_st(int k, int c) { const int kk = k; return ((kk >> 3) * 2 + (c >> 5)) * 512 + ((kk & 7) * 32 + (c & 31)) * 2; }
__device__ __forceinline__ int v_rd_base(int lane) { return ((lane & 3) << 3) | (((lane >> 2) & 3) << 6) | (((lane >> 4) & 1) << 5) | (((lane >> 5) & 1) << 8); }
typedef short v4i16_t __attribute__((ext_vector_type(4)));
template <int OFF> __device__ __forceinline__ s16x4 tr_read(int vb) { s16x4 r; asm volatile("ds_read_b64_tr_b16 %0, %1 offset:%2" : "=&v"(r) : "v"(vb), "i"(OFF) : "memory"); return r; }
struct VFrag { s16x4 l0, h0, l1, h1, l2, h2, l3, h3; };
template <int D0> __device__ __forceinline__ void vread(VFrag& f, int vb) {
    f.l0 = tr_read<D0 * 512 + 0 * 2048>(vb); f.h0 = tr_read<D0 * 512 + 0 * 2048 + 1024>(vb); f.l1 = tr_read<D0 * 512 + 1 * 2048>(vb); f.h1 = tr_read<D0 * 512 + 1 * 2048 + 1024>(vb);
    f.l2 = tr_read<D0 * 512 + 2 * 2048>(vb); f.h2 = tr_read<D0 * 512 + 2 * 2048 + 1024>(vb); f.l3 = tr_read<D0 * 512 + 3 * 2048>(vb); f.h3 = tr_read<D0 * 512 + 3 * 2048 + 1024>(vb);
}
__device__ __forceinline__ void pv_mma(f32x16& od, const VFrag& f, bf16x8 pa0, bf16x8 pa1, bf16x8 pa2, bf16x8 pa3) {
#define ATT_PK(L, H) (bf16x8){L[0], L[1], L[2], L[3], H[0], H[1], H[2], H[3]}
    od = __builtin_amdgcn_mfma_f32_32x32x16_bf16(pa0, ATT_PK(f.l0, f.h0), od, 0, 0, 0);
    od = __builtin_amdgcn_mfma_f32_32x32x16_bf16(pa1, ATT_PK(f.l1, f.h1), od, 0, 0, 0);
    od = __builtin_amdgcn_mfma_f32_32x32x16_bf16(pa2, ATT_PK(f.l2, f.h2), od, 0, 0, 0);
    od = __builtin_amdgcn_mfma_f32_32x32x16_bf16(pa3, ATT_PK(f.l3, f.h3), od, 0, 0, 0);
#undef ATT_PK
}
template <int D0> __device__ __forceinline__ void pv_one(f32x16& od, int vb, bf16x8 pa0, bf16x8 pa1, bf16x8 pa2, bf16x8 pa3) {
    VFrag f; vread<D0>(f, vb); asm volatile("s_waitcnt lgkmcnt(0)" ::: "memory"); ATT_SBAR(); pv_mma(od, f, pa0, pa1, pa2, pa3);
}
struct Tensors { const bf16* P; const bf16* QKVM; bf16* O; const float* sink; const float* dnorm; float lam, lam_init; int l; };

constexpr float THR = 8.f;
__device__ __forceinline__ float rowmax32(const f32x16& p0, const f32x16& p1) {
    float a = fmaxf(fmaxf(p0[0], p0[1]), p1[0]), b = fmaxf(fmaxf(p0[2], p0[3]), p1[1]); a = fmaxf(fmaxf(a, p1[2]), p1[3]);
#pragma unroll
    for (int r = 4; r < 16; r += 4) { a = fmaxf(fmaxf(a, p0[r]), p0[r + 1]); b = fmaxf(fmaxf(b, p0[r + 2]), p0[r + 3]); a = fmaxf(fmaxf(a, p1[r]), p1[r + 1]); b = fmaxf(fmaxf(b, p1[r + 2]), p1[r + 3]); }
    float m = fmaxf(a, b);
    auto rr = __builtin_amdgcn_permlane32_swap(__float_as_uint(m), __float_as_uint(m), false, false);
    return fmaxf(__uint_as_float(rr[0]), __uint_as_float(rr[1]));
}
__device__ __forceinline__ void partialSM(f32x16& p0, f32x16& p1, const float rm, float& mhat, f32x16& negm, float& alpha) {
    alpha = 1.f;
    if (__builtin_expect(__any(rm > THR), 0)) {
        const float dl = fmaxf(rm, 0.f); mhat += dl;
#pragma unroll
        for (int r = 0; r < 16; ++r) { p0[r] -= dl; p1[r] -= dl; }
#pragma unroll
        for (int r = 0; r < 16; ++r) negm[r] = -mhat;
        asm volatile("" : "+v"(negm));
        alpha = __builtin_amdgcn_exp2f(-dl);
    }
}
__device__ __forceinline__ void finishSM(f32x16& p0, f32x16& p1, const float alpha, float& l_reg, bf16x8& pa0, bf16x8& pa1, bf16x8& pa2, bf16x8& pa3) {
#pragma unroll
    for (int r = 0; r < 16; ++r) { p0[r] = __builtin_amdgcn_exp2f(p0[r]); p1[r] = __builtin_amdgcn_exp2f(p1[r]); }
    float ps = 0.f, pt = 0.f;
#pragma unroll
    for (int r = 0; r < 16; ++r) { ps += p0[r]; pt += p1[r]; }
    l_reg = l_reg * alpha + (ps + pt);
#define ATT_PK8(P, BASE, OUT) do { u32x4 w = {cvtpk(P[BASE + 0], P[BASE + 1]), cvtpk(P[BASE + 2], P[BASE + 3]), cvtpk(P[BASE + 4], P[BASE + 5]), cvtpk(P[BASE + 6], P[BASE + 7])}; OUT = __builtin_bit_cast(bf16x8, w); } while (0)
    ATT_PK8(p0, 0, pa0); ATT_PK8(p0, 8, pa1); ATT_PK8(p1, 0, pa2); ATT_PK8(p1, 8, pa3);
#undef ATT_PK8
}
template <int ROWB> __device__ __forceinline__ int kswz(int row, int cb) { return row * ROWB + (ROWB == 128 ? (cb ^ (((row >> 1) & 7) << 4)) : (cb ^ ((row & 15) << 4))); }
template <int NB, int ROWB, int CB0, int D00> __device__ __forceinline__ void kread(bf16x8 (&kf)[2 * NB], const LAS unsigned char* Kb, int r32, int hi) {
#pragma unroll
    for (int d = 0; d < NB; ++d) { const int cb = CB0 + ((D00 + d) * 16 + hi * 8) * 2;
        kf[2 * d] = *(const LAS bf16x8*)(Kb + kswz<ROWB>(r32, cb)); kf[2 * d + 1] = *(const LAS bf16x8*)(Kb + kswz<ROWB>(32 + r32, cb)); }
}
template <int NB, int D00> __device__ __forceinline__ void kmma(f32x16& p0, f32x16& p1, const bf16x8 (&kf)[2 * NB], const bf16x8* qr, const f32x16& negm) {
#pragma unroll
    for (int d = 0; d < NB; ++d) {
        if (D00 + d == 0) { p0 = __builtin_amdgcn_mfma_f32_32x32x16_bf16(kf[0], qr[0], negm, 0, 0, 0); p1 = __builtin_amdgcn_mfma_f32_32x32x16_bf16(kf[1], qr[0], negm, 0, 0, 0); }
        else { p0 = __builtin_amdgcn_mfma_f32_32x32x16_bf16(kf[2 * d], qr[D00 + d], p0, 0, 0, 0); p1 = __builtin_amdgcn_mfma_f32_32x32x16_bf16(kf[2 * d + 1], qr[D00 + d], p1, 0, 0, 0); } }
}
template <int NKS, int ROWB, int CB0> __device__ __forceinline__ void qkt2(f32x16& p0, f32x16& p1, const LAS unsigned char* Kb, const bf16x8* qr, const f32x16& negm, int r32, int hi) {
    constexpr int N1 = NKS > 4 ? 3 : NKS, N2 = NKS - N1;
    bf16x8 ka[2 * N1]; kread<N1, ROWB, CB0, 0>(ka, Kb, r32, hi);
    if constexpr (N2 > 0) { bf16x8 kb[2 * N2]; kread<N2, ROWB, CB0, N1>(kb, Kb, r32, hi);
        kmma<N1, 0>(p0, p1, ka, qr, negm); kmma<N2, N1>(p0, p1, kb, qr, negm); }
    else kmma<N1, 0>(p0, p1, ka, qr, negm);
}

template <int TYPE> struct Ring { static constexpr int KSLOT = TYPE == 1 ? 16384 : 8192, VSLOT = 8192, L_K = 0, L_V = 3 * KSLOT, L_WS = L_V + 4 * VSLOT, L_OST = L_WS + 2048; };
template <int TYPE, int CB0> __device__ __forceinline__ void flash_pass(const Tensors& Tn, LAS unsigned char* lds, const int tid, const int b, const int h, const bool lat, const int q0, const int var, const bf16x8* qr,
                                                                        f32x16 (&o)[2], float& l_out, float& m_out) {
    constexpr int NKS = TYPE == 0 ? 4 : (TYPE == 1 ? 6 : 2);
    constexpr int ROWB = TYPE == 1 ? 256 : 128;
    typedef Ring<TYPE> RG;
    const int lane = tid & 63, wid = __builtin_amdgcn_readfirstlane(tid >> 6), r32 = lane & 31, hi = lane >> 5;
    LAS float* al_l = (LAS float*)(lds + RG::L_WS) + wid * 64;
    const int kvh = h >> 2;
    const bf16* Kp = TYPE == 0 ? Tn.P + P_AK + kvh * 64 : (TYPE == 1 ? Tn.QKVM + 512 + h * 128 : Tn.P + P_DK + h * 64);
    const bf16* Vp = TYPE == 0 ? Tn.P + P_AV + kvh * 64 : (TYPE == 1 ? Tn.QKVM + 512 + h * 128 + 64 : Tn.P + P_DV + h * 64);
    constexpr int KPITCH = TYPE == 1 ? LDM : LDP;
    int kl0 = 0, nloc = 0;
    if (lat) { if (TYPE == 0) { kl0 = q0 - 128 < 0 ? 0 : q0 - 128; const int kl1 = q0 + 256 + 128 > T ? T : q0 + 256 + 128; nloc = (kl1 - kl0) >> 6; } else { kl0 = 0; nloc = T / 64; } }
    const int NT = 4 + nloc;
    const int crow0 = RL + b * LC, lrow0 = b * T + kl0;
#define ATT_TROW(i) ((var & 64) ? crow0 : ((i) < 4 ? crow0 + 64 * (i) : lrow0 + 64 * ((i) - 4)))
    const bf16* ksrc0; const bf16* ksrc1 = nullptr;
    if (TYPE != 1) { const int row = 8 * wid + (lane >> 3), c = (lane & 7) ^ ((row >> 1) & 7); ksrc0 = Kp + (size_t)row * KPITCH + c * 8; }
    else {
        { const int row = 8 * wid + (lane >> 4), c = (lane & 15) ^ (row & 15); ksrc0 = c < 8 ? Kp + (size_t)row * LDM + c * 8 : (c < 12 ? Tn.P + (size_t)row * LDP + P_KR + (c - 8) * 8 : Kp + (size_t)row * LDM); }
        { const int row = 8 * wid + 4 + (lane >> 4), c = (lane & 15) ^ (row & 15); ksrc1 = c < 8 ? Kp + (size_t)row * LDM + c * 8 : (c < 12 ? Tn.P + (size_t)row * LDP + P_KR + (c - 8) * 8 : Kp + (size_t)row * LDM); }
    }
    const bool k0p = TYPE == 1 && (((lane & 15) ^ ((8 * wid + (lane >> 4)) & 15)) >= 8) && (((lane & 15) ^ ((8 * wid + (lane >> 4)) & 15)) < 12);
    const bool k1p = TYPE == 1 && (((lane & 15) ^ ((8 * wid + 4 + (lane >> 4)) & 15)) >= 8) && (((lane & 15) ^ ((8 * wid + 4 + (lane >> 4)) & 15)) < 12);
    const bf16* vsrc = Vp + (size_t)(8 * wid + ((lane & 31) >> 2)) * KPITCH + (lane >> 5) * 32 + (lane & 3) * 8;
#define ATT_DMA_K(i, slot) do { if (var & 8) break; const int g_ = ATT_TROW((i) < NT ? (i) : NT - 1); \
        __builtin_amdgcn_global_load_lds((const unsigned*)(ksrc0 + (size_t)g_ * (k0p ? LDP : KPITCH)), (LAS unsigned*)(lds + RG::L_K + (slot) * RG::KSLOT + wid * (ROWB * 8)), 16, 0, 0); \
        if (TYPE == 1) __builtin_amdgcn_global_load_lds((const unsigned*)(ksrc1 + (size_t)g_ * (k1p ? LDP : KPITCH)), (LAS unsigned*)(lds + RG::L_K + (slot) * RG::KSLOT + wid * (ROWB * 8) + 1024), 16, 0, 0); } while (0)
#define ATT_DMA_V(i, slot) do { if (var & 8) break; const int g_ = ATT_TROW((i) < NT ? (i) : NT - 1); \
        __builtin_amdgcn_global_load_lds((const unsigned*)(vsrc + (size_t)g_ * KPITCH), (LAS unsigned*)(lds + RG::L_V + (slot) * RG::VSLOT + wid * 1024), 16, 0, 0); } while (0)
#define ATT_WAITBAR() do { if (var & 16) break; if (TYPE == 1) asm volatile("s_waitcnt vmcnt(3)" ::: "memory"); else asm volatile("s_waitcnt vmcnt(2)" ::: "memory"); __builtin_amdgcn_s_barrier(); asm volatile("" ::: "memory"); } while (0)
#define ATT_RESC(a) do { if (__any((a) < 1.f)) { if (hi == 0) al_l[r32] = (a); asm volatile("s_waitcnt lgkmcnt(0)" ::: "memory"); \
        _Pragma("unroll") for (int r = 0; r < 16; ++r) { const float f_ = al_l[crow(r, hi)]; o[0][r] *= f_; o[1][r] *= f_; } } } while (0)
    const int qpos = q0 + wid * 32 + r32;
#define ATT_MASK(P0, P1, i) do { if (TYPE == 0) { const int kt0_ = kl0 + 64 * ((i) - 4) - qpos, lo_ = (i) >= 4 ? -128 : -(1 << 28), hi_ = (i) >= 4 ? 128 : (1 << 28); \
        _Pragma("unroll") for (int r = 0; r < 16; ++r) { const int k0_ = kt0_ + crow(r, hi); P0[r] = (k0_ < lo_ || k0_ > hi_) ? -1e30f : P0[r]; P1[r] = (k0_ + 32 < lo_ || k0_ + 32 > hi_) ? -1e30f : P1[r]; } } } while (0)
    const int vb0 = (int)(uintptr_t)(lds + RG::L_V) + v_rd_base(lane);
    const LAS unsigned char* Kr = lds + RG::L_K;
    float mhat = 0.f, l_reg = 0.f; f32x16 negm = f32x16{};
    int sp = 2, sc = 0;
#define ATT_ROT() do { const int t_ = sp; sp = sc; sc = (sc == 2 ? 0 : sc + 1); (void)t_; } while (0)
    const bool lag = ATT_STAGGER && wid >= 4;
    f32x16 p0 = f32x16{}, p1 = f32x16{}; bf16x8 pa0 = bf16x8{}, pa1 = bf16x8{}, pa2 = bf16x8{}, pa3 = bf16x8{};
#define ATT_SOFT(t, FIRST) do { ATT_MASK(p0, p1, t); float rm_ = rowmax32(p0, p1); float alpha_ = 1.f; \
        if (FIRST) { mhat = rm_; _Pragma("unroll") for (int r = 0; r < 16; ++r) { p0[r] -= rm_; p1[r] -= rm_; negm[r] = -rm_; } asm volatile("" : "+v"(negm)); } \
        else if (__builtin_expect(__any(rm_ > THR), 0)) { const float dl = fmaxf(rm_, 0.f); mhat += dl; \
            _Pragma("unroll") for (int r = 0; r < 16; ++r) { p0[r] -= dl; p1[r] -= dl; negm[r] = -mhat; } asm volatile("" : "+v"(negm)); \
            alpha_ = __builtin_amdgcn_exp2f(-dl); ATT_RESC(alpha_); } \
        finishSM(p0, p1, alpha_, l_reg, pa0, pa1, pa2, pa3); } while (0)
#define ATT_STEP(t) do { \
        if (lag || !ATT_LATE_DMA) { ATT_DMA_K((t) + 2, sp); ATT_DMA_V((t) + 1, ((t) + 1) & 3); } \
        { bf16x8 kf_[2 * NKS]; att::VFrag va_, vb_; const int vbt_ = vb0 + (((t) - 1) & 3) * RG::VSLOT; \
          kread<NKS, ROWB, CB0, 0>(kf_, Kr + sc * RG::KSLOT, r32, hi); vread<0>(va_, vbt_); \
          asm volatile("s_waitcnt lgkmcnt(0)" ::: "memory"); ATT_SBAR(); \
          kmma<NKS, 0>(p0, p1, kf_, qr, negm); ATT_SBAR(); \
          vread<1>(vb_, vbt_); ATT_SBAR(); \
          pv_mma(o[0], va_, pa0, pa1, pa2, pa3); \
          asm volatile("s_waitcnt lgkmcnt(0)" ::: "memory"); ATT_SBAR(); \
          pv_mma(o[1], vb_, pa0, pa1, pa2, pa3); } \
        asm volatile("" : "+v"(p0), "+v"(p1), "+v"(o[0]), "+v"(o[1])); \
        if (lag) ATT_WAITBAR(); \
        if (!lag && ATT_LATE_DMA) { ATT_DMA_K((t) + 2, sp); ATT_DMA_V((t) + 1, ((t) + 1) & 3); }     \
        ATT_SOFT(t, false); \
        asm volatile("" : "+v"(pa0), "+v"(pa1), "+v"(pa2), "+v"(pa3), "+v"(l_reg)); \
        if (!lag) ATT_WAITBAR(); ATT_ROT(); } while (0)
    ATT_DMA_K(0, 0); ATT_DMA_V(0, 0); ATT_DMA_K(1, 1);
    asm volatile("s_waitcnt vmcnt(0)" ::: "memory"); __builtin_amdgcn_s_barrier(); asm volatile("" ::: "memory");
    { ATT_DMA_K(2, 2); ATT_DMA_V(1, 1);
      qkt2<NKS, ROWB, CB0>(p0, p1, Kr, qr, negm, r32, hi);
      asm volatile("" : "+v"(p0), "+v"(p1));
      if (lag) ATT_WAITBAR();
      ATT_SOFT(0, true);
      asm volatile("" : "+v"(pa0), "+v"(pa1), "+v"(pa2), "+v"(pa3), "+v"(l_reg));
      if (!lag) ATT_WAITBAR(); ATT_ROT(); }
    for (int j = 1; j < ((var & 32) ? ATT_XSTEPS : NT); ++j) ATT_STEP(j);
    pv_one<0>(o[0], vb0 + ((NT - 1) & 3) * RG::VSLOT, pa0, pa1, pa2, pa3); pv_one<1>(o[1], vb0 + ((NT - 1) & 3) * RG::VSLOT, pa0, pa1, pa2, pa3);
    asm volatile("s_waitcnt vmcnt(0)" ::: "memory"); __builtin_amdgcn_s_barrier(); asm volatile("" ::: "memory");
#undef ATT_SOFT
    { auto rr = __builtin_amdgcn_permlane32_swap(__float_as_uint(l_reg), __float_as_uint(l_reg), false, false); l_reg = __uint_as_float(rr[0]) + __uint_as_float(rr[1]); }
    l_out = l_reg; m_out = mhat;
#undef ATT_TROW
#undef ATT_DMA_K
#undef ATT_DMA_V
#undef ATT_WAITBAR
#undef ATT_RESC
#undef ATT_MASK
#undef ATT_ROT
#undef ATT_STEP
}

template <int TYPE> __device__ __forceinline__ void unit(const Tensors& Tn, LAS unsigned char* lds, const int tid, const int b, const int h, const bool lat, const int q0, const int var) {
    constexpr int NKS = TYPE == 0 ? 4 : (TYPE == 1 ? 6 : 2);
    const int lane = tid & 63, wid = __builtin_amdgcn_readfirstlane(tid >> 6), r32 = lane & 31, hi = lane >> 5;
    typedef Ring<TYPE> RG;
    LAS float* wsf = (LAS float*)(lds + RG::L_WS) + wid * 64;
    const int qrow0 = (lat ? b * T + q0 : RL + b * LC) + wid * 32;
    bf16x8 qr[TYPE == 2 ? 4 : NKS];
    { const bf16* qp = TYPE == 0 ? Tn.P + (size_t)(qrow0 + r32) * LDP + P_AQ + h * 64 : (TYPE == 1 ? Tn.QKVM + (size_t)(qrow0 + r32) * LDM + h * 96 : Tn.P + (size_t)(qrow0 + r32) * LDP + P_DQ + h * 64);
#pragma unroll
      for (int d0 = 0; d0 < (TYPE == 2 ? 4 : NKS); ++d0) qr[d0] = *(const bf16x8*)(qp + d0 * 16 + hi * 8); }
    f32x16 oA[2] = {f32x16{}, f32x16{}}; float l0, m0;
    flash_pass<TYPE, 0>(Tn, lds, tid, b, h, lat, q0, var, qr, oA, l0, m0);
    f32x16 oB[2] = {f32x16{}, f32x16{}}; float l1 = 1.f, m1 = 0.f;
    LAS float* stash = (LAS float*)(lds + RG::L_OST + wid * 8192);
    if (TYPE == 2) {
#pragma unroll
        for (int r = 0; r < 16; ++r) { stash[r * 64 + lane] = oA[0][r]; stash[(16 + r) * 64 + lane] = oA[1][r]; }
        flash_pass<TYPE, 64>(Tn, lds, tid, b, h, lat, q0, var, qr + 2, oB, l1, m1);
#pragma unroll
        for (int r = 0; r < 16; ++r) { oA[0][r] = stash[r * 64 + lane]; oA[1][r] = stash[(16 + r) * 64 + lane]; }
        asm volatile("s_waitcnt lgkmcnt(0)" ::: "memory");
    }
    if (TYPE == 0) l0 += __builtin_amdgcn_exp2f(Tn.sink[Tn.l * 8 + h] * 1.4426950408889634f - m0);
    if (hi == 0) { wsf[r32] = l0; if (TYPE == 2) wsf[32 + r32] = l1; }
    asm volatile("s_waitcnt lgkmcnt(0)" ::: "memory");
    LAS bf16* stg = (LAS bf16*)(lds + RG::L_OST + wid * (TYPE == 2 ? 8192 : 4096));
    if (TYPE != 2) {
#pragma unroll
        for (int r = 0; r < 16; ++r) { const float rl = __builtin_amdgcn_rcpf(wsf[crow(r, hi)]); const int orow = crow(r, hi);
            stg[orow * 64 + r32] = (bf16)f2bf(oA[0][r] * rl); stg[orow * 64 + 32 + r32] = (bf16)f2bf(oA[1][r] * rl); }
    } else {
        const float g0 = Tn.dnorm[Tn.l * 64 + r32], g1 = Tn.dnorm[Tn.l * 64 + 32 + r32];
#pragma unroll
        for (int r = 0; r < 16; ++r) { const float rl0 = __builtin_amdgcn_rcpf(wsf[crow(r, hi)]), rl1 = Tn.lam * __builtin_amdgcn_rcpf(wsf[32 + crow(r, hi)]);
            const float a0 = oA[0][r] * rl0 - oB[0][r] * rl1, a1 = oA[1][r] * rl0 - oB[1][r] * rl1;
            float ss = a0 * a0 + a1 * a1;
#pragma unroll
            for (int o_ = 1; o_ < 32; o_ <<= 1) ss += shx(ss, o_, lane);
            const float rs = (1.f - Tn.lam_init) * __builtin_amdgcn_rsqf(ss * (1.f / 64.f) + EPS); const int orow = crow(r, hi);
            stg[orow * 64 + r32] = (bf16)f2bf(a0 * rs * g0); stg[orow * 64 + 32 + r32] = (bf16)f2bf(a1 * rs * g1); }
    }
    asm volatile("s_waitcnt lgkmcnt(0)" ::: "memory");
    { bf16* Ow = Tn.O + (size_t)qrow0 * D + (TYPE == 0 ? h * 64 : (TYPE == 1 ? 512 + h * 64 : 768 + h * 64));
#pragma unroll
      for (int i = 0; i < 4; ++i) { const int row = i * 8 + (lane >> 3), ch = lane & 7; *(u32x4*)(Ow + (size_t)row * D + ch * 8) = *(const LAS u32x4*)(stg + row * 64 + ch * 8); } }
    asm volatile("s_waitcnt lgkmcnt(0)" ::: "memory"); __builtin_amdgcn_s_barrier(); asm volatile("" ::: "memory");
}
}

__device__ __forceinline__ void attn_phase(Frame& F, const int l, const bool need_ctx) {
    att::Tensors Tn; Tn.P = F_P; Tn.QKVM = F_QKVM; Tn.O = F_O; Tn.sink = F_sink; Tn.dnorm = F_diff_norm; Tn.l = l;
    { float s1 = 0.f, s2 = 0.f;
      if (F.lane < 32) { s1 = F_lq1[l * 32 + F.lane] * F_lk1[l * 32 + F.lane]; s2 = F_lq2[l * 32 + F.lane] * F_lk2[l * 32 + F.lane]; }
      s1 = wave_sum(s1, F.lane); s2 = wave_sum(s2, F.lane);
      int ll_ = l; asm volatile("" : "+s"(ll_));
      const float li_ = ll_ == 0 ? 0.200000000f : (ll_ == 1 ? 0.355509068f : (ll_ == 2 ? 0.470713018f : 0.556058204f));
      const float lm_ = __expf(s1) - __expf(s2) + li_;
      Tn.lam_init = li_; Tn.lam = __builtin_bit_cast(float, __builtin_amdgcn_readfirstlane(__builtin_bit_cast(int, lm_))); }
    const int b = F.bid & 7, j = F.bid >> 3;
    if (F.G != 256) return;
    const int nu = (need_ctx && j < 16) ? 5 : 4;
    for (int u = 0; u < nu + ATT_EXTRA; ++u) {
        int type, h, q0; bool lat = true; const int var = u >= nu ? ATT_XVAR : 0;
        if (u >= nu) { type = ATT_EXTRA_TYPE; h = (j >> 3); q0 = (j & 7) * 256; Tn.O = F_ACT; }
        else if (u == 0) { type = 2; h = j >> 3; q0 = (j & 7) * 256; }
        else if (u == 1) { type = 1; h = j >> 3; q0 = (j & 7) * 256; }
        else if (u < 4) { type = 0; h = j >> 2; q0 = (j & 3) * 512 + (u - 2) * 256; }
        else { lat = false; q0 = 0; if (j < 8) { type = 0; h = j; } else if (j < 12) { type = 1; h = j - 8; } else { type = 2; h = j - 12; } }
        int t_ = F.tid; asm volatile("" : "+v"(t_));
        if (type == 0) att::unit<0>(Tn, F.lds, t_, b, h, lat, q0, var);
        else if (type == 1) att::unit<1>(Tn, F.lds, t_, b, h, lat, q0, var);
        else att::unit<2>(Tn, F.lds, t_, b, h, lat, q0, var);
    }
}

enum { PH_P0 = 0, PH_L0 = 1, PH_PER_LAYER = 9, PH_FINAL = PH_L0 + DEPTH * PH_PER_LAYER, NPH = PH_FINAL + 1 };
enum { SP_NORM1 = 0, SP_INPROJ = 1, SP_UP = 2, SP_ATTN = 3, SP_OUT = 4, SP_NORM2 = 5, SP_TOPK = 6, SP_MOE1 = 7, SP_MOE2 = 8 };

#ifndef REPS_INIT
#define REPS_INIT {1, 1, 1, 1, 1, 1, 1, 1, 1}
#endif
#ifndef REP_P0
#define REP_P0 1
#endif
#ifndef REP_FINAL
#define REP_FINAL 1
#endif
#ifndef KROT_ON
#define KROT_ON 0
#endif
#ifndef PROBE_NOMMA
#define PROBE_NOMMA 0
#endif
#ifndef PHMASK
#define PHMASK 0x3ff
#endif
#define PHON(b) ((PHMASK >> (b)) & 1)
#define REPSEL(s) ((s) == 0 ? reps_sp[0] : (s) == 1 ? reps_sp[1] : (s) == 2 ? reps_sp[2] : (s) == 3 ? reps_sp[3] : (s) == 4 ? reps_sp[4] : (s) == 5 ? reps_sp[5] : (s) == 6 ? reps_sp[6] : (s) == 7 ? reps_sp[7] : reps_sp[8])
__global__ void __launch_bounds__(NWAVES * 64, 2) mk(Args args) {
    extern __shared__ __attribute__((aligned(16))) unsigned char lds_raw[];
    Frame F;
    F.lds = (LAS unsigned char*)lds_raw;
    F.tid = threadIdx.x; F.lane = F.tid & 63; F.wave = __builtin_amdgcn_readfirstlane(F.tid >> 6); F.bid = blockIdx.x; F.G = gridDim.x;
    const int wave_s = F.wave;
    F.in = (const float* const*)args.in; F.out = (GAS float*)args.out; F.ws = (GAS unsigned char*)args.ws;
    volatile LAS unsigned* MISC = (volatile LAS unsigned*)(F.lds + MISC_OFF);
    for (int u = F.tid; u < (LDS_BYTES - LDSCTL_OFF) / 4; u += NWAVES * 64) ((LAS unsigned*)(F.lds + LDSCTL_OFF))[u] = 0u;
    __syncthreads();
    XcdBarrier bar = xcd_barrier_post((unsigned*)(args.ws + WS_CTL) + CW_BAR + args.li * XCD_BAR_WORDS, MISC + 8);
    const int gx = F.bid & 7, gj = F.bid >> 3, gpx = F.G >> 3, krot = KROT_ON ? (gj & 7) + 3 * (gj >> 3) : 0;
    constexpr int reps_sp[9] = REPS_INIT;
    for (int ph = args.ph_lo; ph < args.ph_hi; ++ph) {
      const int nrep = ph == PH_P0 ? REP_P0 : (ph == PH_FINAL ? REP_FINAL : (REPSEL((ph - PH_L0) % PH_PER_LAYER)));
      for (int rep = 0; rep < nrep; ++rep) {
        const float keep = rep + 1 == nrep ? 1.f : 0.f;
        { unsigned char* w_ = args.ws; asm volatile("" : "+s"(w_)); F.ws = (GAS unsigned char*)w_; int z_ = 0; asm volatile("" : "+s"(z_)); F.in = (const float* const*)args.in + z_;
          int l_; asm volatile("v_mbcnt_lo_u32_b32 %0, -1, 0\n\tv_mbcnt_hi_u32_b32 %0, -1, %0" : "=v"(l_));
          int w_s = wave_s; asm volatile("" : "+s"(w_s)); F.lane = l_; F.wave = w_s; F.tid = w_s * 64 + l_; }
        if (ph == PH_P0) { if (PHON(9)) p0_phase(F); }
        else if (ph == PH_FINAL) { if (PHON(0)) norm_phase(F, DEPTH, 2, RL, keep); }
        else {
            const int l = (ph - PH_L0) / PH_PER_LAYER, sp = (ph - PH_L0) % PH_PER_LAYER;
            const bool need_ctx = l < DEPTH - 1; const int rows_mix = need_ctx ? R : RL;
            const bf16* wl = F_WB + (size_t)l * W_LAYER;
            if (sp == SP_NORM1) { if (PHON(0)) norm_phase(F, l, 0, R, keep); }
            else if (sp == SP_INPROJ && PHON(1)) {
                pg8::Gemm g{F_ACT, wl + W_IN, nullptr, 0, D, D}; OrderRows S{gx, gj, gpx, R / 192 / 8, LDP / 256, (PROBE_NOMMA && rep + 1 < nrep) ? 1 : 0, krot, 192};
                EpiInProj<3> E{F_P, F_ROPE, F_RSQ};
                pg8::gemm_phase<false, 3>(F.lds, F.tid, g, S, E);
                { const int nbusy = 8;
                  if (BG_PREP && l + 1 < DEPTH && rep + 1 == nrep && gj >= nbusy) prep_layer(F, l + 1, ((gx * (gpx - nbusy) + (gj - nbusy)) * NWAVES) + F.wave, 8 * (gpx - nbusy) * NWAVES); }
            } else if (sp == SP_UP && PHON(2)) {
                pg8::Gemm g{F_P + P_CQ, wl + W_UP, nullptr, 0, LDP, UPK}; OrderRows S{gx, gj, gpx, R / 192 / 8, 4, 0, krot, 192};
                EpiUp<3> E{F_QKVM, F_ROPE, F_RSQ};
                pg8::gemm_phase<false, 3>(F.lds, F.tid, g, S, E);
            } else if (sp == SP_ATTN) { if (PHON(3)) attn_phase(F, l, need_ctx);
            } else if (sp == SP_OUT && PHON(4)) {
                pg8::Gemm g{F_O, wl + W_OUT, nullptr, 0, D, D};
                if (need_ctx) { OrderRows S{gx, gj, gpx, R / 192 / 8, 4, 0, krot, 192}; EpiOut<3> E{F_X, F_MOD + (size_t)l * 9 * 6144, keep, F_x, F_ctx, 0}; pg8::gemm_phase<false, 3>(F.lds, F.tid, g, S, E); }
                else { OrderRows S{gx, gj, gpx, RL / 256 / 8, 4, 0, krot, 256}; EpiOut<4> E{F_X, F_MOD + (size_t)l * 9 * 6144, keep, F_x, F_ctx, 0}; pg8::gemm_phase<false, 4>(F.lds, F.tid, g, S, E); }
            } else if (sp == SP_NORM2) { if (PHON(5)) norm_phase(F, l, 1, rows_mix, keep); }
            else if (sp == SP_TOPK) { if (PHON(6)) topk_phase(F, need_ctx ? 16 : 8); }
            else if (sp == SP_MOE1 && PHON(7)) {
                pg8::Gemm g{F_ACT, wl + W_GU, F_STOK, (size_t)1024 * 1024, D, D};
                if (need_ctx) { OrderMoe S{gx, gj, gpx, 12, 4, krot, 192}; EpiGU<3> E{F_HID}; pg8::gemm_phase<true, 3>(F.lds, F.tid, g, S, E); }
                else { OrderMoe S{gx, gj, gpx, 8, 4, krot, 256}; EpiGU<4> E{F_HID}; pg8::gemm_phase<true, 4>(F.lds, F.tid, g, S, E); }
            } else if (sp == SP_MOE2 && PHON(8)) {
                pg8::Gemm g{F_HID, wl + W_DN, nullptr, (size_t)1024 * 512, DE, DE};
                if (need_ctx) { OrderMoe S{gx, gj, gpx, 12, 4, krot, 192}; EpiDown<3> E{F_Y, F_SGATE}; pg8::gemm_phase<false, 3>(F.lds, F.tid, g, S, E); }
                else { OrderMoe S{gx, gj, gpx, 8, 4, krot, 256}; EpiDown<4> E{F_Y, F_SGATE}; pg8::gemm_phase<false, 4>(F.lds, F.tid, g, S, E); }
            }
        }
        if (ph + 1 < args.ph_hi || rep + 1 < nrep) { xcd_barrier(bar, F.tid);
#ifdef EXTRA_BAR
            xcd_barrier(bar, F.tid);
#endif
        }
      }
    }
}

extern "C" void kernel_launch(void* const* d_in, const int* in_sizes, int n_in, void* d_out, int out_size, void* d_ws, size_t ws_size, hipStream_t stream) {
    static int grid = 0;
    if (grid == 0) {
        if (n_in != 25 || ws_size < WS_END || out_size != RL * D) { fprintf(stderr, "kernel_launch: unexpected shapes (n_in %d, ws %zu < %zu, out %d)\n", n_in, ws_size, (size_t)WS_END, out_size); grid = -1; return; }
        int dev = 0, cus = 0, per_cu = 0;
        if (hipGetDevice(&dev) != hipSuccess || hipDeviceGetAttribute(&cus, hipDeviceAttributeMultiprocessorCount, dev) != hipSuccess) { grid = -1; return; }
        if (hipFuncSetAttribute((const void*)mk, hipFuncAttributeMaxDynamicSharedMemorySize, LDS_BYTES) != hipSuccess) { fprintf(stderr, "kernel_launch: hipFuncSetAttribute failed\n"); grid = -1; return; }
        if (hipOccupancyMaxActiveBlocksPerMultiprocessor(&per_cu, (const void*)mk, NWAVES * 64, LDS_BYTES) != hipSuccess || per_cu < 1) { fprintf(stderr, "kernel_launch: occupancy query says %d\n", per_cu); }
        (void)hipGetLastError();
        grid = cus;
        if (grid % 8 != 0) { fprintf(stderr, "kernel_launch: %d CUs, expected a multiple of 8\n", grid); grid = -1; return; }
    }
    if (grid < 0) return;
    (void)hipMemsetAsync((char*)d_ws + WS_CTL, 0, CTL_ZERO_BYTES, stream);
    Args a; memset(&a, 0, sizeof a);
    for (int i = 0; i < 25; ++i) a.in[i] = (const float*)d_in[i];
    a.out = (float*)d_out; a.ws = (unsigned char*)d_ws;
    a.ph_lo = 0; a.ph_hi = NPH; a.li = 0;
    hipLaunchKernelGGL(mk, dim3(grid), dim3(NWAVES * 64), LDS_BYTES, stream, a);
}
```

```cpp
#include <hip/hip_runtime.h>
#include <stdint.h>
#include <string.h>
#include <stdio.h>

typedef unsigned short bf16;
typedef unsigned u32x4 __attribute__((ext_vector_type(4)));
typedef unsigned u32x2 __attribute__((ext_vector_type(2)));
typedef float f32x4 __attribute__((ext_vector_type(4)));
typedef float f32x16 __attribute__((ext_vector_type(16)));
typedef short bf16x8 __attribute__((ext_vector_type(8)));
#define LAS __attribute__((address_space(3)))
#define GAS __attribute__((address_space(1)))

constexpr int D = 1024, NB = 8, T = 2048, LC = 256, DEPTH = 4;
constexpr int RL = NB * T, RC = NB * LC, R = RL + RC;
constexpr int INW = 1952, LDP = 2048;
constexpr int NE = 16, DE = 512;
constexpr int CAPL = 256, CAPC = 32;
constexpr int SLOTS_E = NB * CAPL + NB * CAPC;
constexpr int SLOTS = NE * SLOTS_E;
constexpr float EPS = 1e-6f;
constexpr int P_AQ = 0, P_AK = 512, P_AV = 640, P_CQ = 768, P_CKV = 1024, P_KR = 1152, P_DQ = 1184, P_DK = 1440, P_DV = 1696;
constexpr int LDM = 1024;
constexpr int UPK = 384;

constexpr size_t MiB = 1u << 20;
constexpr size_t WS_CTL = 0;
constexpr size_t CTL_ZERO_BYTES = 256 * 1024;
constexpr size_t WS_MOD = 1 * MiB;
constexpr size_t WS_ROPE = 2 * MiB;
constexpr size_t WS_RSQ = 3 * MiB;
constexpr size_t WS_AFF = 4 * MiB;
constexpr size_t WS_INV = 6 * MiB;
constexpr size_t WS_STOK = 8 * MiB;
constexpr size_t WS_SGATE = 9 * MiB;
constexpr size_t WS_X = 10 * MiB;
constexpr size_t WS_ACT = 82 * MiB;
constexpr size_t WS_P = 118 * MiB;
constexpr size_t WS_Y = WS_P;
constexpr size_t WS_QKVM = 190 * MiB;
constexpr size_t WS_O = 226 * MiB;
constexpr size_t WS_HID = WS_O;
constexpr size_t WS_W = 262 * MiB;
constexpr size_t W_IN = 0;
constexpr size_t W_UP = W_IN + (size_t)LDP * D;
constexpr size_t W_OUT = W_UP + (size_t)1024 * UPK;
constexpr size_t W_GU = W_OUT + (size_t)D * D;
constexpr size_t W_DN = W_GU + (size_t)NE * 1024 * 1024;
constexpr size_t W_LAYER = W_DN + (size_t)NE * 1024 * 512;
constexpr size_t WS_END = WS_W + (size_t)DEPTH * W_LAYER * 2;

__device__ __forceinline__ unsigned f2bf(float f) { unsigned u = __builtin_bit_cast(unsigned, f); return (u + 0x7fffu + ((u >> 16) & 1u)) >> 16; }
__device__ __forceinline__ float bf2f(unsigned h) { return __builtin_bit_cast(float, h << 16); }
__device__ __forceinline__ unsigned pk2(float lo, float hi) { return f2bf(lo) | (f2bf(hi) << 16); }
__device__ __forceinline__ float shx(float v, int o, int lane) { return __builtin_bit_cast(float, __builtin_amdgcn_ds_bpermute((lane ^ o) << 2, __builtin_bit_cast(int, v))); }
__device__ __forceinline__ int shi(int v, int src) { return __builtin_amdgcn_ds_bpermute(src << 2, v); }
__device__ __forceinline__ float wave_sum(float v, int lane) {
#pragma unroll
    for (int o = 1; o < 64; o <<= 1) v += shx(v, o, lane);
    return v;
}
__device__ __forceinline__ float siluf(float v) { return v / (1.f + __expf(-v)); }
#define LDS_WAIT() asm volatile("s_waitcnt lgkmcnt(0)" ::: "memory")
#define VM_WAIT() asm volatile("s_waitcnt vmcnt(0)" ::: "memory")

struct Args {
    const float* in[25]; float* out; unsigned char* ws; int ph_lo, ph_hi, li, pad;
};

#ifndef PROBE_HOT
#define PROBE_HOT 0
#endif
#ifndef PROBE_NOLDS
#define PROBE_NOLDS 0
#endif
#ifndef GEMM_ASKIP
#define GEMM_ASKIP 0
#endif
namespace pg8 {
constexpr int BM = 256, BK = 64, HALF = 128, HTB = HALF * BK * 2  , STAGE_BYTES = 8 * HTB;
__host__ __device__ __forceinline__ int lds_byte(int r, int c) { const int st = (r >> 4) * 2 + (c >> 5), rr = r & 15, cc = c & 31, ob = rr * 64 + cc * 2; return st * 1024 + (ob ^ (((ob >> 9) & 1) << 5)); }
__host__ __device__ __forceinline__ void stage_rc(int b, int& R, int& C) { const int st = b / 1024, sb = b % 1024, swz = sb ^ (((sb >> 9) & 1) << 5); R = (st >> 1) * 16 + swz / 64; C = (st & 1) * 32 + (swz % 64) / 2; }
__host__ __device__ __forceinline__ int perm32(int rho) { const int n = rho >> 4, i = rho & 15; return 8 * (i >> 2) + 4 * n + (i & 3); }

struct Unit { int arow0, orow0, col0, e, quad; };
struct Gemm { const bf16* A; const bf16* Bt; const int* gather; size_t b_estride; int lda, K; };

template <bool GATHER, int MF, class Epi, class Sched>
__device__ __forceinline__ void gemm_phase(LAS unsigned char* lds, const int tid, const Gemm g, const Sched& S, const Epi& E) {
    const int wid = __builtin_amdgcn_readfirstlane(tid >> 6), lane = tid & 63, wr = wid >> 2, wc = wid & 3, fr = lane & 15, fq = lane >> 4;
    constexpr bool ASKIP = (MF == 3) && GEMM_ASKIP;
    constexpr int HR = 32 * MF;
    const int K = g.K, nt = K / BK;
    unsigned voffA[2], voffB[2]; int sR[2];
#pragma unroll
    for (int i = 0; i < 2; ++i) { int C_; stage_rc(tid * 16 + i * 8192, sR[i], C_); const int Rb = (sR[i] & ~31) + perm32(sR[i] & 31);
        voffA[i] = GATHER ? (unsigned)C_ * 2u : (unsigned)(sR[i] * g.lda + C_) * 2u; voffB[i] = (unsigned)(Rb * K + C_) * 2u; }
    const unsigned lda2 = (unsigned)g.lda * 2u;
    const unsigned hstepA = (unsigned)HR * g.lda * 2u;
    const unsigned kstep = (unsigned)(BK * 2);
    const int krot = (2 * S.rot) % nt;
#define PG8_KT(i) ((PROBE_HOT && hot_) ? 0u : (unsigned)(((i) + krot) >= nt ? (i) + krot - nt : (i) + krot) * kstep)
    const unsigned hstepB = (unsigned)HALF * K * 2u;
    const __amdgpu_buffer_rsrc_t rsA = __builtin_amdgcn_make_buffer_rsrc((void*)g.A, 0, 0x7fffffff, 0x00020000);
    const __amdgpu_buffer_rsrc_t rsB = __builtin_amdgcn_make_buffer_rsrc((void*)g.Bt, 0, 0x7fffffff, 0x00020000);
    const unsigned ldsw = (unsigned)wid * 1024u;
    const int aoff = lds_byte(wr * (16 * MF) + fr, fq * 8), boff = lds_byte(wc * 32 + fr, fq * 8);
#define PG8_SA(b, h) (((b) * 2 + (h)) * HTB)
#define PG8_SB(b, h) ((4 + (b) * 2 + (h)) * HTB)
#define PG8_STAGE2(bufoff, rsrc, v0, v1, soff) do { \
        __builtin_amdgcn_raw_ptr_buffer_load_lds(rsrc, (LAS unsigned*)(lds + (bufoff) + ldsw), 16, (int)(v0), (int)(soff), 0, 0); \
        __builtin_amdgcn_raw_ptr_buffer_load_lds(rsrc, (LAS unsigned*)(lds + (bufoff) + ldsw + 8192), 16, (int)(v1), (int)(soff), 0, 0); } while (0)
#define PG8_STAGEB(bufoff, soff) PG8_STAGE2(bufoff, rsB, voffB[0], voffB[1], soff)
#define PG8_STAGE1(bufoff, rsrc, v0, soff) __builtin_amdgcn_raw_ptr_buffer_load_lds(rsrc, (LAS unsigned*)(lds + (bufoff) + ldsw), 16, (int)(v0), (int)(soff), 0, 0)
#define PG8_STAGEA(bufoff, ubase, r0, r1, h, koff) do { if constexpr (GATHER) { \
        if (ASKIP && wr == 1) PG8_STAGE1(bufoff, rsA, (((r0) >> (16 * (h))) & 0xffffu) * lda2 + voffA[0], (koff)); \
        else PG8_STAGE2(bufoff, rsA, (((r0) >> (16 * (h))) & 0xffffu) * lda2 + voffA[0], (((r1) >> (16 * (h))) & 0xffffu) * lda2 + voffA[1], (koff)); } \
        else { if (ASKIP && wr == 1) PG8_STAGE1(bufoff, rsA, voffA[0], (ubase) + (h) * hstepA + (koff)); \
        else PG8_STAGE2(bufoff, rsA, voffA[0], voffA[1], (ubase) + (h) * hstepA + (koff)); } } while (0)
#define PG8_LDA(dst, b, h) do { if (PROBE_NOLDS && hot_) break; _Pragma("unroll") for (int m = 0; m < MF; ++m) _Pragma("unroll") for (int k = 0; k < 2; ++k) dst[m][k] = *(const LAS bf16x8*)(lds + PG8_SA(b, h) + aoff + m * 2048 + k * 1024); } while (0)
#define PG8_LDB(dst, b, h) do { if (PROBE_NOLDS && hot_) break; _Pragma("unroll") for (int n = 0; n < 2; ++n) _Pragma("unroll") for (int k = 0; k < 2; ++k) dst[n][k] = *(const LAS bf16x8*)(lds + PG8_SB(b, h) + boff + n * 2048 + k * 1024); } while (0)
#define PG8_MMA(ai, bj, At, Bt) do { __builtin_amdgcn_s_setprio(1); _Pragma("unroll") for (int m = 0; m < MF; ++m) _Pragma("unroll") for (int n = 0; n < 2; ++n) _Pragma("unroll") for (int k = 0; k < 2; ++k) \
        acc[ai][bj][m][n] = __builtin_amdgcn_mfma_f32_16x16x32_bf16(Bt[n][k], At[m][k], acc[ai][bj][m][n], 0, 0, 0); __builtin_amdgcn_s_setprio(0); } while (0)
#define PG8_WAIT_V(n) asm volatile("s_waitcnt vmcnt(" #n ")" ::: "memory")
#define PG8_WAIT_V2(n, nskip) do { if (ASKIP && wr == 1) PG8_WAIT_V(nskip); else PG8_WAIT_V(n); } while (0)
#define PG8_WAIT_L(n) asm volatile("s_waitcnt lgkmcnt(" #n ")" ::: "memory")
#define PG8_BAR __builtin_amdgcn_s_barrier()
#define PG8_SCHED __builtin_amdgcn_sched_barrier(0)
#define PG8_ROWS(dst, u) do { if constexpr (GATHER) { _Pragma("unroll") for (int i = 0; i < 2; ++i) { \
        const int sr_ = sR[i] < HR ? sR[i] : sR[i] - 32;     \
        const unsigned a_ = (unsigned)g.gather[(u).arow0 + sr_], b_ = (unsigned)g.gather[(u).arow0 + ((u).quad ? 0 : HR) + sr_]; dst[i] = a_ | (b_ << 16); } \
        asm volatile("" : "+v"(dst[0]), "+v"(dst[1])); } } while (0)
    Unit cur, nxt; int ui = 0;
    if (!S.next(0, cur)) return;
    const bool hot_ = cur.quad == 2;
    f32x4 acc[2][2][MF][2];
#pragma unroll
    for (int a = 0; a < 2; ++a)
#pragma unroll
        for (int b = 0; b < 2; ++b)
#pragma unroll
            for (int m = 0; m < MF; ++m)
#pragma unroll
                for (int n = 0; n < 2; ++n) acc[a][b][m][n] = (f32x4){0.f, 0.f, 0.f, 0.f};
    bf16x8 At[MF][2], B0[2][2], B1[2][2];
    unsigned rp[2] = {0u, 0u}, rn[2] = {0u, 0u};
    PG8_ROWS(rp, cur);
    unsigned cA = (unsigned)cur.arow0 * lda2;
    unsigned cB = (unsigned)(((size_t)cur.e * g.b_estride + (size_t)cur.col0 * K) * 2);
    PG8_STAGEB(PG8_SB(0, 0), cB + PG8_KT(0)); PG8_STAGEB(PG8_SB(0, 1), cB + hstepB + PG8_KT(0)); PG8_STAGEA(PG8_SA(0, 0), cA, rp[0], rp[1], 0, PG8_KT(0)); PG8_STAGEA(PG8_SA(0, 1), cA, rp[0], rp[1], 1, PG8_KT(0));
    if (wr == 1) PG8_BAR;
    PG8_WAIT_V2(2, 1); PG8_BAR;
    PG8_STAGEB(PG8_SB(1, 0), cB + PG8_KT(1)); PG8_STAGEA(PG8_SA(1, 0), cA, rp[0], rp[1], 0, PG8_KT(1)); PG8_STAGEB(PG8_SB(1, 1), cB + hstepB + PG8_KT(1));
    PG8_WAIT_V2(6, 5); PG8_BAR;
    for (;;) {
        const bool has_next = S.next(ui + 1, nxt);
        if (has_next) { PG8_ROWS(rn, nxt); } else { rn[0] = rp[0]; rn[1] = rp[1]; }
        const unsigned nA = has_next ? (unsigned)nxt.arow0 * lda2 : cA;
        const unsigned nB = has_next ? (unsigned)(((size_t)nxt.e * g.b_estride + (size_t)nxt.col0 * K) * 2) : cB;
#pragma unroll 1
        for (int t = 0; t < nt; t += 2) {
            const bool last = (t == nt - 2);
            const unsigned k1 = PG8_KT(t + 1), k2 = last ? PG8_KT(0) : PG8_KT(t + 2), k3 = last ? PG8_KT(1) : PG8_KT(t + 3);
            const unsigned u2 = last ? nA : cA; const unsigned b2 = (last ? nB : cB) + k2; const unsigned b3 = (last ? nB : cB) + k3;
            const unsigned q0 = last ? rn[0] : rp[0], q1 = last ? rn[1] : rp[1];
            PG8_LDB(B0, 0, 0); PG8_LDB(B1, 0, 1); PG8_SCHED; PG8_LDA(At, 0, 0); PG8_STAGEA(PG8_SA(1, 1), cA, rp[0], rp[1], 1, k1);
            PG8_WAIT_V2(8, 6); PG8_WAIT_L(0); PG8_BAR; if (cur.quad < 2) PG8_MMA(0, 0, At, B0); if (!cur.quad) PG8_MMA(0, 1, At, B1); PG8_BAR; PG8_SCHED;
            PG8_LDA(At, 0, 1); PG8_STAGEB(PG8_SB(0, 0), b2); PG8_STAGEB(PG8_SB(0, 1), b2 + hstepB); PG8_STAGEA(PG8_SA(0, 0), u2, q0, q1, 0, k2);
            PG8_WAIT_V2(8, 6); PG8_WAIT_L(0); PG8_BAR; if (!cur.quad) { PG8_MMA(1, 0, At, B0); PG8_MMA(1, 1, At, B1); } PG8_BAR; PG8_SCHED;
            PG8_LDB(B0, 1, 0); PG8_LDB(B1, 1, 1); PG8_SCHED; PG8_LDA(At, 1, 0); PG8_STAGEA(PG8_SA(0, 1), u2, q0, q1, 1, k2);
            PG8_WAIT_V2(8, 6); PG8_WAIT_L(0); PG8_BAR; if (cur.quad < 2) PG8_MMA(0, 0, At, B0); if (!cur.quad) PG8_MMA(0, 1, At, B1); PG8_BAR; PG8_SCHED;
            PG8_LDA(At, 1, 1); PG8_STAGEB(PG8_SB(1, 0), b3); PG8_STAGEB(PG8_SB(1, 1), b3 + hstepB); PG8_STAGEA(PG8_SA(1, 0), u2, q0, q1, 0, k3);
            PG8_WAIT_V2(8, 6); PG8_WAIT_L(0); PG8_BAR; if (!cur.quad) { PG8_MMA(1, 0, At, B0); PG8_MMA(1, 1, At, B1); } PG8_BAR; PG8_SCHED;
        }
        if (wr == 0) PG8_BAR;
        E(acc, cur, wr, wc, fr, fq);
        if (!has_next) break;
#pragma unroll
        for (int a = 0; a < 2; ++a)
#pragma unroll
            for (int b = 0; b < 2; ++b)
#pragma unroll
                for (int m = 0; m < MF; ++m)
#pragma unroll
                    for (int n = 0; n < 2; ++n) acc[a][b][m][n] = (f32x4){0.f, 0.f, 0.f, 0.f};
        cur = nxt; cB = nB; cA = nA; ++ui; rp[0] = rn[0]; rp[1] = rn[1];
        if (wr == 1) PG8_BAR;
    }
    PG8_WAIT_V(0);
    PG8_BAR;
#undef PG8_SA
#undef PG8_SB
#undef PG8_STAGE2
#undef PG8_STAGEB
#undef PG8_LDA
#undef PG8_LDB
#undef PG8_MMA
#undef PG8_WAIT_V
#undef PG8_WAIT_V2
#undef PG8_STAGE1
#undef PG8_WAIT_L
#undef PG8_BAR
#undef PG8_SCHED
#undef PG8_KT
#undef PG8_ROWS
#undef PG8_STAGEA
}
}

#ifndef QUAD_SPLIT
#define QUAD_SPLIT 1
#endif
__device__ __forceinline__ bool deal(int i, int j, int gpx, int U, int& unit, int& quad) {
    const int q = i * gpx + j, nfull = (U / gpx) * gpx, left = U - nfull;
    if (q < nfull || left * 4 > gpx || !QUAD_SPLIT) { if (q >= U) return false; unit = q; quad = -1; return true; }
    const int s_ = q - nfull; if (s_ >= left * 4) return false; unit = nfull + (s_ >> 2); quad = s_ & 3; return true;
}
struct OrderRows {
    int x, j, gpx, rpx, nN, nomma, rot, TR;
    __device__ __forceinline__ bool next(int i, pg8::Unit& u) const {
        int q, quad; if (!deal(i, j, gpx, rpx * nN, q, quad)) return false;
        const int pm = x * rpx + q / nN, pn = q % nN; u.arow0 = pm * TR; u.col0 = pn * 256; u.e = 0; u.quad = quad >= 0;
        if (quad >= 0) { u.arow0 += (quad >> 1) * (TR / 2); u.col0 += (quad & 1) * 128; }
        if (nomma) u.quad = 2;
        u.orow0 = u.arow0; return true; }
};
struct OrderMoe {
    int x, j, gpx, nME, nN, rot, TR;
    __device__ __forceinline__ bool next(int i, pg8::Unit& u) const {
        int q, quad; const int per = nME * nN; if (!deal(i, j, gpx, 2 * per, q, quad)) return false;
        const int e = 2 * x + q / per, rem = q % per, pmE = rem / nN, pn = rem % nN;
        u.arow0 = e * SLOTS_E + pmE * TR; u.col0 = pn * 256; u.e = e; u.quad = quad >= 0;
        if (quad >= 0) { u.arow0 += (quad >> 1) * (TR / 2); u.col0 += (quad & 1) * 128; }
        u.orow0 = u.arow0; return true; }
};

constexpr float QS_A = 0.125f * 1.4426950408889634f, QS_B = 0.10206207261596577f * 1.4426950408889634f, QS_C = 0.17677669529663687f * 1.4426950408889634f;
typedef float f32x4e __attribute__((ext_vector_type(4)));
#define EPI_ROWS(ai, m) (u.orow0 + (ai) * (32 * MF) + wr * (16 * MF) + (m) * 16 + fr)
#define EPI_COL0(bj) (u.col0 + (bj) * 128 + wc * 32 + 8 * fq)
__device__ __forceinline__ void rope8(f32x4& v0, f32x4& v1, const float* cs, const float* sn) {
    const f32x4 c = *(const f32x4*)cs, s = *(const f32x4*)sn;
    f32x4 a = v0, b = v1;
    v0.x = a.x * c.x - a.y * s.x; v0.y = a.y * c.x + a.x * s.x; v0.z = a.z * c.y - a.w * s.y; v0.w = a.w * c.y + a.z * s.y;
    v1.x = b.x * c.z - b.y * s.z; v1.y = b.y * c.z + b.x * s.z; v1.z = b.z * c.w - b.w * s.w; v1.w = b.w * c.w + b.z * s.w;
}
__device__ __forceinline__ u32x4 pack8(const f32x4 v0, const f32x4 v1) { u32x4 w; w.x = pk2(v0.x, v0.y); w.y = pk2(v0.z, v0.w); w.z = pk2(v1.x, v1.y); w.w = pk2(v1.z, v1.w); return w; }

template <int MF> struct EpiInProj {
    bf16* P; const float* rope; float* RSQ;
    __device__ __forceinline__ void operator()(const f32x4 (&acc)[2][2][MF][2], const pg8::Unit& u, int wr, int wc, int fr, int fq) const {
#pragma unroll
        for (int bj = 0; bj < 2; ++bj) {
            if (u.quad && bj) continue;
            const int c0 = EPI_COL0(bj);
            const bool secA = c0 < P_AV, secB = c0 >= P_KR && c0 < P_DV;
            const int which = (c0 >= P_CQ && c0 < P_CKV) ? 0 : ((c0 >= P_CKV && c0 < P_KR) ? 1 : -1);
            const int p0 = secA ? ((c0 & 63) >> 1) : ((c0 & 31) >> 1);
            const float qs = c0 < P_AK ? QS_A : ((c0 >= P_DQ && c0 < P_DK) ? QS_C : 1.f);
#pragma unroll
            for (int ai = 0; ai < 2; ++ai)
#pragma unroll
                for (int m = 0; m < MF; ++m) {
                    if (u.quad && ai) continue;
                    const int row = EPI_ROWS(ai, m);
                    f32x4 v0 = acc[ai][bj][m][0] * qs, v1 = acc[ai][bj][m][1] * qs;
                    if (row < RL && (secA || secB)) { const int t = row & (T - 1);
                        const float* cs = secA ? rope + t * 32 + p0 : rope + T * 64 + t * 16 + p0;
                        const float* sn = secA ? rope + T * 32 + t * 32 + p0 : rope + T * 64 + T * 16 + t * 16 + p0;
                        rope8(v0, v1, cs, sn); }
                    if (which >= 0) { float s = (v0.x * v0.x + v0.y * v0.y) + (v0.z * v0.z + v0.w * v0.w) + (v1.x * v1.x + v1.y * v1.y) + (v1.z * v1.z + v1.w * v1.w);
                        { const int ln_ = fq * 16 + fr; s += shx(s, 16, ln_); s += shx(s, 32, ln_); }
                        if (fq == 0) RSQ[(size_t)row * 12 + ((c0 - P_CQ) >> 5)] = s; }
                    *(u32x4*)(P + (size_t)row * LDP + c0) = pack8(v0, v1);
                }
        }
    }
};
template <int MF> struct EpiUp {
    bf16* QKVM; const float* rope; const float* RSQ;
    __device__ __forceinline__ void operator()(const f32x4 (&acc)[2][2][MF][2], const pg8::Unit& u, int wr, int wc, int fr, int fq) const {
        const bool isq = u.col0 < 512;
        const float inv = isq ? (1.f / 256.f) : (1.f / 128.f);
        const int cw = u.col0 + wc * 32 + 8 * fq;
        int j0 = cw; j0 -= j0 >= 192 ? 192 : 0; j0 -= j0 >= 96 ? 96 : 0;
        int j1 = j0 + 32; j1 -= j1 >= 96 ? 96 : 0;
        const bool rot0 = isq && cw < 384 && j0 >= 64, rot1 = isq && cw + 128 < 384 && j1 >= 64;
        const float* tb = rope + T * 64;
#pragma unroll
        for (int ai = 0; ai < 2; ++ai)
#pragma unroll
            for (int m = 0; m < MF; ++m) {
                if (u.quad && ai) continue;
                const int row = EPI_ROWS(ai, m);
                const float* rq = RSQ + (size_t)row * 12; float sq;
                if (isq) { const f32x4 pa_ = *(const f32x4*)rq, pb_ = *(const f32x4*)(rq + 4); sq = ((pa_.x + pa_.y) + (pa_.z + pa_.w)) + ((pb_.x + pb_.y) + (pb_.z + pb_.w)); }
                else { const f32x4 pc_ = *(const f32x4*)(rq + 8); sq = (pc_.x + pc_.y) + (pc_.z + pc_.w); }
                const float rs = __builtin_amdgcn_rsqf(sq * inv + EPS) * (isq ? QS_B : 1.f);
                const int t = row & (T - 1);
                bf16* dst = QKVM + (size_t)row * LDM + cw;
                { f32x4 v0 = acc[ai][0][m][0] * rs, v1 = acc[ai][0][m][1] * rs;
                  if (rot0 && row < RL) rope8(v0, v1, tb + t * 16 + ((j0 - 64) >> 1), tb + T * 16 + t * 16 + ((j0 - 64) >> 1));
                  *(u32x4*)dst = pack8(v0, v1); }
                if (!u.quad) { f32x4 v0 = acc[ai][1][m][0] * rs, v1 = acc[ai][1][m][1] * rs;
                  if (rot1 && row < RL) rope8(v0, v1, tb + t * 16 + ((j1 - 64) >> 1), tb + T * 16 + t * 16 + ((j1 - 64) >> 1));
                  *(u32x4*)(dst + 128) = pack8(v0, v1); }
            }
    }
};
template <int MF> struct EpiOut {
    float* X; const float* MODl; float keep; const float* xlat; const float* xctx; int first;
    __device__ __forceinline__ void operator()(const f32x4 (&acc)[2][2][MF][2], const pg8::Unit& u, int wr, int wc, int fr, int fq) const {
        const float* xsrc = first ? (u.orow0 < RL ? xlat : xctx - (size_t)RL * D) : X;
#pragma unroll
        for (int ai = 0; ai < 2; ++ai)
#pragma unroll
            for (int m = 0; m < MF; ++m) {
                if (u.quad && ai) continue;
                const int row_ = EPI_ROWS(ai, m); const int mb = row_ < RL ? row_ >> 11 : 8;
                const float* g1 = MODl + (size_t)mb * 6144 + 2048;
#pragma unroll
                for (int bj = 0; bj < 2; ++bj) {
                    if (u.quad && bj) continue;
                    const int c0 = EPI_COL0(bj);
                    const f32x4 ga = *(const f32x4*)(g1 + c0) * keep, gb = *(const f32x4*)(g1 + c0 + 4) * keep;
                    float* xp = X + (size_t)row_ * D + c0; const float* xs = xsrc + (size_t)row_ * D + c0;
                    f32x4 xa = *(const f32x4*)xs, xb = *(const f32x4*)(xs + 4);
                    xa += ga * acc[ai][bj][m][0]; xb += gb * acc[ai][bj][m][1];
                    *(f32x4*)xp = xa; *(f32x4*)(xp + 4) = xb;
                }
            }
    }
};
template <int MF> struct EpiGU {
    bf16* HID;
    __device__ __forceinline__ void operator()(const f32x4 (&acc)[2][2][MF][2], const pg8::Unit& u, int wr, int wc, int fr, int fq) const {
#pragma unroll
        for (int bj = 0; bj < 2; ++bj) {
            if (u.quad && bj) continue;
            const int hc = EPI_COL0(bj) >> 1;
#pragma unroll
            for (int ai = 0; ai < 2; ++ai)
#pragma unroll
                for (int m = 0; m < MF; ++m) {
                    if (u.quad && ai) continue;
                    const f32x4 g = acc[ai][bj][m][0], up = acc[ai][bj][m][1];
                    u32x2 w; w.x = pk2(siluf(g.x) * up.x, siluf(g.y) * up.y); w.y = pk2(siluf(g.z) * up.z, siluf(g.w) * up.w);
                    *(u32x2*)(HID + (size_t)EPI_ROWS(ai, m) * DE + hc) = w;
                }
        }
    }
};
template <int MF> struct EpiDown {
    bf16* Y; const float* SGATE;
    __device__ __forceinline__ void operator()(const f32x4 (&acc)[2][2][MF][2], const pg8::Unit& u, int wr, int wc, int fr, int fq) const {
#pragma unroll
        for (int ai = 0; ai < 2; ++ai)
#pragma unroll
            for (int m = 0; m < MF; ++m) {
                if (u.quad && ai) continue;
                const int row = EPI_ROWS(ai, m); const float gt = SGATE[row];
#pragma unroll
                for (int bj = 0; bj < 2; ++bj)
                    if (!(u.quad && bj)) *(u32x4*)(Y + (size_t)row * D + EPI_COL0(bj)) = pack8(acc[ai][bj][m][0] * gt, acc[ai][bj][m][1] * gt);
            }
    }
};

constexpr int NWAVES = 8;
constexpr int RING_BYTES = 131072;
constexpr int LDSCTL_OFF = RING_BYTES, MISC_OFF = LDSCTL_OFF + 320;
constexpr int LDS_BYTES = 147456;
constexpr int CW_BAR = 4096;
typedef GAS unsigned gu32;

#define XB_TMO      128
#define XB_XCNT(j)  (256  + 64 * (j))
#define XB_XSUB(j)  (1280 + 64 * (j))
#define XB_XGEN(j)  (2304 + 64 * (j))
#define XB_TOP      3328
#define XB_TOPGEN   3392
#define XCD_BAR_WORDS 3456
#define XB_SPIN_CAP (1u << 18)
__device__ __forceinline__ unsigned xb_ld(unsigned* p)              { return __hip_atomic_load(p, __ATOMIC_RELAXED, __HIP_MEMORY_SCOPE_AGENT); }
__device__ __forceinline__ unsigned xb_add(unsigned* p, unsigned v) { return __hip_atomic_fetch_add(p, v, __ATOMIC_RELAXED, __HIP_MEMORY_SCOPE_AGENT); }
__device__ __forceinline__ unsigned xb_xcc_id() { return (unsigned)__builtin_amdgcn_s_getreg((3 << 11) | 20) & 0xFu; }
#define XB_SPIN(cond, bar) do { unsigned _sp = 0; while (cond) { __builtin_amdgcn_s_sleep(1); \
    if ((++_sp & 255u) == 0u) { if (xb_ld(&(bar)[XB_TMO])) break; if (_sp > XB_SPIN_CAP) { atomicAdd(&(bar)[XB_TMO], 1u); break; } } } } while (0)
struct XcdBarrier { unsigned* bar; unsigned x; volatile LAS unsigned* st; };
__device__ __forceinline__ XcdBarrier xcd_barrier_post(unsigned* bar, volatile LAS unsigned* st) {
    XcdBarrier b; b.bar = bar; b.x = xb_xcc_id(); b.st = st;
    if (threadIdx.x == 0) (void)xb_add(&bar[XB_XCNT(b.x)], 1u);
    return b;
}
__device__ __forceinline__ void xcd_barrier_complete(unsigned* bar, unsigned x, unsigned& nloc, unsigned& nx) {
    const unsigned G = gridDim.x * gridDim.y * gridDim.z;
    unsigned sum, cnt, mine, sp = 0u;
    for (;;) {
        sum = 0u; cnt = 0u; mine = 0u;
#pragma unroll
        for (unsigned j = 0; j < 16; ++j) { const unsigned c = xb_ld(&bar[XB_XCNT(j)]); sum += c; cnt += (c > 0u) ? 1u : 0u; mine = (j == x) ? c : mine; }
        if (sum == G) break;
        __builtin_amdgcn_s_sleep(1);
        if ((++sp & 255u) == 0u) { if (xb_ld(&bar[XB_TMO])) break; if (sp > XB_SPIN_CAP) { atomicAdd(&bar[XB_TMO], 1u); break; } }
    }
    nloc = mine > 0u ? mine : 1u; nx = cnt > 0u ? cnt : 1u;
}
__device__ __forceinline__ void xcd_barrier(const XcdBarrier& b, const int tid) {
    asm volatile("s_waitcnt vmcnt(0)" ::: "memory");
    __syncthreads();
    if (tid == 0) {
        unsigned* bar = b.bar;
        __builtin_amdgcn_s_waitcnt(0);
        unsigned nloc = b.st[0], nx = b.st[1];
        if (nloc == 0u) { xcd_barrier_complete(bar, b.x, nloc, nx); b.st[0] = nloc; b.st[1] = nx; }
        const unsigned old = xb_add(&bar[XB_XSUB(b.x)], 1u);
        const unsigned gen = old / nloc;
        if (old + 1u == (gen + 1u) * nloc) {
            __builtin_amdgcn_fence(__ATOMIC_RELEASE, "agent");
            asm volatile("s_waitcnt vmcnt(0)" ::: "memory");
            const unsigned og = xb_add(&bar[XB_TOP], 1u);
            const unsigned tg = og / nx;
            if (og + 1u == (tg + 1u) * nx) xb_add(&bar[XB_TOPGEN], 1u);
            else XB_SPIN(xb_ld(&bar[XB_TOPGEN]) == tg, bar);
            __builtin_amdgcn_fence(__ATOMIC_ACQUIRE, "agent");
            xb_add(&bar[XB_XGEN(b.x)], 1u);
            asm volatile("s_waitcnt vmcnt(0)" ::: "memory");
        } else {
            XB_SPIN(xb_ld(&bar[XB_XGEN(b.x)]) == gen, bar);
            __builtin_amdgcn_fence(__ATOMIC_ACQUIRE, "agent");
            asm volatile("s_waitcnt vmcnt(0)" ::: "memory");
        }
    }
    __syncthreads();
}

struct Frame { LAS unsigned char* lds; int tid, lane, wave, bid, G; const float* const* in; GAS float* out; GAS unsigned char* ws; };
#define IN_(k) ((const float*)(const GAS float*)F.in[(k)])
#define F_x IN_(0)
#define F_c IN_(1)
#define F_ctx IN_(2)
#define F_c_ctx IN_(3)
#define F_norm1 IN_(4)
#define F_norm2 IN_(5)
#define F_w_ada IN_(6)
#define F_b_ada IN_(7)
#define F_w_in IN_(8)
#define F_sink IN_(9)
#define F_mla_q_norm IN_(10)
#define F_w_uq IN_(11)
#define F_mla_kv_norm IN_(12)
#define F_w_ukv IN_(13)
#define F_lq1 IN_(14)
#define F_lk1 IN_(15)
#define F_lq2 IN_(16)
#define F_lk2 IN_(17)
#define F_diff_norm IN_(18)
#define F_w_out IN_(19)
#define F_w_router IN_(20)
#define F_w_gate IN_(21)
#define F_w_up IN_(22)
#define F_w_down IN_(23)
#define F_final_norm IN_(24)
#define F_MOD ((float*)(GAS float*)(F.ws + WS_MOD))
#define F_ROPE ((float*)(GAS float*)(F.ws + WS_ROPE))
#define F_RSQ ((float*)(GAS float*)(F.ws + WS_RSQ))
#define F_AFF ((float*)(GAS float*)(F.ws + WS_AFF))
#define F_INV ((int*)(GAS int*)(F.ws + WS_INV))
#define F_STOK ((int*)(GAS int*)(F.ws + WS_STOK))
#define F_SGATE ((float*)(GAS float*)(F.ws + WS_SGATE))
#define F_X ((float*)(GAS float*)(F.ws + WS_X))
#define F_ACT ((bf16*)(GAS bf16*)(F.ws + WS_ACT))
#define F_P ((bf16*)(GAS bf16*)(F.ws + WS_P))
#define F_Y ((bf16*)(GAS bf16*)(F.ws + WS_Y))
#define F_QKVM ((bf16*)(GAS bf16*)(F.ws + WS_QKVM))
#define F_O ((bf16*)(GAS bf16*)(F.ws + WS_O))
#define F_HID ((bf16*)(GAS bf16*)(F.ws + WS_HID))
#define F_WB ((bf16*)(GAS bf16*)(F.ws + WS_W))

__device__ __forceinline__ int rot64(int dp) { const int p = dp >> 1, half = dp & 1, axis = p >> 4, f = p & 15; return axis * 32 + half * 16 + f; }
__device__ __forceinline__ int rot32(int dp) { const int p = dp >> 1, half = dp & 1, axis = p >> 3, f = p & 7; return axis * 16 + half * 8 + f; }
__device__ __forceinline__ int src_col_in(int n) {
    if (n >= INW) return -1;
    if (n < P_AV) return (n & ~63) + rot64(n & 63);
    if (n >= P_KR && n < P_DV) return (n & ~31) + rot32(n & 31);
    return n;
}
__device__ __forceinline__ void prep_tile(const float* src, int N, int k0, const float* kscale, bf16* dst, int ldd, LAS float* scr, int lane) {
    float v[32];
#pragma unroll
    for (int i = 0; i < 32; ++i) { const int kk = 2 * i + (lane >> 5); v[i] = src ? src[(size_t)(k0 + kk) * N] : 0.f; }
    if (kscale) {
#pragma unroll
        for (int i = 0; i < 32; ++i) v[i] *= kscale[k0 + 2 * i + (lane >> 5)]; }
#pragma unroll
    for (int i = 0; i < 32; ++i) scr[(2 * i + (lane >> 5)) * 33 + (lane & 31)] = v[i];
    LDS_WAIT();
    const int c = lane & 7;
#pragma unroll
    for (int j = 0; j < 4; ++j) { const int n = (lane >> 3) + 8 * j; const LAS float* s = scr + (8 * c) * 33 + n;
        u32x4 o; o.x = pk2(s[0], s[33]); o.y = pk2(s[66], s[99]); o.z = pk2(s[132], s[165]); o.w = pk2(s[198], s[231]);
        *(u32x4*)(dst + (size_t)n * ldd + 8 * c) = o; }
    LDS_WAIT();
}
constexpr int PI_IN = 16 * 64, PI_UP = 6 * 32, PI_OUT = 16 * 32, PI_GU = NE * 16 * 32, PI_DN = NE * 8 * 32, PI_LAYER = PI_IN + PI_UP + PI_OUT + PI_GU + PI_DN;
#ifndef BG_PREP
#define BG_PREP 0
#endif
__device__ __forceinline__ void prep_layer(Frame& F, const int l, const int worker, const int nworkers) {
    const int lane = F.lane, wave = F.wave;
    LAS float* scr = (LAS float*)(F.lds + 57344 + wave * 8448);
    for (int it = worker; it < PI_LAYER; it += nworkers) {
        int r = it; bf16* wl = F_WB + (size_t)l * W_LAYER;
        const int nl = lane & 31;
        if (r < PI_IN) { const int kb = r / 64, nb = r % 64, n = nb * 32 + nl, sc = src_col_in(n);
            prep_tile(sc >= 0 ? F_w_in + (size_t)l * D * INW + sc : nullptr, INW, kb * 64, nullptr, wl + W_IN + (size_t)(nb * 32) * D + kb * 64, D, scr, lane); continue; } r -= PI_IN;
        if (r < PI_UP) { const int kb = r / 32, nb = r % 32, n = nb * 32 + nl, k0 = kb * 64; const float* src = nullptr; const float* ks = nullptr; int N = 384, ksrc = k0;
            if (n < 384 && k0 < 256) { const int h = n / 96, j = n % 96; const int sc = j < 64 ? n : h * 96 + 64 + rot32(j - 64); src = F_w_uq + (size_t)l * 256 * 384 + sc; ks = F_mla_q_norm + l * 256; N = 384; }
            else if (n >= 512 && k0 >= 256) { src = F_w_ukv + (size_t)l * 128 * 512 + (n - 512); ks = F_mla_kv_norm + l * 128; N = 512; ksrc = k0 - 256; }
            { float v[32];
#pragma unroll
              for (int i = 0; i < 32; ++i) { const int kk = 2 * i + (lane >> 5); v[i] = src ? src[(size_t)(ksrc + kk) * N] * ks[ksrc + kk] : 0.f; }
#pragma unroll
              for (int i = 0; i < 32; ++i) scr[(2 * i + (lane >> 5)) * 33 + (lane & 31)] = v[i];
              LDS_WAIT();
              const int c = lane & 7; bf16* dst = wl + W_UP + (size_t)(nb * 32) * UPK + k0;
#pragma unroll
              for (int j = 0; j < 4; ++j) { const int nn = (lane >> 3) + 8 * j; const LAS float* s = scr + (8 * c) * 33 + nn;
                  u32x4 o; o.x = pk2(s[0], s[33]); o.y = pk2(s[66], s[99]); o.z = pk2(s[132], s[165]); o.w = pk2(s[198], s[231]);
                  *(u32x4*)(dst + (size_t)nn * UPK + 8 * c) = o; }
              LDS_WAIT(); }
            continue; } r -= PI_UP;
        if (r < PI_OUT) { const int kb = r / 32, nb = r % 32;
            prep_tile(F_w_out + (size_t)l * D * D + nb * 32 + nl, D, kb * 64, nullptr, wl + W_OUT + (size_t)(nb * 32) * D + kb * 64, D, scr, lane); continue; } r -= PI_OUT;
        if (r < PI_GU) { const int e = r / 512, q = r % 512, kb = q / 32, nb = q % 32, n = nb * 32 + nl, f = (n >> 3) * 4 + (n & 3);
            const float* src = ((n & 4) ? F_w_up : F_w_gate) + ((size_t)l * NE + e) * D * DE + f;
            prep_tile(src, DE, kb * 64, nullptr, wl + W_GU + (size_t)e * 1024 * 1024 + (size_t)(nb * 32) * D + kb * 64, D, scr, lane); continue; } r -= PI_GU;
        { const int e = r / 256, q = r % 256, kb = q / 32, nb = q % 32;
            prep_tile(F_w_down + ((size_t)l * NE + e) * DE * D + nb * 32 + nl, D, kb * 64, nullptr, wl + W_DN + (size_t)e * 1024 * 512 + (size_t)(nb * 32) * DE + kb * 64, DE, scr, lane); }
    }
}

__device__ __forceinline__ void p0_phase(Frame& F) {
    const int tid = F.tid, lane = F.lane, wave = F.wave;
    {
        LAS float* sl = (LAS float*)F.lds;
        LAS float* red = (LAS float*)(F.lds + 36864);
        for (int i = tid; i < 9 * 1024; i += 512) { const float v = i < 8 * 1024 ? F_c[i] : F_c_ctx[i - 8 * 1024]; sl[i] = siluf(v); }
        __syncthreads();
        for (int it = F.bid; it < DEPTH * 96; it += F.G) {
            const int l = it / 96, cg = it % 96, col = cg * 64 + lane;
            float acc[9];
#pragma unroll
            for (int r = 0; r < 9; ++r) acc[r] = 0.f;
            const float* w = F_w_ada + (size_t)l * D * 6144 + (size_t)(wave * 128) * 6144 + col;
#pragma unroll 16
            for (int k = 0; k < 128; ++k) { const float wv = w[(size_t)k * 6144];
#pragma unroll
                for (int r = 0; r < 9; ++r) acc[r] += sl[r * 1024 + wave * 128 + k] * wv; }
#pragma unroll
            for (int r = 0; r < 9; ++r) red[(wave * 9 + r) * 64 + lane] = acc[r];
            __syncthreads();
            for (int o = tid; o < 576; o += 512) { const int r = o >> 6, cc = o & 63; float s = 0.f;
#pragma unroll
                for (int w8 = 0; w8 < 8; ++w8) s += red[(w8 * 9 + r) * 64 + cc];
                F_MOD[((size_t)l * 9 + r) * 6144 + cg * 64 + cc] = s + F_b_ada[l * 6144 + cg * 64 + cc]; }
            __syncthreads();
        }
    }
    const int gw = F.bid * NWAVES + wave, NGW = F.G * NWAVES;
    { const size_t n4 = (size_t)R * D / 4, nl4 = (size_t)RL * D / 4;
      for (size_t i = (size_t)F.bid * 512 + tid; i < n4; i += (size_t)F.G * 512) { const f32x4 v = i < nl4 ? ((const f32x4*)F_x)[i] : ((const f32x4*)F_ctx)[i - nl4]; ((f32x4*)F_X)[i] = v; } }
    for (int i = F.bid * 512 + tid; i < T * 48; i += F.G * 512) {
        const int t = i / 48, j = i % 48; int axis, f, nf;
        if (j < 32) { axis = j >> 4; f = j & 15; nf = 16; } else { axis = (j - 32) >> 3; f = (j - 32) & 7; nf = 8; }
        const float inv = exp2f(-(float)f / (float)nf * 13.287712379549449f);
        const float ang = (float)(axis == 0 ? (t >> 6) : (t & 63)) * inv;
        const float cv = cosf(ang), sv = sinf(ang);
        if (j < 32) { F_ROPE[t * 32 + j] = cv; F_ROPE[T * 32 + t * 32 + j] = sv; } else { F_ROPE[T * 64 + t * 16 + j - 32] = cv; F_ROPE[T * 64 + T * 16 + t * 16 + j - 32] = sv; }
    }
    for (int l = 0; l < (BG_PREP ? 1 : DEPTH); ++l) prep_layer(F, l, gw, NGW);
}

#ifndef PROBE_NOROUTER
#define PROBE_NOROUTER 0
#endif
#define half_swap_add(keepv, sendv, off) ((keepv) + shx((sendv), (off), lane))
__device__ __forceinline__ void norm_phase(Frame& F, int l, int mode, int nrows, const float keep) {
    const int lane = F.lane, gw = F.bid * NWAVES + F.wave, NGW = F.G * NWAVES;
    LAS float* wrT = (LAS float*)F.lds;
    if (mode == 1) {
        const float* wr = F_w_router + (size_t)l * D * NE;
        for (int i = F.tid; i < D * NE; i += 512) wrT[(i & 15) * 1028 + (i >> 4)] = wr[i];
        __syncthreads();
    }
    const float* gain = mode == 0 ? F_norm1 + (size_t)l * D : (mode == 1 ? F_norm2 + (size_t)l * D : F_final_norm);
    const bool comb = mode != 1 && l > 0;
    f32x4 vn[2][4];
#define NORM_LOAD(dst, rr0) do { _Pragma("unroll") for (int q = 0; q < 2; ++q) _Pragma("unroll") for (int j = 0; j < 4; ++j) dst[q][j] = ((const f32x4*)(F_X + (size_t)((rr0) + q) * D))[lane + 64 * j]; } while (0)
    if (gw * 2 < nrows) NORM_LOAD(vn, gw * 2);
    for (int r0 = gw * 2; r0 < nrows; r0 += NGW * 2) {
        const int mb = r0 < RL ? r0 / T : 8;
        f32x4 v[2][4];
#pragma unroll
        for (int q = 0; q < 2; ++q)
#pragma unroll
            for (int j = 0; j < 4; ++j) v[q][j] = vn[q][j];
        if (r0 + NGW * 2 < nrows) NORM_LOAD(vn, r0 + NGW * 2);
        if (comb) {
            const float* g2 = F_MOD + ((size_t)(l - 1) * 9 + mb) * 6144 + 5120;
            const int myinv = lane < 2 * NE ? F_INV[(size_t)r0 * NE + lane] : -1;
            f32x4 s[2][4];
#pragma unroll
            for (int q = 0; q < 2; ++q)
#pragma unroll
                for (int j = 0; j < 4; ++j) s[q][j] = (f32x4){0.f, 0.f, 0.f, 0.f};
            for (int e = 0; e < NE; ++e) {
#pragma unroll
                for (int q = 0; q < 2; ++q) { const int sl = shi(myinv, q * NE + e);
                    if (sl >= 0) { const bf16* yr = F_Y + (size_t)sl * D;
#pragma unroll
                        for (int j = 0; j < 4; ++j) { const u32x2 w = ((const u32x2*)yr)[lane + 64 * j];
                            s[q][j].x += bf2f(w.x & 0xffff); s[q][j].y += bf2f(w.x >> 16); s[q][j].z += bf2f(w.y & 0xffff); s[q][j].w += bf2f(w.y >> 16); } } } }
#pragma unroll
            for (int j = 0; j < 4; ++j) { const f32x4 g = ((const f32x4*)g2)[lane + 64 * j];
#pragma unroll
                for (int q = 0; q < 2; ++q) { v[q][j] += g * s[q][j] * keep; ((f32x4*)(F_X + (size_t)(r0 + q) * D))[lane + 64 * j] = v[q][j]; } }
        }
        float ss0 = 0.f, ss1 = 0.f;
#pragma unroll
        for (int j = 0; j < 4; ++j) { ss0 += (v[0][j].x * v[0][j].x + v[0][j].y * v[0][j].y) + (v[0][j].z * v[0][j].z + v[0][j].w * v[0][j].w);
                                      ss1 += (v[1][j].x * v[1][j].x + v[1][j].y * v[1][j].y) + (v[1][j].z * v[1][j].z + v[1][j].w * v[1][j].w); }
#pragma unroll
        for (int o = 1; o < 64; o <<= 1) { ss0 += shx(ss0, o, lane); ss1 += shx(ss1, o, lane); }
        const float rs[2] = {1.0f / sqrtf(ss0 * (1.f / D) + EPS), 1.0f / sqrtf(ss1 * (1.f / D) + EPS)};
        if (mode == 2) {
#pragma unroll
            for (int j = 0; j < 4; ++j) { const f32x4 g = ((const f32x4*)gain)[lane + 64 * j];
#pragma unroll
                for (int q = 0; q < 2; ++q) ((f32x4*)((float*)F.out + (size_t)(r0 + q) * D))[lane + 64 * j] = v[q][j] * rs[q] * g; }
        } else {
            const float* md = F_MOD + ((size_t)l * 9 + mb) * 6144 + (mode == 0 ? 0 : 3072);
#pragma unroll
            for (int j = 0; j < 4; ++j) { const f32x4 g = ((const f32x4*)gain)[lane + 64 * j];
                const f32x4 sh = ((const f32x4*)md)[lane + 64 * j], sc = ((const f32x4*)(md + 1024))[lane + 64 * j];
#pragma unroll
                for (int q = 0; q < 2; ++q) { v[q][j] = v[q][j] * rs[q] * g * (sc + 1.0f) + sh;
                    u32x2 w; w.x = pk2(v[q][j].x, v[q][j].y); w.y = pk2(v[q][j].z, v[q][j].w);
                    ((u32x2*)(F_ACT + (size_t)(r0 + q) * D))[lane + 64 * j] = w; } }
            if (mode == 1 && !(PROBE_NOROUTER && keep == 0.f)) {
                float a[2][NE];
                typedef float f32x2r __attribute__((ext_vector_type(2)));
#pragma unroll
                for (int e = 0; e < NE; ++e) { f32x2r p0 = {0.f, 0.f}, p1 = {0.f, 0.f};
#pragma unroll
                    for (int j = 0; j < 4; ++j) { const f32x4 w = *(const LAS f32x4*)(wrT + e * 1028 + 256 * j + 4 * lane);
                        const f32x2r wl = {w.x, w.y}, wh = {w.z, w.w};
                        p0 = __builtin_elementwise_fma((f32x2r){v[0][j].x, v[0][j].y}, wl, p0); p0 = __builtin_elementwise_fma((f32x2r){v[0][j].z, v[0][j].w}, wh, p0);
                        p1 = __builtin_elementwise_fma((f32x2r){v[1][j].x, v[1][j].y}, wl, p1); p1 = __builtin_elementwise_fma((f32x2r){v[1][j].z, v[1][j].w}, wh, p1); }
                    a[0][e] = p0.x + p0.y; a[1][e] = p1.x + p1.y; if ((e & 1) == 1) __builtin_amdgcn_sched_barrier(0); }
                float b16[NE];
#pragma unroll
                for (int e = 0; e < NE; ++e) { const bool up = lane >= 32; b16[e] = half_swap_add(up ? a[1][e] : a[0][e], up ? a[0][e] : a[1][e], 32); }
                float b8[8];
#pragma unroll
                for (int e = 0; e < 8; ++e) { const bool up = (lane & 16) != 0; b8[e] = half_swap_add(up ? b16[8 + e] : b16[e], up ? b16[e] : b16[8 + e], 16); }
                float b4[4];
#pragma unroll
                for (int e = 0; e < 4; ++e) { const bool up = (lane & 8) != 0; b4[e] = half_swap_add(up ? b8[4 + e] : b8[e], up ? b8[e] : b8[4 + e], 8); }
                float b2[2];
#pragma unroll
                for (int e = 0; e < 2; ++e) { const bool up = (lane & 4) != 0; b2[e] = half_swap_add(up ? b4[2 + e] : b4[e], up ? b4[e] : b4[2 + e], 4); }
                float lg; { const bool up = (lane & 2) != 0; lg = half_swap_add(up ? b2[1] : b2[0], up ? b2[0] : b2[1], 2); }
                lg += shx(lg, 1, lane);
                float mx = lg;
#pragma unroll
                for (int o = 2; o < 32; o <<= 1) mx = fmaxf(mx, shx(mx, o, lane));
                const float ex = __expf(lg - mx); float sum = ex;
#pragma unroll
                for (int o = 2; o < 32; o <<= 1) sum += shx(sum, o, lane);
                const int eidx = ((lane >> 4) & 1) * 8 + ((lane >> 3) & 1) * 4 + ((lane >> 2) & 1) * 2 + ((lane >> 1) & 1);
                if ((lane & 1) == 0) F_AFF[(size_t)(r0 + (lane >> 5)) * NE + eidx] = ex / sum;
            }
        }
    }
}

#undef NORM_LOAD
__device__ __forceinline__ void topk_phase(Frame& F, int nsets) {
    LAS unsigned* cnt = (LAS unsigned*)F.lds;
    const int tid = F.tid, lane = F.lane, wave = F.wave;
    for (int it = F.bid; it < nsets * NE; it += F.G) {
        const int set = it / NE, e = it % NE; const bool lat = set < 8; const int b = lat ? set : set - 8;
        const int n = lat ? T : LC, cap = lat ? CAPL : CAPC, row0 = lat ? b * T : RL + b * LC, slot0 = e * SLOTS_E + (lat ? b * CAPL : NB * CAPL + b * CAPC);
        unsigned v[4];
#pragma unroll
        for (int q = 0; q < 4; ++q) { const int idx = 4 * tid + q; v[q] = idx < n ? __builtin_bit_cast(unsigned, F_AFF[(size_t)(row0 + idx) * NE + e]) : 0u; }
        unsigned prefix = 0u; int par = 0;
        for (int bit = 30; bit >= 0; --bit) {
            const unsigned cand = prefix | (1u << bit);
            unsigned c = 0;
#pragma unroll
            for (int q = 0; q < 4; ++q) c += (unsigned)__popcll(__ballot(v[q] >= cand));
            if (lane == 0) cnt[par * 8 + wave] = c;
            __syncthreads();
            unsigned tot = 0;
#pragma unroll
            for (int w = 0; w < 8; ++w) tot += cnt[par * 8 + w];
            if (tot >= (unsigned)cap) prefix = cand;
            par ^= 1;
        }
        unsigned g4 = 0, e4 = 0;
#pragma unroll
        for (int q = 0; q < 4; ++q) { g4 += v[q] > prefix ? 1u : 0u; e4 += v[q] == prefix ? 1u : 0u; }
        unsigned pk = g4 | (e4 << 16), inc = pk;
#pragma unroll
        for (int o = 1; o < 64; o <<= 1) { const unsigned t = (unsigned)shi((int)inc, lane - o); if (lane >= o) inc += t; }
        __syncthreads();
        if (lane == 63) cnt[16 + wave] = inc;
        __syncthreads();
        unsigned base = 0, total = 0;
#pragma unroll
        for (int w = 0; w < 8; ++w) { const unsigned t = cnt[16 + w]; total += t; if (w < wave) base += t; }
        const unsigned excl = base + inc - pk;
        unsigned gpre = excl & 0xffffu, epre = excl >> 16; const unsigned need = (unsigned)cap - (total & 0xffffu);
#pragma unroll
        for (int q = 0; q < 4; ++q) { const int idx = 4 * tid + q;
            if (idx < n) { const bool isg = v[q] > prefix, ise = v[q] == prefix; const bool sel = isg || (ise && epre < need);
                const int slot = slot0 + (int)(gpre + (epre < need ? epre : need));
                if (sel) { F_STOK[slot] = row0 + idx; F_SGATE[slot] = __builtin_bit_cast(float, v[q]); }
                F_INV[(size_t)(row0 + idx) * NE + e] = sel ? slot : -1;
                gpre += isg ? 1u : 0u; epre += ise ? 1u : 0u; } }
        __syncthreads();
    }
}

#ifndef ATT_EXTRA
#define ATT_EXTRA 0
#define ATT_EXTRA_TYPE 0
#endif
#ifndef ATT_LATE_DMA
#define ATT_LATE_DMA 0
#endif
#ifndef ATT_STAGGER
#define ATT_STAGGER 1
#endif
#ifndef ATT_XVAR
#define ATT_XVAR 0
#endif
#ifndef ATT_XSTEPS
#define ATT_XSTEPS 4
#endif
namespace att {
typedef short s16x4 __attribute__((ext_vector_type(4)));
typedef float f32x2_t __attribute__((ext_vector_type(2)));
typedef __bf16 bf16x2_t __attribute__((ext_vector_type(2)));
constexpr int L_K = 0, KBUF = 16384, L_V = 2 * KBUF, VBUF = 8192, L_WS = L_V + 2 * VBUF, L_OST = L_WS + 8 * 256, L_END = L_OST + 8 * 4096;
#define ATT_SBAR() __builtin_amdgcn_sched_barrier(0)
#define ATT_SGB(mask, n) __builtin_amdgcn_sched_group_barrier(mask, n, 0)
__device__ __forceinline__ int crow(int r, int hi) { return (r & 3) + 8 * (r >> 2) + 4 * hi; }
__device__ __forceinline__ unsigned cvtpk(float lo, float hi) { f32x2_t v = {lo, hi}; bf16x2_t b = __builtin_convertvector(v, bf16x2_t); return __builtin_bit_cast(unsigned, b); }
__device__ __forceinline__ int v_st(int k, int c) { const int kk = k; return ((kk >> 3) * 2 + (c >> 5)) * 512 + ((kk & 7) * 32 + (c & 31)) * 2; }
__device__ __forceinline__ int v_rd_base(int lane) { return ((lane & 3) << 3) | (((lane >> 2) & 3) << 6) | (((lane >> 4) & 1) << 5) | (((lane >> 5) & 1) << 8); }
typedef short v4i16_t __attribute__((ext_vector_type(4)));
template <int OFF> __device__ __forceinline__ s16x4 tr_read(int vb) { s16x4 r; asm volatile("ds_read_b64_tr_b16 %0, %1 offset:%2" : "=&v"(r) : "v"(vb), "i"(OFF) : "memory"); return r; }
struct VFrag { s16x4 l0, h0, l1, h1, l2, h2, l3, h3; };
template <int D0> __device__ __forceinline__ void vread(VFrag& f, int vb) {
    f.l0 = tr_read<D0 * 512 + 0 * 2048>(vb); f.h0 = tr_read<D0 * 512 + 0 * 2048 + 1024>(vb); f.l1 = tr_read<D0 * 512 + 1 * 2048>(vb); f.h1 = tr_read<D0 * 512 + 1 * 2048 + 1024>(vb);
    f.l2 = tr_read<D0 * 512 + 2 * 2048>(vb); f.h2 = tr_read<D0 * 512 + 2 * 2048 + 1024>(vb); f.l3 = tr_read<D0 * 512 + 3 * 2048>(vb); f.h3 = tr_read<D0 * 512 + 3 * 2048 + 1024>(vb);
}
__device__ __forceinline__ void pv_mma(f32x16& od, const VFrag& f, bf16x8 pa0, bf16x8 pa1, bf16x8 pa2, bf16x8 pa3) {
#define ATT_PK(L, H) (bf16x8){L[0], L[1], L[2], L[3], H[0], H[1], H[2], H[3]}
    od = __builtin_amdgcn_mfma_f32_32x32x16_bf16(pa0, ATT_PK(f.l0, f.h0), od, 0, 0, 0);
    od = __builtin_amdgcn_mfma_f32_32x32x16_bf16(pa1, ATT_PK(f.l1, f.h1), od, 0, 0, 0);
    od = __builtin_amdgcn_mfma_f32_32x32x16_bf16(pa2, ATT_PK(f.l2, f.h2), od, 0, 0, 0);
    od = __builtin_amdgcn_mfma_f32_32x32x16_bf16(pa3, ATT_PK(f.l3, f.h3), od, 0, 0, 0);
#undef ATT_PK
}
template <int D0> __device__ __forceinline__ void pv_one(f32x16& od, int vb, bf16x8 pa0, bf16x8 pa1, bf16x8 pa2, bf16x8 pa3) {
    VFrag f; vread<D0>(f, vb); asm volatile("s_waitcnt lgkmcnt(0)" ::: "memory"); ATT_SBAR(); pv_mma(od, f, pa0, pa1, pa2, pa3);
}
struct Tensors { const bf16* P; const bf16* QKVM; bf16* O; const float* sink; const float* dnorm; float lam, lam_init; int l; };

constexpr float THR = 8.f;
__device__ __forceinline__ float rowmax32(const f32x16& p0, const f32x16& p1) {
    float a = fmaxf(fmaxf(p0[0], p0[1]), p1[0]), b = fmaxf(fmaxf(p0[2], p0[3]), p1[1]); a = fmaxf(fmaxf(a, p1[2]), p1[3]);
#pragma unroll
    for (int r = 4; r < 16; r += 4) { a = fmaxf(fmaxf(a, p0[r]), p0[r + 1]); b = fmaxf(fmaxf(b, p0[r + 2]), p0[r + 3]); a = fmaxf(fmaxf(a, p1[r]), p1[r + 1]); b = fmaxf(fmaxf(b, p1[r + 2]), p1[r + 3]); }
    float m = fmaxf(a, b);
    auto rr = __builtin_amdgcn_permlane32_swap(__float_as_uint(m), __float_as_uint(m), false, false);
    return fmaxf(__uint_as_float(rr[0]), __uint_as_float(rr[1]));
}
__device__ __forceinline__ void partialSM(f32x16& p0, f32x16& p1, const float rm, float& mhat, f32x16& negm, float& alpha) {
    alpha = 1.f;
    if (__builtin_expect(__any(rm > THR), 0)) {
        const float dl = fmaxf(rm, 0.f); mhat += dl;
#pragma unroll
        for (int r = 0; r < 16; ++r) { p0[r] -= dl; p1[r] -= dl; }
#pragma unroll
        for (int r = 0; r < 16; ++r) negm[r] = -mhat;
        asm volatile("" : "+v"(negm));
        alpha = __builtin_amdgcn_exp2f(-dl);
    }
}
__device__ __forceinline__ void finishSM(f32x16& p0, f32x16& p1, const float alpha, float& l_reg, bf16x8& pa0, bf16x8& pa1, bf16x8& pa2, bf16x8& pa3) {
#pragma unroll
    for (int r = 0; r < 16; ++r) { p0[r] = __builtin_amdgcn_exp2f(p0[r]); p1[r] = __builtin_amdgcn_exp2f(p1[r]); }
    float ps = 0.f, pt = 0.f;
#pragma unroll
    for (int r = 0; r < 16; ++r) { ps += p0[r]; pt += p1[r]; }
    l_reg = l_reg * alpha + (ps + pt);
#define ATT_PK8(P, BASE, OUT) do { u32x4 w = {cvtpk(P[BASE + 0], P[BASE + 1]), cvtpk(P[BASE + 2], P[BASE + 3]), cvtpk(P[BASE + 4], P[BASE + 5]), cvtpk(P[BASE + 6], P[BASE + 7])}; OUT = __builtin_bit_cast(bf16x8, w); } while (0)
    ATT_PK8(p0, 0, pa0); ATT_PK8(p0, 8, pa1); ATT_PK8(p1, 0, pa2); ATT_PK8(p1, 8, pa3);
#undef ATT_PK8
}
template <int ROWB> __device__ __forceinline__ int kswz(int row, int cb) { return row * ROWB + (ROWB == 128 ? (cb ^ (((row >> 1) & 7) << 4)) : (cb ^ ((row & 15) << 4))); }
template <int NB, int ROWB, int CB0, int D00> __device__ __forceinline__ void kread(bf16x8 (&kf)[2 * NB], const LAS unsigned char* Kb, int r32, int hi) {
#pragma unroll
    for (int d = 0; d < NB; ++d) { const int cb = CB0 + ((D00 + d) * 16 + hi * 8) * 2;
        kf[2 * d] = *(const LAS bf16x8*)(Kb + kswz<ROWB>(r32, cb)); kf[2 * d + 1] = *(const LAS bf16x8*)(Kb + kswz<ROWB>(32 + r32, cb)); }
}
template <int NB, int D00> __device__ __forceinline__ void kmma(f32x16& p0, f32x16& p1, const bf16x8 (&kf)[2 * NB], const bf16x8* qr, const f32x16& negm) {
#pragma unroll
    for (int d = 0; d < NB; ++d) {
        if (D00 + d == 0) { p0 = __builtin_amdgcn_mfma_f32_32x32x16_bf16(kf[0], qr[0], negm, 0, 0, 0); p1 = __builtin_amdgcn_mfma_f32_32x32x16_bf16(kf[1], qr[0], negm, 0, 0, 0); }
        else { p0 = __builtin_amdgcn_mfma_f32_32x32x16_bf16(kf[2 * d], qr[D00 + d], p0, 0, 0, 0); p1 = __builtin_amdgcn_mfma_f32_32x32x16_bf16(kf[2 * d + 1], qr[D00 + d], p1, 0, 0, 0); } }
}
template <int NKS, int ROWB, int CB0> __device__ __forceinline__ void qkt2(f32x16& p0, f32x16& p1, const LAS unsigned char* Kb, const bf16x8* qr, const f32x16& negm, int r32, int hi) {
    constexpr int N1 = NKS > 4 ? 3 : NKS, N2 = NKS - N1;
    bf16x8 ka[2 * N1]; kread<N1, ROWB, CB0, 0>(ka, Kb, r32, hi);
    if constexpr (N2 > 0) { bf16x8 kb[2 * N2]; kread<N2, ROWB, CB0, N1>(kb, Kb, r32, hi);
        kmma<N1, 0>(p0, p1, ka, qr, negm); kmma<N2, N1>(p0, p1, kb, qr, negm); }
    else kmma<N1, 0>(p0, p1, ka, qr, negm);
}

template <int TYPE> struct Ring { static constexpr int KSLOT = TYPE == 1 ? 16384 : 8192, VSLOT = 8192, L_K = 0, L_V = 3 * KSLOT, L_WS = L_V + 4 * VSLOT, L_OST = L_WS + 2048; };
template <int TYPE, int CB0> __device__ __forceinline__ void flash_pass(const Tensors& Tn, LAS unsigned char* lds, const int tid, const int b, const int h, const bool lat, const int q0, const int wrow, const int var, const bf16x8* qr,
                                                                        f32x16 (&o)[2], float& l_out, float& m_out) {
    constexpr int NKS = TYPE == 0 ? 4 : (TYPE == 1 ? 6 : 2);
    constexpr int ROWB = TYPE == 1 ? 256 : 128;
    typedef Ring<TYPE> RG;
    const int lane = tid & 63, wid = __builtin_amdgcn_readfirstlane(tid >> 6), r32 = lane & 31, hi = lane >> 5;
    LAS float* al_l = (LAS float*)(lds + RG::L_WS) + wid * 64;
    const int kvh = h >> 2;
    const bf16* Kp = TYPE == 0 ? Tn.P + P_AK + kvh * 64 : (TYPE == 1 ? Tn.QKVM + 512 + h * 128 : Tn.P + P_DK + h * 64);
    const bf16* Vp = TYPE == 0 ? Tn.P + P_AV + kvh * 64 : (TYPE == 1 ? Tn.QKVM + 512 + h * 128 + 64 : Tn.P + P_DV + h * 64);
    constexpr int KPITCH = TYPE == 1 ? LDM : LDP;
    int kl0 = 0, nloc = 0;
    if (lat) { if (TYPE == 0) { kl0 = q0 - 128 < 0 ? 0 : q0 - 128; const int kl1 = q0 + 64 + 128 > T ? T : q0 + 64 + 128; nloc = (kl1 - kl0) >> 6; } else { kl0 = 0; nloc = T / 64; } }
    const int NT = 4 + nloc;
    const int crow0 = RL + b * LC, lrow0 = b * T + kl0;
#define ATT_TROW(i) ((var & 64) ? crow0 : ((i) < 4 ? crow0 + 64 * (i) : lrow0 + 64 * ((i) - 4)))
    const bf16* ksrc0; const bf16* ksrc1 = nullptr;
    if (TYPE != 1) { const int row = 8 * wid + (lane >> 3), c = (lane & 7) ^ ((row >> 1) & 7); ksrc0 = Kp + (size_t)row * KPITCH + c * 8; }
    else {
        { const int row = 8 * wid + (lane >> 4), c = (lane & 15) ^ (row & 15); ksrc0 = c < 8 ? Kp + (size_t)row * LDM + c * 8 : (c < 12 ? Tn.P + (size_t)row * LDP + P_KR + (c - 8) * 8 : Kp + (size_t)row * LDM); }
        { const int row = 8 * wid + 4 + (lane >> 4), c = (lane & 15) ^ (row & 15); ksrc1 = c < 8 ? Kp + (size_t)row * LDM + c * 8 : (c < 12 ? Tn.P + (size_t)row * LDP + P_KR + (c - 8) * 8 : Kp + (size_t)row * LDM); }
    }
    const bool k0p = TYPE == 1 && (((lane & 15) ^ ((8 * wid + (lane >> 4)) & 15)) >= 8) && (((lane & 15) ^ ((8 * wid + (lane >> 4)) & 15)) < 12);
    const bool k1p = TYPE == 1 && (((lane & 15) ^ ((8 * wid + 4 + (lane >> 4)) & 15)) >= 8) && (((lane & 15) ^ ((8 * wid + 4 + (lane >> 4)) & 15)) < 12);
    const bf16* vsrc = Vp + (size_t)(8 * wid + ((lane & 31) >> 2)) * KPITCH + (lane >> 5) * 32 + (lane & 3) * 8;
#define ATT_DMA_K(i, slot) do { if (var & 8) break; const int g_ = ATT_TROW((i) < NT ? (i) : NT - 1); \
        __builtin_amdgcn_global_load_lds((const unsigned*)(ksrc0 + (size_t)g_ * (k0p ? LDP : KPITCH)), (LAS unsigned*)(lds + RG::L_K + (slot) * RG::KSLOT + wid * (ROWB * 8)), 16, 0, 0); \
        if (TYPE == 1) __builtin_amdgcn_global_load_lds((const unsigned*)(ksrc1 + (size_t)g_ * (k1p ? LDP : KPITCH)), (LAS unsigned*)(lds + RG::L_K + (slot) * RG::KSLOT + wid * (ROWB * 8) + 1024), 16, 0, 0); } while (0)
#define ATT_DMA_V(i, slot) do { if (var & 8) break; const int g_ = ATT_TROW((i) < NT ? (i) : NT - 1); \
        __builtin_amdgcn_global_load_lds((const unsigned*)(vsrc + (size_t)g_ * KPITCH), (LAS unsigned*)(lds + RG::L_V + (slot) * RG::VSLOT + wid * 1024), 16, 0, 0); } while (0)
#define ATT_WAITBAR() do { if (var & 16) break; if (TYPE == 1) asm volatile("s_waitcnt vmcnt(3)" ::: "memory"); else asm volatile("s_waitcnt vmcnt(2)" ::: "memory"); __builtin_amdgcn_s_barrier(); asm volatile("" ::: "memory"); } while (0)
#define ATT_RESC(a) do { if (__any((a) < 1.f)) { if (hi == 0) al_l[r32] = (a); asm volatile("s_waitcnt lgkmcnt(0)" ::: "memory"); \
        _Pragma("unroll") for (int r = 0; r < 16; ++r) { const float f_ = al_l[crow(r, hi)]; o[0][r] *= f_; o[1][r] *= f_; } } } while (0)
    const int qpos = q0 + wrow + r32;
#define ATT_MASK(P0, P1, i) do { if (TYPE == 0) { const int kt0_ = kl0 + 64 * ((i) - 4) - qpos, lo_ = (i) >= 4 ? -128 : -(1 << 28), hi_ = (i) >= 4 ? 128 : (1 << 28); \
        _Pragma("unroll") for (int r = 0; r < 16; ++r) { const int k0_ = kt0_ + crow(r, hi); P0[r] = (k0_ < lo_ || k0_ > hi_) ? -1e30f : P0[r]; P1[r] = (k0_ + 32 < lo_ || k0_ + 32 > hi_) ? -1e30f : P1[r]; } } } while (0)
    const int vb0 = (int)(uintptr_t)(lds + RG::L_V) + v_rd_base(lane);
    const LAS unsigned char* Kr = lds + RG::L_K;
    float mhat = 0.f, l_reg = 0.f; f32x16 negm = f32x16{};
    int sp = 2, sc = 0;
#define ATT_ROT() do { const int t_ = sp; sp = sc; sc = (sc == 2 ? 0 : sc + 1); (void)t_; } while (0)
    const bool lag = ATT_STAGGER && wid >= 4;
    f32x16 p0 = f32x16{}, p1 = f32x16{}; bf16x8 pa0 = bf16x8{}, pa1 = bf16x8{}, pa2 = bf16x8{}, pa3 = bf16x8{};
#define ATT_SOFT(t, FIRST) do { ATT_MASK(p0, p1, t); float rm_ = rowmax32(p0, p1); float alpha_ = 1.f; \
        if (FIRST) { mhat = rm_; _Pragma("unroll") for (int r = 0; r < 16; ++r) { p0[r] -= rm_; p1[r] -= rm_; negm[r] = -rm_; } asm volatile("" : "+v"(negm)); } \
        else if (__builtin_expect(__any(rm_ > THR), 0)) { const float dl = fmaxf(rm_, 0.f); mhat += dl; \
            _Pragma("unroll") for (int r = 0; r < 16; ++r) { p0[r] -= dl; p1[r] -= dl; negm[r] = -mhat; } asm volatile("" : "+v"(negm)); \
            alpha_ = __builtin_amdgcn_exp2f(-dl); ATT_RESC(alpha_); } \
        finishSM(p0, p1, alpha_, l_reg, pa0, pa1, pa2, pa3); } while (0)
#define ATT_STEP(t) do { \
        if (lag || !ATT_LATE_DMA) { ATT_DMA_K((t) + 2, sp); ATT_DMA_V((t) + 1, ((t) + 1) & 3); } \
        { bf16x8 kf_[2 * NKS]; att::VFrag va_, vb_; const int vbt_ = vb0 + (((t) - 1) & 3) * RG::VSLOT; \
          kread<NKS, ROWB, CB0, 0>(kf_, Kr + sc * RG::KSLOT, r32, hi); vread<0>(va_, vbt_); \
          asm volatile("s_waitcnt lgkmcnt(0)" ::: "memory"); ATT_SBAR(); \
          kmma<NKS, 0>(p0, p1, kf_, qr, negm); ATT_SBAR(); \
          vread<1>(vb_, vbt_); ATT_SBAR(); \
          pv_mma(o[0], va_, pa0, pa1, pa2, pa3); \
          asm volatile("s_waitcnt lgkmcnt(0)" ::: "memory"); ATT_SBAR(); \
          pv_mma(o[1], vb_, pa0, pa1, pa2, pa3); } \
        asm volatile("" : "+v"(p0), "+v"(p1), "+v"(o[0]), "+v"(o[1])); \
        if (lag) ATT_WAITBAR(); \
        if (!lag && ATT_LATE_DMA) { ATT_DMA_K((t) + 2, sp); ATT_DMA_V((t) + 1, ((t) + 1) & 3); }     \
        ATT_SOFT(t, false); \
        asm volatile("" : "+v"(pa0), "+v"(pa1), "+v"(pa2), "+v"(pa3), "+v"(l_reg)); \
        if (!lag) ATT_WAITBAR(); ATT_ROT(); } while (0)
    ATT_DMA_K(0, 0); ATT_DMA_V(0, 0); ATT_DMA_K(1, 1);
    asm volatile("s_waitcnt vmcnt(0)" ::: "memory"); __builtin_amdgcn_s_barrier(); asm volatile("" ::: "memory");
    { ATT_DMA_K(2, 2); ATT_DMA_V(1, 1);
      qkt2<NKS, ROWB, CB0>(p0, p1, Kr, qr, negm, r32, hi);
      asm volatile("" : "+v"(p0), "+v"(p1));
      if (lag) ATT_WAITBAR();
      ATT_SOFT(0, true);
      asm volatile("" : "+v"(pa0), "+v"(pa1), "+v"(pa2), "+v"(pa3), "+v"(l_reg));
      if (!lag) ATT_WAITBAR(); ATT_ROT(); }
    for (int j = 1; j < ((var & 32) ? ATT_XSTEPS : NT); ++j) ATT_STEP(j);
    pv_one<0>(o[0], vb0 + ((NT - 1) & 3) * RG::VSLOT, pa0, pa1, pa2, pa3); pv_one<1>(o[1], vb0 + ((NT - 1) & 3) * RG::VSLOT, pa0, pa1, pa2, pa3);
    asm volatile("s_waitcnt vmcnt(0)" ::: "memory"); __builtin_amdgcn_s_barrier(); asm volatile("" ::: "memory");
#undef ATT_SOFT
    { auto rr = __builtin_amdgcn_permlane32_swap(__float_as_uint(l_reg), __float_as_uint(l_reg), false, false); l_reg = __uint_as_float(rr[0]) + __uint_as_float(rr[1]); }
    l_out = l_reg; m_out = mhat;
#undef ATT_TROW
#undef ATT_DMA_K
#undef ATT_DMA_V
#undef ATT_WAITBAR
#undef ATT_RESC
#undef ATT_MASK
#undef ATT_ROT
#undef ATT_STEP
}

template <int TYPE> __device__ __forceinline__ void unit(const Tensors& Tn, LAS unsigned char* lds, const int tid, const int b, const int h, const bool lat, const int q0, const int var) {
    constexpr int NKS = TYPE == 0 ? 4 : (TYPE == 1 ? 6 : 2);
    const int lane = tid & 63, wid = __builtin_amdgcn_readfirstlane(tid >> 6), r32 = lane & 31, hi = lane >> 5;
    typedef Ring<TYPE> RG;
    LAS float* wsf = (LAS float*)(lds + RG::L_WS) + wid * 64;
    const int hw = TYPE == 0 ? h * 4 + (wid & 3) : h, wrow = TYPE == 0 ? (wid >> 2) * 32 : wid * 32;
    const int qrow0 = (lat ? b * T + q0 : RL + b * LC + q0) + wrow;
    bf16x8 qr[TYPE == 2 ? 4 : NKS];
    { const bf16* qp = TYPE == 0 ? Tn.P + (size_t)(qrow0 + r32) * LDP + P_AQ + hw * 64 : (TYPE == 1 ? Tn.QKVM + (size_t)(qrow0 + r32) * LDM + h * 96 : Tn.P + (size_t)(qrow0 + r32) * LDP + P_DQ + h * 64);
#pragma unroll
      for (int d0 = 0; d0 < (TYPE == 2 ? 4 : NKS); ++d0) qr[d0] = *(const bf16x8*)(qp + d0 * 16 + hi * 8); }
    f32x16 oA[2] = {f32x16{}, f32x16{}}; float l0, m0;
    flash_pass<TYPE, 0>(Tn, lds, tid, b, hw, lat, q0, wrow, var, qr, oA, l0, m0);
    f32x16 oB[2] = {f32x16{}, f32x16{}}; float l1 = 1.f, m1 = 0.f;
    LAS float* stash = (LAS float*)(lds + RG::L_OST + wid * 8192);
    if (TYPE == 2) {
#pragma unroll
        for (int r = 0; r < 16; ++r) { stash[r * 64 + lane] = oA[0][r]; stash[(16 + r) * 64 + lane] = oA[1][r]; }
        flash_pass<TYPE, 64>(Tn, lds, tid, b, h, lat, q0, wrow, var, qr + 2, oB, l1, m1);
#pragma unroll
        for (int r = 0; r < 16; ++r) { oA[0][r] = stash[r * 64 + lane]; oA[1][r] = stash[(16 + r) * 64 + lane]; }
        asm volatile("s_waitcnt lgkmcnt(0)" ::: "memory");
    }
    if (TYPE == 0) l0 += __builtin_amdgcn_exp2f(Tn.sink[Tn.l * 8 + hw] * 1.4426950408889634f - m0);
    if (hi == 0) { wsf[r32] = l0; if (TYPE == 2) wsf[32 + r32] = l1; }
    asm volatile("s_waitcnt lgkmcnt(0)" ::: "memory");
    LAS bf16* stg = (LAS bf16*)(lds + RG::L_OST + wid * (TYPE == 2 ? 8192 : 4096));
    if (TYPE != 2) {
#pragma unroll
        for (int r = 0; r < 16; ++r) { const float rl = __builtin_amdgcn_rcpf(wsf[crow(r, hi)]); const int orow = crow(r, hi);
            stg[orow * 64 + r32] = (bf16)f2bf(oA[0][r] * rl); stg[orow * 64 + 32 + r32] = (bf16)f2bf(oA[1][r] * rl); }
    } else {
        const float g0 = Tn.dnorm[Tn.l * 64 + r32], g1 = Tn.dnorm[Tn.l * 64 + 32 + r32];
#pragma unroll
        for (int r = 0; r < 16; ++r) { const float rl0 = __builtin_amdgcn_rcpf(wsf[crow(r, hi)]), rl1 = Tn.lam * __builtin_amdgcn_rcpf(wsf[32 + crow(r, hi)]);
            const float a0 = oA[0][r] * rl0 - oB[0][r] * rl1, a1 = oA[1][r] * rl0 - oB[1][r] * rl1;
            float ss = a0 * a0 + a1 * a1;
#pragma unroll
            for (int o_ = 1; o_ < 32; o_ <<= 1) ss += shx(ss, o_, lane);
            const float rs = (1.f - Tn.lam_init) * __builtin_amdgcn_rsqf(ss * (1.f / 64.f) + EPS); const int orow = crow(r, hi);
            stg[orow * 64 + r32] = (bf16)f2bf(a0 * rs * g0); stg[orow * 64 + 32 + r32] = (bf16)f2bf(a1 * rs * g1); }
    }
    asm volatile("s_waitcnt lgkmcnt(0)" ::: "memory");
    { bf16* Ow = Tn.O + (size_t)qrow0 * D + (TYPE == 0 ? hw * 64 : (TYPE == 1 ? 512 + h * 64 : 768 + h * 64));
#pragma unroll
      for (int i = 0; i < 4; ++i) { const int row = i * 8 + (lane >> 3), ch = lane & 7; *(u32x4*)(Ow + (size_t)row * D + ch * 8) = *(const LAS u32x4*)(stg + row * 64 + ch * 8); } }
    asm volatile("s_waitcnt lgkmcnt(0)" ::: "memory"); __builtin_amdgcn_s_barrier(); asm volatile("" ::: "memory");
}
}

__device__ __forceinline__ void attn_phase(Frame& F, const int l, const bool need_ctx) {
    att::Tensors Tn; Tn.P = F_P; Tn.QKVM = F_QKVM; Tn.O = F_O; Tn.sink = F_sink; Tn.dnorm = F_diff_norm; Tn.l = l;
    { float s1 = 0.f, s2 = 0.f;
      if (F.lane < 32) { s1 = F_lq1[l * 32 + F.lane] * F_lk1[l * 32 + F.lane]; s2 = F_lq2[l * 32 + F.lane] * F_lk2[l * 32 + F.lane]; }
      s1 = wave_sum(s1, F.lane); s2 = wave_sum(s2, F.lane);
      int ll_ = l; asm volatile("" : "+s"(ll_));
      const float li_ = ll_ == 0 ? 0.200000000f : (ll_ == 1 ? 0.355509068f : (ll_ == 2 ? 0.470713018f : 0.556058204f));
      const float lm_ = __expf(s1) - __expf(s2) + li_;
      Tn.lam_init = li_; Tn.lam = __builtin_bit_cast(float, __builtin_amdgcn_readfirstlane(__builtin_bit_cast(int, lm_))); }
    const int b = F.bid & 7, j = F.bid >> 3;
    if (F.G != 256) return;
    const int nu = (need_ctx && j < 16) ? 5 : 4;
    for (int u = 0; u < nu + ATT_EXTRA; ++u) {
        int type, h, q0; bool lat = true; const int var = u >= nu ? ATT_XVAR : 0;
        if (u >= nu) { type = ATT_EXTRA_TYPE; h = ATT_EXTRA_TYPE == 0 ? ((j >> 3) & 1) : (j >> 3); q0 = ATT_EXTRA_TYPE == 0 ? j * 64 : (j & 7) * 256; Tn.O = F_ACT; }
        else if (u == 0) { type = 2; h = j >> 3; q0 = (j & 7) * 256; }
        else if (u == 1) { type = 1; h = j >> 3; q0 = (j & 7) * 256; }
        else if (u < 4) { type = 0; h = u - 2; q0 = j * 64; }
        else { lat = false; q0 = 0; if (j < 8) { type = 0; h = j >> 2; q0 = (j & 3) * 64; } else if (j < 12) { type = 1; h = j - 8; } else { type = 2; h = j - 12; } }
        int t_ = F.tid; asm volatile("" : "+v"(t_));
        if (type == 0) att::unit<0>(Tn, F.lds, t_, b, h, lat, q0, var);
        else if (type == 1) att::unit<1>(Tn, F.lds, t_, b, h, lat, q0, var);
        else att::unit<2>(Tn, F.lds, t_, b, h, lat, q0, var);
    }
}

enum { PH_P0 = 0, PH_L0 = 1, PH_PER_LAYER = 9, PH_FINAL = PH_L0 + DEPTH * PH_PER_LAYER, NPH = PH_FINAL + 1 };
enum { SP_NORM1 = 0, SP_INPROJ = 1, SP_UP = 2, SP_ATTN = 3, SP_OUT = 4, SP_NORM2 = 5, SP_TOPK = 6, SP_MOE1 = 7, SP_MOE2 = 8 };

#ifndef REPS_INIT
#define REPS_INIT {1, 1, 1, 1, 1, 1, 1, 1, 1}
#endif
#ifndef REP_P0
#define REP_P0 1
#endif
#ifndef REP_FINAL
#define REP_FINAL 1
#endif
#ifndef KROT_ON
#define KROT_ON 0
#endif
#ifndef PROBE_NOMMA
#define PROBE_NOMMA 0
#endif
#ifndef PHMASK
#define PHMASK 0x3ff
#endif
#define PHON(b) ((PHMASK >> (b)) & 1)
#define REPSEL(s) ((s) == 0 ? reps_sp[0] : (s) == 1 ? reps_sp[1] : (s) == 2 ? reps_sp[2] : (s) == 3 ? reps_sp[3] : (s) == 4 ? reps_sp[4] : (s) == 5 ? reps_sp[5] : (s) == 6 ? reps_sp[6] : (s) == 7 ? reps_sp[7] : reps_sp[8])
__global__ void __launch_bounds__(NWAVES * 64, 2) mk(Args args) {
    extern __shared__ __attribute__((aligned(16))) unsigned char lds_raw[];
    Frame F;
    F.lds = (LAS unsigned char*)lds_raw;
    F.tid = threadIdx.x; F.lane = F.tid & 63; F.wave = __builtin_amdgcn_readfirstlane(F.tid >> 6); F.bid = blockIdx.x; F.G = gridDim.x;
    const int wave_s = F.wave;
    F.in = (const float* const*)args.in; F.out = (GAS float*)args.out; F.ws = (GAS unsigned char*)args.ws;
    volatile LAS unsigned* MISC = (volatile LAS unsigned*)(F.lds + MISC_OFF);
    for (int u = F.tid; u < (LDS_BYTES - LDSCTL_OFF) / 4; u += NWAVES * 64) ((LAS unsigned*)(F.lds + LDSCTL_OFF))[u] = 0u;
    __syncthreads();
    XcdBarrier bar = xcd_barrier_post((unsigned*)(args.ws + WS_CTL) + CW_BAR + args.li * XCD_BAR_WORDS, MISC + 8);
    const int gx = F.bid & 7, gj = F.bid >> 3, gpx = F.G >> 3, krot = KROT_ON ? (gj & 7) + 3 * (gj >> 3) : 0;
    constexpr int reps_sp[9] = REPS_INIT;
    for (int ph = args.ph_lo; ph < args.ph_hi; ++ph) {
      const int nrep = ph == PH_P0 ? REP_P0 : (ph == PH_FINAL ? REP_FINAL : (REPSEL((ph - PH_L0) % PH_PER_LAYER)));
      for (int rep = 0; rep < nrep; ++rep) {
        const float keep = rep + 1 == nrep ? 1.f : 0.f;
        { unsigned char* w_ = args.ws; asm volatile("" : "+s"(w_)); F.ws = (GAS unsigned char*)w_; int z_ = 0; asm volatile("" : "+s"(z_)); F.in = (const float* const*)args.in + z_;
          int l_; asm volatile("v_mbcnt_lo_u32_b32 %0, -1, 0\n\tv_mbcnt_hi_u32_b32 %0, -1, %0" : "=v"(l_));
          int w_s = wave_s; asm volatile("" : "+s"(w_s)); F.lane = l_; F.wave = w_s; F.tid = w_s * 64 + l_; }
        if (ph == PH_P0) { if (PHON(9)) p0_phase(F); }
        else if (ph == PH_FINAL) { if (PHON(0)) norm_phase(F, DEPTH, 2, RL, keep); }
        else {
            const int l = (ph - PH_L0) / PH_PER_LAYER, sp = (ph - PH_L0) % PH_PER_LAYER;
            const bool need_ctx = l < DEPTH - 1; const int rows_mix = need_ctx ? R : RL;
            const bf16* wl = F_WB + (size_t)l * W_LAYER;
            if (sp == SP_NORM1) { if (PHON(0)) norm_phase(F, l, 0, R, keep); }
            else if (sp == SP_INPROJ && PHON(1)) {
                pg8::Gemm g{F_ACT, wl + W_IN, nullptr, 0, D, D}; OrderRows S{gx, gj, gpx, R / 192 / 8, LDP / 256, (PROBE_NOMMA && rep + 1 < nrep) ? 1 : 0, krot, 192};
                EpiInProj<3> E{F_P, F_ROPE, F_RSQ};
                pg8::gemm_phase<false, 3>(F.lds, F.tid, g, S, E);
                { const int nbusy = 8;
                  if (BG_PREP && l + 1 < DEPTH && rep + 1 == nrep && gj >= nbusy) prep_layer(F, l + 1, ((gx * (gpx - nbusy) + (gj - nbusy)) * NWAVES) + F.wave, 8 * (gpx - nbusy) * NWAVES); }
            } else if (sp == SP_UP && PHON(2)) {
                pg8::Gemm g{F_P + P_CQ, wl + W_UP, nullptr, 0, LDP, UPK}; OrderRows S{gx, gj, gpx, R / 192 / 8, 4, 0, krot, 192};
                EpiUp<3> E{F_QKVM, F_ROPE, F_RSQ};
                pg8::gemm_phase<false, 3>(F.lds, F.tid, g, S, E);
            } else if (sp == SP_ATTN) { if (PHON(3)) attn_phase(F, l, need_ctx);
            } else if (sp == SP_OUT && PHON(4)) {
                pg8::Gemm g{F_O, wl + W_OUT, nullptr, 0, D, D};
                if (need_ctx) { OrderRows S{gx, gj, gpx, R / 192 / 8, 4, 0, krot, 192}; EpiOut<3> E{F_X, F_MOD + (size_t)l * 9 * 6144, keep, F_x, F_ctx, 0}; pg8::gemm_phase<false, 3>(F.lds, F.tid, g, S, E); }
                else { OrderRows S{gx, gj, gpx, RL / 256 / 8, 4, 0, krot, 256}; EpiOut<4> E{F_X, F_MOD + (size_t)l * 9 * 6144, keep, F_x, F_ctx, 0}; pg8::gemm_phase<false, 4>(F.lds, F.tid, g, S, E); }
            } else if (sp == SP_NORM2) { if (PHON(5)) norm_phase(F, l, 1, rows_mix, keep); }
            else if (sp == SP_TOPK) { if (PHON(6)) topk_phase(F, need_ctx ? 16 : 8); }
            else if (sp == SP_MOE1 && PHON(7)) {
                pg8::Gemm g{F_ACT, wl + W_GU, F_STOK, (size_t)1024 * 1024, D, D};
                if (need_ctx) { OrderMoe S{gx, gj, gpx, 12, 4, krot, 192}; EpiGU<3> E{F_HID}; pg8::gemm_phase<true, 3>(F.lds, F.tid, g, S, E); }
                else { OrderMoe S{gx, gj, gpx, 8, 4, krot, 256}; EpiGU<4> E{F_HID}; pg8::gemm_phase<true, 4>(F.lds, F.tid, g, S, E); }
            } else if (sp == SP_MOE2 && PHON(8)) {
                pg8::Gemm g{F_HID, wl + W_DN, nullptr, (size_t)1024 * 512, DE, DE};
                if (need_ctx) { OrderMoe S{gx, gj, gpx, 12, 4, krot, 192}; EpiDown<3> E{F_Y, F_SGATE}; pg8::gemm_phase<false, 3>(F.lds, F.tid, g, S, E); }
                else { OrderMoe S{gx, gj, gpx, 8, 4, krot, 256}; EpiDown<4> E{F_Y, F_SGATE}; pg8::gemm_phase<false, 4>(F.lds, F.tid, g, S, E); }
            }
        }
        if (ph + 1 < args.ph_hi || rep + 1 < nrep) { xcd_barrier(bar, F.tid);
#ifdef EXTRA_BAR
            xcd_barrier(bar, F.tid);
#endif
        }
      }
    }
}

extern "C" void kernel_launch(void* const* d_in, const int* in_sizes, int n_in, void* d_out, int out_size, void* d_ws, size_t ws_size, hipStream_t stream) {
    static int grid = 0;
    if (grid == 0) {
        if (n_in != 25 || ws_size < WS_END || out_size != RL * D) { fprintf(stderr, "kernel_launch: unexpected shapes (n_in %d, ws %zu < %zu, out %d)\n", n_in, ws_size, (size_t)WS_END, out_size); grid = -1; return; }
        int dev = 0, cus = 0, per_cu = 0;
        if (hipGetDevice(&dev) != hipSuccess || hipDeviceGetAttribute(&cus, hipDeviceAttributeMultiprocessorCount, dev) != hipSuccess) { grid = -1; return; }
        if (hipFuncSetAttribute((const void*)mk, hipFuncAttributeMaxDynamicSharedMemorySize, LDS_BYTES) != hipSuccess) { fprintf(stderr, "kernel_launch: hipFuncSetAttribute failed\n"); grid = -1; return; }
        if (hipOccupancyMaxActiveBlocksPerMultiprocessor(&per_cu, (const void*)mk, NWAVES * 64, LDS_BYTES) != hipSuccess || per_cu < 1) { fprintf(stderr, "kernel_launch: occupancy query says %d\n", per_cu); }
        (void)hipGetLastError();
        grid = cus;
        if (grid % 8 != 0) { fprintf(stderr, "kernel_launch: %d CUs, expected a multiple of 8\n", grid); grid = -1; return; }
    }
    if (grid < 0) return;
    (void)hipMemsetAsync((char*)d_ws + WS_CTL, 0, CTL_ZERO_BYTES, stream);
    Args a; memset(&a, 0, sizeof a);
    for (int i = 0; i < 25; ++i) a.in[i] = (const float*)d_in[i];
    a.out = (float*)d_out; a.ws = (unsigned char*)d_ws;
    a.ph_lo = 0; a.ph_hi = NPH; a.li = 0;
    hipLaunchKernelGGL(mk, dim3(grid), dim3(NWAVES * 64), LDS_BYTES, stream, a);
}
```

```cpp
#include <hip/hip_runtime.h>
#include <stdint.h>
#include <string.h>
#include <stdio.h>

typedef unsigned short bf16;
typedef unsigned u32x4 __attribute__((ext_vector_type(4)));
typedef unsigned u32x2 __attribute__((ext_vector_type(2)));
typedef float f32x4 __attribute__((ext_vector_type(4)));
typedef float f32x16 __attribute__((ext_vector_type(16)));
typedef short bf16x8 __attribute__((ext_vector_type(8)));
#define LAS __attribute__((address_space(3)))
#define GAS __attribute__((address_space(1)))

constexpr int D = 1024, NB = 8, T = 2048, LC = 256, DEPTH = 4;
constexpr int RL = NB * T, RC = NB * LC, R = RL + RC;
constexpr int INW = 1952, LDP = 2048;
constexpr int NE = 16, DE = 512;
constexpr int CAPL = 256, CAPC = 32;
constexpr int SLOTS_E = NB * CAPL + NB * CAPC;
constexpr int SLOTS = NE * SLOTS_E;
constexpr float EPS = 1e-6f;
constexpr int P_AQ = 0, P_AK = 512, P_AV = 640, P_CQ = 768, P_CKV = 1024, P_KR = 1152, P_DQ = 1184, P_DK = 1440, P_DV = 1696;
constexpr int LDM = 1024;
constexpr int UPK = 384;

constexpr size_t MiB = 1u << 20;
constexpr size_t WS_CTL = 0;
constexpr size_t CTL_ZERO_BYTES = 256 * 1024;
constexpr size_t WS_MOD = 1 * MiB;
constexpr size_t WS_ROPE = 2 * MiB;
constexpr size_t WS_RSQ = 3 * MiB;
constexpr size_t WS_AFF = 4 * MiB;
constexpr size_t WS_INV = 6 * MiB;
constexpr size_t WS_STOK = 8 * MiB;
constexpr size_t WS_SGATE = 9 * MiB;
constexpr size_t WS_X = 10 * MiB;
constexpr size_t WS_ACT = 82 * MiB;
constexpr size_t WS_P = 118 * MiB;
constexpr size_t WS_Y = WS_P;
constexpr size_t WS_QKVM = 190 * MiB;
constexpr size_t WS_O = 226 * MiB;
constexpr size_t WS_HID = WS_O;
constexpr size_t WS_W = 262 * MiB;
constexpr size_t W_IN = 0;
constexpr size_t W_UP = W_IN + (size_t)LDP * D;
constexpr size_t W_OUT = W_UP + (size_t)1024 * UPK;
constexpr size_t W_GU = W_OUT + (size_t)D * D;
constexpr size_t W_DN = W_GU + (size_t)NE * 1024 * 1024;
constexpr size_t W_LAYER = W_DN + (size_t)NE * 1024 * 512;
constexpr size_t WS_END = WS_W + (size_t)DEPTH * W_LAYER * 2;

__device__ __forceinline__ unsigned f2bf(float f) { unsigned u = __builtin_bit_cast(unsigned, f); return (u + 0x7fffu + ((u >> 16) & 1u)) >> 16; }
__device__ __forceinline__ float bf2f(unsigned h) { return __builtin_bit_cast(float, h << 16); }
__device__ __forceinline__ unsigned pk2(float lo, float hi) { return f2bf(lo) | (f2bf(hi) << 16); }
__device__ __forceinline__ float shx(float v, int o, int lane) { return __builtin_bit_cast(float, __builtin_amdgcn_ds_bpermute((lane ^ o) << 2, __builtin_bit_cast(int, v))); }
__device__ __forceinline__ int shi(int v, int src) { return __builtin_amdgcn_ds_bpermute(src << 2, v); }
__device__ __forceinline__ float wave_sum(float v, int lane) {
#pragma unroll
    for (int o = 1; o < 64; o <<= 1) v += shx(v, o, lane);
    return v;
}
__device__ __forceinline__ float siluf(float v) { return v / (1.f + __expf(-v)); }
#define LDS_WAIT() asm volatile("s_waitcnt lgkmcnt(0)" ::: "memory")
#define VM_WAIT() asm volatile("s_waitcnt vmcnt(0)" ::: "memory")

struct Args {
    const float* in[25]; float* out; unsigned char* ws; int ph_lo, ph_hi, li, pad;
};

#ifndef PROBE_HOT
#define PROBE_HOT 0
#endif
#ifndef PROBE_NOEPI
#define PROBE_NOEPI 0
#endif
#ifndef PROBE_NOLDS
#define PROBE_NOLDS 0
#endif
#ifndef GEMM_ASKIP
#define GEMM_ASKIP 0
#endif
namespace pg8 {
constexpr int BM = 256, BK = 64, HALF = 128, HTB = HALF * BK * 2  , STAGE_BYTES = 8 * HTB;
__host__ __device__ __forceinline__ int lds_byte(int r, int c) { const int st = (r >> 4) * 2 + (c >> 5), rr = r & 15, cc = c & 31, ob = rr * 64 + cc * 2; return st * 1024 + (ob ^ (((ob >> 9) & 1) << 5)); }
__host__ __device__ __forceinline__ void stage_rc(int b, int& R, int& C) { const int st = b / 1024, sb = b % 1024, swz = sb ^ (((sb >> 9) & 1) << 5); R = (st >> 1) * 16 + swz / 64; C = (st & 1) * 32 + (swz % 64) / 2; }
__host__ __device__ __forceinline__ int perm32(int rho) { const int n = rho >> 4, i = rho & 15; return 8 * (i >> 2) + 4 * n + (i & 3); }

struct Unit { int arow0, orow0, col0, e, quad; };
struct Gemm { const bf16* A; const bf16* Bt; const int* gather; size_t b_estride; int lda, K; };

template <bool GATHER, int MF, class Epi, class Sched>
__device__ __forceinline__ void gemm_phase(LAS unsigned char* lds, const int tid, const Gemm g, const Sched& S, const Epi& E) {
    const int wid = __builtin_amdgcn_readfirstlane(tid >> 6), lane = tid & 63, wr = wid >> 2, wc = wid & 3, fr = lane & 15, fq = lane >> 4;
    constexpr bool ASKIP = (MF == 3) && GEMM_ASKIP;
    constexpr int HR = 32 * MF;
    const int K = g.K, nt = K / BK;
    unsigned voffA[2], voffB[2]; int sR[2];
#pragma unroll
    for (int i = 0; i < 2; ++i) { int C_; stage_rc(tid * 16 + i * 8192, sR[i], C_); const int Rb = (sR[i] & ~31) + perm32(sR[i] & 31);
        voffA[i] = GATHER ? (unsigned)C_ * 2u : (unsigned)(sR[i] * g.lda + C_) * 2u; voffB[i] = (unsigned)(Rb * K + C_) * 2u; }
    const unsigned lda2 = (unsigned)g.lda * 2u;
    const unsigned hstepA = (unsigned)HR * g.lda * 2u;
    const unsigned kstep = (unsigned)(BK * 2);
    const int krot = (2 * S.rot) % nt;
#define PG8_KT(i) ((PROBE_HOT && hot_) ? 0u : (unsigned)(((i) + krot) >= nt ? (i) + krot - nt : (i) + krot) * kstep)
    const unsigned hstepB = (unsigned)HALF * K * 2u;
    const __amdgpu_buffer_rsrc_t rsA = __builtin_amdgcn_make_buffer_rsrc((void*)g.A, 0, 0x7fffffff, 0x00020000);
    const __amdgpu_buffer_rsrc_t rsB = __builtin_amdgcn_make_buffer_rsrc((void*)g.Bt, 0, 0x7fffffff, 0x00020000);
    const unsigned ldsw = (unsigned)wid * 1024u;
    const int aoff = lds_byte(wr * (16 * MF) + fr, fq * 8), boff = lds_byte(wc * 32 + fr, fq * 8);
#define PG8_SA(b, h) (((b) * 2 + (h)) * HTB)
#define PG8_SB(b, h) ((4 + (b) * 2 + (h)) * HTB)
#define PG8_STAGE2(bufoff, rsrc, v0, v1, soff) do { \
        __builtin_amdgcn_raw_ptr_buffer_load_lds(rsrc, (LAS unsigned*)(lds + (bufoff) + ldsw), 16, (int)(v0), (int)(soff), 0, 0); \
        __builtin_amdgcn_raw_ptr_buffer_load_lds(rsrc, (LAS unsigned*)(lds + (bufoff) + ldsw + 8192), 16, (int)(v1), (int)(soff), 0, 0); } while (0)
#define PG8_STAGEB(bufoff, soff) PG8_STAGE2(bufoff, rsB, voffB[0], voffB[1], soff)
#define PG8_STAGE1(bufoff, rsrc, v0, soff) __builtin_amdgcn_raw_ptr_buffer_load_lds(rsrc, (LAS unsigned*)(lds + (bufoff) + ldsw), 16, (int)(v0), (int)(soff), 0, 0)
#define PG8_STAGEA(bufoff, ubase, r0, r1, h, koff) do { if constexpr (GATHER) { \
        if (ASKIP && wr == 1) PG8_STAGE1(bufoff, rsA, (((r0) >> (16 * (h))) & 0xffffu) * lda2 + voffA[0], (koff)); \
        else PG8_STAGE2(bufoff, rsA, (((r0) >> (16 * (h))) & 0xffffu) * lda2 + voffA[0], (((r1) >> (16 * (h))) & 0xffffu) * lda2 + voffA[1], (koff)); } \
        else { if (ASKIP && wr == 1) PG8_STAGE1(bufoff, rsA, voffA[0], (ubase) + (h) * hstepA + (koff)); \
        else PG8_STAGE2(bufoff, rsA, voffA[0], voffA[1], (ubase) + (h) * hstepA + (koff)); } } while (0)
#define PG8_LDA(dst, b, h) do { if (PROBE_NOLDS && hot_) break; _Pragma("unroll") for (int m = 0; m < MF; ++m) _Pragma("unroll") for (int k = 0; k < 2; ++k) dst[m][k] = *(const LAS bf16x8*)(lds + PG8_SA(b, h) + aoff + m * 2048 + k * 1024); } while (0)
#define PG8_LDB(dst, b, h) do { if (PROBE_NOLDS && hot_) break; _Pragma("unroll") for (int n = 0; n < 2; ++n) _Pragma("unroll") for (int k = 0; k < 2; ++k) dst[n][k] = *(const LAS bf16x8*)(lds + PG8_SB(b, h) + boff + n * 2048 + k * 1024); } while (0)
#define PG8_MMA(ai, bj, At, Bt) do { __builtin_amdgcn_s_setprio(1); _Pragma("unroll") for (int m = 0; m < MF; ++m) _Pragma("unroll") for (int n = 0; n < 2; ++n) _Pragma("unroll") for (int k = 0; k < 2; ++k) \
        acc[ai][bj][m][n] = __builtin_amdgcn_mfma_f32_16x16x32_bf16(Bt[n][k], At[m][k], acc[ai][bj][m][n], 0, 0, 0); __builtin_amdgcn_s_setprio(0); } while (0)
#define PG8_WAIT_V(n) asm volatile("s_waitcnt vmcnt(" #n ")" ::: "memory")
#define PG8_WAIT_V2(n, nskip) do { if (ASKIP && wr == 1) PG8_WAIT_V(nskip); else PG8_WAIT_V(n); } while (0)
#define PG8_WAIT_L(n) asm volatile("s_waitcnt lgkmcnt(" #n ")" ::: "memory")
#define PG8_BAR __builtin_amdgcn_s_barrier()
#define PG8_SCHED __builtin_amdgcn_sched_barrier(0)
#define PG8_ROWS(dst, u) do { if constexpr (GATHER) { _Pragma("unroll") for (int i = 0; i < 2; ++i) { \
        const int sr_ = sR[i] < HR ? sR[i] : sR[i] - 32;     \
        const unsigned a_ = (unsigned)g.gather[(u).arow0 + sr_], b_ = (unsigned)g.gather[(u).arow0 + ((u).quad ? 0 : HR) + sr_]; dst[i] = a_ | (b_ << 16); } \
        asm volatile("" : "+v"(dst[0]), "+v"(dst[1])); } } while (0)
    Unit cur, nxt; int ui = 0;
    if (!S.next(0, cur)) return;
    const bool hot_ = cur.quad == 2;
    f32x4 acc[2][2][MF][2];
#pragma unroll
    for (int a = 0; a < 2; ++a)
#pragma unroll
        for (int b = 0; b < 2; ++b)
#pragma unroll
            for (int m = 0; m < MF; ++m)
#pragma unroll
                for (int n = 0; n < 2; ++n) acc[a][b][m][n] = (f32x4){0.f, 0.f, 0.f, 0.f};
    bf16x8 At[MF][2], B0[2][2], B1[2][2];
    unsigned rp[2] = {0u, 0u}, rn[2] = {0u, 0u};
    PG8_ROWS(rp, cur);
    unsigned cA = (unsigned)cur.arow0 * lda2;
    unsigned cB = (unsigned)(((size_t)cur.e * g.b_estride + (size_t)cur.col0 * K) * 2);
    PG8_STAGEB(PG8_SB(0, 0), cB + PG8_KT(0)); PG8_STAGEB(PG8_SB(0, 1), cB + hstepB + PG8_KT(0)); PG8_STAGEA(PG8_SA(0, 0), cA, rp[0], rp[1], 0, PG8_KT(0)); PG8_STAGEA(PG8_SA(0, 1), cA, rp[0], rp[1], 1, PG8_KT(0));
    if (wr == 1) PG8_BAR;
    PG8_WAIT_V2(2, 1); PG8_BAR;
    PG8_STAGEB(PG8_SB(1, 0), cB + PG8_KT(1)); PG8_STAGEA(PG8_SA(1, 0), cA, rp[0], rp[1], 0, PG8_KT(1)); PG8_STAGEB(PG8_SB(1, 1), cB + hstepB + PG8_KT(1));
    PG8_WAIT_V2(6, 5); PG8_BAR;
    for (;;) {
        const bool has_next = S.next(ui + 1, nxt);
        if (has_next) { PG8_ROWS(rn, nxt); } else { rn[0] = rp[0]; rn[1] = rp[1]; }
        const unsigned nA = has_next ? (unsigned)nxt.arow0 * lda2 : cA;
        const unsigned nB = has_next ? (unsigned)(((size_t)nxt.e * g.b_estride + (size_t)nxt.col0 * K) * 2) : cB;
#pragma unroll 1
        for (int t = 0; t < nt; t += 2) {
            const bool last = (t == nt - 2);
            const unsigned k1 = PG8_KT(t + 1), k2 = last ? PG8_KT(0) : PG8_KT(t + 2), k3 = last ? PG8_KT(1) : PG8_KT(t + 3);
            const unsigned u2 = last ? nA : cA; const unsigned b2 = (last ? nB : cB) + k2; const unsigned b3 = (last ? nB : cB) + k3;
            const unsigned q0 = last ? rn[0] : rp[0], q1 = last ? rn[1] : rp[1];
            PG8_LDB(B0, 0, 0); PG8_LDB(B1, 0, 1); PG8_SCHED; PG8_LDA(At, 0, 0); PG8_STAGEA(PG8_SA(1, 1), cA, rp[0], rp[1], 1, k1);
            PG8_WAIT_V2(8, 6); PG8_WAIT_L(0); PG8_BAR; if (cur.quad < 2) PG8_MMA(0, 0, At, B0); if (!cur.quad) PG8_MMA(0, 1, At, B1); PG8_BAR; PG8_SCHED;
            PG8_LDA(At, 0, 1); PG8_STAGEB(PG8_SB(0, 0), b2); PG8_STAGEB(PG8_SB(0, 1), b2 + hstepB); PG8_STAGEA(PG8_SA(0, 0), u2, q0, q1, 0, k2);
            PG8_WAIT_V2(8, 6); PG8_WAIT_L(0); PG8_BAR; if (!cur.quad) { PG8_MMA(1, 0, At, B0); PG8_MMA(1, 1, At, B1); } PG8_BAR; PG8_SCHED;
            PG8_LDB(B0, 1, 0); PG8_LDB(B1, 1, 1); PG8_SCHED; PG8_LDA(At, 1, 0); PG8_STAGEA(PG8_SA(0, 1), u2, q0, q1, 1, k2);
            PG8_WAIT_V2(8, 6); PG8_WAIT_L(0); PG8_BAR; if (cur.quad < 2) PG8_MMA(0, 0, At, B0); if (!cur.quad) PG8_MMA(0, 1, At, B1); PG8_BAR; PG8_SCHED;
            PG8_LDA(At, 1, 1); PG8_STAGEB(PG8_SB(1, 0), b3); PG8_STAGEB(PG8_SB(1, 1), b3 + hstepB); PG8_STAGEA(PG8_SA(1, 0), u2, q0, q1, 0, k3);
            PG8_WAIT_V2(8, 6); PG8_WAIT_L(0); PG8_BAR; if (!cur.quad) { PG8_MMA(1, 0, At, B0); PG8_MMA(1, 1, At, B1); } PG8_BAR; PG8_SCHED;
        }
        if (wr == 0) PG8_BAR;
        if (!(PROBE_NOEPI && hot_)) E(acc, cur, wr, wc, fr, fq);
        if (!has_next) break;
#pragma unroll
        for (int a = 0; a < 2; ++a)
#pragma unroll
            for (int b = 0; b < 2; ++b)
#pragma unroll
                for (int m = 0; m < MF; ++m)
#pragma unroll
                    for (int n = 0; n < 2; ++n) acc[a][b][m][n] = (f32x4){0.f, 0.f, 0.f, 0.f};
        cur = nxt; cB = nB; cA = nA; ++ui; rp[0] = rn[0]; rp[1] = rn[1];
        if (wr == 1) PG8_BAR;
    }
    PG8_WAIT_V(0);
    PG8_BAR;
#undef PG8_SA
#undef PG8_SB
#undef PG8_STAGE2
#undef PG8_STAGEB
#undef PG8_LDA
#undef PG8_LDB
#undef PG8_MMA
#undef PG8_WAIT_V
#undef PG8_WAIT_V2
#undef PG8_STAGE1
#undef PG8_WAIT_L
#undef PG8_BAR
#undef PG8_SCHED
#undef PG8_KT
#undef PG8_ROWS
#undef PG8_STAGEA
}
constexpr int PTB = 96 * BK * 2, SB_OFF = 6 * PTB, STAGE288_BYTES = SB_OFF + 4 * HTB;
template <bool GATHER, class Epi, class Sched>
__device__ __forceinline__ void gemm_phase288(LAS unsigned char* lds, const int tid, const Gemm g, const Sched& S, const Epi& E) {
    constexpr int MF = 3;
    const int wid = __builtin_amdgcn_readfirstlane(tid >> 6), lane = tid & 63, wr = wid >> 2, wc = wid & 3, fr = lane & 15, fq = lane >> 4;
    const int K = g.K, nt = K / BK;
    unsigned voffA[2], voffB[2]; int sR[2];
#pragma unroll
    for (int i = 0; i < 2; ++i) { int C_; stage_rc(tid * 16 + i * 8192, sR[i], C_); const int Rb = (sR[i] & ~31) + perm32(sR[i] & 31);
        if (sR[i] > 95) sR[i] = 95;
        voffA[i] = GATHER ? (unsigned)C_ * 2u : (unsigned)(sR[i] * g.lda + C_) * 2u; voffB[i] = (unsigned)(Rb * K + C_) * 2u; }
    const unsigned lda2 = (unsigned)g.lda * 2u;
    const unsigned pstepA = 96u * g.lda * 2u;
    const unsigned kstep = (unsigned)(BK * 2);
    const unsigned hstepB = (unsigned)HALF * K * 2u;
    const __amdgpu_buffer_rsrc_t rsA = __builtin_amdgcn_make_buffer_rsrc((void*)g.A, 0, 0x7fffffff, 0x00020000);
    const __amdgpu_buffer_rsrc_t rsB = __builtin_amdgcn_make_buffer_rsrc((void*)g.Bt, 0, 0x7fffffff, 0x00020000);
    const unsigned ldsw = (unsigned)wid * 1024u;
    const int aoff = lds_byte(wr * 48 + fr, fq * 8), boff = lds_byte(wc * 32 + fr, fq * 8);
#define PG9_SA(b, a) (((b) * 3 + (a)) * PTB)
#define PG9_SB(b, h) (SB_OFF + ((b) * 2 + (h)) * HTB)
#define PG9_DMA(rsrc, dstoff, v, soff) __builtin_amdgcn_raw_ptr_buffer_load_lds(rsrc, (LAS unsigned*)(lds + (dstoff) + ldsw), 16, (int)(v), (int)(soff), 0, 0)
#define PG9_STAGEB(bufoff, soff) do { PG9_DMA(rsB, (bufoff), voffB[0], (soff)); PG9_DMA(rsB, (bufoff) + 8192, voffB[1], (soff)); } while (0)
#define PG9_RIDX(r, a, i) ((a) < 2 ? (((r)[i] >> (16 * (a))) & 0xffffu) : (((r)[2] >> (16 * (i))) & 0xffffu))
#define PG9_STAGEA(bufoff, ubase, r, a, koff) do { if constexpr (GATHER) { \
        PG9_DMA(rsA, (bufoff), PG9_RIDX(r, a, 0) * lda2 + voffA[0], (koff)); if (wr == 0) PG9_DMA(rsA, (bufoff) + 8192, PG9_RIDX(r, a, 1) * lda2 + voffA[1], (koff)); } \
        else { PG9_DMA(rsA, (bufoff), voffA[0], (ubase) + (a) * pstepA + (koff)); if (wr == 0) PG9_DMA(rsA, (bufoff) + 8192, voffA[1], (ubase) + (a) * pstepA + (koff)); } } while (0)
#define PG9_LDA(dst, b, a) do { _Pragma("unroll") for (int m = 0; m < MF; ++m) _Pragma("unroll") for (int k = 0; k < 2; ++k) dst[m][k] = *(const LAS bf16x8*)(lds + PG9_SA(b, a) + aoff + m * 2048 + k * 1024); } while (0)
#define PG9_LDB(dst, b, h) do { _Pragma("unroll") for (int n = 0; n < 2; ++n) _Pragma("unroll") for (int k = 0; k < 2; ++k) dst[n][k] = *(const LAS bf16x8*)(lds + PG9_SB(b, h) + boff + n * 2048 + k * 1024); } while (0)
#define PG9_MMA(ai, bj, At, Bt) do { __builtin_amdgcn_s_setprio(1); _Pragma("unroll") for (int m = 0; m < MF; ++m) _Pragma("unroll") for (int n = 0; n < 2; ++n) _Pragma("unroll") for (int k = 0; k < 2; ++k) \
        acc[ai][bj][m][n] = __builtin_amdgcn_mfma_f32_16x16x32_bf16(Bt[n][k], At[m][k], acc[ai][bj][m][n], 0, 0, 0); __builtin_amdgcn_s_setprio(0); } while (0)
#define PG9_WAIT_V(n) asm volatile("s_waitcnt vmcnt(" #n ")" ::: "memory")
#define PG9_WAIT_V2(n0, n1) do { if (wr == 1) PG9_WAIT_V(n1); else PG9_WAIT_V(n0); } while (0)
#define PG9_WAIT_L(n) asm volatile("s_waitcnt lgkmcnt(" #n ")" ::: "memory")
#define PG9_BAR __builtin_amdgcn_s_barrier()
#define PG9_SCHED __builtin_amdgcn_sched_barrier(0)
#define PG9_ROWS(dst, u) do { if constexpr (GATHER) { unsigned t2_[2]; _Pragma("unroll") for (int i = 0; i < 2; ++i) { \
        const unsigned a_ = (unsigned)g.gather[(u).arow0 + sR[i]], b_ = (unsigned)g.gather[(u).arow0 + 96 + sR[i]]; t2_[i] = (unsigned)g.gather[(u).arow0 + 192 + sR[i]]; dst[i] = a_ | (b_ << 16); } \
        dst[2] = t2_[0] | (t2_[1] << 16); asm volatile("" : "+v"(dst[0]), "+v"(dst[1]), "+v"(dst[2])); } } while (0)
    Unit cur, nxt; int ui = 0;
    if (!S.next(0, cur)) return;
    f32x4 acc[3][2][MF][2];
#pragma unroll
    for (int a = 0; a < 3; ++a)
#pragma unroll
        for (int b = 0; b < 2; ++b)
#pragma unroll
            for (int m = 0; m < MF; ++m)
#pragma unroll
                for (int n = 0; n < 2; ++n) acc[a][b][m][n] = (f32x4){0.f, 0.f, 0.f, 0.f};
    bf16x8 At[MF][2], B0[2][2], B1[2][2];
    unsigned rp[3] = {0u, 0u, 0u}, rn[3] = {0u, 0u, 0u};
    PG9_ROWS(rp, cur);
    unsigned cA = (unsigned)cur.arow0 * lda2;
    unsigned cB = (unsigned)(((size_t)cur.e * g.b_estride + (size_t)cur.col0 * K) * 2);
    PG9_STAGEB(PG9_SB(0, 0), cB); PG9_STAGEB(PG9_SB(0, 1), cB + hstepB); PG9_STAGEA(PG9_SA(0, 0), cA, rp, 0, 0u); PG9_STAGEA(PG9_SA(0, 1), cA, rp, 1, 0u); PG9_STAGEA(PG9_SA(0, 2), cA, rp, 2, 0u);
    PG9_STAGEB(PG9_SB(1, 0), cB + kstep); PG9_STAGEB(PG9_SB(1, 1), cB + hstepB + kstep); PG9_STAGEA(PG9_SA(1, 0), cA, rp, 0, kstep); PG9_STAGEA(PG9_SA(1, 1), cA, rp, 1, kstep);
    PG9_WAIT_V2(12, 8); PG9_BAR;
    if (wr == 1) PG9_BAR;
    for (;;) {
        const bool has_next = S.next(ui + 1, nxt);
        if (has_next) { PG9_ROWS(rn, nxt); } else { rn[0] = rp[0]; rn[1] = rp[1]; rn[2] = rp[2]; }
        const unsigned nA = has_next ? (unsigned)nxt.arow0 * lda2 : cA;
        const unsigned nB = has_next ? (unsigned)(((size_t)nxt.e * g.b_estride + (size_t)nxt.col0 * K) * 2) : cB;
#pragma unroll 1
        for (int t = 0; t < nt; t += 2) {
            const bool last = (t == nt - 2);
            const unsigned k1 = (unsigned)(t + 1) * kstep, k2 = last ? 0u : (unsigned)(t + 2) * kstep, k3 = last ? kstep : (unsigned)(t + 3) * kstep;
            const unsigned u2 = last ? nA : cA; const unsigned b2 = (last ? nB : cB) + k2; const unsigned b3 = (last ? nB : cB) + k3;
            unsigned q[3]; q[0] = last ? rn[0] : rp[0]; q[1] = last ? rn[1] : rp[1]; q[2] = last ? rn[2] : rp[2];
            PG9_LDB(B0, 0, 0); PG9_LDB(B1, 0, 1); PG9_SCHED; PG9_LDA(At, 0, 0); PG9_STAGEA(PG9_SA(1, 2), cA, rp, 2, k1);
            PG9_WAIT_V2(12, 8); PG9_WAIT_L(0); PG9_BAR; PG9_MMA(0, 0, At, B0); PG9_MMA(0, 1, At, B1); PG9_BAR; PG9_SCHED;
            PG9_LDA(At, 0, 1); PG9_STAGEB(PG9_SB(0, 0), b2); PG9_STAGEB(PG9_SB(0, 1), b2 + hstepB); PG9_STAGEA(PG9_SA(0, 0), u2, q, 0, k2);
            PG9_WAIT_V2(16, 12); PG9_WAIT_L(0); PG9_BAR; PG9_MMA(1, 0, At, B0); PG9_MMA(1, 1, At, B1); PG9_BAR; PG9_SCHED;
            PG9_LDA(At, 0, 2); PG9_STAGEA(PG9_SA(0, 1), u2, q, 1, k2);
            PG9_WAIT_V2(12, 8); PG9_WAIT_L(0); PG9_BAR; PG9_MMA(2, 0, At, B0); PG9_MMA(2, 1, At, B1); PG9_BAR; PG9_SCHED;
            PG9_LDB(B0, 1, 0); PG9_LDB(B1, 1, 1); PG9_SCHED; PG9_LDA(At, 1, 0); PG9_STAGEA(PG9_SA(0, 2), u2, q, 2, k2);
            PG9_WAIT_V2(12, 8); PG9_WAIT_L(0); PG9_BAR; PG9_MMA(0, 0, At, B0); PG9_MMA(0, 1, At, B1); PG9_BAR; PG9_SCHED;
            PG9_LDA(At, 1, 1); PG9_STAGEB(PG9_SB(1, 0), b3); PG9_STAGEB(PG9_SB(1, 1), b3 + hstepB); PG9_STAGEA(PG9_SA(1, 0), u2, q, 0, k3);
            PG9_WAIT_V2(16, 12); PG9_WAIT_L(0); PG9_BAR; PG9_MMA(1, 0, At, B0); PG9_MMA(1, 1, At, B1); PG9_BAR; PG9_SCHED;
            PG9_LDA(At, 1, 2); PG9_STAGEA(PG9_SA(1, 1), u2, q, 1, k3);
            PG9_WAIT_V2(12, 8); PG9_WAIT_L(0); PG9_BAR; PG9_MMA(2, 0, At, B0); PG9_MMA(2, 1, At, B1); PG9_BAR; PG9_SCHED;
        }
        if (wr == 0) PG9_BAR;
        E(acc, cur, wr, wc, fr, fq);
        if (!has_next) break;
#pragma unroll
        for (int a = 0; a < 3; ++a)
#pragma unroll
            for (int b = 0; b < 2; ++b)
#pragma unroll
                for (int m = 0; m < MF; ++m)
#pragma unroll
                    for (int n = 0; n < 2; ++n) acc[a][b][m][n] = (f32x4){0.f, 0.f, 0.f, 0.f};
        cur = nxt; cB = nB; cA = nA; ++ui; rp[0] = rn[0]; rp[1] = rn[1]; rp[2] = rn[2];
        if (wr == 1) PG9_BAR;
    }
    PG9_WAIT_V(0);
    PG9_BAR;
#undef PG9_SA
#undef PG9_SB
#undef PG9_DMA
#undef PG9_STAGEB
#undef PG9_RIDX
#undef PG9_STAGEA
#undef PG9_LDA
#undef PG9_LDB
#undef PG9_MMA
#undef PG9_WAIT_V
#undef PG9_WAIT_V2
#undef PG9_WAIT_L
#undef PG9_BAR
#undef PG9_SCHED
#undef PG9_ROWS
}
}

#ifndef QUAD_SPLIT
#define QUAD_SPLIT 1
#endif
__device__ __forceinline__ bool deal(int i, int j, int gpx, int U, int& unit, int& quad) {
    const int q = i * gpx + j, nfull = (U / gpx) * gpx, left = U - nfull;
    if (q < nfull || left * 4 > gpx || !QUAD_SPLIT) { if (q >= U) return false; unit = q; quad = -1; return true; }
    const int s_ = q - nfull; if (s_ >= left * 4) return false; unit = nfull + (s_ >> 2); quad = s_ & 3; return true;
}
struct OrderRows {
    int x, j, gpx, rpx, nN, nomma, rot, TR;
    __device__ __forceinline__ bool next(int i, pg8::Unit& u) const {
        int q, quad; if (!deal(i, j, gpx, rpx * nN, q, quad)) return false;
        const int pm = x * rpx + q / nN, pn = q % nN; u.arow0 = pm * TR; u.col0 = pn * 256; u.e = 0; u.quad = quad >= 0;
        if (quad >= 0) { u.arow0 += (quad >> 1) * (TR / 2); u.col0 += (quad & 1) * 128; }
        if (nomma) u.quad = 2;
        u.orow0 = u.arow0; return true; }
};
struct OrderMoe {
    int x, j, gpx, nME, nN, rot, TR;
    __device__ __forceinline__ bool next(int i, pg8::Unit& u) const {
        int q, quad; const int per = nME * nN; if (!deal(i, j, gpx, 2 * per, q, quad)) return false;
        const int e = 2 * x + q / per, rem = q % per, pmE = rem / nN, pn = rem % nN;
        u.arow0 = e * SLOTS_E + pmE * TR; u.col0 = pn * 256; u.e = e; u.quad = quad >= 0;
        if (quad >= 0) { u.arow0 += (quad >> 1) * (TR / 2); u.col0 += (quad & 1) * 128; }
        u.orow0 = u.arow0; return true; }
};

constexpr float QS_A = 0.125f * 1.4426950408889634f, QS_B = 0.10206207261596577f * 1.4426950408889634f, QS_C = 0.17677669529663687f * 1.4426950408889634f;
typedef float f32x4e __attribute__((ext_vector_type(4)));
#define EPI_ROWS(ai, m) (u.orow0 + (ai) * (32 * MF) + wr * (16 * MF) + (m) * 16 + fr)
#define EPI_COL0(bj) (u.col0 + (bj) * 128 + wc * 32 + 8 * fq)
__device__ __forceinline__ void rope8(f32x4& v0, f32x4& v1, const float* cs, const float* sn) {
    const f32x4 c = *(const f32x4*)cs, s = *(const f32x4*)sn;
    f32x4 a = v0, b = v1;
    v0.x = a.x * c.x - a.y * s.x; v0.y = a.y * c.x + a.x * s.x; v0.z = a.z * c.y - a.w * s.y; v0.w = a.w * c.y + a.z * s.y;
    v1.x = b.x * c.z - b.y * s.z; v1.y = b.y * c.z + b.x * s.z; v1.z = b.z * c.w - b.w * s.w; v1.w = b.w * c.w + b.z * s.w;
}
__device__ __forceinline__ u32x4 pack8(const f32x4 v0, const f32x4 v1) { u32x4 w; w.x = pk2(v0.x, v0.y); w.y = pk2(v0.z, v0.w); w.z = pk2(v1.x, v1.y); w.w = pk2(v1.z, v1.w); return w; }

template <int MF, int NA = 2> struct EpiInProj {
    bf16* P; const float* rope; float* RSQ;
    __device__ __forceinline__ void operator()(const f32x4 (&acc)[NA][2][MF][2], const pg8::Unit& u, int wr, int wc, int fr, int fq) const {
#pragma unroll
        for (int bj = 0; bj < 2; ++bj) {
            if (u.quad && bj) continue;
            const int c0 = EPI_COL0(bj);
            const bool secA = c0 < P_AV, secB = c0 >= P_KR && c0 < P_DV;
            const int which = (c0 >= P_CQ && c0 < P_CKV) ? 0 : ((c0 >= P_CKV && c0 < P_KR) ? 1 : -1);
            const int p0 = secA ? ((c0 & 63) >> 1) : ((c0 & 31) >> 1);
            const float qs = c0 < P_AK ? QS_A : ((c0 >= P_DQ && c0 < P_DK) ? QS_C : 1.f);
#pragma unroll
            for (int ai = 0; ai < NA; ++ai)
#pragma unroll
                for (int m = 0; m < MF; ++m) {
                    if (u.quad && ai) continue;
                    const int row = EPI_ROWS(ai, m);
                    f32x4 v0 = acc[ai][bj][m][0] * qs, v1 = acc[ai][bj][m][1] * qs;
                    if (row < RL && (secA || secB)) { const int t = row & (T - 1);
                        const float* cs = secA ? rope + t * 32 + p0 : rope + T * 64 + t * 16 + p0;
                        const float* sn = secA ? rope + T * 32 + t * 32 + p0 : rope + T * 64 + T * 16 + t * 16 + p0;
                        rope8(v0, v1, cs, sn); }
                    if (which >= 0) { float s = (v0.x * v0.x + v0.y * v0.y) + (v0.z * v0.z + v0.w * v0.w) + (v1.x * v1.x + v1.y * v1.y) + (v1.z * v1.z + v1.w * v1.w);
                        { const int ln_ = fq * 16 + fr; s += shx(s, 16, ln_); s += shx(s, 32, ln_); }
                        if (fq == 0) RSQ[(size_t)row * 12 + ((c0 - P_CQ) >> 5)] = s; }
                    *(u32x4*)(P + (size_t)row * LDP + c0) = pack8(v0, v1);
                }
        }
    }
};
template <int MF, int NA = 2> struct EpiUp {
    bf16* QKVM; const float* rope; const float* RSQ;
    __device__ __forceinline__ void operator()(const f32x4 (&acc)[NA][2][MF][2], const pg8::Unit& u, int wr, int wc, int fr, int fq) const {
        const bool isq = u.col0 < 512;
        const float inv = isq ? (1.f / 256.f) : (1.f / 128.f);
        const int cw = u.col0 + wc * 32 + 8 * fq;
        int j0 = cw; j0 -= j0 >= 192 ? 192 : 0; j0 -= j0 >= 96 ? 96 : 0;
        int j1 = j0 + 32; j1 -= j1 >= 96 ? 96 : 0;
        const bool rot0 = isq && cw < 384 && j0 >= 64, rot1 = isq && cw + 128 < 384 && j1 >= 64;
        const float* tb = rope + T * 64;
#pragma unroll
        for (int ai = 0; ai < NA; ++ai)
#pragma unroll
            for (int m = 0; m < MF; ++m) {
                if (u.quad && ai) continue;
                const int row = EPI_ROWS(ai, m);
                const float* rq = RSQ + (size_t)row * 12; float sq;
                if (isq) { const f32x4 pa_ = *(const f32x4*)rq, pb_ = *(const f32x4*)(rq + 4); sq = ((pa_.x + pa_.y) + (pa_.z + pa_.w)) + ((pb_.x + pb_.y) + (pb_.z + pb_.w)); }
                else { const f32x4 pc_ = *(const f32x4*)(rq + 8); sq = (pc_.x + pc_.y) + (pc_.z + pc_.w); }
                const float rs = __builtin_amdgcn_rsqf(sq * inv + EPS) * (isq ? QS_B : 1.f);
                const int t = row & (T - 1);
                bf16* dst = QKVM + (size_t)row * LDM + cw;
                { f32x4 v0 = acc[ai][0][m][0] * rs, v1 = acc[ai][0][m][1] * rs;
                  if (rot0 && row < RL) rope8(v0, v1, tb + t * 16 + ((j0 - 64) >> 1), tb + T * 16 + t * 16 + ((j0 - 64) >> 1));
                  *(u32x4*)dst = pack8(v0, v1); }
                if (!u.quad) { f32x4 v0 = acc[ai][1][m][0] * rs, v1 = acc[ai][1][m][1] * rs;
                  if (rot1 && row < RL) rope8(v0, v1, tb + t * 16 + ((j1 - 64) >> 1), tb + T * 16 + t * 16 + ((j1 - 64) >> 1));
                  *(u32x4*)(dst + 128) = pack8(v0, v1); }
            }
    }
};
template <int MF, int NA = 2> struct EpiOut {
    float* X; const float* MODl; float keep; const float* xlat; const float* xctx; int first;
    __device__ __forceinline__ void operator()(const f32x4 (&acc)[NA][2][MF][2], const pg8::Unit& u, int wr, int wc, int fr, int fq) const {
        const float* xsrc = first ? (u.orow0 < RL ? xlat : xctx - (size_t)RL * D) : X;
#pragma unroll
        for (int ai = 0; ai < NA; ++ai)
#pragma unroll
            for (int m = 0; m < MF; ++m) {
                if (u.quad && ai) continue;
                const int row_ = EPI_ROWS(ai, m); const int mb = row_ < RL ? row_ >> 11 : 8;
                const float* g1 = MODl + (size_t)mb * 6144 + 2048;
#pragma unroll
                for (int bj = 0; bj < 2; ++bj) {
                    if (u.quad && bj) continue;
                    const int c0 = EPI_COL0(bj);
                    const f32x4 ga = *(const f32x4*)(g1 + c0) * keep, gb = *(const f32x4*)(g1 + c0 + 4) * keep;
                    float* xp = X + (size_t)row_ * D + c0; const float* xs = xsrc + (size_t)row_ * D + c0;
                    f32x4 xa = *(const f32x4*)xs, xb = *(const f32x4*)(xs + 4);
                    xa += ga * acc[ai][bj][m][0]; xb += gb * acc[ai][bj][m][1];
                    *(f32x4*)xp = xa; *(f32x4*)(xp + 4) = xb;
                }
            }
    }
};
template <int MF, int NA = 2> struct EpiGU {
    bf16* HID;
    __device__ __forceinline__ void operator()(const f32x4 (&acc)[NA][2][MF][2], const pg8::Unit& u, int wr, int wc, int fr, int fq) const {
#pragma unroll
        for (int bj = 0; bj < 2; ++bj) {
            if (u.quad && bj) continue;
            const int hc = EPI_COL0(bj) >> 1;
#pragma unroll
            for (int ai = 0; ai < NA; ++ai)
#pragma unroll
                for (int m = 0; m < MF; ++m) {
                    if (u.quad && ai) continue;
                    const f32x4 g = acc[ai][bj][m][0], up = acc[ai][bj][m][1];
                    u32x2 w; w.x = pk2(siluf(g.x) * up.x, siluf(g.y) * up.y); w.y = pk2(siluf(g.z) * up.z, siluf(g.w) * up.w);
                    *(u32x2*)(HID + (size_t)EPI_ROWS(ai, m) * DE + hc) = w;
                }
        }
    }
};
template <int MF, int NA = 2> struct EpiDown {
    bf16* Y; const float* SGATE;
    __device__ __forceinline__ void operator()(const f32x4 (&acc)[NA][2][MF][2], const pg8::Unit& u, int wr, int wc, int fr, int fq) const {
#pragma unroll
        for (int ai = 0; ai < NA; ++ai)
#pragma unroll
            for (int m = 0; m < MF; ++m) {
                if (u.quad && ai) continue;
                const int row = EPI_ROWS(ai, m); const float gt = SGATE[row];
#pragma unroll
                for (int bj = 0; bj < 2; ++bj)
                    if (!(u.quad && bj)) *(u32x4*)(Y + (size_t)row * D + EPI_COL0(bj)) = pack8(acc[ai][bj][m][0] * gt, acc[ai][bj][m][1] * gt);
            }
    }
};

constexpr int NWAVES = 8;
constexpr int RING_BYTES = 139264;
constexpr int LDSCTL_OFF = RING_BYTES, MISC_OFF = LDSCTL_OFF + 320;
constexpr int LDS_BYTES = 147456;
constexpr int CW_BAR = 4096;
typedef GAS unsigned gu32;

#define XB_TMO      128
#define XB_XCNT(j)  (256  + 64 * (j))
#define XB_XSUB(j)  (1280 + 64 * (j))
#define XB_XGEN(j)  (2304 + 64 * (j))
#define XB_TOP      3328
#define XB_TOPGEN   3392
#define XCD_BAR_WORDS 3456
#define XB_SPIN_CAP (1u << 18)
__device__ __forceinline__ unsigned xb_ld(unsigned* p)              { return __hip_atomic_load(p, __ATOMIC_RELAXED, __HIP_MEMORY_SCOPE_AGENT); }
__device__ __forceinline__ unsigned xb_add(unsigned* p, unsigned v) { return __hip_atomic_fetch_add(p, v, __ATOMIC_RELAXED, __HIP_MEMORY_SCOPE_AGENT); }
__device__ __forceinline__ unsigned xb_xcc_id() { return (unsigned)__builtin_amdgcn_s_getreg((3 << 11) | 20) & 0xFu; }
#define XB_SPIN(cond, bar) do { unsigned _sp = 0; while (cond) { __builtin_amdgcn_s_sleep(1); \
    if ((++_sp & 255u) == 0u) { if (xb_ld(&(bar)[XB_TMO])) break; if (_sp > XB_SPIN_CAP) { atomicAdd(&(bar)[XB_TMO], 1u); break; } } } } while (0)
struct XcdBarrier { unsigned* bar; unsigned x; volatile LAS unsigned* st; };
__device__ __forceinline__ XcdBarrier xcd_barrier_post(unsigned* bar, volatile LAS unsigned* st) {
    XcdBarrier b; b.bar = bar; b.x = xb_xcc_id(); b.st = st;
    if (threadIdx.x == 0) (void)xb_add(&bar[XB_XCNT(b.x)], 1u);
    return b;
}
__device__ __forceinline__ void xcd_barrier_complete(unsigned* bar, unsigned x, unsigned& nloc, unsigned& nx) {
    const unsigned G = gridDim.x * gridDim.y * gridDim.z;
    unsigned sum, cnt, mine, sp = 0u;
    for (;;) {
        sum = 0u; cnt = 0u; mine = 0u;
#pragma unroll
        for (unsigned j = 0; j < 16; ++j) { const unsigned c = xb_ld(&bar[XB_XCNT(j)]); sum += c; cnt += (c > 0u) ? 1u : 0u; mine = (j == x) ? c : mine; }
        if (sum == G) break;
        __builtin_amdgcn_s_sleep(1);
        if ((++sp & 255u) == 0u) { if (xb_ld(&bar[XB_TMO])) break; if (sp > XB_SPIN_CAP) { atomicAdd(&bar[XB_TMO], 1u); break; } }
    }
    nloc = mine > 0u ? mine : 1u; nx = cnt > 0u ? cnt : 1u;
}
__device__ __forceinline__ void xcd_barrier(const XcdBarrier& b, const int tid) {
    asm volatile("s_waitcnt vmcnt(0)" ::: "memory");
    __syncthreads();
    if (tid == 0) {
        unsigned* bar = b.bar;
        __builtin_amdgcn_s_waitcnt(0);
        unsigned nloc = b.st[0], nx = b.st[1];
        if (nloc == 0u) { xcd_barrier_complete(bar, b.x, nloc, nx); b.st[0] = nloc; b.st[1] = nx; }
        const unsigned old = xb_add(&bar[XB_XSUB(b.x)], 1u);
        const unsigned gen = old / nloc;
        if (old + 1u == (gen + 1u) * nloc) {
            __builtin_amdgcn_fence(__ATOMIC_RELEASE, "agent");
            asm volatile("s_waitcnt vmcnt(0)" ::: "memory");
            const unsigned og = xb_add(&bar[XB_TOP], 1u);
            const unsigned tg = og / nx;
            if (og + 1u == (tg + 1u) * nx) xb_add(&bar[XB_TOPGEN], 1u);
            else XB_SPIN(xb_ld(&bar[XB_TOPGEN]) == tg, bar);
            __builtin_amdgcn_fence(__ATOMIC_ACQUIRE, "agent");
            xb_add(&bar[XB_XGEN(b.x)], 1u);
            asm volatile("s_waitcnt vmcnt(0)" ::: "memory");
        } else {
            XB_SPIN(xb_ld(&bar[XB_XGEN(b.x)]) == gen, bar);
            __builtin_amdgcn_fence(__ATOMIC_ACQUIRE, "agent");
            asm volatile("s_waitcnt vmcnt(0)" ::: "memory");
        }
    }
    __syncthreads();
}

struct Frame { LAS unsigned char* lds; int tid, lane, wave, bid, G; const float* const* in; GAS float* out; GAS unsigned char* ws; };
#define IN_(k) ((const float*)(const GAS float*)F.in[(k)])
#define F_x IN_(0)
#define F_c IN_(1)
#define F_ctx IN_(2)
#define F_c_ctx IN_(3)
#define F_norm1 IN_(4)
#define F_norm2 IN_(5)
#define F_w_ada IN_(6)
#define F_b_ada IN_(7)
#define F_w_in IN_(8)
#define F_sink IN_(9)
#define F_mla_q_norm IN_(10)
#define F_w_uq IN_(11)
#define F_mla_kv_norm IN_(12)
#define F_w_ukv IN_(13)
#define F_lq1 IN_(14)
#define F_lk1 IN_(15)
#define F_lq2 IN_(16)
#define F_lk2 IN_(17)
#define F_diff_norm IN_(18)
#define F_w_out IN_(19)
#define F_w_router IN_(20)
#define F_w_gate IN_(21)
#define F_w_up IN_(22)
#define F_w_down IN_(23)
#define F_final_norm IN_(24)
#define F_MOD ((float*)(GAS float*)(F.ws + WS_MOD))
#define F_ROPE ((float*)(GAS float*)(F.ws + WS_ROPE))
#define F_RSQ ((float*)(GAS float*)(F.ws + WS_RSQ))
#define F_AFF ((float*)(GAS float*)(F.ws + WS_AFF))
#define F_INV ((int*)(GAS int*)(F.ws + WS_INV))
#define F_STOK ((int*)(GAS int*)(F.ws + WS_STOK))
#define F_SGATE ((float*)(GAS float*)(F.ws + WS_SGATE))
#define F_X ((float*)(GAS float*)(F.ws + WS_X))
#define F_ACT ((bf16*)(GAS bf16*)(F.ws + WS_ACT))
#define F_P ((bf16*)(GAS bf16*)(F.ws + WS_P))
#define F_Y ((bf16*)(GAS bf16*)(F.ws + WS_Y))
#define F_QKVM ((bf16*)(GAS bf16*)(F.ws + WS_QKVM))
#define F_O ((bf16*)(GAS bf16*)(F.ws + WS_O))
#define F_HID ((bf16*)(GAS bf16*)(F.ws + WS_HID))
#define F_WB ((bf16*)(GAS bf16*)(F.ws + WS_W))

__device__ __forceinline__ int rot64(int dp) { const int p = dp >> 1, half = dp & 1, axis = p >> 4, f = p & 15; return axis * 32 + half * 16 + f; }
__device__ __forceinline__ int rot32(int dp) { const int p = dp >> 1, half = dp & 1, axis = p >> 3, f = p & 7; return axis * 16 + half * 8 + f; }
__device__ __forceinline__ int src_col_in(int n) {
    if (n >= INW) return -1;
    if (n < P_AV) return (n & ~63) + rot64(n & 63);
    if (n >= P_KR && n < P_DV) return (n & ~31) + rot32(n & 31);
    return n;
}
__device__ __forceinline__ void prep_tile(const float* src, int N, int k0, const float* kscale, bf16* dst, int ldd, LAS float* scr, int lane) {
    float v[32];
#pragma unroll
    for (int i = 0; i < 32; ++i) { const int kk = 2 * i + (lane >> 5); v[i] = src ? src[(size_t)(k0 + kk) * N] : 0.f; }
    if (kscale) {
#pragma unroll
        for (int i = 0; i < 32; ++i) v[i] *= kscale[k0 + 2 * i + (lane >> 5)]; }
#pragma unroll
    for (int i = 0; i < 32; ++i) scr[(2 * i + (lane >> 5)) * 33 + (lane & 31)] = v[i];
    LDS_WAIT();
    const int c = lane & 7;
#pragma unroll
    for (int j = 0; j < 4; ++j) { const int n = (lane >> 3) + 8 * j; const LAS float* s = scr + (8 * c) * 33 + n;
        u32x4 o; o.x = pk2(s[0], s[33]); o.y = pk2(s[66], s[99]); o.z = pk2(s[132], s[165]); o.w = pk2(s[198], s[231]);
        *(u32x4*)(dst + (size_t)n * ldd + 8 * c) = o; }
    LDS_WAIT();
}
constexpr int PI_IN = 16 * 64, PI_UP = 6 * 32, PI_OUT = 16 * 32, PI_GU = NE * 16 * 32, PI_DN = NE * 8 * 32, PI_LAYER = PI_IN + PI_UP + PI_OUT + PI_GU + PI_DN;
#ifndef BG_PREP
#define BG_PREP 0
#ifndef MOE_PF
#define MOE_PF 0
#endif
#endif
__device__ __forceinline__ void prep_layer(Frame& F, const int l, const int worker, const int nworkers) {
    const int lane = F.lane, wave = F.wave;
    LAS float* scr = (LAS float*)(F.lds + 57344 + wave * 8448);
    for (int it = worker; it < PI_LAYER; it += nworkers) {
        int r = it; bf16* wl = F_WB + (size_t)l * W_LAYER;
        const int nl = lane & 31;
        if (r < PI_IN) { const int kb = r / 64, nb = r % 64, n = nb * 32 + nl, sc = src_col_in(n);
            prep_tile(sc >= 0 ? F_w_in + (size_t)l * D * INW + sc : nullptr, INW, kb * 64, nullptr, wl + W_IN + (size_t)(nb * 32) * D + kb * 64, D, scr, lane); continue; } r -= PI_IN;
        if (r < PI_UP) { const int kb = r / 32, nb = r % 32, n = nb * 32 + nl, k0 = kb * 64; const float* src = nullptr; const float* ks = nullptr; int N = 384, ksrc = k0;
            if (n < 384 && k0 < 256) { const int h = n / 96, j = n % 96; const int sc = j < 64 ? n : h * 96 + 64 + rot32(j - 64); src = F_w_uq + (size_t)l * 256 * 384 + sc; ks = F_mla_q_norm + l * 256; N = 384; }
            else if (n >= 512 && k0 >= 256) { src = F_w_ukv + (size_t)l * 128 * 512 + (n - 512); ks = F_mla_kv_norm + l * 128; N = 512; ksrc = k0 - 256; }
            { float v[32];
#pragma unroll
              for (int i = 0; i < 32; ++i) { const int kk = 2 * i + (lane >> 5); v[i] = src ? src[(size_t)(ksrc + kk) * N] * ks[ksrc + kk] : 0.f; }
#pragma unroll
              for (int i = 0; i < 32; ++i) scr[(2 * i + (lane >> 5)) * 33 + (lane & 31)] = v[i];
              LDS_WAIT();
              const int c = lane & 7; bf16* dst = wl + W_UP + (size_t)(nb * 32) * UPK + k0;
#pragma unroll
              for (int j = 0; j < 4; ++j) { const int nn = (lane >> 3) + 8 * j; const LAS float* s = scr + (8 * c) * 33 + nn;
                  u32x4 o; o.x = pk2(s[0], s[33]); o.y = pk2(s[66], s[99]); o.z = pk2(s[132], s[165]); o.w = pk2(s[198], s[231]);
                  *(u32x4*)(dst + (size_t)nn * UPK + 8 * c) = o; }
              LDS_WAIT(); }
            continue; } r -= PI_UP;
        if (r < PI_OUT) { const int kb = r / 32, nb = r % 32;
            prep_tile(F_w_out + (size_t)l * D * D + nb * 32 + nl, D, kb * 64, nullptr, wl + W_OUT + (size_t)(nb * 32) * D + kb * 64, D, scr, lane); continue; } r -= PI_OUT;
        if (r < PI_GU) { const int e = r / 512, q = r % 512, kb = q / 32, nb = q % 32, n = nb * 32 + nl, f = (n >> 3) * 4 + (n & 3);
            const float* src = ((n & 4) ? F_w_up : F_w_gate) + ((size_t)l * NE + e) * D * DE + f;
            prep_tile(src, DE, kb * 64, nullptr, wl + W_GU + (size_t)e * 1024 * 1024 + (size_t)(nb * 32) * D + kb * 64, D, scr, lane); continue; } r -= PI_GU;
        { const int e = r / 256, q = r % 256, kb = q / 32, nb = q % 32;
            prep_tile(F_w_down + ((size_t)l * NE + e) * DE * D + nb * 32 + nl, D, kb * 64, nullptr, wl + W_DN + (size_t)e * 1024 * 512 + (size_t)(nb * 32) * DE + kb * 64, DE, scr, lane); }
    }
}

__device__ __forceinline__ void p0_phase(Frame& F) {
    const int tid = F.tid, lane = F.lane, wave = F.wave;
    {
        LAS float* sl = (LAS float*)F.lds;
        LAS float* red = (LAS float*)(F.lds + 36864);
        for (int i = tid; i < 9 * 1024; i += 512) { const float v = i < 8 * 1024 ? F_c[i] : F_c_ctx[i - 8 * 1024]; sl[i] = siluf(v); }
        __syncthreads();
        for (int it = F.bid; it < DEPTH * 96; it += F.G) {
            const int l = it / 96, cg = it % 96, col = cg * 64 + lane;
            float acc[9];
#pragma unroll
            for (int r = 0; r < 9; ++r) acc[r] = 0.f;
            const float* w = F_w_ada + (size_t)l * D * 6144 + (size_t)(wave * 128) * 6144 + col;
#pragma unroll 16
            for (int k = 0; k < 128; ++k) { const float wv = w[(size_t)k * 6144];
#pragma unroll
                for (int r = 0; r < 9; ++r) acc[r] += sl[r * 1024 + wave * 128 + k] * wv; }
#pragma unroll
            for (int r = 0; r < 9; ++r) red[(wave * 9 + r) * 64 + lane] = acc[r];
            __syncthreads();
            for (int o = tid; o < 576; o += 512) { const int r = o >> 6, cc = o & 63; float s = 0.f;
#pragma unroll
                for (int w8 = 0; w8 < 8; ++w8) s += red[(w8 * 9 + r) * 64 + cc];
                F_MOD[((size_t)l * 9 + r) * 6144 + cg * 64 + cc] = s + F_b_ada[l * 6144 + cg * 64 + cc]; }
            __syncthreads();
        }
    }
    const int gw = F.bid * NWAVES + wave, NGW = F.G * NWAVES;
    { const size_t n4 = (size_t)R * D / 4, nl4 = (size_t)RL * D / 4;
      for (size_t i = (size_t)F.bid * 512 + tid; i < n4; i += (size_t)F.G * 512) { const f32x4 v = i < nl4 ? ((const f32x4*)F_x)[i] : ((const f32x4*)F_ctx)[i - nl4]; ((f32x4*)F_X)[i] = v; } }
    for (int i = F.bid * 512 + tid; i < T * 48; i += F.G * 512) {
        const int t = i / 48, j = i % 48; int axis, f, nf;
        if (j < 32) { axis = j >> 4; f = j & 15; nf = 16; } else { axis = (j - 32) >> 3; f = (j - 32) & 7; nf = 8; }
        const float inv = exp2f(-(float)f / (float)nf * 13.287712379549449f);
        const float ang = (float)(axis == 0 ? (t >> 6) : (t & 63)) * inv;
        const float cv = cosf(ang), sv = sinf(ang);
        if (j < 32) { F_ROPE[t * 32 + j] = cv; F_ROPE[T * 32 + t * 32 + j] = sv; } else { F_ROPE[T * 64 + t * 16 + j - 32] = cv; F_ROPE[T * 64 + T * 16 + t * 16 + j - 32] = sv; }
    }
    for (int l = 0; l < (BG_PREP ? 1 : DEPTH); ++l) prep_layer(F, l, gw, NGW);
}

#ifndef PROBE_NOROUTER
#define PROBE_NOROUTER 0
#endif
#define half_swap_add(keepv, sendv, off) ((keepv) + shx((sendv), (off), lane))
__device__ __forceinline__ void norm_phase(Frame& F, int l, int mode, int nrows, const float keep) {
    const int lane = F.lane, gw = F.bid * NWAVES + F.wave, NGW = F.G * NWAVES;
    LAS float* wrT = (LAS float*)F.lds;
    if (mode == 1) {
        const float* wr = F_w_router + (size_t)l * D * NE;
        for (int i = F.tid; i < D * NE; i += 512) wrT[(i & 15) * 1028 + (i >> 4)] = wr[i];
        __syncthreads();
    }
    const float* gain = mode == 0 ? F_norm1 + (size_t)l * D : (mode == 1 ? F_norm2 + (size_t)l * D : F_final_norm);
    const bool comb = mode != 1 && l > 0;
    f32x4 vn[2][4];
#define NORM_LOAD(dst, rr0) do { _Pragma("unroll") for (int q = 0; q < 2; ++q) _Pragma("unroll") for (int j = 0; j < 4; ++j) dst[q][j] = ((const f32x4*)(F_X + (size_t)((rr0) + q) * D))[lane + 64 * j]; } while (0)
    if (gw * 2 < nrows) NORM_LOAD(vn, gw * 2);
    for (int r0 = gw * 2; r0 < nrows; r0 += NGW * 2) {
        const int mb = r0 < RL ? r0 / T : 8;
        f32x4 v[2][4];
#pragma unroll
        for (int q = 0; q < 2; ++q)
#pragma unroll
            for (int j = 0; j < 4; ++j) v[q][j] = vn[q][j];
        if (r0 + NGW * 2 < nrows) NORM_LOAD(vn, r0 + NGW * 2);
        if (comb) {
            const float* g2 = F_MOD + ((size_t)(l - 1) * 9 + mb) * 6144 + 5120;
            const int myinv = lane < 2 * NE ? F_INV[(size_t)r0 * NE + lane] : -1;
            f32x4 s[2][4];
#pragma unroll
            for (int q = 0; q < 2; ++q)
#pragma unroll
                for (int j = 0; j < 4; ++j) s[q][j] = (f32x4){0.f, 0.f, 0.f, 0.f};
            for (int e = 0; e < NE; ++e) {
#pragma unroll
                for (int q = 0; q < 2; ++q) { const int sl = shi(myinv, q * NE + e);
                    if (sl >= 0) { const bf16* yr = F_Y + (size_t)sl * D;
#pragma unroll
                        for (int j = 0; j < 4; ++j) { const u32x2 w = ((const u32x2*)yr)[lane + 64 * j];
                            s[q][j].x += bf2f(w.x & 0xffff); s[q][j].y += bf2f(w.x >> 16); s[q][j].z += bf2f(w.y & 0xffff); s[q][j].w += bf2f(w.y >> 16); } } } }
#pragma unroll
            for (int j = 0; j < 4; ++j) { const f32x4 g = ((const f32x4*)g2)[lane + 64 * j];
#pragma unroll
                for (int q = 0; q < 2; ++q) { v[q][j] += g * s[q][j] * keep; ((f32x4*)(F_X + (size_t)(r0 + q) * D))[lane + 64 * j] = v[q][j]; } }
        }
        float ss0 = 0.f, ss1 = 0.f;
#pragma unroll
        for (int j = 0; j < 4; ++j) { ss0 += (v[0][j].x * v[0][j].x + v[0][j].y * v[0][j].y) + (v[0][j].z * v[0][j].z + v[0][j].w * v[0][j].w);
                                      ss1 += (v[1][j].x * v[1][j].x + v[1][j].y * v[1][j].y) + (v[1][j].z * v[1][j].z + v[1][j].w * v[1][j].w); }
#pragma unroll
        for (int o = 1; o < 64; o <<= 1) { ss0 += shx(ss0, o, lane); ss1 += shx(ss1, o, lane); }
        const float rs[2] = {1.0f / sqrtf(ss0 * (1.f / D) + EPS), 1.0f / sqrtf(ss1 * (1.f / D) + EPS)};
        if (mode == 2) {
#pragma unroll
            for (int j = 0; j < 4; ++j) { const f32x4 g = ((const f32x4*)gain)[lane + 64 * j];
#pragma unroll
                for (int q = 0; q < 2; ++q) ((f32x4*)((float*)F.out + (size_t)(r0 + q) * D))[lane + 64 * j] = v[q][j] * rs[q] * g; }
        } else {
            const float* md = F_MOD + ((size_t)l * 9 + mb) * 6144 + (mode == 0 ? 0 : 3072);
#pragma unroll
            for (int j = 0; j < 4; ++j) { const f32x4 g = ((const f32x4*)gain)[lane + 64 * j];
                const f32x4 sh = ((const f32x4*)md)[lane + 64 * j], sc = ((const f32x4*)(md + 1024))[lane + 64 * j];
#pragma unroll
                for (int q = 0; q < 2; ++q) { v[q][j] = v[q][j] * rs[q] * g * (sc + 1.0f) + sh;
                    u32x2 w; w.x = pk2(v[q][j].x, v[q][j].y); w.y = pk2(v[q][j].z, v[q][j].w);
                    ((u32x2*)(F_ACT + (size_t)(r0 + q) * D))[lane + 64 * j] = w; } }
            if (mode == 1 && !(PROBE_NOROUTER && keep == 0.f)) {
                float a[2][NE];
                typedef float f32x2r __attribute__((ext_vector_type(2)));
#pragma unroll
                for (int e = 0; e < NE; ++e) { f32x2r p0 = {0.f, 0.f}, p1 = {0.f, 0.f};
#pragma unroll
                    for (int j = 0; j < 4; ++j) { const f32x4 w = *(const LAS f32x4*)(wrT + e * 1028 + 256 * j + 4 * lane);
                        const f32x2r wl = {w.x, w.y}, wh = {w.z, w.w};
                        p0 = __builtin_elementwise_fma((f32x2r){v[0][j].x, v[0][j].y}, wl, p0); p0 = __builtin_elementwise_fma((f32x2r){v[0][j].z, v[0][j].w}, wh, p0);
                        p1 = __builtin_elementwise_fma((f32x2r){v[1][j].x, v[1][j].y}, wl, p1); p1 = __builtin_elementwise_fma((f32x2r){v[1][j].z, v[1][j].w}, wh, p1); }
                    a[0][e] = p0.x + p0.y; a[1][e] = p1.x + p1.y; if ((e & 1) == 1) __builtin_amdgcn_sched_barrier(0); }
                float b16[NE];
#pragma unroll
                for (int e = 0; e < NE; ++e) { const bool up = lane >= 32; b16[e] = half_swap_add(up ? a[1][e] : a[0][e], up ? a[0][e] : a[1][e], 32); }
                float b8[8];
#pragma unroll
                for (int e = 0; e < 8; ++e) { const bool up = (lane & 16) != 0; b8[e] = half_swap_add(up ? b16[8 + e] : b16[e], up ? b16[e] : b16[8 + e], 16); }
                float b4[4];
#pragma unroll
                for (int e = 0; e < 4; ++e) { const bool up = (lane & 8) != 0; b4[e] = half_swap_add(up ? b8[4 + e] : b8[e], up ? b8[e] : b8[4 + e], 8); }
                float b2[2];
#pragma unroll
                for (int e = 0; e < 2; ++e) { const bool up = (lane & 4) != 0; b2[e] = half_swap_add(up ? b4[2 + e] : b4[e], up ? b4[e] : b4[2 + e], 4); }
                float lg; { const bool up = (lane & 2) != 0; lg = half_swap_add(up ? b2[1] : b2[0], up ? b2[0] : b2[1], 2); }
                lg += shx(lg, 1, lane);
                float mx = lg;
#pragma unroll
                for (int o = 2; o < 32; o <<= 1) mx = fmaxf(mx, shx(mx, o, lane));
                const float ex = __expf(lg - mx); float sum = ex;
#pragma unroll
                for (int o = 2; o < 32; o <<= 1) sum += shx(sum, o, lane);
                const int eidx = ((lane >> 4) & 1) * 8 + ((lane >> 3) & 1) * 4 + ((lane >> 2) & 1) * 2 + ((lane >> 1) & 1);
                if ((lane & 1) == 0) F_AFF[(size_t)(r0 + (lane >> 5)) * NE + eidx] = ex / sum;
            }
        }
    }
}

#undef NORM_LOAD
__device__ __forceinline__ void topk_phase(Frame& F, int nsets) {
    LAS unsigned* cnt = (LAS unsigned*)F.lds;
    const int tid = F.tid, lane = F.lane, wave = F.wave;
    for (int it = F.bid; it < nsets * NE; it += F.G) {
        const int set = it / NE, e = it % NE; const bool lat = set < 8; const int b = lat ? set : set - 8;
        const int n = lat ? T : LC, cap = lat ? CAPL : CAPC, row0 = lat ? b * T : RL + b * LC, slot0 = e * SLOTS_E + (lat ? b * CAPL : NB * CAPL + b * CAPC);
        unsigned v[4];
#pragma unroll
        for (int q = 0; q < 4; ++q) { const int idx = 4 * tid + q; v[q] = idx < n ? __builtin_bit_cast(unsigned, F_AFF[(size_t)(row0 + idx) * NE + e]) : 0u; }
        unsigned prefix = 0u; int par = 0;
        for (int bit = 30; bit >= 0; --bit) {
            const unsigned cand = prefix | (1u << bit);
            unsigned c = 0;
#pragma unroll
            for (int q = 0; q < 4; ++q) c += (unsigned)__popcll(__ballot(v[q] >= cand));
            if (lane == 0) cnt[par * 8 + wave] = c;
            __syncthreads();
            unsigned tot = 0;
#pragma unroll
            for (int w = 0; w < 8; ++w) tot += cnt[par * 8 + w];
            if (tot >= (unsigned)cap) prefix = cand;
            par ^= 1;
        }
        unsigned g4 = 0, e4 = 0;
#pragma unroll
        for (int q = 0; q < 4; ++q) { g4 += v[q] > prefix ? 1u : 0u; e4 += v[q] == prefix ? 1u : 0u; }
        unsigned pk = g4 | (e4 << 16), inc = pk;
#pragma unroll
        for (int o = 1; o < 64; o <<= 1) { const unsigned t = (unsigned)shi((int)inc, lane - o); if (lane >= o) inc += t; }
        __syncthreads();
        if (lane == 63) cnt[16 + wave] = inc;
        __syncthreads();
        unsigned base = 0, total = 0;
#pragma unroll
        for (int w = 0; w < 8; ++w) { const unsigned t = cnt[16 + w]; total += t; if (w < wave) base += t; }
        const unsigned excl = base + inc - pk;
        unsigned gpre = excl & 0xffffu, epre = excl >> 16; const unsigned need = (unsigned)cap - (total & 0xffffu);
#pragma unroll
        for (int q = 0; q < 4; ++q) { const int idx = 4 * tid + q;
            if (idx < n) { const bool isg = v[q] > prefix, ise = v[q] == prefix; const bool sel = isg || (ise && epre < need);
                const int slot = slot0 + (int)(gpre + (epre < need ? epre : need));
                if (sel) { F_STOK[slot] = row0 + idx; F_SGATE[slot] = __builtin_bit_cast(float, v[q]); }
                F_INV[(size_t)(row0 + idx) * NE + e] = sel ? slot : -1;
                gpre += isg ? 1u : 0u; epre += ise ? 1u : 0u; } }
        __syncthreads();
    }
}

#ifndef ATT_EXTRA
#define ATT_EXTRA 0
#define ATT_EXTRA_TYPE 0
#endif
#ifndef ATT_LATE_DMA
#define ATT_LATE_DMA 0
#endif
#ifndef ATT_STAGGER
#define ATT_STAGGER 1
#endif
#ifndef ATT_XVAR
#define ATT_XVAR 0
#endif
#ifndef ATT_XSTEPS
#define ATT_XSTEPS 4
#endif
namespace att {
typedef short s16x4 __attribute__((ext_vector_type(4)));
typedef float f32x2_t __attribute__((ext_vector_type(2)));
typedef __bf16 bf16x2_t __attribute__((ext_vector_type(2)));
constexpr int L_K = 0, KBUF = 16384, L_V = 2 * KBUF, VBUF = 8192, L_WS = L_V + 2 * VBUF, L_OST = L_WS + 8 * 256, L_END = L_OST + 8 * 4096;
#define ATT_SBAR() __builtin_amdgcn_sched_barrier(0)
#define ATT_SGB(mask, n) __builtin_amdgcn_sched_group_barrier(mask, n, 0)
__device__ __forceinline__ int crow(int r, int hi) { return (r & 3) + 8 * (r >> 2) + 4 * hi; }
__device__ __forceinline__ unsigned cvtpk(float lo, float hi) { f32x2_t v = {lo, hi}; bf16x2_t b = __builtin_convertvector(v, bf16x2_t); return __builtin_bit_cast(unsigned, b); }
__device__ __forceinline__ int v_st(int k, int c) { const int kk = k; return ((kk >> 3) * 2 + (c >> 5)) * 512 + ((kk & 7) * 32 + (c & 31)) * 2; }
__device__ __forceinline__ int v_rd_base(int lane) { return ((lane & 3) << 3) | (((lane >> 2) & 3) << 6) | (((lane >> 4) & 1) << 5) | (((lane >> 5) & 1) << 8); }
typedef short v4i16_t __attribute__((ext_vector_type(4)));
template <int OFF> __device__ __forceinline__ s16x4 tr_read(int vb) { s16x4 r; asm volatile("ds_read_b64_tr_b16 %0, %1 offset:%2" : "=&v"(r) : "v"(vb), "i"(OFF) : "memory"); return r; }
struct VFrag { s16x4 l0, h0, l1, h1, l2, h2, l3, h3; };
template <int D0> __device__ __forceinline__ void vread(VFrag& f, int vb) {
    f.l0 = tr_read<D0 * 512 + 0 * 2048>(vb); f.h0 = tr_read<D0 * 512 + 0 * 2048 + 1024>(vb); f.l1 = tr_read<D0 * 512 + 1 * 2048>(vb); f.h1 = tr_read<D0 * 512 + 1 * 2048 + 1024>(vb);
    f.l2 = tr_read<D0 * 512 + 2 * 2048>(vb); f.h2 = tr_read<D0 * 512 + 2 * 2048 + 1024>(vb); f.l3 = tr_read<D0 * 512 + 3 * 2048>(vb); f.h3 = tr_read<D0 * 512 + 3 * 2048 + 1024>(vb);
}
__device__ __forceinline__ void pv_mma(f32x16& od, const VFrag& f, bf16x8 pa0, bf16x8 pa1, bf16x8 pa2, bf16x8 pa3) {
#define ATT_PK(L, H) (bf16x8){L[0], L[1], L[2], L[3], H[0], H[1], H[2], H[3]}
    od = __builtin_amdgcn_mfma_f32_32x32x16_bf16(pa0, ATT_PK(f.l0, f.h0), od, 0, 0, 0);
    od = __builtin_amdgcn_mfma_f32_32x32x16_bf16(pa1, ATT_PK(f.l1, f.h1), od, 0, 0, 0);
    od = __builtin_amdgcn_mfma_f32_32x32x16_bf16(pa2, ATT_PK(f.l2, f.h2), od, 0, 0, 0);
    od = __builtin_amdgcn_mfma_f32_32x32x16_bf16(pa3, ATT_PK(f.l3, f.h3), od, 0, 0, 0);
#undef ATT_PK
}
template <int D0> __device__ __forceinline__ void pv_one(f32x16& od, int vb, bf16x8 pa0, bf16x8 pa1, bf16x8 pa2, bf16x8 pa3) {
    VFrag f; vread<D0>(f, vb); asm volatile("s_waitcnt lgkmcnt(0)" ::: "memory"); ATT_SBAR(); pv_mma(od, f, pa0, pa1, pa2, pa3);
}
struct Tensors { const bf16* P; const bf16* QKVM; bf16* O; const float* sink; const float* dnorm; float lam, lam_init; int l; };

constexpr float THR = 8.f;
__device__ __forceinline__ float rowmax32(const f32x16& p0, const f32x16& p1) {
    float a = fmaxf(fmaxf(p0[0], p0[1]), p1[0]), b = fmaxf(fmaxf(p0[2], p0[3]), p1[1]); a = fmaxf(fmaxf(a, p1[2]), p1[3]);
#pragma unroll
    for (int r = 4; r < 16; r += 4) { a = fmaxf(fmaxf(a, p0[r]), p0[r + 1]); b = fmaxf(fmaxf(b, p0[r + 2]), p0[r + 3]); a = fmaxf(fmaxf(a, p1[r]), p1[r + 1]); b = fmaxf(fmaxf(b, p1[r + 2]), p1[r + 3]); }
    float m = fmaxf(a, b);
    auto rr = __builtin_amdgcn_permlane32_swap(__float_as_uint(m), __float_as_uint(m), false, false);
    return fmaxf(__uint_as_float(rr[0]), __uint_as_float(rr[1]));
}
__device__ __forceinline__ void partialSM(f32x16& p0, f32x16& p1, const float rm, float& mhat, f32x16& negm, float& alpha) {
    alpha = 1.f;
    if (__builtin_expect(__any(rm > THR), 0)) {
        const float dl = fmaxf(rm, 0.f); mhat += dl;
#pragma unroll
        for (int r = 0; r < 16; ++r) { p0[r] -= dl; p1[r] -= dl; }
#pragma unroll
        for (int r = 0; r < 16; ++r) negm[r] = -mhat;
        asm volatile("" : "+v"(negm));
        alpha = __builtin_amdgcn_exp2f(-dl);
    }
}
__device__ __forceinline__ void finishSM(f32x16& p0, f32x16& p1, const float alpha, float& l_reg, bf16x8& pa0, bf16x8& pa1, bf16x8& pa2, bf16x8& pa3) {
#pragma unroll
    for (int r = 0; r < 16; ++r) { p0[r] = __builtin_amdgcn_exp2f(p0[r]); p1[r] = __builtin_amdgcn_exp2f(p1[r]); }
    float ps = 0.f, pt = 0.f;
#pragma unroll
    for (int r = 0; r < 16; ++r) { ps += p0[r]; pt += p1[r]; }
    l_reg = l_reg * alpha + (ps + pt);
#define ATT_PK8(P, BASE, OUT) do { u32x4 w = {cvtpk(P[BASE + 0], P[BASE + 1]), cvtpk(P[BASE + 2], P[BASE + 3]), cvtpk(P[BASE + 4], P[BASE + 5]), cvtpk(P[BASE + 6], P[BASE + 7])}; OUT = __builtin_bit_cast(bf16x8, w); } while (0)
    ATT_PK8(p0, 0, pa0); ATT_PK8(p0, 8, pa1); ATT_PK8(p1, 0, pa2); ATT_PK8(p1, 8, pa3);
#undef ATT_PK8
}
template <int ROWB> __device__ __forceinline__ int kswz(int row, int cb) { return row * ROWB + (ROWB == 128 ? (cb ^ (((row >> 1) & 7) << 4)) : (cb ^ ((row & 15) << 4))); }
template <int NB, int ROWB, int CB0, int D00> __device__ __forceinline__ void kread(bf16x8 (&kf)[2 * NB], const LAS unsigned char* Kb, int r32, int hi) {
#pragma unroll
    for (int d = 0; d < NB; ++d) { const int cb = CB0 + ((D00 + d) * 16 + hi * 8) * 2;
        kf[2 * d] = *(const LAS bf16x8*)(Kb + kswz<ROWB>(r32, cb)); kf[2 * d + 1] = *(const LAS bf16x8*)(Kb + kswz<ROWB>(32 + r32, cb)); }
}
template <int NB, int D00> __device__ __forceinline__ void kmma(f32x16& p0, f32x16& p1, const bf16x8 (&kf)[2 * NB], const bf16x8* qr, const f32x16& negm) {
#pragma unroll
    for (int d = 0; d < NB; ++d) {
        if (D00 + d == 0) { p0 = __builtin_amdgcn_mfma_f32_32x32x16_bf16(kf[0], qr[0], negm, 0, 0, 0); p1 = __builtin_amdgcn_mfma_f32_32x32x16_bf16(kf[1], qr[0], negm, 0, 0, 0); }
        else { p0 = __builtin_amdgcn_mfma_f32_32x32x16_bf16(kf[2 * d], qr[D00 + d], p0, 0, 0, 0); p1 = __builtin_amdgcn_mfma_f32_32x32x16_bf16(kf[2 * d + 1], qr[D00 + d], p1, 0, 0, 0); } }
}
template <int NKS, int ROWB, int CB0> __device__ __forceinline__ void qkt2(f32x16& p0, f32x16& p1, const LAS unsigned char* Kb, const bf16x8* qr, const f32x16& negm, int r32, int hi) {
    constexpr int N1 = NKS > 4 ? 3 : NKS, N2 = NKS - N1;
    bf16x8 ka[2 * N1]; kread<N1, ROWB, CB0, 0>(ka, Kb, r32, hi);
    if constexpr (N2 > 0) { bf16x8 kb[2 * N2]; kread<N2, ROWB, CB0, N1>(kb, Kb, r32, hi);
        kmma<N1, 0>(p0, p1, ka, qr, negm); kmma<N2, N1>(p0, p1, kb, qr, negm); }
    else kmma<N1, 0>(p0, p1, ka, qr, negm);
}

template <int TYPE> struct Ring { static constexpr int KSLOT = TYPE == 1 ? 16384 : 8192, VSLOT = 8192, L_K = 0, L_V = 3 * KSLOT, L_WS = L_V + 4 * VSLOT, L_OST = L_WS + 2048; };
template <int TYPE, int CB0> __device__ __forceinline__ void flash_pass(const Tensors& Tn, LAS unsigned char* lds, const int tid, const int b, const int h, const bool lat, const int q0, const int wrow, const int var, const bf16x8* qr,
                                                                        f32x16 (&o)[2], float& l_out, float& m_out) {
    constexpr int NKS = TYPE == 0 ? 4 : (TYPE == 1 ? 6 : 2);
    constexpr int ROWB = TYPE == 1 ? 256 : 128;
    typedef Ring<TYPE> RG;
    const int lane = tid & 63, wid = __builtin_amdgcn_readfirstlane(tid >> 6), r32 = lane & 31, hi = lane >> 5;
    LAS float* al_l = (LAS float*)(lds + RG::L_WS) + wid * 64;
    const int kvh = h >> 2;
    const bf16* Kp = TYPE == 0 ? Tn.P + P_AK + kvh * 64 : (TYPE == 1 ? Tn.QKVM + 512 + h * 128 : Tn.P + P_DK + h * 64);
    const bf16* Vp = TYPE == 0 ? Tn.P + P_AV + kvh * 64 : (TYPE == 1 ? Tn.QKVM + 512 + h * 128 + 64 : Tn.P + P_DV + h * 64);
    constexpr int KPITCH = TYPE == 1 ? LDM : LDP;
    int kl0 = 0, nloc = 0;
    if (lat) { if (TYPE == 0) { kl0 = q0 - 128 < 0 ? 0 : q0 - 128; const int kl1 = q0 + 64 + 128 > T ? T : q0 + 64 + 128; nloc = (kl1 - kl0) >> 6; } else { kl0 = 0; nloc = T / 64; } }
    const int NT = 4 + nloc;
    const int crow0 = RL + b * LC, lrow0 = b * T + kl0;
#define ATT_TROW(i) ((var & 64) ? crow0 : ((i) < 4 ? crow0 + 64 * (i) : lrow0 + 64 * ((i) - 4)))
    const bf16* ksrc0; const bf16* ksrc1 = nullptr;
    if (TYPE != 1) { const int row = 8 * wid + (lane >> 3), c = (lane & 7) ^ ((row >> 1) & 7); ksrc0 = Kp + (size_t)row * KPITCH + c * 8; }
    else {
        { const int row = 8 * wid + (lane >> 4), c = (lane & 15) ^ (row & 15); ksrc0 = c < 8 ? Kp + (size_t)row * LDM + c * 8 : (c < 12 ? Tn.P + (size_t)row * LDP + P_KR + (c - 8) * 8 : Kp + (size_t)row * LDM); }
        { const int row = 8 * wid + 4 + (lane >> 4), c = (lane & 15) ^ (row & 15); ksrc1 = c < 8 ? Kp + (size_t)row * LDM + c * 8 : (c < 12 ? Tn.P + (size_t)row * LDP + P_KR + (c - 8) * 8 : Kp + (size_t)row * LDM); }
    }
    const bool k0p = TYPE == 1 && (((lane & 15) ^ ((8 * wid + (lane >> 4)) & 15)) >= 8) && (((lane & 15) ^ ((8 * wid + (lane >> 4)) & 15)) < 12);
    const bool k1p = TYPE == 1 && (((lane & 15) ^ ((8 * wid + 4 + (lane >> 4)) & 15)) >= 8) && (((lane & 15) ^ ((8 * wid + 4 + (lane >> 4)) & 15)) < 12);
    const bf16* vsrc = Vp + (size_t)(8 * wid + ((lane & 31) >> 2)) * KPITCH + (lane >> 5) * 32 + (lane & 3) * 8;
#define ATT_DMA_K(i, slot) do { if (var & 8) break; const int g_ = ATT_TROW((i) < NT ? (i) : NT - 1); \
        __builtin_amdgcn_global_load_lds((const unsigned*)(ksrc0 + (size_t)g_ * (k0p ? LDP : KPITCH)), (LAS unsigned*)(lds + RG::L_K + (slot) * RG::KSLOT + wid * (ROWB * 8)), 16, 0, 0); \
        if (TYPE == 1) __builtin_amdgcn_global_load_lds((const unsigned*)(ksrc1 + (size_t)g_ * (k1p ? LDP : KPITCH)), (LAS unsigned*)(lds + RG::L_K + (slot) * RG::KSLOT + wid * (ROWB * 8) + 1024), 16, 0, 0); } while (0)
#define ATT_DMA_V(i, slot) do { if (var & 8) break; const int g_ = ATT_TROW((i) < NT ? (i) : NT - 1); \
        __builtin_amdgcn_global_load_lds((const unsigned*)(vsrc + (size_t)g_ * KPITCH), (LAS unsigned*)(lds + RG::L_V + (slot) * RG::VSLOT + wid * 1024), 16, 0, 0); } while (0)
#define ATT_WAITBAR() do { if (var & 16) break; if (TYPE == 1) asm volatile("s_waitcnt vmcnt(3)" ::: "memory"); else asm volatile("s_waitcnt vmcnt(2)" ::: "memory"); __builtin_amdgcn_s_barrier(); asm volatile("" ::: "memory"); } while (0)
#define ATT_RESC(a) do { if (__any((a) < 1.f)) { if (hi == 0) al_l[r32] = (a); asm volatile("s_waitcnt lgkmcnt(0)" ::: "memory"); \
        _Pragma("unroll") for (int r = 0; r < 16; ++r) { const float f_ = al_l[crow(r, hi)]; o[0][r] *= f_; o[1][r] *= f_; } } } while (0)
    const int qpos = q0 + wrow + r32;
#define ATT_MASK(P0, P1, i) do { if (TYPE == 0) { const int kt0_ = kl0 + 64 * ((i) - 4) - qpos, lo_ = (i) >= 4 ? -128 : -(1 << 28), hi_ = (i) >= 4 ? 128 : (1 << 28); \
        _Pragma("unroll") for (int r = 0; r < 16; ++r) { const int k0_ = kt0_ + crow(r, hi); P0[r] = (k0_ < lo_ || k0_ > hi_) ? -1e30f : P0[r]; P1[r] = (k0_ + 32 < lo_ || k0_ + 32 > hi_) ? -1e30f : P1[r]; } } } while (0)
    const int vb0 = (int)(uintptr_t)(lds + RG::L_V) + v_rd_base(lane);
    const LAS unsigned char* Kr = lds + RG::L_K;
    float mhat = 0.f, l_reg = 0.f; f32x16 negm = f32x16{};
    int sp = 2, sc = 0;
#define ATT_ROT() do { const int t_ = sp; sp = sc; sc = (sc == 2 ? 0 : sc + 1); (void)t_; } while (0)
    const bool lag = ATT_STAGGER && wid >= 4;
    f32x16 p0 = f32x16{}, p1 = f32x16{}; bf16x8 pa0 = bf16x8{}, pa1 = bf16x8{}, pa2 = bf16x8{}, pa3 = bf16x8{};
#define ATT_SOFT(t, FIRST) do { ATT_MASK(p0, p1, t); float rm_ = rowmax32(p0, p1); float alpha_ = 1.f; \
        if (FIRST) { mhat = rm_; _Pragma("unroll") for (int r = 0; r < 16; ++r) { p0[r] -= rm_; p1[r] -= rm_; negm[r] = -rm_; } asm volatile("" : "+v"(negm)); } \
        else if (__builtin_expect(__any(rm_ > THR), 0)) { const float dl = fmaxf(rm_, 0.f); mhat += dl; \
            _Pragma("unroll") for (int r = 0; r < 16; ++r) { p0[r] -= dl; p1[r] -= dl; negm[r] = -mhat; } asm volatile("" : "+v"(negm)); \
            alpha_ = __builtin_amdgcn_exp2f(-dl); ATT_RESC(alpha_); } \
        finishSM(p0, p1, alpha_, l_reg, pa0, pa1, pa2, pa3); } while (0)
#define ATT_STEP(t) do { \
        if (lag || !ATT_LATE_DMA) { ATT_DMA_K((t) + 2, sp); ATT_DMA_V((t) + 1, ((t) + 1) & 3); } \
        { bf16x8 kf_[2 * NKS]; att::VFrag va_, vb_; const int vbt_ = vb0 + (((t) - 1) & 3) * RG::VSLOT; \
          kread<NKS, ROWB, CB0, 0>(kf_, Kr + sc * RG::KSLOT, r32, hi); vread<0>(va_, vbt_); \
          asm volatile("s_waitcnt lgkmcnt(0)" ::: "memory"); ATT_SBAR(); \
          kmma<NKS, 0>(p0, p1, kf_, qr, negm); ATT_SBAR(); \
          vread<1>(vb_, vbt_); ATT_SBAR(); \
          pv_mma(o[0], va_, pa0, pa1, pa2, pa3); \
          asm volatile("s_waitcnt lgkmcnt(0)" ::: "memory"); ATT_SBAR(); \
          pv_mma(o[1], vb_, pa0, pa1, pa2, pa3); } \
        asm volatile("" : "+v"(p0), "+v"(p1), "+v"(o[0]), "+v"(o[1])); \
        if (lag) ATT_WAITBAR(); \
        if (!lag && ATT_LATE_DMA) { ATT_DMA_K((t) + 2, sp); ATT_DMA_V((t) + 1, ((t) + 1) & 3); }     \
        ATT_SOFT(t, false); \
        asm volatile("" : "+v"(pa0), "+v"(pa1), "+v"(pa2), "+v"(pa3), "+v"(l_reg)); \
        if (!lag) ATT_WAITBAR(); ATT_ROT(); } while (0)
    ATT_DMA_K(0, 0); ATT_DMA_V(0, 0); ATT_DMA_K(1, 1);
    asm volatile("s_waitcnt vmcnt(0)" ::: "memory"); __builtin_amdgcn_s_barrier(); asm volatile("" ::: "memory");
    { ATT_DMA_K(2, 2); ATT_DMA_V(1, 1);
      qkt2<NKS, ROWB, CB0>(p0, p1, Kr, qr, negm, r32, hi);
      asm volatile("" : "+v"(p0), "+v"(p1));
      if (lag) ATT_WAITBAR();
      ATT_SOFT(0, true);
      asm volatile("" : "+v"(pa0), "+v"(pa1), "+v"(pa2), "+v"(pa3), "+v"(l_reg));
      if (!lag) ATT_WAITBAR(); ATT_ROT(); }
    for (int j = 1; j < ((var & 32) ? ATT_XSTEPS : NT); ++j) ATT_STEP(j);
    pv_one<0>(o[0], vb0 + ((NT - 1) & 3) * RG::VSLOT, pa0, pa1, pa2, pa3); pv_one<1>(o[1], vb0 + ((NT - 1) & 3) * RG::VSLOT, pa0, pa1, pa2, pa3);
    asm volatile("s_waitcnt vmcnt(0)" ::: "memory"); __builtin_amdgcn_s_barrier(); asm volatile("" ::: "memory");
#undef ATT_SOFT
    { auto rr = __builtin_amdgcn_permlane32_swap(__float_as_uint(l_reg), __float_as_uint(l_reg), false, false); l_reg = __uint_as_float(rr[0]) + __uint_as_float(rr[1]); }
    l_out = l_reg; m_out = mhat;
#undef ATT_TROW
#undef ATT_DMA_K
#undef ATT_DMA_V
#undef ATT_WAITBAR
#undef ATT_RESC
#undef ATT_MASK
#undef ATT_ROT
#undef ATT_STEP
}

template <int TYPE> __device__ __forceinline__ void unit(const Tensors& Tn, LAS unsigned char* lds, const int tid, const int b, const int h, const bool lat, const int q0, const int var) {
    constexpr int NKS = TYPE == 0 ? 4 : (TYPE == 1 ? 6 : 2);
    const int lane = tid & 63, wid = __builtin_amdgcn_readfirstlane(tid >> 6), r32 = lane & 31, hi = lane >> 5;
    typedef Ring<TYPE> RG;
    LAS float* wsf = (LAS float*)(lds + RG::L_WS) + wid * 64;
    const int hw = TYPE == 0 ? h * 4 + (wid & 3) : h, wrow = TYPE == 0 ? (wid >> 2) * 32 : wid * 32;
    const int qrow0 = (lat ? b * T + q0 : RL + b * LC + q0) + wrow;
    bf16x8 qr[TYPE == 2 ? 4 : NKS];
    { const bf16* qp = TYPE == 0 ? Tn.P + (size_t)(qrow0 + r32) * LDP + P_AQ + hw * 64 : (TYPE == 1 ? Tn.QKVM + (size_t)(qrow0 + r32) * LDM + h * 96 : Tn.P + (size_t)(qrow0 + r32) * LDP + P_DQ + h * 64);
#pragma unroll
      for (int d0 = 0; d0 < (TYPE == 2 ? 4 : NKS); ++d0) qr[d0] = *(const bf16x8*)(qp + d0 * 16 + hi * 8); }
    f32x16 oA[2] = {f32x16{}, f32x16{}}; float l0, m0;
    flash_pass<TYPE, 0>(Tn, lds, tid, b, hw, lat, q0, wrow, var, qr, oA, l0, m0);
    f32x16 oB[2] = {f32x16{}, f32x16{}}; float l1 = 1.f, m1 = 0.f;
    LAS float* stash = (LAS float*)(lds + RG::L_OST + wid * 8192);
    if (TYPE == 2) {
#pragma unroll
        for (int r = 0; r < 16; ++r) { stash[r * 64 + lane] = oA[0][r]; stash[(16 + r) * 64 + lane] = oA[1][r]; }
        flash_pass<TYPE, 64>(Tn, lds, tid, b, h, lat, q0, wrow, var, qr + 2, oB, l1, m1);
#pragma unroll
        for (int r = 0; r < 16; ++r) { oA[0][r] = stash[r * 64 + lane]; oA[1][r] = stash[(16 + r) * 64 + lane]; }
        asm volatile("s_waitcnt lgkmcnt(0)" ::: "memory");
    }
    if (TYPE == 0) l0 += __builtin_amdgcn_exp2f(Tn.sink[Tn.l * 8 + hw] * 1.4426950408889634f - m0);
    if (hi == 0) { wsf[r32] = l0; if (TYPE == 2) wsf[32 + r32] = l1; }
    asm volatile("s_waitcnt lgkmcnt(0)" ::: "memory");
    LAS bf16* stg = (LAS bf16*)(lds + RG::L_OST + wid * (TYPE == 2 ? 8192 : 4096));
    if (TYPE != 2) {
#pragma unroll
        for (int r = 0; r < 16; ++r) { const float rl = __builtin_amdgcn_rcpf(wsf[crow(r, hi)]); const int orow = crow(r, hi);
            stg[orow * 64 + r32] = (bf16)f2bf(oA[0][r] * rl); stg[orow * 64 + 32 + r32] = (bf16)f2bf(oA[1][r] * rl); }
    } else {
        const float g0 = Tn.dnorm[Tn.l * 64 + r32], g1 = Tn.dnorm[Tn.l * 64 + 32 + r32];
#pragma unroll
        for (int r = 0; r < 16; ++r) { const float rl0 = __builtin_amdgcn_rcpf(wsf[crow(r, hi)]), rl1 = Tn.lam * __builtin_amdgcn_rcpf(wsf[32 + crow(r, hi)]);
            const float a0 = oA[0][r] * rl0 - oB[0][r] * rl1, a1 = oA[1][r] * rl0 - oB[1][r] * rl1;
            float ss = a0 * a0 + a1 * a1;
#pragma unroll
            for (int o_ = 1; o_ < 32; o_ <<= 1) ss += shx(ss, o_, lane);
            const float rs = (1.f - Tn.lam_init) * __builtin_amdgcn_rsqf(ss * (1.f / 64.f) + EPS); const int orow = crow(r, hi);
            stg[orow * 64 + r32] = (bf16)f2bf(a0 * rs * g0); stg[orow * 64 + 32 + r32] = (bf16)f2bf(a1 * rs * g1); }
    }
    asm volatile("s_waitcnt lgkmcnt(0)" ::: "memory");
    { bf16* Ow = Tn.O + (size_t)qrow0 * D + (TYPE == 0 ? hw * 64 : (TYPE == 1 ? 512 + h * 64 : 768 + h * 64));
#pragma unroll
      for (int i = 0; i < 4; ++i) { const int row = i * 8 + (lane >> 3), ch = lane & 7; *(u32x4*)(Ow + (size_t)row * D + ch * 8) = *(const LAS u32x4*)(stg + row * 64 + ch * 8); } }
    asm volatile("s_waitcnt lgkmcnt(0)" ::: "memory"); __builtin_amdgcn_s_barrier(); asm volatile("" ::: "memory");
}
}

__device__ __forceinline__ void attn_phase(Frame& F, const int l, const bool need_ctx) {
    att::Tensors Tn; Tn.P = F_P; Tn.QKVM = F_QKVM; Tn.O = F_O; Tn.sink = F_sink; Tn.dnorm = F_diff_norm; Tn.l = l;
    { float s1 = 0.f, s2 = 0.f;
      if (F.lane < 32) { s1 = F_lq1[l * 32 + F.lane] * F_lk1[l * 32 + F.lane]; s2 = F_lq2[l * 32 + F.lane] * F_lk2[l * 32 + F.lane]; }
      s1 = wave_sum(s1, F.lane); s2 = wave_sum(s2, F.lane);
      int ll_ = l; asm volatile("" : "+s"(ll_));
      const float li_ = ll_ == 0 ? 0.200000000f : (ll_ == 1 ? 0.355509068f : (ll_ == 2 ? 0.470713018f : 0.556058204f));
      const float lm_ = __expf(s1) - __expf(s2) + li_;
      Tn.lam_init = li_; Tn.lam = __builtin_bit_cast(float, __builtin_amdgcn_readfirstlane(__builtin_bit_cast(int, lm_))); }
    const int b = F.bid & 7, j = F.bid >> 3;
    if (F.G != 256) return;
    const int nu = (need_ctx && j < 16) ? 5 : 4;
    for (int u = 0; u < nu + ATT_EXTRA; ++u) {
        int type, h, q0; bool lat = true; const int var = u >= nu ? ATT_XVAR : 0;
        if (u >= nu) { type = ATT_EXTRA_TYPE; h = ATT_EXTRA_TYPE == 0 ? ((j >> 3) & 1) : (j >> 3); q0 = ATT_EXTRA_TYPE == 0 ? j * 64 : (j & 7) * 256; Tn.O = F_ACT; }
        else if (u == 0) { type = 2; h = j >> 3; q0 = (j & 7) * 256; }
        else if (u == 1) { type = 1; h = j >> 3; q0 = (j & 7) * 256; }
        else if (u < 4) { type = 0; h = u - 2; q0 = j * 64; }
        else { lat = false; q0 = 0; if (j < 8) { type = 0; h = j >> 2; q0 = (j & 3) * 64; } else if (j < 12) { type = 1; h = j - 8; } else { type = 2; h = j - 12; } }
        int t_ = F.tid; asm volatile("" : "+v"(t_));
        if (type == 0) att::unit<0>(Tn, F.lds, t_, b, h, lat, q0, var);
        else if (type == 1) att::unit<1>(Tn, F.lds, t_, b, h, lat, q0, var);
        else att::unit<2>(Tn, F.lds, t_, b, h, lat, q0, var);
    }
}

enum { PH_P0 = 0, PH_L0 = 1, PH_PER_LAYER = 9, PH_FINAL = PH_L0 + DEPTH * PH_PER_LAYER, NPH = PH_FINAL + 1 };
enum { SP_NORM1 = 0, SP_INPROJ = 1, SP_UP = 2, SP_ATTN = 3, SP_OUT = 4, SP_NORM2 = 5, SP_TOPK = 6, SP_MOE1 = 7, SP_MOE2 = 8 };

#ifndef REPS_INIT
#define REPS_INIT {1, 1, 1, 1, 1, 1, 1, 1, 1}
#endif
#ifndef REP_P0
#define REP_P0 1
#endif
#ifndef REP_FINAL
#define REP_FINAL 1
#endif
#ifndef KROT_ON
#define KROT_ON 0
#endif
#ifndef PROBE_NOMMA
#define PROBE_NOMMA 0
#endif
#ifndef PHMASK
#define PHMASK 0x3ff
#endif
#define PHON(b) ((PHMASK >> (b)) & 1)
#define REPSEL(s) ((s) == 0 ? reps_sp[0] : (s) == 1 ? reps_sp[1] : (s) == 2 ? reps_sp[2] : (s) == 3 ? reps_sp[3] : (s) == 4 ? reps_sp[4] : (s) == 5 ? reps_sp[5] : (s) == 6 ? reps_sp[6] : (s) == 7 ? reps_sp[7] : reps_sp[8])
__global__ void __launch_bounds__(NWAVES * 64, 2) mk(Args args) {
    extern __shared__ __attribute__((aligned(16))) unsigned char lds_raw[];
    Frame F;
    F.lds = (LAS unsigned char*)lds_raw;
    F.tid = threadIdx.x; F.lane = F.tid & 63; F.wave = __builtin_amdgcn_readfirstlane(F.tid >> 6); F.bid = blockIdx.x; F.G = gridDim.x;
    const int wave_s = F.wave;
    F.in = (const float* const*)args.in; F.out = (GAS float*)args.out; F.ws = (GAS unsigned char*)args.ws;
    volatile LAS unsigned* MISC = (volatile LAS unsigned*)(F.lds + MISC_OFF);
    for (int u = F.tid; u < (LDS_BYTES - LDSCTL_OFF) / 4; u += NWAVES * 64) ((LAS unsigned*)(F.lds + LDSCTL_OFF))[u] = 0u;
    __syncthreads();
    XcdBarrier bar = xcd_barrier_post((unsigned*)(args.ws + WS_CTL) + CW_BAR + args.li * XCD_BAR_WORDS, MISC + 8);
    const int gx = F.bid & 7, gj = F.bid >> 3, gpx = F.G >> 3, krot = KROT_ON ? (gj & 7) + 3 * (gj >> 3) : 0;
    constexpr int reps_sp[9] = REPS_INIT;
    for (int ph = args.ph_lo; ph < args.ph_hi; ++ph) {
      const int nrep = ph == PH_P0 ? REP_P0 : (ph == PH_FINAL ? REP_FINAL : (REPSEL((ph - PH_L0) % PH_PER_LAYER)));
      for (int rep = 0; rep < nrep; ++rep) {
        const float keep = rep + 1 == nrep ? 1.f : 0.f;
        { unsigned char* w_ = args.ws; asm volatile("" : "+s"(w_)); F.ws = (GAS unsigned char*)w_; int z_ = 0; asm volatile("" : "+s"(z_)); F.in = (const float* const*)args.in + z_;
          int l_; asm volatile("v_mbcnt_lo_u32_b32 %0, -1, 0\n\tv_mbcnt_hi_u32_b32 %0, -1, %0" : "=v"(l_));
          int w_s = wave_s; asm volatile("" : "+s"(w_s)); F.lane = l_; F.wave = w_s; F.tid = w_s * 64 + l_; }
        if (ph == PH_P0) { if (PHON(9)) p0_phase(F); }
        else if (ph == PH_FINAL) { if (PHON(0)) norm_phase(F, DEPTH, 2, RL, keep); }
        else {
            const int l = (ph - PH_L0) / PH_PER_LAYER, sp = (ph - PH_L0) % PH_PER_LAYER;
            const bool need_ctx = l < DEPTH - 1; const int rows_mix = need_ctx ? R : RL;
            const bf16* wl = F_WB + (size_t)l * W_LAYER;
            if (sp == SP_NORM1) { if (PHON(0)) norm_phase(F, l, 0, R, keep); }
            else if (sp == SP_INPROJ && PHON(1)) {
                pg8::Gemm g{F_ACT, wl + W_IN, nullptr, 0, D, D}; OrderRows S{gx, gj, gpx, R / 288 / 8, LDP / 256, 0, krot, 288};
                EpiInProj<3, 3> E{F_P, F_ROPE, F_RSQ};
                pg8::gemm_phase288<false>(F.lds, F.tid, g, S, E);
                { const int nbusy = 8;
                  if (BG_PREP && l + 1 < DEPTH && rep + 1 == nrep && gj >= nbusy) prep_layer(F, l + 1, ((gx * (gpx - nbusy) + (gj - nbusy)) * NWAVES) + F.wave, 8 * (gpx - nbusy) * NWAVES); }
            } else if (sp == SP_UP && PHON(2)) {
                pg8::Gemm g{F_P + P_CQ, wl + W_UP, nullptr, 0, LDP, UPK}; OrderRows S{gx, gj, gpx, R / 288 / 8, 4, 0, krot, 288};
                EpiUp<3, 3> E{F_QKVM, F_ROPE, F_RSQ};
                pg8::gemm_phase288<false>(F.lds, F.tid, g, S, E);
            } else if (sp == SP_ATTN) { if (PHON(3)) attn_phase(F, l, need_ctx);
            } else if (sp == SP_OUT && PHON(4)) {
                pg8::Gemm g{F_O, wl + W_OUT, nullptr, 0, D, D};
                if (need_ctx) { OrderRows S{gx, gj, gpx, R / 288 / 8, 4, 0, krot, 288}; EpiOut<3, 3> E{F_X, F_MOD + (size_t)l * 9 * 6144, keep, F_x, F_ctx, 0}; pg8::gemm_phase288<false>(F.lds, F.tid, g, S, E); }
                else { OrderRows S{gx, gj, gpx, RL / 256 / 8, 4, 0, krot, 256}; EpiOut<4> E{F_X, F_MOD + (size_t)l * 9 * 6144, keep, F_x, F_ctx, 0}; pg8::gemm_phase<false, 4>(F.lds, F.tid, g, S, E); }
            } else if (sp == SP_NORM2) { if (PHON(5)) norm_phase(F, l, 1, rows_mix, keep); }
            else if (sp == SP_TOPK) { if (PHON(6)) topk_phase(F, need_ctx ? 16 : 8);
#if MOE_PF
                { unsigned acc = 0;
                  for (int e2 = 0; e2 < 2; ++e2) { const int e = 2 * gx + e2;
                    const u32x4* p1 = (const u32x4*)(wl + W_GU + (size_t)e * 1024 * 1024); const u32x4* p2 = (const u32x4*)(wl + W_DN + (size_t)e * 1024 * 512);
#pragma unroll 4
                    for (int i = gj * 512 + F.tid; i < 131072; i += gpx * 512) acc ^= p1[i].x;
#pragma unroll 4
                    for (int i = gj * 512 + F.tid; i < 65536; i += gpx * 512) acc ^= p2[i].x; }
                  asm volatile("" :: "v"(acc)); }
#endif
            }
            else if (sp == SP_MOE1 && PHON(7)) {
                pg8::Gemm g{F_ACT, wl + W_GU, F_STOK, (size_t)1024 * 1024, D, D};
                if (need_ctx) { OrderMoe S{gx, gj, gpx, 8, 4, krot, 288}; EpiGU<3, 3> E{F_HID}; pg8::gemm_phase288<true>(F.lds, F.tid, g, S, E); }
                else { OrderMoe S{gx, gj, gpx, 8, 4, krot, 256}; EpiGU<4> E{F_HID}; pg8::gemm_phase<true, 4>(F.lds, F.tid, g, S, E); }
            } else if (sp == SP_MOE2 && PHON(8)) {
                pg8::Gemm g{F_HID, wl + W_DN, nullptr, (size_t)1024 * 512, DE, DE};
                if (need_ctx) { OrderMoe S{gx, gj, gpx, 8, 4, krot, 288}; EpiDown<3, 3> E{F_Y, F_SGATE}; pg8::gemm_phase288<false>(F.lds, F.tid, g, S, E); }
                else { OrderMoe S{gx, gj, gpx, 8, 4, krot, 256}; EpiDown<4> E{F_Y, F_SGATE}; pg8::gemm_phase<false, 4>(F.lds, F.tid, g, S, E); }
            }
        }
        if (ph + 1 < args.ph_hi || rep + 1 < nrep) { xcd_barrier(bar, F.tid);
#ifdef EXTRA_BAR
            xcd_barrier(bar, F.tid);
#endif
        }
      }
    }
}

extern "C" void kernel_launch(void* const* d_in, const int* in_sizes, int n_in, void* d_out, int out_size, void* d_ws, size_t ws_size, hipStream_t stream) {
    static int grid = 0;
    if (grid == 0) {
        if (n_in != 25 || ws_size < WS_END || out_size != RL * D) { fprintf(stderr, "kernel_launch: unexpected shapes (n_in %d, ws %zu < %zu, out %d)\n", n_in, ws_size, (size_t)WS_END, out_size); grid = -1; return; }
        int dev = 0, cus = 0, per_cu = 0;
        if (hipGetDevice(&dev) != hipSuccess || hipDeviceGetAttribute(&cus, hipDeviceAttributeMultiprocessorCount, dev) != hipSuccess) { grid = -1; return; }
        if (hipFuncSetAttribute((const void*)mk, hipFuncAttributeMaxDynamicSharedMemorySize, LDS_BYTES) != hipSuccess) { fprintf(stderr, "kernel_launch: hipFuncSetAttribute failed\n"); grid = -1; return; }
        if (hipOccupancyMaxActiveBlocksPerMultiprocessor(&per_cu, (const void*)mk, NWAVES * 64, LDS_BYTES) != hipSuccess || per_cu < 1) { fprintf(stderr, "kernel_launch: occupancy query says %d\n", per_cu); }
        (void)hipGetLastError();
        grid = cus;
        if (grid % 8 != 0) { fprintf(stderr, "kernel_launch: %d CUs, expected a multiple of 8\n", grid); grid = -1; return; }
    }
    if (grid < 0) return;
    (void)hipMemsetAsync((char*)d_ws + WS_CTL, 0, CTL_ZERO_BYTES, stream);
    Args a; memset(&a, 0, sizeof a);
    for (int i = 0; i < 25; ++i) a.in[i] = (const float*)d_in[i];
    a.out = (float*)d_out; a.ws = (unsigned char*)d_ws;
    a.ph_lo = 0; a.ph_hi = NPH; a.li = 0;
    hipLaunchKernelGGL(mk, dim3(grid), dim3(NWAVES * 64), LDS_BYTES, stream, a);
}
```

```cpp
#include <hip/hip_runtime.h>
#include <stdint.h>
#include <string.h>
#include <stdio.h>

typedef unsigned short bf16;
typedef unsigned u32x4 __attribute__((ext_vector_type(4)));
typedef unsigned u32x2 __attribute__((ext_vector_type(2)));
typedef float f32x4 __attribute__((ext_vector_type(4)));
typedef float f32x16 __attribute__((ext_vector_type(16)));
typedef short bf16x8 __attribute__((ext_vector_type(8)));
#define LAS __attribute__((address_space(3)))
#define GAS __attribute__((address_space(1)))

constexpr int D = 1024, NB = 8, T = 2048, LC = 256, DEPTH = 4;
constexpr int RL = NB * T, RC = NB * LC, R = RL + RC;
constexpr int INW = 1952, LDP = 2048;
constexpr int NE = 16, DE = 512;
constexpr int CAPL = 256, CAPC = 32;
constexpr int SLOTS_E = NB * CAPL + NB * CAPC;
constexpr int SLOTS = NE * SLOTS_E;
constexpr float EPS = 1e-6f;
constexpr int P_AQ = 0, P_AK = 512, P_AV = 640, P_CQ = 768, P_CKV = 1024, P_KR = 1152, P_DQ = 1184, P_DK = 1440, P_DV = 1696;
constexpr int LDM = 1024;
constexpr int UPK = 384;

constexpr size_t MiB = 1u << 20;
constexpr size_t WS_CTL = 0;
constexpr size_t CTL_ZERO_BYTES = 256 * 1024;
constexpr size_t WS_MOD = 1 * MiB;
constexpr size_t WS_ROPE = 2 * MiB;
constexpr size_t WS_RSQ = 3 * MiB;
constexpr size_t WS_AFF = 4 * MiB;
constexpr size_t WS_INV = 6 * MiB;
constexpr size_t WS_STOK = 8 * MiB;
constexpr size_t WS_SGATE = 9 * MiB;
#ifndef X_BF16
#define X_BF16 1
#endif
constexpr size_t WS_X = 10 * MiB;
constexpr size_t WS_ACT = 82 * MiB;
constexpr size_t WS_P = 118 * MiB;
constexpr size_t WS_Y = WS_P;
constexpr size_t WS_QKVM = 190 * MiB;
constexpr size_t WS_O = 226 * MiB;
constexpr size_t WS_HID = WS_O;
constexpr size_t WS_W = 262 * MiB;
constexpr size_t W_IN = 0;
constexpr size_t W_UP = W_IN + (size_t)LDP * D;
constexpr size_t W_OUT = W_UP + (size_t)1024 * UPK;
constexpr size_t W_GU = W_OUT + (size_t)D * D;
constexpr size_t W_DN = W_GU + (size_t)NE * 1024 * 1024;
constexpr size_t W_LAYER = W_DN + (size_t)NE * 1024 * 512;
constexpr size_t WS_END = WS_W + (size_t)DEPTH * W_LAYER * 2;

__device__ __forceinline__ unsigned f2bf(float f) { unsigned u = __builtin_bit_cast(unsigned, f); return (u + 0x7fffu + ((u >> 16) & 1u)) >> 16; }
__device__ __forceinline__ float bf2f(unsigned h) { return __builtin_bit_cast(float, h << 16); }
__device__ __forceinline__ unsigned pk2(float lo, float hi) { return f2bf(lo) | (f2bf(hi) << 16); }
__device__ __forceinline__ float shx(float v, int o, int lane) { return __builtin_bit_cast(float, __builtin_amdgcn_ds_bpermute((lane ^ o) << 2, __builtin_bit_cast(int, v))); }
__device__ __forceinline__ int shi(int v, int src) { return __builtin_amdgcn_ds_bpermute(src << 2, v); }
__device__ __forceinline__ float wave_sum(float v, int lane) {
#pragma unroll
    for (int o = 1; o < 64; o <<= 1) v += shx(v, o, lane);
    return v;
}
__device__ __forceinline__ float siluf(float v) { return v / (1.f + __expf(-v)); }
#define LDS_WAIT() asm volatile("s_waitcnt lgkmcnt(0)" ::: "memory")
#define VM_WAIT() asm volatile("s_waitcnt vmcnt(0)" ::: "memory")

struct Args {
    const float* in[25]; float* out; unsigned char* ws; int ph_lo, ph_hi, li, pad;
};

#ifndef PROBE_HOT
#define PROBE_HOT 0
#endif
#ifndef PROBE_NOEPI
#define PROBE_NOEPI 0
#endif
#ifndef PROBE_NOLDS
#define PROBE_NOLDS 0
#endif
#ifndef GEMM_ASKIP
#define GEMM_ASKIP 0
#endif
namespace pg8 {
constexpr int BM = 256, BK = 64, HALF = 128, HTB = HALF * BK * 2  , STAGE_BYTES = 8 * HTB;
__host__ __device__ __forceinline__ int lds_byte(int r, int c) { const int st = (r >> 4) * 2 + (c >> 5), rr = r & 15, cc = c & 31, ob = rr * 64 + cc * 2; return st * 1024 + (ob ^ (((ob >> 9) & 1) << 5)); }
__host__ __device__ __forceinline__ void stage_rc(int b, int& R, int& C) { const int st = b / 1024, sb = b % 1024, swz = sb ^ (((sb >> 9) & 1) << 5); R = (st >> 1) * 16 + swz / 64; C = (st & 1) * 32 + (swz % 64) / 2; }
__host__ __device__ __forceinline__ int perm32(int rho) { const int n = rho >> 4, i = rho & 15; return 8 * (i >> 2) + 4 * n + (i & 3); }

struct Unit { int arow0, orow0, col0, e, quad; };
struct Gemm { const bf16* A; const bf16* Bt; const int* gather; size_t b_estride; int lda, K; };

template <bool GATHER, int MF, class Epi, class Sched>
__device__ __forceinline__ void gemm_phase(LAS unsigned char* lds, const int tid, const Gemm g, const Sched& S, const Epi& E) {
    const int wid = __builtin_amdgcn_readfirstlane(tid >> 6), lane = tid & 63, wr = wid >> 2, wc = wid & 3, fr = lane & 15, fq = lane >> 4;
    constexpr bool ASKIP = (MF == 3) && GEMM_ASKIP;
    constexpr int HR = 32 * MF;
    const int K = g.K, nt = K / BK;
    unsigned voffA[2], voffB[2]; int sR[2];
#pragma unroll
    for (int i = 0; i < 2; ++i) { int C_; stage_rc(tid * 16 + i * 8192, sR[i], C_); const int Rb = (sR[i] & ~31) + perm32(sR[i] & 31);
        voffA[i] = GATHER ? (unsigned)C_ * 2u : (unsigned)(sR[i] * g.lda + C_) * 2u; voffB[i] = (unsigned)(Rb * K + C_) * 2u; }
    const unsigned lda2 = (unsigned)g.lda * 2u;
    const unsigned hstepA = (unsigned)HR * g.lda * 2u;
    const unsigned kstep = (unsigned)(BK * 2);
    const int krot = (2 * S.rot) % nt;
#define PG8_KT(i) ((PROBE_HOT && hot_) ? 0u : (unsigned)(((i) + krot) >= nt ? (i) + krot - nt : (i) + krot) * kstep)
    const unsigned hstepB = (unsigned)HALF * K * 2u;
    const __amdgpu_buffer_rsrc_t rsA = __builtin_amdgcn_make_buffer_rsrc((void*)g.A, 0, 0x7fffffff, 0x00020000);
    const __amdgpu_buffer_rsrc_t rsB = __builtin_amdgcn_make_buffer_rsrc((void*)g.Bt, 0, 0x7fffffff, 0x00020000);
    const unsigned ldsw = (unsigned)wid * 1024u;
    const int aoff = lds_byte(wr * (16 * MF) + fr, fq * 8), boff = lds_byte(wc * 32 + fr, fq * 8);
#define PG8_SA(b, h) (((b) * 2 + (h)) * HTB)
#define PG8_SB(b, h) ((4 + (b) * 2 + (h)) * HTB)
#define PG8_STAGE2(bufoff, rsrc, v0, v1, soff) do { \
        __builtin_amdgcn_raw_ptr_buffer_load_lds(rsrc, (LAS unsigned*)(lds + (bufoff) + ldsw), 16, (int)(v0), (int)(soff), 0, 0); \
        __builtin_amdgcn_raw_ptr_buffer_load_lds(rsrc, (LAS unsigned*)(lds + (bufoff) + ldsw + 8192), 16, (int)(v1), (int)(soff), 0, 0); } while (0)
#define PG8_STAGEB(bufoff, soff) PG8_STAGE2(bufoff, rsB, voffB[0], voffB[1], soff)
#define PG8_STAGE1(bufoff, rsrc, v0, soff) __builtin_amdgcn_raw_ptr_buffer_load_lds(rsrc, (LAS unsigned*)(lds + (bufoff) + ldsw), 16, (int)(v0), (int)(soff), 0, 0)
#define PG8_STAGEA(bufoff, ubase, r0, r1, h, koff) do { if constexpr (GATHER) { \
        if (ASKIP && wr == 1) PG8_STAGE1(bufoff, rsA, (((r0) >> (16 * (h))) & 0xffffu) * lda2 + voffA[0], (koff)); \
        else PG8_STAGE2(bufoff, rsA, (((r0) >> (16 * (h))) & 0xffffu) * lda2 + voffA[0], (((r1) >> (16 * (h))) & 0xffffu) * lda2 + voffA[1], (koff)); } \
        else { if (ASKIP && wr == 1) PG8_STAGE1(bufoff, rsA, voffA[0], (ubase) + (h) * hstepA + (koff)); \
        else PG8_STAGE2(bufoff, rsA, voffA[0], voffA[1], (ubase) + (h) * hstepA + (koff)); } } while (0)
#define PG8_LDA(dst, b, h) do { if (PROBE_NOLDS && hot_) break; _Pragma("unroll") for (int m = 0; m < MF; ++m) _Pragma("unroll") for (int k = 0; k < 2; ++k) dst[m][k] = *(const LAS bf16x8*)(lds + PG8_SA(b, h) + aoff + m * 2048 + k * 1024); } while (0)
#define PG8_LDB(dst, b, h) do { if (PROBE_NOLDS && hot_) break; _Pragma("unroll") for (int n = 0; n < 2; ++n) _Pragma("unroll") for (int k = 0; k < 2; ++k) dst[n][k] = *(const LAS bf16x8*)(lds + PG8_SB(b, h) + boff + n * 2048 + k * 1024); } while (0)
#define PG8_MMA(ai, bj, At, Bt) do { __builtin_amdgcn_s_setprio(1); _Pragma("unroll") for (int m = 0; m < MF; ++m) _Pragma("unroll") for (int n = 0; n < 2; ++n) _Pragma("unroll") for (int k = 0; k < 2; ++k) \
        acc[ai][bj][m][n] = __builtin_amdgcn_mfma_f32_16x16x32_bf16(Bt[n][k], At[m][k], acc[ai][bj][m][n], 0, 0, 0); __builtin_amdgcn_s_setprio(0); } while (0)
#define PG8_WAIT_V(n) asm volatile("s_waitcnt vmcnt(" #n ")" ::: "memory")
#define PG8_WAIT_V2(n, nskip) do { if (ASKIP && wr == 1) PG8_WAIT_V(nskip); else PG8_WAIT_V(n); } while (0)
#define PG8_WAIT_L(n) asm volatile("s_waitcnt lgkmcnt(" #n ")" ::: "memory")
#define PG8_BAR __builtin_amdgcn_s_barrier()
#define PG8_SCHED __builtin_amdgcn_sched_barrier(0)
#define PG8_ROWS(dst, u) do { if constexpr (GATHER) { _Pragma("unroll") for (int i = 0; i < 2; ++i) { \
        const int sr_ = sR[i] < HR ? sR[i] : sR[i] - 32;     \
        const unsigned a_ = (unsigned)g.gather[(u).arow0 + sr_], b_ = (unsigned)g.gather[(u).arow0 + ((u).quad ? 0 : HR) + sr_]; dst[i] = a_ | (b_ << 16); } \
        asm volatile("" : "+v"(dst[0]), "+v"(dst[1])); } } while (0)
    Unit cur, nxt; int ui = 0;
    if (!S.next(0, cur)) return;
    const bool hot_ = cur.quad == 2;
    f32x4 acc[2][2][MF][2];
#pragma unroll
    for (int a = 0; a < 2; ++a)
#pragma unroll
        for (int b = 0; b < 2; ++b)
#pragma unroll
            for (int m = 0; m < MF; ++m)
#pragma unroll
                for (int n = 0; n < 2; ++n) acc[a][b][m][n] = (f32x4){0.f, 0.f, 0.f, 0.f};
    bf16x8 At[MF][2], B0[2][2], B1[2][2];
    unsigned rp[2] = {0u, 0u}, rn[2] = {0u, 0u};
    PG8_ROWS(rp, cur);
    unsigned cA = (unsigned)cur.arow0 * lda2;
    unsigned cB = (unsigned)(((size_t)cur.e * g.b_estride + (size_t)cur.col0 * K) * 2);
    PG8_STAGEB(PG8_SB(0, 0), cB + PG8_KT(0)); PG8_STAGEB(PG8_SB(0, 1), cB + hstepB + PG8_KT(0)); PG8_STAGEA(PG8_SA(0, 0), cA, rp[0], rp[1], 0, PG8_KT(0)); PG8_STAGEA(PG8_SA(0, 1), cA, rp[0], rp[1], 1, PG8_KT(0));
    if (wr == 1) PG8_BAR;
    PG8_WAIT_V2(2, 1); PG8_BAR;
    PG8_STAGEB(PG8_SB(1, 0), cB + PG8_KT(1)); PG8_STAGEA(PG8_SA(1, 0), cA, rp[0], rp[1], 0, PG8_KT(1)); PG8_STAGEB(PG8_SB(1, 1), cB + hstepB + PG8_KT(1));
    PG8_WAIT_V2(6, 5); PG8_BAR;
    for (;;) {
        const bool has_next = S.next(ui + 1, nxt);
        if (has_next) { PG8_ROWS(rn, nxt); } else { rn[0] = rp[0]; rn[1] = rp[1]; }
        const unsigned nA = has_next ? (unsigned)nxt.arow0 * lda2 : cA;
        const unsigned nB = has_next ? (unsigned)(((size_t)nxt.e * g.b_estride + (size_t)nxt.col0 * K) * 2) : cB;
#pragma unroll 1
        for (int t = 0; t < nt; t += 2) {
            const bool last = (t == nt - 2);
            const unsigned k1 = PG8_KT(t + 1), k2 = last ? PG8_KT(0) : PG8_KT(t + 2), k3 = last ? PG8_KT(1) : PG8_KT(t + 3);
            const unsigned u2 = last ? nA : cA; const unsigned b2 = (last ? nB : cB) + k2; const unsigned b3 = (last ? nB : cB) + k3;
            const unsigned q0 = last ? rn[0] : rp[0], q1 = last ? rn[1] : rp[1];
            PG8_LDB(B0, 0, 0); PG8_LDB(B1, 0, 1); PG8_SCHED; PG8_LDA(At, 0, 0); PG8_STAGEA(PG8_SA(1, 1), cA, rp[0], rp[1], 1, k1);
            PG8_WAIT_V2(8, 6); PG8_WAIT_L(0); PG8_BAR; if (cur.quad < 2) PG8_MMA(0, 0, At, B0); if (!cur.quad) PG8_MMA(0, 1, At, B1); PG8_BAR; PG8_SCHED;
            PG8_LDA(At, 0, 1); PG8_STAGEB(PG8_SB(0, 0), b2); PG8_STAGEB(PG8_SB(0, 1), b2 + hstepB); PG8_STAGEA(PG8_SA(0, 0), u2, q0, q1, 0, k2);
            PG8_WAIT_V2(8, 6); PG8_WAIT_L(0); PG8_BAR; if (!cur.quad) { PG8_MMA(1, 0, At, B0); PG8_MMA(1, 1, At, B1); } PG8_BAR; PG8_SCHED;
            PG8_LDB(B0, 1, 0); PG8_LDB(B1, 1, 1); PG8_SCHED; PG8_LDA(At, 1, 0); PG8_STAGEA(PG8_SA(0, 1), u2, q0, q1, 1, k2);
            PG8_WAIT_V2(8, 6); PG8_WAIT_L(0); PG8_BAR; if (cur.quad < 2) PG8_MMA(0, 0, At, B0); if (!cur.quad) PG8_MMA(0, 1, At, B1); PG8_BAR; PG8_SCHED;
            PG8_LDA(At, 1, 1); PG8_STAGEB(PG8_SB(1, 0), b3); PG8_STAGEB(PG8_SB(1, 1), b3 + hstepB); PG8_STAGEA(PG8_SA(1, 0), u2, q0, q1, 0, k3);
            PG8_WAIT_V2(8, 6); PG8_WAIT_L(0); PG8_BAR; if (!cur.quad) { PG8_MMA(1, 0, At, B0); PG8_MMA(1, 1, At, B1); } PG8_BAR; PG8_SCHED;
        }
        if (wr == 0) PG8_BAR;
        if (!(PROBE_NOEPI && hot_)) E(acc, cur, wr, wc, fr, fq);
        if (!has_next) break;
#pragma unroll
        for (int a = 0; a < 2; ++a)
#pragma unroll
            for (int b = 0; b < 2; ++b)
#pragma unroll
                for (int m = 0; m < MF; ++m)
#pragma unroll
                    for (int n = 0; n < 2; ++n) acc[a][b][m][n] = (f32x4){0.f, 0.f, 0.f, 0.f};
        cur = nxt; cB = nB; cA = nA; ++ui; rp[0] = rn[0]; rp[1] = rn[1];
        if (wr == 1) PG8_BAR;
    }
    PG8_WAIT_V(0);
    PG8_BAR;
#undef PG8_SA
#undef PG8_SB
#undef PG8_STAGE2
#undef PG8_STAGEB
#undef PG8_LDA
#undef PG8_LDB
#undef PG8_MMA
#undef PG8_WAIT_V
#undef PG8_WAIT_V2
#undef PG8_STAGE1
#undef PG8_WAIT_L
#undef PG8_BAR
#undef PG8_SCHED
#undef PG8_KT
#undef PG8_ROWS
#undef PG8_STAGEA
}
constexpr int PTB = 96 * BK * 2, SB_OFF = 6 * PTB, STAGE288_BYTES = SB_OFF + 4 * HTB;
template <bool GATHER, class Epi, class Sched>
__device__ __forceinline__ void gemm_phase288(LAS unsigned char* lds, const int tid, const Gemm g, const Sched& S, const Epi& E) {
    constexpr int MF = 3;
    const int wid = __builtin_amdgcn_readfirstlane(tid >> 6), lane = tid & 63, wr = wid >> 2, wc = wid & 3, fr = lane & 15, fq = lane >> 4;
    const int K = g.K, nt = K / BK;
    unsigned voffA[2], voffB[2]; int sR[2];
#pragma unroll
    for (int i = 0; i < 2; ++i) { int C_; stage_rc(tid * 16 + i * 8192, sR[i], C_); const int Rb = (sR[i] & ~31) + perm32(sR[i] & 31);
        voffB[i] = (unsigned)(Rb * K + C_) * 2u;
        if (i == 1) stage_rc((tid & 255) * 16 + 8192, sR[i], C_);
        voffA[i] = GATHER ? (unsigned)C_ * 2u : (unsigned)(sR[i] * g.lda + C_) * 2u; }
    const unsigned lda2 = (unsigned)g.lda * 2u;
    const unsigned pstepA = 96u * g.lda * 2u;
    const unsigned kstep = (unsigned)(BK * 2);
    const unsigned hstepB = (unsigned)HALF * K * 2u;
    const __amdgpu_buffer_rsrc_t rsA = __builtin_amdgcn_make_buffer_rsrc((void*)g.A, 0, 0x7fffffff, 0x00020000);
    const __amdgpu_buffer_rsrc_t rsB = __builtin_amdgcn_make_buffer_rsrc((void*)g.Bt, 0, 0x7fffffff, 0x00020000);
    const unsigned ldsw = (unsigned)wid * 1024u, ldsx = 8192u + (unsigned)(wid & 3) * 1024u;
    const int aoff = lds_byte(wr * 48 + fr, fq * 8), boff = lds_byte(wc * 32 + fr, fq * 8);
#define PG9_SA(b, a) (((b) * 3 + (a)) * PTB)
#define PG9_SB(b, h) (SB_OFF + ((b) * 2 + (h)) * HTB)
#define PG9_DMA(rsrc, dstoff, v, soff) __builtin_amdgcn_raw_ptr_buffer_load_lds(rsrc, (LAS unsigned*)(lds + (dstoff) + ldsw), 16, (int)(v), (int)(soff), 0, 0)
#define PG9_STAGEB(bufoff, soff) do { PG9_DMA(rsB, (bufoff), voffB[0], (soff)); PG9_DMA(rsB, (bufoff) + 8192, voffB[1], (soff)); } while (0)
#define PG9_RIDX(r, a, i) ((a) < 2 ? (((r)[i] >> (16 * (a))) & 0xffffu) : (((r)[2] >> (16 * (i))) & 0xffffu))
#define PG9_DMAX(rsrc, dstoff, v, soff) __builtin_amdgcn_raw_ptr_buffer_load_lds(rsrc, (LAS unsigned*)(lds + (dstoff) + ldsx), 16, (int)(v), (int)(soff), 0, 0)
#define PG9_STAGEA(bufoff, ubase, r, a, koff, OWN) do { if constexpr (GATHER) { \
        PG9_DMA(rsA, (bufoff), PG9_RIDX(r, a, 0) * lda2 + voffA[0], (koff)); if (wr == (OWN)) PG9_DMAX(rsA, (bufoff), PG9_RIDX(r, a, 1) * lda2 + voffA[1], (koff)); } \
        else { PG9_DMA(rsA, (bufoff), voffA[0], (ubase) + (a) * pstepA + (koff)); if (wr == (OWN)) PG9_DMAX(rsA, (bufoff), voffA[1], (ubase) + (a) * pstepA + (koff)); } } while (0)
#define PG9_LDA(dst, b, a) do { _Pragma("unroll") for (int m = 0; m < MF; ++m) _Pragma("unroll") for (int k = 0; k < 2; ++k) dst[m][k] = *(const LAS bf16x8*)(lds + PG9_SA(b, a) + aoff + m * 2048 + k * 1024); } while (0)
#define PG9_LDB(dst, b, h) do { _Pragma("unroll") for (int n = 0; n < 2; ++n) _Pragma("unroll") for (int k = 0; k < 2; ++k) dst[n][k] = *(const LAS bf16x8*)(lds + PG9_SB(b, h) + boff + n * 2048 + k * 1024); } while (0)
#define PG9_MMA(ai, bj, At, Bt) do { __builtin_amdgcn_s_setprio(1); _Pragma("unroll") for (int m = 0; m < MF; ++m) _Pragma("unroll") for (int n = 0; n < 2; ++n) _Pragma("unroll") for (int k = 0; k < 2; ++k) \
        acc[ai][bj][m][n] = __builtin_amdgcn_mfma_f32_16x16x32_bf16(Bt[n][k], At[m][k], acc[ai][bj][m][n], 0, 0, 0); __builtin_amdgcn_s_setprio(0); } while (0)
#define PG9_WAIT_V(n) asm volatile("s_waitcnt vmcnt(" #n ")" ::: "memory")
#define PG9_WAIT_L(n) asm volatile("s_waitcnt lgkmcnt(" #n ")" ::: "memory")
#define PG9_BAR __builtin_amdgcn_s_barrier()
#define PG9_SCHED __builtin_amdgcn_sched_barrier(0)
#define PG9_ROWS(dst, u) do { if constexpr (GATHER) { unsigned t2_[2]; _Pragma("unroll") for (int i = 0; i < 2; ++i) { \
        const unsigned a_ = (unsigned)g.gather[(u).arow0 + sR[i]], b_ = (unsigned)g.gather[(u).arow0 + 96 + sR[i]]; t2_[i] = (unsigned)g.gather[(u).arow0 + 192 + sR[i]]; dst[i] = a_ | (b_ << 16); } \
        dst[2] = t2_[0] | (t2_[1] << 16); asm volatile("" : "+v"(dst[0]), "+v"(dst[1]), "+v"(dst[2])); } } while (0)
    Unit cur, nxt; int ui = 0;
    if (!S.next(0, cur)) return;
    f32x4 acc[3][2][MF][2];
#pragma unroll
    for (int a = 0; a < 3; ++a)
#pragma unroll
        for (int b = 0; b < 2; ++b)
#pragma unroll
            for (int m = 0; m < MF; ++m)
#pragma unroll
                for (int n = 0; n < 2; ++n) acc[a][b][m][n] = (f32x4){0.f, 0.f, 0.f, 0.f};
    bf16x8 At[MF][2], B0[2][2], B1[2][2];
    unsigned rp[3] = {0u, 0u, 0u}, rn[3] = {0u, 0u, 0u};
    PG9_ROWS(rp, cur);
    unsigned cA = (unsigned)cur.arow0 * lda2;
    unsigned cB = (unsigned)(((size_t)cur.e * g.b_estride + (size_t)cur.col0 * K) * 2);
    PG9_STAGEB(PG9_SB(0, 0), cB); PG9_STAGEA(PG9_SA(0, 0), cA, rp, 0, 0u, 0); PG9_STAGEB(PG9_SB(0, 1), cB + hstepB); PG9_STAGEA(PG9_SA(0, 1), cA, rp, 1, 0u, 1); PG9_STAGEA(PG9_SA(0, 2), cA, rp, 2, 0u, 0);
    PG9_STAGEB(PG9_SB(1, 0), cB + kstep); PG9_STAGEA(PG9_SA(1, 0), cA, rp, 0, kstep, 1); PG9_STAGEB(PG9_SB(1, 1), cB + hstepB + kstep); PG9_STAGEA(PG9_SA(1, 1), cA, rp, 1, kstep, 0);
    PG9_WAIT_V(10); PG9_BAR;
    if (wr == 1) PG9_BAR;
    for (;;) {
        const bool has_next = S.next(ui + 1, nxt);
        if (has_next) { PG9_ROWS(rn, nxt); } else { rn[0] = rp[0]; rn[1] = rp[1]; rn[2] = rp[2]; }
        const unsigned nA = has_next ? (unsigned)nxt.arow0 * lda2 : cA;
        const unsigned nB = has_next ? (unsigned)(((size_t)nxt.e * g.b_estride + (size_t)nxt.col0 * K) * 2) : cB;
#pragma unroll 1
        for (int t = 0; t < nt; t += 2) {
            const bool last = (t == nt - 2);
            const unsigned k1 = (unsigned)(t + 1) * kstep, k2 = last ? 0u : (unsigned)(t + 2) * kstep, k3 = last ? kstep : (unsigned)(t + 3) * kstep;
            const unsigned u2 = last ? nA : cA; const unsigned b2 = (last ? nB : cB) + k2; const unsigned b3 = (last ? nB : cB) + k3;
            unsigned q[3]; q[0] = last ? rn[0] : rp[0]; q[1] = last ? rn[1] : rp[1]; q[2] = last ? rn[2] : rp[2];
            PG9_LDB(B0, 0, 0); PG9_LDB(B1, 0, 1); PG9_SCHED; PG9_LDA(At, 0, 0); PG9_STAGEA(PG9_SA(1, 2), cA, rp, 2, k1, 1);
            PG9_WAIT_V(10); PG9_WAIT_L(0); PG9_BAR; PG9_MMA(0, 0, At, B0); PG9_MMA(0, 1, At, B1); PG9_BAR; PG9_SCHED;
            PG9_LDA(At, 0, 1); PG9_STAGEB(PG9_SB(0, 0), b2); PG9_STAGEA(PG9_SA(0, 0), u2, q, 0, k2, 0);
            PG9_WAIT_V(12); PG9_WAIT_L(0); PG9_BAR; PG9_MMA(1, 0, At, B0); PG9_MMA(1, 1, At, B1); PG9_BAR; PG9_SCHED;
            PG9_LDA(At, 0, 2); PG9_STAGEB(PG9_SB(0, 1), b2 + hstepB); PG9_STAGEA(PG9_SA(0, 1), u2, q, 1, k2, 1);
            PG9_WAIT_V(10); PG9_WAIT_L(0); PG9_BAR; PG9_MMA(2, 0, At, B0); PG9_MMA(2, 1, At, B1); PG9_BAR; PG9_SCHED;
            PG9_LDB(B0, 1, 0); PG9_LDB(B1, 1, 1); PG9_SCHED; PG9_LDA(At, 1, 0); PG9_STAGEA(PG9_SA(0, 2), u2, q, 2, k2, 0);
            PG9_WAIT_V(10); PG9_WAIT_L(0); PG9_BAR; PG9_MMA(0, 0, At, B0); PG9_MMA(0, 1, At, B1); PG9_BAR; PG9_SCHED;
            PG9_LDA(At, 1, 1); PG9_STAGEB(PG9_SB(1, 0), b3); PG9_STAGEA(PG9_SA(1, 0), u2, q, 0, k3, 1);
            PG9_WAIT_V(12); PG9_WAIT_L(0); PG9_BAR; PG9_MMA(1, 0, At, B0); PG9_MMA(1, 1, At, B1); PG9_BAR; PG9_SCHED;
            PG9_LDA(At, 1, 2); PG9_STAGEB(PG9_SB(1, 1), b3 + hstepB); PG9_STAGEA(PG9_SA(1, 1), u2, q, 1, k3, 0);
            PG9_WAIT_V(10); PG9_WAIT_L(0); PG9_BAR; PG9_MMA(2, 0, At, B0); PG9_MMA(2, 1, At, B1); PG9_BAR; PG9_SCHED;
        }
        if (wr == 0) PG9_BAR;
        E(acc, cur, wr, wc, fr, fq);
        if (!has_next) break;
#pragma unroll
        for (int a = 0; a < 3; ++a)
#pragma unroll
            for (int b = 0; b < 2; ++b)
#pragma unroll
                for (int m = 0; m < MF; ++m)
#pragma unroll
                    for (int n = 0; n < 2; ++n) acc[a][b][m][n] = (f32x4){0.f, 0.f, 0.f, 0.f};
        cur = nxt; cB = nB; cA = nA; ++ui; rp[0] = rn[0]; rp[1] = rn[1]; rp[2] = rn[2];
        if (wr == 1) PG9_BAR;
    }
    PG9_WAIT_V(0);
    PG9_BAR;
#undef PG9_SA
#undef PG9_SB
#undef PG9_DMA
#undef PG9_DMAX
#undef PG9_STAGEB
#undef PG9_RIDX
#undef PG9_STAGEA
#undef PG9_LDA
#undef PG9_LDB
#undef PG9_MMA
#undef PG9_WAIT_V
#undef PG9_WAIT_L
#undef PG9_BAR
#undef PG9_SCHED
#undef PG9_ROWS
}
}

#ifndef QUAD_SPLIT
#define QUAD_SPLIT 1
#endif
__device__ __forceinline__ bool deal(int i, int j, int gpx, int U, int& unit, int& quad) {
    const int q = i * gpx + j, nfull = (U / gpx) * gpx, left = U - nfull;
    if (q < nfull || left * 4 > gpx || !QUAD_SPLIT) { if (q >= U) return false; unit = q; quad = -1; return true; }
    const int s_ = q - nfull; if (s_ >= left * 4) return false; unit = nfull + (s_ >> 2); quad = s_ & 3; return true;
}
struct OrderRows {
    int x, j, gpx, rpx, nN, nomma, rot, TR;
    __device__ __forceinline__ bool next(int i, pg8::Unit& u) const {
        int q, quad; if (!deal(i, j, gpx, rpx * nN, q, quad)) return false;
        const int pm = x * rpx + q / nN, pn = q % nN; u.arow0 = pm * TR; u.col0 = pn * 256; u.e = 0; u.quad = quad >= 0;
        if (quad >= 0) { u.arow0 += (quad >> 1) * (TR / 2); u.col0 += (quad & 1) * 128; }
        if (nomma) u.quad = 2;
        u.orow0 = u.arow0; return true; }
};
struct OrderMoe {
    int x, j, gpx, nME, nN, rot, TR;
    __device__ __forceinline__ bool next(int i, pg8::Unit& u) const {
        int q, quad; const int per = nME * nN; if (!deal(i, j, gpx, 2 * per, q, quad)) return false;
        const int e = 2 * x + q / per, rem = q % per, pmE = rem / nN, pn = rem % nN;
        u.arow0 = e * SLOTS_E + pmE * TR; u.col0 = pn * 256; u.e = e; u.quad = quad >= 0;
        if (quad >= 0) { u.arow0 += (quad >> 1) * (TR / 2); u.col0 += (quad & 1) * 128; }
        u.orow0 = u.arow0; return true; }
};

#if X_BF16
typedef bf16 XT;
#else
typedef float XT;
#endif
constexpr float QS_A = 0.125f * 1.4426950408889634f, QS_B = 0.10206207261596577f * 1.4426950408889634f, QS_C = 0.17677669529663687f * 1.4426950408889634f;
typedef float f32x4e __attribute__((ext_vector_type(4)));
#define EPI_ROWS(ai, m) (u.orow0 + (ai) * (32 * MF) + wr * (16 * MF) + (m) * 16 + fr)
#define EPI_COL0(bj) (u.col0 + (bj) * 128 + wc * 32 + 8 * fq)
__device__ __forceinline__ void rope8(f32x4& v0, f32x4& v1, const float* cs, const float* sn) {
    const f32x4 c = *(const f32x4*)cs, s = *(const f32x4*)sn;
    f32x4 a = v0, b = v1;
    v0.x = a.x * c.x - a.y * s.x; v0.y = a.y * c.x + a.x * s.x; v0.z = a.z * c.y - a.w * s.y; v0.w = a.w * c.y + a.z * s.y;
    v1.x = b.x * c.z - b.y * s.z; v1.y = b.y * c.z + b.x * s.z; v1.z = b.z * c.w - b.w * s.w; v1.w = b.w * c.w + b.z * s.w;
}
__device__ __forceinline__ u32x4 pack8(const f32x4 v0, const f32x4 v1) { u32x4 w; w.x = pk2(v0.x, v0.y); w.y = pk2(v0.z, v0.w); w.z = pk2(v1.x, v1.y); w.w = pk2(v1.z, v1.w); return w; }

template <int MF, int NA = 2> struct EpiInProj {
    bf16* P; const float* rope; float* RSQ;
    __device__ __forceinline__ void operator()(const f32x4 (&acc)[NA][2][MF][2], const pg8::Unit& u, int wr, int wc, int fr, int fq) const {
#pragma unroll
        for (int bj = 0; bj < 2; ++bj) {
            if (u.quad && bj) continue;
            const int c0 = EPI_COL0(bj);
            const bool secA = c0 < P_AV, secB = c0 >= P_KR && c0 < P_DV;
            const int which = (c0 >= P_CQ && c0 < P_CKV) ? 0 : ((c0 >= P_CKV && c0 < P_KR) ? 1 : -1);
            const int p0 = secA ? ((c0 & 63) >> 1) : ((c0 & 31) >> 1);
            const float qs = c0 < P_AK ? QS_A : ((c0 >= P_DQ && c0 < P_DK) ? QS_C : 1.f);
#pragma unroll
            for (int ai = 0; ai < NA; ++ai)
#pragma unroll
                for (int m = 0; m < MF; ++m) {
                    if (u.quad && ai) continue;
                    const int row = EPI_ROWS(ai, m);
                    f32x4 v0 = acc[ai][bj][m][0] * qs, v1 = acc[ai][bj][m][1] * qs;
                    if (row < RL && (secA || secB)) { const int t = row & (T - 1);
                        const float* cs = secA ? rope + t * 32 + p0 : rope + T * 64 + t * 16 + p0;
                        const float* sn = secA ? rope + T * 32 + t * 32 + p0 : rope + T * 64 + T * 16 + t * 16 + p0;
                        rope8(v0, v1, cs, sn); }
                    if (which >= 0) { float s = (v0.x * v0.x + v0.y * v0.y) + (v0.z * v0.z + v0.w * v0.w) + (v1.x * v1.x + v1.y * v1.y) + (v1.z * v1.z + v1.w * v1.w);
                        { const int ln_ = fq * 16 + fr; s += shx(s, 16, ln_); s += shx(s, 32, ln_); }
                        if (fq == 0) RSQ[(size_t)row * 12 + ((c0 - P_CQ) >> 5)] = s; }
                    *(u32x4*)(P + (size_t)row * LDP + c0) = pack8(v0, v1);
                }
        }
    }
};
template <int MF, int NA = 2> struct EpiUp {
    bf16* QKVM; const float* rope; const float* RSQ;
    __device__ __forceinline__ void operator()(const f32x4 (&acc)[NA][2][MF][2], const pg8::Unit& u, int wr, int wc, int fr, int fq) const {
        const bool isq = u.col0 < 512;
        const float inv = isq ? (1.f / 256.f) : (1.f / 128.f);
        const int cw = u.col0 + wc * 32 + 8 * fq;
        int j0 = cw; j0 -= j0 >= 192 ? 192 : 0; j0 -= j0 >= 96 ? 96 : 0;
        int j1 = j0 + 32; j1 -= j1 >= 96 ? 96 : 0;
        const bool rot0 = isq && cw < 384 && j0 >= 64, rot1 = isq && cw + 128 < 384 && j1 >= 64;
        const float* tb = rope + T * 64;
#pragma unroll
        for (int ai = 0; ai < NA; ++ai)
#pragma unroll
            for (int m = 0; m < MF; ++m) {
                if (u.quad && ai) continue;
                const int row = EPI_ROWS(ai, m);
                const float* rq = RSQ + (size_t)row * 12; float sq;
                if (isq) { const f32x4 pa_ = *(const f32x4*)rq, pb_ = *(const f32x4*)(rq + 4); sq = ((pa_.x + pa_.y) + (pa_.z + pa_.w)) + ((pb_.x + pb_.y) + (pb_.z + pb_.w)); }
                else { const f32x4 pc_ = *(const f32x4*)(rq + 8); sq = (pc_.x + pc_.y) + (pc_.z + pc_.w); }
                const float rs = __builtin_amdgcn_rsqf(sq * inv + EPS) * (isq ? QS_B : 1.f);
                const int t = row & (T - 1);
                bf16* dst = QKVM + (size_t)row * LDM + cw;
                { f32x4 v0 = acc[ai][0][m][0] * rs, v1 = acc[ai][0][m][1] * rs;
                  if (rot0 && row < RL) rope8(v0, v1, tb + t * 16 + ((j0 - 64) >> 1), tb + T * 16 + t * 16 + ((j0 - 64) >> 1));
                  *(u32x4*)dst = pack8(v0, v1); }
                if (!u.quad) { f32x4 v0 = acc[ai][1][m][0] * rs, v1 = acc[ai][1][m][1] * rs;
                  if (rot1 && row < RL) rope8(v0, v1, tb + t * 16 + ((j1 - 64) >> 1), tb + T * 16 + t * 16 + ((j1 - 64) >> 1));
                  *(u32x4*)(dst + 128) = pack8(v0, v1); }
            }
    }
};
template <int MF, int NA = 2> struct EpiOut {
    XT* X; const float* MODl; float keep;
    __device__ __forceinline__ void operator()(const f32x4 (&acc)[NA][2][MF][2], const pg8::Unit& u, int wr, int wc, int fr, int fq) const {
#pragma unroll
        for (int ai = 0; ai < NA; ++ai)
#pragma unroll
            for (int m = 0; m < MF; ++m) {
                if (u.quad && ai) continue;
                const int row_ = EPI_ROWS(ai, m); const int mb = row_ < RL ? row_ >> 11 : 8;
                const float* g1 = MODl + (size_t)mb * 6144 + 2048;
#pragma unroll
                for (int bj = 0; bj < 2; ++bj) {
                    if (u.quad && bj) continue;
                    const int c0 = EPI_COL0(bj);
                    const f32x4 ga = *(const f32x4*)(g1 + c0) * keep, gb = *(const f32x4*)(g1 + c0 + 4) * keep;
                    XT* xp = X + (size_t)row_ * D + c0;
#if X_BF16
                    const u32x4 xw = *(const u32x4*)xp;
                    f32x4 xa = (f32x4){bf2f(xw.x & 0xffffu), bf2f(xw.x >> 16), bf2f(xw.y & 0xffffu), bf2f(xw.y >> 16)}, xb = (f32x4){bf2f(xw.z & 0xffffu), bf2f(xw.z >> 16), bf2f(xw.w & 0xffffu), bf2f(xw.w >> 16)};
                    xa += ga * acc[ai][bj][m][0]; xb += gb * acc[ai][bj][m][1];
                    *(u32x4*)xp = pack8(xa, xb);
#else
                    f32x4 xa = *(const f32x4*)xp, xb = *(const f32x4*)(xp + 4);
                    xa += ga * acc[ai][bj][m][0]; xb += gb * acc[ai][bj][m][1];
                    *(f32x4*)xp = xa; *(f32x4*)(xp + 4) = xb;
#endif
                }
            }
    }
};
template <int MF, int NA = 2> struct EpiGU {
    bf16* HID;
    __device__ __forceinline__ void operator()(const f32x4 (&acc)[NA][2][MF][2], const pg8::Unit& u, int wr, int wc, int fr, int fq) const {
#pragma unroll
        for (int bj = 0; bj < 2; ++bj) {
            if (u.quad && bj) continue;
            const int hc = EPI_COL0(bj) >> 1;
#pragma unroll
            for (int ai = 0; ai < NA; ++ai)
#pragma unroll
                for (int m = 0; m < MF; ++m) {
                    if (u.quad && ai) continue;
                    const f32x4 g = acc[ai][bj][m][0], up = acc[ai][bj][m][1];
                    u32x2 w; w.x = pk2(siluf(g.x) * up.x, siluf(g.y) * up.y); w.y = pk2(siluf(g.z) * up.z, siluf(g.w) * up.w);
                    *(u32x2*)(HID + (size_t)EPI_ROWS(ai, m) * DE + hc) = w;
                }
        }
    }
};
template <int MF, int NA = 2> struct EpiDown {
    bf16* Y; const float* SGATE;
    __device__ __forceinline__ void operator()(const f32x4 (&acc)[NA][2][MF][2], const pg8::Unit& u, int wr, int wc, int fr, int fq) const {
#pragma unroll
        for (int ai = 0; ai < NA; ++ai)
#pragma unroll
            for (int m = 0; m < MF; ++m) {
                if (u.quad && ai) continue;
                const int row = EPI_ROWS(ai, m); const float gt = SGATE[row];
#pragma unroll
                for (int bj = 0; bj < 2; ++bj)
                    if (!(u.quad && bj)) *(u32x4*)(Y + (size_t)row * D + EPI_COL0(bj)) = pack8(acc[ai][bj][m][0] * gt, acc[ai][bj][m][1] * gt);
            }
    }
};

constexpr int NWAVES = 8;
constexpr int RING_BYTES = 139264;
constexpr int LDSCTL_OFF = RING_BYTES, MISC_OFF = LDSCTL_OFF + 320;
constexpr int LDS_BYTES = 147456;
constexpr int CW_BAR = 4096;
typedef GAS unsigned gu32;

#define XB_TMO      128
#define XB_XCNT(j)  (256  + 64 * (j))
#define XB_XSUB(j)  (1280 + 64 * (j))
#define XB_XGEN(j)  (2304 + 64 * (j))
#define XB_TOP      3328
#define XB_TOPGEN   3392
#define XCD_BAR_WORDS 3456
#define XB_SPIN_CAP (1u << 18)
__device__ __forceinline__ unsigned xb_ld(unsigned* p)              { return __hip_atomic_load(p, __ATOMIC_RELAXED, __HIP_MEMORY_SCOPE_AGENT); }
__device__ __forceinline__ unsigned xb_add(unsigned* p, unsigned v) { return __hip_atomic_fetch_add(p, v, __ATOMIC_RELAXED, __HIP_MEMORY_SCOPE_AGENT); }
__device__ __forceinline__ unsigned xb_xcc_id() { return (unsigned)__builtin_amdgcn_s_getreg((3 << 11) | 20) & 0xFu; }
#define XB_SPIN(cond, bar) do { unsigned _sp = 0; while (cond) { __builtin_amdgcn_s_sleep(1); \
    if ((++_sp & 255u) == 0u) { if (xb_ld(&(bar)[XB_TMO])) break; if (_sp > XB_SPIN_CAP) { atomicAdd(&(bar)[XB_TMO], 1u); break; } } } } while (0)
struct XcdBarrier { unsigned* bar; unsigned x; volatile LAS unsigned* st; };
__device__ __forceinline__ XcdBarrier xcd_barrier_post(unsigned* bar, volatile LAS unsigned* st) {
    XcdBarrier b; b.bar = bar; b.x = xb_xcc_id(); b.st = st;
    if (threadIdx.x == 0) (void)xb_add(&bar[XB_XCNT(b.x)], 1u);
    return b;
}
__device__ __forceinline__ void xcd_barrier_complete(unsigned* bar, unsigned x, unsigned& nloc, unsigned& nx) {
    const unsigned G = gridDim.x * gridDim.y * gridDim.z;
    unsigned sum, cnt, mine, sp = 0u;
    for (;;) {
        sum = 0u; cnt = 0u; mine = 0u;
#pragma unroll
        for (unsigned j = 0; j < 16; ++j) { const unsigned c = xb_ld(&bar[XB_XCNT(j)]); sum += c; cnt += (c > 0u) ? 1u : 0u; mine = (j == x) ? c : mine; }
        if (sum == G) break;
        __builtin_amdgcn_s_sleep(1);
        if ((++sp & 255u) == 0u) { if (xb_ld(&bar[XB_TMO])) break; if (sp > XB_SPIN_CAP) { atomicAdd(&bar[XB_TMO], 1u); break; } }
    }
    nloc = mine > 0u ? mine : 1u; nx = cnt > 0u ? cnt : 1u;
}
__device__ __forceinline__ void xcd_barrier(const XcdBarrier& b, const int tid) {
    asm volatile("s_waitcnt vmcnt(0)" ::: "memory");
    __syncthreads();
    if (tid == 0) {
        unsigned* bar = b.bar;
        __builtin_amdgcn_s_waitcnt(0);
        unsigned nloc = b.st[0], nx = b.st[1];
        if (nloc == 0u) { xcd_barrier_complete(bar, b.x, nloc, nx); b.st[0] = nloc; b.st[1] = nx; }
        const unsigned old = xb_add(&bar[XB_XSUB(b.x)], 1u);
        const unsigned gen = old / nloc;
        if (old + 1u == (gen + 1u) * nloc) {
            __builtin_amdgcn_fence(__ATOMIC_RELEASE, "agent");
            asm volatile("s_waitcnt vmcnt(0)" ::: "memory");
            const unsigned og = xb_add(&bar[XB_TOP], 1u);
            const unsigned tg = og / nx;
            if (og + 1u == (tg + 1u) * nx) xb_add(&bar[XB_TOPGEN], 1u);
            else XB_SPIN(xb_ld(&bar[XB_TOPGEN]) == tg, bar);
            __builtin_amdgcn_fence(__ATOMIC_ACQUIRE, "agent");
            xb_add(&bar[XB_XGEN(b.x)], 1u);
            asm volatile("s_waitcnt vmcnt(0)" ::: "memory");
        } else {
            XB_SPIN(xb_ld(&bar[XB_XGEN(b.x)]) == gen, bar);
            __builtin_amdgcn_fence(__ATOMIC_ACQUIRE, "agent");
            asm volatile("s_waitcnt vmcnt(0)" ::: "memory");
        }
    }
    __syncthreads();
}

struct Frame { LAS unsigned char* lds; int tid, lane, wave, bid, G; const float* const* in; GAS float* out; GAS unsigned char* ws; };
#define IN_(k) ((const float*)(const GAS float*)F.in[(k)])
#define F_x IN_(0)
#define F_c IN_(1)
#define F_ctx IN_(2)
#define F_c_ctx IN_(3)
#define F_norm1 IN_(4)
#define F_norm2 IN_(5)
#define F_w_ada IN_(6)
#define F_b_ada IN_(7)
#define F_w_in IN_(8)
#define F_sink IN_(9)
#define F_mla_q_norm IN_(10)
#define F_w_uq IN_(11)
#define F_mla_kv_norm IN_(12)
#define F_w_ukv IN_(13)
#define F_lq1 IN_(14)
#define F_lk1 IN_(15)
#define F_lq2 IN_(16)
#define F_lk2 IN_(17)
#define F_diff_norm IN_(18)
#define F_w_out IN_(19)
#define F_w_router IN_(20)
#define F_w_gate IN_(21)
#define F_w_up IN_(22)
#define F_w_down IN_(23)
#define F_final_norm IN_(24)
#define F_MOD ((float*)(GAS float*)(F.ws + WS_MOD))
#define F_ROPE ((float*)(GAS float*)(F.ws + WS_ROPE))
#define F_RSQ ((float*)(GAS float*)(F.ws + WS_RSQ))
#define F_AFF ((float*)(GAS float*)(F.ws + WS_AFF))
#define F_INV ((int*)(GAS int*)(F.ws + WS_INV))
#define F_STOK ((int*)(GAS int*)(F.ws + WS_STOK))
#define F_SGATE ((float*)(GAS float*)(F.ws + WS_SGATE))
#define F_X ((float*)(GAS float*)(F.ws + WS_X))
#define F_XB ((bf16*)(GAS bf16*)(F.ws + WS_X))
#define F_ACT ((bf16*)(GAS bf16*)(F.ws + WS_ACT))
#define F_P ((bf16*)(GAS bf16*)(F.ws + WS_P))
#define F_Y ((bf16*)(GAS bf16*)(F.ws + WS_Y))
#define F_QKVM ((bf16*)(GAS bf16*)(F.ws + WS_QKVM))
#define F_O ((bf16*)(GAS bf16*)(F.ws + WS_O))
#define F_HID ((bf16*)(GAS bf16*)(F.ws + WS_HID))
#define F_WB ((bf16*)(GAS bf16*)(F.ws + WS_W))

__device__ __forceinline__ int rot64(int dp) { const int p = dp >> 1, half = dp & 1, axis = p >> 4, f = p & 15; return axis * 32 + half * 16 + f; }
__device__ __forceinline__ int rot32(int dp) { const int p = dp >> 1, half = dp & 1, axis = p >> 3, f = p & 7; return axis * 16 + half * 8 + f; }
__device__ __forceinline__ int src_col_in(int n) {
    if (n >= INW) return -1;
    if (n < P_AV) return (n & ~63) + rot64(n & 63);
    if (n >= P_KR && n < P_DV) return (n & ~31) + rot32(n & 31);
    return n;
}
__device__ __forceinline__ void prep_tile(const float* src, int N, int k0, const float* kscale, bf16* dst, int ldd, LAS float* scr, int lane) {
    float v[32];
#pragma unroll
    for (int i = 0; i < 32; ++i) { const int kk = 2 * i + (lane >> 5); v[i] = src ? src[(size_t)(k0 + kk) * N] : 0.f; }
    if (kscale) {
#pragma unroll
        for (int i = 0; i < 32; ++i) v[i] *= kscale[k0 + 2 * i + (lane >> 5)]; }
#pragma unroll
    for (int i = 0; i < 32; ++i) scr[(2 * i + (lane >> 5)) * 33 + (lane & 31)] = v[i];
    LDS_WAIT();
    const int c = lane & 7;
#pragma unroll
    for (int j = 0; j < 4; ++j) { const int n = (lane >> 3) + 8 * j; const LAS float* s = scr + (8 * c) * 33 + n;
        u32x4 o; o.x = pk2(s[0], s[33]); o.y = pk2(s[66], s[99]); o.z = pk2(s[132], s[165]); o.w = pk2(s[198], s[231]);
        *(u32x4*)(dst + (size_t)n * ldd + 8 * c) = o; }
    LDS_WAIT();
}
constexpr int PI_IN = 16 * 64, PI_UP = 6 * 32, PI_OUT = 16 * 32, PI_GU = NE * 16 * 32, PI_DN = NE * 8 * 32, PI_LAYER = PI_IN + PI_UP + PI_OUT + PI_GU + PI_DN;
#ifndef BG_PREP
#define BG_PREP 0
#ifndef MOE_PF
#define MOE_PF 0
#endif
#endif
__device__ __forceinline__ void prep_layer(Frame& F, const int l, const int worker, const int nworkers) {
    const int lane = F.lane, wave = F.wave;
    LAS float* scr = (LAS float*)(F.lds + 57344 + wave * 8448);
    for (int it = worker; it < PI_LAYER; it += nworkers) {
        int r = it; bf16* wl = F_WB + (size_t)l * W_LAYER;
        const int nl = lane & 31;
        if (r < PI_IN) { const int kb = r / 64, nb = r % 64, n = nb * 32 + nl, sc = src_col_in(n);
            prep_tile(sc >= 0 ? F_w_in + (size_t)l * D * INW + sc : nullptr, INW, kb * 64, nullptr, wl + W_IN + (size_t)(nb * 32) * D + kb * 64, D, scr, lane); continue; } r -= PI_IN;
        if (r < PI_UP) { const int kb = r / 32, nb = r % 32, n = nb * 32 + nl, k0 = kb * 64; const float* src = nullptr; const float* ks = nullptr; int N = 384, ksrc = k0;
            if (n < 384 && k0 < 256) { const int h = n / 96, j = n % 96; const int sc = j < 64 ? n : h * 96 + 64 + rot32(j - 64); src = F_w_uq + (size_t)l * 256 * 384 + sc; ks = F_mla_q_norm + l * 256; N = 384; }
            else if (n >= 512 && k0 >= 256) { src = F_w_ukv + (size_t)l * 128 * 512 + (n - 512); ks = F_mla_kv_norm + l * 128; N = 512; ksrc = k0 - 256; }
            { float v[32];
#pragma unroll
              for (int i = 0; i < 32; ++i) { const int kk = 2 * i + (lane >> 5); v[i] = src ? src[(size_t)(ksrc + kk) * N] * ks[ksrc + kk] : 0.f; }
#pragma unroll
              for (int i = 0; i < 32; ++i) scr[(2 * i + (lane >> 5)) * 33 + (lane & 31)] = v[i];
              LDS_WAIT();
              const int c = lane & 7; bf16* dst = wl + W_UP + (size_t)(nb * 32) * UPK + k0;
#pragma unroll
              for (int j = 0; j < 4; ++j) { const int nn = (lane >> 3) + 8 * j; const LAS float* s = scr + (8 * c) * 33 + nn;
                  u32x4 o; o.x = pk2(s[0], s[33]); o.y = pk2(s[66], s[99]); o.z = pk2(s[132], s[165]); o.w = pk2(s[198], s[231]);
                  *(u32x4*)(dst + (size_t)nn * UPK + 8 * c) = o; }
              LDS_WAIT(); }
            continue; } r -= PI_UP;
        if (r < PI_OUT) { const int kb = r / 32, nb = r % 32;
            prep_tile(F_w_out + (size_t)l * D * D + nb * 32 + nl, D, kb * 64, nullptr, wl + W_OUT + (size_t)(nb * 32) * D + kb * 64, D, scr, lane); continue; } r -= PI_OUT;
        if (r < PI_GU) { const int e = r / 512, q = r % 512, kb = q / 32, nb = q % 32, n = nb * 32 + nl, f = (n >> 3) * 4 + (n & 3);
            const float* src = ((n & 4) ? F_w_up : F_w_gate) + ((size_t)l * NE + e) * D * DE + f;
            prep_tile(src, DE, kb * 64, nullptr, wl + W_GU + (size_t)e * 1024 * 1024 + (size_t)(nb * 32) * D + kb * 64, D, scr, lane); continue; } r -= PI_GU;
        { const int e = r / 256, q = r % 256, kb = q / 32, nb = q % 32;
            prep_tile(F_w_down + ((size_t)l * NE + e) * DE * D + nb * 32 + nl, D, kb * 64, nullptr, wl + W_DN + (size_t)e * 1024 * 512 + (size_t)(nb * 32) * DE + kb * 64, DE, scr, lane); }
    }
}

__device__ __forceinline__ void p0_phase(Frame& F) {
    const int tid = F.tid, lane = F.lane, wave = F.wave;
    {
        LAS float* sl = (LAS float*)F.lds;
        LAS float* red = (LAS float*)(F.lds + 36864);
        for (int i = tid; i < 9 * 1024; i += 512) { const float v = i < 8 * 1024 ? F_c[i] : F_c_ctx[i - 8 * 1024]; sl[i] = siluf(v); }
        __syncthreads();
        for (int it = F.bid; it < DEPTH * 96; it += F.G) {
            const int l = it / 96, cg = it % 96, col = cg * 64 + lane;
            float acc[9];
#pragma unroll
            for (int r = 0; r < 9; ++r) acc[r] = 0.f;
            const float* w = F_w_ada + (size_t)l * D * 6144 + (size_t)(wave * 128) * 6144 + col;
#pragma unroll 16
            for (int k = 0; k < 128; ++k) { const float wv = w[(size_t)k * 6144];
#pragma unroll
                for (int r = 0; r < 9; ++r) acc[r] += sl[r * 1024 + wave * 128 + k] * wv; }
#pragma unroll
            for (int r = 0; r < 9; ++r) red[(wave * 9 + r) * 64 + lane] = acc[r];
            __syncthreads();
            for (int o = tid; o < 576; o += 512) { const int r = o >> 6, cc = o & 63; float s = 0.f;
#pragma unroll
                for (int w8 = 0; w8 < 8; ++w8) s += red[(w8 * 9 + r) * 64 + cc];
                F_MOD[((size_t)l * 9 + r) * 6144 + cg * 64 + cc] = s + F_b_ada[l * 6144 + cg * 64 + cc]; }
            __syncthreads();
        }
    }
    const int gw = F.bid * NWAVES + wave, NGW = F.G * NWAVES;
    { const size_t n4 = (size_t)R * D / 4, nl4 = (size_t)RL * D / 4;
      for (size_t i = (size_t)F.bid * 512 + tid; i < n4; i += (size_t)F.G * 512) { const f32x4 v = i < nl4 ? ((const f32x4*)F_x)[i] : ((const f32x4*)F_ctx)[i - nl4];
#if X_BF16
          u32x2 w; w.x = pk2(v.x, v.y); w.y = pk2(v.z, v.w); ((u32x2*)F_XB)[i] = w; } }
#else
          ((f32x4*)F_X)[i] = v; } }
#endif
    for (int i = F.bid * 512 + tid; i < T * 48; i += F.G * 512) {
        const int t = i / 48, j = i % 48; int axis, f, nf;
        if (j < 32) { axis = j >> 4; f = j & 15; nf = 16; } else { axis = (j - 32) >> 3; f = (j - 32) & 7; nf = 8; }
        const float inv = exp2f(-(float)f / (float)nf * 13.287712379549449f);
        const float ang = (float)(axis == 0 ? (t >> 6) : (t & 63)) * inv;
        const float cv = cosf(ang), sv = sinf(ang);
        if (j < 32) { F_ROPE[t * 32 + j] = cv; F_ROPE[T * 32 + t * 32 + j] = sv; } else { F_ROPE[T * 64 + t * 16 + j - 32] = cv; F_ROPE[T * 64 + T * 16 + t * 16 + j - 32] = sv; }
    }
    for (int l = 0; l < (BG_PREP ? 1 : DEPTH); ++l) prep_layer(F, l, gw, NGW);
}

#ifndef PROBE_NOROUTER
#define PROBE_NOROUTER 0
#endif
#define half_swap_add(keepv, sendv, off) ((keepv) + shx((sendv), (off), lane))
__device__ __forceinline__ void norm_phase(Frame& F, int l, int mode, int nrows, const float keep) {
    const int lane = F.lane, gw = F.bid * NWAVES + F.wave, NGW = F.G * NWAVES;
    LAS float* wrT = (LAS float*)F.lds;
    if (mode == 1) {
        const float* wr = F_w_router + (size_t)l * D * NE;
        for (int i = F.tid; i < D * NE; i += 512) wrT[(i & 15) * 1028 + (i >> 4)] = wr[i];
        __syncthreads();
    }
    const float* gain = mode == 0 ? F_norm1 + (size_t)l * D : (mode == 1 ? F_norm2 + (size_t)l * D : F_final_norm);
    const bool comb = mode != 1 && l > 0;
    f32x4 vn[2][4];
#if X_BF16
#define NORM_LOAD(dst, rr0) do { _Pragma("unroll") for (int q = 0; q < 2; ++q) _Pragma("unroll") for (int j = 0; j < 4; ++j) { const u32x2 w_ = ((const u32x2*)(F_XB + (size_t)((rr0) + q) * D))[lane + 64 * j]; \
        dst[q][j] = (f32x4){bf2f(w_.x & 0xffffu), bf2f(w_.x >> 16), bf2f(w_.y & 0xffffu), bf2f(w_.y >> 16)}; } } while (0)
#else
#define NORM_LOAD(dst, rr0) do { _Pragma("unroll") for (int q = 0; q < 2; ++q) _Pragma("unroll") for (int j = 0; j < 4; ++j) dst[q][j] = ((const f32x4*)(F_X + (size_t)((rr0) + q) * D))[lane + 64 * j]; } while (0)
#endif
    if (gw * 2 < nrows) NORM_LOAD(vn, gw * 2);
    for (int r0 = gw * 2; r0 < nrows; r0 += NGW * 2) {
        const int mb = r0 < RL ? r0 / T : 8;
        f32x4 v[2][4];
#pragma unroll
        for (int q = 0; q < 2; ++q)
#pragma unroll
            for (int j = 0; j < 4; ++j) v[q][j] = vn[q][j];
        if (r0 + NGW * 2 < nrows) NORM_LOAD(vn, r0 + NGW * 2);
        if (comb) {
            const float* g2 = F_MOD + ((size_t)(l - 1) * 9 + mb) * 6144 + 5120;
            const int myinv = lane < 2 * NE ? F_INV[(size_t)r0 * NE + lane] : -1;
            f32x4 s[2][4];
#pragma unroll
            for (int q = 0; q < 2; ++q)
#pragma unroll
                for (int j = 0; j < 4; ++j) s[q][j] = (f32x4){0.f, 0.f, 0.f, 0.f};
            for (int e = 0; e < NE; ++e) {
#pragma unroll
                for (int q = 0; q < 2; ++q) { const int sl = shi(myinv, q * NE + e);
                    if (sl >= 0) { const bf16* yr = F_Y + (size_t)sl * D;
#pragma unroll
                        for (int j = 0; j < 4; ++j) { const u32x2 w = ((const u32x2*)yr)[lane + 64 * j];
                            s[q][j].x += bf2f(w.x & 0xffff); s[q][j].y += bf2f(w.x >> 16); s[q][j].z += bf2f(w.y & 0xffff); s[q][j].w += bf2f(w.y >> 16); } } } }
#pragma unroll
            for (int j = 0; j < 4; ++j) { const f32x4 g = ((const f32x4*)g2)[lane + 64 * j];
#pragma unroll
                for (int q = 0; q < 2; ++q) { v[q][j] += g * s[q][j] * keep;
#if X_BF16
                    u32x2 w; w.x = pk2(v[q][j].x, v[q][j].y); w.y = pk2(v[q][j].z, v[q][j].w); ((u32x2*)(F_XB + (size_t)(r0 + q) * D))[lane + 64 * j] = w;
#else
                    ((f32x4*)(F_X + (size_t)(r0 + q) * D))[lane + 64 * j] = v[q][j];
#endif
                } }
        }
        float ss0 = 0.f, ss1 = 0.f;
#pragma unroll
        for (int j = 0; j < 4; ++j) { ss0 += (v[0][j].x * v[0][j].x + v[0][j].y * v[0][j].y) + (v[0][j].z * v[0][j].z + v[0][j].w * v[0][j].w);
                                      ss1 += (v[1][j].x * v[1][j].x + v[1][j].y * v[1][j].y) + (v[1][j].z * v[1][j].z + v[1][j].w * v[1][j].w); }
#pragma unroll
        for (int o = 1; o < 64; o <<= 1) { ss0 += shx(ss0, o, lane); ss1 += shx(ss1, o, lane); }
        const float rs[2] = {1.0f / sqrtf(ss0 * (1.f / D) + EPS), 1.0f / sqrtf(ss1 * (1.f / D) + EPS)};
        if (mode == 2) {
#pragma unroll
            for (int j = 0; j < 4; ++j) { const f32x4 g = ((const f32x4*)gain)[lane + 64 * j];
#pragma unroll
                for (int q = 0; q < 2; ++q) ((f32x4*)((float*)F.out + (size_t)(r0 + q) * D))[lane + 64 * j] = v[q][j] * rs[q] * g; }
        } else {
            const float* md = F_MOD + ((size_t)l * 9 + mb) * 6144 + (mode == 0 ? 0 : 3072);
#pragma unroll
            for (int j = 0; j < 4; ++j) { const f32x4 g = ((const f32x4*)gain)[lane + 64 * j];
                const f32x4 sh = ((const f32x4*)md)[lane + 64 * j], sc = ((const f32x4*)(md + 1024))[lane + 64 * j];
#pragma unroll
                for (int q = 0; q < 2; ++q) { v[q][j] = v[q][j] * rs[q] * g * (sc + 1.0f) + sh;
                    u32x2 w; w.x = pk2(v[q][j].x, v[q][j].y); w.y = pk2(v[q][j].z, v[q][j].w);
                    ((u32x2*)(F_ACT + (size_t)(r0 + q) * D))[lane + 64 * j] = w; } }
            if (mode == 1 && !(PROBE_NOROUTER && keep == 0.f)) {
                float a[2][NE];
                typedef float f32x2r __attribute__((ext_vector_type(2)));
#pragma unroll
                for (int e = 0; e < NE; ++e) { f32x2r p0 = {0.f, 0.f}, p1 = {0.f, 0.f};
#pragma unroll
                    for (int j = 0; j < 4; ++j) { const f32x4 w = *(const LAS f32x4*)(wrT + e * 1028 + 256 * j + 4 * lane);
                        const f32x2r wl = {w.x, w.y}, wh = {w.z, w.w};
                        p0 = __builtin_elementwise_fma((f32x2r){v[0][j].x, v[0][j].y}, wl, p0); p0 = __builtin_elementwise_fma((f32x2r){v[0][j].z, v[0][j].w}, wh, p0);
                        p1 = __builtin_elementwise_fma((f32x2r){v[1][j].x, v[1][j].y}, wl, p1); p1 = __builtin_elementwise_fma((f32x2r){v[1][j].z, v[1][j].w}, wh, p1); }
                    a[0][e] = p0.x + p0.y; a[1][e] = p1.x + p1.y; if ((e & 1) == 1) __builtin_amdgcn_sched_barrier(0); }
                float b16[NE];
#pragma unroll
                for (int e = 0; e < NE; ++e) { const bool up = lane >= 32; b16[e] = half_swap_add(up ? a[1][e] : a[0][e], up ? a[0][e] : a[1][e], 32); }
                float b8[8];
#pragma unroll
                for (int e = 0; e < 8; ++e) { const bool up = (lane & 16) != 0; b8[e] = half_swap_add(up ? b16[8 + e] : b16[e], up ? b16[e] : b16[8 + e], 16); }
                float b4[4];
#pragma unroll
                for (int e = 0; e < 4; ++e) { const bool up = (lane & 8) != 0; b4[e] = half_swap_add(up ? b8[4 + e] : b8[e], up ? b8[e] : b8[4 + e], 8); }
                float b2[2];
#pragma unroll
                for (int e = 0; e < 2; ++e) { const bool up = (lane & 4) != 0; b2[e] = half_swap_add(up ? b4[2 + e] : b4[e], up ? b4[e] : b4[2 + e], 4); }
                float lg; { const bool up = (lane & 2) != 0; lg = half_swap_add(up ? b2[1] : b2[0], up ? b2[0] : b2[1], 2); }
                lg += shx(lg, 1, lane);
                float mx = lg;
#pragma unroll
                for (int o = 2; o < 32; o <<= 1) mx = fmaxf(mx, shx(mx, o, lane));
                const float ex = __expf(lg - mx); float sum = ex;
#pragma unroll
                for (int o = 2; o < 32; o <<= 1) sum += shx(sum, o, lane);
                const int eidx = ((lane >> 4) & 1) * 8 + ((lane >> 3) & 1) * 4 + ((lane >> 2) & 1) * 2 + ((lane >> 1) & 1);
                if ((lane & 1) == 0) F_AFF[(size_t)(r0 + (lane >> 5)) * NE + eidx] = ex / sum;
            }
        }
    }
}

#undef NORM_LOAD
__device__ __forceinline__ void topk_phase(Frame& F, int nsets) {
    LAS unsigned* cnt = (LAS unsigned*)F.lds;
    const int tid = F.tid, lane = F.lane, wave = F.wave;
    for (int it = F.bid; it < nsets * NE; it += F.G) {
        const int set = it / NE, e = it % NE; const bool lat = set < 8; const int b = lat ? set : set - 8;
        const int n = lat ? T : LC, cap = lat ? CAPL : CAPC, row0 = lat ? b * T : RL + b * LC, slot0 = e * SLOTS_E + (lat ? b * CAPL : NB * CAPL + b * CAPC);
        unsigned v[4];
#pragma unroll
        for (int q = 0; q < 4; ++q) { const int idx = 4 * tid + q; v[q] = idx < n ? __builtin_bit_cast(unsigned, F_AFF[(size_t)(row0 + idx) * NE + e]) : 0u; }
        unsigned prefix = 0u; int par = 0;
        for (int bit = 30; bit >= 0; --bit) {
            const unsigned cand = prefix | (1u << bit);
            unsigned c = 0;
#pragma unroll
            for (int q = 0; q < 4; ++q) c += (unsigned)__popcll(__ballot(v[q] >= cand));
            if (lane == 0) cnt[par * 8 + wave] = c;
            __syncthreads();
            unsigned tot = 0;
#pragma unroll
            for (int w = 0; w < 8; ++w) tot += cnt[par * 8 + w];
            if (tot >= (unsigned)cap) prefix = cand;
            par ^= 1;
        }
        unsigned g4 = 0, e4 = 0;
#pragma unroll
        for (int q = 0; q < 4; ++q) { g4 += v[q] > prefix ? 1u : 0u; e4 += v[q] == prefix ? 1u : 0u; }
        unsigned pk = g4 | (e4 << 16), inc = pk;
#pragma unroll
        for (int o = 1; o < 64; o <<= 1) { const unsigned t = (unsigned)shi((int)inc, lane - o); if (lane >= o) inc += t; }
        __syncthreads();
        if (lane == 63) cnt[16 + wave] = inc;
        __syncthreads();
        unsigned base = 0, total = 0;
#pragma unroll
        for (int w = 0; w < 8; ++w) { const unsigned t = cnt[16 + w]; total += t; if (w < wave) base += t; }
        const unsigned excl = base + inc - pk;
        unsigned gpre = excl & 0xffffu, epre = excl >> 16; const unsigned need = (unsigned)cap - (total & 0xffffu);
#pragma unroll
        for (int q = 0; q < 4; ++q) { const int idx = 4 * tid + q;
            if (idx < n) { const bool isg = v[q] > prefix, ise = v[q] == prefix; const bool sel = isg || (ise && epre < need);
                const int slot = slot0 + (int)(gpre + (epre < need ? epre : need));
                if (sel) { F_STOK[slot] = row0 + idx; F_SGATE[slot] = __builtin_bit_cast(float, v[q]); }
                F_INV[(size_t)(row0 + idx) * NE + e] = sel ? slot : -1;
                gpre += isg ? 1u : 0u; epre += ise ? 1u : 0u; } }
        __syncthreads();
    }
}

#ifndef ATT_EXTRA
#define ATT_EXTRA 0
#define ATT_EXTRA_TYPE 0
#endif
#ifndef ATT_LATE_DMA
#define ATT_LATE_DMA 0
#endif
#ifndef ATT_STAGGER
#define ATT_STAGGER 1
#endif
#ifndef ATT_XVAR
#define ATT_XVAR 0
#endif
#ifndef ATT_XSTEPS
#define ATT_XSTEPS 4
#endif
namespace att {
typedef short s16x4 __attribute__((ext_vector_type(4)));
typedef float f32x2_t __attribute__((ext_vector_type(2)));
typedef __bf16 bf16x2_t __attribute__((ext_vector_type(2)));
constexpr int L_K = 0, KBUF = 16384, L_V = 2 * KBUF, VBUF = 8192, L_WS = L_V + 2 * VBUF, L_OST = L_WS + 8 * 256, L_END = L_OST + 8 * 4096;
#define ATT_SBAR() __builtin_amdgcn_sched_barrier(0)
#define ATT_SGB(mask, n) __builtin_amdgcn_sched_group_barrier(mask, n, 0)
__device__ __forceinline__ int crow(int r, int hi) { return (r & 3) + 8 * (r >> 2) + 4 * hi; }
__device__ __forceinline__ unsigned cvtpk(float lo, float hi) { f32x2_t v = {lo, hi}; bf16x2_t b = __builtin_convertvector(v, bf16x2_t); return __builtin_bit_cast(unsigned, b); }
__device__ __forceinline__ int v_st(int k, int c) { const int kk = k; return ((kk >> 3) * 2 + (c >> 5)) * 512 + ((kk & 7) * 32 + (c & 31)) * 2; }
__device__ __forceinline__ int v_rd_base(int lane) { return ((lane & 3) << 3) | (((lane >> 2) & 3) << 6) | (((lane >> 4) & 1) << 5) | (((lane >> 5) & 1) << 8); }
typedef short v4i16_t __attribute__((ext_vector_type(4)));
template <int OFF> __device__ __forceinline__ s16x4 tr_read(int vb) { s16x4 r; asm volatile("ds_read_b64_tr_b16 %0, %1 offset:%2" : "=&v"(r) : "v"(vb), "i"(OFF) : "memory"); return r; }
struct VFrag { s16x4 l0, h0, l1, h1, l2, h2, l3, h3; };
template <int D0> __device__ __forceinline__ void vread(VFrag& f, int vb) {
    f.l0 = tr_read<D0 * 512 + 0 * 2048>(vb); f.h0 = tr_read<D0 * 512 + 0 * 2048 + 1024>(vb); f.l1 = tr_read<D0 * 512 + 1 * 2048>(vb); f.h1 = tr_read<D0 * 512 + 1 * 2048 + 1024>(vb);
    f.l2 = tr_read<D0 * 512 + 2 * 2048>(vb); f.h2 = tr_read<D0 * 512 + 2 * 2048 + 1024>(vb); f.l3 = tr_read<D0 * 512 + 3 * 2048>(vb); f.h3 = tr_read<D0 * 512 + 3 * 2048 + 1024>(vb);
}
__device__ __forceinline__ void pv_mma(f32x16& od, const VFrag& f, bf16x8 pa0, bf16x8 pa1, bf16x8 pa2, bf16x8 pa3) {
#define ATT_PK(L, H) (bf16x8){L[0], L[1], L[2], L[3], H[0], H[1], H[2], H[3]}
    od = __builtin_amdgcn_mfma_f32_32x32x16_bf16(pa0, ATT_PK(f.l0, f.h0), od, 0, 0, 0);
    od = __builtin_amdgcn_mfma_f32_32x32x16_bf16(pa1, ATT_PK(f.l1, f.h1), od, 0, 0, 0);
    od = __builtin_amdgcn_mfma_f32_32x32x16_bf16(pa2, ATT_PK(f.l2, f.h2), od, 0, 0, 0);
    od = __builtin_amdgcn_mfma_f32_32x32x16_bf16(pa3, ATT_PK(f.l3, f.h3), od, 0, 0, 0);
#undef ATT_PK
}
template <int D0> __device__ __forceinline__ void pv_one(f32x16& od, int vb, bf16x8 pa0, bf16x8 pa1, bf16x8 pa2, bf16x8 pa3) {
    VFrag f; vread<D0>(f, vb); asm volatile("s_waitcnt lgkmcnt(0)" ::: "memory"); ATT_SBAR(); pv_mma(od, f, pa0, pa1, pa2, pa3);
}
struct Tensors { const bf16* P; const bf16* QKVM; bf16* O; const float* sink; const float* dnorm; float lam, lam_init; int l; };

constexpr float THR = 8.f;
__device__ __forceinline__ float rowmax32(const f32x16& p0, const f32x16& p1) {
    float a = fmaxf(fmaxf(p0[0], p0[1]), p1[0]), b = fmaxf(fmaxf(p0[2], p0[3]), p1[1]); a = fmaxf(fmaxf(a, p1[2]), p1[3]);
#pragma unroll
    for (int r = 4; r < 16; r += 4) { a = fmaxf(fmaxf(a, p0[r]), p0[r + 1]); b = fmaxf(fmaxf(b, p0[r + 2]), p0[r + 3]); a = fmaxf(fmaxf(a, p1[r]), p1[r + 1]); b = fmaxf(fmaxf(b, p1[r + 2]), p1[r + 3]); }
    float m = fmaxf(a, b);
    auto rr = __builtin_amdgcn_permlane32_swap(__float_as_uint(m), __float_as_uint(m), false, false);
    return fmaxf(__uint_as_float(rr[0]), __uint_as_float(rr[1]));
}
__device__ __forceinline__ void partialSM(f32x16& p0, f32x16& p1, const float rm, float& mhat, f32x16& negm, float& alpha) {
    alpha = 1.f;
    if (__builtin_expect(__any(rm > THR), 0)) {
        const float dl = fmaxf(rm, 0.f); mhat += dl;
#pragma unroll
        for (int r = 0; r < 16; ++r) { p0[r] -= dl; p1[r] -= dl; }
#pragma unroll
        for (int r = 0; r < 16; ++r) negm[r] = -mhat;
        asm volatile("" : "+v"(negm));
        alpha = __builtin_amdgcn_exp2f(-dl);
    }
}
__device__ __forceinline__ void finishSM(f32x16& p0, f32x16& p1, const float alpha, float& l_reg, bf16x8& pa0, bf16x8& pa1, bf16x8& pa2, bf16x8& pa3) {
#pragma unroll
    for (int r = 0; r < 16; ++r) { p0[r] = __builtin_amdgcn_exp2f(p0[r]); p1[r] = __builtin_amdgcn_exp2f(p1[r]); }
    float ps = 0.f, pt = 0.f;
#pragma unroll
    for (int r = 0; r < 16; ++r) { ps += p0[r]; pt += p1[r]; }
    l_reg = l_reg * alpha + (ps + pt);
#define ATT_PK8(P, BASE, OUT) do { u32x4 w = {cvtpk(P[BASE + 0], P[BASE + 1]), cvtpk(P[BASE + 2], P[BASE + 3]), cvtpk(P[BASE + 4], P[BASE + 5]), cvtpk(P[BASE + 6], P[BASE + 7])}; OUT = __builtin_bit_cast(bf16x8, w); } while (0)
    ATT_PK8(p0, 0, pa0); ATT_PK8(p0, 8, pa1); ATT_PK8(p1, 0, pa2); ATT_PK8(p1, 8, pa3);
#undef ATT_PK8
}
template <int ROWB> __device__ __forceinline__ int kswz(int row, int cb) { return row * ROWB + (ROWB == 128 ? (cb ^ (((row >> 1) & 7) << 4)) : (cb ^ ((row & 15) << 4))); }
template <int NB, int ROWB, int CB0, int D00> __device__ __forceinline__ void kread(bf16x8 (&kf)[2 * NB], const LAS unsigned char* Kb, int r32, int hi) {
#pragma unroll
    for (int d = 0; d < NB; ++d) { const int cb = CB0 + ((D00 + d) * 16 + hi * 8) * 2;
        kf[2 * d] = *(const LAS bf16x8*)(Kb + kswz<ROWB>(r32, cb)); kf[2 * d + 1] = *(const LAS bf16x8*)(Kb + kswz<ROWB>(32 + r32, cb)); }
}
template <int NB, int D00> __device__ __forceinline__ void kmma(f32x16& p0, f32x16& p1, const bf16x8 (&kf)[2 * NB], const bf16x8* qr, const f32x16& negm) {
#pragma unroll
    for (int d = 0; d < NB; ++d) {
        if (D00 + d == 0) { p0 = __builtin_amdgcn_mfma_f32_32x32x16_bf16(kf[0], qr[0], negm, 0, 0, 0); p1 = __builtin_amdgcn_mfma_f32_32x32x16_bf16(kf[1], qr[0], negm, 0, 0, 0); }
        else { p0 = __builtin_amdgcn_mfma_f32_32x32x16_bf16(kf[2 * d], qr[D00 + d], p0, 0, 0, 0); p1 = __builtin_amdgcn_mfma_f32_32x32x16_bf16(kf[2 * d + 1], qr[D00 + d], p1, 0, 0, 0); } }
}
template <int NKS, int ROWB, int CB0> __device__ __forceinline__ void qkt2(f32x16& p0, f32x16& p1, const LAS unsigned char* Kb, const bf16x8* qr, const f32x16& negm, int r32, int hi) {
    constexpr int N1 = NKS > 4 ? 3 : NKS, N2 = NKS - N1;
    bf16x8 ka[2 * N1]; kread<N1, ROWB, CB0, 0>(ka, Kb, r32, hi);
    if constexpr (N2 > 0) { bf16x8 kb[2 * N2]; kread<N2, ROWB, CB0, N1>(kb, Kb, r32, hi);
        kmma<N1, 0>(p0, p1, ka, qr, negm); kmma<N2, N1>(p0, p1, kb, qr, negm); }
    else kmma<N1, 0>(p0, p1, ka, qr, negm);
}

template <int TYPE> struct Ring { static constexpr int KSLOT = TYPE == 1 ? 16384 : 8192, VSLOT = 8192, L_K = 0, L_V = 3 * KSLOT, L_WS = L_V + 4 * VSLOT, L_OST = L_WS + 2048; };
template <int TYPE, int CB0> __device__ __forceinline__ void flash_pass(const Tensors& Tn, LAS unsigned char* lds, const int tid, const int b, const int h, const bool lat, const int q0, const int wrow, const int var, const bf16x8* qr,
                                                                        f32x16 (&o)[2], float& l_out, float& m_out) {
    constexpr int NKS = TYPE == 0 ? 4 : (TYPE == 1 ? 6 : 2);
    constexpr int ROWB = TYPE == 1 ? 256 : 128;
    typedef Ring<TYPE> RG;
    const int lane = tid & 63, wid = __builtin_amdgcn_readfirstlane(tid >> 6), r32 = lane & 31, hi = lane >> 5;
    LAS float* al_l = (LAS float*)(lds + RG::L_WS) + wid * 64;
    const int kvh = h >> 2;
    const bf16* Kp = TYPE == 0 ? Tn.P + P_AK + kvh * 64 : (TYPE == 1 ? Tn.QKVM + 512 + h * 128 : Tn.P + P_DK + h * 64);
    const bf16* Vp = TYPE == 0 ? Tn.P + P_AV + kvh * 64 : (TYPE == 1 ? Tn.QKVM + 512 + h * 128 + 64 : Tn.P + P_DV + h * 64);
    constexpr int KPITCH = TYPE == 1 ? LDM : LDP;
    int kl0 = 0, nloc = 0;
    if (lat) { if (TYPE == 0) { kl0 = q0 - 128 < 0 ? 0 : q0 - 128; const int kl1 = q0 + 64 + 128 > T ? T : q0 + 64 + 128; nloc = (kl1 - kl0) >> 6; } else { kl0 = 0; nloc = T / 64; } }
    const int NT = 4 + nloc;
    const int crow0 = RL + b * LC, lrow0 = b * T + kl0;
#define ATT_TROW(i) ((var & 64) ? crow0 : ((i) < 4 ? crow0 + 64 * (i) : lrow0 + 64 * ((i) - 4)))
    const bf16* ksrc0; const bf16* ksrc1 = nullptr;
    if (TYPE != 1) { const int row = 8 * wid + (lane >> 3), c = (lane & 7) ^ ((row >> 1) & 7); ksrc0 = Kp + (size_t)row * KPITCH + c * 8; }
    else {
        { const int row = 8 * wid + (lane >> 4), c = (lane & 15) ^ (row & 15); ksrc0 = c < 8 ? Kp + (size_t)row * LDM + c * 8 : (c < 12 ? Tn.P + (size_t)row * LDP + P_KR + (c - 8) * 8 : Kp + (size_t)row * LDM); }
        { const int row = 8 * wid + 4 + (lane >> 4), c = (lane & 15) ^ (row & 15); ksrc1 = c < 8 ? Kp + (size_t)row * LDM + c * 8 : (c < 12 ? Tn.P + (size_t)row * LDP + P_KR + (c - 8) * 8 : Kp + (size_t)row * LDM); }
    }
    const bool k0p = TYPE == 1 && (((lane & 15) ^ ((8 * wid + (lane >> 4)) & 15)) >= 8) && (((lane & 15) ^ ((8 * wid + (lane >> 4)) & 15)) < 12);
    const bool k1p = TYPE == 1 && (((lane & 15) ^ ((8 * wid + 4 + (lane >> 4)) & 15)) >= 8) && (((lane & 15) ^ ((8 * wid + 4 + (lane >> 4)) & 15)) < 12);
    const bf16* vsrc = Vp + (size_t)(8 * wid + ((lane & 31) >> 2)) * KPITCH + (lane >> 5) * 32 + (lane & 3) * 8;
#define ATT_DMA_K(i, slot) do { if (var & 8) break; const int g_ = ATT_TROW((i) < NT ? (i) : NT - 1); \
        __builtin_amdgcn_global_load_lds((const unsigned*)(ksrc0 + (size_t)g_ * (k0p ? LDP : KPITCH)), (LAS unsigned*)(lds + RG::L_K + (slot) * RG::KSLOT + wid * (ROWB * 8)), 16, 0, 0); \
        if (TYPE == 1) __builtin_amdgcn_global_load_lds((const unsigned*)(ksrc1 + (size_t)g_ * (k1p ? LDP : KPITCH)), (LAS unsigned*)(lds + RG::L_K + (slot) * RG::KSLOT + wid * (ROWB * 8) + 1024), 16, 0, 0); } while (0)
#define ATT_DMA_V(i, slot) do { if (var & 8) break; const int g_ = ATT_TROW((i) < NT ? (i) : NT - 1); \
        __builtin_amdgcn_global_load_lds((const unsigned*)(vsrc + (size_t)g_ * KPITCH), (LAS unsigned*)(lds + RG::L_V + (slot) * RG::VSLOT + wid * 1024), 16, 0, 0); } while (0)
#define ATT_WAITBAR() do { if (var & 16) break; if (TYPE == 1) asm volatile("s_waitcnt vmcnt(3)" ::: "memory"); else asm volatile("s_waitcnt vmcnt(2)" ::: "memory"); __builtin_amdgcn_s_barrier(); asm volatile("" ::: "memory"); } while (0)
#define ATT_RESC(a) do { if (__any((a) < 1.f)) { if (hi == 0) al_l[r32] = (a); asm volatile("s_waitcnt lgkmcnt(0)" ::: "memory"); \
        _Pragma("unroll") for (int r = 0; r < 16; ++r) { const float f_ = al_l[crow(r, hi)]; o[0][r] *= f_; o[1][r] *= f_; } } } while (0)
    const int qpos = q0 + wrow + r32;
#define ATT_MASK(P0, P1, i) do { if (TYPE == 0) { const int kt0_ = kl0 + 64 * ((i) - 4) - qpos, lo_ = (i) >= 4 ? -128 : -(1 << 28), hi_ = (i) >= 4 ? 128 : (1 << 28); \
        _Pragma("unroll") for (int r = 0; r < 16; ++r) { const int k0_ = kt0_ + crow(r, hi); P0[r] = (k0_ < lo_ || k0_ > hi_) ? -1e30f : P0[r]; P1[r] = (k0_ + 32 < lo_ || k0_ + 32 > hi_) ? -1e30f : P1[r]; } } } while (0)
    const int vb0 = (int)(uintptr_t)(lds + RG::L_V) + v_rd_base(lane);
    const LAS unsigned char* Kr = lds + RG::L_K;
    float mhat = 0.f, l_reg = 0.f; f32x16 negm = f32x16{};
    int sp = 2, sc = 0;
#define ATT_ROT() do { const int t_ = sp; sp = sc; sc = (sc == 2 ? 0 : sc + 1); (void)t_; } while (0)
#ifndef ATT_LAGSEL
#define ATT_LAGSEL 0
#endif
    const bool lag = ATT_STAGGER && (ATT_LAGSEL == 0 ? wid >= 4 : (ATT_LAGSEL == 1 ? (wid & 1) != 0 : ((wid >> 1) & 1) != 0));
    f32x16 p0 = f32x16{}, p1 = f32x16{}; bf16x8 pa0 = bf16x8{}, pa1 = bf16x8{}, pa2 = bf16x8{}, pa3 = bf16x8{};
#define ATT_SOFT(t, FIRST) do { ATT_MASK(p0, p1, t); float rm_ = rowmax32(p0, p1); float alpha_ = 1.f; \
        if (FIRST) { mhat = rm_; _Pragma("unroll") for (int r = 0; r < 16; ++r) { p0[r] -= rm_; p1[r] -= rm_; negm[r] = -rm_; } asm volatile("" : "+v"(negm)); } \
        else if (__builtin_expect(__any(rm_ > THR), 0)) { const float dl = fmaxf(rm_, 0.f); mhat += dl; \
            _Pragma("unroll") for (int r = 0; r < 16; ++r) { p0[r] -= dl; p1[r] -= dl; negm[r] = -mhat; } asm volatile("" : "+v"(negm)); \
            alpha_ = __builtin_amdgcn_exp2f(-dl); ATT_RESC(alpha_); } \
        finishSM(p0, p1, alpha_, l_reg, pa0, pa1, pa2, pa3); } while (0)
#define ATT_STEP(t) do { \
        if (lag || !ATT_LATE_DMA) { ATT_DMA_K((t) + 2, sp); ATT_DMA_V((t) + 1, ((t) + 1) & 3); } \
        { bf16x8 kf_[2 * NKS]; att::VFrag va_, vb_; const int vbt_ = vb0 + (((t) - 1) & 3) * RG::VSLOT; \
          kread<NKS, ROWB, CB0, 0>(kf_, Kr + sc * RG::KSLOT, r32, hi); vread<0>(va_, vbt_); \
          asm volatile("s_waitcnt lgkmcnt(0)" ::: "memory"); ATT_SBAR(); \
          kmma<NKS, 0>(p0, p1, kf_, qr, negm); ATT_SBAR(); \
          vread<1>(vb_, vbt_); ATT_SBAR(); \
          pv_mma(o[0], va_, pa0, pa1, pa2, pa3); \
          asm volatile("s_waitcnt lgkmcnt(0)" ::: "memory"); ATT_SBAR(); \
          pv_mma(o[1], vb_, pa0, pa1, pa2, pa3); } \
        asm volatile("" : "+v"(p0), "+v"(p1), "+v"(o[0]), "+v"(o[1])); \
        if (lag) ATT_WAITBAR(); \
        if (!lag && ATT_LATE_DMA) { ATT_DMA_K((t) + 2, sp); ATT_DMA_V((t) + 1, ((t) + 1) & 3); }     \
        ATT_SOFT(t, false); \
        asm volatile("" : "+v"(pa0), "+v"(pa1), "+v"(pa2), "+v"(pa3), "+v"(l_reg)); \
        if (!lag) ATT_WAITBAR(); ATT_ROT(); } while (0)
    ATT_DMA_K(0, 0); ATT_DMA_V(0, 0); ATT_DMA_K(1, 1);
    asm volatile("s_waitcnt vmcnt(0)" ::: "memory"); __builtin_amdgcn_s_barrier(); asm volatile("" ::: "memory");
    { ATT_DMA_K(2, 2); ATT_DMA_V(1, 1);
      qkt2<NKS, ROWB, CB0>(p0, p1, Kr, qr, negm, r32, hi);
      asm volatile("" : "+v"(p0), "+v"(p1));
      if (lag) ATT_WAITBAR();
      ATT_SOFT(0, true);
      asm volatile("" : "+v"(pa0), "+v"(pa1), "+v"(pa2), "+v"(pa3), "+v"(l_reg));
      if (!lag) ATT_WAITBAR(); ATT_ROT(); }
    for (int j = 1; j < ((var & 32) ? ATT_XSTEPS : NT); ++j) ATT_STEP(j);
    pv_one<0>(o[0], vb0 + ((NT - 1) & 3) * RG::VSLOT, pa0, pa1, pa2, pa3); pv_one<1>(o[1], vb0 + ((NT - 1) & 3) * RG::VSLOT, pa0, pa1, pa2, pa3);
    asm volatile("s_waitcnt vmcnt(0)" ::: "memory"); __builtin_amdgcn_s_barrier(); asm volatile("" ::: "memory");
#undef ATT_SOFT
    { auto rr = __builtin_amdgcn_permlane32_swap(__float_as_uint(l_reg), __float_as_uint(l_reg), false, false); l_reg = __uint_as_float(rr[0]) + __uint_as_float(rr[1]); }
    l_out = l_reg; m_out = mhat;
#undef ATT_TROW
#undef ATT_DMA_K
#undef ATT_DMA_V
#undef ATT_WAITBAR
#undef ATT_RESC
#undef ATT_MASK
#undef ATT_ROT
#undef ATT_STEP
}

template <int TYPE> __device__ __forceinline__ void unit(const Tensors& Tn, LAS unsigned char* lds, const int tid, const int b, const int h, const bool lat, const int q0, const int var) {
    constexpr int NKS = TYPE == 0 ? 4 : (TYPE == 1 ? 6 : 2);
    const int lane = tid & 63, wid = __builtin_amdgcn_readfirstlane(tid >> 6), r32 = lane & 31, hi = lane >> 5;
    typedef Ring<TYPE> RG;
    LAS float* wsf = (LAS float*)(lds + RG::L_WS) + wid * 64;
    const int hw = TYPE == 0 ? h * 4 + (wid & 3) : h, wrow = TYPE == 0 ? (wid >> 2) * 32 : wid * 32;
    const int qrow0 = (lat ? b * T + q0 : RL + b * LC + q0) + wrow;
    bf16x8 qr[TYPE == 2 ? 4 : NKS];
    { const bf16* qp = TYPE == 0 ? Tn.P + (size_t)(qrow0 + r32) * LDP + P_AQ + hw * 64 : (TYPE == 1 ? Tn.QKVM + (size_t)(qrow0 + r32) * LDM + h * 96 : Tn.P + (size_t)(qrow0 + r32) * LDP + P_DQ + h * 64);
#pragma unroll
      for (int d0 = 0; d0 < (TYPE == 2 ? 4 : NKS); ++d0) qr[d0] = *(const bf16x8*)(qp + d0 * 16 + hi * 8); }
    f32x16 oA[2] = {f32x16{}, f32x16{}}; float l0, m0;
    flash_pass<TYPE, 0>(Tn, lds, tid, b, hw, lat, q0, wrow, var, qr, oA, l0, m0);
    f32x16 oB[2] = {f32x16{}, f32x16{}}; float l1 = 1.f, m1 = 0.f;
    LAS float* stash = (LAS float*)(lds + RG::L_OST + wid * 8192);
    if (TYPE == 2) {
#pragma unroll
        for (int r = 0; r < 16; ++r) { stash[r * 64 + lane] = oA[0][r]; stash[(16 + r) * 64 + lane] = oA[1][r]; }
        flash_pass<TYPE, 64>(Tn, lds, tid, b, h, lat, q0, wrow, var, qr + 2, oB, l1, m1);
#pragma unroll
        for (int r = 0; r < 16; ++r) { oA[0][r] = stash[r * 64 + lane]; oA[1][r] = stash[(16 + r) * 64 + lane]; }
        asm volatile("s_waitcnt lgkmcnt(0)" ::: "memory");
    }
    if (TYPE == 0) l0 += __builtin_amdgcn_exp2f(Tn.sink[Tn.l * 8 + hw] * 1.4426950408889634f - m0);
    if (hi == 0) { wsf[r32] = l0; if (TYPE == 2) wsf[32 + r32] = l1; }
    asm volatile("s_waitcnt lgkmcnt(0)" ::: "memory");
    LAS bf16* stg = (LAS bf16*)(lds + RG::L_OST + wid * (TYPE == 2 ? 8192 : 4096));
    if (TYPE != 2) {
#pragma unroll
        for (int r = 0; r < 16; ++r) { const float rl = __builtin_amdgcn_rcpf(wsf[crow(r, hi)]); const int orow = crow(r, hi);
            stg[orow * 64 + r32] = (bf16)f2bf(oA[0][r] * rl); stg[orow * 64 + 32 + r32] = (bf16)f2bf(oA[1][r] * rl); }
    } else {
        const float g0 = Tn.dnorm[Tn.l * 64 + r32], g1 = Tn.dnorm[Tn.l * 64 + 32 + r32];
#pragma unroll
        for (int r = 0; r < 16; ++r) { const float rl0 = __builtin_amdgcn_rcpf(wsf[crow(r, hi)]), rl1 = Tn.lam * __builtin_amdgcn_rcpf(wsf[32 + crow(r, hi)]);
            const float a0 = oA[0][r] * rl0 - oB[0][r] * rl1, a1 = oA[1][r] * rl0 - oB[1][r] * rl1;
            float ss = a0 * a0 + a1 * a1;
#pragma unroll
            for (int o_ = 1; o_ < 32; o_ <<= 1) ss += shx(ss, o_, lane);
            const float rs = (1.f - Tn.lam_init) * __builtin_amdgcn_rsqf(ss * (1.f / 64.f) + EPS); const int orow = crow(r, hi);
            stg[orow * 64 + r32] = (bf16)f2bf(a0 * rs * g0); stg[orow * 64 + 32 + r32] = (bf16)f2bf(a1 * rs * g1); }
    }
    asm volatile("s_waitcnt lgkmcnt(0)" ::: "memory");
    { bf16* Ow = Tn.O + (size_t)qrow0 * D + (TYPE == 0 ? hw * 64 : (TYPE == 1 ? 512 + h * 64 : 768 + h * 64));
#pragma unroll
      for (int i = 0; i < 4; ++i) { const int row = i * 8 + (lane >> 3), ch = lane & 7; *(u32x4*)(Ow + (size_t)row * D + ch * 8) = *(const LAS u32x4*)(stg + row * 64 + ch * 8); } }
    asm volatile("s_waitcnt lgkmcnt(0)" ::: "memory"); __builtin_amdgcn_s_barrier(); asm volatile("" ::: "memory");
}
}

__device__ __forceinline__ void attn_phase(Frame& F, const int l, const bool need_ctx) {
    att::Tensors Tn; Tn.P = F_P; Tn.QKVM = F_QKVM; Tn.O = F_O; Tn.sink = F_sink; Tn.dnorm = F_diff_norm; Tn.l = l;
    { float s1 = 0.f, s2 = 0.f;
      if (F.lane < 32) { s1 = F_lq1[l * 32 + F.lane] * F_lk1[l * 32 + F.lane]; s2 = F_lq2[l * 32 + F.lane] * F_lk2[l * 32 + F.lane]; }
      s1 = wave_sum(s1, F.lane); s2 = wave_sum(s2, F.lane);
      int ll_ = l; asm volatile("" : "+s"(ll_));
      const float li_ = ll_ == 0 ? 0.200000000f : (ll_ == 1 ? 0.355509068f : (ll_ == 2 ? 0.470713018f : 0.556058204f));
      const float lm_ = __expf(s1) - __expf(s2) + li_;
      Tn.lam_init = li_; Tn.lam = __builtin_bit_cast(float, __builtin_amdgcn_readfirstlane(__builtin_bit_cast(int, lm_))); }
    const int b = F.bid & 7, j = F.bid >> 3;
    if (F.G != 256) return;
    const int nu = (need_ctx && j < 16) ? 5 : 4;
    for (int u = 0; u < nu + ATT_EXTRA; ++u) {
        int type, h, q0; bool lat = true; const int var = u >= nu ? ATT_XVAR : 0;
        if (u >= nu) { type = ATT_EXTRA_TYPE; h = ATT_EXTRA_TYPE == 0 ? ((j >> 3) & 1) : (j >> 3); q0 = ATT_EXTRA_TYPE == 0 ? j * 64 : (j & 7) * 256; Tn.O = F_ACT; }
        else if (u == 0) { type = 2; h = j >> 3; q0 = (j & 7) * 256; }
        else if (u == 1) { type = 1; h = j >> 3; q0 = (j & 7) * 256; }
        else if (u < 4) { type = 0; h = u - 2; q0 = j * 64; }
        else { lat = false; q0 = 0; if (j < 8) { type = 0; h = j >> 2; q0 = (j & 3) * 64; } else if (j < 12) { type = 1; h = j - 8; } else { type = 2; h = j - 12; } }
        int t_ = F.tid; asm volatile("" : "+v"(t_));
        if (type == 0) att::unit<0>(Tn, F.lds, t_, b, h, lat, q0, var);
        else if (type == 1) att::unit<1>(Tn, F.lds, t_, b, h, lat, q0, var);
        else att::unit<2>(Tn, F.lds, t_, b, h, lat, q0, var);
    }
}

enum { PH_P0 = 0, PH_L0 = 1, PH_PER_LAYER = 9, PH_FINAL = PH_L0 + DEPTH * PH_PER_LAYER, NPH = PH_FINAL + 1 };
enum { SP_NORM1 = 0, SP_INPROJ = 1, SP_UP = 2, SP_ATTN = 3, SP_OUT = 4, SP_NORM2 = 5, SP_TOPK = 6, SP_MOE1 = 7, SP_MOE2 = 8 };

#ifndef REPS_INIT
#define REPS_INIT {1, 1, 1, 1, 1, 1, 1, 1, 1}
#endif
#ifndef REP_P0
#define REP_P0 1
#endif
#ifndef REP_FINAL
#define REP_FINAL 1
#endif
#ifndef KROT_ON
#define KROT_ON 0
#endif
#ifndef PROBE_NOMMA
#define PROBE_NOMMA 0
#endif
#ifndef PHMASK
#define PHMASK 0x3ff
#endif
#define PHON(b) ((PHMASK >> (b)) & 1)
#define REPSEL(s) ((s) == 0 ? reps_sp[0] : (s) == 1 ? reps_sp[1] : (s) == 2 ? reps_sp[2] : (s) == 3 ? reps_sp[3] : (s) == 4 ? reps_sp[4] : (s) == 5 ? reps_sp[5] : (s) == 6 ? reps_sp[6] : (s) == 7 ? reps_sp[7] : reps_sp[8])
__global__ void __launch_bounds__(NWAVES * 64, 2) mk(Args args) {
    extern __shared__ __attribute__((aligned(16))) unsigned char lds_raw[];
    Frame F;
    F.lds = (LAS unsigned char*)lds_raw;
    F.tid = threadIdx.x; F.lane = F.tid & 63; F.wave = __builtin_amdgcn_readfirstlane(F.tid >> 6); F.bid = blockIdx.x; F.G = gridDim.x;
    const int wave_s = F.wave;
    F.in = (const float* const*)args.in; F.out = (GAS float*)args.out; F.ws = (GAS unsigned char*)args.ws;
    volatile LAS unsigned* MISC = (volatile LAS unsigned*)(F.lds + MISC_OFF);
    for (int u = F.tid; u < (LDS_BYTES - LDSCTL_OFF) / 4; u += NWAVES * 64) ((LAS unsigned*)(F.lds + LDSCTL_OFF))[u] = 0u;
    __syncthreads();
    XcdBarrier bar = xcd_barrier_post((unsigned*)(args.ws + WS_CTL) + CW_BAR + args.li * XCD_BAR_WORDS, MISC + 8);
    const int gx = F.bid & 7, gj = F.bid >> 3, gpx = F.G >> 3, krot = KROT_ON ? (gj & 7) + 3 * (gj >> 3) : 0;
    constexpr int reps_sp[9] = REPS_INIT;
    for (int ph = args.ph_lo; ph < args.ph_hi; ++ph) {
      const int nrep = ph == PH_P0 ? REP_P0 : (ph == PH_FINAL ? REP_FINAL : (REPSEL((ph - PH_L0) % PH_PER_LAYER)));
      for (int rep = 0; rep < nrep; ++rep) {
        const float keep = rep + 1 == nrep ? 1.f : 0.f;
        { unsigned char* w_ = args.ws; asm volatile("" : "+s"(w_)); F.ws = (GAS unsigned char*)w_; int z_ = 0; asm volatile("" : "+s"(z_)); F.in = (const float* const*)args.in + z_;
          int l_; asm volatile("v_mbcnt_lo_u32_b32 %0, -1, 0\n\tv_mbcnt_hi_u32_b32 %0, -1, %0" : "=v"(l_));
          int w_s = wave_s; asm volatile("" : "+s"(w_s)); F.lane = l_; F.wave = w_s; F.tid = w_s * 64 + l_; }
        if (ph == PH_P0) { if (PHON(9)) p0_phase(F); }
        else if (ph == PH_FINAL) { if (PHON(0)) norm_phase(F, DEPTH, 2, RL, keep); }
        else {
            const int l = (ph - PH_L0) / PH_PER_LAYER, sp = (ph - PH_L0) % PH_PER_LAYER;
            const bool need_ctx = l < DEPTH - 1; const int rows_mix = need_ctx ? R : RL;
            const bf16* wl = F_WB + (size_t)l * W_LAYER;
            if (sp == SP_NORM1) { if (PHON(0)) norm_phase(F, l, 0, R, keep); }
            else if (sp == SP_INPROJ && PHON(1)) {
                pg8::Gemm g{F_ACT, wl + W_IN, nullptr, 0, D, D}; OrderRows S{gx, gj, gpx, R / 288 / 8, LDP / 256, 0, krot, 288};
                EpiInProj<3, 3> E{F_P, F_ROPE, F_RSQ};
                pg8::gemm_phase288<false>(F.lds, F.tid, g, S, E);
                { const int nbusy = 8;
                  if (BG_PREP && l + 1 < DEPTH && rep + 1 == nrep && gj >= nbusy) prep_layer(F, l + 1, ((gx * (gpx - nbusy) + (gj - nbusy)) * NWAVES) + F.wave, 8 * (gpx - nbusy) * NWAVES); }
            } else if (sp == SP_UP && PHON(2)) {
                pg8::Gemm g{F_P + P_CQ, wl + W_UP, nullptr, 0, LDP, UPK}; OrderRows S{gx, gj, gpx, R / 288 / 8, 4, 0, krot, 288};
                EpiUp<3, 3> E{F_QKVM, F_ROPE, F_RSQ};
                pg8::gemm_phase288<false>(F.lds, F.tid, g, S, E);
            } else if (sp == SP_ATTN) { if (PHON(3)) attn_phase(F, l, need_ctx);
            } else if (sp == SP_OUT && PHON(4)) {
                pg8::Gemm g{F_O, wl + W_OUT, nullptr, 0, D, D};
                if (need_ctx) { OrderRows S{gx, gj, gpx, R / 288 / 8, 4, 0, krot, 288}; EpiOut<3, 3> E{(XT*)F_XB, F_MOD + (size_t)l * 9 * 6144, keep}; pg8::gemm_phase288<false>(F.lds, F.tid, g, S, E); }
                else { OrderRows S{gx, gj, gpx, RL / 256 / 8, 4, 0, krot, 256}; EpiOut<4> E{(XT*)F_XB, F_MOD + (size_t)l * 9 * 6144, keep}; pg8::gemm_phase<false, 4>(F.lds, F.tid, g, S, E); }
            } else if (sp == SP_NORM2) { if (PHON(5)) norm_phase(F, l, 1, rows_mix, keep); }
            else if (sp == SP_TOPK) { if (PHON(6)) topk_phase(F, need_ctx ? 16 : 8);
#if MOE_PF
                { unsigned acc = 0;
                  for (int e2 = 0; e2 < 2; ++e2) { const int e = 2 * gx + e2;
                    const u32x4* p1 = (const u32x4*)(wl + W_GU + (size_t)e * 1024 * 1024); const u32x4* p2 = (const u32x4*)(wl + W_DN + (size_t)e * 1024 * 512);
#pragma unroll 4
                    for (int i = gj * 512 + F.tid; i < 131072; i += gpx * 512) acc ^= p1[i].x;
#pragma unroll 4
                    for (int i = gj * 512 + F.tid; i < 65536; i += gpx * 512) acc ^= p2[i].x; }
                  asm volatile("" :: "v"(acc)); }
#endif
            }
            else if (sp == SP_MOE1 && PHON(7)) {
                pg8::Gemm g{F_ACT, wl + W_GU, F_STOK, (size_t)1024 * 1024, D, D};
                if (need_ctx) { OrderMoe S{gx, gj, gpx, 8, 4, krot, 288}; EpiGU<3, 3> E{F_HID}; pg8::gemm_phase288<true>(F.lds, F.tid, g, S, E); }
                else { OrderMoe S{gx, gj, gpx, 8, 4, krot, 256}; EpiGU<4> E{F_HID}; pg8::gemm_phase<true, 4>(F.lds, F.tid, g, S, E); }
            } else if (sp == SP_MOE2 && PHON(8)) {
                pg8::Gemm g{F_HID, wl + W_DN, nullptr, (size_t)1024 * 512, DE, DE};
                if (need_ctx) { OrderMoe S{gx, gj, gpx, 8, 4, krot, 288}; EpiDown<3, 3> E{F_Y, F_SGATE}; pg8::gemm_phase288<false>(F.lds, F.tid, g, S, E); }
                else { OrderMoe S{gx, gj, gpx, 8, 4, krot, 256}; EpiDown<4> E{F_Y, F_SGATE}; pg8::gemm_phase<false, 4>(F.lds, F.tid, g, S, E); }
            }
        }
        if (ph + 1 < args.ph_hi || rep + 1 < nrep) { xcd_barrier(bar, F.tid);
#ifdef EXTRA_BAR
            xcd_barrier(bar, F.tid);
#endif
        }
      }
    }
}

extern "C" void kernel_launch(void* const* d_in, const int* in_sizes, int n_in, void* d_out, int out_size, void* d_ws, size_t ws_size, hipStream_t stream) {
    static int grid = 0;
    if (grid == 0) {
        if (n_in != 25 || ws_size < WS_END || out_size != RL * D) { fprintf(stderr, "kernel_launch: unexpected shapes (n_in %d, ws %zu < %zu, out %d)\n", n_in, ws_size, (size_t)WS_END, out_size); grid = -1; return; }
        int dev = 0, cus = 0, per_cu = 0;
        if (hipGetDevice(&dev) != hipSuccess || hipDeviceGetAttribute(&cus, hipDeviceAttributeMultiprocessorCount, dev) != hipSuccess) { grid = -1; return; }
        if (hipFuncSetAttribute((const void*)mk, hipFuncAttributeMaxDynamicSharedMemorySize, LDS_BYTES) != hipSuccess) { fprintf(stderr, "kernel_launch: hipFuncSetAttribute failed\n"); grid = -1; return; }
        if (hipOccupancyMaxActiveBlocksPerMultiprocessor(&per_cu, (const void*)mk, NWAVES * 64, LDS_BYTES) != hipSuccess || per_cu < 1) { fprintf(stderr, "kernel_launch: occupancy query says %d\n", per_cu); }
        (void)hipGetLastError();
        grid = cus;
        if (grid % 8 != 0) { fprintf(stderr, "kernel_launch: %d CUs, expected a multiple of 8\n", grid); grid = -1; return; }
    }
    if (grid < 0) return;
    (void)hipMemsetAsync((char*)d_ws + WS_CTL, 0, CTL_ZERO_BYTES, stream);
    Args a; memset(&a, 0, sizeof a);
    for (int i = 0; i < 25; ++i) a.in[i] = (const float*)d_in[i];
    a.out = (float*)d_out; a.ws = (unsigned char*)d_ws;
    a.ph_lo = 0; a.ph_hi = NPH; a.li = 0;
    hipLaunchKernelGGL(mk, dim3(grid), dim3(NWAVES * 64), LDS_BYTES, stream, a);
}
```

```cpp
#include <hip/hip_runtime.h>
#include <stdint.h>
#include <string.h>
#include <stdio.h>

typedef unsigned short bf16;
typedef unsigned u32x4 __attribute__((ext_vector_type(4)));
typedef unsigned u32x2 __attribute__((ext_vector_type(2)));
typedef float f32x4 __attribute__((ext_vector_type(4)));
typedef float f32x16 __attribute__((ext_vector_type(16)));
typedef short bf16x8 __attribute__((ext_vector_type(8)));
#define LAS __attribute__((address_space(3)))
#define GAS __attribute__((address_space(1)))

constexpr int D = 1024, NB = 8, T = 2048, LC = 256, DEPTH = 4;
constexpr int RL = NB * T, RC = NB * LC, R = RL + RC;
constexpr int INW = 1952, LDP = 2048;
constexpr int NE = 16, DE = 512;
constexpr int CAPL = 256, CAPC = 32;
constexpr int SLOTS_E = NB * CAPL + NB * CAPC;
constexpr int SLOTS = NE * SLOTS_E;
constexpr float EPS = 1e-6f;
constexpr int P_AQ = 0, P_AK = 512, P_AV = 640, P_CQ = 768, P_CKV = 1024, P_KR = 1152, P_DQ = 1184, P_DK = 1440, P_DV = 1696;
constexpr int LDM = 1024;
constexpr int UPK = 384;

constexpr size_t MiB = 1u << 20;
constexpr size_t WS_CTL = 0;
constexpr size_t CTL_ZERO_BYTES = 256 * 1024;
constexpr size_t WS_MOD = 1 * MiB;
constexpr size_t WS_ROPE = 2 * MiB;
constexpr size_t WS_RSQ = 3 * MiB;
constexpr size_t WS_AFF = 4 * MiB;
constexpr size_t WS_INV = 6 * MiB;
constexpr size_t WS_STOK = 8 * MiB;
constexpr size_t WS_SGATE = 9 * MiB;
#ifndef X_BF16
#define X_BF16 1
#endif
constexpr size_t WS_X = 10 * MiB;
constexpr size_t WS_ACT = 82 * MiB;
constexpr size_t WS_P = 118 * MiB;
constexpr size_t WS_Y = WS_P;
constexpr size_t WS_QKVM = 190 * MiB;
constexpr size_t WS_O = 226 * MiB;
constexpr size_t WS_HID = WS_O;
constexpr size_t WS_W = 262 * MiB;
constexpr size_t W_IN = 0;
constexpr size_t W_UP = W_IN + (size_t)LDP * D;
constexpr size_t W_OUT = W_UP + (size_t)1024 * UPK;
constexpr size_t W_GU = W_OUT + (size_t)D * D;
constexpr size_t W_DN = W_GU + (size_t)NE * 1024 * 1024;
constexpr size_t W_LAYER = W_DN + (size_t)NE * 1024 * 512;
constexpr size_t WS_END = WS_W + (size_t)DEPTH * W_LAYER * 2;

__device__ __forceinline__ unsigned f2bf(float f) { unsigned u = __builtin_bit_cast(unsigned, f); return (u + 0x7fffu + ((u >> 16) & 1u)) >> 16; }
__device__ __forceinline__ float bf2f(unsigned h) { return __builtin_bit_cast(float, h << 16); }
typedef float f32x2c_t __attribute__((ext_vector_type(2)));
typedef __bf16 bf16x2c_t __attribute__((ext_vector_type(2)));
#ifndef HW_CVT
#define HW_CVT 1
#endif
__device__ __forceinline__ unsigned pk2(float lo, float hi) {
#if HW_CVT
    f32x2c_t v = {lo, hi}; bf16x2c_t b = __builtin_convertvector(v, bf16x2c_t); return __builtin_bit_cast(unsigned, b);
#else
    return f2bf(lo) | (f2bf(hi) << 16);
#endif
}
__device__ __forceinline__ float shx(float v, int o, int lane) { return __builtin_bit_cast(float, __builtin_amdgcn_ds_bpermute((lane ^ o) << 2, __builtin_bit_cast(int, v))); }
__device__ __forceinline__ int shi(int v, int src) { return __builtin_amdgcn_ds_bpermute(src << 2, v); }
__device__ __forceinline__ float wave_sum(float v, int lane) {
#pragma unroll
    for (int o = 1; o < 64; o <<= 1) v += shx(v, o, lane);
    return v;
}
__device__ __forceinline__ float siluf(float v) { return v / (1.f + __expf(-v)); }
#define LDS_WAIT() asm volatile("s_waitcnt lgkmcnt(0)" ::: "memory")
#define VM_WAIT() asm volatile("s_waitcnt vmcnt(0)" ::: "memory")

struct Args {
    const float* in[25]; float* out; unsigned char* ws; int ph_lo, ph_hi, li, pad;
};

#ifndef PROBE_HOT
#define PROBE_HOT 0
#endif
#ifndef PROBE_NOEPI
#define PROBE_NOEPI 0
#endif
#ifndef PROBE_NOLDS
#define PROBE_NOLDS 0
#endif
#ifndef GEMM_AUX
#define GEMM_AUX 0
#endif
#ifndef GEMM_PRIO
#define GEMM_PRIO 1
#endif
#ifndef GEMM_ASKIP
#define GEMM_ASKIP 0
#endif
namespace pg8 {
constexpr int BM = 256, BK = 64, HALF = 128, HTB = HALF * BK * 2  , STAGE_BYTES = 8 * HTB;
__host__ __device__ __forceinline__ int lds_byte(int r, int c) { const int st = (r >> 4) * 2 + (c >> 5), rr = r & 15, cc = c & 31, ob = rr * 64 + cc * 2; return st * 1024 + (ob ^ (((ob >> 9) & 1) << 5)); }
__host__ __device__ __forceinline__ void stage_rc(int b, int& R, int& C) { const int st = b / 1024, sb = b % 1024, swz = sb ^ (((sb >> 9) & 1) << 5); R = (st >> 1) * 16 + swz / 64; C = (st & 1) * 32 + (swz % 64) / 2; }
__host__ __device__ __forceinline__ int perm32(int rho) { const int n = rho >> 4, i = rho & 15; return 8 * (i >> 2) + 4 * n + (i & 3); }

struct Unit { int arow0, orow0, col0, e, quad; };
struct Gemm { const bf16* A; const bf16* Bt; const int* gather; size_t b_estride; int lda, K; };

template <bool GATHER, int MF, class Epi, class Sched>
__device__ __forceinline__ void gemm_phase(LAS unsigned char* lds, const int tid, const Gemm g, const Sched& S, const Epi& E) {
    const int wid = __builtin_amdgcn_readfirstlane(tid >> 6), lane = tid & 63, wr = wid >> 2, wc = wid & 3, fr = lane & 15, fq = lane >> 4;
    constexpr bool ASKIP = (MF == 3) && GEMM_ASKIP;
    constexpr int HR = 32 * MF;
    const int K = g.K, nt = K / BK;
    unsigned voffA[2], voffB[2]; int sR[2];
#pragma unroll
    for (int i = 0; i < 2; ++i) { int C_; stage_rc(tid * 16 + i * 8192, sR[i], C_); const int Rb = (sR[i] & ~31) + perm32(sR[i] & 31);
        voffA[i] = GATHER ? (unsigned)C_ * 2u : (unsigned)(sR[i] * g.lda + C_) * 2u; voffB[i] = (unsigned)(Rb * K + C_) * 2u; }
    const unsigned lda2 = (unsigned)g.lda * 2u;
    const unsigned hstepA = (unsigned)HR * g.lda * 2u;
    const unsigned kstep = (unsigned)(BK * 2);
    const int krot = (2 * S.rot) % nt;
#define PG8_KT(i) ((PROBE_HOT && hot_) ? 0u : (unsigned)(((i) + krot) >= nt ? (i) + krot - nt : (i) + krot) * kstep)
    const unsigned hstepB = (unsigned)HALF * K * 2u;
    const __amdgpu_buffer_rsrc_t rsA = __builtin_amdgcn_make_buffer_rsrc((void*)g.A, 0, 0x7fffffff, 0x00020000);
    const __amdgpu_buffer_rsrc_t rsB = __builtin_amdgcn_make_buffer_rsrc((void*)g.Bt, 0, 0x7fffffff, 0x00020000);
    const unsigned ldsw = (unsigned)wid * 1024u;
    const int aoff = lds_byte(wr * (16 * MF) + fr, fq * 8), boff = lds_byte(wc * 32 + fr, fq * 8);
#define PG8_SA(b, h) (((b) * 2 + (h)) * HTB)
#define PG8_SB(b, h) ((4 + (b) * 2 + (h)) * HTB)
#define PG8_STAGE2(bufoff, rsrc, v0, v1, soff) do { \
        __builtin_amdgcn_raw_ptr_buffer_load_lds(rsrc, (LAS unsigned*)(lds + (bufoff) + ldsw), 16, (int)(v0), (int)(soff), 0, 0); \
        __builtin_amdgcn_raw_ptr_buffer_load_lds(rsrc, (LAS unsigned*)(lds + (bufoff) + ldsw + 8192), 16, (int)(v1), (int)(soff), 0, 0); } while (0)
#define PG8_STAGEB(bufoff, soff) PG8_STAGE2(bufoff, rsB, voffB[0], voffB[1], soff)
#define PG8_STAGE1(bufoff, rsrc, v0, soff) __builtin_amdgcn_raw_ptr_buffer_load_lds(rsrc, (LAS unsigned*)(lds + (bufoff) + ldsw), 16, (int)(v0), (int)(soff), 0, 0)
#define PG8_STAGEA(bufoff, ubase, r0, r1, h, koff) do { if constexpr (GATHER) { \
        if (ASKIP && wr == 1) PG8_STAGE1(bufoff, rsA, (((r0) >> (16 * (h))) & 0xffffu) * lda2 + voffA[0], (koff)); \
        else PG8_STAGE2(bufoff, rsA, (((r0) >> (16 * (h))) & 0xffffu) * lda2 + voffA[0], (((r1) >> (16 * (h))) & 0xffffu) * lda2 + voffA[1], (koff)); } \
        else { if (ASKIP && wr == 1) PG8_STAGE1(bufoff, rsA, voffA[0], (ubase) + (h) * hstepA + (koff)); \
        else PG8_STAGE2(bufoff, rsA, voffA[0], voffA[1], (ubase) + (h) * hstepA + (koff)); } } while (0)
#define PG8_LDA(dst, b, h) do { if (PROBE_NOLDS && hot_) break; _Pragma("unroll") for (int m = 0; m < MF; ++m) _Pragma("unroll") for (int k = 0; k < 2; ++k) dst[m][k] = *(const LAS bf16x8*)(lds + PG8_SA(b, h) + aoff + m * 2048 + k * 1024); } while (0)
#define PG8_LDB(dst, b, h) do { if (PROBE_NOLDS && hot_) break; _Pragma("unroll") for (int n = 0; n < 2; ++n) _Pragma("unroll") for (int k = 0; k < 2; ++k) dst[n][k] = *(const LAS bf16x8*)(lds + PG8_SB(b, h) + boff + n * 2048 + k * 1024); } while (0)
#define PG8_MMA(ai, bj, At, Bt) do { __builtin_amdgcn_s_setprio(1); _Pragma("unroll") for (int m = 0; m < MF; ++m) _Pragma("unroll") for (int n = 0; n < 2; ++n) _Pragma("unroll") for (int k = 0; k < 2; ++k) \
        acc[ai][bj][m][n] = __builtin_amdgcn_mfma_f32_16x16x32_bf16(Bt[n][k], At[m][k], acc[ai][bj][m][n], 0, 0, 0); __builtin_amdgcn_s_setprio(0); } while (0)
#define PG8_WAIT_V(n) asm volatile("s_waitcnt vmcnt(" #n ")" ::: "memory")
#define PG8_WAIT_V2(n, nskip) do { if (ASKIP && wr == 1) PG8_WAIT_V(nskip); else PG8_WAIT_V(n); } while (0)
#define PG8_WAIT_L(n) asm volatile("s_waitcnt lgkmcnt(" #n ")" ::: "memory")
#define PG8_BAR __builtin_amdgcn_s_barrier()
#define PG8_SCHED __builtin_amdgcn_sched_barrier(0)
#define PG8_ROWS(dst, u) do { if constexpr (GATHER) { _Pragma("unroll") for (int i = 0; i < 2; ++i) { \
        const int sr_ = sR[i] < HR ? sR[i] : sR[i] - 32;     \
        const unsigned a_ = (unsigned)g.gather[(u).arow0 + sr_], b_ = (unsigned)g.gather[(u).arow0 + ((u).quad ? 0 : HR) + sr_]; dst[i] = a_ | (b_ << 16); } \
        asm volatile("" : "+v"(dst[0]), "+v"(dst[1])); } } while (0)
    Unit cur, nxt; int ui = 0;
    if (!S.next(0, cur)) return;
    const bool hot_ = cur.quad == 2;
    f32x4 acc[2][2][MF][2];
#pragma unroll
    for (int a = 0; a < 2; ++a)
#pragma unroll
        for (int b = 0; b < 2; ++b)
#pragma unroll
            for (int m = 0; m < MF; ++m)
#pragma unroll
                for (int n = 0; n < 2; ++n) acc[a][b][m][n] = (f32x4){0.f, 0.f, 0.f, 0.f};
    bf16x8 At[MF][2], B0[2][2], B1[2][2];
    unsigned rp[2] = {0u, 0u}, rn[2] = {0u, 0u};
    PG8_ROWS(rp, cur);
    unsigned cA = (unsigned)cur.arow0 * lda2;
    unsigned cB = (unsigned)(((size_t)cur.e * g.b_estride + (size_t)cur.col0 * K) * 2);
    PG8_STAGEB(PG8_SB(0, 0), cB + PG8_KT(0)); PG8_STAGEB(PG8_SB(0, 1), cB + hstepB + PG8_KT(0)); PG8_STAGEA(PG8_SA(0, 0), cA, rp[0], rp[1], 0, PG8_KT(0)); PG8_STAGEA(PG8_SA(0, 1), cA, rp[0], rp[1], 1, PG8_KT(0));
    if (wr == 1) PG8_BAR;
    PG8_WAIT_V2(2, 1); PG8_BAR;
    PG8_STAGEB(PG8_SB(1, 0), cB + PG8_KT(1)); PG8_STAGEA(PG8_SA(1, 0), cA, rp[0], rp[1], 0, PG8_KT(1)); PG8_STAGEB(PG8_SB(1, 1), cB + hstepB + PG8_KT(1));
    PG8_WAIT_V2(6, 5); PG8_BAR;
    for (;;) {
        const bool has_next = S.next(ui + 1, nxt);
        if (has_next) { PG8_ROWS(rn, nxt); } else { rn[0] = rp[0]; rn[1] = rp[1]; }
        const unsigned nA = has_next ? (unsigned)nxt.arow0 * lda2 : cA;
        const unsigned nB = has_next ? (unsigned)(((size_t)nxt.e * g.b_estride + (size_t)nxt.col0 * K) * 2) : cB;
#pragma unroll 1
        for (int t = 0; t < nt; t += 2) {
            const bool last = (t == nt - 2);
            const unsigned k1 = PG8_KT(t + 1), k2 = last ? PG8_KT(0) : PG8_KT(t + 2), k3 = last ? PG8_KT(1) : PG8_KT(t + 3);
            const unsigned u2 = last ? nA : cA; const unsigned b2 = (last ? nB : cB) + k2; const unsigned b3 = (last ? nB : cB) + k3;
            const unsigned q0 = last ? rn[0] : rp[0], q1 = last ? rn[1] : rp[1];
            PG8_LDB(B0, 0, 0); PG8_LDB(B1, 0, 1); PG8_SCHED; PG8_LDA(At, 0, 0); PG8_STAGEA(PG8_SA(1, 1), cA, rp[0], rp[1], 1, k1);
            PG8_WAIT_V2(8, 6); PG8_WAIT_L(0); PG8_BAR; if (cur.quad < 2) PG8_MMA(0, 0, At, B0); if (!cur.quad) PG8_MMA(0, 1, At, B1); PG8_BAR; PG8_SCHED;
            PG8_LDA(At, 0, 1); PG8_STAGEB(PG8_SB(0, 0), b2); PG8_STAGEB(PG8_SB(0, 1), b2 + hstepB); PG8_STAGEA(PG8_SA(0, 0), u2, q0, q1, 0, k2);
            PG8_WAIT_V2(8, 6); PG8_WAIT_L(0); PG8_BAR; if (!cur.quad) { PG8_MMA(1, 0, At, B0); PG8_MMA(1, 1, At, B1); } PG8_BAR; PG8_SCHED;
            PG8_LDB(B0, 1, 0); PG8_LDB(B1, 1, 1); PG8_SCHED; PG8_LDA(At, 1, 0); PG8_STAGEA(PG8_SA(0, 1), u2, q0, q1, 1, k2);
            PG8_WAIT_V2(8, 6); PG8_WAIT_L(0); PG8_BAR; if (cur.quad < 2) PG8_MMA(0, 0, At, B0); if (!cur.quad) PG8_MMA(0, 1, At, B1); PG8_BAR; PG8_SCHED;
            PG8_LDA(At, 1, 1); PG8_STAGEB(PG8_SB(1, 0), b3); PG8_STAGEB(PG8_SB(1, 1), b3 + hstepB); PG8_STAGEA(PG8_SA(1, 0), u2, q0, q1, 0, k3);
            PG8_WAIT_V2(8, 6); PG8_WAIT_L(0); PG8_BAR; if (!cur.quad) { PG8_MMA(1, 0, At, B0); PG8_MMA(1, 1, At, B1); } PG8_BAR; PG8_SCHED;
        }
        if (wr == 0) PG8_BAR;
        if (!(PROBE_NOEPI && hot_)) E(acc, cur, wr, wc, fr, fq);
        if (!has_next) break;
#pragma unroll
        for (int a = 0; a < 2; ++a)
#pragma unroll
            for (int b = 0; b < 2; ++b)
#pragma unroll
                for (int m = 0; m < MF; ++m)
#pragma unroll
                    for (int n = 0; n < 2; ++n) acc[a][b][m][n] = (f32x4){0.f, 0.f, 0.f, 0.f};
        cur = nxt; cB = nB; cA = nA; ++ui; rp[0] = rn[0]; rp[1] = rn[1];
        if (wr == 1) PG8_BAR;
    }
    PG8_WAIT_V(0);
    PG8_BAR;
#undef PG8_SA
#undef PG8_SB
#undef PG8_STAGE2
#undef PG8_STAGEB
#undef PG8_LDA
#undef PG8_LDB
#undef PG8_MMA
#undef PG8_WAIT_V
#undef PG8_WAIT_V2
#undef PG8_STAGE1
#undef PG8_WAIT_L
#undef PG8_BAR
#undef PG8_SCHED
#undef PG8_KT
#undef PG8_ROWS
#undef PG8_STAGEA
}
constexpr int PTB = 96 * BK * 2, SB_OFF = 6 * PTB, STAGE288_BYTES = SB_OFF + 4 * HTB;
template <bool GATHER, class Epi, class Sched>
__device__ __forceinline__ void gemm_phase288(LAS unsigned char* lds, const int tid, const Gemm g, const Sched& S, const Epi& E) {
    constexpr int MF = 3;
    const int wid = __builtin_amdgcn_readfirstlane(tid >> 6), lane = tid & 63, wr = wid >> 2, wc = wid & 3, fr = lane & 15, fq = lane >> 4;
    const int K = g.K, nt = K / BK;
    unsigned voffA[2], voffB[2]; int sR[2];
#pragma unroll
    for (int i = 0; i < 2; ++i) { int C_; stage_rc(tid * 16 + i * 8192, sR[i], C_); const int Rb = (sR[i] & ~31) + perm32(sR[i] & 31);
        voffB[i] = (unsigned)(Rb * K + C_) * 2u;
        if (i == 1) stage_rc((tid & 255) * 16 + 8192, sR[i], C_);
        voffA[i] = GATHER ? (unsigned)C_ * 2u : (unsigned)(sR[i] * g.lda + C_) * 2u; }
    const unsigned lda2 = (unsigned)g.lda * 2u;
    const unsigned pstepA = 96u * g.lda * 2u;
    const unsigned kstep = (unsigned)(BK * 2);
    const unsigned hstepB = (unsigned)HALF * K * 2u;
    const __amdgpu_buffer_rsrc_t rsA = __builtin_amdgcn_make_buffer_rsrc((void*)g.A, 0, 0x7fffffff, 0x00020000);
    const __amdgpu_buffer_rsrc_t rsB = __builtin_amdgcn_make_buffer_rsrc((void*)g.Bt, 0, 0x7fffffff, 0x00020000);
    const unsigned ldsw = (unsigned)wid * 1024u, ldsx = 8192u + (unsigned)(wid & 3) * 1024u;
    const int aoff = lds_byte(wr * 48 + fr, fq * 8), boff = lds_byte(wc * 32 + fr, fq * 8);
#define PG9_SA(b, a) (((b) * 3 + (a)) * PTB)
#define PG9_SB(b, h) (SB_OFF + ((b) * 2 + (h)) * HTB)
#define PG9_DMA(rsrc, dstoff, v, soff) __builtin_amdgcn_raw_ptr_buffer_load_lds(rsrc, (LAS unsigned*)(lds + (dstoff) + ldsw), 16, (int)(v), (int)(soff), 0, GEMM_AUX)
#define PG9_STAGEB(bufoff, soff) do { PG9_DMA(rsB, (bufoff), voffB[0], (soff)); PG9_DMA(rsB, (bufoff) + 8192, voffB[1], (soff)); } while (0)
#define PG9_RIDX(r, a, i) ((a) < 2 ? (((r)[i] >> (16 * (a))) & 0xffffu) : (((r)[2] >> (16 * (i))) & 0xffffu))
#define PG9_DMAX(rsrc, dstoff, v, soff) __builtin_amdgcn_raw_ptr_buffer_load_lds(rsrc, (LAS unsigned*)(lds + (dstoff) + ldsx), 16, (int)(v), (int)(soff), 0, GEMM_AUX)
#define PG9_STAGEA(bufoff, ubase, r, a, koff, OWN) do { if constexpr (GATHER) { \
        PG9_DMA(rsA, (bufoff), PG9_RIDX(r, a, 0) * lda2 + voffA[0], (koff)); if (wr == (OWN)) PG9_DMAX(rsA, (bufoff), PG9_RIDX(r, a, 1) * lda2 + voffA[1], (koff)); } \
        else { PG9_DMA(rsA, (bufoff), voffA[0], (ubase) + (a) * pstepA + (koff)); if (wr == (OWN)) PG9_DMAX(rsA, (bufoff), voffA[1], (ubase) + (a) * pstepA + (koff)); } } while (0)
#define PG9_LDA(dst, b, a) do { _Pragma("unroll") for (int m = 0; m < MF; ++m) _Pragma("unroll") for (int k = 0; k < 2; ++k) dst[m][k] = *(const LAS bf16x8*)(lds + PG9_SA(b, a) + aoff + m * 2048 + k * 1024); } while (0)
#define PG9_LDB(dst, b, h) do { _Pragma("unroll") for (int n = 0; n < 2; ++n) _Pragma("unroll") for (int k = 0; k < 2; ++k) dst[n][k] = *(const LAS bf16x8*)(lds + PG9_SB(b, h) + boff + n * 2048 + k * 1024); } while (0)
#define PG9_MMA(ai, bj, At, Bt) do { if (GEMM_PRIO) __builtin_amdgcn_s_setprio(1); _Pragma("unroll") for (int m = 0; m < MF; ++m) _Pragma("unroll") for (int n = 0; n < 2; ++n) _Pragma("unroll") for (int k = 0; k < 2; ++k) \
        acc[ai][bj][m][n] = __builtin_amdgcn_mfma_f32_16x16x32_bf16(Bt[n][k], At[m][k], acc[ai][bj][m][n], 0, 0, 0); if (GEMM_PRIO) __builtin_amdgcn_s_setprio(0); } while (0)
#define PG9_WAIT_V(n) asm volatile("s_waitcnt vmcnt(" #n ")" ::: "memory")
#define PG9_WAIT_L(n) asm volatile("s_waitcnt lgkmcnt(" #n ")" ::: "memory")
#define PG9_BAR __builtin_amdgcn_s_barrier()
#define PG9_SCHED __builtin_amdgcn_sched_barrier(0)
#define PG9_ROWS(dst, u) do { if constexpr (GATHER) { unsigned t2_[2]; _Pragma("unroll") for (int i = 0; i < 2; ++i) { \
        const unsigned a_ = (unsigned)g.gather[(u).arow0 + sR[i]], b_ = (unsigned)g.gather[(u).arow0 + 96 + sR[i]]; t2_[i] = (unsigned)g.gather[(u).arow0 + 192 + sR[i]]; dst[i] = a_ | (b_ << 16); } \
        dst[2] = t2_[0] | (t2_[1] << 16); asm volatile("" : "+v"(dst[0]), "+v"(dst[1]), "+v"(dst[2])); } } while (0)
    Unit cur, nxt; int ui = 0;
    if (!S.next(0, cur)) return;
    f32x4 acc[3][2][MF][2];
#pragma unroll
    for (int a = 0; a < 3; ++a)
#pragma unroll
        for (int b = 0; b < 2; ++b)
#pragma unroll
            for (int m = 0; m < MF; ++m)
#pragma unroll
                for (int n = 0; n < 2; ++n) acc[a][b][m][n] = (f32x4){0.f, 0.f, 0.f, 0.f};
    bf16x8 At[MF][2], B0[2][2], B1[2][2];
    unsigned rp[3] = {0u, 0u, 0u}, rn[3] = {0u, 0u, 0u};
    PG9_ROWS(rp, cur);
    unsigned cA = (unsigned)cur.arow0 * lda2;
    unsigned cB = (unsigned)(((size_t)cur.e * g.b_estride + (size_t)cur.col0 * K) * 2);
    PG9_STAGEB(PG9_SB(0, 0), cB); PG9_STAGEA(PG9_SA(0, 0), cA, rp, 0, 0u, 0); PG9_STAGEB(PG9_SB(0, 1), cB + hstepB); PG9_STAGEA(PG9_SA(0, 1), cA, rp, 1, 0u, 1); PG9_STAGEA(PG9_SA(0, 2), cA, rp, 2, 0u, 0);
    PG9_STAGEB(PG9_SB(1, 0), cB + kstep); PG9_STAGEA(PG9_SA(1, 0), cA, rp, 0, kstep, 1); PG9_STAGEB(PG9_SB(1, 1), cB + hstepB + kstep); PG9_STAGEA(PG9_SA(1, 1), cA, rp, 1, kstep, 0);
    PG9_WAIT_V(10); PG9_BAR;
    if (wr == 1) PG9_BAR;
    for (;;) {
        const bool has_next = S.next(ui + 1, nxt);
        if (has_next) { PG9_ROWS(rn, nxt); } else { rn[0] = rp[0]; rn[1] = rp[1]; rn[2] = rp[2]; }
        const unsigned nA = has_next ? (unsigned)nxt.arow0 * lda2 : cA;
        const unsigned nB = has_next ? (unsigned)(((size_t)nxt.e * g.b_estride + (size_t)nxt.col0 * K) * 2) : cB;
#pragma unroll 1
        for (int t = 0; t < nt; t += 2) {
            const bool last = (t == nt - 2);
            const unsigned k1 = (unsigned)(t + 1) * kstep, k2 = last ? 0u : (unsigned)(t + 2) * kstep, k3 = last ? kstep : (unsigned)(t + 3) * kstep;
            const unsigned u2 = last ? nA : cA; const unsigned b2 = (last ? nB : cB) + k2; const unsigned b3 = (last ? nB : cB) + k3;
            unsigned q[3]; q[0] = last ? rn[0] : rp[0]; q[1] = last ? rn[1] : rp[1]; q[2] = last ? rn[2] : rp[2];
            PG9_LDB(B0, 0, 0); PG9_LDB(B1, 0, 1); PG9_SCHED; PG9_LDA(At, 0, 0); PG9_STAGEA(PG9_SA(1, 2), cA, rp, 2, k1, 1);
            PG9_WAIT_V(10); PG9_WAIT_L(0); PG9_BAR; PG9_MMA(0, 0, At, B0); PG9_MMA(0, 1, At, B1); PG9_BAR; PG9_SCHED;
            PG9_LDA(At, 0, 1); PG9_STAGEB(PG9_SB(0, 0), b2); PG9_STAGEA(PG9_SA(0, 0), u2, q, 0, k2, 0);
            PG9_WAIT_V(12); PG9_WAIT_L(0); PG9_BAR; PG9_MMA(1, 0, At, B0); PG9_MMA(1, 1, At, B1); PG9_BAR; PG9_SCHED;
            PG9_LDA(At, 0, 2); PG9_STAGEB(PG9_SB(0, 1), b2 + hstepB); PG9_STAGEA(PG9_SA(0, 1), u2, q, 1, k2, 1);
            PG9_WAIT_V(10); PG9_WAIT_L(0); PG9_BAR; PG9_MMA(2, 0, At, B0); PG9_MMA(2, 1, At, B1); PG9_BAR; PG9_SCHED;
            PG9_LDB(B0, 1, 0); PG9_LDB(B1, 1, 1); PG9_SCHED; PG9_LDA(At, 1, 0); PG9_STAGEA(PG9_SA(0, 2), u2, q, 2, k2, 0);
            PG9_WAIT_V(10); PG9_WAIT_L(0); PG9_BAR; PG9_MMA(0, 0, At, B0); PG9_MMA(0, 1, At, B1); PG9_BAR; PG9_SCHED;
            PG9_LDA(At, 1, 1); PG9_STAGEB(PG9_SB(1, 0), b3); PG9_STAGEA(PG9_SA(1, 0), u2, q, 0, k3, 1);
            PG9_WAIT_V(12); PG9_WAIT_L(0); PG9_BAR; PG9_MMA(1, 0, At, B0); PG9_MMA(1, 1, At, B1); PG9_BAR; PG9_SCHED;
            PG9_LDA(At, 1, 2); PG9_STAGEB(PG9_SB(1, 1), b3 + hstepB); PG9_STAGEA(PG9_SA(1, 1), u2, q, 1, k3, 0);
            PG9_WAIT_V(10); PG9_WAIT_L(0); PG9_BAR; PG9_MMA(2, 0, At, B0); PG9_MMA(2, 1, At, B1); PG9_BAR; PG9_SCHED;
        }
        if (wr == 0) PG9_BAR;
        E(acc, cur, wr, wc, fr, fq);
        if (!has_next) break;
#pragma unroll
        for (int a = 0; a < 3; ++a)
#pragma unroll
            for (int b = 0; b < 2; ++b)
#pragma unroll
                for (int m = 0; m < MF; ++m)
#pragma unroll
                    for (int n = 0; n < 2; ++n) acc[a][b][m][n] = (f32x4){0.f, 0.f, 0.f, 0.f};
        cur = nxt; cB = nB; cA = nA; ++ui; rp[0] = rn[0]; rp[1] = rn[1]; rp[2] = rn[2];
        if (wr == 1) PG9_BAR;
    }
    PG9_WAIT_V(0);
    PG9_BAR;
#undef PG9_SA
#undef PG9_SB
#undef PG9_DMA
#undef PG9_DMAX
#undef PG9_STAGEB
#undef PG9_RIDX
#undef PG9_STAGEA
#undef PG9_LDA
#undef PG9_LDB
#undef PG9_MMA
#undef PG9_WAIT_V
#undef PG9_WAIT_L
#undef PG9_BAR
#undef PG9_SCHED
#undef PG9_ROWS
}
}

#ifndef QUAD_SPLIT
#define QUAD_SPLIT 1
#endif
__device__ __forceinline__ bool deal(int i, int j, int gpx, int U, int& unit, int& quad) {
    const int q = i * gpx + j, nfull = (U / gpx) * gpx, left = U - nfull;
    if (q < nfull || left * 4 > gpx || !QUAD_SPLIT) { if (q >= U) return false; unit = q; quad = -1; return true; }
    const int s_ = q - nfull; if (s_ >= left * 4) return false; unit = nfull + (s_ >> 2); quad = s_ & 3; return true;
}
struct OrderRows {
    int x, j, gpx, rpx, nN, nomma, rot, TR;
    __device__ __forceinline__ bool next(int i, pg8::Unit& u) const {
        int q, quad; if (!deal(i, j, gpx, rpx * nN, q, quad)) return false;
        const int pm = x * rpx + q / nN, pn = q % nN; u.arow0 = pm * TR; u.col0 = pn * 256; u.e = 0; u.quad = quad >= 0;
        if (quad >= 0) { u.arow0 += (quad >> 1) * (TR / 2); u.col0 += (quad & 1) * 128; }
        if (nomma) u.quad = 2;
        u.orow0 = u.arow0; return true; }
};
struct OrderMoe {
    int x, j, gpx, nME, nN, rot, TR;
    __device__ __forceinline__ bool next(int i, pg8::Unit& u) const {
        int q, quad; const int per = nME * nN; if (!deal(i, j, gpx, 2 * per, q, quad)) return false;
        const int e = 2 * x + q / per, rem = q % per, pmE = rem / nN, pn = rem % nN;
        u.arow0 = e * SLOTS_E + pmE * TR; u.col0 = pn * 256; u.e = e; u.quad = quad >= 0;
        if (quad >= 0) { u.arow0 += (quad >> 1) * (TR / 2); u.col0 += (quad & 1) * 128; }
        u.orow0 = u.arow0; return true; }
};

#if X_BF16
typedef bf16 XT;
#else
typedef float XT;
#endif
constexpr float QS_A = 0.125f * 1.4426950408889634f, QS_B = 0.10206207261596577f * 1.4426950408889634f, QS_C = 0.17677669529663687f * 1.4426950408889634f;
typedef float f32x4e __attribute__((ext_vector_type(4)));
#define EPI_ROWS(ai, m) (u.orow0 + (ai) * (32 * MF) + wr * (16 * MF) + (m) * 16 + fr)
#define EPI_COL0(bj) (u.col0 + (bj) * 128 + wc * 32 + 8 * fq)
__device__ __forceinline__ void rope8(f32x4& v0, f32x4& v1, const float* cs, const float* sn) {
    const f32x4 c = *(const f32x4*)cs, s = *(const f32x4*)sn;
    f32x4 a = v0, b = v1;
    v0.x = a.x * c.x - a.y * s.x; v0.y = a.y * c.x + a.x * s.x; v0.z = a.z * c.y - a.w * s.y; v0.w = a.w * c.y + a.z * s.y;
    v1.x = b.x * c.z - b.y * s.z; v1.y = b.y * c.z + b.x * s.z; v1.z = b.z * c.w - b.w * s.w; v1.w = b.w * c.w + b.z * s.w;
}
__device__ __forceinline__ u32x4 pack8(const f32x4 v0, const f32x4 v1) { u32x4 w; w.x = pk2(v0.x, v0.y); w.y = pk2(v0.z, v0.w); w.z = pk2(v1.x, v1.y); w.w = pk2(v1.z, v1.w); return w; }

template <int MF, int NA = 2> struct EpiInProj {
    bf16* P; const float* rope; float* RSQ;
    __device__ __forceinline__ void operator()(const f32x4 (&acc)[NA][2][MF][2], const pg8::Unit& u, int wr, int wc, int fr, int fq) const {
#pragma unroll
        for (int bj = 0; bj < 2; ++bj) {
            if (u.quad && bj) continue;
            const int c0 = EPI_COL0(bj);
            const bool secA = c0 < P_AV, secB = c0 >= P_KR && c0 < P_DV;
            const int which = (c0 >= P_CQ && c0 < P_CKV) ? 0 : ((c0 >= P_CKV && c0 < P_KR) ? 1 : -1);
            const int p0 = secA ? ((c0 & 63) >> 1) : ((c0 & 31) >> 1);
            const float qs = c0 < P_AK ? QS_A : ((c0 >= P_DQ && c0 < P_DK) ? QS_C : 1.f);
#pragma unroll
            for (int ai = 0; ai < NA; ++ai)
#pragma unroll
                for (int m = 0; m < MF; ++m) {
                    if (u.quad && ai) continue;
                    const int row = EPI_ROWS(ai, m);
                    f32x4 v0 = acc[ai][bj][m][0] * qs, v1 = acc[ai][bj][m][1] * qs;
                    if (row < RL && (secA || secB)) { const int t = row & (T - 1);
                        const float* cs = secA ? rope + t * 32 + p0 : rope + T * 64 + t * 16 + p0;
                        const float* sn = secA ? rope + T * 32 + t * 32 + p0 : rope + T * 64 + T * 16 + t * 16 + p0;
                        rope8(v0, v1, cs, sn); }
                    if (which >= 0) { float s = (v0.x * v0.x + v0.y * v0.y) + (v0.z * v0.z + v0.w * v0.w) + (v1.x * v1.x + v1.y * v1.y) + (v1.z * v1.z + v1.w * v1.w);
                        { const int ln_ = fq * 16 + fr; s += shx(s, 16, ln_); s += shx(s, 32, ln_); }
                        if (fq == 0) RSQ[(size_t)row * 12 + ((c0 - P_CQ) >> 5)] = s; }
                    *(u32x4*)(P + (size_t)row * LDP + c0) = pack8(v0, v1);
                }
        }
    }
};
template <int MF, int NA = 2> struct EpiUp {
    bf16* QKVM; const float* rope; const float* RSQ;
    __device__ __forceinline__ void operator()(const f32x4 (&acc)[NA][2][MF][2], const pg8::Unit& u, int wr, int wc, int fr, int fq) const {
        const bool isq = u.col0 < 512;
        const float inv = isq ? (1.f / 256.f) : (1.f / 128.f);
        const int cw = u.col0 + wc * 32 + 8 * fq;
        int j0 = cw; j0 -= j0 >= 192 ? 192 : 0; j0 -= j0 >= 96 ? 96 : 0;
        int j1 = j0 + 32; j1 -= j1 >= 96 ? 96 : 0;
        const bool rot0 = isq && cw < 384 && j0 >= 64, rot1 = isq && cw + 128 < 384 && j1 >= 64;
        const float* tb = rope + T * 64;
#pragma unroll
        for (int ai = 0; ai < NA; ++ai)
#pragma unroll
            for (int m = 0; m < MF; ++m) {
                if (u.quad && ai) continue;
                const int row = EPI_ROWS(ai, m);
                const float* rq = RSQ + (size_t)row * 12; float sq;
                if (isq) { const f32x4 pa_ = *(const f32x4*)rq, pb_ = *(const f32x4*)(rq + 4); sq = ((pa_.x + pa_.y) + (pa_.z + pa_.w)) + ((pb_.x + pb_.y) + (pb_.z + pb_.w)); }
                else { const f32x4 pc_ = *(const f32x4*)(rq + 8); sq = (pc_.x + pc_.y) + (pc_.z + pc_.w); }
                const float rs = __builtin_amdgcn_rsqf(sq * inv + EPS) * (isq ? QS_B : 1.f);
                const int t = row & (T - 1);
                bf16* dst = QKVM + (size_t)row * LDM + cw;
                { f32x4 v0 = acc[ai][0][m][0] * rs, v1 = acc[ai][0][m][1] * rs;
                  if (rot0 && row < RL) rope8(v0, v1, tb + t * 16 + ((j0 - 64) >> 1), tb + T * 16 + t * 16 + ((j0 - 64) >> 1));
                  *(u32x4*)dst = pack8(v0, v1); }
                if (!u.quad) { f32x4 v0 = acc[ai][1][m][0] * rs, v1 = acc[ai][1][m][1] * rs;
                  if (rot1 && row < RL) rope8(v0, v1, tb + t * 16 + ((j1 - 64) >> 1), tb + T * 16 + t * 16 + ((j1 - 64) >> 1));
                  *(u32x4*)(dst + 128) = pack8(v0, v1); }
            }
    }
};
template <int MF, int NA = 2> struct EpiOut {
    XT* X; const float* MODl; float keep;
    __device__ __forceinline__ void operator()(const f32x4 (&acc)[NA][2][MF][2], const pg8::Unit& u, int wr, int wc, int fr, int fq) const {
#pragma unroll
        for (int ai = 0; ai < NA; ++ai)
#pragma unroll
            for (int m = 0; m < MF; ++m) {
                if (u.quad && ai) continue;
                const int row_ = EPI_ROWS(ai, m); const int mb = row_ < RL ? row_ >> 11 : 8;
                const float* g1 = MODl + (size_t)mb * 6144 + 2048;
#pragma unroll
                for (int bj = 0; bj < 2; ++bj) {
                    if (u.quad && bj) continue;
                    const int c0 = EPI_COL0(bj);
                    const f32x4 ga = *(const f32x4*)(g1 + c0) * keep, gb = *(const f32x4*)(g1 + c0 + 4) * keep;
                    XT* xp = X + (size_t)row_ * D + c0;
#if X_BF16
                    const u32x4 xw = *(const u32x4*)xp;
                    f32x4 xa = (f32x4){bf2f(xw.x & 0xffffu), bf2f(xw.x >> 16), bf2f(xw.y & 0xffffu), bf2f(xw.y >> 16)}, xb = (f32x4){bf2f(xw.z & 0xffffu), bf2f(xw.z >> 16), bf2f(xw.w & 0xffffu), bf2f(xw.w >> 16)};
                    xa += ga * acc[ai][bj][m][0]; xb += gb * acc[ai][bj][m][1];
                    *(u32x4*)xp = pack8(xa, xb);
#else
                    f32x4 xa = *(const f32x4*)xp, xb = *(const f32x4*)(xp + 4);
                    xa += ga * acc[ai][bj][m][0]; xb += gb * acc[ai][bj][m][1];
                    *(f32x4*)xp = xa; *(f32x4*)(xp + 4) = xb;
#endif
                }
            }
    }
};
template <int MF, int NA = 2> struct EpiGU {
    bf16* HID;
    __device__ __forceinline__ void operator()(const f32x4 (&acc)[NA][2][MF][2], const pg8::Unit& u, int wr, int wc, int fr, int fq) const {
#pragma unroll
        for (int bj = 0; bj < 2; ++bj) {
            if (u.quad && bj) continue;
            const int hc = EPI_COL0(bj) >> 1;
#pragma unroll
            for (int ai = 0; ai < NA; ++ai)
#pragma unroll
                for (int m = 0; m < MF; ++m) {
                    if (u.quad && ai) continue;
                    const f32x4 g = acc[ai][bj][m][0], up = acc[ai][bj][m][1];
                    u32x2 w; w.x = pk2(siluf(g.x) * up.x, siluf(g.y) * up.y); w.y = pk2(siluf(g.z) * up.z, siluf(g.w) * up.w);
                    *(u32x2*)(HID + (size_t)EPI_ROWS(ai, m) * DE + hc) = w;
                }
        }
    }
};
template <int MF, int NA = 2> struct EpiDown {
    bf16* Y; const float* SGATE;
    __device__ __forceinline__ void operator()(const f32x4 (&acc)[NA][2][MF][2], const pg8::Unit& u, int wr, int wc, int fr, int fq) const {
#pragma unroll
        for (int ai = 0; ai < NA; ++ai)
#pragma unroll
            for (int m = 0; m < MF; ++m) {
                if (u.quad && ai) continue;
                const int row = EPI_ROWS(ai, m); const float gt = SGATE[row];
#pragma unroll
                for (int bj = 0; bj < 2; ++bj)
                    if (!(u.quad && bj)) *(u32x4*)(Y + (size_t)row * D + EPI_COL0(bj)) = pack8(acc[ai][bj][m][0] * gt, acc[ai][bj][m][1] * gt);
            }
    }
};

constexpr int NWAVES = 8;
constexpr int RING_BYTES = 139264;
constexpr int LDSCTL_OFF = RING_BYTES, MISC_OFF = LDSCTL_OFF + 320;
constexpr int LDS_BYTES = 147456;
constexpr int CW_BAR = 4096;
typedef GAS unsigned gu32;

#define XB_TMO      128
#define XB_XCNT(j)  (256  + 64 * (j))
#define XB_XSUB(j)  (1280 + 64 * (j))
#define XB_XGEN(j)  (2304 + 64 * (j))
#define XB_TOP      3328
#define XB_TOPGEN   3392
#define XCD_BAR_WORDS 3456
#define XB_SPIN_CAP (1u << 18)
__device__ __forceinline__ unsigned xb_ld(unsigned* p)              { return __hip_atomic_load(p, __ATOMIC_RELAXED, __HIP_MEMORY_SCOPE_AGENT); }
__device__ __forceinline__ unsigned xb_add(unsigned* p, unsigned v) { return __hip_atomic_fetch_add(p, v, __ATOMIC_RELAXED, __HIP_MEMORY_SCOPE_AGENT); }
__device__ __forceinline__ unsigned xb_xcc_id() { return (unsigned)__builtin_amdgcn_s_getreg((3 << 11) | 20) & 0xFu; }
#define XB_SPIN(cond, bar) do { unsigned _sp = 0; while (cond) { __builtin_amdgcn_s_sleep(1); \
    if ((++_sp & 255u) == 0u) { if (xb_ld(&(bar)[XB_TMO])) break; if (_sp > XB_SPIN_CAP) { atomicAdd(&(bar)[XB_TMO], 1u); break; } } } } while (0)
struct XcdBarrier { unsigned* bar; unsigned x; volatile LAS unsigned* st; };
__device__ __forceinline__ XcdBarrier xcd_barrier_post(unsigned* bar, volatile LAS unsigned* st) {
    XcdBarrier b; b.bar = bar; b.x = xb_xcc_id(); b.st = st;
    if (threadIdx.x == 0) (void)xb_add(&bar[XB_XCNT(b.x)], 1u);
    return b;
}
__device__ __forceinline__ void xcd_barrier_complete(unsigned* bar, unsigned x, unsigned& nloc, unsigned& nx) {
    const unsigned G = gridDim.x * gridDim.y * gridDim.z;
    unsigned sum, cnt, mine, sp = 0u;
    for (;;) {
        sum = 0u; cnt = 0u; mine = 0u;
#pragma unroll
        for (unsigned j = 0; j < 16; ++j) { const unsigned c = xb_ld(&bar[XB_XCNT(j)]); sum += c; cnt += (c > 0u) ? 1u : 0u; mine = (j == x) ? c : mine; }
        if (sum == G) break;
        __builtin_amdgcn_s_sleep(1);
        if ((++sp & 255u) == 0u) { if (xb_ld(&bar[XB_TMO])) break; if (sp > XB_SPIN_CAP) { atomicAdd(&bar[XB_TMO], 1u); break; } }
    }
    nloc = mine > 0u ? mine : 1u; nx = cnt > 0u ? cnt : 1u;
}
__device__ __forceinline__ void xcd_barrier(const XcdBarrier& b, const int tid) {
    asm volatile("s_waitcnt vmcnt(0)" ::: "memory");
    __syncthreads();
    if (tid == 0) {
        unsigned* bar = b.bar;
        __builtin_amdgcn_s_waitcnt(0);
        unsigned nloc = b.st[0], nx = b.st[1];
        if (nloc == 0u) { xcd_barrier_complete(bar, b.x, nloc, nx); b.st[0] = nloc; b.st[1] = nx; }
        const unsigned old = xb_add(&bar[XB_XSUB(b.x)], 1u);
        const unsigned gen = old / nloc;
        if (old + 1u == (gen + 1u) * nloc) {
            __builtin_amdgcn_fence(__ATOMIC_RELEASE, "agent");
            asm volatile("s_waitcnt vmcnt(0)" ::: "memory");
            const unsigned og = xb_add(&bar[XB_TOP], 1u);
            const unsigned tg = og / nx;
            if (og + 1u == (tg + 1u) * nx) xb_add(&bar[XB_TOPGEN], 1u);
            else XB_SPIN(xb_ld(&bar[XB_TOPGEN]) == tg, bar);
            __builtin_amdgcn_fence(__ATOMIC_ACQUIRE, "agent");
            xb_add(&bar[XB_XGEN(b.x)], 1u);
            asm volatile("s_waitcnt vmcnt(0)" ::: "memory");
        } else {
            XB_SPIN(xb_ld(&bar[XB_XGEN(b.x)]) == gen, bar);
            __builtin_amdgcn_fence(__ATOMIC_ACQUIRE, "agent");
            asm volatile("s_waitcnt vmcnt(0)" ::: "memory");
        }
    }
    __syncthreads();
}

struct Frame { LAS unsigned char* lds; int tid, lane, wave, bid, G; const float* const* in; GAS float* out; GAS unsigned char* ws; };
#define IN_(k) ((const float*)(const GAS float*)F.in[(k)])
#define F_x IN_(0)
#define F_c IN_(1)
#define F_ctx IN_(2)
#define F_c_ctx IN_(3)
#define F_norm1 IN_(4)
#define F_norm2 IN_(5)
#define F_w_ada IN_(6)
#define F_b_ada IN_(7)
#define F_w_in IN_(8)
#define F_sink IN_(9)
#define F_mla_q_norm IN_(10)
#define F_w_uq IN_(11)
#define F_mla_kv_norm IN_(12)
#define F_w_ukv IN_(13)
#define F_lq1 IN_(14)
#define F_lk1 IN_(15)
#define F_lq2 IN_(16)
#define F_lk2 IN_(17)
#define F_diff_norm IN_(18)
#define F_w_out IN_(19)
#define F_w_router IN_(20)
#define F_w_gate IN_(21)
#define F_w_up IN_(22)
#define F_w_down IN_(23)
#define F_final_norm IN_(24)
#define F_MOD ((float*)(GAS float*)(F.ws + WS_MOD))
#define F_ROPE ((float*)(GAS float*)(F.ws + WS_ROPE))
#define F_RSQ ((float*)(GAS float*)(F.ws + WS_RSQ))
#define F_AFF ((float*)(GAS float*)(F.ws + WS_AFF))
#define F_INV ((int*)(GAS int*)(F.ws + WS_INV))
#define F_STOK ((int*)(GAS int*)(F.ws + WS_STOK))
#define F_SGATE ((float*)(GAS float*)(F.ws + WS_SGATE))
#define F_X ((float*)(GAS float*)(F.ws + WS_X))
#define F_XB ((bf16*)(GAS bf16*)(F.ws + WS_X))
#define F_ACT ((bf16*)(GAS bf16*)(F.ws + WS_ACT))
#define F_P ((bf16*)(GAS bf16*)(F.ws + WS_P))
#define F_Y ((bf16*)(GAS bf16*)(F.ws + WS_Y))
#define F_QKVM ((bf16*)(GAS bf16*)(F.ws + WS_QKVM))
#define F_O ((bf16*)(GAS bf16*)(F.ws + WS_O))
#define F_HID ((bf16*)(GAS bf16*)(F.ws + WS_HID))
#define F_WB ((bf16*)(GAS bf16*)(F.ws + WS_W))

__device__ __forceinline__ int rot64(int dp) { const int p = dp >> 1, half = dp & 1, axis = p >> 4, f = p & 15; return axis * 32 + half * 16 + f; }
__device__ __forceinline__ int rot32(int dp) { const int p = dp >> 1, half = dp & 1, axis = p >> 3, f = p & 7; return axis * 16 + half * 8 + f; }
__device__ __forceinline__ int src_col_in(int n) {
    if (n >= INW) return -1;
    if (n < P_AV) return (n & ~63) + rot64(n & 63);
    if (n >= P_KR && n < P_DV) return (n & ~31) + rot32(n & 31);
    return n;
}
__device__ __forceinline__ void prep_tile(const float* src, int N, int k0, const float* kscale, bf16* dst, int ldd, LAS float* scr, int lane) {
    float v[32];
#pragma unroll
    for (int i = 0; i < 32; ++i) { const int kk = 2 * i + (lane >> 5); v[i] = src ? src[(size_t)(k0 + kk) * N] : 0.f; }
    if (kscale) {
#pragma unroll
        for (int i = 0; i < 32; ++i) v[i] *= kscale[k0 + 2 * i + (lane >> 5)]; }
#pragma unroll
    for (int i = 0; i < 32; ++i) scr[(2 * i + (lane >> 5)) * 33 + (lane & 31)] = v[i];
    LDS_WAIT();
    const int c = lane & 7;
#pragma unroll
    for (int j = 0; j < 4; ++j) { const int n = (lane >> 3) + 8 * j; const LAS float* s = scr + (8 * c) * 33 + n;
        u32x4 o; o.x = pk2(s[0], s[33]); o.y = pk2(s[66], s[99]); o.z = pk2(s[132], s[165]); o.w = pk2(s[198], s[231]);
        *(u32x4*)(dst + (size_t)n * ldd + 8 * c) = o; }
    LDS_WAIT();
}
constexpr int PI_IN = 16 * 64, PI_UP = 6 * 32, PI_OUT = 16 * 32, PI_GU = NE * 16 * 32, PI_DN = NE * 8 * 32, PI_LAYER = PI_IN + PI_UP + PI_OUT + PI_GU + PI_DN;
#ifndef BG_PREP
#define BG_PREP 0
#ifndef MOE_PF
#define MOE_PF 0
#endif
#endif
__device__ __forceinline__ void prep_layer(Frame& F, const int l, const int worker, const int nworkers) {
    const int lane = F.lane, wave = F.wave;
    LAS float* scr = (LAS float*)(F.lds + 57344 + wave * 8448);
    for (int it = worker; it < PI_LAYER; it += nworkers) {
        int r = it; bf16* wl = F_WB + (size_t)l * W_LAYER;
        const int nl = lane & 31;
        if (r < PI_IN) { const int kb = r / 64, nb = r % 64, n = nb * 32 + nl, sc = src_col_in(n);
            prep_tile(sc >= 0 ? F_w_in + (size_t)l * D * INW + sc : nullptr, INW, kb * 64, nullptr, wl + W_IN + (size_t)(nb * 32) * D + kb * 64, D, scr, lane); continue; } r -= PI_IN;
        if (r < PI_UP) { const int kb = r / 32, nb = r % 32, n = nb * 32 + nl, k0 = kb * 64; const float* src = nullptr; const float* ks = nullptr; int N = 384, ksrc = k0;
            if (n < 384 && k0 < 256) { const int h = n / 96, j = n % 96; const int sc = j < 64 ? n : h * 96 + 64 + rot32(j - 64); src = F_w_uq + (size_t)l * 256 * 384 + sc; ks = F_mla_q_norm + l * 256; N = 384; }
            else if (n >= 512 && k0 >= 256) { src = F_w_ukv + (size_t)l * 128 * 512 + (n - 512); ks = F_mla_kv_norm + l * 128; N = 512; ksrc = k0 - 256; }
            { float v[32];
#pragma unroll
              for (int i = 0; i < 32; ++i) { const int kk = 2 * i + (lane >> 5); v[i] = src ? src[(size_t)(ksrc + kk) * N] * ks[ksrc + kk] : 0.f; }
#pragma unroll
              for (int i = 0; i < 32; ++i) scr[(2 * i + (lane >> 5)) * 33 + (lane & 31)] = v[i];
              LDS_WAIT();
              const int c = lane & 7; bf16* dst = wl + W_UP + (size_t)(nb * 32) * UPK + k0;
#pragma unroll
              for (int j = 0; j < 4; ++j) { const int nn = (lane >> 3) + 8 * j; const LAS float* s = scr + (8 * c) * 33 + nn;
                  u32x4 o; o.x = pk2(s[0], s[33]); o.y = pk2(s[66], s[99]); o.z = pk2(s[132], s[165]); o.w = pk2(s[198], s[231]);
                  *(u32x4*)(dst + (size_t)nn * UPK + 8 * c) = o; }
              LDS_WAIT(); }
            continue; } r -= PI_UP;
        if (r < PI_OUT) { const int kb = r / 32, nb = r % 32;
            prep_tile(F_w_out + (size_t)l * D * D + nb * 32 + nl, D, kb * 64, nullptr, wl + W_OUT + (size_t)(nb * 32) * D + kb * 64, D, scr, lane); continue; } r -= PI_OUT;
        if (r < PI_GU) { const int e = r / 512, q = r % 512, kb = q / 32, nb = q % 32, n = nb * 32 + nl, f = (n >> 3) * 4 + (n & 3);
            const float* src = ((n & 4) ? F_w_up : F_w_gate) + ((size_t)l * NE + e) * D * DE + f;
            prep_tile(src, DE, kb * 64, nullptr, wl + W_GU + (size_t)e * 1024 * 1024 + (size_t)(nb * 32) * D + kb * 64, D, scr, lane); continue; } r -= PI_GU;
        { const int e = r / 256, q = r % 256, kb = q / 32, nb = q % 32;
            prep_tile(F_w_down + ((size_t)l * NE + e) * DE * D + nb * 32 + nl, D, kb * 64, nullptr, wl + W_DN + (size_t)e * 1024 * 512 + (size_t)(nb * 32) * DE + kb * 64, DE, scr, lane); }
    }
}

__device__ __forceinline__ void p0_phase(Frame& F) {
    const int tid = F.tid, lane = F.lane, wave = F.wave;
    {
        LAS float* sl = (LAS float*)F.lds;
        LAS float* red = (LAS float*)(F.lds + 36864);
        for (int i = tid; i < 9 * 1024; i += 512) { const float v = i < 8 * 1024 ? F_c[i] : F_c_ctx[i - 8 * 1024]; sl[i] = siluf(v); }
        __syncthreads();
        for (int it = F.bid; it < DEPTH * 96; it += F.G) {
            const int l = it / 96, cg = it % 96, col = cg * 64 + lane;
            float acc[9];
#pragma unroll
            for (int r = 0; r < 9; ++r) acc[r] = 0.f;
            const float* w = F_w_ada + (size_t)l * D * 6144 + (size_t)(wave * 128) * 6144 + col;
#pragma unroll 16
            for (int k = 0; k < 128; ++k) { const float wv = w[(size_t)k * 6144];
#pragma unroll
                for (int r = 0; r < 9; ++r) acc[r] += sl[r * 1024 + wave * 128 + k] * wv; }
#pragma unroll
            for (int r = 0; r < 9; ++r) red[(wave * 9 + r) * 64 + lane] = acc[r];
            __syncthreads();
            for (int o = tid; o < 576; o += 512) { const int r = o >> 6, cc = o & 63; float s = 0.f;
#pragma unroll
                for (int w8 = 0; w8 < 8; ++w8) s += red[(w8 * 9 + r) * 64 + cc];
                F_MOD[((size_t)l * 9 + r) * 6144 + cg * 64 + cc] = s + F_b_ada[l * 6144 + cg * 64 + cc]; }
            __syncthreads();
        }
    }
    const int gw = F.bid * NWAVES + wave, NGW = F.G * NWAVES;
    { const size_t n4 = (size_t)R * D / 4, nl4 = (size_t)RL * D / 4;
      for (size_t i = (size_t)F.bid * 512 + tid; i < n4; i += (size_t)F.G * 512) { const f32x4 v = i < nl4 ? ((const f32x4*)F_x)[i] : ((const f32x4*)F_ctx)[i - nl4];
#if X_BF16
          u32x2 w; w.x = pk2(v.x, v.y); w.y = pk2(v.z, v.w); ((u32x2*)F_XB)[i] = w; } }
#else
          ((f32x4*)F_X)[i] = v; } }
#endif
    for (int i = F.bid * 512 + tid; i < T * 48; i += F.G * 512) {
        const int t = i / 48, j = i % 48; int axis, f, nf;
        if (j < 32) { axis = j >> 4; f = j & 15; nf = 16; } else { axis = (j - 32) >> 3; f = (j - 32) & 7; nf = 8; }
        const float inv = exp2f(-(float)f / (float)nf * 13.287712379549449f);
        const float ang = (float)(axis == 0 ? (t >> 6) : (t & 63)) * inv;
        const float cv = cosf(ang), sv = sinf(ang);
        if (j < 32) { F_ROPE[t * 32 + j] = cv; F_ROPE[T * 32 + t * 32 + j] = sv; } else { F_ROPE[T * 64 + t * 16 + j - 32] = cv; F_ROPE[T * 64 + T * 16 + t * 16 + j - 32] = sv; }
    }
    for (int l = 0; l < (BG_PREP ? 1 : DEPTH); ++l) prep_layer(F, l, gw, NGW);
}

#ifndef PROBE_NOROUTER
#define PROBE_NOROUTER 0
#endif
#define half_swap_add(keepv, sendv, off) ((keepv) + shx((sendv), (off), lane))
__device__ __forceinline__ void norm_phase(Frame& F, int l, int mode, int nrows, const float keep) {
    const int lane = F.lane, gw = F.bid * NWAVES + F.wave, NGW = F.G * NWAVES;
    LAS float* wrT = (LAS float*)F.lds;
    if (mode == 1) {
        const float* wr = F_w_router + (size_t)l * D * NE;
        for (int i = F.tid; i < D * NE; i += 512) wrT[(i & 15) * 1028 + (i >> 4)] = wr[i];
        __syncthreads();
    }
    const float* gain = mode == 0 ? F_norm1 + (size_t)l * D : (mode == 1 ? F_norm2 + (size_t)l * D : F_final_norm);
    const bool comb = mode != 1 && l > 0;
    f32x4 vn[2][4];
#if X_BF16
#define NORM_LOAD(dst, rr0) do { _Pragma("unroll") for (int q = 0; q < 2; ++q) _Pragma("unroll") for (int j = 0; j < 4; ++j) { const u32x2 w_ = ((const u32x2*)(F_XB + (size_t)((rr0) + q) * D))[lane + 64 * j]; \
        dst[q][j] = (f32x4){bf2f(w_.x & 0xffffu), bf2f(w_.x >> 16), bf2f(w_.y & 0xffffu), bf2f(w_.y >> 16)}; } } while (0)
#else
#define NORM_LOAD(dst, rr0) do { _Pragma("unroll") for (int q = 0; q < 2; ++q) _Pragma("unroll") for (int j = 0; j < 4; ++j) dst[q][j] = ((const f32x4*)(F_X + (size_t)((rr0) + q) * D))[lane + 64 * j]; } while (0)
#endif
    if (gw * 2 < nrows) NORM_LOAD(vn, gw * 2);
    for (int r0 = gw * 2; r0 < nrows; r0 += NGW * 2) {
        const int mb = r0 < RL ? r0 / T : 8;
        f32x4 v[2][4];
#pragma unroll
        for (int q = 0; q < 2; ++q)
#pragma unroll
            for (int j = 0; j < 4; ++j) v[q][j] = vn[q][j];
        if (r0 + NGW * 2 < nrows) NORM_LOAD(vn, r0 + NGW * 2);
        if (comb) {
            const float* g2 = F_MOD + ((size_t)(l - 1) * 9 + mb) * 6144 + 5120;
            const int myinv = lane < 2 * NE ? F_INV[(size_t)r0 * NE + lane] : -1;
            f32x4 s[2][4];
#pragma unroll
            for (int q = 0; q < 2; ++q)
#pragma unroll
                for (int j = 0; j < 4; ++j) s[q][j] = (f32x4){0.f, 0.f, 0.f, 0.f};
            for (int e = 0; e < NE; ++e) {
#pragma unroll
                for (int q = 0; q < 2; ++q) { const int sl = shi(myinv, q * NE + e);
                    if (sl >= 0) { const bf16* yr = F_Y + (size_t)sl * D;
#pragma unroll
                        for (int j = 0; j < 4; ++j) { const u32x2 w = ((const u32x2*)yr)[lane + 64 * j];
                            s[q][j].x += bf2f(w.x & 0xffff); s[q][j].y += bf2f(w.x >> 16); s[q][j].z += bf2f(w.y & 0xffff); s[q][j].w += bf2f(w.y >> 16); } } } }
#pragma unroll
            for (int j = 0; j < 4; ++j) { const f32x4 g = ((const f32x4*)g2)[lane + 64 * j];
#pragma unroll
                for (int q = 0; q < 2; ++q) { v[q][j] += g * s[q][j] * keep;
#if X_BF16
                    u32x2 w; w.x = pk2(v[q][j].x, v[q][j].y); w.y = pk2(v[q][j].z, v[q][j].w); ((u32x2*)(F_XB + (size_t)(r0 + q) * D))[lane + 64 * j] = w;
#else
                    ((f32x4*)(F_X + (size_t)(r0 + q) * D))[lane + 64 * j] = v[q][j];
#endif
                } }
        }
        float ss0 = 0.f, ss1 = 0.f;
#pragma unroll
        for (int j = 0; j < 4; ++j) { ss0 += (v[0][j].x * v[0][j].x + v[0][j].y * v[0][j].y) + (v[0][j].z * v[0][j].z + v[0][j].w * v[0][j].w);
                                      ss1 += (v[1][j].x * v[1][j].x + v[1][j].y * v[1][j].y) + (v[1][j].z * v[1][j].z + v[1][j].w * v[1][j].w); }
#pragma unroll
        for (int o = 1; o < 64; o <<= 1) { ss0 += shx(ss0, o, lane); ss1 += shx(ss1, o, lane); }
        const float rs[2] = {1.0f / sqrtf(ss0 * (1.f / D) + EPS), 1.0f / sqrtf(ss1 * (1.f / D) + EPS)};
        if (mode == 2) {
#pragma unroll
            for (int j = 0; j < 4; ++j) { const f32x4 g = ((const f32x4*)gain)[lane + 64 * j];
#pragma unroll
                for (int q = 0; q < 2; ++q) ((f32x4*)((float*)F.out + (size_t)(r0 + q) * D))[lane + 64 * j] = v[q][j] * rs[q] * g; }
        } else {
            const float* md = F_MOD + ((size_t)l * 9 + mb) * 6144 + (mode == 0 ? 0 : 3072);
#pragma unroll
            for (int j = 0; j < 4; ++j) { const f32x4 g = ((const f32x4*)gain)[lane + 64 * j];
                const f32x4 sh = ((const f32x4*)md)[lane + 64 * j], sc = ((const f32x4*)(md + 1024))[lane + 64 * j];
#pragma unroll
                for (int q = 0; q < 2; ++q) { v[q][j] = v[q][j] * rs[q] * g * (sc + 1.0f) + sh;
                    u32x2 w; w.x = pk2(v[q][j].x, v[q][j].y); w.y = pk2(v[q][j].z, v[q][j].w);
                    ((u32x2*)(F_ACT + (size_t)(r0 + q) * D))[lane + 64 * j] = w; } }
            if (mode == 1 && !(PROBE_NOROUTER && keep == 0.f)) {
                float a[2][NE];
                typedef float f32x2r __attribute__((ext_vector_type(2)));
#pragma unroll
                for (int e = 0; e < NE; ++e) { f32x2r p0 = {0.f, 0.f}, p1 = {0.f, 0.f};
#pragma unroll
                    for (int j = 0; j < 4; ++j) { const f32x4 w = *(const LAS f32x4*)(wrT + e * 1028 + 256 * j + 4 * lane);
                        const f32x2r wl = {w.x, w.y}, wh = {w.z, w.w};
                        p0 = __builtin_elementwise_fma((f32x2r){v[0][j].x, v[0][j].y}, wl, p0); p0 = __builtin_elementwise_fma((f32x2r){v[0][j].z, v[0][j].w}, wh, p0);
                        p1 = __builtin_elementwise_fma((f32x2r){v[1][j].x, v[1][j].y}, wl, p1); p1 = __builtin_elementwise_fma((f32x2r){v[1][j].z, v[1][j].w}, wh, p1); }
                    a[0][e] = p0.x + p0.y; a[1][e] = p1.x + p1.y; if ((e & 1) == 1) __builtin_amdgcn_sched_barrier(0); }
                float b16[NE];
#pragma unroll
                for (int e = 0; e < NE; ++e) { const bool up = lane >= 32; b16[e] = half_swap_add(up ? a[1][e] : a[0][e], up ? a[0][e] : a[1][e], 32); }
                float b8[8];
#pragma unroll
                for (int e = 0; e < 8; ++e) { const bool up = (lane & 16) != 0; b8[e] = half_swap_add(up ? b16[8 + e] : b16[e], up ? b16[e] : b16[8 + e], 16); }
                float b4[4];
#pragma unroll
                for (int e = 0; e < 4; ++e) { const bool up = (lane & 8) != 0; b4[e] = half_swap_add(up ? b8[4 + e] : b8[e], up ? b8[e] : b8[4 + e], 8); }
                float b2[2];
#pragma unroll
                for (int e = 0; e < 2; ++e) { const bool up = (lane & 4) != 0; b2[e] = half_swap_add(up ? b4[2 + e] : b4[e], up ? b4[e] : b4[2 + e], 4); }
                float lg; { const bool up = (lane & 2) != 0; lg = half_swap_add(up ? b2[1] : b2[0], up ? b2[0] : b2[1], 2); }
                lg += shx(lg, 1, lane);
                float mx = lg;
#pragma unroll
                for (int o = 2; o < 32; o <<= 1) mx = fmaxf(mx, shx(mx, o, lane));
                const float ex = __expf(lg - mx); float sum = ex;
#pragma unroll
                for (int o = 2; o < 32; o <<= 1) sum += shx(sum, o, lane);
                const int eidx = ((lane >> 4) & 1) * 8 + ((lane >> 3) & 1) * 4 + ((lane >> 2) & 1) * 2 + ((lane >> 1) & 1);
                if ((lane & 1) == 0) F_AFF[(size_t)(r0 + (lane >> 5)) * NE + eidx] = ex / sum;
            }
        }
    }
}

#undef NORM_LOAD
__device__ __forceinline__ void topk_phase(Frame& F, int nsets) {
    LAS unsigned* cnt = (LAS unsigned*)F.lds;
    const int tid = F.tid, lane = F.lane, wave = F.wave;
    for (int it = F.bid; it < nsets * NE; it += F.G) {
        const int set = it / NE, e = it % NE; const bool lat = set < 8; const int b = lat ? set : set - 8;
        const int n = lat ? T : LC, cap = lat ? CAPL : CAPC, row0 = lat ? b * T : RL + b * LC, slot0 = e * SLOTS_E + (lat ? b * CAPL : NB * CAPL + b * CAPC);
        unsigned v[4];
#pragma unroll
        for (int q = 0; q < 4; ++q) { const int idx = 4 * tid + q; v[q] = idx < n ? __builtin_bit_cast(unsigned, F_AFF[(size_t)(row0 + idx) * NE + e]) : 0u; }
        unsigned prefix = 0u; int par = 0;
        for (int bit = 30; bit >= 0; --bit) {
            const unsigned cand = prefix | (1u << bit);
            unsigned c = 0;
#pragma unroll
            for (int q = 0; q < 4; ++q) c += (unsigned)__popcll(__ballot(v[q] >= cand));
            if (lane == 0) cnt[par * 8 + wave] = c;
            __syncthreads();
            unsigned tot = 0;
#pragma unroll
            for (int w = 0; w < 8; ++w) tot += cnt[par * 8 + w];
            if (tot >= (unsigned)cap) prefix = cand;
            par ^= 1;
        }
        unsigned g4 = 0, e4 = 0;
#pragma unroll
        for (int q = 0; q < 4; ++q) { g4 += v[q] > prefix ? 1u : 0u; e4 += v[q] == prefix ? 1u : 0u; }
        unsigned pk = g4 | (e4 << 16), inc = pk;
#pragma unroll
        for (int o = 1; o < 64; o <<= 1) { const unsigned t = (unsigned)shi((int)inc, lane - o); if (lane >= o) inc += t; }
        __syncthreads();
        if (lane == 63) cnt[16 + wave] = inc;
        __syncthreads();
        unsigned base = 0, total = 0;
#pragma unroll
        for (int w = 0; w < 8; ++w) { const unsigned t = cnt[16 + w]; total += t; if (w < wave) base += t; }
        const unsigned excl = base + inc - pk;
        unsigned gpre = excl & 0xffffu, epre = excl >> 16; const unsigned need = (unsigned)cap - (total & 0xffffu);
#pragma unroll
        for (int q = 0; q < 4; ++q) { const int idx = 4 * tid + q;
            if (idx < n) { const bool isg = v[q] > prefix, ise = v[q] == prefix; const bool sel = isg || (ise && epre < need);
                const int slot = slot0 + (int)(gpre + (epre < need ? epre : need));
                if (sel) { F_STOK[slot] = row0 + idx; F_SGATE[slot] = __builtin_bit_cast(float, v[q]); }
                F_INV[(size_t)(row0 + idx) * NE + e] = sel ? slot : -1;
                gpre += isg ? 1u : 0u; epre += ise ? 1u : 0u; } }
        __syncthreads();
    }
}

#ifndef ATT_EXTRA
#define ATT_EXTRA 0
#define ATT_EXTRA_TYPE 0
#endif
#ifndef ATT_LATE_DMA
#define ATT_LATE_DMA 0
#endif
#ifndef ATT_STAGGER
#define ATT_STAGGER 1
#endif
#ifndef ATT_XVAR
#define ATT_XVAR 0
#endif
#ifndef ATT_XSTEPS
#define ATT_XSTEPS 4
#endif
namespace att {
typedef short s16x4 __attribute__((ext_vector_type(4)));
typedef float f32x2_t __attribute__((ext_vector_type(2)));
typedef __bf16 bf16x2_t __attribute__((ext_vector_type(2)));
constexpr int L_K = 0, KBUF = 16384, L_V = 2 * KBUF, VBUF = 8192, L_WS = L_V + 2 * VBUF, L_OST = L_WS + 8 * 256, L_END = L_OST + 8 * 4096;
#define ATT_SBAR() __builtin_amdgcn_sched_barrier(0)
#define ATT_SGB(mask, n) __builtin_amdgcn_sched_group_barrier(mask, n, 0)
__device__ __forceinline__ int crow(int r, int hi) { return (r & 3) + 8 * (r >> 2) + 4 * hi; }
__device__ __forceinline__ unsigned cvtpk(float lo, float hi) { f32x2_t v = {lo, hi}; bf16x2_t b = __builtin_convertvector(v, bf16x2_t); return __builtin_bit_cast(unsigned, b); }
__device__ __forceinline__ int v_st(int k, int c) { const int kk = k; return ((kk >> 3) * 2 + (c >> 5)) * 512 + ((kk & 7) * 32 + (c & 31)) * 2; }
__device__ __forceinline__ int v_rd_base(int lane) { return ((lane & 3) << 3) | (((lane >> 2) & 3) << 6) | (((lane >> 4) & 1) << 5) | (((lane >> 5) & 1) << 8); }
typedef short v4i16_t __attribute__((ext_vector_type(4)));
template <int OFF> __device__ __forceinline__ s16x4 tr_read(int vb) { s16x4 r; asm volatile("ds_read_b64_tr_b16 %0, %1 offset:%2" : "=&v"(r) : "v"(vb), "i"(OFF) : "memory"); return r; }
struct VFrag { s16x4 l0, h0, l1, h1, l2, h2, l3, h3; };
template <int D0> __device__ __forceinline__ void vread(VFrag& f, int vb) {
    f.l0 = tr_read<D0 * 512 + 0 * 2048>(vb); f.h0 = tr_read<D0 * 512 + 0 * 2048 + 1024>(vb); f.l1 = tr_read<D0 * 512 + 1 * 2048>(vb); f.h1 = tr_read<D0 * 512 + 1 * 2048 + 1024>(vb);
    f.l2 = tr_read<D0 * 512 + 2 * 2048>(vb); f.h2 = tr_read<D0 * 512 + 2 * 2048 + 1024>(vb); f.l3 = tr_read<D0 * 512 + 3 * 2048>(vb); f.h3 = tr_read<D0 * 512 + 3 * 2048 + 1024>(vb);
}
__device__ __forceinline__ void pv_mma(f32x16& od, const VFrag& f, bf16x8 pa0, bf16x8 pa1, bf16x8 pa2, bf16x8 pa3) {
#define ATT_PK(L, H) (bf16x8){L[0], L[1], L[2], L[3], H[0], H[1], H[2], H[3]}
    od = __builtin_amdgcn_mfma_f32_32x32x16_bf16(pa0, ATT_PK(f.l0, f.h0), od, 0, 0, 0);
    od = __builtin_amdgcn_mfma_f32_32x32x16_bf16(pa1, ATT_PK(f.l1, f.h1), od, 0, 0, 0);
    od = __builtin_amdgcn_mfma_f32_32x32x16_bf16(pa2, ATT_PK(f.l2, f.h2), od, 0, 0, 0);
    od = __builtin_amdgcn_mfma_f32_32x32x16_bf16(pa3, ATT_PK(f.l3, f.h3), od, 0, 0, 0);
#undef ATT_PK
}
template <int D0> __device__ __forceinline__ void pv_one(f32x16& od, int vb, bf16x8 pa0, bf16x8 pa1, bf16x8 pa2, bf16x8 pa3) {
    VFrag f; vread<D0>(f, vb); asm volatile("s_waitcnt lgkmcnt(0)" ::: "memory"); ATT_SBAR(); pv_mma(od, f, pa0, pa1, pa2, pa3);
}
struct Tensors { const bf16* P; const bf16* QKVM; bf16* O; const float* sink; const float* dnorm; float lam, lam_init; int l; };

constexpr float THR = 8.f;
__device__ __forceinline__ float rowmax32(const f32x16& p0, const f32x16& p1) {
    float a = fmaxf(fmaxf(p0[0], p0[1]), p1[0]), b = fmaxf(fmaxf(p0[2], p0[3]), p1[1]); a = fmaxf(fmaxf(a, p1[2]), p1[3]);
#pragma unroll
    for (int r = 4; r < 16; r += 4) { a = fmaxf(fmaxf(a, p0[r]), p0[r + 1]); b = fmaxf(fmaxf(b, p0[r + 2]), p0[r + 3]); a = fmaxf(fmaxf(a, p1[r]), p1[r + 1]); b = fmaxf(fmaxf(b, p1[r + 2]), p1[r + 3]); }
    float m = fmaxf(a, b);
    auto rr = __builtin_amdgcn_permlane32_swap(__float_as_uint(m), __float_as_uint(m), false, false);
    return fmaxf(__uint_as_float(rr[0]), __uint_as_float(rr[1]));
}
__device__ __forceinline__ void partialSM(f32x16& p0, f32x16& p1, const float rm, float& mhat, f32x16& negm, float& alpha) {
    alpha = 1.f;
    if (__builtin_expect(__any(rm > THR), 0)) {
        const float dl = fmaxf(rm, 0.f); mhat += dl;
#pragma unroll
        for (int r = 0; r < 16; ++r) { p0[r] -= dl; p1[r] -= dl; }
#pragma unroll
        for (int r = 0; r < 16; ++r) negm[r] = -mhat;
        asm volatile("" : "+v"(negm));
        alpha = __builtin_amdgcn_exp2f(-dl);
    }
}
__device__ __forceinline__ void finishSM(f32x16& p0, f32x16& p1, const float alpha, float& l_reg, bf16x8& pa0, bf16x8& pa1, bf16x8& pa2, bf16x8& pa3) {
#pragma unroll
    for (int r = 0; r < 16; ++r) { p0[r] = __builtin_amdgcn_exp2f(p0[r]); p1[r] = __builtin_amdgcn_exp2f(p1[r]); }
    float ps = 0.f, pt = 0.f;
#pragma unroll
    for (int r = 0; r < 16; ++r) { ps += p0[r]; pt += p1[r]; }
    l_reg = l_reg * alpha + (ps + pt);
#define ATT_PK8(P, BASE, OUT) do { u32x4 w = {cvtpk(P[BASE + 0], P[BASE + 1]), cvtpk(P[BASE + 2], P[BASE + 3]), cvtpk(P[BASE + 4], P[BASE + 5]), cvtpk(P[BASE + 6], P[BASE + 7])}; OUT = __builtin_bit_cast(bf16x8, w); } while (0)
    ATT_PK8(p0, 0, pa0); ATT_PK8(p0, 8, pa1); ATT_PK8(p1, 0, pa2); ATT_PK8(p1, 8, pa3);
#undef ATT_PK8
}
template <int ROWB> __device__ __forceinline__ int kswz(int row, int cb) { return row * ROWB + (ROWB == 128 ? (cb ^ (((row >> 1) & 7) << 4)) : (cb ^ ((row & 15) << 4))); }
template <int NB, int ROWB, int CB0, int D00> __device__ __forceinline__ void kread(bf16x8 (&kf)[2 * NB], const LAS unsigned char* Kb, int r32, int hi) {
#pragma unroll
    for (int d = 0; d < NB; ++d) { const int cb = CB0 + ((D00 + d) * 16 + hi * 8) * 2;
        kf[2 * d] = *(const LAS bf16x8*)(Kb + kswz<ROWB>(r32, cb)); kf[2 * d + 1] = *(const LAS bf16x8*)(Kb + kswz<ROWB>(32 + r32, cb)); }
}
template <int NB, int D00> __device__ __forceinline__ void kmma(f32x16& p0, f32x16& p1, const bf16x8 (&kf)[2 * NB], const bf16x8* qr, const f32x16& negm) {
#pragma unroll
    for (int d = 0; d < NB; ++d) {
        if (D00 + d == 0) { p0 = __builtin_amdgcn_mfma_f32_32x32x16_bf16(kf[0], qr[0], negm, 0, 0, 0); p1 = __builtin_amdgcn_mfma_f32_32x32x16_bf16(kf[1], qr[0], negm, 0, 0, 0); }
        else { p0 = __builtin_amdgcn_mfma_f32_32x32x16_bf16(kf[2 * d], qr[D00 + d], p0, 0, 0, 0); p1 = __builtin_amdgcn_mfma_f32_32x32x16_bf16(kf[2 * d + 1], qr[D00 + d], p1, 0, 0, 0); } }
}
template <int NKS, int ROWB, int CB0> __device__ __forceinline__ void qkt2(f32x16& p0, f32x16& p1, const LAS unsigned char* Kb, const bf16x8* qr, const f32x16& negm, int r32, int hi) {
    constexpr int N1 = NKS > 4 ? 3 : NKS, N2 = NKS - N1;
    bf16x8 ka[2 * N1]; kread<N1, ROWB, CB0, 0>(ka, Kb, r32, hi);
    if constexpr (N2 > 0) { bf16x8 kb[2 * N2]; kread<N2, ROWB, CB0, N1>(kb, Kb, r32, hi);
        kmma<N1, 0>(p0, p1, ka, qr, negm); kmma<N2, N1>(p0, p1, kb, qr, negm); }
    else kmma<N1, 0>(p0, p1, ka, qr, negm);
}

template <int TYPE> struct Ring { static constexpr int KSLOT = TYPE == 1 ? 16384 : 8192, VSLOT = 8192, L_K = 0, L_V = 3 * KSLOT, L_WS = L_V + 4 * VSLOT, L_OST = L_WS + 2048; };
template <int TYPE, int CB0> __device__ __forceinline__ void flash_pass(const Tensors& Tn, LAS unsigned char* lds, const int tid, const int b, const int h, const bool lat, const int q0, const int wrow, const int var, const bf16x8* qr,
                                                                        f32x16 (&o)[2], float& l_out, float& m_out) {
    constexpr int NKS = TYPE == 0 ? 4 : (TYPE == 1 ? 6 : 2);
    constexpr int ROWB = TYPE == 1 ? 256 : 128;
    typedef Ring<TYPE> RG;
    const int lane = tid & 63, wid = __builtin_amdgcn_readfirstlane(tid >> 6), r32 = lane & 31, hi = lane >> 5;
    LAS float* al_l = (LAS float*)(lds + RG::L_WS) + wid * 64;
    const int kvh = h >> 2;
    const bf16* Kp = TYPE == 0 ? Tn.P + P_AK + kvh * 64 : (TYPE == 1 ? Tn.QKVM + 512 + h * 128 : Tn.P + P_DK + h * 64);
    const bf16* Vp = TYPE == 0 ? Tn.P + P_AV + kvh * 64 : (TYPE == 1 ? Tn.QKVM + 512 + h * 128 + 64 : Tn.P + P_DV + h * 64);
    constexpr int KPITCH = TYPE == 1 ? LDM : LDP;
    int kl0 = 0, nloc = 0;
    if (lat) { if (TYPE == 0) { kl0 = q0 - 128 < 0 ? 0 : q0 - 128; const int kl1 = q0 + 64 + 128 > T ? T : q0 + 64 + 128; nloc = (kl1 - kl0) >> 6; } else { kl0 = 0; nloc = T / 64; } }
    const int NT = 4 + nloc;
    const int crow0 = RL + b * LC, lrow0 = b * T + kl0;
#define ATT_TROW(i) ((var & 64) ? crow0 : ((i) < 4 ? crow0 + 64 * (i) : lrow0 + 64 * ((i) - 4)))
    const bf16* ksrc0; const bf16* ksrc1 = nullptr;
    if (TYPE != 1) { const int row = 8 * wid + (lane >> 3), c = (lane & 7) ^ ((row >> 1) & 7); ksrc0 = Kp + (size_t)row * KPITCH + c * 8; }
    else {
        { const int row = 8 * wid + (lane >> 4), c = (lane & 15) ^ (row & 15); ksrc0 = c < 8 ? Kp + (size_t)row * LDM + c * 8 : (c < 12 ? Tn.P + (size_t)row * LDP + P_KR + (c - 8) * 8 : Kp + (size_t)row * LDM); }
        { const int row = 8 * wid + 4 + (lane >> 4), c = (lane & 15) ^ (row & 15); ksrc1 = c < 8 ? Kp + (size_t)row * LDM + c * 8 : (c < 12 ? Tn.P + (size_t)row * LDP + P_KR + (c - 8) * 8 : Kp + (size_t)row * LDM); }
    }
    const bool k0p = TYPE == 1 && (((lane & 15) ^ ((8 * wid + (lane >> 4)) & 15)) >= 8) && (((lane & 15) ^ ((8 * wid + (lane >> 4)) & 15)) < 12);
    const bool k1p = TYPE == 1 && (((lane & 15) ^ ((8 * wid + 4 + (lane >> 4)) & 15)) >= 8) && (((lane & 15) ^ ((8 * wid + 4 + (lane >> 4)) & 15)) < 12);
    const bf16* vsrc = Vp + (size_t)(8 * wid + ((lane & 31) >> 2)) * KPITCH + (lane >> 5) * 32 + (lane & 3) * 8;
#define ATT_DMA_K(i, slot) do { if (var & 8) break; const int g_ = ATT_TROW((i) < NT ? (i) : NT - 1); \
        __builtin_amdgcn_global_load_lds((const unsigned*)(ksrc0 + (size_t)g_ * (k0p ? LDP : KPITCH)), (LAS unsigned*)(lds + RG::L_K + (slot) * RG::KSLOT + wid * (ROWB * 8)), 16, 0, 0); \
        if (TYPE == 1) __builtin_amdgcn_global_load_lds((const unsigned*)(ksrc1 + (size_t)g_ * (k1p ? LDP : KPITCH)), (LAS unsigned*)(lds + RG::L_K + (slot) * RG::KSLOT + wid * (ROWB * 8) + 1024), 16, 0, 0); } while (0)
#define ATT_DMA_V(i, slot) do { if (var & 8) break; const int g_ = ATT_TROW((i) < NT ? (i) : NT - 1); \
        __builtin_amdgcn_global_load_lds((const unsigned*)(vsrc + (size_t)g_ * KPITCH), (LAS unsigned*)(lds + RG::L_V + (slot) * RG::VSLOT + wid * 1024), 16, 0, 0); } while (0)
#define ATT_WAITBAR() do { if (var & 16) break; if (TYPE == 1) asm volatile("s_waitcnt vmcnt(3)" ::: "memory"); else asm volatile("s_waitcnt vmcnt(2)" ::: "memory"); __builtin_amdgcn_s_barrier(); asm volatile("" ::: "memory"); } while (0)
#define ATT_RESC(a) do { if (__any((a) < 1.f)) { if (hi == 0) al_l[r32] = (a); asm volatile("s_waitcnt lgkmcnt(0)" ::: "memory"); \
        _Pragma("unroll") for (int r = 0; r < 16; ++r) { const float f_ = al_l[crow(r, hi)]; o[0][r] *= f_; o[1][r] *= f_; } } } while (0)
    const int qpos = q0 + wrow + r32;
#define ATT_MASK(P0, P1, i) do { if (TYPE == 0) { const int kt0_ = kl0 + 64 * ((i) - 4) - qpos, lo_ = (i) >= 4 ? -128 : -(1 << 28), hi_ = (i) >= 4 ? 128 : (1 << 28); \
        _Pragma("unroll") for (int r = 0; r < 16; ++r) { const int k0_ = kt0_ + crow(r, hi); P0[r] = (k0_ < lo_ || k0_ > hi_) ? -1e30f : P0[r]; P1[r] = (k0_ + 32 < lo_ || k0_ + 32 > hi_) ? -1e30f : P1[r]; } } } while (0)
    const int vb0 = (int)(uintptr_t)(lds + RG::L_V) + v_rd_base(lane);
    const LAS unsigned char* Kr = lds + RG::L_K;
    float mhat = 0.f, l_reg = 0.f; f32x16 negm = f32x16{};
    int sp = 2, sc = 0;
#define ATT_ROT() do { const int t_ = sp; sp = sc; sc = (sc == 2 ? 0 : sc + 1); (void)t_; } while (0)
#ifndef ATT_LAGSEL
#define ATT_LAGSEL 0
#endif
    const bool lag = ATT_STAGGER && (ATT_LAGSEL == 0 ? wid >= 4 : (ATT_LAGSEL == 1 ? (wid & 1) != 0 : ((wid >> 1) & 1) != 0));
    f32x16 p0 = f32x16{}, p1 = f32x16{}; bf16x8 pa0 = bf16x8{}, pa1 = bf16x8{}, pa2 = bf16x8{}, pa3 = bf16x8{};
#define ATT_SOFT(t, FIRST) do { ATT_MASK(p0, p1, t); float rm_ = rowmax32(p0, p1); float alpha_ = 1.f; \
        if (FIRST) { mhat = rm_; _Pragma("unroll") for (int r = 0; r < 16; ++r) { p0[r] -= rm_; p1[r] -= rm_; negm[r] = -rm_; } asm volatile("" : "+v"(negm)); } \
        else if (__builtin_expect(__any(rm_ > THR), 0)) { const float dl = fmaxf(rm_, 0.f); mhat += dl; \
            _Pragma("unroll") for (int r = 0; r < 16; ++r) { p0[r] -= dl; p1[r] -= dl; negm[r] = -mhat; } asm volatile("" : "+v"(negm)); \
            alpha_ = __builtin_amdgcn_exp2f(-dl); ATT_RESC(alpha_); } \
        finishSM(p0, p1, alpha_, l_reg, pa0, pa1, pa2, pa3); } while (0)
#define ATT_STEP(t) do { \
        if (lag || !ATT_LATE_DMA) { ATT_DMA_K((t) + 2, sp); ATT_DMA_V((t) + 1, ((t) + 1) & 3); } \
        { bf16x8 kf_[2 * NKS]; att::VFrag va_, vb_; const int vbt_ = vb0 + (((t) - 1) & 3) * RG::VSLOT; \
          kread<NKS, ROWB, CB0, 0>(kf_, Kr + sc * RG::KSLOT, r32, hi); vread<0>(va_, vbt_); \
          asm volatile("s_waitcnt lgkmcnt(0)" ::: "memory"); ATT_SBAR(); \
          kmma<NKS, 0>(p0, p1, kf_, qr, negm); ATT_SBAR(); \
          vread<1>(vb_, vbt_); ATT_SBAR(); \
          pv_mma(o[0], va_, pa0, pa1, pa2, pa3); \
          asm volatile("s_waitcnt lgkmcnt(0)" ::: "memory"); ATT_SBAR(); \
          pv_mma(o[1], vb_, pa0, pa1, pa2, pa3); } \
        asm volatile("" : "+v"(p0), "+v"(p1), "+v"(o[0]), "+v"(o[1])); \
        if (lag) ATT_WAITBAR(); \
        if (!lag && ATT_LATE_DMA) { ATT_DMA_K((t) + 2, sp); ATT_DMA_V((t) + 1, ((t) + 1) & 3); }     \
        ATT_SOFT(t, false); \
        asm volatile("" : "+v"(pa0), "+v"(pa1), "+v"(pa2), "+v"(pa3), "+v"(l_reg)); \
        if (!lag) ATT_WAITBAR(); ATT_ROT(); } while (0)
    ATT_DMA_K(0, 0); ATT_DMA_V(0, 0); ATT_DMA_K(1, 1);
    asm volatile("s_waitcnt vmcnt(0)" ::: "memory"); __builtin_amdgcn_s_barrier(); asm volatile("" ::: "memory");
    { ATT_DMA_K(2, 2); ATT_DMA_V(1, 1);
      qkt2<NKS, ROWB, CB0>(p0, p1, Kr, qr, negm, r32, hi);
      asm volatile("" : "+v"(p0), "+v"(p1));
      if (lag) ATT_WAITBAR();
      ATT_SOFT(0, true);
      asm volatile("" : "+v"(pa0), "+v"(pa1), "+v"(pa2), "+v"(pa3), "+v"(l_reg));
      if (!lag) ATT_WAITBAR(); ATT_ROT(); }
    for (int j = 1; j < ((var & 32) ? ATT_XSTEPS : NT); ++j) ATT_STEP(j);
    pv_one<0>(o[0], vb0 + ((NT - 1) & 3) * RG::VSLOT, pa0, pa1, pa2, pa3); pv_one<1>(o[1], vb0 + ((NT - 1) & 3) * RG::VSLOT, pa0, pa1, pa2, pa3);
    asm volatile("s_waitcnt vmcnt(0)" ::: "memory"); __builtin_amdgcn_s_barrier(); asm volatile("" ::: "memory");
#undef ATT_SOFT
    { auto rr = __builtin_amdgcn_permlane32_swap(__float_as_uint(l_reg), __float_as_uint(l_reg), false, false); l_reg = __uint_as_float(rr[0]) + __uint_as_float(rr[1]); }
    l_out = l_reg; m_out = mhat;
#undef ATT_TROW
#undef ATT_DMA_K
#undef ATT_DMA_V
#undef ATT_WAITBAR
#undef ATT_RESC
#undef ATT_MASK
#undef ATT_ROT
#undef ATT_STEP
}

template <int TYPE> __device__ __forceinline__ void unit(const Tensors& Tn, LAS unsigned char* lds, const int tid, const int b, const int h, const bool lat, const int q0, const int var) {
    constexpr int NKS = TYPE == 0 ? 4 : (TYPE == 1 ? 6 : 2);
    const int lane = tid & 63, wid = __builtin_amdgcn_readfirstlane(tid >> 6), r32 = lane & 31, hi = lane >> 5;
    typedef Ring<TYPE> RG;
    LAS float* wsf = (LAS float*)(lds + RG::L_WS) + wid * 64;
    const int hw = TYPE == 0 ? h * 4 + (wid & 3) : h, wrow = TYPE == 0 ? (wid >> 2) * 32 : wid * 32;
    const int qrow0 = (lat ? b * T + q0 : RL + b * LC + q0) + wrow;
    bf16x8 qr[TYPE == 2 ? 4 : NKS];
    { const bf16* qp = TYPE == 0 ? Tn.P + (size_t)(qrow0 + r32) * LDP + P_AQ + hw * 64 : (TYPE == 1 ? Tn.QKVM + (size_t)(qrow0 + r32) * LDM + h * 96 : Tn.P + (size_t)(qrow0 + r32) * LDP + P_DQ + h * 64);
#pragma unroll
      for (int d0 = 0; d0 < (TYPE == 2 ? 4 : NKS); ++d0) qr[d0] = *(const bf16x8*)(qp + d0 * 16 + hi * 8); }
    f32x16 oA[2] = {f32x16{}, f32x16{}}; float l0, m0;
    flash_pass<TYPE, 0>(Tn, lds, tid, b, hw, lat, q0, wrow, var, qr, oA, l0, m0);
    f32x16 oB[2] = {f32x16{}, f32x16{}}; float l1 = 1.f, m1 = 0.f;
    LAS float* stash = (LAS float*)(lds + RG::L_OST + wid * 8192);
    if (TYPE == 2) {
#pragma unroll
        for (int r = 0; r < 16; ++r) { stash[r * 64 + lane] = oA[0][r]; stash[(16 + r) * 64 + lane] = oA[1][r]; }
        flash_pass<TYPE, 64>(Tn, lds, tid, b, h, lat, q0, wrow, var, qr + 2, oB, l1, m1);
#pragma unroll
        for (int r = 0; r < 16; ++r) { oA[0][r] = stash[r * 64 + lane]; oA[1][r] = stash[(16 + r) * 64 + lane]; }
        asm volatile("s_waitcnt lgkmcnt(0)" ::: "memory");
    }
    if (TYPE == 0) l0 += __builtin_amdgcn_exp2f(Tn.sink[Tn.l * 8 + hw] * 1.4426950408889634f - m0);
    if (hi == 0) { wsf[r32] = l0; if (TYPE == 2) wsf[32 + r32] = l1; }
    asm volatile("s_waitcnt lgkmcnt(0)" ::: "memory");
    LAS bf16* stg = (LAS bf16*)(lds + RG::L_OST + wid * (TYPE == 2 ? 8192 : 4096));
    if (TYPE != 2) {
#pragma unroll
        for (int r = 0; r < 16; ++r) { const float rl = __builtin_amdgcn_rcpf(wsf[crow(r, hi)]); const int orow = crow(r, hi);
            stg[orow * 64 + r32] = (bf16)f2bf(oA[0][r] * rl); stg[orow * 64 + 32 + r32] = (bf16)f2bf(oA[1][r] * rl); }
    } else {
        const float g0 = Tn.dnorm[Tn.l * 64 + r32], g1 = Tn.dnorm[Tn.l * 64 + 32 + r32];
#pragma unroll
        for (int r = 0; r < 16; ++r) { const float rl0 = __builtin_amdgcn_rcpf(wsf[crow(r, hi)]), rl1 = Tn.lam * __builtin_amdgcn_rcpf(wsf[32 + crow(r, hi)]);
            const float a0 = oA[0][r] * rl0 - oB[0][r] * rl1, a1 = oA[1][r] * rl0 - oB[1][r] * rl1;
            float ss = a0 * a0 + a1 * a1;
#pragma unroll
            for (int o_ = 1; o_ < 32; o_ <<= 1) ss += shx(ss, o_, lane);
            const float rs = (1.f - Tn.lam_init) * __builtin_amdgcn_rsqf(ss * (1.f / 64.f) + EPS); const int orow = crow(r, hi);
            stg[orow * 64 + r32] = (bf16)f2bf(a0 * rs * g0); stg[orow * 64 + 32 + r32] = (bf16)f2bf(a1 * rs * g1); }
    }
    asm volatile("s_waitcnt lgkmcnt(0)" ::: "memory");
    { bf16* Ow = Tn.O + (size_t)qrow0 * D + (TYPE == 0 ? hw * 64 : (TYPE == 1 ? 512 + h * 64 : 768 + h * 64));
#pragma unroll
      for (int i = 0; i < 4; ++i) { const int row = i * 8 + (lane >> 3), ch = lane & 7; *(u32x4*)(Ow + (size_t)row * D + ch * 8) = *(const LAS u32x4*)(stg + row * 64 + ch * 8); } }
    asm volatile("s_waitcnt lgkmcnt(0)" ::: "memory"); __builtin_amdgcn_s_barrier(); asm volatile("" ::: "memory");
}
}

__device__ __forceinline__ void attn_phase(Frame& F, const int l, const bool need_ctx) {
    att::Tensors Tn; Tn.P = F_P; Tn.QKVM = F_QKVM; Tn.O = F_O; Tn.sink = F_sink; Tn.dnorm = F_diff_norm; Tn.l = l;
    { float s1 = 0.f, s2 = 0.f;
      if (F.lane < 32) { s1 = F_lq1[l * 32 + F.lane] * F_lk1[l * 32 + F.lane]; s2 = F_lq2[l * 32 + F.lane] * F_lk2[l * 32 + F.lane]; }
      s1 = wave_sum(s1, F.lane); s2 = wave_sum(s2, F.lane);
      int ll_ = l; asm volatile("" : "+s"(ll_));
      const float li_ = ll_ == 0 ? 0.200000000f : (ll_ == 1 ? 0.355509068f : (ll_ == 2 ? 0.470713018f : 0.556058204f));
      const float lm_ = __expf(s1) - __expf(s2) + li_;
      Tn.lam_init = li_; Tn.lam = __builtin_bit_cast(float, __builtin_amdgcn_readfirstlane(__builtin_bit_cast(int, lm_))); }
    const int b = F.bid & 7, j = F.bid >> 3;
    if (F.G != 256) return;
    const int nu = (need_ctx && j < 16) ? 5 : 4;
    for (int u = 0; u < nu + ATT_EXTRA; ++u) {
        int type, h, q0; bool lat = true; const int var = u >= nu ? ATT_XVAR : 0;
        if (u >= nu) { type = ATT_EXTRA_TYPE; h = ATT_EXTRA_TYPE == 0 ? ((j >> 3) & 1) : (j >> 3); q0 = ATT_EXTRA_TYPE == 0 ? j * 64 : (j & 7) * 256; Tn.O = F_ACT; }
        else if (u == 0) { type = 2; h = j >> 3; q0 = (j & 7) * 256; }
        else if (u == 1) { type = 1; h = j >> 3; q0 = (j & 7) * 256; }
        else if (u < 4) { type = 0; h = u - 2; q0 = j * 64; }
        else { lat = false; q0 = 0; if (j < 8) { type = 0; h = j >> 2; q0 = (j & 3) * 64; } else if (j < 12) { type = 1; h = j - 8; } else { type = 2; h = j - 12; } }
        int t_ = F.tid; asm volatile("" : "+v"(t_));
        if (type == 0) att::unit<0>(Tn, F.lds, t_, b, h, lat, q0, var);
        else if (type == 1) att::unit<1>(Tn, F.lds, t_, b, h, lat, q0, var);
        else att::unit<2>(Tn, F.lds, t_, b, h, lat, q0, var);
    }
}

enum { PH_P0 = 0, PH_L0 = 1, PH_PER_LAYER = 9, PH_FINAL = PH_L0 + DEPTH * PH_PER_LAYER, NPH = PH_FINAL + 1 };
enum { SP_NORM1 = 0, SP_INPROJ = 1, SP_UP = 2, SP_ATTN = 3, SP_OUT = 4, SP_NORM2 = 5, SP_TOPK = 6, SP_MOE1 = 7, SP_MOE2 = 8 };

#ifndef REPS_INIT
#define REPS_INIT {1, 1, 1, 1, 1, 1, 1, 1, 1}
#endif
#ifndef REP_P0
#define REP_P0 1
#endif
#ifndef REP_FINAL
#define REP_FINAL 1
#endif
#ifndef KROT_ON
#define KROT_ON 0
#endif
#ifndef PROBE_NOMMA
#define PROBE_NOMMA 0
#endif
#ifndef PHMASK
#define PHMASK 0x3ff
#endif
#define PHON(b) ((PHMASK >> (b)) & 1)
#define REPSEL(s) ((s) == 0 ? reps_sp[0] : (s) == 1 ? reps_sp[1] : (s) == 2 ? reps_sp[2] : (s) == 3 ? reps_sp[3] : (s) == 4 ? reps_sp[4] : (s) == 5 ? reps_sp[5] : (s) == 6 ? reps_sp[6] : (s) == 7 ? reps_sp[7] : reps_sp[8])
__global__ void __launch_bounds__(NWAVES * 64, 2) mk(Args args) {
    extern __shared__ __attribute__((aligned(16))) unsigned char lds_raw[];
    Frame F;
    F.lds = (LAS unsigned char*)lds_raw;
    F.tid = threadIdx.x; F.lane = F.tid & 63; F.wave = __builtin_amdgcn_readfirstlane(F.tid >> 6); F.bid = blockIdx.x; F.G = gridDim.x;
    const int wave_s = F.wave;
    F.in = (const float* const*)args.in; F.out = (GAS float*)args.out; F.ws = (GAS unsigned char*)args.ws;
    volatile LAS unsigned* MISC = (volatile LAS unsigned*)(F.lds + MISC_OFF);
    for (int u = F.tid; u < (LDS_BYTES - LDSCTL_OFF) / 4; u += NWAVES * 64) ((LAS unsigned*)(F.lds + LDSCTL_OFF))[u] = 0u;
    __syncthreads();
    XcdBarrier bar = xcd_barrier_post((unsigned*)(args.ws + WS_CTL) + CW_BAR + args.li * XCD_BAR_WORDS, MISC + 8);
    const int gx = F.bid & 7, gj = F.bid >> 3, gpx = F.G >> 3, krot = KROT_ON ? (gj & 7) + 3 * (gj >> 3) : 0;
    constexpr int reps_sp[9] = REPS_INIT;
    for (int ph = args.ph_lo; ph < args.ph_hi; ++ph) {
      const int nrep = ph == PH_P0 ? REP_P0 : (ph == PH_FINAL ? REP_FINAL : (REPSEL((ph - PH_L0) % PH_PER_LAYER)));
      for (int rep = 0; rep < nrep; ++rep) {
        const float keep = rep + 1 == nrep ? 1.f : 0.f;
        { unsigned char* w_ = args.ws; asm volatile("" : "+s"(w_)); F.ws = (GAS unsigned char*)w_; int z_ = 0; asm volatile("" : "+s"(z_)); F.in = (const float* const*)args.in + z_;
          int l_; asm volatile("v_mbcnt_lo_u32_b32 %0, -1, 0\n\tv_mbcnt_hi_u32_b32 %0, -1, %0" : "=v"(l_));
          int w_s = wave_s; asm volatile("" : "+s"(w_s)); F.lane = l_; F.wave = w_s; F.tid = w_s * 64 + l_; }
        if (ph == PH_P0) { if (PHON(9)) p0_phase(F); }
        else if (ph == PH_FINAL) { if (PHON(0)) norm_phase(F, DEPTH, 2, RL, keep); }
        else {
            const int l = (ph - PH_L0) / PH_PER_LAYER, sp = (ph - PH_L0) % PH_PER_LAYER;
            const bool need_ctx = l < DEPTH - 1; const int rows_mix = need_ctx ? R : RL;
            const bf16* wl = F_WB + (size_t)l * W_LAYER;
            if (sp == SP_NORM1) { if (PHON(0)) norm_phase(F, l, 0, R, keep); }
            else if (sp == SP_INPROJ && PHON(1)) {
                pg8::Gemm g{F_ACT, wl + W_IN, nullptr, 0, D, D}; OrderRows S{gx, gj, gpx, R / 288 / 8, LDP / 256, 0, krot, 288};
                EpiInProj<3, 3> E{F_P, F_ROPE, F_RSQ};
                pg8::gemm_phase288<false>(F.lds, F.tid, g, S, E);
                { const int nbusy = 8;
                  if (BG_PREP && l + 1 < DEPTH && rep + 1 == nrep && gj >= nbusy) prep_layer(F, l + 1, ((gx * (gpx - nbusy) + (gj - nbusy)) * NWAVES) + F.wave, 8 * (gpx - nbusy) * NWAVES); }
            } else if (sp == SP_UP && PHON(2)) {
                pg8::Gemm g{F_P + P_CQ, wl + W_UP, nullptr, 0, LDP, UPK}; OrderRows S{gx, gj, gpx, R / 288 / 8, 4, 0, krot, 288};
                EpiUp<3, 3> E{F_QKVM, F_ROPE, F_RSQ};
                pg8::gemm_phase288<false>(F.lds, F.tid, g, S, E);
            } else if (sp == SP_ATTN) { if (PHON(3)) attn_phase(F, l, need_ctx);
            } else if (sp == SP_OUT && PHON(4)) {
                pg8::Gemm g{F_O, wl + W_OUT, nullptr, 0, D, D};
                if (need_ctx) { OrderRows S{gx, gj, gpx, R / 288 / 8, 4, 0, krot, 288}; EpiOut<3, 3> E{(XT*)F_XB, F_MOD + (size_t)l * 9 * 6144, keep}; pg8::gemm_phase288<false>(F.lds, F.tid, g, S, E); }
                else { OrderRows S{gx, gj, gpx, RL / 256 / 8, 4, 0, krot, 256}; EpiOut<4> E{(XT*)F_XB, F_MOD + (size_t)l * 9 * 6144, keep}; pg8::gemm_phase<false, 4>(F.lds, F.tid, g, S, E); }
            } else if (sp == SP_NORM2) { if (PHON(5)) norm_phase(F, l, 1, rows_mix, keep); }
            else if (sp == SP_TOPK) { if (PHON(6)) topk_phase(F, need_ctx ? 16 : 8);
#if MOE_PF
                { unsigned acc = 0;
                  for (int e2 = 0; e2 < 2; ++e2) { const int e = 2 * gx + e2;
                    const u32x4* p1 = (const u32x4*)(wl + W_GU + (size_t)e * 1024 * 1024); const u32x4* p2 = (const u32x4*)(wl + W_DN + (size_t)e * 1024 * 512);
#pragma unroll 4
                    for (int i = gj * 512 + F.tid; i < 131072; i += gpx * 512) acc ^= p1[i].x;
#pragma unroll 4
                    for (int i = gj * 512 + F.tid; i < 65536; i += gpx * 512) acc ^= p2[i].x; }
                  asm volatile("" :: "v"(acc)); }
#endif
            }
            else if (sp == SP_MOE1 && PHON(7)) {
                pg8::Gemm g{F_ACT, wl + W_GU, F_STOK, (size_t)1024 * 1024, D, D};
                if (need_ctx) { OrderMoe S{gx, gj, gpx, 8, 4, krot, 288}; EpiGU<3, 3> E{F_HID}; pg8::gemm_phase288<true>(F.lds, F.tid, g, S, E); }
                else { OrderMoe S{gx, gj, gpx, 8, 4, krot, 256}; EpiGU<4> E{F_HID}; pg8::gemm_phase<true, 4>(F.lds, F.tid, g, S, E); }
            } else if (sp == SP_MOE2 && PHON(8)) {
                pg8::Gemm g{F_HID, wl + W_DN, nullptr, (size_t)1024 * 512, DE, DE};
                if (need_ctx) { OrderMoe S{gx, gj, gpx, 8, 4, krot, 288}; EpiDown<3, 3> E{F_Y, F_SGATE}; pg8::gemm_phase288<false>(F.lds, F.tid, g, S, E); }
                else { OrderMoe S{gx, gj, gpx, 8, 4, krot, 256}; EpiDown<4> E{F_Y, F_SGATE}; pg8::gemm_phase<false, 4>(F.lds, F.tid, g, S, E); }
            }
        }
        if (ph + 1 < args.ph_hi || rep + 1 < nrep) { xcd_barrier(bar, F.tid);
#ifdef EXTRA_BAR
            xcd_barrier(bar, F.tid);
#endif
        }
      }
    }
}

extern "C" void kernel_launch(void* const* d_in, const int* in_sizes, int n_in, void* d_out, int out_size, void* d_ws, size_t ws_size, hipStream_t stream) {
    static int grid = 0;
    if (grid == 0) {
        if (n_in != 25 || ws_size < WS_END || out_size != RL * D) { fprintf(stderr, "kernel_launch: unexpected shapes (n_in %d, ws %zu < %zu, out %d)\n", n_in, ws_size, (size_t)WS_END, out_size); grid = -1; return; }
        int dev = 0, cus = 0, per_cu = 0;
        if (hipGetDevice(&dev) != hipSuccess || hipDeviceGetAttribute(&cus, hipDeviceAttributeMultiprocessorCount, dev) != hipSuccess) { grid = -1; return; }
        if (hipFuncSetAttribute((const void*)mk, hipFuncAttributeMaxDynamicSharedMemorySize, LDS_BYTES) != hipSuccess) { fprintf(stderr, "kernel_launch: hipFuncSetAttribute failed\n"); grid = -1; return; }
        if (hipOccupancyMaxActiveBlocksPerMultiprocessor(&per_cu, (const void*)mk, NWAVES * 64, LDS_BYTES) != hipSuccess || per_cu < 1) { fprintf(stderr, "kernel_launch: occupancy query says %d\n", per_cu); }
        (void)hipGetLastError();
        grid = cus;
        if (grid % 8 != 0) { fprintf(stderr, "kernel_launch: %d CUs, expected a multiple of 8\n", grid); grid = -1; return; }
    }
    if (grid < 0) return;
    (void)hipMemsetAsync((char*)d_ws + WS_CTL, 0, CTL_ZERO_BYTES, stream);
    Args a; memset(&a, 0, sizeof a);
    for (int i = 0; i < 25; ++i) a.in[i] = (const float*)d_in[i];
    a.out = (float*)d_out; a.ws = (unsigned char*)d_ws;
    a.ph_lo = 0; a.ph_hi = NPH; a.li = 0;
    hipLaunchKernelGGL(mk, dim3(grid), dim3(NWAVES * 64), LDS_BYTES, stream, a);
}
```

```cpp
#include <hip/hip_runtime.h>
#include <stdint.h>
#include <string.h>
#include <stdio.h>

typedef unsigned short bf16;
typedef unsigned u32x4 __attribute__((ext_vector_type(4)));
typedef unsigned u32x2 __attribute__((ext_vector_type(2)));
typedef float f32x4 __attribute__((ext_vector_type(4)));
typedef float f32x16 __attribute__((ext_vector_type(16)));
typedef short bf16x8 __attribute__((ext_vector_type(8)));
#define LAS __attribute__((address_space(3)))
#define GAS __attribute__((address_space(1)))

constexpr int D = 1024, NB = 8, T = 2048, LC = 256, DEPTH = 4;
constexpr int RL = NB * T, RC = NB * LC, R = RL + RC;
constexpr int INW = 1952, LDP = 2048;
constexpr int NE = 16, DE = 512;
constexpr int CAPL = 256, CAPC = 32;
constexpr int SLOTS_E = NB * CAPL + NB * CAPC;
constexpr int SLOTS = NE * SLOTS_E;
constexpr float EPS = 1e-6f;
constexpr int P_AQ = 0, P_AK = 512, P_AV = 640, P_CQ = 768, P_CKV = 1024, P_KR = 1152, P_DQ = 1184, P_DK = 1440, P_DV = 1696;
constexpr int LDM = 1024;
constexpr int UPK = 384;

constexpr size_t MiB = 1u << 20;
constexpr size_t WS_CTL = 0;
constexpr size_t CTL_ZERO_BYTES = 256 * 1024;
constexpr size_t WS_MOD = 1 * MiB;
constexpr size_t WS_ROPE = 2 * MiB;
constexpr size_t WS_RSQ = 3 * MiB;
constexpr size_t WS_AFF = 4 * MiB;
constexpr size_t WS_INV = 6 * MiB;
constexpr size_t WS_STOK = 8 * MiB;
constexpr size_t WS_SGATE = 9 * MiB;
#ifndef X_BF16
#define X_BF16 1
#endif
constexpr size_t WS_X = 10 * MiB;
constexpr size_t WS_ACT = 82 * MiB;
constexpr size_t WS_P = 118 * MiB;
constexpr size_t WS_Y = WS_P;
constexpr size_t WS_QKVM = 190 * MiB;
constexpr size_t WS_O = 226 * MiB;
constexpr size_t WS_HID = WS_O;
constexpr size_t WS_W = 262 * MiB;
constexpr size_t W_IN = 0;
constexpr size_t W_UP = W_IN + (size_t)LDP * D;
constexpr size_t W_OUT = W_UP + (size_t)1024 * UPK;
constexpr size_t W_GU = W_OUT + (size_t)D * D;
constexpr size_t W_DN = W_GU + (size_t)NE * 1024 * 1024;
constexpr size_t W_LAYER = W_DN + (size_t)NE * 1024 * 512;
constexpr size_t WS_END = WS_W + (size_t)DEPTH * W_LAYER * 2;

__device__ __forceinline__ unsigned f2bf(float f) { unsigned u = __builtin_bit_cast(unsigned, f); return (u + 0x7fffu + ((u >> 16) & 1u)) >> 16; }
__device__ __forceinline__ float bf2f(unsigned h) { return __builtin_bit_cast(float, h << 16); }
#ifndef WT_STORES
#define WT_STORES 0
#endif
__device__ __forceinline__ void st16(void* p, const u32x4 v) {
#if WT_STORES
    asm volatile("global_store_dwordx4 %0, %1, off sc1\n\ts_nop 1" :: "v"(p), "v"(v) : "memory");
#else
    *(u32x4*)p = v;
#endif
}
typedef float f32x2c_t __attribute__((ext_vector_type(2)));
typedef __bf16 bf16x2c_t __attribute__((ext_vector_type(2)));
#ifndef HW_CVT
#define HW_CVT 1
#endif
__device__ __forceinline__ unsigned pk2(float lo, float hi) {
#if HW_CVT
    f32x2c_t v = {lo, hi}; bf16x2c_t b = __builtin_convertvector(v, bf16x2c_t); return __builtin_bit_cast(unsigned, b);
#else
    return f2bf(lo) | (f2bf(hi) << 16);
#endif
}
__device__ __forceinline__ float shx(float v, int o, int lane) { return __builtin_bit_cast(float, __builtin_amdgcn_ds_bpermute((lane ^ o) << 2, __builtin_bit_cast(int, v))); }
__device__ __forceinline__ int shi(int v, int src) { return __builtin_amdgcn_ds_bpermute(src << 2, v); }
__device__ __forceinline__ float wave_sum(float v, int lane) {
#pragma unroll
    for (int o = 1; o < 64; o <<= 1) v += shx(v, o, lane);
    return v;
}
__device__ __forceinline__ float siluf(float v) { return v / (1.f + __expf(-v)); }
#define LDS_WAIT() asm volatile("s_waitcnt lgkmcnt(0)" ::: "memory")
#define VM_WAIT() asm volatile("s_waitcnt vmcnt(0)" ::: "memory")

struct Args {
    const float* in[25]; float* out; unsigned char* ws; int ph_lo, ph_hi, li, pad;
};

#ifndef PROBE_HOT
#define PROBE_HOT 0
#endif
#ifndef PROBE_NOEPI
#define PROBE_NOEPI 0
#endif
#ifndef PROBE_NOLDS
#define PROBE_NOLDS 0
#endif
#ifndef GEMM_AUX
#define GEMM_AUX 0
#endif
#ifndef GEMM_PRIO
#define GEMM_PRIO 1
#endif
#ifndef GEMM_ASKIP
#define GEMM_ASKIP 0
#endif
namespace pg8 {
constexpr int BM = 256, BK = 64, HALF = 128, HTB = HALF * BK * 2  , STAGE_BYTES = 8 * HTB;
__host__ __device__ __forceinline__ int lds_byte(int r, int c) { const int st = (r >> 4) * 2 + (c >> 5), rr = r & 15, cc = c & 31, ob = rr * 64 + cc * 2; return st * 1024 + (ob ^ (((ob >> 9) & 1) << 5)); }
__host__ __device__ __forceinline__ void stage_rc(int b, int& R, int& C) { const int st = b / 1024, sb = b % 1024, swz = sb ^ (((sb >> 9) & 1) << 5); R = (st >> 1) * 16 + swz / 64; C = (st & 1) * 32 + (swz % 64) / 2; }
__host__ __device__ __forceinline__ int perm32(int rho) { const int n = rho >> 4, i = rho & 15; return 8 * (i >> 2) + 4 * n + (i & 3); }

struct Unit { int arow0, orow0, col0, e, quad; };
struct Gemm { const bf16* A; const bf16* Bt; const int* gather; size_t b_estride; int lda, K; };

template <bool GATHER, int MF, class Epi, class Sched>
__device__ __forceinline__ void gemm_phase(LAS unsigned char* lds, const int tid, const Gemm g, const Sched& S, const Epi& E) {
    const int wid = __builtin_amdgcn_readfirstlane(tid >> 6), lane = tid & 63, wr = wid >> 2, wc = wid & 3, fr = lane & 15, fq = lane >> 4;
    constexpr bool ASKIP = (MF == 3) && GEMM_ASKIP;
    constexpr int HR = 32 * MF;
    const int K = g.K, nt = K / BK;
    unsigned voffA[2], voffB[2]; int sR[2];
#pragma unroll
    for (int i = 0; i < 2; ++i) { int C_; stage_rc(tid * 16 + i * 8192, sR[i], C_); const int Rb = (sR[i] & ~31) + perm32(sR[i] & 31);
        voffA[i] = GATHER ? (unsigned)C_ * 2u : (unsigned)(sR[i] * g.lda + C_) * 2u; voffB[i] = (unsigned)(Rb * K + C_) * 2u; }
    const unsigned lda2 = (unsigned)g.lda * 2u;
    const unsigned hstepA = (unsigned)HR * g.lda * 2u;
    const unsigned kstep = (unsigned)(BK * 2);
    const int krot = (2 * S.rot) % nt;
#define PG8_KT(i) ((PROBE_HOT && hot_) ? 0u : (unsigned)(((i) + krot) >= nt ? (i) + krot - nt : (i) + krot) * kstep)
    const unsigned hstepB = (unsigned)HALF * K * 2u;
    const __amdgpu_buffer_rsrc_t rsA = __builtin_amdgcn_make_buffer_rsrc((void*)g.A, 0, 0x7fffffff, 0x00020000);
    const __amdgpu_buffer_rsrc_t rsB = __builtin_amdgcn_make_buffer_rsrc((void*)g.Bt, 0, 0x7fffffff, 0x00020000);
    const unsigned ldsw = (unsigned)wid * 1024u;
    const int aoff = lds_byte(wr * (16 * MF) + fr, fq * 8), boff = lds_byte(wc * 32 + fr, fq * 8);
#define PG8_SA(b, h) (((b) * 2 + (h)) * HTB)
#define PG8_SB(b, h) ((4 + (b) * 2 + (h)) * HTB)
#define PG8_STAGE2(bufoff, rsrc, v0, v1, soff) do { \
        __builtin_amdgcn_raw_ptr_buffer_load_lds(rsrc, (LAS unsigned*)(lds + (bufoff) + ldsw), 16, (int)(v0), (int)(soff), 0, 0); \
        __builtin_amdgcn_raw_ptr_buffer_load_lds(rsrc, (LAS unsigned*)(lds + (bufoff) + ldsw + 8192), 16, (int)(v1), (int)(soff), 0, 0); } while (0)
#define PG8_STAGEB(bufoff, soff) PG8_STAGE2(bufoff, rsB, voffB[0], voffB[1], soff)
#define PG8_STAGE1(bufoff, rsrc, v0, soff) __builtin_amdgcn_raw_ptr_buffer_load_lds(rsrc, (LAS unsigned*)(lds + (bufoff) + ldsw), 16, (int)(v0), (int)(soff), 0, 0)
#define PG8_STAGEA(bufoff, ubase, r0, r1, h, koff) do { if constexpr (GATHER) { \
        if (ASKIP && wr == 1) PG8_STAGE1(bufoff, rsA, (((r0) >> (16 * (h))) & 0xffffu) * lda2 + voffA[0], (koff)); \
        else PG8_STAGE2(bufoff, rsA, (((r0) >> (16 * (h))) & 0xffffu) * lda2 + voffA[0], (((r1) >> (16 * (h))) & 0xffffu) * lda2 + voffA[1], (koff)); } \
        else { if (ASKIP && wr == 1) PG8_STAGE1(bufoff, rsA, voffA[0], (ubase) + (h) * hstepA + (koff)); \
        else PG8_STAGE2(bufoff, rsA, voffA[0], voffA[1], (ubase) + (h) * hstepA + (koff)); } } while (0)
#define PG8_LDA(dst, b, h) do { if (PROBE_NOLDS && hot_) break; _Pragma("unroll") for (int m = 0; m < MF; ++m) _Pragma("unroll") for (int k = 0; k < 2; ++k) dst[m][k] = *(const LAS bf16x8*)(lds + PG8_SA(b, h) + aoff + m * 2048 + k * 1024); } while (0)
#define PG8_LDB(dst, b, h) do { if (PROBE_NOLDS && hot_) break; _Pragma("unroll") for (int n = 0; n < 2; ++n) _Pragma("unroll") for (int k = 0; k < 2; ++k) dst[n][k] = *(const LAS bf16x8*)(lds + PG8_SB(b, h) + boff + n * 2048 + k * 1024); } while (0)
#define PG8_MMA(ai, bj, At, Bt) do { __builtin_amdgcn_s_setprio(1); _Pragma("unroll") for (int m = 0; m < MF; ++m) _Pragma("unroll") for (int n = 0; n < 2; ++n) _Pragma("unroll") for (int k = 0; k < 2; ++k) \
        acc[ai][bj][m][n] = __builtin_amdgcn_mfma_f32_16x16x32_bf16(Bt[n][k], At[m][k], acc[ai][bj][m][n], 0, 0, 0); __builtin_amdgcn_s_setprio(0); } while (0)
#define PG8_WAIT_V(n) asm volatile("s_waitcnt vmcnt(" #n ")" ::: "memory")
#define PG8_WAIT_V2(n, nskip) do { if (ASKIP && wr == 1) PG8_WAIT_V(nskip); else PG8_WAIT_V(n); } while (0)
#define PG8_WAIT_L(n) asm volatile("s_waitcnt lgkmcnt(" #n ")" ::: "memory")
#define PG8_BAR __builtin_amdgcn_s_barrier()
#define PG8_SCHED __builtin_amdgcn_sched_barrier(0)
#define PG8_ROWS(dst, u) do { if constexpr (GATHER) { _Pragma("unroll") for (int i = 0; i < 2; ++i) { \
        const int sr_ = sR[i] < HR ? sR[i] : sR[i] - 32;     \
        const unsigned a_ = (unsigned)g.gather[(u).arow0 + sr_], b_ = (unsigned)g.gather[(u).arow0 + ((u).quad ? 0 : HR) + sr_]; dst[i] = a_ | (b_ << 16); } \
        asm volatile("" : "+v"(dst[0]), "+v"(dst[1])); } } while (0)
    Unit cur, nxt; int ui = 0;
    if (!S.next(0, cur)) return;
    const bool hot_ = cur.quad == 2;
    f32x4 acc[2][2][MF][2];
#pragma unroll
    for (int a = 0; a < 2; ++a)
#pragma unroll
        for (int b = 0; b < 2; ++b)
#pragma unroll
            for (int m = 0; m < MF; ++m)
#pragma unroll
                for (int n = 0; n < 2; ++n) acc[a][b][m][n] = (f32x4){0.f, 0.f, 0.f, 0.f};
    bf16x8 At[MF][2], B0[2][2], B1[2][2];
    unsigned rp[2] = {0u, 0u}, rn[2] = {0u, 0u};
    PG8_ROWS(rp, cur);
    unsigned cA = (unsigned)cur.arow0 * lda2;
    unsigned cB = (unsigned)(((size_t)cur.e * g.b_estride + (size_t)cur.col0 * K) * 2);
    PG8_STAGEB(PG8_SB(0, 0), cB + PG8_KT(0)); PG8_STAGEB(PG8_SB(0, 1), cB + hstepB + PG8_KT(0)); PG8_STAGEA(PG8_SA(0, 0), cA, rp[0], rp[1], 0, PG8_KT(0)); PG8_STAGEA(PG8_SA(0, 1), cA, rp[0], rp[1], 1, PG8_KT(0));
    if (wr == 1) PG8_BAR;
    PG8_WAIT_V2(2, 1); PG8_BAR;
    PG8_STAGEB(PG8_SB(1, 0), cB + PG8_KT(1)); PG8_STAGEA(PG8_SA(1, 0), cA, rp[0], rp[1], 0, PG8_KT(1)); PG8_STAGEB(PG8_SB(1, 1), cB + hstepB + PG8_KT(1));
    PG8_WAIT_V2(6, 5); PG8_BAR;
    for (;;) {
        const bool has_next = S.next(ui + 1, nxt);
        if (has_next) { PG8_ROWS(rn, nxt); } else { rn[0] = rp[0]; rn[1] = rp[1]; }
        const unsigned nA = has_next ? (unsigned)nxt.arow0 * lda2 : cA;
        const unsigned nB = has_next ? (unsigned)(((size_t)nxt.e * g.b_estride + (size_t)nxt.col0 * K) * 2) : cB;
#pragma unroll 1
        for (int t = 0; t < nt; t += 2) {
            const bool last = (t == nt - 2);
            const unsigned k1 = PG8_KT(t + 1), k2 = last ? PG8_KT(0) : PG8_KT(t + 2), k3 = last ? PG8_KT(1) : PG8_KT(t + 3);
            const unsigned u2 = last ? nA : cA; const unsigned b2 = (last ? nB : cB) + k2; const unsigned b3 = (last ? nB : cB) + k3;
            const unsigned q0 = last ? rn[0] : rp[0], q1 = last ? rn[1] : rp[1];
            PG8_LDB(B0, 0, 0); PG8_LDB(B1, 0, 1); PG8_SCHED; PG8_LDA(At, 0, 0); PG8_STAGEA(PG8_SA(1, 1), cA, rp[0], rp[1], 1, k1);
            PG8_WAIT_V2(8, 6); PG8_WAIT_L(0); PG8_BAR; if (cur.quad < 2) PG8_MMA(0, 0, At, B0); if (!cur.quad) PG8_MMA(0, 1, At, B1); PG8_BAR; PG8_SCHED;
            PG8_LDA(At, 0, 1); PG8_STAGEB(PG8_SB(0, 0), b2); PG8_STAGEB(PG8_SB(0, 1), b2 + hstepB); PG8_STAGEA(PG8_SA(0, 0), u2, q0, q1, 0, k2);
            PG8_WAIT_V2(8, 6); PG8_WAIT_L(0); PG8_BAR; if (!cur.quad) { PG8_MMA(1, 0, At, B0); PG8_MMA(1, 1, At, B1); } PG8_BAR; PG8_SCHED;
            PG8_LDB(B0, 1, 0); PG8_LDB(B1, 1, 1); PG8_SCHED; PG8_LDA(At, 1, 0); PG8_STAGEA(PG8_SA(0, 1), u2, q0, q1, 1, k2);
            PG8_WAIT_V2(8, 6); PG8_WAIT_L(0); PG8_BAR; if (cur.quad < 2) PG8_MMA(0, 0, At, B0); if (!cur.quad) PG8_MMA(0, 1, At, B1); PG8_BAR; PG8_SCHED;
            PG8_LDA(At, 1, 1); PG8_STAGEB(PG8_SB(1, 0), b3); PG8_STAGEB(PG8_SB(1, 1), b3 + hstepB); PG8_STAGEA(PG8_SA(1, 0), u2, q0, q1, 0, k3);
            PG8_WAIT_V2(8, 6); PG8_WAIT_L(0); PG8_BAR; if (!cur.quad) { PG8_MMA(1, 0, At, B0); PG8_MMA(1, 1, At, B1); } PG8_BAR; PG8_SCHED;
        }
        if (wr == 0) PG8_BAR;
        if (!(PROBE_NOEPI && hot_)) E(acc, cur, wr, wc, fr, fq);
        if (!has_next) break;
#pragma unroll
        for (int a = 0; a < 2; ++a)
#pragma unroll
            for (int b = 0; b < 2; ++b)
#pragma unroll
                for (int m = 0; m < MF; ++m)
#pragma unroll
                    for (int n = 0; n < 2; ++n) acc[a][b][m][n] = (f32x4){0.f, 0.f, 0.f, 0.f};
        cur = nxt; cB = nB; cA = nA; ++ui; rp[0] = rn[0]; rp[1] = rn[1];
        if (wr == 1) PG8_BAR;
    }
    PG8_WAIT_V(0);
    PG8_BAR;
#undef PG8_SA
#undef PG8_SB
#undef PG8_STAGE2
#undef PG8_STAGEB
#undef PG8_LDA
#undef PG8_LDB
#undef PG8_MMA
#undef PG8_WAIT_V
#undef PG8_WAIT_V2
#undef PG8_STAGE1
#undef PG8_WAIT_L
#undef PG8_BAR
#undef PG8_SCHED
#undef PG8_KT
#undef PG8_ROWS
#undef PG8_STAGEA
}
constexpr int PTB = 96 * BK * 2, SB_OFF = 6 * PTB, STAGE288_BYTES = SB_OFF + 4 * HTB;
template <bool GATHER, class Epi, class Sched>
__device__ __forceinline__ void gemm_phase288(LAS unsigned char* lds, const int tid, const Gemm g, const Sched& S, const Epi& E) {
    constexpr int MF = 3;
    const int wid = __builtin_amdgcn_readfirstlane(tid >> 6), lane = tid & 63, wr = wid >> 2, wc = wid & 3, fr = lane & 15, fq = lane >> 4;
    const int K = g.K, nt = K / BK;
    unsigned voffA[2], voffB[2]; int sR[2];
#pragma unroll
    for (int i = 0; i < 2; ++i) { int C_; stage_rc(tid * 16 + i * 8192, sR[i], C_); const int Rb = (sR[i] & ~31) + perm32(sR[i] & 31);
        voffB[i] = (unsigned)(Rb * K + C_) * 2u;
        if (i == 1) stage_rc((tid & 255) * 16 + 8192, sR[i], C_);
        voffA[i] = GATHER ? (unsigned)C_ * 2u : (unsigned)(sR[i] * g.lda + C_) * 2u; }
    const unsigned lda2 = (unsigned)g.lda * 2u;
    const unsigned pstepA = 96u * g.lda * 2u;
    const unsigned kstep = (unsigned)(BK * 2);
    const unsigned hstepB = (unsigned)HALF * K * 2u;
    const __amdgpu_buffer_rsrc_t rsA = __builtin_amdgcn_make_buffer_rsrc((void*)g.A, 0, 0x7fffffff, 0x00020000);
    const __amdgpu_buffer_rsrc_t rsB = __builtin_amdgcn_make_buffer_rsrc((void*)g.Bt, 0, 0x7fffffff, 0x00020000);
    const unsigned ldsw = (unsigned)wid * 1024u, ldsx = 8192u + (unsigned)(wid & 3) * 1024u;
    const int aoff = lds_byte(wr * 48 + fr, fq * 8), boff = lds_byte(wc * 32 + fr, fq * 8);
#define PG9_SA(b, a) (((b) * 3 + (a)) * PTB)
#define PG9_SB(b, h) (SB_OFF + ((b) * 2 + (h)) * HTB)
#define PG9_DMA(rsrc, dstoff, v, soff) __builtin_amdgcn_raw_ptr_buffer_load_lds(rsrc, (LAS unsigned*)(lds + (dstoff) + ldsw), 16, (int)(v), (int)(soff), 0, GEMM_AUX)
#define PG9_STAGEB(bufoff, soff) do { PG9_DMA(rsB, (bufoff), voffB[0], (soff)); PG9_DMA(rsB, (bufoff) + 8192, voffB[1], (soff)); } while (0)
#define PG9_RIDX(r, a, i) ((a) < 2 ? (((r)[i] >> (16 * (a))) & 0xffffu) : (((r)[2] >> (16 * (i))) & 0xffffu))
#define PG9_DMAX(rsrc, dstoff, v, soff) __builtin_amdgcn_raw_ptr_buffer_load_lds(rsrc, (LAS unsigned*)(lds + (dstoff) + ldsx), 16, (int)(v), (int)(soff), 0, GEMM_AUX)
#define PG9_STAGEA(bufoff, ubase, r, a, koff, OWN) do { if constexpr (GATHER) { \
        PG9_DMA(rsA, (bufoff), PG9_RIDX(r, a, 0) * lda2 + voffA[0], (koff)); if (wr == (OWN)) PG9_DMAX(rsA, (bufoff), PG9_RIDX(r, a, 1) * lda2 + voffA[1], (koff)); } \
        else { PG9_DMA(rsA, (bufoff), voffA[0], (ubase) + (a) * pstepA + (koff)); if (wr == (OWN)) PG9_DMAX(rsA, (bufoff), voffA[1], (ubase) + (a) * pstepA + (koff)); } } while (0)
#define PG9_LDA(dst, b, a) do { _Pragma("unroll") for (int m = 0; m < MF; ++m) _Pragma("unroll") for (int k = 0; k < 2; ++k) dst[m][k] = *(const LAS bf16x8*)(lds + PG9_SA(b, a) + aoff + m * 2048 + k * 1024); } while (0)
#define PG9_LDB(dst, b, h) do { _Pragma("unroll") for (int n = 0; n < 2; ++n) _Pragma("unroll") for (int k = 0; k < 2; ++k) dst[n][k] = *(const LAS bf16x8*)(lds + PG9_SB(b, h) + boff + n * 2048 + k * 1024); } while (0)
#define PG9_MMA(ai, bj, At, Bt) do { if (GEMM_PRIO) __builtin_amdgcn_s_setprio(1); _Pragma("unroll") for (int m = 0; m < MF; ++m) _Pragma("unroll") for (int n = 0; n < 2; ++n) _Pragma("unroll") for (int k = 0; k < 2; ++k) \
        acc[ai][bj][m][n] = __builtin_amdgcn_mfma_f32_16x16x32_bf16(Bt[n][k], At[m][k], acc[ai][bj][m][n], 0, 0, 0); if (GEMM_PRIO) __builtin_amdgcn_s_setprio(0); } while (0)
#define PG9_WAIT_V(n) asm volatile("s_waitcnt vmcnt(" #n ")" ::: "memory")
#define PG9_WAIT_L(n) asm volatile("s_waitcnt lgkmcnt(" #n ")" ::: "memory")
#define PG9_BAR __builtin_amdgcn_s_barrier()
#define PG9_SCHED __builtin_amdgcn_sched_barrier(0)
#define PG9_ROWS(dst, u) do { if constexpr (GATHER) { unsigned t2_[2]; _Pragma("unroll") for (int i = 0; i < 2; ++i) { \
        const unsigned a_ = (unsigned)g.gather[(u).arow0 + sR[i]], b_ = (unsigned)g.gather[(u).arow0 + 96 + sR[i]]; t2_[i] = (unsigned)g.gather[(u).arow0 + 192 + sR[i]]; dst[i] = a_ | (b_ << 16); } \
        dst[2] = t2_[0] | (t2_[1] << 16); asm volatile("" : "+v"(dst[0]), "+v"(dst[1]), "+v"(dst[2])); } } while (0)
    Unit cur, nxt; int ui = 0;
    if (!S.next(0, cur)) return;
    f32x4 acc[3][2][MF][2];
#pragma unroll
    for (int a = 0; a < 3; ++a)
#pragma unroll
        for (int b = 0; b < 2; ++b)
#pragma unroll
            for (int m = 0; m < MF; ++m)
#pragma unroll
                for (int n = 0; n < 2; ++n) acc[a][b][m][n] = (f32x4){0.f, 0.f, 0.f, 0.f};
    bf16x8 At[MF][2], B0[2][2], B1[2][2];
    unsigned rp[3] = {0u, 0u, 0u}, rn[3] = {0u, 0u, 0u};
    PG9_ROWS(rp, cur);
    unsigned cA = (unsigned)cur.arow0 * lda2;
    unsigned cB = (unsigned)(((size_t)cur.e * g.b_estride + (size_t)cur.col0 * K) * 2);
    PG9_STAGEB(PG9_SB(0, 0), cB); PG9_STAGEA(PG9_SA(0, 0), cA, rp, 0, 0u, 0); PG9_STAGEB(PG9_SB(0, 1), cB + hstepB); PG9_STAGEA(PG9_SA(0, 1), cA, rp, 1, 0u, 1); PG9_STAGEA(PG9_SA(0, 2), cA, rp, 2, 0u, 0);
    PG9_STAGEB(PG9_SB(1, 0), cB + kstep); PG9_STAGEA(PG9_SA(1, 0), cA, rp, 0, kstep, 1); PG9_STAGEB(PG9_SB(1, 1), cB + hstepB + kstep); PG9_STAGEA(PG9_SA(1, 1), cA, rp, 1, kstep, 0);
    PG9_WAIT_V(10); PG9_BAR;
    if (wr == 1) PG9_BAR;
    for (;;) {
        const bool has_next = S.next(ui + 1, nxt);
        if (has_next) { PG9_ROWS(rn, nxt); } else { rn[0] = rp[0]; rn[1] = rp[1]; rn[2] = rp[2]; }
        const unsigned nA = has_next ? (unsigned)nxt.arow0 * lda2 : cA;
        const unsigned nB = has_next ? (unsigned)(((size_t)nxt.e * g.b_estride + (size_t)nxt.col0 * K) * 2) : cB;
#pragma unroll 1
        for (int t = 0; t < nt; t += 2) {
            const bool last = (t == nt - 2);
            const unsigned k1 = (unsigned)(t + 1) * kstep, k2 = last ? 0u : (unsigned)(t + 2) * kstep, k3 = last ? kstep : (unsigned)(t + 3) * kstep;
            const unsigned u2 = last ? nA : cA; const unsigned b2 = (last ? nB : cB) + k2; const unsigned b3 = (last ? nB : cB) + k3;
            unsigned q[3]; q[0] = last ? rn[0] : rp[0]; q[1] = last ? rn[1] : rp[1]; q[2] = last ? rn[2] : rp[2];
            PG9_LDB(B0, 0, 0); PG9_LDB(B1, 0, 1); PG9_SCHED; PG9_LDA(At, 0, 0); PG9_STAGEA(PG9_SA(1, 2), cA, rp, 2, k1, 1);
            PG9_WAIT_V(10); PG9_WAIT_L(0); PG9_BAR; PG9_MMA(0, 0, At, B0); PG9_MMA(0, 1, At, B1); PG9_BAR; PG9_SCHED;
            PG9_LDA(At, 0, 1); PG9_STAGEB(PG9_SB(0, 0), b2); PG9_STAGEA(PG9_SA(0, 0), u2, q, 0, k2, 0);
            PG9_WAIT_V(12); PG9_WAIT_L(0); PG9_BAR; PG9_MMA(1, 0, At, B0); PG9_MMA(1, 1, At, B1); PG9_BAR; PG9_SCHED;
            PG9_LDA(At, 0, 2); PG9_STAGEB(PG9_SB(0, 1), b2 + hstepB); PG9_STAGEA(PG9_SA(0, 1), u2, q, 1, k2, 1);
            PG9_WAIT_V(10); PG9_WAIT_L(0); PG9_BAR; PG9_MMA(2, 0, At, B0); PG9_MMA(2, 1, At, B1); PG9_BAR; PG9_SCHED;
            PG9_LDB(B0, 1, 0); PG9_LDB(B1, 1, 1); PG9_SCHED; PG9_LDA(At, 1, 0); PG9_STAGEA(PG9_SA(0, 2), u2, q, 2, k2, 0);
            PG9_WAIT_V(10); PG9_WAIT_L(0); PG9_BAR; PG9_MMA(0, 0, At, B0); PG9_MMA(0, 1, At, B1); PG9_BAR; PG9_SCHED;
            PG9_LDA(At, 1, 1); PG9_STAGEB(PG9_SB(1, 0), b3); PG9_STAGEA(PG9_SA(1, 0), u2, q, 0, k3, 1);
            PG9_WAIT_V(12); PG9_WAIT_L(0); PG9_BAR; PG9_MMA(1, 0, At, B0); PG9_MMA(1, 1, At, B1); PG9_BAR; PG9_SCHED;
            PG9_LDA(At, 1, 2); PG9_STAGEB(PG9_SB(1, 1), b3 + hstepB); PG9_STAGEA(PG9_SA(1, 1), u2, q, 1, k3, 0);
            PG9_WAIT_V(10); PG9_WAIT_L(0); PG9_BAR; PG9_MMA(2, 0, At, B0); PG9_MMA(2, 1, At, B1); PG9_BAR; PG9_SCHED;
        }
        if (wr == 0) PG9_BAR;
        E(acc, cur, wr, wc, fr, fq);
        if (!has_next) break;
#pragma unroll
        for (int a = 0; a < 3; ++a)
#pragma unroll
            for (int b = 0; b < 2; ++b)
#pragma unroll
                for (int m = 0; m < MF; ++m)
#pragma unroll
                    for (int n = 0; n < 2; ++n) acc[a][b][m][n] = (f32x4){0.f, 0.f, 0.f, 0.f};
        cur = nxt; cB = nB; cA = nA; ++ui; rp[0] = rn[0]; rp[1] = rn[1]; rp[2] = rn[2];
        if (wr == 1) PG9_BAR;
    }
    PG9_WAIT_V(0);
    PG9_BAR;
#undef PG9_SA
#undef PG9_SB
#undef PG9_DMA
#undef PG9_DMAX
#undef PG9_STAGEB
#undef PG9_RIDX
#undef PG9_STAGEA
#undef PG9_LDA
#undef PG9_LDB
#undef PG9_MMA
#undef PG9_WAIT_V
#undef PG9_WAIT_L
#undef PG9_BAR
#undef PG9_SCHED
#undef PG9_ROWS
}
}

#ifndef QUAD_SPLIT
#define QUAD_SPLIT 1
#endif
__device__ __forceinline__ bool deal(int i, int j, int gpx, int U, int& unit, int& quad) {
    const int q = i * gpx + j, nfull = (U / gpx) * gpx, left = U - nfull;
    if (q < nfull || left * 4 > gpx || !QUAD_SPLIT) { if (q >= U) return false; unit = q; quad = -1; return true; }
    const int s_ = q - nfull; if (s_ >= left * 4) return false; unit = nfull + (s_ >> 2); quad = s_ & 3; return true;
}
struct OrderRows {
    int x, j, gpx, rpx, nN, nomma, rot, TR;
    __device__ __forceinline__ bool next(int i, pg8::Unit& u) const {
        int q, quad; if (!deal(i, j, gpx, rpx * nN, q, quad)) return false;
        const int pm = x * rpx + q / nN, pn = q % nN; u.arow0 = pm * TR; u.col0 = pn * 256; u.e = 0; u.quad = quad >= 0;
        if (quad >= 0) { u.arow0 += (quad >> 1) * (TR / 2); u.col0 += (quad & 1) * 128; }
        if (nomma) u.quad = 2;
        u.orow0 = u.arow0; return true; }
};
struct OrderMoe {
    int x, j, gpx, nME, nN, rot, TR;
    __device__ __forceinline__ bool next(int i, pg8::Unit& u) const {
        int q, quad; const int per = nME * nN; if (!deal(i, j, gpx, 2 * per, q, quad)) return false;
        const int e = 2 * x + q / per, rem = q % per, pmE = rem / nN, pn = rem % nN;
        u.arow0 = e * SLOTS_E + pmE * TR; u.col0 = pn * 256; u.e = e; u.quad = quad >= 0;
        if (quad >= 0) { u.arow0 += (quad >> 1) * (TR / 2); u.col0 += (quad & 1) * 128; }
        u.orow0 = u.arow0; return true; }
};

#if X_BF16
typedef bf16 XT;
#else
typedef float XT;
#endif
constexpr float QS_A = 0.125f * 1.4426950408889634f, QS_B = 0.10206207261596577f * 1.4426950408889634f, QS_C = 0.17677669529663687f * 1.4426950408889634f;
typedef float f32x4e __attribute__((ext_vector_type(4)));
#define EPI_ROWS(ai, m) (u.orow0 + (ai) * (32 * MF) + wr * (16 * MF) + (m) * 16 + fr)
#define EPI_COL0(bj) (u.col0 + (bj) * 128 + wc * 32 + 8 * fq)
__device__ __forceinline__ void rope8(f32x4& v0, f32x4& v1, const float* cs, const float* sn) {
    const f32x4 c = *(const f32x4*)cs, s = *(const f32x4*)sn;
    f32x4 a = v0, b = v1;
    v0.x = a.x * c.x - a.y * s.x; v0.y = a.y * c.x + a.x * s.x; v0.z = a.z * c.y - a.w * s.y; v0.w = a.w * c.y + a.z * s.y;
    v1.x = b.x * c.z - b.y * s.z; v1.y = b.y * c.z + b.x * s.z; v1.z = b.z * c.w - b.w * s.w; v1.w = b.w * c.w + b.z * s.w;
}
__device__ __forceinline__ u32x4 pack8(const f32x4 v0, const f32x4 v1) { u32x4 w; w.x = pk2(v0.x, v0.y); w.y = pk2(v0.z, v0.w); w.z = pk2(v1.x, v1.y); w.w = pk2(v1.z, v1.w); return w; }

template <int MF, int NA = 2> struct EpiInProj {
    bf16* P; const float* rope; float* RSQ;
    __device__ __forceinline__ void operator()(const f32x4 (&acc)[NA][2][MF][2], const pg8::Unit& u, int wr, int wc, int fr, int fq) const {
#pragma unroll
        for (int bj = 0; bj < 2; ++bj) {
            if (u.quad && bj) continue;
            const int c0 = EPI_COL0(bj);
            const bool secA = c0 < P_AV, secB = c0 >= P_KR && c0 < P_DV;
            const int which = (c0 >= P_CQ && c0 < P_CKV) ? 0 : ((c0 >= P_CKV && c0 < P_KR) ? 1 : -1);
            const int p0 = secA ? ((c0 & 63) >> 1) : ((c0 & 31) >> 1);
            const float qs = c0 < P_AK ? QS_A : ((c0 >= P_DQ && c0 < P_DK) ? QS_C : 1.f);
#pragma unroll
            for (int ai = 0; ai < NA; ++ai)
#pragma unroll
                for (int m = 0; m < MF; ++m) {
                    if (u.quad && ai) continue;
                    const int row = EPI_ROWS(ai, m);
                    f32x4 v0 = acc[ai][bj][m][0] * qs, v1 = acc[ai][bj][m][1] * qs;
                    if (row < RL && (secA || secB)) { const int t = row & (T - 1);
                        const float* cs = secA ? rope + t * 32 + p0 : rope + T * 64 + t * 16 + p0;
                        const float* sn = secA ? rope + T * 32 + t * 32 + p0 : rope + T * 64 + T * 16 + t * 16 + p0;
                        rope8(v0, v1, cs, sn); }
                    if (which >= 0) { float s = (v0.x * v0.x + v0.y * v0.y) + (v0.z * v0.z + v0.w * v0.w) + (v1.x * v1.x + v1.y * v1.y) + (v1.z * v1.z + v1.w * v1.w);
                        { const int ln_ = fq * 16 + fr; s += shx(s, 16, ln_); s += shx(s, 32, ln_); }
                        if (fq == 0) RSQ[(size_t)row * 12 + ((c0 - P_CQ) >> 5)] = s; }
                    st16(P + (size_t)row * LDP + c0, pack8(v0, v1));
                }
        }
    }
};
template <int MF, int NA = 2> struct EpiUp {
    bf16* QKVM; const float* rope; const float* RSQ;
    __device__ __forceinline__ void operator()(const f32x4 (&acc)[NA][2][MF][2], const pg8::Unit& u, int wr, int wc, int fr, int fq) const {
        const bool isq = u.col0 < 512;
        const float inv = isq ? (1.f / 256.f) : (1.f / 128.f);
        const int cw = u.col0 + wc * 32 + 8 * fq;
        int j0 = cw; j0 -= j0 >= 192 ? 192 : 0; j0 -= j0 >= 96 ? 96 : 0;
        int j1 = j0 + 32; j1 -= j1 >= 96 ? 96 : 0;
        const bool rot0 = isq && cw < 384 && j0 >= 64, rot1 = isq && cw + 128 < 384 && j1 >= 64;
        const float* tb = rope + T * 64;
#pragma unroll
        for (int ai = 0; ai < NA; ++ai)
#pragma unroll
            for (int m = 0; m < MF; ++m) {
                if (u.quad && ai) continue;
                const int row = EPI_ROWS(ai, m);
                const float* rq = RSQ + (size_t)row * 12; float sq;
                if (isq) { const f32x4 pa_ = *(const f32x4*)rq, pb_ = *(const f32x4*)(rq + 4); sq = ((pa_.x + pa_.y) + (pa_.z + pa_.w)) + ((pb_.x + pb_.y) + (pb_.z + pb_.w)); }
                else { const f32x4 pc_ = *(const f32x4*)(rq + 8); sq = (pc_.x + pc_.y) + (pc_.z + pc_.w); }
                const float rs = __builtin_amdgcn_rsqf(sq * inv + EPS) * (isq ? QS_B : 1.f);
                const int t = row & (T - 1);
                bf16* dst = QKVM + (size_t)row * LDM + cw;
                { f32x4 v0 = acc[ai][0][m][0] * rs, v1 = acc[ai][0][m][1] * rs;
                  if (rot0 && row < RL) rope8(v0, v1, tb + t * 16 + ((j0 - 64) >> 1), tb + T * 16 + t * 16 + ((j0 - 64) >> 1));
                  st16(dst, pack8(v0, v1)); }
                if (!u.quad) { f32x4 v0 = acc[ai][1][m][0] * rs, v1 = acc[ai][1][m][1] * rs;
                  if (rot1 && row < RL) rope8(v0, v1, tb + t * 16 + ((j1 - 64) >> 1), tb + T * 16 + t * 16 + ((j1 - 64) >> 1));
                  st16(dst + 128, pack8(v0, v1)); }
            }
    }
};
template <int MF, int NA = 2> struct EpiOut {
    XT* X; const float* MODl; float keep;
    __device__ __forceinline__ void operator()(const f32x4 (&acc)[NA][2][MF][2], const pg8::Unit& u, int wr, int wc, int fr, int fq) const {
#pragma unroll
        for (int ai = 0; ai < NA; ++ai)
#pragma unroll
            for (int m = 0; m < MF; ++m) {
                if (u.quad && ai) continue;
                const int row_ = EPI_ROWS(ai, m); const int mb = row_ < RL ? row_ >> 11 : 8;
                const float* g1 = MODl + (size_t)mb * 6144 + 2048;
#pragma unroll
                for (int bj = 0; bj < 2; ++bj) {
                    if (u.quad && bj) continue;
                    const int c0 = EPI_COL0(bj);
                    const f32x4 ga = *(const f32x4*)(g1 + c0) * keep, gb = *(const f32x4*)(g1 + c0 + 4) * keep;
                    XT* xp = X + (size_t)row_ * D + c0;
#if X_BF16
                    const u32x4 xw = *(const u32x4*)xp;
                    f32x4 xa = (f32x4){bf2f(xw.x & 0xffffu), bf2f(xw.x >> 16), bf2f(xw.y & 0xffffu), bf2f(xw.y >> 16)}, xb = (f32x4){bf2f(xw.z & 0xffffu), bf2f(xw.z >> 16), bf2f(xw.w & 0xffffu), bf2f(xw.w >> 16)};
                    xa += ga * acc[ai][bj][m][0]; xb += gb * acc[ai][bj][m][1];
                    st16(xp, pack8(xa, xb));
#else
                    f32x4 xa = *(const f32x4*)xp, xb = *(const f32x4*)(xp + 4);
                    xa += ga * acc[ai][bj][m][0]; xb += gb * acc[ai][bj][m][1];
                    *(f32x4*)xp = xa; *(f32x4*)(xp + 4) = xb;
#endif
                }
            }
    }
};
template <int MF, int NA = 2> struct EpiGU {
    bf16* HID;
    __device__ __forceinline__ void operator()(const f32x4 (&acc)[NA][2][MF][2], const pg8::Unit& u, int wr, int wc, int fr, int fq) const {
#pragma unroll
        for (int bj = 0; bj < 2; ++bj) {
            if (u.quad && bj) continue;
            const int hc = EPI_COL0(bj) >> 1;
#pragma unroll
            for (int ai = 0; ai < NA; ++ai)
#pragma unroll
                for (int m = 0; m < MF; ++m) {
                    if (u.quad && ai) continue;
                    const f32x4 g = acc[ai][bj][m][0], up = acc[ai][bj][m][1];
                    u32x2 w; w.x = pk2(siluf(g.x) * up.x, siluf(g.y) * up.y); w.y = pk2(siluf(g.z) * up.z, siluf(g.w) * up.w);
                    *(u32x2*)(HID + (size_t)EPI_ROWS(ai, m) * DE + hc) = w;
                }
        }
    }
};
template <int MF, int NA = 2> struct EpiDown {
    bf16* Y; const float* SGATE;
    __device__ __forceinline__ void operator()(const f32x4 (&acc)[NA][2][MF][2], const pg8::Unit& u, int wr, int wc, int fr, int fq) const {
#pragma unroll
        for (int ai = 0; ai < NA; ++ai)
#pragma unroll
            for (int m = 0; m < MF; ++m) {
                if (u.quad && ai) continue;
                const int row = EPI_ROWS(ai, m); const float gt = SGATE[row];
#pragma unroll
                for (int bj = 0; bj < 2; ++bj)
                    if (!(u.quad && bj)) st16(Y + (size_t)row * D + EPI_COL0(bj), pack8(acc[ai][bj][m][0] * gt, acc[ai][bj][m][1] * gt));
            }
    }
};

constexpr int NWAVES = 8;
constexpr int RING_BYTES = 139264;
constexpr int LDSCTL_OFF = RING_BYTES, MISC_OFF = LDSCTL_OFF + 320;
constexpr int LDS_BYTES = 147456;
constexpr int CW_BAR = 4096;
typedef GAS unsigned gu32;

#define XB_TMO      128
#define XB_XCNT(j)  (256  + 64 * (j))
#define XB_XSUB(j)  (1280 + 64 * (j))
#define XB_XGEN(j)  (2304 + 64 * (j))
#define XB_TOP      3328
#define XB_TOPGEN   3392
#define XCD_BAR_WORDS 3456
#define XB_SPIN_CAP (1u << 18)
__device__ __forceinline__ unsigned xb_ld(unsigned* p)              { return __hip_atomic_load(p, __ATOMIC_RELAXED, __HIP_MEMORY_SCOPE_AGENT); }
__device__ __forceinline__ unsigned xb_add(unsigned* p, unsigned v) { return __hip_atomic_fetch_add(p, v, __ATOMIC_RELAXED, __HIP_MEMORY_SCOPE_AGENT); }
__device__ __forceinline__ unsigned xb_xcc_id() { return (unsigned)__builtin_amdgcn_s_getreg((3 << 11) | 20) & 0xFu; }
#define XB_SPIN(cond, bar) do { unsigned _sp = 0; while (cond) { __builtin_amdgcn_s_sleep(1); \
    if ((++_sp & 255u) == 0u) { if (xb_ld(&(bar)[XB_TMO])) break; if (_sp > XB_SPIN_CAP) { atomicAdd(&(bar)[XB_TMO], 1u); break; } } } } while (0)
struct XcdBarrier { unsigned* bar; unsigned x; volatile LAS unsigned* st; };
__device__ __forceinline__ XcdBarrier xcd_barrier_post(unsigned* bar, volatile LAS unsigned* st) {
    XcdBarrier b; b.bar = bar; b.x = xb_xcc_id(); b.st = st;
    if (threadIdx.x == 0) (void)xb_add(&bar[XB_XCNT(b.x)], 1u);
    return b;
}
__device__ __forceinline__ void xcd_barrier_complete(unsigned* bar, unsigned x, unsigned& nloc, unsigned& nx) {
    const unsigned G = gridDim.x * gridDim.y * gridDim.z;
    unsigned sum, cnt, mine, sp = 0u;
    for (;;) {
        sum = 0u; cnt = 0u; mine = 0u;
#pragma unroll
        for (unsigned j = 0; j < 16; ++j) { const unsigned c = xb_ld(&bar[XB_XCNT(j)]); sum += c; cnt += (c > 0u) ? 1u : 0u; mine = (j == x) ? c : mine; }
        if (sum == G) break;
        __builtin_amdgcn_s_sleep(1);
        if ((++sp & 255u) == 0u) { if (xb_ld(&bar[XB_TMO])) break; if (sp > XB_SPIN_CAP) { atomicAdd(&bar[XB_TMO], 1u); break; } }
    }
    nloc = mine > 0u ? mine : 1u; nx = cnt > 0u ? cnt : 1u;
}
__device__ __forceinline__ void xcd_barrier(const XcdBarrier& b, const int tid) {
    asm volatile("s_waitcnt vmcnt(0)" ::: "memory");
    __syncthreads();
    if (tid == 0) {
        unsigned* bar = b.bar;
        __builtin_amdgcn_s_waitcnt(0);
        unsigned nloc = b.st[0], nx = b.st[1];
        if (nloc == 0u) { xcd_barrier_complete(bar, b.x, nloc, nx); b.st[0] = nloc; b.st[1] = nx; }
        const unsigned old = xb_add(&bar[XB_XSUB(b.x)], 1u);
        const unsigned gen = old / nloc;
        if (old + 1u == (gen + 1u) * nloc) {
            __builtin_amdgcn_fence(__ATOMIC_RELEASE, "agent");
            asm volatile("s_waitcnt vmcnt(0)" ::: "memory");
            const unsigned og = xb_add(&bar[XB_TOP], 1u);
            const unsigned tg = og / nx;
            if (og + 1u == (tg + 1u) * nx) xb_add(&bar[XB_TOPGEN], 1u);
            else XB_SPIN(xb_ld(&bar[XB_TOPGEN]) == tg, bar);
            __builtin_amdgcn_fence(__ATOMIC_ACQUIRE, "agent");
            xb_add(&bar[XB_XGEN(b.x)], 1u);
            asm volatile("s_waitcnt vmcnt(0)" ::: "memory");
        } else {
            XB_SPIN(xb_ld(&bar[XB_XGEN(b.x)]) == gen, bar);
            __builtin_amdgcn_fence(__ATOMIC_ACQUIRE, "agent");
            asm volatile("s_waitcnt vmcnt(0)" ::: "memory");
        }
    }
    __syncthreads();
}

struct Frame { LAS unsigned char* lds; int tid, lane, wave, bid, G; const float* const* in; GAS float* out; GAS unsigned char* ws; };
#define IN_(k) ((const float*)(const GAS float*)F.in[(k)])
#define F_x IN_(0)
#define F_c IN_(1)
#define F_ctx IN_(2)
#define F_c_ctx IN_(3)
#define F_norm1 IN_(4)
#define F_norm2 IN_(5)
#define F_w_ada IN_(6)
#define F_b_ada IN_(7)
#define F_w_in IN_(8)
#define F_sink IN_(9)
#define F_mla_q_norm IN_(10)
#define F_w_uq IN_(11)
#define F_mla_kv_norm IN_(12)
#define F_w_ukv IN_(13)
#define F_lq1 IN_(14)
#define F_lk1 IN_(15)
#define F_lq2 IN_(16)
#define F_lk2 IN_(17)
#define F_diff_norm IN_(18)
#define F_w_out IN_(19)
#define F_w_router IN_(20)
#define F_w_gate IN_(21)
#define F_w_up IN_(22)
#define F_w_down IN_(23)
#define F_final_norm IN_(24)
#define F_MOD ((float*)(GAS float*)(F.ws + WS_MOD))
#define F_ROPE ((float*)(GAS float*)(F.ws + WS_ROPE))
#define F_RSQ ((float*)(GAS float*)(F.ws + WS_RSQ))
#define F_AFF ((float*)(GAS float*)(F.ws + WS_AFF))
#define F_INV ((int*)(GAS int*)(F.ws + WS_INV))
#define F_STOK ((int*)(GAS int*)(F.ws + WS_STOK))
#define F_SGATE ((float*)(GAS float*)(F.ws + WS_SGATE))
#define F_X ((float*)(GAS float*)(F.ws + WS_X))
#define F_XB ((bf16*)(GAS bf16*)(F.ws + WS_X))
#define F_ACT ((bf16*)(GAS bf16*)(F.ws + WS_ACT))
#define F_P ((bf16*)(GAS bf16*)(F.ws + WS_P))
#define F_Y ((bf16*)(GAS bf16*)(F.ws + WS_Y))
#define F_QKVM ((bf16*)(GAS bf16*)(F.ws + WS_QKVM))
#define F_O ((bf16*)(GAS bf16*)(F.ws + WS_O))
#define F_HID ((bf16*)(GAS bf16*)(F.ws + WS_HID))
#define F_WB ((bf16*)(GAS bf16*)(F.ws + WS_W))

__device__ __forceinline__ int rot64(int dp) { const int p = dp >> 1, half = dp & 1, axis = p >> 4, f = p & 15; return axis * 32 + half * 16 + f; }
__device__ __forceinline__ int rot32(int dp) { const int p = dp >> 1, half = dp & 1, axis = p >> 3, f = p & 7; return axis * 16 + half * 8 + f; }
__device__ __forceinline__ int src_col_in(int n) {
    if (n >= INW) return -1;
    if (n < P_AV) return (n & ~63) + rot64(n & 63);
    if (n >= P_KR && n < P_DV) return (n & ~31) + rot32(n & 31);
    return n;
}
__device__ __forceinline__ void prep_tile(const float* src, int N, int k0, const float* kscale, bf16* dst, int ldd, LAS float* scr, int lane) {
    float v[32];
#pragma unroll
    for (int i = 0; i < 32; ++i) { const int kk = 2 * i + (lane >> 5); v[i] = src ? src[(size_t)(k0 + kk) * N] : 0.f; }
    if (kscale) {
#pragma unroll
        for (int i = 0; i < 32; ++i) v[i] *= kscale[k0 + 2 * i + (lane >> 5)]; }
#pragma unroll
    for (int i = 0; i < 32; ++i) scr[(2 * i + (lane >> 5)) * 33 + (lane & 31)] = v[i];
    LDS_WAIT();
    const int c = lane & 7;
#pragma unroll
    for (int j = 0; j < 4; ++j) { const int n = (lane >> 3) + 8 * j; const LAS float* s = scr + (8 * c) * 33 + n;
        u32x4 o; o.x = pk2(s[0], s[33]); o.y = pk2(s[66], s[99]); o.z = pk2(s[132], s[165]); o.w = pk2(s[198], s[231]);
        *(u32x4*)(dst + (size_t)n * ldd + 8 * c) = o; }
    LDS_WAIT();
}
constexpr int PI_IN = 16 * 64, PI_UP = 6 * 32, PI_OUT = 16 * 32, PI_GU = NE * 16 * 32, PI_DN = NE * 8 * 32, PI_LAYER = PI_IN + PI_UP + PI_OUT + PI_GU + PI_DN;
#ifndef BG_PREP
#define BG_PREP 0
#ifndef MOE_PF
#define MOE_PF 0
#endif
#endif
__device__ __forceinline__ void prep_layer(Frame& F, const int l, const int worker, const int nworkers) {
    const int lane = F.lane, wave = F.wave;
    LAS float* scr = (LAS float*)(F.lds + 57344 + wave * 8448);
    for (int it = worker; it < PI_LAYER; it += nworkers) {
        int r = it; bf16* wl = F_WB + (size_t)l * W_LAYER;
        const int nl = lane & 31;
        if (r < PI_IN) { const int kb = r / 64, nb = r % 64, n = nb * 32 + nl, sc = src_col_in(n);
            prep_tile(sc >= 0 ? F_w_in + (size_t)l * D * INW + sc : nullptr, INW, kb * 64, nullptr, wl + W_IN + (size_t)(nb * 32) * D + kb * 64, D, scr, lane); continue; } r -= PI_IN;
        if (r < PI_UP) { const int kb = r / 32, nb = r % 32, n = nb * 32 + nl, k0 = kb * 64; const float* src = nullptr; const float* ks = nullptr; int N = 384, ksrc = k0;
            if (n < 384 && k0 < 256) { const int h = n / 96, j = n % 96; const int sc = j < 64 ? n : h * 96 + 64 + rot32(j - 64); src = F_w_uq + (size_t)l * 256 * 384 + sc; ks = F_mla_q_norm + l * 256; N = 384; }
            else if (n >= 512 && k0 >= 256) { src = F_w_ukv + (size_t)l * 128 * 512 + (n - 512); ks = F_mla_kv_norm + l * 128; N = 512; ksrc = k0 - 256; }
            { float v[32];
#pragma unroll
              for (int i = 0; i < 32; ++i) { const int kk = 2 * i + (lane >> 5); v[i] = src ? src[(size_t)(ksrc + kk) * N] * ks[ksrc + kk] : 0.f; }
#pragma unroll
              for (int i = 0; i < 32; ++i) scr[(2 * i + (lane >> 5)) * 33 + (lane & 31)] = v[i];
              LDS_WAIT();
              const int c = lane & 7; bf16* dst = wl + W_UP + (size_t)(nb * 32) * UPK + k0;
#pragma unroll
              for (int j = 0; j < 4; ++j) { const int nn = (lane >> 3) + 8 * j; const LAS float* s = scr + (8 * c) * 33 + nn;
                  u32x4 o; o.x = pk2(s[0], s[33]); o.y = pk2(s[66], s[99]); o.z = pk2(s[132], s[165]); o.w = pk2(s[198], s[231]);
                  *(u32x4*)(dst + (size_t)nn * UPK + 8 * c) = o; }
              LDS_WAIT(); }
            continue; } r -= PI_UP;
        if (r < PI_OUT) { const int kb = r / 32, nb = r % 32;
            prep_tile(F_w_out + (size_t)l * D * D + nb * 32 + nl, D, kb * 64, nullptr, wl + W_OUT + (size_t)(nb * 32) * D + kb * 64, D, scr, lane); continue; } r -= PI_OUT;
        if (r < PI_GU) { const int e = r / 512, q = r % 512, kb = q / 32, nb = q % 32, n = nb * 32 + nl, f = (n >> 3) * 4 + (n & 3);
            const float* src = ((n & 4) ? F_w_up : F_w_gate) + ((size_t)l * NE + e) * D * DE + f;
            prep_tile(src, DE, kb * 64, nullptr, wl + W_GU + (size_t)e * 1024 * 1024 + (size_t)(nb * 32) * D + kb * 64, D, scr, lane); continue; } r -= PI_GU;
        { const int e = r / 256, q = r % 256, kb = q / 32, nb = q % 32;
            prep_tile(F_w_down + ((size_t)l * NE + e) * DE * D + nb * 32 + nl, D, kb * 64, nullptr, wl + W_DN + (size_t)e * 1024 * 512 + (size_t)(nb * 32) * DE + kb * 64, DE, scr, lane); }
    }
}

__device__ __forceinline__ void p0_phase(Frame& F) {
    const int tid = F.tid, lane = F.lane, wave = F.wave;
    {
        LAS float* sl = (LAS float*)F.lds;
        LAS float* red = (LAS float*)(F.lds + 36864);
        for (int i = tid; i < 9 * 1024; i += 512) { const float v = i < 8 * 1024 ? F_c[i] : F_c_ctx[i - 8 * 1024]; sl[i] = siluf(v); }
        __syncthreads();
        for (int it = F.bid; it < DEPTH * 96; it += F.G) {
            const int l = it / 96, cg = it % 96, col = cg * 64 + lane;
            float acc[9];
#pragma unroll
            for (int r = 0; r < 9; ++r) acc[r] = 0.f;
            const float* w = F_w_ada + (size_t)l * D * 6144 + (size_t)(wave * 128) * 6144 + col;
#pragma unroll 16
            for (int k = 0; k < 128; ++k) { const float wv = w[(size_t)k * 6144];
#pragma unroll
                for (int r = 0; r < 9; ++r) acc[r] += sl[r * 1024 + wave * 128 + k] * wv; }
#pragma unroll
            for (int r = 0; r < 9; ++r) red[(wave * 9 + r) * 64 + lane] = acc[r];
            __syncthreads();
            for (int o = tid; o < 576; o += 512) { const int r = o >> 6, cc = o & 63; float s = 0.f;
#pragma unroll
                for (int w8 = 0; w8 < 8; ++w8) s += red[(w8 * 9 + r) * 64 + cc];
                F_MOD[((size_t)l * 9 + r) * 6144 + cg * 64 + cc] = s + F_b_ada[l * 6144 + cg * 64 + cc]; }
            __syncthreads();
        }
    }
    const int gw = F.bid * NWAVES + wave, NGW = F.G * NWAVES;
    { const size_t n4 = (size_t)R * D / 4, nl4 = (size_t)RL * D / 4;
      for (size_t i = (size_t)F.bid * 512 + tid; i < n4; i += (size_t)F.G * 512) { const f32x4 v = i < nl4 ? ((const f32x4*)F_x)[i] : ((const f32x4*)F_ctx)[i - nl4];
#if X_BF16
          u32x2 w; w.x = pk2(v.x, v.y); w.y = pk2(v.z, v.w); ((u32x2*)F_XB)[i] = w; } }
#else
          ((f32x4*)F_X)[i] = v; } }
#endif
    for (int i = F.bid * 512 + tid; i < T * 48; i += F.G * 512) {
        const int t = i / 48, j = i % 48; int axis, f, nf;
        if (j < 32) { axis = j >> 4; f = j & 15; nf = 16; } else { axis = (j - 32) >> 3; f = (j - 32) & 7; nf = 8; }
        const float inv = exp2f(-(float)f / (float)nf * 13.287712379549449f);
        const float ang = (float)(axis == 0 ? (t >> 6) : (t & 63)) * inv;
        const float cv = cosf(ang), sv = sinf(ang);
        if (j < 32) { F_ROPE[t * 32 + j] = cv; F_ROPE[T * 32 + t * 32 + j] = sv; } else { F_ROPE[T * 64 + t * 16 + j - 32] = cv; F_ROPE[T * 64 + T * 16 + t * 16 + j - 32] = sv; }
    }
    for (int l = 0; l < (BG_PREP ? 1 : DEPTH); ++l) prep_layer(F, l, gw, NGW);
}

#ifndef PROBE_NOROUTER
#define PROBE_NOROUTER 0
#endif
#define half_swap_add(keepv, sendv, off) ((keepv) + shx((sendv), (off), lane))
__device__ __forceinline__ void norm_phase(Frame& F, int l, int mode, int nrows, const float keep) {
    const int lane = F.lane, gw = F.bid * NWAVES + F.wave, NGW = F.G * NWAVES;
    LAS float* wrT = (LAS float*)F.lds;
    if (mode == 1) {
        const float* wr = F_w_router + (size_t)l * D * NE;
        for (int i = F.tid; i < D * NE; i += 512) wrT[(i & 15) * 1028 + (i >> 4)] = wr[i];
        __syncthreads();
    }
    const float* gain = mode == 0 ? F_norm1 + (size_t)l * D : (mode == 1 ? F_norm2 + (size_t)l * D : F_final_norm);
    const bool comb = mode != 1 && l > 0;
    f32x4 vn[2][4];
#if X_BF16
#define NORM_LOAD(dst, rr0) do { _Pragma("unroll") for (int q = 0; q < 2; ++q) _Pragma("unroll") for (int j = 0; j < 4; ++j) { const u32x2 w_ = ((const u32x2*)(F_XB + (size_t)((rr0) + q) * D))[lane + 64 * j]; \
        dst[q][j] = (f32x4){bf2f(w_.x & 0xffffu), bf2f(w_.x >> 16), bf2f(w_.y & 0xffffu), bf2f(w_.y >> 16)}; } } while (0)
#else
#define NORM_LOAD(dst, rr0) do { _Pragma("unroll") for (int q = 0; q < 2; ++q) _Pragma("unroll") for (int j = 0; j < 4; ++j) dst[q][j] = ((const f32x4*)(F_X + (size_t)((rr0) + q) * D))[lane + 64 * j]; } while (0)
#endif
    if (gw * 2 < nrows) NORM_LOAD(vn, gw * 2);
    for (int r0 = gw * 2; r0 < nrows; r0 += NGW * 2) {
        const int mb = r0 < RL ? r0 / T : 8;
        f32x4 v[2][4];
#pragma unroll
        for (int q = 0; q < 2; ++q)
#pragma unroll
            for (int j = 0; j < 4; ++j) v[q][j] = vn[q][j];
        if (r0 + NGW * 2 < nrows) NORM_LOAD(vn, r0 + NGW * 2);
        if (comb) {
            const float* g2 = F_MOD + ((size_t)(l - 1) * 9 + mb) * 6144 + 5120;
            const int myinv = lane < 2 * NE ? F_INV[(size_t)r0 * NE + lane] : -1;
            f32x4 s[2][4];
#pragma unroll
            for (int q = 0; q < 2; ++q)
#pragma unroll
                for (int j = 0; j < 4; ++j) s[q][j] = (f32x4){0.f, 0.f, 0.f, 0.f};
            for (int e = 0; e < NE; ++e) {
#pragma unroll
                for (int q = 0; q < 2; ++q) { const int sl = shi(myinv, q * NE + e);
                    if (sl >= 0) { const bf16* yr = F_Y + (size_t)sl * D;
#pragma unroll
                        for (int j = 0; j < 4; ++j) { const u32x2 w = ((const u32x2*)yr)[lane + 64 * j];
                            s[q][j].x += bf2f(w.x & 0xffff); s[q][j].y += bf2f(w.x >> 16); s[q][j].z += bf2f(w.y & 0xffff); s[q][j].w += bf2f(w.y >> 16); } } } }
#pragma unroll
            for (int j = 0; j < 4; ++j) { const f32x4 g = ((const f32x4*)g2)[lane + 64 * j];
#pragma unroll
                for (int q = 0; q < 2; ++q) { v[q][j] += g * s[q][j] * keep;
#if X_BF16
                    u32x2 w; w.x = pk2(v[q][j].x, v[q][j].y); w.y = pk2(v[q][j].z, v[q][j].w); ((u32x2*)(F_XB + (size_t)(r0 + q) * D))[lane + 64 * j] = w;
#else
                    ((f32x4*)(F_X + (size_t)(r0 + q) * D))[lane + 64 * j] = v[q][j];
#endif
                } }
        }
        float ss0 = 0.f, ss1 = 0.f;
#pragma unroll
        for (int j = 0; j < 4; ++j) { ss0 += (v[0][j].x * v[0][j].x + v[0][j].y * v[0][j].y) + (v[0][j].z * v[0][j].z + v[0][j].w * v[0][j].w);
                                      ss1 += (v[1][j].x * v[1][j].x + v[1][j].y * v[1][j].y) + (v[1][j].z * v[1][j].z + v[1][j].w * v[1][j].w); }
#pragma unroll
        for (int o = 1; o < 64; o <<= 1) { ss0 += shx(ss0, o, lane); ss1 += shx(ss1, o, lane); }
        const float rs[2] = {1.0f / sqrtf(ss0 * (1.f / D) + EPS), 1.0f / sqrtf(ss1 * (1.f / D) + EPS)};
        if (mode == 2) {
#pragma unroll
            for (int j = 0; j < 4; ++j) { const f32x4 g = ((const f32x4*)gain)[lane + 64 * j];
#pragma unroll
                for (int q = 0; q < 2; ++q) ((f32x4*)((float*)F.out + (size_t)(r0 + q) * D))[lane + 64 * j] = v[q][j] * rs[q] * g; }
        } else {
            const float* md = F_MOD + ((size_t)l * 9 + mb) * 6144 + (mode == 0 ? 0 : 3072);
#pragma unroll
            for (int j = 0; j < 4; ++j) { const f32x4 g = ((const f32x4*)gain)[lane + 64 * j];
                const f32x4 sh = ((const f32x4*)md)[lane + 64 * j], sc = ((const f32x4*)(md + 1024))[lane + 64 * j];
#pragma unroll
                for (int q = 0; q < 2; ++q) { v[q][j] = v[q][j] * rs[q] * g * (sc + 1.0f) + sh;
                    u32x2 w; w.x = pk2(v[q][j].x, v[q][j].y); w.y = pk2(v[q][j].z, v[q][j].w);
                    ((u32x2*)(F_ACT + (size_t)(r0 + q) * D))[lane + 64 * j] = w; } }
            if (mode == 1 && !(PROBE_NOROUTER && keep == 0.f)) {
                float a[2][NE];
                typedef float f32x2r __attribute__((ext_vector_type(2)));
#pragma unroll
                for (int e = 0; e < NE; ++e) { f32x2r p0 = {0.f, 0.f}, p1 = {0.f, 0.f};
#pragma unroll
                    for (int j = 0; j < 4; ++j) { const f32x4 w = *(const LAS f32x4*)(wrT + e * 1028 + 256 * j + 4 * lane);
                        const f32x2r wl = {w.x, w.y}, wh = {w.z, w.w};
                        p0 = __builtin_elementwise_fma((f32x2r){v[0][j].x, v[0][j].y}, wl, p0); p0 = __builtin_elementwise_fma((f32x2r){v[0][j].z, v[0][j].w}, wh, p0);
                        p1 = __builtin_elementwise_fma((f32x2r){v[1][j].x, v[1][j].y}, wl, p1); p1 = __builtin_elementwise_fma((f32x2r){v[1][j].z, v[1][j].w}, wh, p1); }
                    a[0][e] = p0.x + p0.y; a[1][e] = p1.x + p1.y; if ((e & 1) == 1) __builtin_amdgcn_sched_barrier(0); }
                float b16[NE];
#pragma unroll
                for (int e = 0; e < NE; ++e) { const bool up = lane >= 32; b16[e] = half_swap_add(up ? a[1][e] : a[0][e], up ? a[0][e] : a[1][e], 32); }
                float b8[8];
#pragma unroll
                for (int e = 0; e < 8; ++e) { const bool up = (lane & 16) != 0; b8[e] = half_swap_add(up ? b16[8 + e] : b16[e], up ? b16[e] : b16[8 + e], 16); }
                float b4[4];
#pragma unroll
                for (int e = 0; e < 4; ++e) { const bool up = (lane & 8) != 0; b4[e] = half_swap_add(up ? b8[4 + e] : b8[e], up ? b8[e] : b8[4 + e], 8); }
                float b2[2];
#pragma unroll
                for (int e = 0; e < 2; ++e) { const bool up = (lane & 4) != 0; b2[e] = half_swap_add(up ? b4[2 + e] : b4[e], up ? b4[e] : b4[2 + e], 4); }
                float lg; { const bool up = (lane & 2) != 0; lg = half_swap_add(up ? b2[1] : b2[0], up ? b2[0] : b2[1], 2); }
                lg += shx(lg, 1, lane);
                float mx = lg;
#pragma unroll
                for (int o = 2; o < 32; o <<= 1) mx = fmaxf(mx, shx(mx, o, lane));
                const float ex = __expf(lg - mx); float sum = ex;
#pragma unroll
                for (int o = 2; o < 32; o <<= 1) sum += shx(sum, o, lane);
                const int eidx = ((lane >> 4) & 1) * 8 + ((lane >> 3) & 1) * 4 + ((lane >> 2) & 1) * 2 + ((lane >> 1) & 1);
                if ((lane & 1) == 0) F_AFF[(size_t)(r0 + (lane >> 5)) * NE + eidx] = ex / sum;
            }
        }
    }
}

#undef NORM_LOAD
__device__ __forceinline__ void topk_phase(Frame& F, int nsets) {
    LAS unsigned* cnt = (LAS unsigned*)F.lds;
    const int tid = F.tid, lane = F.lane, wave = F.wave;
    for (int it = F.bid; it < nsets * NE; it += F.G) {
        const int set = it / NE, e = it % NE; const bool lat = set < 8; const int b = lat ? set : set - 8;
        const int n = lat ? T : LC, cap = lat ? CAPL : CAPC, row0 = lat ? b * T : RL + b * LC, slot0 = e * SLOTS_E + (lat ? b * CAPL : NB * CAPL + b * CAPC);
        unsigned v[4];
#pragma unroll
        for (int q = 0; q < 4; ++q) { const int idx = 4 * tid + q; v[q] = idx < n ? __builtin_bit_cast(unsigned, F_AFF[(size_t)(row0 + idx) * NE + e]) : 0u; }
        unsigned prefix = 0u; int par = 0;
        for (int bit = 30; bit >= 0; --bit) {
            const unsigned cand = prefix | (1u << bit);
            unsigned c = 0;
#pragma unroll
            for (int q = 0; q < 4; ++q) c += (unsigned)__popcll(__ballot(v[q] >= cand));
            if (lane == 0) cnt[par * 8 + wave] = c;
            __syncthreads();
            unsigned tot = 0;
#pragma unroll
            for (int w = 0; w < 8; ++w) tot += cnt[par * 8 + w];
            if (tot >= (unsigned)cap) prefix = cand;
            par ^= 1;
        }
        unsigned g4 = 0, e4 = 0;
#pragma unroll
        for (int q = 0; q < 4; ++q) { g4 += v[q] > prefix ? 1u : 0u; e4 += v[q] == prefix ? 1u : 0u; }
        unsigned pk = g4 | (e4 << 16), inc = pk;
#pragma unroll
        for (int o = 1; o < 64; o <<= 1) { const unsigned t = (unsigned)shi((int)inc, lane - o); if (lane >= o) inc += t; }
        __syncthreads();
        if (lane == 63) cnt[16 + wave] = inc;
        __syncthreads();
        unsigned base = 0, total = 0;
#pragma unroll
        for (int w = 0; w < 8; ++w) { const unsigned t = cnt[16 + w]; total += t; if (w < wave) base += t; }
        const unsigned excl = base + inc - pk;
        unsigned gpre = excl & 0xffffu, epre = excl >> 16; const unsigned need = (unsigned)cap - (total & 0xffffu);
#pragma unroll
        for (int q = 0; q < 4; ++q) { const int idx = 4 * tid + q;
            if (idx < n) { const bool isg = v[q] > prefix, ise = v[q] == prefix; const bool sel = isg || (ise && epre < need);
                const int slot = slot0 + (int)(gpre + (epre < need ? epre : need));
                if (sel) { F_STOK[slot] = row0 + idx; F_SGATE[slot] = __builtin_bit_cast(float, v[q]); }
                F_INV[(size_t)(row0 + idx) * NE + e] = sel ? slot : -1;
                gpre += isg ? 1u : 0u; epre += ise ? 1u : 0u; } }
        __syncthreads();
    }
}

#ifndef ATT_EXTRA
#define ATT_EXTRA 0
#define ATT_EXTRA_TYPE 0
#endif
#ifndef ATT_LATE_DMA
#define ATT_LATE_DMA 0
#endif
#ifndef ATT_STAGGER
#define ATT_STAGGER 1
#endif
#ifndef ATT_XVAR
#define ATT_XVAR 0
#endif
#ifndef ATT_XSTEPS
#define ATT_XSTEPS 4
#endif
namespace att {
typedef short s16x4 __attribute__((ext_vector_type(4)));
typedef float f32x2_t __attribute__((ext_vector_type(2)));
typedef __bf16 bf16x2_t __attribute__((ext_vector_type(2)));
constexpr int L_K = 0, KBUF = 16384, L_V = 2 * KBUF, VBUF = 8192, L_WS = L_V + 2 * VBUF, L_OST = L_WS + 8 * 256, L_END = L_OST + 8 * 4096;
#define ATT_SBAR() __builtin_amdgcn_sched_barrier(0)
#define ATT_SGB(mask, n) __builtin_amdgcn_sched_group_barrier(mask, n, 0)
__device__ __forceinline__ int crow(int r, int hi) { return (r & 3) + 8 * (r >> 2) + 4 * hi; }
__device__ __forceinline__ unsigned cvtpk(float lo, float hi) { f32x2_t v = {lo, hi}; bf16x2_t b = __builtin_convertvector(v, bf16x2_t); return __builtin_bit_cast(unsigned, b); }
__device__ __forceinline__ int v_st(int k, int c) { const int kk = k; return ((kk >> 3) * 2 + (c >> 5)) * 512 + ((kk & 7) * 32 + (c & 31)) * 2; }
__device__ __forceinline__ int v_rd_base(int lane) { return ((lane & 3) << 3) | (((lane >> 2) & 3) << 6) | (((lane >> 4) & 1) << 5) | (((lane >> 5) & 1) << 8); }
typedef short v4i16_t __attribute__((ext_vector_type(4)));
template <int OFF> __device__ __forceinline__ s16x4 tr_read(int vb) { s16x4 r; asm volatile("ds_read_b64_tr_b16 %0, %1 offset:%2" : "=&v"(r) : "v"(vb), "i"(OFF) : "memory"); return r; }
struct VFrag { s16x4 l0, h0, l1, h1, l2, h2, l3, h3; };
template <int D0> __device__ __forceinline__ void vread(VFrag& f, int vb) {
    f.l0 = tr_read<D0 * 512 + 0 * 2048>(vb); f.h0 = tr_read<D0 * 512 + 0 * 2048 + 1024>(vb); f.l1 = tr_read<D0 * 512 + 1 * 2048>(vb); f.h1 = tr_read<D0 * 512 + 1 * 2048 + 1024>(vb);
    f.l2 = tr_read<D0 * 512 + 2 * 2048>(vb); f.h2 = tr_read<D0 * 512 + 2 * 2048 + 1024>(vb); f.l3 = tr_read<D0 * 512 + 3 * 2048>(vb); f.h3 = tr_read<D0 * 512 + 3 * 2048 + 1024>(vb);
}
__device__ __forceinline__ void pv_mma(f32x16& od, const VFrag& f, bf16x8 pa0, bf16x8 pa1, bf16x8 pa2, bf16x8 pa3) {
#define ATT_PK(L, H) (bf16x8){L[0], L[1], L[2], L[3], H[0], H[1], H[2], H[3]}
    od = __builtin_amdgcn_mfma_f32_32x32x16_bf16(pa0, ATT_PK(f.l0, f.h0), od, 0, 0, 0);
    od = __builtin_amdgcn_mfma_f32_32x32x16_bf16(pa1, ATT_PK(f.l1, f.h1), od, 0, 0, 0);
    od = __builtin_amdgcn_mfma_f32_32x32x16_bf16(pa2, ATT_PK(f.l2, f.h2), od, 0, 0, 0);
    od = __builtin_amdgcn_mfma_f32_32x32x16_bf16(pa3, ATT_PK(f.l3, f.h3), od, 0, 0, 0);
#undef ATT_PK
}
template <int D0> __device__ __forceinline__ void pv_one(f32x16& od, int vb, bf16x8 pa0, bf16x8 pa1, bf16x8 pa2, bf16x8 pa3) {
    VFrag f; vread<D0>(f, vb); asm volatile("s_waitcnt lgkmcnt(0)" ::: "memory"); ATT_SBAR(); pv_mma(od, f, pa0, pa1, pa2, pa3);
}
struct Tensors { const bf16* P; const bf16* QKVM; bf16* O; const float* sink; const float* dnorm; float lam, lam_init; int l; };

constexpr float THR = 8.f;
__device__ __forceinline__ float mx3(float a, float b, float c) { float d; asm("v_max3_f32 %0, %1, %2, %3" : "=v"(d) : "v"(a), "v"(b), "v"(c)); return d; }
__device__ __forceinline__ float mx2(float a, float b) { float d; asm("v_max_f32 %0, %1, %2" : "=v"(d) : "v"(a), "v"(b)); return d; }
__device__ __forceinline__ float rowmax32(const f32x16& p0, const f32x16& p1) {
    const float a0 = mx3(p0[0], p0[1], p0[2]), a1 = mx3(p0[3], p0[4], p0[5]), a2 = mx3(p0[6], p0[7], p0[8]), a3 = mx3(p0[9], p0[10], p0[11]), a4 = mx3(p0[12], p0[13], p0[14]);
    const float b0 = mx3(p1[0], p1[1], p1[2]), b1 = mx3(p1[3], p1[4], p1[5]), b2 = mx3(p1[6], p1[7], p1[8]), b3 = mx3(p1[9], p1[10], p1[11]), b4 = mx3(p1[12], p1[13], p1[14]);
    const float c0 = mx3(a0, a1, a2), c1 = mx3(a3, a4, p0[15]), c2 = mx3(b0, b1, b2), c3 = mx3(b3, b4, p1[15]);
    const float m = mx2(mx3(c0, c1, c2), c3);
    auto rr = __builtin_amdgcn_permlane32_swap(__float_as_uint(m), __float_as_uint(m), false, false);
    return mx2(__uint_as_float(rr[0]), __uint_as_float(rr[1]));
}
__device__ __forceinline__ void partialSM(f32x16& p0, f32x16& p1, const float rm, float& mhat, f32x16& negm, float& alpha) {
    alpha = 1.f;
    if (__builtin_expect(__any(rm > THR), 0)) {
        const float dl = fmaxf(rm, 0.f); mhat += dl;
#pragma unroll
        for (int r = 0; r < 16; ++r) { p0[r] -= dl; p1[r] -= dl; }
#pragma unroll
        for (int r = 0; r < 16; ++r) negm[r] = -mhat;
        asm volatile("" : "+v"(negm));
        alpha = __builtin_amdgcn_exp2f(-dl);
    }
}
__device__ __forceinline__ void finishSM(f32x16& p0, f32x16& p1, const float alpha, float& l_reg, bf16x8& pa0, bf16x8& pa1, bf16x8& pa2, bf16x8& pa3) {
#pragma unroll
    for (int r = 0; r < 16; ++r) { p0[r] = __builtin_amdgcn_exp2f(p0[r]); p1[r] = __builtin_amdgcn_exp2f(p1[r]); }
    float ps = 0.f, pt = 0.f;
#pragma unroll
    for (int r = 0; r < 16; ++r) { ps += p0[r]; pt += p1[r]; }
    l_reg = l_reg * alpha + (ps + pt);
#define ATT_PK8(P, BASE, OUT) do { u32x4 w = {cvtpk(P[BASE + 0], P[BASE + 1]), cvtpk(P[BASE + 2], P[BASE + 3]), cvtpk(P[BASE + 4], P[BASE + 5]), cvtpk(P[BASE + 6], P[BASE + 7])}; OUT = __builtin_bit_cast(bf16x8, w); } while (0)
    ATT_PK8(p0, 0, pa0); ATT_PK8(p0, 8, pa1); ATT_PK8(p1, 0, pa2); ATT_PK8(p1, 8, pa3);
#undef ATT_PK8
}
template <int ROWB> __device__ __forceinline__ int kswz(int row, int cb) { return row * ROWB + (ROWB == 128 ? (cb ^ (((row >> 1) & 7) << 4)) : (cb ^ ((row & 15) << 4))); }
template <int NB, int ROWB, int CB0, int D00> __device__ __forceinline__ void kread(bf16x8 (&kf)[2 * NB], const LAS unsigned char* Kb, int r32, int hi) {
#pragma unroll
    for (int d = 0; d < NB; ++d) { const int cb = CB0 + ((D00 + d) * 16 + hi * 8) * 2;
        kf[2 * d] = *(const LAS bf16x8*)(Kb + kswz<ROWB>(r32, cb)); kf[2 * d + 1] = *(const LAS bf16x8*)(Kb + kswz<ROWB>(32 + r32, cb)); }
}
template <int NB, int D00> __device__ __forceinline__ void kmma(f32x16& p0, f32x16& p1, const bf16x8 (&kf)[2 * NB], const bf16x8* qr, const f32x16& negm) {
#pragma unroll
    for (int d = 0; d < NB; ++d) {
        if (D00 + d == 0) { p0 = __builtin_amdgcn_mfma_f32_32x32x16_bf16(kf[0], qr[0], negm, 0, 0, 0); p1 = __builtin_amdgcn_mfma_f32_32x32x16_bf16(kf[1], qr[0], negm, 0, 0, 0); }
        else { p0 = __builtin_amdgcn_mfma_f32_32x32x16_bf16(kf[2 * d], qr[D00 + d], p0, 0, 0, 0); p1 = __builtin_amdgcn_mfma_f32_32x32x16_bf16(kf[2 * d + 1], qr[D00 + d], p1, 0, 0, 0); } }
}
template <int NKS, int ROWB, int CB0> __device__ __forceinline__ void qkt2(f32x16& p0, f32x16& p1, const LAS unsigned char* Kb, const bf16x8* qr, const f32x16& negm, int r32, int hi) {
    constexpr int N1 = NKS > 4 ? 3 : NKS, N2 = NKS - N1;
    bf16x8 ka[2 * N1]; kread<N1, ROWB, CB0, 0>(ka, Kb, r32, hi);
    if constexpr (N2 > 0) { bf16x8 kb[2 * N2]; kread<N2, ROWB, CB0, N1>(kb, Kb, r32, hi);
        kmma<N1, 0>(p0, p1, ka, qr, negm); kmma<N2, N1>(p0, p1, kb, qr, negm); }
    else kmma<N1, 0>(p0, p1, ka, qr, negm);
}

template <int TYPE> struct Ring { static constexpr int KSLOT = TYPE == 1 ? 16384 : 8192, VSLOT = 8192, L_K = 0, L_V = 3 * KSLOT, L_WS = L_V + 4 * VSLOT, L_OST = L_WS + 2048; };
template <int TYPE, int CB0> __device__ __forceinline__ void flash_pass(const Tensors& Tn, LAS unsigned char* lds, const int tid, const int b, const int h, const bool lat, const int q0, const int wrow, const int var, const bf16x8* qr,
                                                                        f32x16 (&o)[2], float& l_out, float& m_out) {
    constexpr int NKS = TYPE == 0 ? 4 : (TYPE == 1 ? 6 : 2);
    constexpr int ROWB = TYPE == 1 ? 256 : 128;
    typedef Ring<TYPE> RG;
    const int lane = tid & 63, wid = __builtin_amdgcn_readfirstlane(tid >> 6), r32 = lane & 31, hi = lane >> 5;
    LAS float* al_l = (LAS float*)(lds + RG::L_WS) + wid * 64;
    const int kvh = h >> 2;
    const bf16* Kp = TYPE == 0 ? Tn.P + P_AK + kvh * 64 : (TYPE == 1 ? Tn.QKVM + 512 + h * 128 : Tn.P + P_DK + h * 64);
    const bf16* Vp = TYPE == 0 ? Tn.P + P_AV + kvh * 64 : (TYPE == 1 ? Tn.QKVM + 512 + h * 128 + 64 : Tn.P + P_DV + h * 64);
    constexpr int KPITCH = TYPE == 1 ? LDM : LDP;
    int kl0 = 0, nloc = 0;
    if (lat) { if (TYPE == 0) { kl0 = q0 - 128 < 0 ? 0 : q0 - 128; const int kl1 = q0 + 64 + 128 > T ? T : q0 + 64 + 128; nloc = (kl1 - kl0) >> 6; } else { kl0 = 0; nloc = T / 64; } }
    const int NT = 4 + nloc;
    const int crow0 = RL + b * LC, lrow0 = b * T + kl0;
#define ATT_TROW(i) ((var & 64) ? crow0 : ((i) < 4 ? crow0 + 64 * (i) : lrow0 + 64 * ((i) - 4)))
    const bf16* ksrc0; const bf16* ksrc1 = nullptr;
    if (TYPE != 1) { const int row = 8 * wid + (lane >> 3), c = (lane & 7) ^ ((row >> 1) & 7); ksrc0 = Kp + (size_t)row * KPITCH + c * 8; }
    else {
        { const int row = 8 * wid + (lane >> 4), c = (lane & 15) ^ (row & 15); ksrc0 = c < 8 ? Kp + (size_t)row * LDM + c * 8 : (c < 12 ? Tn.P + (size_t)row * LDP + P_KR + (c - 8) * 8 : Kp + (size_t)row * LDM); }
        { const int row = 8 * wid + 4 + (lane >> 4), c = (lane & 15) ^ (row & 15); ksrc1 = c < 8 ? Kp + (size_t)row * LDM + c * 8 : (c < 12 ? Tn.P + (size_t)row * LDP + P_KR + (c - 8) * 8 : Kp + (size_t)row * LDM); }
    }
    const bool k0p = TYPE == 1 && (((lane & 15) ^ ((8 * wid + (lane >> 4)) & 15)) >= 8) && (((lane & 15) ^ ((8 * wid + (lane >> 4)) & 15)) < 12);
    const bool k1p = TYPE == 1 && (((lane & 15) ^ ((8 * wid + 4 + (lane >> 4)) & 15)) >= 8) && (((lane & 15) ^ ((8 * wid + 4 + (lane >> 4)) & 15)) < 12);
    const bf16* vsrc = Vp + (size_t)(8 * wid + ((lane & 31) >> 2)) * KPITCH + (lane >> 5) * 32 + (lane & 3) * 8;
#define ATT_DMA_K(i, slot) do { if (var & 8) break; const int g_ = ATT_TROW((i) < NT ? (i) : NT - 1); \
        __builtin_amdgcn_global_load_lds((const unsigned*)(ksrc0 + (size_t)g_ * (k0p ? LDP : KPITCH)), (LAS unsigned*)(lds + RG::L_K + (slot) * RG::KSLOT + wid * (ROWB * 8)), 16, 0, 0); \
        if (TYPE == 1) __builtin_amdgcn_global_load_lds((const unsigned*)(ksrc1 + (size_t)g_ * (k1p ? LDP : KPITCH)), (LAS unsigned*)(lds + RG::L_K + (slot) * RG::KSLOT + wid * (ROWB * 8) + 1024), 16, 0, 0); } while (0)
#define ATT_DMA_V(i, slot) do { if (var & 8) break; const int g_ = ATT_TROW((i) < NT ? (i) : NT - 1); \
        __builtin_amdgcn_global_load_lds((const unsigned*)(vsrc + (size_t)g_ * KPITCH), (LAS unsigned*)(lds + RG::L_V + (slot) * RG::VSLOT + wid * 1024), 16, 0, 0); } while (0)
#define ATT_WAITBAR() do { if (var & 16) break; if (TYPE == 1) asm volatile("s_waitcnt vmcnt(3)" ::: "memory"); else asm volatile("s_waitcnt vmcnt(2)" ::: "memory"); __builtin_amdgcn_s_barrier(); asm volatile("" ::: "memory"); } while (0)
#define ATT_RESC(a) do { if (__any((a) < 1.f)) { if (hi == 0) al_l[r32] = (a); asm volatile("s_waitcnt lgkmcnt(0)" ::: "memory"); \
        _Pragma("unroll") for (int r = 0; r < 16; ++r) { const float f_ = al_l[crow(r, hi)]; o[0][r] *= f_; o[1][r] *= f_; } } } while (0)
    const int qpos = q0 + wrow + r32;
#define ATT_MASK(P0, P1, i) do { if (TYPE == 0 && (i) >= 4 && (kl0 + 64 * ((i) - 4) - q0 <= -128 || kl0 + 64 * ((i) - 4) - q0 >= 128)) {     \
        const int kt0_ = kl0 + 64 * ((i) - 4) - qpos, lo_ = -128, hi_ = 128; \
        _Pragma("unroll") for (int r = 0; r < 16; ++r) { const int k0_ = kt0_ + crow(r, hi); P0[r] = (k0_ < lo_ || k0_ > hi_) ? -1e30f : P0[r]; P1[r] = (k0_ + 32 < lo_ || k0_ + 32 > hi_) ? -1e30f : P1[r]; } } } while (0)
    const int vb0 = (int)(uintptr_t)(lds + RG::L_V) + v_rd_base(lane);
    const LAS unsigned char* Kr = lds + RG::L_K;
    float mhat = 0.f, l_reg = 0.f; f32x16 negm = f32x16{};
    int sp = 2, sc = 0;
#define ATT_ROT() do { const int t_ = sp; sp = sc; sc = (sc == 2 ? 0 : sc + 1); (void)t_; } while (0)
#ifndef ATT_LAGSEL
#define ATT_LAGSEL 0
#endif
    const bool lag = ATT_STAGGER && (ATT_LAGSEL == 0 ? wid >= 4 : (ATT_LAGSEL == 1 ? (wid & 1) != 0 : ((wid >> 1) & 1) != 0));
    f32x16 p0 = f32x16{}, p1 = f32x16{}; bf16x8 pa0 = bf16x8{}, pa1 = bf16x8{}, pa2 = bf16x8{}, pa3 = bf16x8{};
#define ATT_SOFT(t, FIRST) do { ATT_MASK(p0, p1, t); float rm_ = rowmax32(p0, p1); float alpha_ = 1.f; \
        if (FIRST) { mhat = rm_; _Pragma("unroll") for (int r = 0; r < 16; ++r) { p0[r] -= rm_; p1[r] -= rm_; negm[r] = -rm_; } asm volatile("" : "+v"(negm)); } \
        else if (__builtin_expect(__any(rm_ > THR), 0)) { const float dl = fmaxf(rm_, 0.f); mhat += dl; \
            _Pragma("unroll") for (int r = 0; r < 16; ++r) { p0[r] -= dl; p1[r] -= dl; negm[r] = -mhat; } asm volatile("" : "+v"(negm)); \
            alpha_ = __builtin_amdgcn_exp2f(-dl); ATT_RESC(alpha_); } \
        finishSM(p0, p1, alpha_, l_reg, pa0, pa1, pa2, pa3); } while (0)
#define ATT_STEP(t) do { \
        if (lag || !ATT_LATE_DMA) { ATT_DMA_K((t) + 2, sp); ATT_DMA_V((t) + 1, ((t) + 1) & 3); } \
        { bf16x8 kf_[2 * NKS]; att::VFrag va_, vb_; const int vbt_ = vb0 + (((t) - 1) & 3) * RG::VSLOT; \
          kread<NKS, ROWB, CB0, 0>(kf_, Kr + sc * RG::KSLOT, r32, hi); vread<0>(va_, vbt_); \
          asm volatile("s_waitcnt lgkmcnt(0)" ::: "memory"); ATT_SBAR(); \
          kmma<NKS, 0>(p0, p1, kf_, qr, negm); ATT_SBAR(); \
          vread<1>(vb_, vbt_); ATT_SBAR(); \
          pv_mma(o[0], va_, pa0, pa1, pa2, pa3); \
          asm volatile("s_waitcnt lgkmcnt(0)" ::: "memory"); ATT_SBAR(); \
          pv_mma(o[1], vb_, pa0, pa1, pa2, pa3); } \
        asm volatile("" : "+v"(p0), "+v"(p1), "+v"(o[0]), "+v"(o[1])); \
        if (lag) ATT_WAITBAR(); \
        if (!lag && ATT_LATE_DMA) { ATT_DMA_K((t) + 2, sp); ATT_DMA_V((t) + 1, ((t) + 1) & 3); }     \
        ATT_SOFT(t, false); \
        asm volatile("" : "+v"(pa0), "+v"(pa1), "+v"(pa2), "+v"(pa3), "+v"(l_reg)); \
        if (!lag) ATT_WAITBAR(); ATT_ROT(); } while (0)
    ATT_DMA_K(0, 0); ATT_DMA_V(0, 0); ATT_DMA_K(1, 1);
    asm volatile("s_waitcnt vmcnt(0)" ::: "memory"); __builtin_amdgcn_s_barrier(); asm volatile("" ::: "memory");
    { ATT_DMA_K(2, 2); ATT_DMA_V(1, 1);
      qkt2<NKS, ROWB, CB0>(p0, p1, Kr, qr, negm, r32, hi);
      asm volatile("" : "+v"(p0), "+v"(p1));
      if (lag) ATT_WAITBAR();
      ATT_SOFT(0, true);
      asm volatile("" : "+v"(pa0), "+v"(pa1), "+v"(pa2), "+v"(pa3), "+v"(l_reg));
      if (!lag) ATT_WAITBAR(); ATT_ROT(); }
    for (int j = 1; j < ((var & 32) ? ATT_XSTEPS : NT); ++j) ATT_STEP(j);
    pv_one<0>(o[0], vb0 + ((NT - 1) & 3) * RG::VSLOT, pa0, pa1, pa2, pa3); pv_one<1>(o[1], vb0 + ((NT - 1) & 3) * RG::VSLOT, pa0, pa1, pa2, pa3);
    asm volatile("s_waitcnt vmcnt(0)" ::: "memory"); __builtin_amdgcn_s_barrier(); asm volatile("" ::: "memory");
#undef ATT_SOFT
    { auto rr = __builtin_amdgcn_permlane32_swap(__float_as_uint(l_reg), __float_as_uint(l_reg), false, false); l_reg = __uint_as_float(rr[0]) + __uint_as_float(rr[1]); }
    l_out = l_reg; m_out = mhat;
#undef ATT_TROW
#undef ATT_DMA_K
#undef ATT_DMA_V
#undef ATT_WAITBAR
#undef ATT_RESC
#undef ATT_MASK
#undef ATT_ROT
#undef ATT_STEP
}

template <int TYPE> __device__ __forceinline__ void unit(const Tensors& Tn, LAS unsigned char* lds, const int tid, const int b, const int h, const bool lat, const int q0, const int var) {
    constexpr int NKS = TYPE == 0 ? 4 : (TYPE == 1 ? 6 : 2);
    const int lane = tid & 63, wid = __builtin_amdgcn_readfirstlane(tid >> 6), r32 = lane & 31, hi = lane >> 5;
    typedef Ring<TYPE> RG;
    LAS float* wsf = (LAS float*)(lds + RG::L_WS) + wid * 64;
    const int hw = TYPE == 0 ? h * 4 + (wid & 3) : h, wrow = TYPE == 0 ? (wid >> 2) * 32 : wid * 32;
    const int qrow0 = (lat ? b * T + q0 : RL + b * LC + q0) + wrow;
    bf16x8 qr[TYPE == 2 ? 4 : NKS];
    { const bf16* qp = TYPE == 0 ? Tn.P + (size_t)(qrow0 + r32) * LDP + P_AQ + hw * 64 : (TYPE == 1 ? Tn.QKVM + (size_t)(qrow0 + r32) * LDM + h * 96 : Tn.P + (size_t)(qrow0 + r32) * LDP + P_DQ + h * 64);
#pragma unroll
      for (int d0 = 0; d0 < (TYPE == 2 ? 4 : NKS); ++d0) qr[d0] = *(const bf16x8*)(qp + d0 * 16 + hi * 8); }
    f32x16 oA[2] = {f32x16{}, f32x16{}}; float l0, m0;
    flash_pass<TYPE, 0>(Tn, lds, tid, b, hw, lat, q0, wrow, var, qr, oA, l0, m0);
    f32x16 oB[2] = {f32x16{}, f32x16{}}; float l1 = 1.f, m1 = 0.f;
    LAS float* stash = (LAS float*)(lds + RG::L_OST + wid * 8192);
    if (TYPE == 2) {
#pragma unroll
        for (int r = 0; r < 16; ++r) { stash[r * 64 + lane] = oA[0][r]; stash[(16 + r) * 64 + lane] = oA[1][r]; }
        flash_pass<TYPE, 64>(Tn, lds, tid, b, h, lat, q0, wrow, var, qr + 2, oB, l1, m1);
#pragma unroll
        for (int r = 0; r < 16; ++r) { oA[0][r] = stash[r * 64 + lane]; oA[1][r] = stash[(16 + r) * 64 + lane]; }
        asm volatile("s_waitcnt lgkmcnt(0)" ::: "memory");
    }
    if (TYPE == 0) l0 += __builtin_amdgcn_exp2f(Tn.sink[Tn.l * 8 + hw] * 1.4426950408889634f - m0);
    if (hi == 0) { wsf[r32] = l0; if (TYPE == 2) wsf[32 + r32] = l1; }
    asm volatile("s_waitcnt lgkmcnt(0)" ::: "memory");
    LAS bf16* stg = (LAS bf16*)(lds + RG::L_OST + wid * (TYPE == 2 ? 8192 : 4096));
    if (TYPE != 2) {
#pragma unroll
        for (int r = 0; r < 16; ++r) { const float rl = __builtin_amdgcn_rcpf(wsf[crow(r, hi)]); const int orow = crow(r, hi);
            stg[orow * 64 + r32] = (bf16)f2bf(oA[0][r] * rl); stg[orow * 64 + 32 + r32] = (bf16)f2bf(oA[1][r] * rl); }
    } else {
        const float g0 = Tn.dnorm[Tn.l * 64 + r32], g1 = Tn.dnorm[Tn.l * 64 + 32 + r32];
#pragma unroll
        for (int r = 0; r < 16; ++r) { const float rl0 = __builtin_amdgcn_rcpf(wsf[crow(r, hi)]), rl1 = Tn.lam * __builtin_amdgcn_rcpf(wsf[32 + crow(r, hi)]);
            const float a0 = oA[0][r] * rl0 - oB[0][r] * rl1, a1 = oA[1][r] * rl0 - oB[1][r] * rl1;
            float ss = a0 * a0 + a1 * a1;
#pragma unroll
            for (int o_ = 1; o_ < 32; o_ <<= 1) ss += shx(ss, o_, lane);
            const float rs = (1.f - Tn.lam_init) * __builtin_amdgcn_rsqf(ss * (1.f / 64.f) + EPS); const int orow = crow(r, hi);
            stg[orow * 64 + r32] = (bf16)f2bf(a0 * rs * g0); stg[orow * 64 + 32 + r32] = (bf16)f2bf(a1 * rs * g1); }
    }
    asm volatile("s_waitcnt lgkmcnt(0)" ::: "memory");
    { bf16* Ow = Tn.O + (size_t)qrow0 * D + (TYPE == 0 ? hw * 64 : (TYPE == 1 ? 512 + h * 64 : 768 + h * 64));
#pragma unroll
      for (int i = 0; i < 4; ++i) { const int row = i * 8 + (lane >> 3), ch = lane & 7; st16(Ow + (size_t)row * D + ch * 8, *(const LAS u32x4*)(stg + row * 64 + ch * 8)); } }
    asm volatile("s_waitcnt lgkmcnt(0)" ::: "memory"); __builtin_amdgcn_s_barrier(); asm volatile("" ::: "memory");
}
}

__device__ __forceinline__ void attn_phase(Frame& F, const int l, const bool need_ctx) {
    att::Tensors Tn; Tn.P = F_P; Tn.QKVM = F_QKVM; Tn.O = F_O; Tn.sink = F_sink; Tn.dnorm = F_diff_norm; Tn.l = l;
    { float s1 = 0.f, s2 = 0.f;
      if (F.lane < 32) { s1 = F_lq1[l * 32 + F.lane] * F_lk1[l * 32 + F.lane]; s2 = F_lq2[l * 32 + F.lane] * F_lk2[l * 32 + F.lane]; }
      s1 = wave_sum(s1, F.lane); s2 = wave_sum(s2, F.lane);
      int ll_ = l; asm volatile("" : "+s"(ll_));
      const float li_ = ll_ == 0 ? 0.200000000f : (ll_ == 1 ? 0.355509068f : (ll_ == 2 ? 0.470713018f : 0.556058204f));
      const float lm_ = __expf(s1) - __expf(s2) + li_;
      Tn.lam_init = li_; Tn.lam = __builtin_bit_cast(float, __builtin_amdgcn_readfirstlane(__builtin_bit_cast(int, lm_))); }
    const int b = F.bid & 7, j = F.bid >> 3;
    if (F.G != 256) return;
    const int nu = (need_ctx && j < 16) ? 5 : 4;
    for (int u = 0; u < nu + ATT_EXTRA; ++u) {
        int type, h, q0; bool lat = true; const int var = u >= nu ? ATT_XVAR : 0;
        if (u >= nu) { type = ATT_EXTRA_TYPE; h = ATT_EXTRA_TYPE == 0 ? ((j >> 3) & 1) : (j >> 3); q0 = ATT_EXTRA_TYPE == 0 ? j * 64 : (j & 7) * 256; Tn.O = F_ACT; }
        else if (u == 0) { type = 2; h = j >> 3; q0 = (j & 7) * 256; }
        else if (u == 1) { type = 1; h = j >> 3; q0 = (j & 7) * 256; }
        else if (u < 4) { type = 0; h = u - 2; q0 = j * 64; }
        else { lat = false; q0 = 0; if (j < 8) { type = 0; h = j >> 2; q0 = (j & 3) * 64; } else if (j < 12) { type = 1; h = j - 8; } else { type = 2; h = j - 12; } }
        int t_ = F.tid; asm volatile("" : "+v"(t_));
        if (type == 0) att::unit<0>(Tn, F.lds, t_, b, h, lat, q0, var);
        else if (type == 1) att::unit<1>(Tn, F.lds, t_, b, h, lat, q0, var);
        else att::unit<2>(Tn, F.lds, t_, b, h, lat, q0, var);
    }
}

enum { PH_P0 = 0, PH_L0 = 1, PH_PER_LAYER = 9, PH_FINAL = PH_L0 + DEPTH * PH_PER_LAYER, NPH = PH_FINAL + 1 };
enum { SP_NORM1 = 0, SP_INPROJ = 1, SP_UP = 2, SP_ATTN = 3, SP_OUT = 4, SP_NORM2 = 5, SP_TOPK = 6, SP_MOE1 = 7, SP_MOE2 = 8 };

#ifndef REPS_INIT
#define REPS_INIT {1, 1, 1, 1, 1, 1, 1, 1, 1}
#endif
#ifndef REP_P0
#define REP_P0 1
#endif
#ifndef REP_FINAL
#define REP_FINAL 1
#endif
#ifndef KROT_ON
#define KROT_ON 0
#endif
#ifndef PROBE_NOMMA
#define PROBE_NOMMA 0
#endif
#ifndef PHMASK
#define PHMASK 0x3ff
#endif
#define PHON(b) ((PHMASK >> (b)) & 1)
#define REPSEL(s) ((s) == 0 ? reps_sp[0] : (s) == 1 ? reps_sp[1] : (s) == 2 ? reps_sp[2] : (s) == 3 ? reps_sp[3] : (s) == 4 ? reps_sp[4] : (s) == 5 ? reps_sp[5] : (s) == 6 ? reps_sp[6] : (s) == 7 ? reps_sp[7] : reps_sp[8])
__global__ void __launch_bounds__(NWAVES * 64, 2) mk(Args args) {
    extern __shared__ __attribute__((aligned(16))) unsigned char lds_raw[];
    Frame F;
    F.lds = (LAS unsigned char*)lds_raw;
    F.tid = threadIdx.x; F.lane = F.tid & 63; F.wave = __builtin_amdgcn_readfirstlane(F.tid >> 6); F.bid = blockIdx.x; F.G = gridDim.x;
    const int wave_s = F.wave;
    F.in = (const float* const*)args.in; F.out = (GAS float*)args.out; F.ws = (GAS unsigned char*)args.ws;
    volatile LAS unsigned* MISC = (volatile LAS unsigned*)(F.lds + MISC_OFF);
    for (int u = F.tid; u < (LDS_BYTES - LDSCTL_OFF) / 4; u += NWAVES * 64) ((LAS unsigned*)(F.lds + LDSCTL_OFF))[u] = 0u;
    __syncthreads();
    XcdBarrier bar = xcd_barrier_post((unsigned*)(args.ws + WS_CTL) + CW_BAR + args.li * XCD_BAR_WORDS, MISC + 8);
    const int gx = F.bid & 7, gj = F.bid >> 3, gpx = F.G >> 3, krot = KROT_ON ? (gj & 7) + 3 * (gj >> 3) : 0;
    constexpr int reps_sp[9] = REPS_INIT;
    for (int ph = args.ph_lo; ph < args.ph_hi; ++ph) {
      const int nrep = ph == PH_P0 ? REP_P0 : (ph == PH_FINAL ? REP_FINAL : (REPSEL((ph - PH_L0) % PH_PER_LAYER)));
      for (int rep = 0; rep < nrep; ++rep) {
        const float keep = rep + 1 == nrep ? 1.f : 0.f;
        { unsigned char* w_ = args.ws; asm volatile("" : "+s"(w_)); F.ws = (GAS unsigned char*)w_; int z_ = 0; asm volatile("" : "+s"(z_)); F.in = (const float* const*)args.in + z_;
          int l_; asm volatile("v_mbcnt_lo_u32_b32 %0, -1, 0\n\tv_mbcnt_hi_u32_b32 %0, -1, %0" : "=v"(l_));
          int w_s = wave_s; asm volatile("" : "+s"(w_s)); F.lane = l_; F.wave = w_s; F.tid = w_s * 64 + l_; }
        if (ph == PH_P0) { if (PHON(9)) p0_phase(F); }
        else if (ph == PH_FINAL) { if (PHON(0)) norm_phase(F, DEPTH, 2, RL, keep); }
        else {
            const int l = (ph - PH_L0) / PH_PER_LAYER, sp = (ph - PH_L0) % PH_PER_LAYER;
            const bool need_ctx = l < DEPTH - 1; const int rows_mix = need_ctx ? R : RL;
            const bf16* wl = F_WB + (size_t)l * W_LAYER;
            if (sp == SP_NORM1) { if (PHON(0)) norm_phase(F, l, 0, R, keep); }
            else if (sp == SP_INPROJ && PHON(1)) {
                pg8::Gemm g{F_ACT, wl + W_IN, nullptr, 0, D, D}; OrderRows S{gx, gj, gpx, R / 288 / 8, LDP / 256, 0, krot, 288};
                EpiInProj<3, 3> E{F_P, F_ROPE, F_RSQ};
                pg8::gemm_phase288<false>(F.lds, F.tid, g, S, E);
                { const int nbusy = 8;
                  if (BG_PREP && l + 1 < DEPTH && rep + 1 == nrep && gj >= nbusy) prep_layer(F, l + 1, ((gx * (gpx - nbusy) + (gj - nbusy)) * NWAVES) + F.wave, 8 * (gpx - nbusy) * NWAVES); }
            } else if (sp == SP_UP && PHON(2)) {
                pg8::Gemm g{F_P + P_CQ, wl + W_UP, nullptr, 0, LDP, UPK}; OrderRows S{gx, gj, gpx, R / 288 / 8, 4, 0, krot, 288};
                EpiUp<3, 3> E{F_QKVM, F_ROPE, F_RSQ};
                pg8::gemm_phase288<false>(F.lds, F.tid, g, S, E);
            } else if (sp == SP_ATTN) { if (PHON(3)) attn_phase(F, l, need_ctx);
            } else if (sp == SP_OUT && PHON(4)) {
                pg8::Gemm g{F_O, wl + W_OUT, nullptr, 0, D, D};
                if (need_ctx) { OrderRows S{gx, gj, gpx, R / 288 / 8, 4, 0, krot, 288}; EpiOut<3, 3> E{(XT*)F_XB, F_MOD + (size_t)l * 9 * 6144, keep}; pg8::gemm_phase288<false>(F.lds, F.tid, g, S, E); }
                else { OrderRows S{gx, gj, gpx, RL / 256 / 8, 4, 0, krot, 256}; EpiOut<4> E{(XT*)F_XB, F_MOD + (size_t)l * 9 * 6144, keep}; pg8::gemm_phase<false, 4>(F.lds, F.tid, g, S, E); }
            } else if (sp == SP_NORM2) { if (PHON(5)) norm_phase(F, l, 1, rows_mix, keep); }
            else if (sp == SP_TOPK) { if (PHON(6)) topk_phase(F, need_ctx ? 16 : 8);
#if MOE_PF
                { unsigned acc = 0;
                  for (int e2 = 0; e2 < 2; ++e2) { const int e = 2 * gx + e2;
                    const u32x4* p1 = (const u32x4*)(wl + W_GU + (size_t)e * 1024 * 1024); const u32x4* p2 = (const u32x4*)(wl + W_DN + (size_t)e * 1024 * 512);
#pragma unroll 4
                    for (int i = gj * 512 + F.tid; i < 131072; i += gpx * 512) acc ^= p1[i].x;
#pragma unroll 4
                    for (int i = gj * 512 + F.tid; i < 65536; i += gpx * 512) acc ^= p2[i].x; }
                  asm volatile("" :: "v"(acc)); }
#endif
            }
            else if (sp == SP_MOE1 && PHON(7)) {
                pg8::Gemm g{F_ACT, wl + W_GU, F_STOK, (size_t)1024 * 1024, D, D};
                if (need_ctx) { OrderMoe S{gx, gj, gpx, 8, 4, krot, 288}; EpiGU<3, 3> E{F_HID}; pg8::gemm_phase288<true>(F.lds, F.tid, g, S, E); }
                else { OrderMoe S{gx, gj, gpx, 8, 4, krot, 256}; EpiGU<4> E{F_HID}; pg8::gemm_phase<true, 4>(F.lds, F.tid, g, S, E); }
            } else if (sp == SP_MOE2 && PHON(8)) {
                pg8::Gemm g{F_HID, wl + W_DN, nullptr, (size_t)1024 * 512, DE, DE};
                if (need_ctx) { OrderMoe S{gx, gj, gpx, 8, 4, krot, 288}; EpiDown<3, 3> E{F_Y, F_SGATE}; pg8::gemm_phase288<false>(F.lds, F.tid, g, S, E); }
                else { OrderMoe S{gx, gj, gpx, 8, 4, krot, 256}; EpiDown<4> E{F_Y, F_SGATE}; pg8::gemm_phase<false, 4>(F.lds, F.tid, g, S, E); }
            }
        }
        if (ph + 1 < args.ph_hi || rep + 1 < nrep) { xcd_barrier(bar, F.tid);
#ifdef EXTRA_BAR
            xcd_barrier(bar, F.tid);
#endif
        }
      }
    }
}

extern "C" void kernel_launch(void* const* d_in, const int* in_sizes, int n_in, void* d_out, int out_size, void* d_ws, size_t ws_size, hipStream_t stream) {
    static int grid = 0;
    if (grid == 0) {
        if (n_in != 25 || ws_size < WS_END || out_size != RL * D) { fprintf(stderr, "kernel_launch: unexpected shapes (n_in %d, ws %zu < %zu, out %d)\n", n_in, ws_size, (size_t)WS_END, out_size); grid = -1; return; }
        int dev = 0, cus = 0, per_cu = 0;
        if (hipGetDevice(&dev) != hipSuccess || hipDeviceGetAttribute(&cus, hipDeviceAttributeMultiprocessorCount, dev) != hipSuccess) { grid = -1; return; }
        if (hipFuncSetAttribute((const void*)mk, hipFuncAttributeMaxDynamicSharedMemorySize, LDS_BYTES) != hipSuccess) { fprintf(stderr, "kernel_launch: hipFuncSetAttribute failed\n"); grid = -1; return; }
        if (hipOccupancyMaxActiveBlocksPerMultiprocessor(&per_cu, (const void*)mk, NWAVES * 64, LDS_BYTES) != hipSuccess || per_cu < 1) { fprintf(stderr, "kernel_launch: occupancy query says %d\n", per_cu); }
        (void)hipGetLastError();
        grid = cus;
        if (grid % 8 != 0) { fprintf(stderr, "kernel_launch: %d CUs, expected a multiple of 8\n", grid); grid = -1; return; }
    }
    if (grid < 0) return;
    (void)hipMemsetAsync((char*)d_ws + WS_CTL, 0, CTL_ZERO_BYTES, stream);
    Args a; memset(&a, 0, sizeof a);
    for (int i = 0; i < 25; ++i) a.in[i] = (const float*)d_in[i];
    a.out = (float*)d_out; a.ws = (unsigned char*)d_ws;
    a.ph_lo = 0; a.ph_hi = NPH; a.li = 0;
    hipLaunchKernelGGL(mk, dim3(grid), dim3(NWAVES * 64), LDS_BYTES, stream, a);
}
```

```cpp
#include <hip/hip_runtime.h>
#include <stdint.h>
#include <string.h>
#include <stdio.h>

typedef unsigned short bf16;
typedef unsigned u32x4 __attribute__((ext_vector_type(4)));
typedef unsigned u32x2 __attribute__((ext_vector_type(2)));
typedef float f32x4 __attribute__((ext_vector_type(4)));
typedef float f32x16 __attribute__((ext_vector_type(16)));
typedef short bf16x8 __attribute__((ext_vector_type(8)));
#define LAS __attribute__((address_space(3)))
#define GAS __attribute__((address_space(1)))

constexpr int D = 1024, NB = 8, T = 2048, LC = 256, DEPTH = 4;
constexpr int RL = NB * T, RC = NB * LC, R = RL + RC;
constexpr int INW = 1952, LDP = 2048;
constexpr int NE = 16, DE = 512;
constexpr int CAPL = 256, CAPC = 32;
constexpr int SLOTS_E = NB * CAPL + NB * CAPC;
constexpr int SLOTS = NE * SLOTS_E;
constexpr float EPS = 1e-6f;
constexpr int P_AQ = 0, P_AK = 512, P_AV = 640, P_CQ = 768, P_CKV = 1024, P_KR = 1152, P_DQ = 1184, P_DK = 1440, P_DV = 1696;
constexpr int LDM = 1024;
constexpr int UPK = 384;

constexpr size_t MiB = 1u << 20;
constexpr size_t WS_CTL = 0;
constexpr size_t CTL_ZERO_BYTES = 256 * 1024;
constexpr size_t WS_MOD = 1 * MiB;
constexpr size_t WS_ROPE = 2 * MiB;
constexpr size_t WS_RSQ = 3 * MiB;
constexpr size_t WS_AFF = 4 * MiB;
constexpr size_t WS_INV = 6 * MiB;
constexpr size_t WS_STOK = 8 * MiB;
constexpr size_t WS_SGATE = 9 * MiB;
#ifndef X_BF16
#define X_BF16 1
#endif
constexpr size_t WS_X = 10 * MiB;
constexpr size_t WS_ACT = 82 * MiB;
constexpr size_t WS_P = 118 * MiB;
constexpr size_t WS_Y = WS_P;
constexpr size_t WS_QKVM = 190 * MiB;
constexpr size_t WS_O = 226 * MiB;
constexpr size_t WS_HID = WS_O;
constexpr size_t WS_W = 262 * MiB;
constexpr size_t W_IN = 0;
constexpr size_t W_UP = W_IN + (size_t)LDP * D;
constexpr size_t W_OUT = W_UP + (size_t)1024 * UPK;
constexpr size_t W_GU = W_OUT + (size_t)D * D;
constexpr size_t W_DN = W_GU + (size_t)NE * 1024 * 1024;
constexpr size_t W_LAYER = W_DN + (size_t)NE * 1024 * 512;
constexpr size_t WS_END = WS_W + (size_t)DEPTH * W_LAYER * 2;

__device__ __forceinline__ unsigned f2bf(float f) { unsigned u = __builtin_bit_cast(unsigned, f); return (u + 0x7fffu + ((u >> 16) & 1u)) >> 16; }
__device__ __forceinline__ float bf2f(unsigned h) { return __builtin_bit_cast(float, h << 16); }
#ifndef WT_STORES
#define WT_STORES 0
#endif
__device__ __forceinline__ void st16(void* p, const u32x4 v) {
#if WT_STORES
    asm volatile("global_store_dwordx4 %0, %1, off sc1\n\ts_nop 1" :: "v"(p), "v"(v) : "memory");
#else
    *(u32x4*)p = v;
#endif
}
typedef float f32x2c_t __attribute__((ext_vector_type(2)));
typedef __bf16 bf16x2c_t __attribute__((ext_vector_type(2)));
#ifndef HW_CVT
#define HW_CVT 1
#endif
__device__ __forceinline__ unsigned pk2(float lo, float hi) {
#if HW_CVT
    f32x2c_t v = {lo, hi}; bf16x2c_t b = __builtin_convertvector(v, bf16x2c_t); return __builtin_bit_cast(unsigned, b);
#else
    return f2bf(lo) | (f2bf(hi) << 16);
#endif
}
__device__ __forceinline__ float shx(float v, int o, int lane) { return __builtin_bit_cast(float, __builtin_amdgcn_ds_bpermute((lane ^ o) << 2, __builtin_bit_cast(int, v))); }
__device__ __forceinline__ int shi(int v, int src) { return __builtin_amdgcn_ds_bpermute(src << 2, v); }
__device__ __forceinline__ float wave_sum(float v, int lane) {
#pragma unroll
    for (int o = 1; o < 64; o <<= 1) v += shx(v, o, lane);
    return v;
}
__device__ __forceinline__ float siluf(float v) { return v / (1.f + __expf(-v)); }
#define LDS_WAIT() asm volatile("s_waitcnt lgkmcnt(0)" ::: "memory")
#define VM_WAIT() asm volatile("s_waitcnt vmcnt(0)" ::: "memory")

struct Args {
    const float* in[25]; float* out; unsigned char* ws; int ph_lo, ph_hi, li, pad;
};

#ifndef PROBE_HOT
#define PROBE_HOT 0
#endif
#ifndef PROBE_NOEPI
#define PROBE_NOEPI 0
#endif
#ifndef PROBE_NOLDS
#define PROBE_NOLDS 0
#endif
#ifndef GEMM_AUX
#define GEMM_AUX 0
#endif
#ifndef GEMM_PRIO
#define GEMM_PRIO 1
#endif
#ifndef GEMM_ASKIP
#define GEMM_ASKIP 0
#endif
namespace pg8 {
constexpr int BM = 256, BK = 64, HALF = 128, HTB = HALF * BK * 2  , STAGE_BYTES = 8 * HTB;
__host__ __device__ __forceinline__ int lds_byte(int r, int c) { const int st = (r >> 4) * 2 + (c >> 5), rr = r & 15, cc = c & 31, ob = rr * 64 + cc * 2; return st * 1024 + (ob ^ (((ob >> 9) & 1) << 5)); }
__host__ __device__ __forceinline__ void stage_rc(int b, int& R, int& C) { const int st = b / 1024, sb = b % 1024, swz = sb ^ (((sb >> 9) & 1) << 5); R = (st >> 1) * 16 + swz / 64; C = (st & 1) * 32 + (swz % 64) / 2; }
__host__ __device__ __forceinline__ int perm32(int rho) { const int n = rho >> 4, i = rho & 15; return 8 * (i >> 2) + 4 * n + (i & 3); }

struct Unit { int arow0, orow0, col0, e, quad; };
struct Gemm { const bf16* A; const bf16* Bt; const int* gather; size_t b_estride; int lda, K; };

template <bool GATHER, int MF, class Epi, class Sched>
__device__ __forceinline__ void gemm_phase(LAS unsigned char* lds, const int tid, const Gemm g, const Sched& S, const Epi& E) {
    const int wid = __builtin_amdgcn_readfirstlane(tid >> 6), lane = tid & 63, wr = wid >> 2, wc = wid & 3, fr = lane & 15, fq = lane >> 4;
    constexpr bool ASKIP = (MF == 3) && GEMM_ASKIP;
    constexpr int HR = 32 * MF;
    const int K = g.K, nt = K / BK;
    unsigned voffA[2], voffB[2]; int sR[2];
#pragma unroll
    for (int i = 0; i < 2; ++i) { int C_; stage_rc(tid * 16 + i * 8192, sR[i], C_); const int Rb = (sR[i] & ~31) + perm32(sR[i] & 31);
        voffA[i] = GATHER ? (unsigned)C_ * 2u : (unsigned)(sR[i] * g.lda + C_) * 2u; voffB[i] = (unsigned)(Rb * K + C_) * 2u; }
    const unsigned lda2 = (unsigned)g.lda * 2u;
    const unsigned hstepA = (unsigned)HR * g.lda * 2u;
    const unsigned kstep = (unsigned)(BK * 2);
    const int krot = (2 * S.rot) % nt;
#define PG8_KT(i) ((PROBE_HOT && hot_) ? 0u : (unsigned)(((i) + krot) >= nt ? (i) + krot - nt : (i) + krot) * kstep)
    const unsigned hstepB = (unsigned)HALF * K * 2u;
    const __amdgpu_buffer_rsrc_t rsA = __builtin_amdgcn_make_buffer_rsrc((void*)g.A, 0, 0x7fffffff, 0x00020000);
    const __amdgpu_buffer_rsrc_t rsB = __builtin_amdgcn_make_buffer_rsrc((void*)g.Bt, 0, 0x7fffffff, 0x00020000);
    const unsigned ldsw = (unsigned)wid * 1024u;
    const int aoff = lds_byte(wr * (16 * MF) + fr, fq * 8), boff = lds_byte(wc * 32 + fr, fq * 8);
#define PG8_SA(b, h) (((b) * 2 + (h)) * HTB)
#define PG8_SB(b, h) ((4 + (b) * 2 + (h)) * HTB)
#define PG8_STAGE2(bufoff, rsrc, v0, v1, soff) do { \
        __builtin_amdgcn_raw_ptr_buffer_load_lds(rsrc, (LAS unsigned*)(lds + (bufoff) + ldsw), 16, (int)(v0), (int)(soff), 0, 0); \
        __builtin_amdgcn_raw_ptr_buffer_load_lds(rsrc, (LAS unsigned*)(lds + (bufoff) + ldsw + 8192), 16, (int)(v1), (int)(soff), 0, 0); } while (0)
#define PG8_STAGEB(bufoff, soff) PG8_STAGE2(bufoff, rsB, voffB[0], voffB[1], soff)
#define PG8_STAGE1(bufoff, rsrc, v0, soff) __builtin_amdgcn_raw_ptr_buffer_load_lds(rsrc, (LAS unsigned*)(lds + (bufoff) + ldsw), 16, (int)(v0), (int)(soff), 0, 0)
#define PG8_STAGEA(bufoff, ubase, r0, r1, h, koff) do { if constexpr (GATHER) { \
        if (ASKIP && wr == 1) PG8_STAGE1(bufoff, rsA, (((r0) >> (16 * (h))) & 0xffffu) * lda2 + voffA[0], (koff)); \
        else PG8_STAGE2(bufoff, rsA, (((r0) >> (16 * (h))) & 0xffffu) * lda2 + voffA[0], (((r1) >> (16 * (h))) & 0xffffu) * lda2 + voffA[1], (koff)); } \
        else { if (ASKIP && wr == 1) PG8_STAGE1(bufoff, rsA, voffA[0], (ubase) + (h) * hstepA + (koff)); \
        else PG8_STAGE2(bufoff, rsA, voffA[0], voffA[1], (ubase) + (h) * hstepA + (koff)); } } while (0)
#define PG8_LDA(dst, b, h) do { if (PROBE_NOLDS && hot_) break; _Pragma("unroll") for (int m = 0; m < MF; ++m) _Pragma("unroll") for (int k = 0; k < 2; ++k) dst[m][k] = *(const LAS bf16x8*)(lds + PG8_SA(b, h) + aoff + m * 2048 + k * 1024); } while (0)
#define PG8_LDB(dst, b, h) do { if (PROBE_NOLDS && hot_) break; _Pragma("unroll") for (int n = 0; n < 2; ++n) _Pragma("unroll") for (int k = 0; k < 2; ++k) dst[n][k] = *(const LAS bf16x8*)(lds + PG8_SB(b, h) + boff + n * 2048 + k * 1024); } while (0)
#define PG8_MMA(ai, bj, At, Bt) do { __builtin_amdgcn_s_setprio(1); _Pragma("unroll") for (int m = 0; m < MF; ++m) _Pragma("unroll") for (int n = 0; n < 2; ++n) _Pragma("unroll") for (int k = 0; k < 2; ++k) \
        acc[ai][bj][m][n] = __builtin_amdgcn_mfma_f32_16x16x32_bf16(Bt[n][k], At[m][k], acc[ai][bj][m][n], 0, 0, 0); __builtin_amdgcn_s_setprio(0); } while (0)
#define PG8_WAIT_V(n) asm volatile("s_waitcnt vmcnt(" #n ")" ::: "memory")
#define PG8_WAIT_V2(n, nskip) do { if (ASKIP && wr == 1) PG8_WAIT_V(nskip); else PG8_WAIT_V(n); } while (0)
#define PG8_WAIT_L(n) asm volatile("s_waitcnt lgkmcnt(" #n ")" ::: "memory")
#define PG8_BAR __builtin_amdgcn_s_barrier()
#define PG8_SCHED __builtin_amdgcn_sched_barrier(0)
#define PG8_ROWS(dst, u) do { if constexpr (GATHER) { _Pragma("unroll") for (int i = 0; i < 2; ++i) { \
        const int sr_ = sR[i] < HR ? sR[i] : sR[i] - 32;     \
        const unsigned a_ = (unsigned)g.gather[(u).arow0 + sr_], b_ = (unsigned)g.gather[(u).arow0 + ((u).quad ? 0 : HR) + sr_]; dst[i] = a_ | (b_ << 16); } \
        asm volatile("" : "+v"(dst[0]), "+v"(dst[1])); } } while (0)
    Unit cur, nxt; int ui = 0;
    if (!S.next(0, cur)) return;
    const bool hot_ = cur.quad == 2;
    f32x4 acc[2][2][MF][2];
#pragma unroll
    for (int a = 0; a < 2; ++a)
#pragma unroll
        for (int b = 0; b < 2; ++b)
#pragma unroll
            for (int m = 0; m < MF; ++m)
#pragma unroll
                for (int n = 0; n < 2; ++n) acc[a][b][m][n] = (f32x4){0.f, 0.f, 0.f, 0.f};
    bf16x8 At[MF][2], B0[2][2], B1[2][2];
    unsigned rp[2] = {0u, 0u}, rn[2] = {0u, 0u};
    PG8_ROWS(rp, cur);
    unsigned cA = (unsigned)cur.arow0 * lda2;
    unsigned cB = (unsigned)(((size_t)cur.e * g.b_estride + (size_t)cur.col0 * K) * 2);
    PG8_STAGEB(PG8_SB(0, 0), cB + PG8_KT(0)); PG8_STAGEB(PG8_SB(0, 1), cB + hstepB + PG8_KT(0)); PG8_STAGEA(PG8_SA(0, 0), cA, rp[0], rp[1], 0, PG8_KT(0)); PG8_STAGEA(PG8_SA(0, 1), cA, rp[0], rp[1], 1, PG8_KT(0));
    if (wr == 1) PG8_BAR;
    PG8_WAIT_V2(2, 1); PG8_BAR;
    PG8_STAGEB(PG8_SB(1, 0), cB + PG8_KT(1)); PG8_STAGEA(PG8_SA(1, 0), cA, rp[0], rp[1], 0, PG8_KT(1)); PG8_STAGEB(PG8_SB(1, 1), cB + hstepB + PG8_KT(1));
    PG8_WAIT_V2(6, 5); PG8_BAR;
    for (;;) {
        const bool has_next = S.next(ui + 1, nxt);
        if (has_next) { PG8_ROWS(rn, nxt); } else { rn[0] = rp[0]; rn[1] = rp[1]; }
        const unsigned nA = has_next ? (unsigned)nxt.arow0 * lda2 : cA;
        const unsigned nB = has_next ? (unsigned)(((size_t)nxt.e * g.b_estride + (size_t)nxt.col0 * K) * 2) : cB;
#pragma unroll 1
        for (int t = 0; t < nt; t += 2) {
            const bool last = (t == nt - 2);
            const unsigned k1 = PG8_KT(t + 1), k2 = last ? PG8_KT(0) : PG8_KT(t + 2), k3 = last ? PG8_KT(1) : PG8_KT(t + 3);
            const unsigned u2 = last ? nA : cA; const unsigned b2 = (last ? nB : cB) + k2; const unsigned b3 = (last ? nB : cB) + k3;
            const unsigned q0 = last ? rn[0] : rp[0], q1 = last ? rn[1] : rp[1];
            PG8_LDB(B0, 0, 0); PG8_LDB(B1, 0, 1); PG8_SCHED; PG8_LDA(At, 0, 0); PG8_STAGEA(PG8_SA(1, 1), cA, rp[0], rp[1], 1, k1);
            PG8_WAIT_V2(8, 6); PG8_WAIT_L(0); PG8_BAR; if (cur.quad < 2) PG8_MMA(0, 0, At, B0); if (!cur.quad) PG8_MMA(0, 1, At, B1); PG8_BAR; PG8_SCHED;
            PG8_LDA(At, 0, 1); PG8_STAGEB(PG8_SB(0, 0), b2); PG8_STAGEB(PG8_SB(0, 1), b2 + hstepB); PG8_STAGEA(PG8_SA(0, 0), u2, q0, q1, 0, k2);
            PG8_WAIT_V2(8, 6); PG8_WAIT_L(0); PG8_BAR; if (!cur.quad) { PG8_MMA(1, 0, At, B0); PG8_MMA(1, 1, At, B1); } PG8_BAR; PG8_SCHED;
            PG8_LDB(B0, 1, 0); PG8_LDB(B1, 1, 1); PG8_SCHED; PG8_LDA(At, 1, 0); PG8_STAGEA(PG8_SA(0, 1), u2, q0, q1, 1, k2);
            PG8_WAIT_V2(8, 6); PG8_WAIT_L(0); PG8_BAR; if (cur.quad < 2) PG8_MMA(0, 0, At, B0); if (!cur.quad) PG8_MMA(0, 1, At, B1); PG8_BAR; PG8_SCHED;
            PG8_LDA(At, 1, 1); PG8_STAGEB(PG8_SB(1, 0), b3); PG8_STAGEB(PG8_SB(1, 1), b3 + hstepB); PG8_STAGEA(PG8_SA(1, 0), u2, q0, q1, 0, k3);
            PG8_WAIT_V2(8, 6); PG8_WAIT_L(0); PG8_BAR; if (!cur.quad) { PG8_MMA(1, 0, At, B0); PG8_MMA(1, 1, At, B1); } PG8_BAR; PG8_SCHED;
        }
        if (wr == 0) PG8_BAR;
        if (!(PROBE_NOEPI && hot_)) E(acc, cur, wr, wc, fr, fq);
        if (!has_next) break;
#pragma unroll
        for (int a = 0; a < 2; ++a)
#pragma unroll
            for (int b = 0; b < 2; ++b)
#pragma unroll
                for (int m = 0; m < MF; ++m)
#pragma unroll
                    for (int n = 0; n < 2; ++n) acc[a][b][m][n] = (f32x4){0.f, 0.f, 0.f, 0.f};
        cur = nxt; cB = nB; cA = nA; ++ui; rp[0] = rn[0]; rp[1] = rn[1];
        if (wr == 1) PG8_BAR;
    }
    PG8_WAIT_V(0);
    PG8_BAR;
#undef PG8_SA
#undef PG8_SB
#undef PG8_STAGE2
#undef PG8_STAGEB
#undef PG8_LDA
#undef PG8_LDB
#undef PG8_MMA
#undef PG8_WAIT_V
#undef PG8_WAIT_V2
#undef PG8_STAGE1
#undef PG8_WAIT_L
#undef PG8_BAR
#undef PG8_SCHED
#undef PG8_KT
#undef PG8_ROWS
#undef PG8_STAGEA
}
constexpr int PTB = 96 * BK * 2, SB_OFF = 6 * PTB, STAGE288_BYTES = SB_OFF + 4 * HTB;
template <bool GATHER, class Epi, class Sched>
__device__ __forceinline__ void gemm_phase288(LAS unsigned char* lds, const int tid, const Gemm g, const Sched& S, const Epi& E) {
    constexpr int MF = 3;
    const int wid = __builtin_amdgcn_readfirstlane(tid >> 6), lane = tid & 63, wr = wid >> 2, wc = wid & 3, fr = lane & 15, fq = lane >> 4;
    const int K = g.K, nt = K / BK;
    unsigned voffA[2], voffB[2]; int sR[2];
#pragma unroll
    for (int i = 0; i < 2; ++i) { int C_; stage_rc(tid * 16 + i * 8192, sR[i], C_); const int Rb = (sR[i] & ~31) + perm32(sR[i] & 31);
        voffB[i] = (unsigned)(Rb * K + C_) * 2u;
        if (i == 1) stage_rc((tid & 255) * 16 + 8192, sR[i], C_);
        voffA[i] = GATHER ? (unsigned)C_ * 2u : (unsigned)(sR[i] * g.lda + C_) * 2u; }
    const unsigned lda2 = (unsigned)g.lda * 2u;
    const unsigned pstepA = 96u * g.lda * 2u;
    const unsigned kstep = (unsigned)(BK * 2);
    const unsigned hstepB = (unsigned)HALF * K * 2u;
    const __amdgpu_buffer_rsrc_t rsA = __builtin_amdgcn_make_buffer_rsrc((void*)g.A, 0, 0x7fffffff, 0x00020000);
    const __amdgpu_buffer_rsrc_t rsB = __builtin_amdgcn_make_buffer_rsrc((void*)g.Bt, 0, 0x7fffffff, 0x00020000);
    const unsigned ldsw = (unsigned)wid * 1024u, ldsx = 8192u + (unsigned)(wid & 3) * 1024u;
    const int aoff = lds_byte(wr * 48 + fr, fq * 8), boff = lds_byte(wc * 32 + fr, fq * 8);
#define PG9_SA(b, a) (((b) * 3 + (a)) * PTB)
#define PG9_SB(b, h) (SB_OFF + ((b) * 2 + (h)) * HTB)
#define PG9_DMA(rsrc, dstoff, v, soff) __builtin_amdgcn_raw_ptr_buffer_load_lds(rsrc, (LAS unsigned*)(lds + (dstoff) + ldsw), 16, (int)(v), (int)(soff), 0, GEMM_AUX)
#define PG9_STAGEB(bufoff, soff) do { PG9_DMA(rsB, (bufoff), voffB[0], (soff)); PG9_DMA(rsB, (bufoff) + 8192, voffB[1], (soff)); } while (0)
#define PG9_RIDX(r, a, i) ((a) < 2 ? (((r)[i] >> (16 * (a))) & 0xffffu) : (((r)[2] >> (16 * (i))) & 0xffffu))
#define PG9_DMAX(rsrc, dstoff, v, soff) __builtin_amdgcn_raw_ptr_buffer_load_lds(rsrc, (LAS unsigned*)(lds + (dstoff) + ldsx), 16, (int)(v), (int)(soff), 0, GEMM_AUX)
#define PG9_STAGEA(bufoff, ubase, r, a, koff, OWN) do { if constexpr (GATHER) { \
        PG9_DMA(rsA, (bufoff), PG9_RIDX(r, a, 0) * lda2 + voffA[0], (koff)); if (wr == (OWN)) PG9_DMAX(rsA, (bufoff), PG9_RIDX(r, a, 1) * lda2 + voffA[1], (koff)); } \
        else { PG9_DMA(rsA, (bufoff), voffA[0], (ubase) + (a) * pstepA + (koff)); if (wr == (OWN)) PG9_DMAX(rsA, (bufoff), voffA[1], (ubase) + (a) * pstepA + (koff)); } } while (0)
#define PG9_LDA(dst, b, a) do { _Pragma("unroll") for (int m = 0; m < MF; ++m) _Pragma("unroll") for (int k = 0; k < 2; ++k) dst[m][k] = *(const LAS bf16x8*)(lds + PG9_SA(b, a) + aoff + m * 2048 + k * 1024); } while (0)
#define PG9_LDB(dst, b, h) do { _Pragma("unroll") for (int n = 0; n < 2; ++n) _Pragma("unroll") for (int k = 0; k < 2; ++k) dst[n][k] = *(const LAS bf16x8*)(lds + PG9_SB(b, h) + boff + n * 2048 + k * 1024); } while (0)
#define PG9_MMA(ai, bj, At, Bt) do { if (GEMM_PRIO) __builtin_amdgcn_s_setprio(1); _Pragma("unroll") for (int m = 0; m < MF; ++m) _Pragma("unroll") for (int n = 0; n < 2; ++n) _Pragma("unroll") for (int k = 0; k < 2; ++k) \
        acc[ai][bj][m][n] = __builtin_amdgcn_mfma_f32_16x16x32_bf16(Bt[n][k], At[m][k], acc[ai][bj][m][n], 0, 0, 0); if (GEMM_PRIO) __builtin_amdgcn_s_setprio(0); } while (0)
#define PG9_WAIT_V(n) asm volatile("s_waitcnt vmcnt(" #n ")" ::: "memory")
#define PG9_WAIT_L(n) asm volatile("s_waitcnt lgkmcnt(" #n ")" ::: "memory")
#define PG9_BAR __builtin_amdgcn_s_barrier()
#define PG9_SCHED __builtin_amdgcn_sched_barrier(0)
#define PG9_ROWS(dst, u) do { if constexpr (GATHER) { unsigned t2_[2]; _Pragma("unroll") for (int i = 0; i < 2; ++i) { \
        const unsigned a_ = (unsigned)g.gather[(u).arow0 + sR[i]], b_ = (unsigned)g.gather[(u).arow0 + 96 + sR[i]]; t2_[i] = (unsigned)g.gather[(u).arow0 + 192 + sR[i]]; dst[i] = a_ | (b_ << 16); } \
        dst[2] = t2_[0] | (t2_[1] << 16); asm volatile("" : "+v"(dst[0]), "+v"(dst[1]), "+v"(dst[2])); } } while (0)
    Unit cur, nxt; int ui = 0;
    if (!S.next(0, cur)) return;
    f32x4 acc[3][2][MF][2];
#pragma unroll
    for (int a = 0; a < 3; ++a)
#pragma unroll
        for (int b = 0; b < 2; ++b)
#pragma unroll
            for (int m = 0; m < MF; ++m)
#pragma unroll
                for (int n = 0; n < 2; ++n) acc[a][b][m][n] = (f32x4){0.f, 0.f, 0.f, 0.f};
    bf16x8 At[MF][2], B0[2][2], B1[2][2];
    unsigned rp[3] = {0u, 0u, 0u}, rn[3] = {0u, 0u, 0u};
    PG9_ROWS(rp, cur);
    unsigned cA = (unsigned)cur.arow0 * lda2;
    unsigned cB = (unsigned)(((size_t)cur.e * g.b_estride + (size_t)cur.col0 * K) * 2);
    unsigned ck = (unsigned)S.kt0(cur) * kstep; int cnt = S.nkt(cur, nt);
    PG9_STAGEB(PG9_SB(0, 0), cB + ck); PG9_STAGEA(PG9_SA(0, 0), cA, rp, 0, ck, 0); PG9_STAGEB(PG9_SB(0, 1), cB + hstepB + ck); PG9_STAGEA(PG9_SA(0, 1), cA, rp, 1, ck, 1); PG9_STAGEA(PG9_SA(0, 2), cA, rp, 2, ck, 0);
    PG9_STAGEB(PG9_SB(1, 0), cB + ck + kstep); PG9_STAGEA(PG9_SA(1, 0), cA, rp, 0, ck + kstep, 1); PG9_STAGEB(PG9_SB(1, 1), cB + hstepB + ck + kstep); PG9_STAGEA(PG9_SA(1, 1), cA, rp, 1, ck + kstep, 0);
    PG9_WAIT_V(10); PG9_BAR;
    if (wr == 1) PG9_BAR;
    for (;;) {
        const bool has_next = S.next(ui + 1, nxt);
        if (has_next) { PG9_ROWS(rn, nxt); } else { rn[0] = rp[0]; rn[1] = rp[1]; rn[2] = rp[2]; }
        const unsigned nA = has_next ? (unsigned)nxt.arow0 * lda2 : cA;
        const unsigned nB = has_next ? (unsigned)(((size_t)nxt.e * g.b_estride + (size_t)nxt.col0 * K) * 2) : cB;
        const unsigned nk = has_next ? (unsigned)S.kt0(nxt) * kstep : ck; const int ncnt = has_next ? S.nkt(nxt, nt) : cnt;
#pragma unroll 1
        for (int t = 0; t < cnt; t += 2) {
            const bool last = (t == cnt - 2);
            const unsigned k1 = ck + (unsigned)(t + 1) * kstep, k2 = last ? nk : ck + (unsigned)(t + 2) * kstep, k3 = last ? nk + kstep : ck + (unsigned)(t + 3) * kstep;
            const unsigned u2 = last ? nA : cA; const unsigned b2 = (last ? nB : cB) + k2; const unsigned b3 = (last ? nB : cB) + k3;
            unsigned q[3]; q[0] = last ? rn[0] : rp[0]; q[1] = last ? rn[1] : rp[1]; q[2] = last ? rn[2] : rp[2];
            PG9_LDB(B0, 0, 0); PG9_LDB(B1, 0, 1); PG9_SCHED; PG9_LDA(At, 0, 0); PG9_STAGEA(PG9_SA(1, 2), cA, rp, 2, k1, 1);
            PG9_WAIT_V(10); PG9_WAIT_L(0); PG9_BAR; PG9_MMA(0, 0, At, B0); PG9_MMA(0, 1, At, B1); PG9_BAR; PG9_SCHED;
            PG9_LDA(At, 0, 1); PG9_STAGEB(PG9_SB(0, 0), b2); PG9_STAGEA(PG9_SA(0, 0), u2, q, 0, k2, 0);
            PG9_WAIT_V(12); PG9_WAIT_L(0); PG9_BAR; PG9_MMA(1, 0, At, B0); PG9_MMA(1, 1, At, B1); PG9_BAR; PG9_SCHED;
            PG9_LDA(At, 0, 2); PG9_STAGEB(PG9_SB(0, 1), b2 + hstepB); PG9_STAGEA(PG9_SA(0, 1), u2, q, 1, k2, 1);
            PG9_WAIT_V(10); PG9_WAIT_L(0); PG9_BAR; PG9_MMA(2, 0, At, B0); PG9_MMA(2, 1, At, B1); PG9_BAR; PG9_SCHED;
            PG9_LDB(B0, 1, 0); PG9_LDB(B1, 1, 1); PG9_SCHED; PG9_LDA(At, 1, 0); PG9_STAGEA(PG9_SA(0, 2), u2, q, 2, k2, 0);
            PG9_WAIT_V(10); PG9_WAIT_L(0); PG9_BAR; PG9_MMA(0, 0, At, B0); PG9_MMA(0, 1, At, B1); PG9_BAR; PG9_SCHED;
            PG9_LDA(At, 1, 1); PG9_STAGEB(PG9_SB(1, 0), b3); PG9_STAGEA(PG9_SA(1, 0), u2, q, 0, k3, 1);
            PG9_WAIT_V(12); PG9_WAIT_L(0); PG9_BAR; PG9_MMA(1, 0, At, B0); PG9_MMA(1, 1, At, B1); PG9_BAR; PG9_SCHED;
            PG9_LDA(At, 1, 2); PG9_STAGEB(PG9_SB(1, 1), b3 + hstepB); PG9_STAGEA(PG9_SA(1, 1), u2, q, 1, k3, 0);
            PG9_WAIT_V(10); PG9_WAIT_L(0); PG9_BAR; PG9_MMA(2, 0, At, B0); PG9_MMA(2, 1, At, B1); PG9_BAR; PG9_SCHED;
        }
        if (wr == 0) PG9_BAR;
        E(acc, cur, wr, wc, fr, fq);
        if (!has_next) break;
#pragma unroll
        for (int a = 0; a < 3; ++a)
#pragma unroll
            for (int b = 0; b < 2; ++b)
#pragma unroll
                for (int m = 0; m < MF; ++m)
#pragma unroll
                    for (int n = 0; n < 2; ++n) acc[a][b][m][n] = (f32x4){0.f, 0.f, 0.f, 0.f};
        cur = nxt; cB = nB; cA = nA; ck = nk; cnt = ncnt; ++ui; rp[0] = rn[0]; rp[1] = rn[1]; rp[2] = rn[2];
        if (wr == 1) PG9_BAR;
    }
    PG9_WAIT_V(0);
    PG9_BAR;
#undef PG9_SA
#undef PG9_SB
#undef PG9_DMA
#undef PG9_DMAX
#undef PG9_STAGEB
#undef PG9_RIDX
#undef PG9_STAGEA
#undef PG9_LDA
#undef PG9_LDB
#undef PG9_MMA
#undef PG9_WAIT_V
#undef PG9_WAIT_L
#undef PG9_BAR
#undef PG9_SCHED
#undef PG9_ROWS
}
}

#ifndef QUAD_SPLIT
#define QUAD_SPLIT 1
#endif
__device__ __forceinline__ bool deal(int i, int j, int gpx, int U, int& unit, int& quad) {
    const int q = i * gpx + j, nfull = (U / gpx) * gpx, left = U - nfull;
    if (q < nfull || left * 4 > gpx || !QUAD_SPLIT) { if (q >= U) return false; unit = q; quad = -1; return true; }
    const int s_ = q - nfull; if (s_ >= left * 4) return false; unit = nfull + (s_ >> 2); quad = s_ & 3; return true;
}
struct OrderRows {
    int x, j, gpx, rpx, nN, nomma, rot, TR;
    __device__ __forceinline__ bool next(int i, pg8::Unit& u) const {
        int q, quad; if (!deal(i, j, gpx, rpx * nN, q, quad)) return false;
        const int pm = x * rpx + q / nN, pn = q % nN; u.arow0 = pm * TR; u.col0 = pn * 256; u.e = 0; u.quad = quad >= 0;
        if (quad >= 0) { u.arow0 += (quad >> 1) * (TR / 2); u.col0 += (quad & 1) * 128; }
        if (nomma) u.quad = 2;
        u.orow0 = u.arow0; return true; }
    __device__ __forceinline__ int kt0(const pg8::Unit&) const { return 0; }
    __device__ __forceinline__ int nkt(const pg8::Unit&, int nt) const { return nt; }
};
struct OrderUp : OrderRows {
    __device__ __forceinline__ int kt0(const pg8::Unit& u) const { return u.col0 < 512 ? 0 : 4; }
    __device__ __forceinline__ int nkt(const pg8::Unit& u, int) const { return u.col0 < 512 ? 4 : 2; }
};
struct OrderMoe {
    int x, j, gpx, nME, nN, rot, TR;
    __device__ __forceinline__ bool next(int i, pg8::Unit& u) const {
        int q, quad; const int per = nME * nN; if (!deal(i, j, gpx, 2 * per, q, quad)) return false;
        const int e = 2 * x + q / per, rem = q % per, pmE = rem / nN, pn = rem % nN;
        u.arow0 = e * SLOTS_E + pmE * TR; u.col0 = pn * 256; u.e = e; u.quad = quad >= 0;
        if (quad >= 0) { u.arow0 += (quad >> 1) * (TR / 2); u.col0 += (quad & 1) * 128; }
        u.orow0 = u.arow0; return true; }
    __device__ __forceinline__ int kt0(const pg8::Unit&) const { return 0; }
    __device__ __forceinline__ int nkt(const pg8::Unit&, int nt) const { return nt; }
};

#if X_BF16
typedef bf16 XT;
#else
typedef float XT;
#endif
constexpr float QS_A = 0.125f * 1.4426950408889634f, QS_B = 0.10206207261596577f * 1.4426950408889634f, QS_C = 0.17677669529663687f * 1.4426950408889634f;
typedef float f32x4e __attribute__((ext_vector_type(4)));
#define EPI_ROWS(ai, m) (u.orow0 + (ai) * (32 * MF) + wr * (16 * MF) + (m) * 16 + fr)
#define EPI_COL0(bj) (u.col0 + (bj) * 128 + wc * 32 + 8 * fq)
__device__ __forceinline__ void rope8(f32x4& v0, f32x4& v1, const float* cs, const float* sn) {
    const f32x4 c = *(const f32x4*)cs, s = *(const f32x4*)sn;
    f32x4 a = v0, b = v1;
    v0.x = a.x * c.x - a.y * s.x; v0.y = a.y * c.x + a.x * s.x; v0.z = a.z * c.y - a.w * s.y; v0.w = a.w * c.y + a.z * s.y;
    v1.x = b.x * c.z - b.y * s.z; v1.y = b.y * c.z + b.x * s.z; v1.z = b.z * c.w - b.w * s.w; v1.w = b.w * c.w + b.z * s.w;
}
__device__ __forceinline__ u32x4 pack8(const f32x4 v0, const f32x4 v1) { u32x4 w; w.x = pk2(v0.x, v0.y); w.y = pk2(v0.z, v0.w); w.z = pk2(v1.x, v1.y); w.w = pk2(v1.z, v1.w); return w; }

template <int MF, int NA = 2> struct EpiInProj {
    bf16* P; const float* rope; float* RSQ;
    __device__ __forceinline__ void operator()(const f32x4 (&acc)[NA][2][MF][2], const pg8::Unit& u, int wr, int wc, int fr, int fq) const {
#pragma unroll
        for (int bj = 0; bj < 2; ++bj) {
            if (u.quad && bj) continue;
            const int c0 = EPI_COL0(bj);
            const bool secA = c0 < P_AV, secB = c0 >= P_KR && c0 < P_DV;
            const int which = (c0 >= P_CQ && c0 < P_CKV) ? 0 : ((c0 >= P_CKV && c0 < P_KR) ? 1 : -1);
            const int p0 = secA ? ((c0 & 63) >> 1) : ((c0 & 31) >> 1);
            const float qs = c0 < P_AK ? QS_A : ((c0 >= P_DQ && c0 < P_DK) ? QS_C : 1.f);
#pragma unroll
            for (int ai = 0; ai < NA; ++ai)
#pragma unroll
                for (int m = 0; m < MF; ++m) {
                    if (u.quad && ai) continue;
                    const int row = EPI_ROWS(ai, m);
                    f32x4 v0 = acc[ai][bj][m][0] * qs, v1 = acc[ai][bj][m][1] * qs;
                    if (row < RL && (secA || secB)) { const int t = row & (T - 1);
                        const float* cs = secA ? rope + t * 32 + p0 : rope + T * 64 + t * 16 + p0;
                        const float* sn = secA ? rope + T * 32 + t * 32 + p0 : rope + T * 64 + T * 16 + t * 16 + p0;
                        rope8(v0, v1, cs, sn); }
                    if (which >= 0) { float s = (v0.x * v0.x + v0.y * v0.y) + (v0.z * v0.z + v0.w * v0.w) + (v1.x * v1.x + v1.y * v1.y) + (v1.z * v1.z + v1.w * v1.w);
                        { const int ln_ = fq * 16 + fr; s += shx(s, 16, ln_); s += shx(s, 32, ln_); }
                        if (fq == 0) RSQ[(size_t)row * 12 + ((c0 - P_CQ) >> 5)] = s; }
                    st16(P + (size_t)row * LDP + c0, pack8(v0, v1));
                }
        }
    }
};
template <int MF, int NA = 2> struct EpiUp {
    bf16* QKVM; const float* rope; const float* RSQ;
    __device__ __forceinline__ void operator()(const f32x4 (&acc)[NA][2][MF][2], const pg8::Unit& u, int wr, int wc, int fr, int fq) const {
        const bool isq = u.col0 < 512;
        const float inv = isq ? (1.f / 256.f) : (1.f / 128.f);
        const int cw = u.col0 + wc * 32 + 8 * fq;
        int j0 = cw; j0 -= j0 >= 192 ? 192 : 0; j0 -= j0 >= 96 ? 96 : 0;
        int j1 = j0 + 32; j1 -= j1 >= 96 ? 96 : 0;
        const bool rot0 = isq && cw < 384 && j0 >= 64, rot1 = isq && cw + 128 < 384 && j1 >= 64;
        const float* tb = rope + T * 64;
#pragma unroll
        for (int ai = 0; ai < NA; ++ai)
#pragma unroll
            for (int m = 0; m < MF; ++m) {
                if (u.quad && ai) continue;
                const int row = EPI_ROWS(ai, m);
                const float* rq = RSQ + (size_t)row * 12; float sq;
                if (isq) { const f32x4 pa_ = *(const f32x4*)rq, pb_ = *(const f32x4*)(rq + 4); sq = ((pa_.x + pa_.y) + (pa_.z + pa_.w)) + ((pb_.x + pb_.y) + (pb_.z + pb_.w)); }
                else { const f32x4 pc_ = *(const f32x4*)(rq + 8); sq = (pc_.x + pc_.y) + (pc_.z + pc_.w); }
                const float rs = __builtin_amdgcn_rsqf(sq * inv + EPS) * (isq ? QS_B : 1.f);
                const int t = row & (T - 1);
                bf16* dst = QKVM + (size_t)row * LDM + cw;
                { f32x4 v0 = acc[ai][0][m][0] * rs, v1 = acc[ai][0][m][1] * rs;
                  if (rot0 && row < RL) rope8(v0, v1, tb + t * 16 + ((j0 - 64) >> 1), tb + T * 16 + t * 16 + ((j0 - 64) >> 1));
                  st16(dst, pack8(v0, v1)); }
                if (!u.quad) { f32x4 v0 = acc[ai][1][m][0] * rs, v1 = acc[ai][1][m][1] * rs;
                  if (rot1 && row < RL) rope8(v0, v1, tb + t * 16 + ((j1 - 64) >> 1), tb + T * 16 + t * 16 + ((j1 - 64) >> 1));
                  st16(dst + 128, pack8(v0, v1)); }
            }
    }
};
template <int MF, int NA = 2> struct EpiOut {
    XT* X; const float* MODl; float keep;
    __device__ __forceinline__ void operator()(const f32x4 (&acc)[NA][2][MF][2], const pg8::Unit& u, int wr, int wc, int fr, int fq) const {
#pragma unroll
        for (int ai = 0; ai < NA; ++ai)
#pragma unroll
            for (int m = 0; m < MF; ++m) {
                if (u.quad && ai) continue;
                const int row_ = EPI_ROWS(ai, m); const int mb = row_ < RL ? row_ >> 11 : 8;
                const float* g1 = MODl + (size_t)mb * 6144 + 2048;
#pragma unroll
                for (int bj = 0; bj < 2; ++bj) {
                    if (u.quad && bj) continue;
                    const int c0 = EPI_COL0(bj);
                    const f32x4 ga = *(const f32x4*)(g1 + c0) * keep, gb = *(const f32x4*)(g1 + c0 + 4) * keep;
                    XT* xp = X + (size_t)row_ * D + c0;
#if X_BF16
                    const u32x4 xw = *(const u32x4*)xp;
                    f32x4 xa = (f32x4){bf2f(xw.x & 0xffffu), bf2f(xw.x >> 16), bf2f(xw.y & 0xffffu), bf2f(xw.y >> 16)}, xb = (f32x4){bf2f(xw.z & 0xffffu), bf2f(xw.z >> 16), bf2f(xw.w & 0xffffu), bf2f(xw.w >> 16)};
                    xa += ga * acc[ai][bj][m][0]; xb += gb * acc[ai][bj][m][1];
                    st16(xp, pack8(xa, xb));
#else
                    f32x4 xa = *(const f32x4*)xp, xb = *(const f32x4*)(xp + 4);
                    xa += ga * acc[ai][bj][m][0]; xb += gb * acc[ai][bj][m][1];
                    *(f32x4*)xp = xa; *(f32x4*)(xp + 4) = xb;
#endif
                }
            }
    }
};
template <int MF, int NA = 2> struct EpiGU {
    bf16* HID;
    __device__ __forceinline__ void operator()(const f32x4 (&acc)[NA][2][MF][2], const pg8::Unit& u, int wr, int wc, int fr, int fq) const {
#pragma unroll
        for (int bj = 0; bj < 2; ++bj) {
            if (u.quad && bj) continue;
            const int hc = EPI_COL0(bj) >> 1;
#pragma unroll
            for (int ai = 0; ai < NA; ++ai)
#pragma unroll
                for (int m = 0; m < MF; ++m) {
                    if (u.quad && ai) continue;
                    const f32x4 g = acc[ai][bj][m][0], up = acc[ai][bj][m][1];
                    u32x2 w; w.x = pk2(siluf(g.x) * up.x, siluf(g.y) * up.y); w.y = pk2(siluf(g.z) * up.z, siluf(g.w) * up.w);
                    *(u32x2*)(HID + (size_t)EPI_ROWS(ai, m) * DE + hc) = w;
                }
        }
    }
};
template <int MF, int NA = 2> struct EpiDown {
    bf16* Y; const float* SGATE;
    __device__ __forceinline__ void operator()(const f32x4 (&acc)[NA][2][MF][2], const pg8::Unit& u, int wr, int wc, int fr, int fq) const {
#pragma unroll
        for (int ai = 0; ai < NA; ++ai)
#pragma unroll
            for (int m = 0; m < MF; ++m) {
                if (u.quad && ai) continue;
                const int row = EPI_ROWS(ai, m); const float gt = SGATE[row];
#pragma unroll
                for (int bj = 0; bj < 2; ++bj)
                    if (!(u.quad && bj)) st16(Y + (size_t)row * D + EPI_COL0(bj), pack8(acc[ai][bj][m][0] * gt, acc[ai][bj][m][1] * gt));
            }
    }
};

constexpr int NWAVES = 8;
constexpr int RING_BYTES = 139264;
constexpr int LDSCTL_OFF = RING_BYTES, MISC_OFF = LDSCTL_OFF + 320;
constexpr int LDS_BYTES = 147456;
constexpr int CW_BAR = 4096;
typedef GAS unsigned gu32;

#define XB_TMO      128
#define XB_XCNT(j)  (256  + 64 * (j))
#define XB_XSUB(j)  (1280 + 64 * (j))
#define XB_XGEN(j)  (2304 + 64 * (j))
#define XB_TOP      3328
#define XB_TOPGEN   3392
#define XCD_BAR_WORDS 3456
#define XB_SPIN_CAP (1u << 18)
__device__ __forceinline__ unsigned xb_ld(unsigned* p)              { return __hip_atomic_load(p, __ATOMIC_RELAXED, __HIP_MEMORY_SCOPE_AGENT); }
__device__ __forceinline__ unsigned xb_add(unsigned* p, unsigned v) { return __hip_atomic_fetch_add(p, v, __ATOMIC_RELAXED, __HIP_MEMORY_SCOPE_AGENT); }
__device__ __forceinline__ unsigned xb_xcc_id() { return (unsigned)__builtin_amdgcn_s_getreg((3 << 11) | 20) & 0xFu; }
#define XB_SPIN(cond, bar) do { unsigned _sp = 0; while (cond) { __builtin_amdgcn_s_sleep(1); \
    if ((++_sp & 255u) == 0u) { if (xb_ld(&(bar)[XB_TMO])) break; if (_sp > XB_SPIN_CAP) { atomicAdd(&(bar)[XB_TMO], 1u); break; } } } } while (0)
struct XcdBarrier { unsigned* bar; unsigned x; volatile LAS unsigned* st; };
__device__ __forceinline__ XcdBarrier xcd_barrier_post(unsigned* bar, volatile LAS unsigned* st) {
    XcdBarrier b; b.bar = bar; b.x = xb_xcc_id(); b.st = st;
    if (threadIdx.x == 0) (void)xb_add(&bar[XB_XCNT(b.x)], 1u);
    return b;
}
__device__ __forceinline__ void xcd_barrier_complete(unsigned* bar, unsigned x, unsigned& nloc, unsigned& nx) {
    const unsigned G = gridDim.x * gridDim.y * gridDim.z;
    unsigned sum, cnt, mine, sp = 0u;
    for (;;) {
        sum = 0u; cnt = 0u; mine = 0u;
#pragma unroll
        for (unsigned j = 0; j < 16; ++j) { const unsigned c = xb_ld(&bar[XB_XCNT(j)]); sum += c; cnt += (c > 0u) ? 1u : 0u; mine = (j == x) ? c : mine; }
        if (sum == G) break;
        __builtin_amdgcn_s_sleep(1);
        if ((++sp & 255u) == 0u) { if (xb_ld(&bar[XB_TMO])) break; if (sp > XB_SPIN_CAP) { atomicAdd(&bar[XB_TMO], 1u); break; } }
    }
    nloc = mine > 0u ? mine : 1u; nx = cnt > 0u ? cnt : 1u;
}
__device__ __forceinline__ void xcd_barrier(const XcdBarrier& b, const int tid) {
    asm volatile("s_waitcnt vmcnt(0)" ::: "memory");
    __syncthreads();
    if (tid == 0) {
        unsigned* bar = b.bar;
        __builtin_amdgcn_s_waitcnt(0);
        unsigned nloc = b.st[0], nx = b.st[1];
        if (nloc == 0u) { xcd_barrier_complete(bar, b.x, nloc, nx); b.st[0] = nloc; b.st[1] = nx; }
        const unsigned old = xb_add(&bar[XB_XSUB(b.x)], 1u);
        const unsigned gen = old / nloc;
        if (old + 1u == (gen + 1u) * nloc) {
            __builtin_amdgcn_fence(__ATOMIC_RELEASE, "agent");
            asm volatile("s_waitcnt vmcnt(0)" ::: "memory");
            const unsigned og = xb_add(&bar[XB_TOP], 1u);
            const unsigned tg = og / nx;
            if (og + 1u == (tg + 1u) * nx) xb_add(&bar[XB_TOPGEN], 1u);
            else XB_SPIN(xb_ld(&bar[XB_TOPGEN]) == tg, bar);
            __builtin_amdgcn_fence(__ATOMIC_ACQUIRE, "agent");
            xb_add(&bar[XB_XGEN(b.x)], 1u);
            asm volatile("s_waitcnt vmcnt(0)" ::: "memory");
        } else {
            XB_SPIN(xb_ld(&bar[XB_XGEN(b.x)]) == gen, bar);
            __builtin_amdgcn_fence(__ATOMIC_ACQUIRE, "agent");
            asm volatile("s_waitcnt vmcnt(0)" ::: "memory");
        }
    }
    __syncthreads();
}

struct Frame { LAS unsigned char* lds; int tid, lane, wave, bid, G; const float* const* in; GAS float* out; GAS unsigned char* ws; };
#define IN_(k) ((const float*)(const GAS float*)F.in[(k)])
#define F_x IN_(0)
#define F_c IN_(1)
#define F_ctx IN_(2)
#define F_c_ctx IN_(3)
#define F_norm1 IN_(4)
#define F_norm2 IN_(5)
#define F_w_ada IN_(6)
#define F_b_ada IN_(7)
#define F_w_in IN_(8)
#define F_sink IN_(9)
#define F_mla_q_norm IN_(10)
#define F_w_uq IN_(11)
#define F_mla_kv_norm IN_(12)
#define F_w_ukv IN_(13)
#define F_lq1 IN_(14)
#define F_lk1 IN_(15)
#define F_lq2 IN_(16)
#define F_lk2 IN_(17)
#define F_diff_norm IN_(18)
#define F_w_out IN_(19)
#define F_w_router IN_(20)
#define F_w_gate IN_(21)
#define F_w_up IN_(22)
#define F_w_down IN_(23)
#define F_final_norm IN_(24)
#define F_MOD ((float*)(GAS float*)(F.ws + WS_MOD))
#define F_ROPE ((float*)(GAS float*)(F.ws + WS_ROPE))
#define F_RSQ ((float*)(GAS float*)(F.ws + WS_RSQ))
#define F_AFF ((float*)(GAS float*)(F.ws + WS_AFF))
#define F_INV ((int*)(GAS int*)(F.ws + WS_INV))
#define F_STOK ((int*)(GAS int*)(F.ws + WS_STOK))
#define F_SGATE ((float*)(GAS float*)(F.ws + WS_SGATE))
#define F_X ((float*)(GAS float*)(F.ws + WS_X))
#define F_XB ((bf16*)(GAS bf16*)(F.ws + WS_X))
#define F_ACT ((bf16*)(GAS bf16*)(F.ws + WS_ACT))
#define F_P ((bf16*)(GAS bf16*)(F.ws + WS_P))
#define F_Y ((bf16*)(GAS bf16*)(F.ws + WS_Y))
#define F_QKVM ((bf16*)(GAS bf16*)(F.ws + WS_QKVM))
#define F_O ((bf16*)(GAS bf16*)(F.ws + WS_O))
#define F_HID ((bf16*)(GAS bf16*)(F.ws + WS_HID))
#define F_WB ((bf16*)(GAS bf16*)(F.ws + WS_W))

__device__ __forceinline__ int rot64(int dp) { const int p = dp >> 1, half = dp & 1, axis = p >> 4, f = p & 15; return axis * 32 + half * 16 + f; }
__device__ __forceinline__ int rot32(int dp) { const int p = dp >> 1, half = dp & 1, axis = p >> 3, f = p & 7; return axis * 16 + half * 8 + f; }
__device__ __forceinline__ int src_col_in(int n) {
    if (n >= INW) return -1;
    if (n < P_AV) return (n & ~63) + rot64(n & 63);
    if (n >= P_KR && n < P_DV) return (n & ~31) + rot32(n & 31);
    return n;
}
__device__ __forceinline__ void prep_tile(const float* src, int N, int k0, const float* kscale, bf16* dst, int ldd, LAS float* scr, int lane) {
    float v[32];
#pragma unroll
    for (int i = 0; i < 32; ++i) { const int kk = 2 * i + (lane >> 5); v[i] = src ? src[(size_t)(k0 + kk) * N] : 0.f; }
    if (kscale) {
#pragma unroll
        for (int i = 0; i < 32; ++i) v[i] *= kscale[k0 + 2 * i + (lane >> 5)]; }
#pragma unroll
    for (int i = 0; i < 32; ++i) scr[(2 * i + (lane >> 5)) * 33 + (lane & 31)] = v[i];
    LDS_WAIT();
    const int c = lane & 7;
#pragma unroll
    for (int j = 0; j < 4; ++j) { const int n = (lane >> 3) + 8 * j; const LAS float* s = scr + (8 * c) * 33 + n;
        u32x4 o; o.x = pk2(s[0], s[33]); o.y = pk2(s[66], s[99]); o.z = pk2(s[132], s[165]); o.w = pk2(s[198], s[231]);
        *(u32x4*)(dst + (size_t)n * ldd + 8 * c) = o; }
    LDS_WAIT();
}
constexpr int PI_IN = 16 * 64, PI_UP = 6 * 32, PI_OUT = 16 * 32, PI_GU = NE * 16 * 32, PI_DN = NE * 8 * 32, PI_LAYER = PI_IN + PI_UP + PI_OUT + PI_GU + PI_DN;
#ifndef BG_PREP
#define BG_PREP 0
#ifndef MOE_PF
#define MOE_PF 0
#endif
#endif
__device__ __forceinline__ void prep_layer(Frame& F, const int l, const int worker, const int nworkers) {
    const int lane = F.lane, wave = F.wave;
    LAS float* scr = (LAS float*)(F.lds + 57344 + wave * 8448);
    for (int it = worker; it < PI_LAYER; it += nworkers) {
        int r = it; bf16* wl = F_WB + (size_t)l * W_LAYER;
        const int nl = lane & 31;
        if (r < PI_IN) { const int kb = r / 64, nb = r % 64, n = nb * 32 + nl, sc = src_col_in(n);
            prep_tile(sc >= 0 ? F_w_in + (size_t)l * D * INW + sc : nullptr, INW, kb * 64, nullptr, wl + W_IN + (size_t)(nb * 32) * D + kb * 64, D, scr, lane); continue; } r -= PI_IN;
        if (r < PI_UP) { const int kb = r / 32, nb = r % 32, n = nb * 32 + nl, k0 = kb * 64; const float* src = nullptr; const float* ks = nullptr; int N = 384, ksrc = k0;
            if (n < 384 && k0 < 256) { const int h = n / 96, j = n % 96; const int sc = j < 64 ? n : h * 96 + 64 + rot32(j - 64); src = F_w_uq + (size_t)l * 256 * 384 + sc; ks = F_mla_q_norm + l * 256; N = 384; }
            else if (n >= 512 && k0 >= 256) { src = F_w_ukv + (size_t)l * 128 * 512 + (n - 512); ks = F_mla_kv_norm + l * 128; N = 512; ksrc = k0 - 256; }
            { float v[32];
#pragma unroll
              for (int i = 0; i < 32; ++i) { const int kk = 2 * i + (lane >> 5); v[i] = src ? src[(size_t)(ksrc + kk) * N] * ks[ksrc + kk] : 0.f; }
#pragma unroll
              for (int i = 0; i < 32; ++i) scr[(2 * i + (lane >> 5)) * 33 + (lane & 31)] = v[i];
              LDS_WAIT();
              const int c = lane & 7; bf16* dst = wl + W_UP + (size_t)(nb * 32) * UPK + k0;
#pragma unroll
              for (int j = 0; j < 4; ++j) { const int nn = (lane >> 3) + 8 * j; const LAS float* s = scr + (8 * c) * 33 + nn;
                  u32x4 o; o.x = pk2(s[0], s[33]); o.y = pk2(s[66], s[99]); o.z = pk2(s[132], s[165]); o.w = pk2(s[198], s[231]);
                  *(u32x4*)(dst + (size_t)nn * UPK + 8 * c) = o; }
              LDS_WAIT(); }
            continue; } r -= PI_UP;
        if (r < PI_OUT) { const int kb = r / 32, nb = r % 32;
            prep_tile(F_w_out + (size_t)l * D * D + nb * 32 + nl, D, kb * 64, nullptr, wl + W_OUT + (size_t)(nb * 32) * D + kb * 64, D, scr, lane); continue; } r -= PI_OUT;
        if (r < PI_GU) { const int e = r / 512, q = r % 512, kb = q / 32, nb = q % 32, n = nb * 32 + nl, f = (n >> 3) * 4 + (n & 3);
            const float* src = ((n & 4) ? F_w_up : F_w_gate) + ((size_t)l * NE + e) * D * DE + f;
            prep_tile(src, DE, kb * 64, nullptr, wl + W_GU + (size_t)e * 1024 * 1024 + (size_t)(nb * 32) * D + kb * 64, D, scr, lane); continue; } r -= PI_GU;
        { const int e = r / 256, q = r % 256, kb = q / 32, nb = q % 32;
            prep_tile(F_w_down + ((size_t)l * NE + e) * DE * D + nb * 32 + nl, D, kb * 64, nullptr, wl + W_DN + (size_t)e * 1024 * 512 + (size_t)(nb * 32) * DE + kb * 64, DE, scr, lane); }
    }
}

__device__ __forceinline__ void p0_phase(Frame& F) {
    const int tid = F.tid, lane = F.lane, wave = F.wave;
    {
        LAS float* sl = (LAS float*)F.lds;
        LAS float* red = (LAS float*)(F.lds + 36864);
        for (int i = tid; i < 9 * 1024; i += 512) { const float v = i < 8 * 1024 ? F_c[i] : F_c_ctx[i - 8 * 1024]; sl[i] = siluf(v); }
        __syncthreads();
        for (int it = F.bid; it < DEPTH * 96; it += F.G) {
            const int l = it / 96, cg = it % 96, col = cg * 64 + lane;
            float acc[9];
#pragma unroll
            for (int r = 0; r < 9; ++r) acc[r] = 0.f;
            const float* w = F_w_ada + (size_t)l * D * 6144 + (size_t)(wave * 128) * 6144 + col;
#pragma unroll 16
            for (int k = 0; k < 128; ++k) { const float wv = w[(size_t)k * 6144];
#pragma unroll
                for (int r = 0; r < 9; ++r) acc[r] += sl[r * 1024 + wave * 128 + k] * wv; }
#pragma unroll
            for (int r = 0; r < 9; ++r) red[(wave * 9 + r) * 64 + lane] = acc[r];
            __syncthreads();
            for (int o = tid; o < 576; o += 512) { const int r = o >> 6, cc = o & 63; float s = 0.f;
#pragma unroll
                for (int w8 = 0; w8 < 8; ++w8) s += red[(w8 * 9 + r) * 64 + cc];
                F_MOD[((size_t)l * 9 + r) * 6144 + cg * 64 + cc] = s + F_b_ada[l * 6144 + cg * 64 + cc]; }
            __syncthreads();
        }
    }
    const int gw = F.bid * NWAVES + wave, NGW = F.G * NWAVES;
    { const size_t n4 = (size_t)R * D / 4, nl4 = (size_t)RL * D / 4;
      for (size_t i = (size_t)F.bid * 512 + tid; i < n4; i += (size_t)F.G * 512) { const f32x4 v = i < nl4 ? ((const f32x4*)F_x)[i] : ((const f32x4*)F_ctx)[i - nl4];
#if X_BF16
          u32x2 w; w.x = pk2(v.x, v.y); w.y = pk2(v.z, v.w); ((u32x2*)F_XB)[i] = w; } }
#else
          ((f32x4*)F_X)[i] = v; } }
#endif
    for (int i = F.bid * 512 + tid; i < T * 48; i += F.G * 512) {
        const int t = i / 48, j = i % 48; int axis, f, nf;
        if (j < 32) { axis = j >> 4; f = j & 15; nf = 16; } else { axis = (j - 32) >> 3; f = (j - 32) & 7; nf = 8; }
        const float inv = exp2f(-(float)f / (float)nf * 13.287712379549449f);
        const float ang = (float)(axis == 0 ? (t >> 6) : (t & 63)) * inv;
        const float cv = cosf(ang), sv = sinf(ang);
        if (j < 32) { F_ROPE[t * 32 + j] = cv; F_ROPE[T * 32 + t * 32 + j] = sv; } else { F_ROPE[T * 64 + t * 16 + j - 32] = cv; F_ROPE[T * 64 + T * 16 + t * 16 + j - 32] = sv; }
    }
    for (int l = 0; l < (BG_PREP ? 1 : DEPTH); ++l) prep_layer(F, l, gw, NGW);
}

#ifndef PROBE_NOROUTER
#define PROBE_NOROUTER 0
#endif
#define half_swap_add(keepv, sendv, off) ((keepv) + shx((sendv), (off), lane))
__device__ __forceinline__ void norm_phase(Frame& F, int l, int mode, int nrows, const float keep) {
    const int lane = F.lane, gw = F.bid * NWAVES + F.wave, NGW = F.G * NWAVES;
    LAS float* wrT = (LAS float*)F.lds;
    if (mode == 1) {
        const float* wr = F_w_router + (size_t)l * D * NE;
        for (int i = F.tid; i < D * NE; i += 512) wrT[(i & 15) * 1028 + (i >> 4)] = wr[i];
        __syncthreads();
    }
    const float* gain = mode == 0 ? F_norm1 + (size_t)l * D : (mode == 1 ? F_norm2 + (size_t)l * D : F_final_norm);
    const bool comb = mode != 1 && l > 0;
    f32x4 vn[2][4];
#if X_BF16
#define NORM_LOAD(dst, rr0) do { _Pragma("unroll") for (int q = 0; q < 2; ++q) _Pragma("unroll") for (int j = 0; j < 4; ++j) { const u32x2 w_ = ((const u32x2*)(F_XB + (size_t)((rr0) + q) * D))[lane + 64 * j]; \
        dst[q][j] = (f32x4){bf2f(w_.x & 0xffffu), bf2f(w_.x >> 16), bf2f(w_.y & 0xffffu), bf2f(w_.y >> 16)}; } } while (0)
#else
#define NORM_LOAD(dst, rr0) do { _Pragma("unroll") for (int q = 0; q < 2; ++q) _Pragma("unroll") for (int j = 0; j < 4; ++j) dst[q][j] = ((const f32x4*)(F_X + (size_t)((rr0) + q) * D))[lane + 64 * j]; } while (0)
#endif
    if (gw * 2 < nrows) NORM_LOAD(vn, gw * 2);
    for (int r0 = gw * 2; r0 < nrows; r0 += NGW * 2) {
        const int mb = r0 < RL ? r0 / T : 8;
        f32x4 v[2][4];
#pragma unroll
        for (int q = 0; q < 2; ++q)
#pragma unroll
            for (int j = 0; j < 4; ++j) v[q][j] = vn[q][j];
        if (r0 + NGW * 2 < nrows) NORM_LOAD(vn, r0 + NGW * 2);
        if (comb) {
            const float* g2 = F_MOD + ((size_t)(l - 1) * 9 + mb) * 6144 + 5120;
            const int myinv = lane < 2 * NE ? F_INV[(size_t)r0 * NE + lane] : -1;
            f32x4 s[2][4];
#pragma unroll
            for (int q = 0; q < 2; ++q)
#pragma unroll
                for (int j = 0; j < 4; ++j) s[q][j] = (f32x4){0.f, 0.f, 0.f, 0.f};
            for (int e = 0; e < NE; ++e) {
#pragma unroll
                for (int q = 0; q < 2; ++q) { const int sl = shi(myinv, q * NE + e);
                    if (sl >= 0) { const bf16* yr = F_Y + (size_t)sl * D;
#pragma unroll
                        for (int j = 0; j < 4; ++j) { const u32x2 w = ((const u32x2*)yr)[lane + 64 * j];
                            s[q][j].x += bf2f(w.x & 0xffff); s[q][j].y += bf2f(w.x >> 16); s[q][j].z += bf2f(w.y & 0xffff); s[q][j].w += bf2f(w.y >> 16); } } } }
#pragma unroll
            for (int j = 0; j < 4; ++j) { const f32x4 g = ((const f32x4*)g2)[lane + 64 * j];
#pragma unroll
                for (int q = 0; q < 2; ++q) { v[q][j] += g * s[q][j] * keep;
#if X_BF16
                    u32x2 w; w.x = pk2(v[q][j].x, v[q][j].y); w.y = pk2(v[q][j].z, v[q][j].w); ((u32x2*)(F_XB + (size_t)(r0 + q) * D))[lane + 64 * j] = w;
#else
                    ((f32x4*)(F_X + (size_t)(r0 + q) * D))[lane + 64 * j] = v[q][j];
#endif
                } }
        }
        float ss0 = 0.f, ss1 = 0.f;
#pragma unroll
        for (int j = 0; j < 4; ++j) { ss0 += (v[0][j].x * v[0][j].x + v[0][j].y * v[0][j].y) + (v[0][j].z * v[0][j].z + v[0][j].w * v[0][j].w);
                                      ss1 += (v[1][j].x * v[1][j].x + v[1][j].y * v[1][j].y) + (v[1][j].z * v[1][j].z + v[1][j].w * v[1][j].w); }
#pragma unroll
        for (int o = 1; o < 64; o <<= 1) { ss0 += shx(ss0, o, lane); ss1 += shx(ss1, o, lane); }
        const float rs[2] = {1.0f / sqrtf(ss0 * (1.f / D) + EPS), 1.0f / sqrtf(ss1 * (1.f / D) + EPS)};
        if (mode == 2) {
#pragma unroll
            for (int j = 0; j < 4; ++j) { const f32x4 g = ((const f32x4*)gain)[lane + 64 * j];
#pragma unroll
                for (int q = 0; q < 2; ++q) ((f32x4*)((float*)F.out + (size_t)(r0 + q) * D))[lane + 64 * j] = v[q][j] * rs[q] * g; }
        } else {
            const float* md = F_MOD + ((size_t)l * 9 + mb) * 6144 + (mode == 0 ? 0 : 3072);
#pragma unroll
            for (int j = 0; j < 4; ++j) { const f32x4 g = ((const f32x4*)gain)[lane + 64 * j];
                const f32x4 sh = ((const f32x4*)md)[lane + 64 * j], sc = ((const f32x4*)(md + 1024))[lane + 64 * j];
#pragma unroll
                for (int q = 0; q < 2; ++q) { v[q][j] = v[q][j] * rs[q] * g * (sc + 1.0f) + sh;
                    u32x2 w; w.x = pk2(v[q][j].x, v[q][j].y); w.y = pk2(v[q][j].z, v[q][j].w);
                    ((u32x2*)(F_ACT + (size_t)(r0 + q) * D))[lane + 64 * j] = w; } }
            if (mode == 1 && !(PROBE_NOROUTER && keep == 0.f)) {
                float a[2][NE];
                typedef float f32x2r __attribute__((ext_vector_type(2)));
#pragma unroll
                for (int e = 0; e < NE; ++e) { f32x2r p0 = {0.f, 0.f}, p1 = {0.f, 0.f};
#pragma unroll
                    for (int j = 0; j < 4; ++j) { const f32x4 w = *(const LAS f32x4*)(wrT + e * 1028 + 256 * j + 4 * lane);
                        const f32x2r wl = {w.x, w.y}, wh = {w.z, w.w};
                        p0 = __builtin_elementwise_fma((f32x2r){v[0][j].x, v[0][j].y}, wl, p0); p0 = __builtin_elementwise_fma((f32x2r){v[0][j].z, v[0][j].w}, wh, p0);
                        p1 = __builtin_elementwise_fma((f32x2r){v[1][j].x, v[1][j].y}, wl, p1); p1 = __builtin_elementwise_fma((f32x2r){v[1][j].z, v[1][j].w}, wh, p1); }
                    a[0][e] = p0.x + p0.y; a[1][e] = p1.x + p1.y; if ((e & 1) == 1) __builtin_amdgcn_sched_barrier(0); }
                float b16[NE];
#pragma unroll
                for (int e = 0; e < NE; ++e) { const bool up = lane >= 32; b16[e] = half_swap_add(up ? a[1][e] : a[0][e], up ? a[0][e] : a[1][e], 32); }
                float b8[8];
#pragma unroll
                for (int e = 0; e < 8; ++e) { const bool up = (lane & 16) != 0; b8[e] = half_swap_add(up ? b16[8 + e] : b16[e], up ? b16[e] : b16[8 + e], 16); }
                float b4[4];
#pragma unroll
                for (int e = 0; e < 4; ++e) { const bool up = (lane & 8) != 0; b4[e] = half_swap_add(up ? b8[4 + e] : b8[e], up ? b8[e] : b8[4 + e], 8); }
                float b2[2];
#pragma unroll
                for (int e = 0; e < 2; ++e) { const bool up = (lane & 4) != 0; b2[e] = half_swap_add(up ? b4[2 + e] : b4[e], up ? b4[e] : b4[2 + e], 4); }
                float lg; { const bool up = (lane & 2) != 0; lg = half_swap_add(up ? b2[1] : b2[0], up ? b2[0] : b2[1], 2); }
                lg += shx(lg, 1, lane);
                float mx = lg;
#pragma unroll
                for (int o = 2; o < 32; o <<= 1) mx = fmaxf(mx, shx(mx, o, lane));
                const float ex = __expf(lg - mx); float sum = ex;
#pragma unroll
                for (int o = 2; o < 32; o <<= 1) sum += shx(sum, o, lane);
                const int eidx = ((lane >> 4) & 1) * 8 + ((lane >> 3) & 1) * 4 + ((lane >> 2) & 1) * 2 + ((lane >> 1) & 1);
                if ((lane & 1) == 0) F_AFF[(size_t)(r0 + (lane >> 5)) * NE + eidx] = ex / sum;
            }
        }
    }
}

#undef NORM_LOAD
__device__ __forceinline__ void topk_phase(Frame& F, int nsets) {
    LAS unsigned* cnt = (LAS unsigned*)F.lds;
    const int tid = F.tid, lane = F.lane, wave = F.wave;
    for (int it = F.bid; it < nsets * NE; it += F.G) {
        const int set = it / NE, e = it % NE; const bool lat = set < 8; const int b = lat ? set : set - 8;
        const int n = lat ? T : LC, cap = lat ? CAPL : CAPC, row0 = lat ? b * T : RL + b * LC, slot0 = e * SLOTS_E + (lat ? b * CAPL : NB * CAPL + b * CAPC);
        unsigned v[4];
#pragma unroll
        for (int q = 0; q < 4; ++q) { const int idx = 4 * tid + q; v[q] = idx < n ? __builtin_bit_cast(unsigned, F_AFF[(size_t)(row0 + idx) * NE + e]) : 0u; }
        unsigned prefix = 0u; int par = 0;
        for (int bit = 30; bit >= 0; --bit) {
            const unsigned cand = prefix | (1u << bit);
            unsigned c = 0;
#pragma unroll
            for (int q = 0; q < 4; ++q) c += (unsigned)__popcll(__ballot(v[q] >= cand));
            if (lane == 0) cnt[par * 8 + wave] = c;
            __syncthreads();
            unsigned tot = 0;
#pragma unroll
            for (int w = 0; w < 8; ++w) tot += cnt[par * 8 + w];
            if (tot >= (unsigned)cap) prefix = cand;
            par ^= 1;
        }
        unsigned g4 = 0, e4 = 0;
#pragma unroll
        for (int q = 0; q < 4; ++q) { g4 += v[q] > prefix ? 1u : 0u; e4 += v[q] == prefix ? 1u : 0u; }
        unsigned pk = g4 | (e4 << 16), inc = pk;
#pragma unroll
        for (int o = 1; o < 64; o <<= 1) { const unsigned t = (unsigned)shi((int)inc, lane - o); if (lane >= o) inc += t; }
        __syncthreads();
        if (lane == 63) cnt[16 + wave] = inc;
        __syncthreads();
        unsigned base = 0, total = 0;
#pragma unroll
        for (int w = 0; w < 8; ++w) { const unsigned t = cnt[16 + w]; total += t; if (w < wave) base += t; }
        const unsigned excl = base + inc - pk;
        unsigned gpre = excl & 0xffffu, epre = excl >> 16; const unsigned need = (unsigned)cap - (total & 0xffffu);
#pragma unroll
        for (int q = 0; q < 4; ++q) { const int idx = 4 * tid + q;
            if (idx < n) { const bool isg = v[q] > prefix, ise = v[q] == prefix; const bool sel = isg || (ise && epre < need);
                const int slot = slot0 + (int)(gpre + (epre < need ? epre : need));
                if (sel) { F_STOK[slot] = row0 + idx; F_SGATE[slot] = __builtin_bit_cast(float, v[q]); }
                F_INV[(size_t)(row0 + idx) * NE + e] = sel ? slot : -1;
                gpre += isg ? 1u : 0u; epre += ise ? 1u : 0u; } }
        __syncthreads();
    }
}

#ifndef ATT_EXTRA
#define ATT_EXTRA 0
#define ATT_EXTRA_TYPE 0
#endif
#ifndef ATT_LATE_DMA
#define ATT_LATE_DMA 0
#endif
#ifndef ATT_STAGGER
#define ATT_STAGGER 1
#endif
#ifndef ATT_XVAR
#define ATT_XVAR 0
#endif
#ifndef ATT_XSTEPS
#define ATT_XSTEPS 4
#endif
namespace att {
typedef short s16x4 __attribute__((ext_vector_type(4)));
typedef float f32x2_t __attribute__((ext_vector_type(2)));
typedef __bf16 bf16x2_t __attribute__((ext_vector_type(2)));
constexpr int L_K = 0, KBUF = 16384, L_V = 2 * KBUF, VBUF = 8192, L_WS = L_V + 2 * VBUF, L_OST = L_WS + 8 * 256, L_END = L_OST + 8 * 4096;
#define ATT_SBAR() __builtin_amdgcn_sched_barrier(0)
#define ATT_SGB(mask, n) __builtin_amdgcn_sched_group_barrier(mask, n, 0)
__device__ __forceinline__ int crow(int r, int hi) { return (r & 3) + 8 * (r >> 2) + 4 * hi; }
__device__ __forceinline__ unsigned cvtpk(float lo, float hi) { f32x2_t v = {lo, hi}; bf16x2_t b = __builtin_convertvector(v, bf16x2_t); return __builtin_bit_cast(unsigned, b); }
__device__ __forceinline__ int v_st(int k, int c) { const int kk = k; return ((kk >> 3) * 2 + (c >> 5)) * 512 + ((kk & 7) * 32 + (c & 31)) * 2; }
__device__ __forceinline__ int v_rd_base(int lane) { return ((lane & 3) << 3) | (((lane >> 2) & 3) << 6) | (((lane >> 4) & 1) << 5) | (((lane >> 5) & 1) << 8); }
typedef short v4i16_t __attribute__((ext_vector_type(4)));
template <int OFF> __device__ __forceinline__ s16x4 tr_read(int vb) { s16x4 r; asm volatile("ds_read_b64_tr_b16 %0, %1 offset:%2" : "=&v"(r) : "v"(vb), "i"(OFF) : "memory"); return r; }
struct VFrag { s16x4 l0, h0, l1, h1, l2, h2, l3, h3; };
template <int D0> __device__ __forceinline__ void vread(VFrag& f, int vb) {
    f.l0 = tr_read<D0 * 512 + 0 * 2048>(vb); f.h0 = tr_read<D0 * 512 + 0 * 2048 + 1024>(vb); f.l1 = tr_read<D0 * 512 + 1 * 2048>(vb); f.h1 = tr_read<D0 * 512 + 1 * 2048 + 1024>(vb);
    f.l2 = tr_read<D0 * 512 + 2 * 2048>(vb); f.h2 = tr_read<D0 * 512 + 2 * 2048 + 1024>(vb); f.l3 = tr_read<D0 * 512 + 3 * 2048>(vb); f.h3 = tr_read<D0 * 512 + 3 * 2048 + 1024>(vb);
}
__device__ __forceinline__ void pv_mma(f32x16& od, const VFrag& f, bf16x8 pa0, bf16x8 pa1, bf16x8 pa2, bf16x8 pa3) {
#define ATT_PK(L, H) (bf16x8){L[0], L[1], L[2], L[3], H[0], H[1], H[2], H[3]}
    od = __builtin_amdgcn_mfma_f32_32x32x16_bf16(pa0, ATT_PK(f.l0, f.h0), od, 0, 0, 0);
    od = __builtin_amdgcn_mfma_f32_32x32x16_bf16(pa1, ATT_PK(f.l1, f.h1), od, 0, 0, 0);
    od = __builtin_amdgcn_mfma_f32_32x32x16_bf16(pa2, ATT_PK(f.l2, f.h2), od, 0, 0, 0);
    od = __builtin_amdgcn_mfma_f32_32x32x16_bf16(pa3, ATT_PK(f.l3, f.h3), od, 0, 0, 0);
#undef ATT_PK
}
template <int D0> __device__ __forceinline__ void pv_one(f32x16& od, int vb, bf16x8 pa0, bf16x8 pa1, bf16x8 pa2, bf16x8 pa3) {
    VFrag f; vread<D0>(f, vb); asm volatile("s_waitcnt lgkmcnt(0)" ::: "memory"); ATT_SBAR(); pv_mma(od, f, pa0, pa1, pa2, pa3);
}
struct Tensors { const bf16* P; const bf16* QKVM; bf16* O; const float* sink; const float* dnorm; float lam, lam_init; int l; };

constexpr float THR = 8.f;
__device__ __forceinline__ float mx3(float a, float b, float c) { float d; asm("v_max3_f32 %0, %1, %2, %3" : "=v"(d) : "v"(a), "v"(b), "v"(c)); return d; }
__device__ __forceinline__ float mx2(float a, float b) { float d; asm("v_max_f32 %0, %1, %2" : "=v"(d) : "v"(a), "v"(b)); return d; }
__device__ __forceinline__ float rowmax32(const f32x16& p0, const f32x16& p1) {
    const float a0 = mx3(p0[0], p0[1], p0[2]), a1 = mx3(p0[3], p0[4], p0[5]), a2 = mx3(p0[6], p0[7], p0[8]), a3 = mx3(p0[9], p0[10], p0[11]), a4 = mx3(p0[12], p0[13], p0[14]);
    const float b0 = mx3(p1[0], p1[1], p1[2]), b1 = mx3(p1[3], p1[4], p1[5]), b2 = mx3(p1[6], p1[7], p1[8]), b3 = mx3(p1[9], p1[10], p1[11]), b4 = mx3(p1[12], p1[13], p1[14]);
    const float c0 = mx3(a0, a1, a2), c1 = mx3(a3, a4, p0[15]), c2 = mx3(b0, b1, b2), c3 = mx3(b3, b4, p1[15]);
    const float m = mx2(mx3(c0, c1, c2), c3);
    auto rr = __builtin_amdgcn_permlane32_swap(__float_as_uint(m), __float_as_uint(m), false, false);
    return mx2(__uint_as_float(rr[0]), __uint_as_float(rr[1]));
}
__device__ __forceinline__ void partialSM(f32x16& p0, f32x16& p1, const float rm, float& mhat, f32x16& negm, float& alpha) {
    alpha = 1.f;
    if (__builtin_expect(__any(rm > THR), 0)) {
        const float dl = fmaxf(rm, 0.f); mhat += dl;
#pragma unroll
        for (int r = 0; r < 16; ++r) { p0[r] -= dl; p1[r] -= dl; }
#pragma unroll
        for (int r = 0; r < 16; ++r) negm[r] = -mhat;
        asm volatile("" : "+v"(negm));
        alpha = __builtin_amdgcn_exp2f(-dl);
    }
}
__device__ __forceinline__ void finishSM(f32x16& p0, f32x16& p1, const float alpha, float& l_reg, bf16x8& pa0, bf16x8& pa1, bf16x8& pa2, bf16x8& pa3) {
#pragma unroll
    for (int r = 0; r < 16; ++r) { p0[r] = __builtin_amdgcn_exp2f(p0[r]); p1[r] = __builtin_amdgcn_exp2f(p1[r]); }
    float ps = 0.f, pt = 0.f;
#pragma unroll
    for (int r = 0; r < 16; ++r) { ps += p0[r]; pt += p1[r]; }
    l_reg = l_reg * alpha + (ps + pt);
#define ATT_PK8(P, BASE, OUT) do { u32x4 w = {cvtpk(P[BASE + 0], P[BASE + 1]), cvtpk(P[BASE + 2], P[BASE + 3]), cvtpk(P[BASE + 4], P[BASE + 5]), cvtpk(P[BASE + 6], P[BASE + 7])}; OUT = __builtin_bit_cast(bf16x8, w); } while (0)
    ATT_PK8(p0, 0, pa0); ATT_PK8(p0, 8, pa1); ATT_PK8(p1, 0, pa2); ATT_PK8(p1, 8, pa3);
#undef ATT_PK8
}
template <int ROWB> __device__ __forceinline__ int kswz(int row, int cb) { return row * ROWB + (ROWB == 128 ? (cb ^ (((row >> 1) & 7) << 4)) : (cb ^ ((row & 15) << 4))); }
template <int NB, int ROWB, int CB0, int D00> __device__ __forceinline__ void kread(bf16x8 (&kf)[2 * NB], const LAS unsigned char* Kb, int r32, int hi) {
#pragma unroll
    for (int d = 0; d < NB; ++d) { const int cb = CB0 + ((D00 + d) * 16 + hi * 8) * 2;
        kf[2 * d] = *(const LAS bf16x8*)(Kb + kswz<ROWB>(r32, cb)); kf[2 * d + 1] = *(const LAS bf16x8*)(Kb + kswz<ROWB>(32 + r32, cb)); }
}
template <int NB, int D00> __device__ __forceinline__ void kmma(f32x16& p0, f32x16& p1, const bf16x8 (&kf)[2 * NB], const bf16x8* qr, const f32x16& negm) {
#pragma unroll
    for (int d = 0; d < NB; ++d) {
        if (D00 + d == 0) { p0 = __builtin_amdgcn_mfma_f32_32x32x16_bf16(kf[0], qr[0], negm, 0, 0, 0); p1 = __builtin_amdgcn_mfma_f32_32x32x16_bf16(kf[1], qr[0], negm, 0, 0, 0); }
        else { p0 = __builtin_amdgcn_mfma_f32_32x32x16_bf16(kf[2 * d], qr[D00 + d], p0, 0, 0, 0); p1 = __builtin_amdgcn_mfma_f32_32x32x16_bf16(kf[2 * d + 1], qr[D00 + d], p1, 0, 0, 0); } }
}
template <int NKS, int ROWB, int CB0> __device__ __forceinline__ void qkt2(f32x16& p0, f32x16& p1, const LAS unsigned char* Kb, const bf16x8* qr, const f32x16& negm, int r32, int hi) {
    constexpr int N1 = NKS > 4 ? 3 : NKS, N2 = NKS - N1;
    bf16x8 ka[2 * N1]; kread<N1, ROWB, CB0, 0>(ka, Kb, r32, hi);
    if constexpr (N2 > 0) { bf16x8 kb[2 * N2]; kread<N2, ROWB, CB0, N1>(kb, Kb, r32, hi);
        kmma<N1, 0>(p0, p1, ka, qr, negm); kmma<N2, N1>(p0, p1, kb, qr, negm); }
    else kmma<N1, 0>(p0, p1, ka, qr, negm);
}

template <int TYPE> struct Ring { static constexpr int KSLOT = TYPE == 1 ? 16384 : 8192, VSLOT = 8192, L_K = 0, L_V = 3 * KSLOT, L_WS = L_V + 4 * VSLOT, L_OST = L_WS + 2048; };
template <int TYPE, int CB0> __device__ __forceinline__ void flash_pass(const Tensors& Tn, LAS unsigned char* lds, const int tid, const int b, const int h, const bool lat, const int q0, const int wrow, const int var, const bf16x8* qr,
                                                                        f32x16 (&o)[2], float& l_out, float& m_out) {
    constexpr int NKS = TYPE == 0 ? 4 : (TYPE == 1 ? 6 : 2);
    constexpr int ROWB = TYPE == 1 ? 256 : 128;
    typedef Ring<TYPE> RG;
    const int lane = tid & 63, wid = __builtin_amdgcn_readfirstlane(tid >> 6), r32 = lane & 31, hi = lane >> 5;
    LAS float* al_l = (LAS float*)(lds + RG::L_WS) + wid * 64;
    const int kvh = h >> 2;
    const bf16* Kp = TYPE == 0 ? Tn.P + P_AK + kvh * 64 : (TYPE == 1 ? Tn.QKVM + 512 + h * 128 : Tn.P + P_DK + h * 64);
    const bf16* Vp = TYPE == 0 ? Tn.P + P_AV + kvh * 64 : (TYPE == 1 ? Tn.QKVM + 512 + h * 128 + 64 : Tn.P + P_DV + h * 64);
    constexpr int KPITCH = TYPE == 1 ? LDM : LDP;
    int kl0 = 0, nloc = 0;
    if (lat) { if (TYPE == 0) { kl0 = q0 - 128 < 0 ? 0 : q0 - 128; const int kl1 = q0 + 64 + 128 > T ? T : q0 + 64 + 128; nloc = (kl1 - kl0) >> 6; } else { kl0 = 0; nloc = T / 64; } }
    const int NT = 4 + nloc;
    const int crow0 = RL + b * LC, lrow0 = b * T + kl0;
#define ATT_TROW(i) ((var & 64) ? crow0 : ((i) < 4 ? crow0 + 64 * (i) : lrow0 + 64 * ((i) - 4)))
    const bf16* ksrc0; const bf16* ksrc1 = nullptr;
    if (TYPE != 1) { const int row = 8 * wid + (lane >> 3), c = (lane & 7) ^ ((row >> 1) & 7); ksrc0 = Kp + (size_t)row * KPITCH + c * 8; }
    else {
        { const int row = 8 * wid + (lane >> 4), c = (lane & 15) ^ (row & 15); ksrc0 = c < 8 ? Kp + (size_t)row * LDM + c * 8 : (c < 12 ? Tn.P + (size_t)row * LDP + P_KR + (c - 8) * 8 : Kp + (size_t)row * LDM); }
        { const int row = 8 * wid + 4 + (lane >> 4), c = (lane & 15) ^ (row & 15); ksrc1 = c < 8 ? Kp + (size_t)row * LDM + c * 8 : (c < 12 ? Tn.P + (size_t)row * LDP + P_KR + (c - 8) * 8 : Kp + (size_t)row * LDM); }
    }
    const bool k0p = TYPE == 1 && (((lane & 15) ^ ((8 * wid + (lane >> 4)) & 15)) >= 8) && (((lane & 15) ^ ((8 * wid + (lane >> 4)) & 15)) < 12);
    const bool k1p = TYPE == 1 && (((lane & 15) ^ ((8 * wid + 4 + (lane >> 4)) & 15)) >= 8) && (((lane & 15) ^ ((8 * wid + 4 + (lane >> 4)) & 15)) < 12);
    const bf16* vsrc = Vp + (size_t)(8 * wid + ((lane & 31) >> 2)) * KPITCH + (lane >> 5) * 32 + (lane & 3) * 8;
#define ATT_DMA_K(i, slot) do { if (var & 8) break; const int g_ = ATT_TROW((i) < NT ? (i) : NT - 1); \
        __builtin_amdgcn_global_load_lds((const unsigned*)(ksrc0 + (size_t)g_ * (k0p ? LDP : KPITCH)), (LAS unsigned*)(lds + RG::L_K + (slot) * RG::KSLOT + wid * (ROWB * 8)), 16, 0, 0); \
        if (TYPE == 1) __builtin_amdgcn_global_load_lds((const unsigned*)(ksrc1 + (size_t)g_ * (k1p ? LDP : KPITCH)), (LAS unsigned*)(lds + RG::L_K + (slot) * RG::KSLOT + wid * (ROWB * 8) + 1024), 16, 0, 0); } while (0)
#define ATT_DMA_V(i, slot) do { if (var & 8) break; const int g_ = ATT_TROW((i) < NT ? (i) : NT - 1); \
        __builtin_amdgcn_global_load_lds((const unsigned*)(vsrc + (size_t)g_ * KPITCH), (LAS unsigned*)(lds + RG::L_V + (slot) * RG::VSLOT + wid * 1024), 16, 0, 0); } while (0)
#define ATT_WAITBAR() do { if (var & 16) break; if (TYPE == 1) asm volatile("s_waitcnt vmcnt(3)" ::: "memory"); else asm volatile("s_waitcnt vmcnt(2)" ::: "memory"); __builtin_amdgcn_s_barrier(); asm volatile("" ::: "memory"); } while (0)
#define ATT_RESC(a) do { if (__any((a) < 1.f)) { if (hi == 0) al_l[r32] = (a); asm volatile("s_waitcnt lgkmcnt(0)" ::: "memory"); \
        _Pragma("unroll") for (int r = 0; r < 16; ++r) { const float f_ = al_l[crow(r, hi)]; o[0][r] *= f_; o[1][r] *= f_; } } } while (0)
    const int qpos = q0 + wrow + r32;
#define ATT_MASK(P0, P1, i) do { if (TYPE == 0 && (i) >= 4 && (kl0 + 64 * ((i) - 4) - q0 <= -128 || kl0 + 64 * ((i) - 4) - q0 >= 128)) {     \
        const int kt0_ = kl0 + 64 * ((i) - 4) - qpos, lo_ = -128, hi_ = 128; \
        _Pragma("unroll") for (int r = 0; r < 16; ++r) { const int k0_ = kt0_ + crow(r, hi); P0[r] = (k0_ < lo_ || k0_ > hi_) ? -1e30f : P0[r]; P1[r] = (k0_ + 32 < lo_ || k0_ + 32 > hi_) ? -1e30f : P1[r]; } } } while (0)
    const int vb0 = (int)(uintptr_t)(lds + RG::L_V) + v_rd_base(lane);
    const LAS unsigned char* Kr = lds + RG::L_K;
    float mhat = 0.f, l_reg = 0.f; f32x16 negm = f32x16{};
    int sp = 2, sc = 0;
#define ATT_ROT() do { const int t_ = sp; sp = sc; sc = (sc == 2 ? 0 : sc + 1); (void)t_; } while (0)
#ifndef ATT_LAGSEL
#define ATT_LAGSEL 0
#endif
    const bool lag = ATT_STAGGER && (ATT_LAGSEL == 0 ? wid >= 4 : (ATT_LAGSEL == 1 ? (wid & 1) != 0 : ((wid >> 1) & 1) != 0));
    f32x16 p0 = f32x16{}, p1 = f32x16{}; bf16x8 pa0 = bf16x8{}, pa1 = bf16x8{}, pa2 = bf16x8{}, pa3 = bf16x8{};
#define ATT_SOFT(t, FIRST) do { ATT_MASK(p0, p1, t); float rm_ = rowmax32(p0, p1); float alpha_ = 1.f; \
        if (FIRST) { mhat = rm_; _Pragma("unroll") for (int r = 0; r < 16; ++r) { p0[r] -= rm_; p1[r] -= rm_; negm[r] = -rm_; } asm volatile("" : "+v"(negm)); } \
        else if (__builtin_expect(__any(rm_ > THR), 0)) { const float dl = fmaxf(rm_, 0.f); mhat += dl; \
            _Pragma("unroll") for (int r = 0; r < 16; ++r) { p0[r] -= dl; p1[r] -= dl; negm[r] = -mhat; } asm volatile("" : "+v"(negm)); \
            alpha_ = __builtin_amdgcn_exp2f(-dl); ATT_RESC(alpha_); } \
        finishSM(p0, p1, alpha_, l_reg, pa0, pa1, pa2, pa3); } while (0)
#define ATT_STEP(t) do { \
        if (lag || !ATT_LATE_DMA) { ATT_DMA_K((t) + 2, sp); ATT_DMA_V((t) + 1, ((t) + 1) & 3); } \
        { bf16x8 kf_[2 * NKS]; att::VFrag va_, vb_; const int vbt_ = vb0 + (((t) - 1) & 3) * RG::VSLOT; \
          kread<NKS, ROWB, CB0, 0>(kf_, Kr + sc * RG::KSLOT, r32, hi); vread<0>(va_, vbt_); \
          asm volatile("s_waitcnt lgkmcnt(0)" ::: "memory"); ATT_SBAR(); \
          kmma<NKS, 0>(p0, p1, kf_, qr, negm); ATT_SBAR(); \
          vread<1>(vb_, vbt_); ATT_SBAR(); \
          pv_mma(o[0], va_, pa0, pa1, pa2, pa3); \
          asm volatile("s_waitcnt lgkmcnt(0)" ::: "memory"); ATT_SBAR(); \
          pv_mma(o[1], vb_, pa0, pa1, pa2, pa3); } \
        asm volatile("" : "+v"(p0), "+v"(p1), "+v"(o[0]), "+v"(o[1])); \
        if (lag) ATT_WAITBAR(); \
        if (!lag && ATT_LATE_DMA) { ATT_DMA_K((t) + 2, sp); ATT_DMA_V((t) + 1, ((t) + 1) & 3); }     \
        ATT_SOFT(t, false); \
        asm volatile("" : "+v"(pa0), "+v"(pa1), "+v"(pa2), "+v"(pa3), "+v"(l_reg)); \
        if (!lag) ATT_WAITBAR(); ATT_ROT(); } while (0)
    ATT_DMA_K(0, 0); ATT_DMA_V(0, 0); ATT_DMA_K(1, 1);
    asm volatile("s_waitcnt vmcnt(0)" ::: "memory"); __builtin_amdgcn_s_barrier(); asm volatile("" ::: "memory");
    { ATT_DMA_K(2, 2); ATT_DMA_V(1, 1);
      qkt2<NKS, ROWB, CB0>(p0, p1, Kr, qr, negm, r32, hi);
      asm volatile("" : "+v"(p0), "+v"(p1));
      if (lag) ATT_WAITBAR();
      ATT_SOFT(0, true);
      asm volatile("" : "+v"(pa0), "+v"(pa1), "+v"(pa2), "+v"(pa3), "+v"(l_reg));
      if (!lag) ATT_WAITBAR(); ATT_ROT(); }
    for (int j = 1; j < ((var & 32) ? ATT_XSTEPS : NT); ++j) ATT_STEP(j);
    pv_one<0>(o[0], vb0 + ((NT - 1) & 3) * RG::VSLOT, pa0, pa1, pa2, pa3); pv_one<1>(o[1], vb0 + ((NT - 1) & 3) * RG::VSLOT, pa0, pa1, pa2, pa3);
    asm volatile("s_waitcnt vmcnt(0)" ::: "memory"); __builtin_amdgcn_s_barrier(); asm volatile("" ::: "memory");
#undef ATT_SOFT
    { auto rr = __builtin_amdgcn_permlane32_swap(__float_as_uint(l_reg), __float_as_uint(l_reg), false, false); l_reg = __uint_as_float(rr[0]) + __uint_as_float(rr[1]); }
    l_out = l_reg; m_out = mhat;
#undef ATT_TROW
#undef ATT_DMA_K
#undef ATT_DMA_V
#undef ATT_WAITBAR
#undef ATT_RESC
#undef ATT_MASK
#undef ATT_ROT
#undef ATT_STEP
}

template <int TYPE> __device__ __forceinline__ void unit(const Tensors& Tn, LAS unsigned char* lds, const int tid, const int b, const int h, const bool lat, const int q0, const int var) {
    constexpr int NKS = TYPE == 0 ? 4 : (TYPE == 1 ? 6 : 2);
    const int lane = tid & 63, wid = __builtin_amdgcn_readfirstlane(tid >> 6), r32 = lane & 31, hi = lane >> 5;
    typedef Ring<TYPE> RG;
    LAS float* wsf = (LAS float*)(lds + RG::L_WS) + wid * 64;
    const int hw = TYPE == 0 ? h * 4 + (wid & 3) : h, wrow = TYPE == 0 ? (wid >> 2) * 32 : wid * 32;
    const int qrow0 = (lat ? b * T + q0 : RL + b * LC + q0) + wrow;
    bf16x8 qr[TYPE == 2 ? 4 : NKS];
    { const bf16* qp = TYPE == 0 ? Tn.P + (size_t)(qrow0 + r32) * LDP + P_AQ + hw * 64 : (TYPE == 1 ? Tn.QKVM + (size_t)(qrow0 + r32) * LDM + h * 96 : Tn.P + (size_t)(qrow0 + r32) * LDP + P_DQ + h * 64);
#pragma unroll
      for (int d0 = 0; d0 < (TYPE == 2 ? 4 : NKS); ++d0) qr[d0] = *(const bf16x8*)(qp + d0 * 16 + hi * 8); }
    f32x16 oA[2] = {f32x16{}, f32x16{}}; float l0, m0;
    flash_pass<TYPE, 0>(Tn, lds, tid, b, hw, lat, q0, wrow, var, qr, oA, l0, m0);
    f32x16 oB[2] = {f32x16{}, f32x16{}}; float l1 = 1.f, m1 = 0.f;
    LAS float* stash = (LAS float*)(lds + RG::L_OST + wid * 8192);
    if (TYPE == 2) {
#pragma unroll
        for (int r = 0; r < 16; ++r) { stash[r * 64 + lane] = oA[0][r]; stash[(16 + r) * 64 + lane] = oA[1][r]; }
        flash_pass<TYPE, 64>(Tn, lds, tid, b, h, lat, q0, wrow, var, qr + 2, oB, l1, m1);
#pragma unroll
        for (int r = 0; r < 16; ++r) { oA[0][r] = stash[r * 64 + lane]; oA[1][r] = stash[(16 + r) * 64 + lane]; }
        asm volatile("s_waitcnt lgkmcnt(0)" ::: "memory");
    }
    if (TYPE == 0) l0 += __builtin_amdgcn_exp2f(Tn.sink[Tn.l * 8 + hw] * 1.4426950408889634f - m0);
    if (hi == 0) { wsf[r32] = l0; if (TYPE == 2) wsf[32 + r32] = l1; }
    asm volatile("s_waitcnt lgkmcnt(0)" ::: "memory");
    LAS bf16* stg = (LAS bf16*)(lds + RG::L_OST + wid * (TYPE == 2 ? 8192 : 4096));
    if (TYPE != 2) {
#pragma unroll
        for (int r = 0; r < 16; ++r) { const float rl = __builtin_amdgcn_rcpf(wsf[crow(r, hi)]); const int orow = crow(r, hi);
            stg[orow * 64 + r32] = (bf16)f2bf(oA[0][r] * rl); stg[orow * 64 + 32 + r32] = (bf16)f2bf(oA[1][r] * rl); }
    } else {
        const float g0 = Tn.dnorm[Tn.l * 64 + r32], g1 = Tn.dnorm[Tn.l * 64 + 32 + r32];
#pragma unroll
        for (int r = 0; r < 16; ++r) { const float rl0 = __builtin_amdgcn_rcpf(wsf[crow(r, hi)]), rl1 = Tn.lam * __builtin_amdgcn_rcpf(wsf[32 + crow(r, hi)]);
            const float a0 = oA[0][r] * rl0 - oB[0][r] * rl1, a1 = oA[1][r] * rl0 - oB[1][r] * rl1;
            float ss = a0 * a0 + a1 * a1;
#pragma unroll
            for (int o_ = 1; o_ < 32; o_ <<= 1) ss += shx(ss, o_, lane);
            const float rs = (1.f - Tn.lam_init) * __builtin_amdgcn_rsqf(ss * (1.f / 64.f) + EPS); const int orow = crow(r, hi);
            stg[orow * 64 + r32] = (bf16)f2bf(a0 * rs * g0); stg[orow * 64 + 32 + r32] = (bf16)f2bf(a1 * rs * g1); }
    }
    asm volatile("s_waitcnt lgkmcnt(0)" ::: "memory");
    { bf16* Ow = Tn.O + (size_t)qrow0 * D + (TYPE == 0 ? hw * 64 : (TYPE == 1 ? 512 + h * 64 : 768 + h * 64));
#pragma unroll
      for (int i = 0; i < 4; ++i) { const int row = i * 8 + (lane >> 3), ch = lane & 7; st16(Ow + (size_t)row * D + ch * 8, *(const LAS u32x4*)(stg + row * 64 + ch * 8)); } }
    asm volatile("s_waitcnt lgkmcnt(0)" ::: "memory"); __builtin_amdgcn_s_barrier(); asm volatile("" ::: "memory");
}
}

__device__ __forceinline__ void attn_phase(Frame& F, const int l, const bool need_ctx) {
    att::Tensors Tn; Tn.P = F_P; Tn.QKVM = F_QKVM; Tn.O = F_O; Tn.sink = F_sink; Tn.dnorm = F_diff_norm; Tn.l = l;
    { float s1 = 0.f, s2 = 0.f;
      if (F.lane < 32) { s1 = F_lq1[l * 32 + F.lane] * F_lk1[l * 32 + F.lane]; s2 = F_lq2[l * 32 + F.lane] * F_lk2[l * 32 + F.lane]; }
      s1 = wave_sum(s1, F.lane); s2 = wave_sum(s2, F.lane);
      int ll_ = l; asm volatile("" : "+s"(ll_));
      const float li_ = ll_ == 0 ? 0.200000000f : (ll_ == 1 ? 0.355509068f : (ll_ == 2 ? 0.470713018f : 0.556058204f));
      const float lm_ = __expf(s1) - __expf(s2) + li_;
      Tn.lam_init = li_; Tn.lam = __builtin_bit_cast(float, __builtin_amdgcn_readfirstlane(__builtin_bit_cast(int, lm_))); }
    const int b = F.bid & 7, j = F.bid >> 3;
    if (F.G != 256) return;
    const int nu = (need_ctx && j < 16) ? 5 : 4;
    for (int u = 0; u < nu + ATT_EXTRA; ++u) {
        int type, h, q0; bool lat = true; const int var = u >= nu ? ATT_XVAR : 0;
        if (u >= nu) { type = ATT_EXTRA_TYPE; h = ATT_EXTRA_TYPE == 0 ? ((j >> 3) & 1) : (j >> 3); q0 = ATT_EXTRA_TYPE == 0 ? j * 64 : (j & 7) * 256; Tn.O = F_ACT; }
        else if (u == 0) { type = 2; h = j >> 3; q0 = (j & 7) * 256; }
        else if (u == 1) { type = 1; h = j >> 3; q0 = (j & 7) * 256; }
        else if (u < 4) { type = 0; h = u - 2; q0 = j * 64; }
        else { lat = false; q0 = 0; if (j < 8) { type = 0; h = j >> 2; q0 = (j & 3) * 64; } else if (j < 12) { type = 1; h = j - 8; } else { type = 2; h = j - 12; } }
        int t_ = F.tid; asm volatile("" : "+v"(t_));
        if (type == 0) att::unit<0>(Tn, F.lds, t_, b, h, lat, q0, var);
        else if (type == 1) att::unit<1>(Tn, F.lds, t_, b, h, lat, q0, var);
        else att::unit<2>(Tn, F.lds, t_, b, h, lat, q0, var);
    }
}

enum { PH_P0 = 0, PH_L0 = 1, PH_PER_LAYER = 9, PH_FINAL = PH_L0 + DEPTH * PH_PER_LAYER, NPH = PH_FINAL + 1 };
enum { SP_NORM1 = 0, SP_INPROJ = 1, SP_UP = 2, SP_ATTN = 3, SP_OUT = 4, SP_NORM2 = 5, SP_TOPK = 6, SP_MOE1 = 7, SP_MOE2 = 8 };

#ifndef REPS_INIT
#define REPS_INIT {1, 1, 1, 1, 1, 1, 1, 1, 1}
#endif
#ifndef REP_P0
#define REP_P0 1
#endif
#ifndef REP_FINAL
#define REP_FINAL 1
#endif
#ifndef KROT_ON
#define KROT_ON 0
#endif
#ifndef PROBE_NOMMA
#define PROBE_NOMMA 0
#endif
#ifndef PHMASK
#define PHMASK 0x3ff
#endif
#define PHON(b) ((PHMASK >> (b)) & 1)
#define REPSEL(s) ((s) == 0 ? reps_sp[0] : (s) == 1 ? reps_sp[1] : (s) == 2 ? reps_sp[2] : (s) == 3 ? reps_sp[3] : (s) == 4 ? reps_sp[4] : (s) == 5 ? reps_sp[5] : (s) == 6 ? reps_sp[6] : (s) == 7 ? reps_sp[7] : reps_sp[8])
__global__ void __launch_bounds__(NWAVES * 64, 2) mk(Args args) {
    extern __shared__ __attribute__((aligned(16))) unsigned char lds_raw[];
    Frame F;
    F.lds = (LAS unsigned char*)lds_raw;
    F.tid = threadIdx.x; F.lane = F.tid & 63; F.wave = __builtin_amdgcn_readfirstlane(F.tid >> 6); F.bid = blockIdx.x; F.G = gridDim.x;
    const int wave_s = F.wave;
    F.in = (const float* const*)args.in; F.out = (GAS float*)args.out; F.ws = (GAS unsigned char*)args.ws;
    volatile LAS unsigned* MISC = (volatile LAS unsigned*)(F.lds + MISC_OFF);
    for (int u = F.tid; u < (LDS_BYTES - LDSCTL_OFF) / 4; u += NWAVES * 64) ((LAS unsigned*)(F.lds + LDSCTL_OFF))[u] = 0u;
    __syncthreads();
    XcdBarrier bar = xcd_barrier_post((unsigned*)(args.ws + WS_CTL) + CW_BAR + args.li * XCD_BAR_WORDS, MISC + 8);
    const int gx = F.bid & 7, gj = F.bid >> 3, gpx = F.G >> 3, krot = KROT_ON ? (gj & 7) + 3 * (gj >> 3) : 0;
    constexpr int reps_sp[9] = REPS_INIT;
    for (int ph = args.ph_lo; ph < args.ph_hi; ++ph) {
      const int nrep = ph == PH_P0 ? REP_P0 : (ph == PH_FINAL ? REP_FINAL : (REPSEL((ph - PH_L0) % PH_PER_LAYER)));
      for (int rep = 0; rep < nrep; ++rep) {
        const float keep = rep + 1 == nrep ? 1.f : 0.f;
        { unsigned char* w_ = args.ws; asm volatile("" : "+s"(w_)); F.ws = (GAS unsigned char*)w_; int z_ = 0; asm volatile("" : "+s"(z_)); F.in = (const float* const*)args.in + z_;
          int l_; asm volatile("v_mbcnt_lo_u32_b32 %0, -1, 0\n\tv_mbcnt_hi_u32_b32 %0, -1, %0" : "=v"(l_));
          int w_s = wave_s; asm volatile("" : "+s"(w_s)); F.lane = l_; F.wave = w_s; F.tid = w_s * 64 + l_; }
        if (ph == PH_P0) { if (PHON(9)) p0_phase(F); }
        else if (ph == PH_FINAL) { if (PHON(0)) norm_phase(F, DEPTH, 2, RL, keep); }
        else {
            const int l = (ph - PH_L0) / PH_PER_LAYER, sp = (ph - PH_L0) % PH_PER_LAYER;
            const bool need_ctx = l < DEPTH - 1; const int rows_mix = need_ctx ? R : RL;
            const bf16* wl = F_WB + (size_t)l * W_LAYER;
            if (sp == SP_NORM1) { if (PHON(0)) norm_phase(F, l, 0, R, keep); }
            else if (sp == SP_INPROJ && PHON(1)) {
                pg8::Gemm g{F_ACT, wl + W_IN, nullptr, 0, D, D}; OrderRows S{gx, gj, gpx, R / 288 / 8, LDP / 256, 0, krot, 288};
                EpiInProj<3, 3> E{F_P, F_ROPE, F_RSQ};
                pg8::gemm_phase288<false>(F.lds, F.tid, g, S, E);
                { const int nbusy = 8;
                  if (BG_PREP && l + 1 < DEPTH && rep + 1 == nrep && gj >= nbusy) prep_layer(F, l + 1, ((gx * (gpx - nbusy) + (gj - nbusy)) * NWAVES) + F.wave, 8 * (gpx - nbusy) * NWAVES); }
            } else if (sp == SP_UP && PHON(2)) {
                pg8::Gemm g{F_P + P_CQ, wl + W_UP, nullptr, 0, LDP, UPK}; OrderUp S{{gx, gj, gpx, R / 288 / 8, 4, 0, krot, 288}};
                EpiUp<3, 3> E{F_QKVM, F_ROPE, F_RSQ};
                pg8::gemm_phase288<false>(F.lds, F.tid, g, S, E);
            } else if (sp == SP_ATTN) { if (PHON(3)) attn_phase(F, l, need_ctx);
            } else if (sp == SP_OUT && PHON(4)) {
                pg8::Gemm g{F_O, wl + W_OUT, nullptr, 0, D, D};
                if (need_ctx) { OrderRows S{gx, gj, gpx, R / 288 / 8, 4, 0, krot, 288}; EpiOut<3, 3> E{(XT*)F_XB, F_MOD + (size_t)l * 9 * 6144, keep}; pg8::gemm_phase288<false>(F.lds, F.tid, g, S, E); }
                else { OrderRows S{gx, gj, gpx, RL / 256 / 8, 4, 0, krot, 256}; EpiOut<4> E{(XT*)F_XB, F_MOD + (size_t)l * 9 * 6144, keep}; pg8::gemm_phase<false, 4>(F.lds, F.tid, g, S, E); }
            } else if (sp == SP_NORM2) { if (PHON(5)) norm_phase(F, l, 1, rows_mix, keep); }
            else if (sp == SP_TOPK) { if (PHON(6)) topk_phase(F, need_ctx ? 16 : 8);
#if MOE_PF
                { unsigned acc = 0;
                  for (int e2 = 0; e2 < 2; ++e2) { const int e = 2 * gx + e2;
                    const u32x4* p1 = (const u32x4*)(wl + W_GU + (size_t)e * 1024 * 1024); const u32x4* p2 = (const u32x4*)(wl + W_DN + (size_t)e * 1024 * 512);
#pragma unroll 4
                    for (int i = gj * 512 + F.tid; i < 131072; i += gpx * 512) acc ^= p1[i].x;
#pragma unroll 4
                    for (int i = gj * 512 + F.tid; i < 65536; i += gpx * 512) acc ^= p2[i].x; }
                  asm volatile("" :: "v"(acc)); }
#endif
            }
            else if (sp == SP_MOE1 && PHON(7)) {
                pg8::Gemm g{F_ACT, wl + W_GU, F_STOK, (size_t)1024 * 1024, D, D};
                if (need_ctx) { OrderMoe S{gx, gj, gpx, 8, 4, krot, 288}; EpiGU<3, 3> E{F_HID}; pg8::gemm_phase288<true>(F.lds, F.tid, g, S, E); }
                else { OrderMoe S{gx, gj, gpx, 8, 4, krot, 256}; EpiGU<4> E{F_HID}; pg8::gemm_phase<true, 4>(F.lds, F.tid, g, S, E); }
            } else if (sp == SP_MOE2 && PHON(8)) {
                pg8::Gemm g{F_HID, wl + W_DN, nullptr, (size_t)1024 * 512, DE, DE};
                if (need_ctx) { OrderMoe S{gx, gj, gpx, 8, 4, krot, 288}; EpiDown<3, 3> E{F_Y, F_SGATE}; pg8::gemm_phase288<false>(F.lds, F.tid, g, S, E); }
                else { OrderMoe S{gx, gj, gpx, 8, 4, krot, 256}; EpiDown<4> E{F_Y, F_SGATE}; pg8::gemm_phase<false, 4>(F.lds, F.tid, g, S, E); }
            }
        }
        if (ph + 1 < args.ph_hi || rep + 1 < nrep) { xcd_barrier(bar, F.tid);
#ifdef EXTRA_BAR
            xcd_barrier(bar, F.tid);
#endif
        }
      }
    }
}

extern "C" void kernel_launch(void* const* d_in, const int* in_sizes, int n_in, void* d_out, int out_size, void* d_ws, size_t ws_size, hipStream_t stream) {
    static int grid = 0;
    if (grid == 0) {
        if (n_in != 25 || ws_size < WS_END || out_size != RL * D) { fprintf(stderr, "kernel_launch: unexpected shapes (n_in %d, ws %zu < %zu, out %d)\n", n_in, ws_size, (size_t)WS_END, out_size); grid = -1; return; }
        int dev = 0, cus = 0, per_cu = 0;
        if (hipGetDevice(&dev) != hipSuccess || hipDeviceGetAttribute(&cus, hipDeviceAttributeMultiprocessorCount, dev) != hipSuccess) { grid = -1; return; }
        if (hipFuncSetAttribute((const void*)mk, hipFuncAttributeMaxDynamicSharedMemorySize, LDS_BYTES) != hipSuccess) { fprintf(stderr, "kernel_launch: hipFuncSetAttribute failed\n"); grid = -1; return; }
        if (hipOccupancyMaxActiveBlocksPerMultiprocessor(&per_cu, (const void*)mk, NWAVES * 64, LDS_BYTES) != hipSuccess || per_cu < 1) { fprintf(stderr, "kernel_launch: occupancy query says %d\n", per_cu); }
        (void)hipGetLastError();
        grid = cus;
        if (grid % 8 != 0) { fprintf(stderr, "kernel_launch: %d CUs, expected a multiple of 8\n", grid); grid = -1; return; }
    }
    if (grid < 0) return;
    (void)hipMemsetAsync((char*)d_ws + WS_CTL, 0, CTL_ZERO_BYTES, stream);
    Args a; memset(&a, 0, sizeof a);
    for (int i = 0; i < 25; ++i) a.in[i] = (const float*)d_in[i];
    a.out = (float*)d_out; a.ws = (unsigned char*)d_ws;
    a.ph_lo = 0; a.ph_hi = NPH; a.li = 0;
    hipLaunchKernelGGL(mk, dim3(grid), dim3(NWAVES * 64), LDS_BYTES, stream, a);
}
```

```cpp
#include <hip/hip_runtime.h>
#include <stdint.h>
#include <string.h>
#include <stdio.h>

typedef unsigned short bf16;
typedef unsigned u32x4 __attribute__((ext_vector_type(4)));
typedef unsigned u32x2 __attribute__((ext_vector_type(2)));
typedef float f32x4 __attribute__((ext_vector_type(4)));
typedef float f32x16 __attribute__((ext_vector_type(16)));
typedef short bf16x8 __attribute__((ext_vector_type(8)));
#define LAS __attribute__((address_space(3)))
#define GAS __attribute__((address_space(1)))

constexpr int D = 1024, NB = 8, T = 2048, LC = 256, DEPTH = 4;
constexpr int RL = NB * T, RC = NB * LC, R = RL + RC;
constexpr int INW = 1952, LDP = 2048;
constexpr int NE = 16, DE = 512;
constexpr int CAPL = 256, CAPC = 32;
constexpr int SLOTS_E = NB * CAPL + NB * CAPC;
constexpr int SLOTS = NE * SLOTS_E;
constexpr float EPS = 1e-6f;
constexpr int P_AQ = 0, P_AK = 512, P_AV = 640, P_CQ = 768, P_CKV = 1024, P_KR = 1152, P_DQ = 1184, P_DK = 1440, P_DV = 1696;
constexpr int LDM = 1024;
constexpr int UPK = 384;

constexpr size_t MiB = 1u << 20;
constexpr size_t WS_CTL = 0;
constexpr size_t CTL_ZERO_BYTES = 256 * 1024;
constexpr size_t WS_MOD = 1 * MiB;
constexpr size_t WS_ROPE = 2 * MiB;
constexpr size_t WS_RSQ = 3 * MiB;
constexpr size_t WS_AFF = 4 * MiB;
constexpr size_t WS_INV = 6 * MiB;
constexpr size_t WS_STOK = 8 * MiB;
constexpr size_t WS_SGATE = 9 * MiB;
#ifndef X_BF16
#define X_BF16 1
#endif
constexpr size_t WS_X = 10 * MiB;
constexpr size_t WS_ACT = 82 * MiB;
constexpr size_t WS_P = 118 * MiB;
constexpr size_t WS_Y = WS_P;
constexpr size_t WS_QKVM = 190 * MiB;
constexpr size_t WS_O = 226 * MiB;
constexpr size_t WS_HID = WS_O;
constexpr size_t WS_W = 262 * MiB;
constexpr size_t W_IN = 0;
constexpr size_t W_UP = W_IN + (size_t)LDP * D;
constexpr size_t W_OUT = W_UP + (size_t)1024 * UPK;
constexpr size_t W_GU = W_OUT + (size_t)D * D;
constexpr size_t W_DN = W_GU + (size_t)NE * 1024 * 1024;
constexpr size_t W_LAYER = W_DN + (size_t)NE * 1024 * 512;
constexpr size_t WS_END = WS_W + (size_t)DEPTH * W_LAYER * 2;

__device__ __forceinline__ unsigned f2bf(float f) { unsigned u = __builtin_bit_cast(unsigned, f); return (u + 0x7fffu + ((u >> 16) & 1u)) >> 16; }
__device__ __forceinline__ float bf2f(unsigned h) { return __builtin_bit_cast(float, h << 16); }
#ifndef WT_STORES
#define WT_STORES 0
#endif
__device__ __forceinline__ void st16(void* p, const u32x4 v) {
#if WT_STORES
    asm volatile("global_store_dwordx4 %0, %1, off sc1\n\ts_nop 1" :: "v"(p), "v"(v) : "memory");
#else
    *(u32x4*)p = v;
#endif
}
typedef float f32x2c_t __attribute__((ext_vector_type(2)));
typedef __bf16 bf16x2c_t __attribute__((ext_vector_type(2)));
#ifndef HW_CVT
#define HW_CVT 1
#endif
__device__ __forceinline__ unsigned pk2(float lo, float hi) {
#if HW_CVT
    f32x2c_t v = {lo, hi}; bf16x2c_t b = __builtin_convertvector(v, bf16x2c_t); return __builtin_bit_cast(unsigned, b);
#else
    return f2bf(lo) | (f2bf(hi) << 16);
#endif
}
__device__ __forceinline__ float shx(float v, int o, int lane) { return __builtin_bit_cast(float, __builtin_amdgcn_ds_bpermute((lane ^ o) << 2, __builtin_bit_cast(int, v))); }
__device__ __forceinline__ int shi(int v, int src) { return __builtin_amdgcn_ds_bpermute(src << 2, v); }
__device__ __forceinline__ float wave_sum(float v, int lane) {
#pragma unroll
    for (int o = 1; o < 64; o <<= 1) v += shx(v, o, lane);
    return v;
}
__device__ __forceinline__ float siluf(float v) { return v / (1.f + __expf(-v)); }
#define LDS_WAIT() asm volatile("s_waitcnt lgkmcnt(0)" ::: "memory")
#define VM_WAIT() asm volatile("s_waitcnt vmcnt(0)" ::: "memory")

struct Args {
    const float* in[25]; float* out; unsigned char* ws; int ph_lo, ph_hi, li, pad;
};

#ifndef PROBE_HOT
#define PROBE_HOT 0
#endif
#ifndef PROBE_NOEPI
#define PROBE_NOEPI 0
#endif
#ifndef PROBE_NOLDS
#define PROBE_NOLDS 0
#endif
#ifndef GEMM_AUX
#define GEMM_AUX 0
#endif
#ifndef GEMM_PRIO
#define GEMM_PRIO 1
#endif
#ifndef PROBE9
#define PROBE9 0
#endif
#ifndef GEMM_DMA_FIRST
#define GEMM_DMA_FIRST 0
#endif
#ifndef GEMM_ASKIP
#define GEMM_ASKIP 0
#endif
namespace pg8 {
constexpr int BM = 256, BK = 64, HALF = 128, HTB = HALF * BK * 2  , STAGE_BYTES = 8 * HTB;
__host__ __device__ __forceinline__ int lds_byte(int r, int c) { const int st = (r >> 4) * 2 + (c >> 5), rr = r & 15, cc = c & 31, ob = rr * 64 + cc * 2; return st * 1024 + (ob ^ (((ob >> 9) & 1) << 5)); }
__host__ __device__ __forceinline__ void stage_rc(int b, int& R, int& C) { const int st = b / 1024, sb = b % 1024, swz = sb ^ (((sb >> 9) & 1) << 5); R = (st >> 1) * 16 + swz / 64; C = (st & 1) * 32 + (swz % 64) / 2; }
__host__ __device__ __forceinline__ int perm32(int rho) { const int n = rho >> 4, i = rho & 15; return 8 * (i >> 2) + 4 * n + (i & 3); }

struct Unit { int arow0, orow0, col0, e, quad; };
struct Gemm { const bf16* A; const bf16* Bt; const int* gather; size_t b_estride; int lda, K; };

template <bool GATHER, int MF, class Epi, class Sched>
__device__ __forceinline__ void gemm_phase(LAS unsigned char* lds, const int tid, const Gemm g, const Sched& S, const Epi& E) {
    const int wid = __builtin_amdgcn_readfirstlane(tid >> 6), lane = tid & 63, wr = wid >> 2, wc = wid & 3, fr = lane & 15, fq = lane >> 4;
    constexpr bool ASKIP = (MF == 3) && GEMM_ASKIP;
    constexpr int HR = 32 * MF;
    const int K = g.K, nt = K / BK;
    unsigned voffA[2], voffB[2]; int sR[2];
#pragma unroll
    for (int i = 0; i < 2; ++i) { int C_; stage_rc(tid * 16 + i * 8192, sR[i], C_); const int Rb = (sR[i] & ~31) + perm32(sR[i] & 31);
        voffA[i] = GATHER ? (unsigned)C_ * 2u : (unsigned)(sR[i] * g.lda + C_) * 2u; voffB[i] = (unsigned)(Rb * K + C_) * 2u; }
    const unsigned lda2 = (unsigned)g.lda * 2u;
    const unsigned hstepA = (unsigned)HR * g.lda * 2u;
    const unsigned kstep = (unsigned)(BK * 2);
    const int krot = (2 * S.rot) % nt;
#define PG8_KT(i) ((PROBE_HOT && hot_) ? 0u : (unsigned)(((i) + krot) >= nt ? (i) + krot - nt : (i) + krot) * kstep)
    const unsigned hstepB = (unsigned)HALF * K * 2u;
    const __amdgpu_buffer_rsrc_t rsA = __builtin_amdgcn_make_buffer_rsrc((void*)g.A, 0, 0x7fffffff, 0x00020000);
    const __amdgpu_buffer_rsrc_t rsB = __builtin_amdgcn_make_buffer_rsrc((void*)g.Bt, 0, 0x7fffffff, 0x00020000);
    const unsigned ldsw = (unsigned)wid * 1024u;
    const int aoff = lds_byte(wr * (16 * MF) + fr, fq * 8), boff = lds_byte(wc * 32 + fr, fq * 8);
#define PG8_SA(b, h) (((b) * 2 + (h)) * HTB)
#define PG8_SB(b, h) ((4 + (b) * 2 + (h)) * HTB)
#define PG8_STAGE2(bufoff, rsrc, v0, v1, soff) do { \
        __builtin_amdgcn_raw_ptr_buffer_load_lds(rsrc, (LAS unsigned*)(lds + (bufoff) + ldsw), 16, (int)(v0), (int)(soff), 0, 0); \
        __builtin_amdgcn_raw_ptr_buffer_load_lds(rsrc, (LAS unsigned*)(lds + (bufoff) + ldsw + 8192), 16, (int)(v1), (int)(soff), 0, 0); } while (0)
#define PG8_STAGEB(bufoff, soff) PG8_STAGE2(bufoff, rsB, voffB[0], voffB[1], soff)
#define PG8_STAGE1(bufoff, rsrc, v0, soff) __builtin_amdgcn_raw_ptr_buffer_load_lds(rsrc, (LAS unsigned*)(lds + (bufoff) + ldsw), 16, (int)(v0), (int)(soff), 0, 0)
#define PG8_STAGEA(bufoff, ubase, r0, r1, h, koff) do { if constexpr (GATHER) { \
        if (ASKIP && wr == 1) PG8_STAGE1(bufoff, rsA, (((r0) >> (16 * (h))) & 0xffffu) * lda2 + voffA[0], (koff)); \
        else PG8_STAGE2(bufoff, rsA, (((r0) >> (16 * (h))) & 0xffffu) * lda2 + voffA[0], (((r1) >> (16 * (h))) & 0xffffu) * lda2 + voffA[1], (koff)); } \
        else { if (ASKIP && wr == 1) PG8_STAGE1(bufoff, rsA, voffA[0], (ubase) + (h) * hstepA + (koff)); \
        else PG8_STAGE2(bufoff, rsA, voffA[0], voffA[1], (ubase) + (h) * hstepA + (koff)); } } while (0)
#define PG8_LDA(dst, b, h) do { if (PROBE_NOLDS && hot_) break; _Pragma("unroll") for (int m = 0; m < MF; ++m) _Pragma("unroll") for (int k = 0; k < 2; ++k) dst[m][k] = *(const LAS bf16x8*)(lds + PG8_SA(b, h) + aoff + m * 2048 + k * 1024); } while (0)
#define PG8_LDB(dst, b, h) do { if (PROBE_NOLDS && hot_) break; _Pragma("unroll") for (int n = 0; n < 2; ++n) _Pragma("unroll") for (int k = 0; k < 2; ++k) dst[n][k] = *(const LAS bf16x8*)(lds + PG8_SB(b, h) + boff + n * 2048 + k * 1024); } while (0)
#define PG8_MMA(ai, bj, At, Bt) do { __builtin_amdgcn_s_setprio(1); _Pragma("unroll") for (int m = 0; m < MF; ++m) _Pragma("unroll") for (int n = 0; n < 2; ++n) _Pragma("unroll") for (int k = 0; k < 2; ++k) \
        acc[ai][bj][m][n] = __builtin_amdgcn_mfma_f32_16x16x32_bf16(Bt[n][k], At[m][k], acc[ai][bj][m][n], 0, 0, 0); __builtin_amdgcn_s_setprio(0); } while (0)
#define PG8_WAIT_V(n) asm volatile("s_waitcnt vmcnt(" #n ")" ::: "memory")
#define PG8_WAIT_V2(n, nskip) do { if (ASKIP && wr == 1) PG8_WAIT_V(nskip); else PG8_WAIT_V(n); } while (0)
#define PG8_WAIT_L(n) asm volatile("s_waitcnt lgkmcnt(" #n ")" ::: "memory")
#define PG8_BAR __builtin_amdgcn_s_barrier()
#define PG8_SCHED __builtin_amdgcn_sched_barrier(0)
#define PG8_ROWS(dst, u) do { if constexpr (GATHER) { _Pragma("unroll") for (int i = 0; i < 2; ++i) { \
        const int sr_ = sR[i] < HR ? sR[i] : sR[i] - 32;     \
        const unsigned a_ = (unsigned)g.gather[(u).arow0 + sr_], b_ = (unsigned)g.gather[(u).arow0 + ((u).quad ? 0 : HR) + sr_]; dst[i] = a_ | (b_ << 16); } \
        asm volatile("" : "+v"(dst[0]), "+v"(dst[1])); } } while (0)
    Unit cur, nxt; int ui = 0;
    if (!S.next(0, cur)) return;
    const bool hot_ = cur.quad == 2;
    f32x4 acc[2][2][MF][2];
#pragma unroll
    for (int a = 0; a < 2; ++a)
#pragma unroll
        for (int b = 0; b < 2; ++b)
#pragma unroll
            for (int m = 0; m < MF; ++m)
#pragma unroll
                for (int n = 0; n < 2; ++n) acc[a][b][m][n] = (f32x4){0.f, 0.f, 0.f, 0.f};
    bf16x8 At[MF][2], B0[2][2], B1[2][2];
    unsigned rp[2] = {0u, 0u}, rn[2] = {0u, 0u};
    PG8_ROWS(rp, cur);
    unsigned cA = (unsigned)cur.arow0 * lda2;
    unsigned cB = (unsigned)(((size_t)cur.e * g.b_estride + (size_t)cur.col0 * K) * 2);
    PG8_STAGEB(PG8_SB(0, 0), cB + PG8_KT(0)); PG8_STAGEB(PG8_SB(0, 1), cB + hstepB + PG8_KT(0)); PG8_STAGEA(PG8_SA(0, 0), cA, rp[0], rp[1], 0, PG8_KT(0)); PG8_STAGEA(PG8_SA(0, 1), cA, rp[0], rp[1], 1, PG8_KT(0));
    if (wr == 1) PG8_BAR;
    PG8_WAIT_V2(2, 1); PG8_BAR;
    PG8_STAGEB(PG8_SB(1, 0), cB + PG8_KT(1)); PG8_STAGEA(PG8_SA(1, 0), cA, rp[0], rp[1], 0, PG8_KT(1)); PG8_STAGEB(PG8_SB(1, 1), cB + hstepB + PG8_KT(1));
    PG8_WAIT_V2(6, 5); PG8_BAR;
    for (;;) {
        const bool has_next = S.next(ui + 1, nxt);
        if (has_next) { PG8_ROWS(rn, nxt); } else { rn[0] = rp[0]; rn[1] = rp[1]; }
        const unsigned nA = has_next ? (unsigned)nxt.arow0 * lda2 : cA;
        const unsigned nB = has_next ? (unsigned)(((size_t)nxt.e * g.b_estride + (size_t)nxt.col0 * K) * 2) : cB;
#pragma unroll 1
        for (int t = 0; t < nt; t += 2) {
            const bool last = (t == nt - 2);
            const unsigned k1 = PG8_KT(t + 1), k2 = last ? PG8_KT(0) : PG8_KT(t + 2), k3 = last ? PG8_KT(1) : PG8_KT(t + 3);
            const unsigned u2 = last ? nA : cA; const unsigned b2 = (last ? nB : cB) + k2; const unsigned b3 = (last ? nB : cB) + k3;
            const unsigned q0 = last ? rn[0] : rp[0], q1 = last ? rn[1] : rp[1];
            PG8_LDB(B0, 0, 0); PG8_LDB(B1, 0, 1); PG8_SCHED; PG8_LDA(At, 0, 0); PG8_STAGEA(PG8_SA(1, 1), cA, rp[0], rp[1], 1, k1);
            PG8_WAIT_V2(8, 6); PG8_WAIT_L(0); PG8_BAR; if (cur.quad < 2) PG8_MMA(0, 0, At, B0); if (!cur.quad) PG8_MMA(0, 1, At, B1); PG8_BAR; PG8_SCHED;
            PG8_LDA(At, 0, 1); PG8_STAGEB(PG8_SB(0, 0), b2); PG8_STAGEB(PG8_SB(0, 1), b2 + hstepB); PG8_STAGEA(PG8_SA(0, 0), u2, q0, q1, 0, k2);
            PG8_WAIT_V2(8, 6); PG8_WAIT_L(0); PG8_BAR; if (!cur.quad) { PG8_MMA(1, 0, At, B0); PG8_MMA(1, 1, At, B1); } PG8_BAR; PG8_SCHED;
            PG8_LDB(B0, 1, 0); PG8_LDB(B1, 1, 1); PG8_SCHED; PG8_LDA(At, 1, 0); PG8_STAGEA(PG8_SA(0, 1), u2, q0, q1, 1, k2);
            PG8_WAIT_V2(8, 6); PG8_WAIT_L(0); PG8_BAR; if (cur.quad < 2) PG8_MMA(0, 0, At, B0); if (!cur.quad) PG8_MMA(0, 1, At, B1); PG8_BAR; PG8_SCHED;
            PG8_LDA(At, 1, 1); PG8_STAGEB(PG8_SB(1, 0), b3); PG8_STAGEB(PG8_SB(1, 1), b3 + hstepB); PG8_STAGEA(PG8_SA(1, 0), u2, q0, q1, 0, k3);
            PG8_WAIT_V2(8, 6); PG8_WAIT_L(0); PG8_BAR; if (!cur.quad) { PG8_MMA(1, 0, At, B0); PG8_MMA(1, 1, At, B1); } PG8_BAR; PG8_SCHED;
        }
        if (wr == 0) PG8_BAR;
        if (!(PROBE_NOEPI && hot_)) E(acc, cur, wr, wc, fr, fq);
        if (!has_next) break;
#pragma unroll
        for (int a = 0; a < 2; ++a)
#pragma unroll
            for (int b = 0; b < 2; ++b)
#pragma unroll
                for (int m = 0; m < MF; ++m)
#pragma unroll
                    for (int n = 0; n < 2; ++n) acc[a][b][m][n] = (f32x4){0.f, 0.f, 0.f, 0.f};
        cur = nxt; cB = nB; cA = nA; ++ui; rp[0] = rn[0]; rp[1] = rn[1];
        if (wr == 1) PG8_BAR;
    }
    PG8_WAIT_V(0);
    PG8_BAR;
#undef PG8_SA
#undef PG8_SB
#undef PG8_STAGE2
#undef PG8_STAGEB
#undef PG8_LDA
#undef PG8_LDB
#undef PG8_MMA
#undef PG8_WAIT_V
#undef PG8_WAIT_V2
#undef PG8_STAGE1
#undef PG8_WAIT_L
#undef PG8_BAR
#undef PG8_SCHED
#undef PG8_KT
#undef PG8_ROWS
#undef PG8_STAGEA
}
constexpr int PTB = 96 * BK * 2, SB_OFF = 6 * PTB, STAGE288_BYTES = SB_OFF + 4 * HTB;
template <bool GATHER, class Epi, class Sched>
__device__ __forceinline__ void gemm_phase288(LAS unsigned char* lds, const int tid, const Gemm g, const Sched& S, const Epi& E) {
    constexpr int MF = 3;
    const int wid = __builtin_amdgcn_readfirstlane(tid >> 6), lane = tid & 63, wr = wid >> 2, wc = wid & 3, fr = lane & 15, fq = lane >> 4;
    const int K = g.K, nt = K / BK;
    unsigned voffA[2], voffB[2]; int sR[2];
#pragma unroll
    for (int i = 0; i < 2; ++i) { int C_; stage_rc(tid * 16 + i * 8192, sR[i], C_); const int Rb = (sR[i] & ~31) + perm32(sR[i] & 31);
        voffB[i] = (unsigned)(Rb * K + C_) * 2u;
        if (i == 1) stage_rc((tid & 255) * 16 + 8192, sR[i], C_);
        voffA[i] = GATHER ? (unsigned)C_ * 2u : (unsigned)(sR[i] * g.lda + C_) * 2u; }
    const unsigned lda2 = (unsigned)g.lda * 2u;
    const unsigned pstepA = 96u * g.lda * 2u;
    const unsigned kstep = (unsigned)(BK * 2);
    const unsigned hstepB = (unsigned)HALF * K * 2u;
    const __amdgpu_buffer_rsrc_t rsA = __builtin_amdgcn_make_buffer_rsrc((void*)g.A, 0, 0x7fffffff, 0x00020000);
    const __amdgpu_buffer_rsrc_t rsB = __builtin_amdgcn_make_buffer_rsrc((void*)g.Bt, 0, 0x7fffffff, 0x00020000);
    const unsigned ldsw = (unsigned)wid * 1024u, ldsx = 8192u + (unsigned)(wid & 3) * 1024u;
    const int aoff = lds_byte(wr * 48 + fr, fq * 8), boff = lds_byte(wc * 32 + fr, fq * 8);
#define PG9_SA(b, a) (((b) * 3 + (a)) * PTB)
#define PG9_SB(b, h) (SB_OFF + ((b) * 2 + (h)) * HTB)
#define PG9_DMA(rsrc, dstoff, v, soff) if (!(PROBE9 & 1) || !pr_) __builtin_amdgcn_raw_ptr_buffer_load_lds(rsrc, (LAS unsigned*)(lds + (dstoff) + ldsw), 16, (int)(v), (int)(soff), 0, GEMM_AUX)
#define PG9_STAGEB(bufoff, soff) do { PG9_DMA(rsB, (bufoff), voffB[0], (soff)); PG9_DMA(rsB, (bufoff) + 8192, voffB[1], (soff)); } while (0)
#define PG9_RIDX(r, a, i) ((a) < 2 ? (((r)[i] >> (16 * (a))) & 0xffffu) : (((r)[2] >> (16 * (i))) & 0xffffu))
#define PG9_DMAX(rsrc, dstoff, v, soff) if (!(PROBE9 & 1) || !pr_) __builtin_amdgcn_raw_ptr_buffer_load_lds(rsrc, (LAS unsigned*)(lds + (dstoff) + ldsx), 16, (int)(v), (int)(soff), 0, GEMM_AUX)
#define PG9_STAGEA(bufoff, ubase, r, a, koff, OWN) do { if constexpr (GATHER) { \
        PG9_DMA(rsA, (bufoff), PG9_RIDX(r, a, 0) * lda2 + voffA[0], (koff)); if (wr == (OWN)) PG9_DMAX(rsA, (bufoff), PG9_RIDX(r, a, 1) * lda2 + voffA[1], (koff)); } \
        else { PG9_DMA(rsA, (bufoff), voffA[0], (ubase) + (a) * pstepA + (koff)); if (wr == (OWN)) PG9_DMAX(rsA, (bufoff), voffA[1], (ubase) + (a) * pstepA + (koff)); } } while (0)
#define PG9_LDA(dst, b, a) do { if ((PROBE9 & 2) && pr_) break; _Pragma("unroll") for (int m = 0; m < MF; ++m) _Pragma("unroll") for (int k = 0; k < 2; ++k) dst[m][k] = *(const LAS bf16x8*)(lds + PG9_SA(b, a) + aoff + m * 2048 + k * 1024); } while (0)
#define PG9_LDB(dst, b, h) do { if ((PROBE9 & 2) && pr_) break; _Pragma("unroll") for (int n = 0; n < 2; ++n) _Pragma("unroll") for (int k = 0; k < 2; ++k) dst[n][k] = *(const LAS bf16x8*)(lds + PG9_SB(b, h) + boff + n * 2048 + k * 1024); } while (0)
#define PG9_MMA(ai, bj, At, Bt) do { if ((PROBE9 & 4) && pr_) break; if (GEMM_PRIO) __builtin_amdgcn_s_setprio(1); _Pragma("unroll") for (int m = 0; m < MF; ++m) _Pragma("unroll") for (int n = 0; n < 2; ++n) _Pragma("unroll") for (int k = 0; k < 2; ++k) \
        acc[ai][bj][m][n] = __builtin_amdgcn_mfma_f32_16x16x32_bf16(Bt[n][k], At[m][k], acc[ai][bj][m][n], 0, 0, 0); if (GEMM_PRIO) __builtin_amdgcn_s_setprio(0); } while (0)
#define PG9_WAIT_V(n) asm volatile("s_waitcnt vmcnt(" #n ")" ::: "memory")
#define PG9_WAIT_L(n) asm volatile("s_waitcnt lgkmcnt(" #n ")" ::: "memory")
#define PG9_BAR __builtin_amdgcn_s_barrier()
#define PG9_SCHED __builtin_amdgcn_sched_barrier(0)
#define PG9_ROWS(dst, u) do { if constexpr (GATHER) { unsigned t2_[2]; _Pragma("unroll") for (int i = 0; i < 2; ++i) { \
        const unsigned a_ = (unsigned)g.gather[(u).arow0 + sR[i]], b_ = (unsigned)g.gather[(u).arow0 + 96 + sR[i]]; t2_[i] = (unsigned)g.gather[(u).arow0 + 192 + sR[i]]; dst[i] = a_ | (b_ << 16); } \
        dst[2] = t2_[0] | (t2_[1] << 16); asm volatile("" : "+v"(dst[0]), "+v"(dst[1]), "+v"(dst[2])); } } while (0)
    Unit cur, nxt; int ui = 0;
    if (!S.next(0, cur)) return;
    const bool pr_ = cur.quad == 2;
    f32x4 acc[3][2][MF][2];
#pragma unroll
    for (int a = 0; a < 3; ++a)
#pragma unroll
        for (int b = 0; b < 2; ++b)
#pragma unroll
            for (int m = 0; m < MF; ++m)
#pragma unroll
                for (int n = 0; n < 2; ++n) acc[a][b][m][n] = (f32x4){0.f, 0.f, 0.f, 0.f};
    bf16x8 At[MF][2], B0[2][2], B1[2][2];
    unsigned rp[3] = {0u, 0u, 0u}, rn[3] = {0u, 0u, 0u};
    PG9_ROWS(rp, cur);
    unsigned cA = (unsigned)cur.arow0 * lda2;
    unsigned cB = (unsigned)(((size_t)cur.e * g.b_estride + (size_t)cur.col0 * K) * 2);
    unsigned ck = (unsigned)S.kt0(cur) * kstep; int cnt = S.nkt(cur, nt);
    PG9_STAGEB(PG9_SB(0, 0), cB + ck); PG9_STAGEA(PG9_SA(0, 0), cA, rp, 0, ck, 0); PG9_STAGEB(PG9_SB(0, 1), cB + hstepB + ck); PG9_STAGEA(PG9_SA(0, 1), cA, rp, 1, ck, 1); PG9_STAGEA(PG9_SA(0, 2), cA, rp, 2, ck, 0);
    PG9_STAGEB(PG9_SB(1, 0), cB + ck + kstep); PG9_STAGEA(PG9_SA(1, 0), cA, rp, 0, ck + kstep, 1); PG9_STAGEB(PG9_SB(1, 1), cB + hstepB + ck + kstep); PG9_STAGEA(PG9_SA(1, 1), cA, rp, 1, ck + kstep, 0);
    PG9_WAIT_V(10); PG9_BAR;
    if (wr == 1) PG9_BAR;
    for (;;) {
        const bool has_next = S.next(ui + 1, nxt);
        if (has_next) { PG9_ROWS(rn, nxt); } else { rn[0] = rp[0]; rn[1] = rp[1]; rn[2] = rp[2]; }
        const unsigned nA = has_next ? (unsigned)nxt.arow0 * lda2 : cA;
        const unsigned nB = has_next ? (unsigned)(((size_t)nxt.e * g.b_estride + (size_t)nxt.col0 * K) * 2) : cB;
        const unsigned nk = has_next ? (unsigned)S.kt0(nxt) * kstep : ck; const int ncnt = has_next ? S.nkt(nxt, nt) : cnt;
#pragma unroll 1
        for (int t = 0; t < cnt; t += 2) {
            const bool last = (t == cnt - 2);
            const unsigned k1 = ck + (unsigned)(t + 1) * kstep, k2 = last ? nk : ck + (unsigned)(t + 2) * kstep, k3 = last ? nk + kstep : ck + (unsigned)(t + 3) * kstep;
            const unsigned u2 = last ? nA : cA; const unsigned b2 = (last ? nB : cB) + k2; const unsigned b3 = (last ? nB : cB) + k3;
            unsigned q[3]; q[0] = last ? rn[0] : rp[0]; q[1] = last ? rn[1] : rp[1]; q[2] = last ? rn[2] : rp[2];
#if GEMM_DMA_FIRST
            PG9_STAGEA(PG9_SA(1, 2), cA, rp, 2, k1, 1); PG9_LDB(B0, 0, 0); PG9_LDB(B1, 0, 1); PG9_SCHED; PG9_LDA(At, 0, 0);
#else
            PG9_LDB(B0, 0, 0); PG9_LDB(B1, 0, 1); PG9_SCHED; PG9_LDA(At, 0, 0); PG9_STAGEA(PG9_SA(1, 2), cA, rp, 2, k1, 1);
#endif
            PG9_WAIT_V(10); PG9_WAIT_L(0); PG9_BAR; PG9_MMA(0, 0, At, B0); PG9_MMA(0, 1, At, B1); PG9_BAR; PG9_SCHED;
#if GEMM_DMA_FIRST
            PG9_STAGEB(PG9_SB(0, 0), b2); PG9_STAGEA(PG9_SA(0, 0), u2, q, 0, k2, 0); PG9_LDA(At, 0, 1);
#else
            PG9_LDA(At, 0, 1); PG9_STAGEB(PG9_SB(0, 0), b2); PG9_STAGEA(PG9_SA(0, 0), u2, q, 0, k2, 0);
#endif
            PG9_WAIT_V(12); PG9_WAIT_L(0); PG9_BAR; PG9_MMA(1, 0, At, B0); PG9_MMA(1, 1, At, B1); PG9_BAR; PG9_SCHED;
#if GEMM_DMA_FIRST
            PG9_STAGEB(PG9_SB(0, 1), b2 + hstepB); PG9_STAGEA(PG9_SA(0, 1), u2, q, 1, k2, 1); PG9_LDA(At, 0, 2);
#else
            PG9_LDA(At, 0, 2); PG9_STAGEB(PG9_SB(0, 1), b2 + hstepB); PG9_STAGEA(PG9_SA(0, 1), u2, q, 1, k2, 1);
#endif
            PG9_WAIT_V(10); PG9_WAIT_L(0); PG9_BAR; PG9_MMA(2, 0, At, B0); PG9_MMA(2, 1, At, B1); PG9_BAR; PG9_SCHED;
#if GEMM_DMA_FIRST
            PG9_STAGEA(PG9_SA(0, 2), u2, q, 2, k2, 0); PG9_LDB(B0, 1, 0); PG9_LDB(B1, 1, 1); PG9_SCHED; PG9_LDA(At, 1, 0);
#else
            PG9_LDB(B0, 1, 0); PG9_LDB(B1, 1, 1); PG9_SCHED; PG9_LDA(At, 1, 0); PG9_STAGEA(PG9_SA(0, 2), u2, q, 2, k2, 0);
#endif
            PG9_WAIT_V(10); PG9_WAIT_L(0); PG9_BAR; PG9_MMA(0, 0, At, B0); PG9_MMA(0, 1, At, B1); PG9_BAR; PG9_SCHED;
#if GEMM_DMA_FIRST
            PG9_STAGEB(PG9_SB(1, 0), b3); PG9_STAGEA(PG9_SA(1, 0), u2, q, 0, k3, 1); PG9_LDA(At, 1, 1);
#else
            PG9_LDA(At, 1, 1); PG9_STAGEB(PG9_SB(1, 0), b3); PG9_STAGEA(PG9_SA(1, 0), u2, q, 0, k3, 1);
#endif
            PG9_WAIT_V(12); PG9_WAIT_L(0); PG9_BAR; PG9_MMA(1, 0, At, B0); PG9_MMA(1, 1, At, B1); PG9_BAR; PG9_SCHED;
#if GEMM_DMA_FIRST
            PG9_STAGEB(PG9_SB(1, 1), b3 + hstepB); PG9_STAGEA(PG9_SA(1, 1), u2, q, 1, k3, 0); PG9_LDA(At, 1, 2);
#else
            PG9_LDA(At, 1, 2); PG9_STAGEB(PG9_SB(1, 1), b3 + hstepB); PG9_STAGEA(PG9_SA(1, 1), u2, q, 1, k3, 0);
#endif
            PG9_WAIT_V(10); PG9_WAIT_L(0); PG9_BAR; PG9_MMA(2, 0, At, B0); PG9_MMA(2, 1, At, B1); PG9_BAR; PG9_SCHED;
        }
        if (wr == 0) PG9_BAR;
        if (!((PROBE9 & 8) && pr_)) E(acc, cur, wr, wc, fr, fq);
        if (!has_next) break;
#pragma unroll
        for (int a = 0; a < 3; ++a)
#pragma unroll
            for (int b = 0; b < 2; ++b)
#pragma unroll
                for (int m = 0; m < MF; ++m)
#pragma unroll
                    for (int n = 0; n < 2; ++n) acc[a][b][m][n] = (f32x4){0.f, 0.f, 0.f, 0.f};
        cur = nxt; cB = nB; cA = nA; ck = nk; cnt = ncnt; ++ui; rp[0] = rn[0]; rp[1] = rn[1]; rp[2] = rn[2];
        if (wr == 1) PG9_BAR;
    }
    PG9_WAIT_V(0);
    PG9_BAR;
#undef PG9_SA
#undef PG9_SB
#undef PG9_DMA
#undef PG9_DMAX
#undef PG9_STAGEB
#undef PG9_RIDX
#undef PG9_STAGEA
#undef PG9_LDA
#undef PG9_LDB
#undef PG9_MMA
#undef PG9_WAIT_V
#undef PG9_WAIT_L
#undef PG9_BAR
#undef PG9_SCHED
#undef PG9_ROWS
}
}

#ifndef QUAD_SPLIT
#define QUAD_SPLIT 1
#endif
__device__ __forceinline__ bool deal(int i, int j, int gpx, int U, int& unit, int& quad) {
    const int q = i * gpx + j, nfull = (U / gpx) * gpx, left = U - nfull;
    if (q < nfull || left * 4 > gpx || !QUAD_SPLIT) { if (q >= U) return false; unit = q; quad = -1; return true; }
    const int s_ = q - nfull; if (s_ >= left * 4) return false; unit = nfull + (s_ >> 2); quad = s_ & 3; return true;
}
struct OrderRows {
    int x, j, gpx, rpx, nN, nomma, rot, TR;
    __device__ __forceinline__ bool next(int i, pg8::Unit& u) const {
        int q, quad; if (!deal(i, j, gpx, rpx * nN, q, quad)) return false;
        const int pm = x * rpx + q / nN, pn = q % nN; u.arow0 = pm * TR; u.col0 = pn * 256; u.e = 0; u.quad = quad >= 0;
        if (quad >= 0) { u.arow0 += (quad >> 1) * (TR / 2); u.col0 += (quad & 1) * 128; }
        if (nomma) u.quad = 2;
        u.orow0 = u.arow0; return true; }
    __device__ __forceinline__ int kt0(const pg8::Unit&) const { return 0; }
    __device__ __forceinline__ int nkt(const pg8::Unit&, int nt) const { return nt; }
};
struct OrderUp : OrderRows {
    __device__ __forceinline__ int kt0(const pg8::Unit& u) const { return u.col0 < 512 ? 0 : 4; }
    __device__ __forceinline__ int nkt(const pg8::Unit& u, int) const { return u.col0 < 512 ? 4 : 2; }
};
struct OrderMoe {
    int x, j, gpx, nME, nN, rot, TR;
    __device__ __forceinline__ bool next(int i, pg8::Unit& u) const {
        int q, quad; const int per = nME * nN; if (!deal(i, j, gpx, 2 * per, q, quad)) return false;
        const int e = 2 * x + q / per, rem = q % per, pmE = rem / nN, pn = rem % nN;
        u.arow0 = e * SLOTS_E + pmE * TR; u.col0 = pn * 256; u.e = e; u.quad = quad >= 0;
        if (quad >= 0) { u.arow0 += (quad >> 1) * (TR / 2); u.col0 += (quad & 1) * 128; }
        u.orow0 = u.arow0; return true; }
    __device__ __forceinline__ int kt0(const pg8::Unit&) const { return 0; }
    __device__ __forceinline__ int nkt(const pg8::Unit&, int nt) const { return nt; }
};

#if X_BF16
typedef bf16 XT;
#else
typedef float XT;
#endif
constexpr float QS_A = 0.125f * 1.4426950408889634f, QS_B = 0.10206207261596577f * 1.4426950408889634f, QS_C = 0.17677669529663687f * 1.4426950408889634f;
typedef float f32x4e __attribute__((ext_vector_type(4)));
#define EPI_ROWS(ai, m) (u.orow0 + (ai) * (32 * MF) + wr * (16 * MF) + (m) * 16 + fr)
#define EPI_COL0(bj) (u.col0 + (bj) * 128 + wc * 32 + 8 * fq)
#ifndef ROPE_ASM
#define ROPE_ASM 0
#endif
__device__ __forceinline__ void rot1(float& x, float& y, const float c, const float s) {
    float t0, t1, ox, oy;
    asm("v_mul_f32 %0, %1, %2" : "=v"(t0) : "v"(y), "v"(s));
    asm("v_mul_f32 %0, %1, %2" : "=v"(t1) : "v"(x), "v"(s));
    asm("v_fma_f32 %0, %1, %2, -%3" : "=v"(ox) : "v"(x), "v"(c), "v"(t0));
    asm("v_fma_f32 %0, %1, %2, %3" : "=v"(oy) : "v"(y), "v"(c), "v"(t1));
    x = ox; y = oy;
}
__device__ __forceinline__ void rope8(f32x4& v0, f32x4& v1, const float* cs, const float* sn) {
    const f32x4 c = *(const f32x4*)cs, s = *(const f32x4*)sn;
#if !ROPE_ASM
    { f32x4 a = v0, b = v1;
      v0.x = a.x * c.x - a.y * s.x; v0.y = a.y * c.x + a.x * s.x; v0.z = a.z * c.y - a.w * s.y; v0.w = a.w * c.y + a.z * s.y;
      v1.x = b.x * c.z - b.y * s.z; v1.y = b.y * c.z + b.x * s.z; v1.z = b.z * c.w - b.w * s.w; v1.w = b.w * c.w + b.z * s.w; return; }
#endif
    float a0 = v0.x, a1 = v0.y, a2 = v0.z, a3 = v0.w, b0 = v1.x, b1 = v1.y, b2 = v1.z, b3 = v1.w;
    rot1(a0, a1, c.x, s.x); rot1(a2, a3, c.y, s.y); rot1(b0, b1, c.z, s.z); rot1(b2, b3, c.w, s.w);
    v0 = (f32x4){a0, a1, a2, a3}; v1 = (f32x4){b0, b1, b2, b3};
}
__device__ __forceinline__ u32x4 pack8(const f32x4 v0, const f32x4 v1) { u32x4 w; w.x = pk2(v0.x, v0.y); w.y = pk2(v0.z, v0.w); w.z = pk2(v1.x, v1.y); w.w = pk2(v1.z, v1.w); return w; }

#ifndef EPI_LEAN
#define EPI_LEAN 0
#endif
#ifndef EPI_PROBE
#define EPI_PROBE 0
#endif
#if EPI_LEAN
__device__ __forceinline__ void rope8v(f32x4& v0, f32x4& v1, const f32x4 c, const f32x4 s) {
    f32x4 a = v0, b = v1;
    v0.x = a.x * c.x - a.y * s.x; v0.y = a.y * c.x + a.x * s.x; v0.z = a.z * c.y - a.w * s.y; v0.w = a.w * c.y + a.z * s.y;
    v1.x = b.x * c.z - b.y * s.z; v1.y = b.y * c.z + b.x * s.z; v1.z = b.z * c.w - b.w * s.w; v1.w = b.w * c.w + b.z * s.w;
}
template <int MF, int NA = 2> struct EpiInProj {
    bf16* P; const float* rope; float* RSQ;
    __device__ __forceinline__ void operator()(const f32x4 (&acc)[NA][2][MF][2], const pg8::Unit& u, int wr, int wc, int fr, int fq) const {
        asm volatile("" : "+v"(fr), "+v"(fq));
#pragma unroll
        for (int bj = 0; bj < 2; ++bj) {
            if (u.quad == 1 && bj) continue;
            const int cw = u.col0 + bj * 128 + wc * 32, c0 = cw + 8 * fq;
            const bool secA = cw < P_AV, secB = cw >= P_KR && cw < P_DV, rot = (secA || secB) && !((EPI_PROBE & 1) && u.quad == 2);
            const int which = ((EPI_PROBE & 2) && u.quad == 2) ? -1 : ((cw >= P_CQ && cw < P_CKV) ? 0 : ((cw >= P_CKV && cw < P_KR) ? 1 : -1));
            const int p0 = secA ? ((c0 & 63) >> 1) : ((c0 & 31) >> 1);
            const float qs = cw < P_AK ? QS_A : ((cw >= P_DQ && cw < P_DK) ? QS_C : 1.f);
            const float* csb = secA ? rope + p0 : rope + T * 64 + p0; const int tstr = secA ? 32 : 16, snoff = secA ? T * 32 : T * 16;
#pragma unroll
            for (int ai = 0; ai < NA; ++ai) {
                if (u.quad == 1 && ai) continue;
#pragma unroll
                for (int m = 0; m < MF; ++m) {
                    const int rowb = u.orow0 + ai * (32 * MF) + wr * (16 * MF) + m * 16, row = rowb + fr;
                    f32x4 v0 = acc[ai][bj][m][0] * qs, v1 = acc[ai][bj][m][1] * qs;
                    if (rot && rowb < RL) { const float* c_ = csb + (row & (T - 1)) * tstr; rope8v(v0, v1, *(const f32x4*)c_, *(const f32x4*)(c_ + snoff)); }
                    if (which >= 0) { float s = (v0.x * v0.x + v0.y * v0.y) + (v0.z * v0.z + v0.w * v0.w) + (v1.x * v1.x + v1.y * v1.y) + (v1.z * v1.z + v1.w * v1.w);
                        { const int ln_ = fq * 16 + fr; s += shx(s, 16, ln_); s += shx(s, 32, ln_); }
                        if (fq == 0) RSQ[(size_t)row * 12 + ((c0 - P_CQ) >> 5)] = s; }
                    st16(P + (size_t)row * LDP + c0, pack8(v0, v1));
                }
            }
        }
    }
};
#else
template <int MF, int NA = 2> struct EpiInProj {
    bf16* P; const float* rope; float* RSQ;
    __device__ __forceinline__ void operator()(const f32x4 (&acc)[NA][2][MF][2], const pg8::Unit& u, int wr, int wc, int fr, int fq) const {
#pragma unroll
        for (int bj = 0; bj < 2; ++bj) {
            if (u.quad == 1 && bj) continue;
            const int c0 = EPI_COL0(bj);
            const bool secA = c0 < P_AV, secB = c0 >= P_KR && c0 < P_DV;
            const int which = (c0 >= P_CQ && c0 < P_CKV) ? 0 : ((c0 >= P_CKV && c0 < P_KR) ? 1 : -1);
            const int p0 = secA ? ((c0 & 63) >> 1) : ((c0 & 31) >> 1);
            const float qs = c0 < P_AK ? QS_A : ((c0 >= P_DQ && c0 < P_DK) ? QS_C : 1.f);
#pragma unroll
            for (int ai = 0; ai < NA; ++ai)
#pragma unroll
                for (int m = 0; m < MF; ++m) {
                    if (u.quad == 1 && ai) continue;
                    const int row = EPI_ROWS(ai, m);
                    f32x4 v0 = acc[ai][bj][m][0] * qs, v1 = acc[ai][bj][m][1] * qs;
                    if (row < RL && (secA || secB)) { const int t = row & (T - 1);
                        const float* cs = secA ? rope + t * 32 + p0 : rope + T * 64 + t * 16 + p0;
                        const float* sn = secA ? rope + T * 32 + t * 32 + p0 : rope + T * 64 + T * 16 + t * 16 + p0;
                        rope8(v0, v1, cs, sn); }
                    if (which >= 0) { float s = (v0.x * v0.x + v0.y * v0.y) + (v0.z * v0.z + v0.w * v0.w) + (v1.x * v1.x + v1.y * v1.y) + (v1.z * v1.z + v1.w * v1.w);
                        { const int ln_ = fq * 16 + fr; s += shx(s, 16, ln_); s += shx(s, 32, ln_); }
                        if (fq == 0) RSQ[(size_t)row * 12 + ((c0 - P_CQ) >> 5)] = s; }
                    if ((PROBE9 & 16) && u.quad == 2) { const u32x4 w_ = pack8(v0, v1); asm volatile("" :: "v"(w_)); }
                    else st16(P + (size_t)row * LDP + c0, pack8(v0, v1));
                }
        }
    }
};
#endif
template <int MF, int NA = 2> struct EpiUp {
    bf16* QKVM; const float* rope; const float* RSQ;
    __device__ __forceinline__ void operator()(const f32x4 (&acc)[NA][2][MF][2], const pg8::Unit& u, int wr, int wc, int fr, int fq) const {
        const bool isq = u.col0 < 512;
        const float inv = isq ? (1.f / 256.f) : (1.f / 128.f);
        const int cw = u.col0 + wc * 32 + 8 * fq;
        int j0 = cw; j0 -= j0 >= 192 ? 192 : 0; j0 -= j0 >= 96 ? 96 : 0;
        int j1 = j0 + 32; j1 -= j1 >= 96 ? 96 : 0;
        const bool rot0 = isq && cw < 384 && j0 >= 64, rot1 = isq && cw + 128 < 384 && j1 >= 64;
        const float* tb = rope + T * 64;
#pragma unroll
        for (int ai = 0; ai < NA; ++ai)
#pragma unroll
            for (int m = 0; m < MF; ++m) {
                if (u.quad && ai) continue;
                const int row = EPI_ROWS(ai, m);
                const float* rq = RSQ + (size_t)row * 12; float sq;
                if (isq) { const f32x4 pa_ = *(const f32x4*)rq, pb_ = *(const f32x4*)(rq + 4); sq = ((pa_.x + pa_.y) + (pa_.z + pa_.w)) + ((pb_.x + pb_.y) + (pb_.z + pb_.w)); }
                else { const f32x4 pc_ = *(const f32x4*)(rq + 8); sq = (pc_.x + pc_.y) + (pc_.z + pc_.w); }
                const float rs = __builtin_amdgcn_rsqf(sq * inv + EPS) * (isq ? QS_B : 1.f);
                const int t = row & (T - 1);
                bf16* dst = QKVM + (size_t)row * LDM + cw;
                { f32x4 v0 = acc[ai][0][m][0] * rs, v1 = acc[ai][0][m][1] * rs;
                  if (rot0 && row < RL) rope8(v0, v1, tb + t * 16 + ((j0 - 64) >> 1), tb + T * 16 + t * 16 + ((j0 - 64) >> 1));
                  st16(dst, pack8(v0, v1)); }
                if (!u.quad) { f32x4 v0 = acc[ai][1][m][0] * rs, v1 = acc[ai][1][m][1] * rs;
                  if (rot1 && row < RL) rope8(v0, v1, tb + t * 16 + ((j1 - 64) >> 1), tb + T * 16 + t * 16 + ((j1 - 64) >> 1));
                  st16(dst + 128, pack8(v0, v1)); }
            }
    }
};
template <int MF, int NA = 2> struct EpiOut {
    XT* X; const float* MODl; float keep;
    __device__ __forceinline__ void operator()(const f32x4 (&acc)[NA][2][MF][2], const pg8::Unit& u, int wr, int wc, int fr, int fq) const {
#pragma unroll
        for (int ai = 0; ai < NA; ++ai)
#pragma unroll
            for (int m = 0; m < MF; ++m) {
                if (u.quad && ai) continue;
                const int row_ = EPI_ROWS(ai, m); const int mb = row_ < RL ? row_ >> 11 : 8;
                const float* g1 = MODl + (size_t)mb * 6144 + 2048;
#pragma unroll
                for (int bj = 0; bj < 2; ++bj) {
                    if (u.quad && bj) continue;
                    const int c0 = EPI_COL0(bj);
                    const f32x4 ga = *(const f32x4*)(g1 + c0) * keep, gb = *(const f32x4*)(g1 + c0 + 4) * keep;
                    XT* xp = X + (size_t)row_ * D + c0;
#if X_BF16
                    const u32x4 xw = *(const u32x4*)xp;
                    f32x4 xa = (f32x4){bf2f(xw.x & 0xffffu), bf2f(xw.x >> 16), bf2f(xw.y & 0xffffu), bf2f(xw.y >> 16)}, xb = (f32x4){bf2f(xw.z & 0xffffu), bf2f(xw.z >> 16), bf2f(xw.w & 0xffffu), bf2f(xw.w >> 16)};
                    xa += ga * acc[ai][bj][m][0]; xb += gb * acc[ai][bj][m][1];
                    st16(xp, pack8(xa, xb));
#else
                    f32x4 xa = *(const f32x4*)xp, xb = *(const f32x4*)(xp + 4);
                    xa += ga * acc[ai][bj][m][0]; xb += gb * acc[ai][bj][m][1];
                    *(f32x4*)xp = xa; *(f32x4*)(xp + 4) = xb;
#endif
                }
            }
    }
};
template <int MF, int NA = 2> struct EpiGU {
    bf16* HID;
    __device__ __forceinline__ void operator()(const f32x4 (&acc)[NA][2][MF][2], const pg8::Unit& u, int wr, int wc, int fr, int fq) const {
#pragma unroll
        for (int bj = 0; bj < 2; ++bj) {
            if (u.quad && bj) continue;
            const int hc = EPI_COL0(bj) >> 1;
#pragma unroll
            for (int ai = 0; ai < NA; ++ai)
#pragma unroll
                for (int m = 0; m < MF; ++m) {
                    if (u.quad && ai) continue;
                    const f32x4 g = acc[ai][bj][m][0], up = acc[ai][bj][m][1];
                    u32x2 w; w.x = pk2(siluf(g.x) * up.x, siluf(g.y) * up.y); w.y = pk2(siluf(g.z) * up.z, siluf(g.w) * up.w);
                    *(u32x2*)(HID + (size_t)EPI_ROWS(ai, m) * DE + hc) = w;
                }
        }
    }
};
template <int MF, int NA = 2> struct EpiDown {
    bf16* Y; const float* SGATE;
    __device__ __forceinline__ void operator()(const f32x4 (&acc)[NA][2][MF][2], const pg8::Unit& u, int wr, int wc, int fr, int fq) const {
#pragma unroll
        for (int ai = 0; ai < NA; ++ai)
#pragma unroll
            for (int m = 0; m < MF; ++m) {
                if (u.quad && ai) continue;
                const int row = EPI_ROWS(ai, m); const float gt = SGATE[row];
#pragma unroll
                for (int bj = 0; bj < 2; ++bj)
                    if (!(u.quad && bj)) st16(Y + (size_t)row * D + EPI_COL0(bj), pack8(acc[ai][bj][m][0] * gt, acc[ai][bj][m][1] * gt));
            }
    }
};

constexpr int NWAVES = 8;
constexpr int RING_BYTES = 139264;
constexpr int LDSCTL_OFF = RING_BYTES, MISC_OFF = LDSCTL_OFF + 320;
constexpr int LDS_BYTES = 147456;
constexpr int CW_BAR = 4096;
typedef GAS unsigned gu32;

#define XB_TMO      128
#define XB_XCNT(j)  (256  + 64 * (j))
#define XB_XSUB(j)  (1280 + 64 * (j))
#define XB_XGEN(j)  (2304 + 64 * (j))
#define XB_TOP      3328
#define XB_TOPGEN   3392
#define XCD_BAR_WORDS 3456
#define XB_SPIN_CAP (1u << 18)
__device__ __forceinline__ unsigned xb_ld(unsigned* p)              { return __hip_atomic_load(p, __ATOMIC_RELAXED, __HIP_MEMORY_SCOPE_AGENT); }
__device__ __forceinline__ unsigned xb_add(unsigned* p, unsigned v) { return __hip_atomic_fetch_add(p, v, __ATOMIC_RELAXED, __HIP_MEMORY_SCOPE_AGENT); }
__device__ __forceinline__ unsigned xb_xcc_id() { return (unsigned)__builtin_amdgcn_s_getreg((3 << 11) | 20) & 0xFu; }
#define XB_SPIN(cond, bar) do { unsigned _sp = 0; while (cond) { __builtin_amdgcn_s_sleep(1); \
    if ((++_sp & 255u) == 0u) { if (xb_ld(&(bar)[XB_TMO])) break; if (_sp > XB_SPIN_CAP) { atomicAdd(&(bar)[XB_TMO], 1u); break; } } } } while (0)
struct XcdBarrier { unsigned* bar; unsigned x; volatile LAS unsigned* st; };
__device__ __forceinline__ XcdBarrier xcd_barrier_post(unsigned* bar, volatile LAS unsigned* st) {
    XcdBarrier b; b.bar = bar; b.x = xb_xcc_id(); b.st = st;
    if (threadIdx.x == 0) (void)xb_add(&bar[XB_XCNT(b.x)], 1u);
    return b;
}
__device__ __forceinline__ void xcd_barrier_complete(unsigned* bar, unsigned x, unsigned& nloc, unsigned& nx) {
    const unsigned G = gridDim.x * gridDim.y * gridDim.z;
    unsigned sum, cnt, mine, sp = 0u;
    for (;;) {
        sum = 0u; cnt = 0u; mine = 0u;
#pragma unroll
        for (unsigned j = 0; j < 16; ++j) { const unsigned c = xb_ld(&bar[XB_XCNT(j)]); sum += c; cnt += (c > 0u) ? 1u : 0u; mine = (j == x) ? c : mine; }
        if (sum == G) break;
        __builtin_amdgcn_s_sleep(1);
        if ((++sp & 255u) == 0u) { if (xb_ld(&bar[XB_TMO])) break; if (sp > XB_SPIN_CAP) { atomicAdd(&bar[XB_TMO], 1u); break; } }
    }
    nloc = mine > 0u ? mine : 1u; nx = cnt > 0u ? cnt : 1u;
}
__device__ __forceinline__ void xcd_barrier(const XcdBarrier& b, const int tid) {
    asm volatile("s_waitcnt vmcnt(0)" ::: "memory");
    __syncthreads();
    if (tid == 0) {
        unsigned* bar = b.bar;
        __builtin_amdgcn_s_waitcnt(0);
        unsigned nloc = b.st[0], nx = b.st[1];
        if (nloc == 0u) { xcd_barrier_complete(bar, b.x, nloc, nx); b.st[0] = nloc; b.st[1] = nx; }
        const unsigned old = xb_add(&bar[XB_XSUB(b.x)], 1u);
        const unsigned gen = old / nloc;
        if (old + 1u == (gen + 1u) * nloc) {
            __builtin_amdgcn_fence(__ATOMIC_RELEASE, "agent");
            asm volatile("s_waitcnt vmcnt(0)" ::: "memory");
            const unsigned og = xb_add(&bar[XB_TOP], 1u);
            const unsigned tg = og / nx;
            if (og + 1u == (tg + 1u) * nx) xb_add(&bar[XB_TOPGEN], 1u);
            else XB_SPIN(xb_ld(&bar[XB_TOPGEN]) == tg, bar);
            __builtin_amdgcn_fence(__ATOMIC_ACQUIRE, "agent");
            xb_add(&bar[XB_XGEN(b.x)], 1u);
            asm volatile("s_waitcnt vmcnt(0)" ::: "memory");
        } else {
            XB_SPIN(xb_ld(&bar[XB_XGEN(b.x)]) == gen, bar);
            __builtin_amdgcn_fence(__ATOMIC_ACQUIRE, "agent");
            asm volatile("s_waitcnt vmcnt(0)" ::: "memory");
        }
    }
    __syncthreads();
}

struct Frame { LAS unsigned char* lds; int tid, lane, wave, bid, G; const float* const* in; GAS float* out; GAS unsigned char* ws; };
#define IN_(k) ((const float*)(const GAS float*)F.in[(k)])
#define F_x IN_(0)
#define F_c IN_(1)
#define F_ctx IN_(2)
#define F_c_ctx IN_(3)
#define F_norm1 IN_(4)
#define F_norm2 IN_(5)
#define F_w_ada IN_(6)
#define F_b_ada IN_(7)
#define F_w_in IN_(8)
#define F_sink IN_(9)
#define F_mla_q_norm IN_(10)
#define F_w_uq IN_(11)
#define F_mla_kv_norm IN_(12)
#define F_w_ukv IN_(13)
#define F_lq1 IN_(14)
#define F_lk1 IN_(15)
#define F_lq2 IN_(16)
#define F_lk2 IN_(17)
#define F_diff_norm IN_(18)
#define F_w_out IN_(19)
#define F_w_router IN_(20)
#define F_w_gate IN_(21)
#define F_w_up IN_(22)
#define F_w_down IN_(23)
#define F_final_norm IN_(24)
#define F_MOD ((float*)(GAS float*)(F.ws + WS_MOD))
#define F_ROPE ((float*)(GAS float*)(F.ws + WS_ROPE))
#define F_RSQ ((float*)(GAS float*)(F.ws + WS_RSQ))
#define F_AFF ((float*)(GAS float*)(F.ws + WS_AFF))
#define F_INV ((int*)(GAS int*)(F.ws + WS_INV))
#define F_STOK ((int*)(GAS int*)(F.ws + WS_STOK))
#define F_SGATE ((float*)(GAS float*)(F.ws + WS_SGATE))
#define F_X ((float*)(GAS float*)(F.ws + WS_X))
#define F_XB ((bf16*)(GAS bf16*)(F.ws + WS_X))
#define F_ACT ((bf16*)(GAS bf16*)(F.ws + WS_ACT))
#define F_P ((bf16*)(GAS bf16*)(F.ws + WS_P))
#define F_Y ((bf16*)(GAS bf16*)(F.ws + WS_Y))
#define F_QKVM ((bf16*)(GAS bf16*)(F.ws + WS_QKVM))
#define F_O ((bf16*)(GAS bf16*)(F.ws + WS_O))
#define F_HID ((bf16*)(GAS bf16*)(F.ws + WS_HID))
#define F_WB ((bf16*)(GAS bf16*)(F.ws + WS_W))

__device__ __forceinline__ int rot64(int dp) { const int p = dp >> 1, half = dp & 1, axis = p >> 4, f = p & 15; return axis * 32 + half * 16 + f; }
__device__ __forceinline__ int rot32(int dp) { const int p = dp >> 1, half = dp & 1, axis = p >> 3, f = p & 7; return axis * 16 + half * 8 + f; }
__device__ __forceinline__ int src_col_in(int n) {
    if (n >= INW) return -1;
    if (n < P_AV) return (n & ~63) + rot64(n & 63);
    if (n >= P_KR && n < P_DV) return (n & ~31) + rot32(n & 31);
    return n;
}
__device__ __forceinline__ void prep_tile(const float* src, int N, int k0, const float* kscale, bf16* dst, int ldd, LAS float* scr, int lane) {
    float v[32];
#pragma unroll
    for (int i = 0; i < 32; ++i) { const int kk = 2 * i + (lane >> 5); v[i] = src ? src[(size_t)(k0 + kk) * N] : 0.f; }
    if (kscale) {
#pragma unroll
        for (int i = 0; i < 32; ++i) v[i] *= kscale[k0 + 2 * i + (lane >> 5)]; }
#pragma unroll
    for (int i = 0; i < 32; ++i) scr[(2 * i + (lane >> 5)) * 33 + (lane & 31)] = v[i];
    LDS_WAIT();
    const int c = lane & 7;
#pragma unroll
    for (int j = 0; j < 4; ++j) { const int n = (lane >> 3) + 8 * j; const LAS float* s = scr + (8 * c) * 33 + n;
        u32x4 o; o.x = pk2(s[0], s[33]); o.y = pk2(s[66], s[99]); o.z = pk2(s[132], s[165]); o.w = pk2(s[198], s[231]);
        *(u32x4*)(dst + (size_t)n * ldd + 8 * c) = o; }
    LDS_WAIT();
}
constexpr int PI_IN = 16 * 64, PI_UP = 6 * 32, PI_OUT = 16 * 32, PI_GU = NE * 16 * 32, PI_DN = NE * 8 * 32, PI_LAYER = PI_IN + PI_UP + PI_OUT + PI_GU + PI_DN;
#ifndef BG_PREP
#define BG_PREP 0
#ifndef WRT_BATCH
#define WRT_BATCH 1
#endif
#ifndef COMB_BATCH
#define COMB_BATCH 0
#endif
#ifndef NORM2_NH
#define NORM2_NH 2
#endif
#ifndef TOPK_RADIX4
#define TOPK_RADIX4 0
#endif
#ifndef MOE_PF
#define MOE_PF 0
#endif
#endif
__device__ __forceinline__ void prep_layer(Frame& F, const int l, const int worker, const int nworkers) {
    const int lane = F.lane, wave = F.wave;
    LAS float* scr = (LAS float*)(F.lds + 57344 + wave * 8448);
    for (int it = worker; it < PI_LAYER; it += nworkers) {
        int r = it; bf16* wl = F_WB + (size_t)l * W_LAYER;
        const int nl = lane & 31;
        if (r < PI_IN) { const int kb = r / 64, nb = r % 64, n = nb * 32 + nl, sc = src_col_in(n);
            prep_tile(sc >= 0 ? F_w_in + (size_t)l * D * INW + sc : nullptr, INW, kb * 64, nullptr, wl + W_IN + (size_t)(nb * 32) * D + kb * 64, D, scr, lane); continue; } r -= PI_IN;
        if (r < PI_UP) { const int kb = r / 32, nb = r % 32, n = nb * 32 + nl, k0 = kb * 64; const float* src = nullptr; const float* ks = nullptr; int N = 384, ksrc = k0;
            if (n < 384 && k0 < 256) { const int h = n / 96, j = n % 96; const int sc = j < 64 ? n : h * 96 + 64 + rot32(j - 64); src = F_w_uq + (size_t)l * 256 * 384 + sc; ks = F_mla_q_norm + l * 256; N = 384; }
            else if (n >= 512 && k0 >= 256) { src = F_w_ukv + (size_t)l * 128 * 512 + (n - 512); ks = F_mla_kv_norm + l * 128; N = 512; ksrc = k0 - 256; }
            { float v[32];
#pragma unroll
              for (int i = 0; i < 32; ++i) { const int kk = 2 * i + (lane >> 5); v[i] = src ? src[(size_t)(ksrc + kk) * N] * ks[ksrc + kk] : 0.f; }
#pragma unroll
              for (int i = 0; i < 32; ++i) scr[(2 * i + (lane >> 5)) * 33 + (lane & 31)] = v[i];
              LDS_WAIT();
              const int c = lane & 7; bf16* dst = wl + W_UP + (size_t)(nb * 32) * UPK + k0;
#pragma unroll
              for (int j = 0; j < 4; ++j) { const int nn = (lane >> 3) + 8 * j; const LAS float* s = scr + (8 * c) * 33 + nn;
                  u32x4 o; o.x = pk2(s[0], s[33]); o.y = pk2(s[66], s[99]); o.z = pk2(s[132], s[165]); o.w = pk2(s[198], s[231]);
                  *(u32x4*)(dst + (size_t)nn * UPK + 8 * c) = o; }
              LDS_WAIT(); }
            continue; } r -= PI_UP;
        if (r < PI_OUT) { const int kb = r / 32, nb = r % 32;
            prep_tile(F_w_out + (size_t)l * D * D + nb * 32 + nl, D, kb * 64, nullptr, wl + W_OUT + (size_t)(nb * 32) * D + kb * 64, D, scr, lane); continue; } r -= PI_OUT;
        if (r < PI_GU) { const int e = r / 512, q = r % 512, kb = q / 32, nb = q % 32, n = nb * 32 + nl, f = (n >> 3) * 4 + (n & 3);
            const float* src = ((n & 4) ? F_w_up : F_w_gate) + ((size_t)l * NE + e) * D * DE + f;
            prep_tile(src, DE, kb * 64, nullptr, wl + W_GU + (size_t)e * 1024 * 1024 + (size_t)(nb * 32) * D + kb * 64, D, scr, lane); continue; } r -= PI_GU;
        { const int e = r / 256, q = r % 256, kb = q / 32, nb = q % 32;
            prep_tile(F_w_down + ((size_t)l * NE + e) * DE * D + nb * 32 + nl, D, kb * 64, nullptr, wl + W_DN + (size_t)e * 1024 * 512 + (size_t)(nb * 32) * DE + kb * 64, DE, scr, lane); }
    }
}

__device__ __forceinline__ void p0_phase(Frame& F) {
    const int tid = F.tid, lane = F.lane, wave = F.wave;
    const int gw = F.bid * NWAVES + wave, NGW = F.G * NWAVES;
    for (int l = (BG_PREP ? 1 : DEPTH) - 1; l >= 0; --l) prep_layer(F, l, gw, NGW);
    {
        LAS float* sl = (LAS float*)F.lds;
        LAS float* red = (LAS float*)(F.lds + 36864);
        for (int i = tid; i < 9 * 1024; i += 512) { const float v = i < 8 * 1024 ? F_c[i] : F_c_ctx[i - 8 * 1024]; sl[i] = siluf(v); }
        __syncthreads();
        for (int it = F.bid; it < DEPTH * 96; it += F.G) {
            const int l = it / 96, cg = it % 96;
            const int c4 = (lane & 15) * 4, kq = lane >> 4;
            f32x4 acc[9];
#pragma unroll
            for (int r = 0; r < 9; ++r) acc[r] = (f32x4){0.f, 0.f, 0.f, 0.f};
            const float* w = F_w_ada + (size_t)l * D * 6144 + (size_t)(wave * 128 + kq) * 6144 + cg * 64 + c4;
#pragma unroll 8
            for (int i = 0; i < 32; ++i) { const f32x4 wv = *(const f32x4*)(w + (size_t)(4 * i) * 6144);
#pragma unroll
                for (int r = 0; r < 9; ++r) acc[r] += wv * sl[r * 1024 + wave * 128 + 4 * i + kq]; }
#pragma unroll
            for (int r = 0; r < 9; ++r) {
                float a0 = acc[r].x, a1 = acc[r].y, a2 = acc[r].z, a3 = acc[r].w;
                a0 += shx(a0, 16, lane); a1 += shx(a1, 16, lane); a2 += shx(a2, 16, lane); a3 += shx(a3, 16, lane);
                a0 += shx(a0, 32, lane); a1 += shx(a1, 32, lane); a2 += shx(a2, 32, lane); a3 += shx(a3, 32, lane);
                if (lane < 16) *(LAS f32x4*)(red + (wave * 9 + r) * 64 + c4) = (f32x4){a0, a1, a2, a3}; }
            __syncthreads();
            for (int o = tid; o < 576; o += 512) { const int r = o >> 6, cc = o & 63; float s = 0.f;
#pragma unroll
                for (int w8 = 0; w8 < 8; ++w8) s += red[(w8 * 9 + r) * 64 + cc];
                F_MOD[((size_t)l * 9 + r) * 6144 + cg * 64 + cc] = s + F_b_ada[l * 6144 + cg * 64 + cc]; }
            __syncthreads();
        }
    }
    { const size_t n4 = (size_t)R * D / 4, nl4 = (size_t)RL * D / 4, st = (size_t)F.G * 512;
      for (size_t i0 = (size_t)F.bid * 512 + tid; i0 < n4; i0 += 4 * st) {
          f32x4 v4[4];
#pragma unroll
          for (int u = 0; u < 4; ++u) { const size_t i = i0 + u * st; if (i < n4) v4[u] = i < nl4 ? ((const f32x4*)F_x)[i] : ((const f32x4*)F_ctx)[i - nl4]; }
#pragma unroll
          for (int u = 0; u < 4; ++u) { const size_t i = i0 + u * st; if (i < n4) {
#if X_BF16
              u32x2 w; w.x = pk2(v4[u].x, v4[u].y); w.y = pk2(v4[u].z, v4[u].w); ((u32x2*)F_XB)[i] = w;
#else
              ((f32x4*)F_X)[i] = v4[u];
#endif
          } }
      } }
    for (int i = F.bid * 512 + tid; i < T * 48; i += F.G * 512) {
        const int t = i / 48, j = i % 48; int axis, f, nf;
        if (j < 32) { axis = j >> 4; f = j & 15; nf = 16; } else { axis = (j - 32) >> 3; f = (j - 32) & 7; nf = 8; }
        const float inv = exp2f(-(float)f / (float)nf * 13.287712379549449f);
        const float ang = (float)(axis == 0 ? (t >> 6) : (t & 63)) * inv;
        const float cv = cosf(ang), sv = sinf(ang);
        if (j < 32) { F_ROPE[t * 32 + j] = cv; F_ROPE[T * 32 + t * 32 + j] = sv; } else { F_ROPE[T * 64 + t * 16 + j - 32] = cv; F_ROPE[T * 64 + T * 16 + t * 16 + j - 32] = sv; }
    }
}

#ifndef PROBE_NOROUTER
#define PROBE_NOROUTER 0
#endif
#define half_swap_add(keepv, sendv, off) ((keepv) + shx((sendv), (off), lane))
template <int NH> __device__ __forceinline__ void norm_phase(Frame& F, int l, int mode, int nrows, const float keep) {
    const int lane = F.lane, gw = F.bid * NWAVES + F.wave, NGW = F.G * NWAVES;
    LAS float* wrT = (LAS float*)F.lds;
    if (mode == 1) {
        const float* wr = F_w_router + (size_t)l * D * NE;
#if WRT_BATCH
        f32x4 t_[8];
#pragma unroll
        for (int q = 0; q < 8; ++q) t_[q] = ((const f32x4*)wr)[F.tid + 512 * q];
#pragma unroll
        for (int q = 0; q < 8; ++q) { const int i = 4 * (F.tid + 512 * q), k = i >> 4, e = i & 15;
            wrT[e * 1028 + k] = t_[q].x; wrT[(e + 1) * 1028 + k] = t_[q].y; wrT[(e + 2) * 1028 + k] = t_[q].z; wrT[(e + 3) * 1028 + k] = t_[q].w; }
#else
        for (int i = F.tid; i < D * NE; i += 512) wrT[(i & 15) * 1028 + (i >> 4)] = wr[i];
#endif
        __syncthreads();
    }
    const float* gain = mode == 0 ? F_norm1 + (size_t)l * D : (mode == 1 ? F_norm2 + (size_t)l * D : F_final_norm);
    const bool comb = mode != 1 && l > 0;
    f32x4 vn[2][4];
#if X_BF16
#define NORM_LOAD(dst, rr0) do { _Pragma("unroll") for (int q = 0; q < 2; ++q) _Pragma("unroll") for (int j = 0; j < 4; ++j) { const u32x2 w_ = ((const u32x2*)(F_XB + (size_t)((rr0) + q) * D))[lane + 64 * j]; \
        dst[q][j] = (f32x4){bf2f(w_.x & 0xffffu), bf2f(w_.x >> 16), bf2f(w_.y & 0xffffu), bf2f(w_.y >> 16)}; } } while (0)
#else
#define NORM_LOAD(dst, rr0) do { _Pragma("unroll") for (int q = 0; q < 2; ++q) _Pragma("unroll") for (int j = 0; j < 4; ++j) dst[q][j] = ((const f32x4*)(F_X + (size_t)((rr0) + q) * D))[lane + 64 * j]; } while (0)
#endif
    if (gw * 2 < nrows) NORM_LOAD(vn, gw * 2);
    for (int rg = gw * 2; rg < nrows; rg += NGW * 2 * NH) {
      f32x4 hv[NH][2][4];
#pragma unroll
      for (int hh = 0; hh < NH; ++hh) {
        const int r0 = rg + hh * NGW * 2;
        if (r0 >= nrows) {
#pragma unroll
            for (int q = 0; q < 2; ++q)
#pragma unroll
                for (int j = 0; j < 4; ++j) hv[hh][q][j] = (f32x4){0.f, 0.f, 0.f, 0.f};
            continue; }
        const int mb = r0 < RL ? r0 / T : 8;
        f32x4 v[2][4];
#pragma unroll
        for (int q = 0; q < 2; ++q)
#pragma unroll
            for (int j = 0; j < 4; ++j) v[q][j] = vn[q][j];
        if (r0 + NGW * 2 < nrows) NORM_LOAD(vn, r0 + NGW * 2);
        if (comb) {
            const float* g2 = F_MOD + ((size_t)(l - 1) * 9 + mb) * 6144 + 5120;
            const int myinv = lane < 2 * NE ? F_INV[(size_t)r0 * NE + lane] : -1;
            f32x4 s[2][4];
#pragma unroll
            for (int q = 0; q < 2; ++q)
#pragma unroll
                for (int j = 0; j < 4; ++j) s[q][j] = (f32x4){0.f, 0.f, 0.f, 0.f};
#if COMB_BATCH
            unsigned long long mk = __ballot(myinv >= 0);
            while (mk) {
                int bq[4], slq[4];
#pragma unroll
                for (int k = 0; k < 4; ++k) { bq[k] = mk ? (int)__builtin_ctzll(mk) : -1; if (mk) mk &= mk - 1;
                    slq[k] = __builtin_amdgcn_readlane(myinv, bq[k] < 0 ? bq[0] : bq[k]); }
                u32x2 wq[4][4];
#pragma unroll
                for (int k = 0; k < 4; ++k) { const bf16* yr = F_Y + (size_t)slq[k] * D;
#pragma unroll
                    for (int j = 0; j < 4; ++j) wq[k][j] = ((const u32x2*)yr)[lane + 64 * j]; }
#pragma unroll
                for (int k = 0; k < 4; ++k) { if (bq[k] < 0) continue;
                    if (bq[k] < NE) {
#pragma unroll
                        for (int j = 0; j < 4; ++j) { const u32x2 w = wq[k][j]; s[0][j].x += bf2f(w.x & 0xffff); s[0][j].y += bf2f(w.x >> 16); s[0][j].z += bf2f(w.y & 0xffff); s[0][j].w += bf2f(w.y >> 16); }
                    } else {
#pragma unroll
                        for (int j = 0; j < 4; ++j) { const u32x2 w = wq[k][j]; s[1][j].x += bf2f(w.x & 0xffff); s[1][j].y += bf2f(w.x >> 16); s[1][j].z += bf2f(w.y & 0xffff); s[1][j].w += bf2f(w.y >> 16); }
                    } }
            }
#else
            for (int e = 0; e < NE; ++e) {
#pragma unroll
                for (int q = 0; q < 2; ++q) { const int sl = shi(myinv, q * NE + e);
                    if (sl >= 0) { const bf16* yr = F_Y + (size_t)sl * D;
#pragma unroll
                        for (int j = 0; j < 4; ++j) { const u32x2 w = ((const u32x2*)yr)[lane + 64 * j];
                            s[q][j].x += bf2f(w.x & 0xffff); s[q][j].y += bf2f(w.x >> 16); s[q][j].z += bf2f(w.y & 0xffff); s[q][j].w += bf2f(w.y >> 16); } } } }
#endif
#pragma unroll
            for (int j = 0; j < 4; ++j) { const f32x4 g = ((const f32x4*)g2)[lane + 64 * j];
#pragma unroll
                for (int q = 0; q < 2; ++q) { v[q][j] += g * s[q][j] * keep;
#if X_BF16
                    u32x2 w; w.x = pk2(v[q][j].x, v[q][j].y); w.y = pk2(v[q][j].z, v[q][j].w); ((u32x2*)(F_XB + (size_t)(r0 + q) * D))[lane + 64 * j] = w;
#else
                    ((f32x4*)(F_X + (size_t)(r0 + q) * D))[lane + 64 * j] = v[q][j];
#endif
                } }
        }
        float ss0 = 0.f, ss1 = 0.f;
#pragma unroll
        for (int j = 0; j < 4; ++j) { ss0 += (v[0][j].x * v[0][j].x + v[0][j].y * v[0][j].y) + (v[0][j].z * v[0][j].z + v[0][j].w * v[0][j].w);
                                      ss1 += (v[1][j].x * v[1][j].x + v[1][j].y * v[1][j].y) + (v[1][j].z * v[1][j].z + v[1][j].w * v[1][j].w); }
#pragma unroll
        for (int o = 1; o < 64; o <<= 1) { ss0 += shx(ss0, o, lane); ss1 += shx(ss1, o, lane); }
        const float rs[2] = {1.0f / sqrtf(ss0 * (1.f / D) + EPS), 1.0f / sqrtf(ss1 * (1.f / D) + EPS)};
        if (mode == 2) {
#pragma unroll
            for (int j = 0; j < 4; ++j) { const f32x4 g = ((const f32x4*)gain)[lane + 64 * j];
#pragma unroll
                for (int q = 0; q < 2; ++q) ((f32x4*)((float*)F.out + (size_t)(r0 + q) * D))[lane + 64 * j] = v[q][j] * rs[q] * g; }
        } else {
            const float* md = F_MOD + ((size_t)l * 9 + mb) * 6144 + (mode == 0 ? 0 : 3072);
#pragma unroll
            for (int j = 0; j < 4; ++j) { const f32x4 g = ((const f32x4*)gain)[lane + 64 * j];
                const f32x4 sh = ((const f32x4*)md)[lane + 64 * j], sc = ((const f32x4*)(md + 1024))[lane + 64 * j];
#pragma unroll
                for (int q = 0; q < 2; ++q) { v[q][j] = v[q][j] * rs[q] * g * (sc + 1.0f) + sh;
                    u32x2 w; w.x = pk2(v[q][j].x, v[q][j].y); w.y = pk2(v[q][j].z, v[q][j].w);
                    ((u32x2*)(F_ACT + (size_t)(r0 + q) * D))[lane + 64 * j] = w; } }
            if (mode == 1) {
#pragma unroll
                for (int q = 0; q < 2; ++q)
#pragma unroll
                    for (int j = 0; j < 4; ++j) hv[hh][q][j] = v[q][j];
            }
        }
      }
      if (mode == 1 && !(PROBE_NOROUTER && keep == 0.f)) {
            constexpr int NRW = 2 * NH;
            float a[NRW][NE];
            typedef float f32x2r __attribute__((ext_vector_type(2)));
#pragma unroll
            for (int e = 0; e < NE; ++e) { f32x2r pp[NRW];
#pragma unroll
                for (int q = 0; q < NRW; ++q) pp[q] = (f32x2r){0.f, 0.f};
#pragma unroll
                for (int j = 0; j < 4; ++j) { const f32x4 w = *(const LAS f32x4*)(wrT + e * 1028 + 256 * j + 4 * lane);
                    const f32x2r wl = {w.x, w.y}, wh = {w.z, w.w};
#pragma unroll
                    for (int q = 0; q < NRW; ++q) { const f32x4 x = hv[q >> 1][q & 1][j];
                        pp[q] = __builtin_elementwise_fma((f32x2r){x.x, x.y}, wl, pp[q]); pp[q] = __builtin_elementwise_fma((f32x2r){x.z, x.w}, wh, pp[q]); } }
#pragma unroll
                for (int q = 0; q < NRW; ++q) a[q][e] = pp[q].x + pp[q].y;
                if ((e & 1) == 1) __builtin_amdgcn_sched_barrier(0); }
            float b16[2][NE];
            if constexpr (NH == 2) {
#pragma unroll
                for (int q = 0; q < 2; ++q)
#pragma unroll
                    for (int e = 0; e < NE; ++e) { const bool up = lane >= 32; b16[q][e] = half_swap_add(up ? a[2 + q][e] : a[q][e], up ? a[q][e] : a[2 + q][e], 32); }
            } else {
#pragma unroll
                for (int q = 0; q < 2; ++q)
#pragma unroll
                    for (int e = 0; e < NE; ++e) b16[q][e] = a[q][e];
            }
            float lg; int rsel, eidx;
            if constexpr (NH == 2) {
                float c16[NE];
#pragma unroll
                for (int e = 0; e < NE; ++e) { const bool up = (lane & 16) != 0; c16[e] = half_swap_add(up ? b16[1][e] : b16[0][e], up ? b16[0][e] : b16[1][e], 16); }
                float b8[8];
#pragma unroll
                for (int e = 0; e < 8; ++e) { const bool up = (lane & 8) != 0; b8[e] = half_swap_add(up ? c16[8 + e] : c16[e], up ? c16[e] : c16[8 + e], 8); }
                float b4[4];
#pragma unroll
                for (int e = 0; e < 4; ++e) { const bool up = (lane & 4) != 0; b4[e] = half_swap_add(up ? b8[4 + e] : b8[e], up ? b8[e] : b8[4 + e], 4); }
                float b2[2];
#pragma unroll
                for (int e = 0; e < 2; ++e) { const bool up = (lane & 2) != 0; b2[e] = half_swap_add(up ? b4[2 + e] : b4[e], up ? b4[e] : b4[2 + e], 2); }
                { const bool up = (lane & 1) != 0; lg = half_swap_add(up ? b2[1] : b2[0], up ? b2[0] : b2[1], 1); }
                rsel = 2 * (lane >> 5) + ((lane >> 4) & 1); eidx = lane & 15;
                float mx = lg;
#pragma unroll
                for (int o = 1; o < 16; o <<= 1) mx = fmaxf(mx, shx(mx, o, lane));
                const float ex = __expf(lg - mx); float sum = ex;
#pragma unroll
                for (int o = 1; o < 16; o <<= 1) sum += shx(sum, o, lane);
                const int rr = rg + (rsel >> 1) * NGW * 2 + (rsel & 1);
                if (rr < nrows) F_AFF[(size_t)rr * NE + eidx] = ex / sum;
            } else {
                float b16x[NE];
#pragma unroll
                for (int e = 0; e < NE; ++e) { const bool up = lane >= 32; b16x[e] = half_swap_add(up ? b16[1][e] : b16[0][e], up ? b16[0][e] : b16[1][e], 32); }
                float b8[8];
#pragma unroll
                for (int e = 0; e < 8; ++e) { const bool up = (lane & 16) != 0; b8[e] = half_swap_add(up ? b16x[8 + e] : b16x[e], up ? b16x[e] : b16x[8 + e], 16); }
                float b4[4];
#pragma unroll
                for (int e = 0; e < 4; ++e) { const bool up = (lane & 8) != 0; b4[e] = half_swap_add(up ? b8[4 + e] : b8[e], up ? b8[e] : b8[4 + e], 8); }
                float b2[2];
#pragma unroll
                for (int e = 0; e < 2; ++e) { const bool up = (lane & 4) != 0; b2[e] = half_swap_add(up ? b4[2 + e] : b4[e], up ? b4[e] : b4[2 + e], 4); }
                { const bool up = (lane & 2) != 0; lg = half_swap_add(up ? b2[1] : b2[0], up ? b2[0] : b2[1], 2); }
                lg += shx(lg, 1, lane);
                float mx = lg;
#pragma unroll
                for (int o = 2; o < 32; o <<= 1) mx = fmaxf(mx, shx(mx, o, lane));
                const float ex = __expf(lg - mx); float sum = ex;
#pragma unroll
                for (int o = 2; o < 32; o <<= 1) sum += shx(sum, o, lane);
                eidx = ((lane >> 4) & 1) * 8 + ((lane >> 3) & 1) * 4 + ((lane >> 2) & 1) * 2 + ((lane >> 1) & 1); rsel = lane >> 5;
                if ((lane & 1) == 0) F_AFF[(size_t)(rg + rsel) * NE + eidx] = ex / sum;
            }
      }
    }
}

#undef NORM_LOAD
__device__ __forceinline__ void topk_phase(Frame& F, int nsets) {
    LAS unsigned* cnt = (LAS unsigned*)F.lds;
    const int tid = F.tid, lane = F.lane, wave = F.wave;
    for (int it = F.bid; it < nsets * NE; it += F.G) {
        const int set = it / NE, e = it % NE; const bool lat = set < 8; const int b = lat ? set : set - 8;
        const int n = lat ? T : LC, cap = lat ? CAPL : CAPC, row0 = lat ? b * T : RL + b * LC, slot0 = e * SLOTS_E + (lat ? b * CAPL : NB * CAPL + b * CAPC);
        unsigned v[4];
#pragma unroll
        for (int q = 0; q < 4; ++q) { const int idx = 4 * tid + q; v[q] = idx < n ? __builtin_bit_cast(unsigned, F_AFF[(size_t)(row0 + idx) * NE + e]) : 0u; }
        unsigned prefix = 0u; int par = 0;
#if TOPK_RADIX4
        for (int rnd = 0; rnd < 16; ++rnd) {
            const int b0 = rnd == 0 ? 30 : 30 - 2 * rnd;
            const unsigned c1v = prefix | (1u << b0), c2v = rnd == 0 ? 0xffffffffu : (prefix | (2u << b0)), c3v = rnd == 0 ? 0xffffffffu : (prefix | (3u << b0));
            unsigned n1 = 0, n2 = 0, n3 = 0;
#pragma unroll
            for (int q = 0; q < 4; ++q) { n1 += (unsigned)__popcll(__ballot(v[q] >= c1v)); n2 += (unsigned)__popcll(__ballot(v[q] >= c2v)); n3 += (unsigned)__popcll(__ballot(v[q] >= c3v)); }
            if (lane == 0) { cnt[par * 24 + wave] = n1; cnt[par * 24 + 8 + wave] = n2; cnt[par * 24 + 16 + wave] = n3; }
            __syncthreads();
            unsigned t1 = 0, t2 = 0, t3 = 0;
#pragma unroll
            for (int w = 0; w < 8; ++w) { t1 += cnt[par * 24 + w]; t2 += cnt[par * 24 + 8 + w]; t3 += cnt[par * 24 + 16 + w]; }
            if (t3 >= (unsigned)cap) prefix = c3v; else if (t2 >= (unsigned)cap) prefix = c2v; else if (t1 >= (unsigned)cap) prefix = c1v;
            par ^= 1;
        }
#else
        for (int bit = 30; bit >= 0; --bit) {
            const unsigned cand = prefix | (1u << bit);
            unsigned c = 0;
#pragma unroll
            for (int q = 0; q < 4; ++q) c += (unsigned)__popcll(__ballot(v[q] >= cand));
            if (lane == 0) cnt[par * 8 + wave] = c;
            __syncthreads();
            unsigned tot = 0;
#pragma unroll
            for (int w = 0; w < 8; ++w) tot += cnt[par * 8 + w];
            if (tot >= (unsigned)cap) prefix = cand;
            par ^= 1;
        }
#endif
        unsigned g4 = 0, e4 = 0;
#pragma unroll
        for (int q = 0; q < 4; ++q) { g4 += v[q] > prefix ? 1u : 0u; e4 += v[q] == prefix ? 1u : 0u; }
        unsigned pk = g4 | (e4 << 16), inc = pk;
#pragma unroll
        for (int o = 1; o < 64; o <<= 1) { const unsigned t = (unsigned)shi((int)inc, lane - o); if (lane >= o) inc += t; }
        __syncthreads();
        if (lane == 63) cnt[16 + wave] = inc;
        __syncthreads();
        unsigned base = 0, total = 0;
#pragma unroll
        for (int w = 0; w < 8; ++w) { const unsigned t = cnt[16 + w]; total += t; if (w < wave) base += t; }
        const unsigned excl = base + inc - pk;
        unsigned gpre = excl & 0xffffu, epre = excl >> 16; const unsigned need = (unsigned)cap - (total & 0xffffu);
#pragma unroll
        for (int q = 0; q < 4; ++q) { const int idx = 4 * tid + q;
            if (idx < n) { const bool isg = v[q] > prefix, ise = v[q] == prefix; const bool sel = isg || (ise && epre < need);
                const int slot = slot0 + (int)(gpre + (epre < need ? epre : need));
                if (sel) { F_STOK[slot] = row0 + idx; F_SGATE[slot] = __builtin_bit_cast(float, v[q]); }
                F_INV[(size_t)(row0 + idx) * NE + e] = sel ? slot : -1;
                gpre += isg ? 1u : 0u; epre += ise ? 1u : 0u; } }
        __syncthreads();
    }
}

#ifndef ATT_EXTRA
#define ATT_EXTRA 0
#define ATT_EXTRA_TYPE 0
#endif
#ifndef ATT_LATE_DMA
#define ATT_LATE_DMA 0
#endif
#ifndef ATT_STAGGER
#define ATT_STAGGER 1
#endif
#ifndef ATT_XVAR
#define ATT_XVAR 0
#endif
#ifndef ATT_XSTEPS
#define ATT_XSTEPS 4
#endif
namespace att {
typedef short s16x4 __attribute__((ext_vector_type(4)));
typedef float f32x2_t __attribute__((ext_vector_type(2)));
typedef __bf16 bf16x2_t __attribute__((ext_vector_type(2)));
constexpr int L_K = 0, KBUF = 16384, L_V = 2 * KBUF, VBUF = 8192, L_WS = L_V + 2 * VBUF, L_OST = L_WS + 8 * 256, L_END = L_OST + 8 * 4096;
#define ATT_SBAR() __builtin_amdgcn_sched_barrier(0)
#define ATT_SGB(mask, n) __builtin_amdgcn_sched_group_barrier(mask, n, 0)
__device__ __forceinline__ int crow(int r, int hi) { return (r & 3) + 8 * (r >> 2) + 4 * hi; }
__device__ __forceinline__ unsigned cvtpk(float lo, float hi) { f32x2_t v = {lo, hi}; bf16x2_t b = __builtin_convertvector(v, bf16x2_t); return __builtin_bit_cast(unsigned, b); }
__device__ __forceinline__ int v_st(int k, int c) { const int kk = k; return ((kk >> 3) * 2 + (c >> 5)) * 512 + ((kk & 7) * 32 + (c & 31)) * 2; }
__device__ __forceinline__ int v_rd_base(int lane) { return ((lane & 3) << 3) | (((lane >> 2) & 3) << 6) | (((lane >> 4) & 1) << 5) | (((lane >> 5) & 1) << 8); }
typedef short v4i16_t __attribute__((ext_vector_type(4)));
template <int OFF> __device__ __forceinline__ s16x4 tr_read(int vb) { s16x4 r; asm volatile("ds_read_b64_tr_b16 %0, %1 offset:%2" : "=&v"(r) : "v"(vb), "i"(OFF) : "memory"); return r; }
struct VFrag { s16x4 l0, h0, l1, h1, l2, h2, l3, h3; };
template <int D0> __device__ __forceinline__ void vread(VFrag& f, int vb) {
    f.l0 = tr_read<D0 * 512 + 0 * 2048>(vb); f.h0 = tr_read<D0 * 512 + 0 * 2048 + 1024>(vb); f.l1 = tr_read<D0 * 512 + 1 * 2048>(vb); f.h1 = tr_read<D0 * 512 + 1 * 2048 + 1024>(vb);
    f.l2 = tr_read<D0 * 512 + 2 * 2048>(vb); f.h2 = tr_read<D0 * 512 + 2 * 2048 + 1024>(vb); f.l3 = tr_read<D0 * 512 + 3 * 2048>(vb); f.h3 = tr_read<D0 * 512 + 3 * 2048 + 1024>(vb);
}
__device__ __forceinline__ void pv_mma(f32x16& od, const VFrag& f, bf16x8 pa0, bf16x8 pa1, bf16x8 pa2, bf16x8 pa3) {
#define ATT_PK(L, H) (bf16x8){L[0], L[1], L[2], L[3], H[0], H[1], H[2], H[3]}
    od = __builtin_amdgcn_mfma_f32_32x32x16_bf16(pa0, ATT_PK(f.l0, f.h0), od, 0, 0, 0);
    od = __builtin_amdgcn_mfma_f32_32x32x16_bf16(pa1, ATT_PK(f.l1, f.h1), od, 0, 0, 0);
    od = __builtin_amdgcn_mfma_f32_32x32x16_bf16(pa2, ATT_PK(f.l2, f.h2), od, 0, 0, 0);
    od = __builtin_amdgcn_mfma_f32_32x32x16_bf16(pa3, ATT_PK(f.l3, f.h3), od, 0, 0, 0);
#undef ATT_PK
}
template <int D0> __device__ __forceinline__ void pv_one(f32x16& od, int vb, bf16x8 pa0, bf16x8 pa1, bf16x8 pa2, bf16x8 pa3) {
    VFrag f; vread<D0>(f, vb); asm volatile("s_waitcnt lgkmcnt(0)" ::: "memory"); ATT_SBAR(); pv_mma(od, f, pa0, pa1, pa2, pa3);
}
#ifndef LSUM_MFMA
#define LSUM_MFMA 0
#endif
__device__ __forceinline__ void lsum_mma(f32x16& la, bf16x8 pa0, bf16x8 pa1, bf16x8 pa2, bf16x8 pa3) {
    const bf16x8 ones = {(short)0x3f80, (short)0x3f80, (short)0x3f80, (short)0x3f80, (short)0x3f80, (short)0x3f80, (short)0x3f80, (short)0x3f80};
    la = __builtin_amdgcn_mfma_f32_32x32x16_bf16(pa0, ones, la, 0, 0, 0); la = __builtin_amdgcn_mfma_f32_32x32x16_bf16(pa1, ones, la, 0, 0, 0);
    la = __builtin_amdgcn_mfma_f32_32x32x16_bf16(pa2, ones, la, 0, 0, 0); la = __builtin_amdgcn_mfma_f32_32x32x16_bf16(pa3, ones, la, 0, 0, 0);
}
struct Tensors { const bf16* P; const bf16* QKVM; bf16* O; const float* sink; const float* dnorm; float lam, lam_init; int l; };

constexpr float THR = 8.f;
__device__ __forceinline__ float mx3(float a, float b, float c) { float d; asm("v_max3_f32 %0, %1, %2, %3" : "=v"(d) : "v"(a), "v"(b), "v"(c)); return d; }
__device__ __forceinline__ float mx2(float a, float b) { float d; asm("v_max_f32 %0, %1, %2" : "=v"(d) : "v"(a), "v"(b)); return d; }
__device__ __forceinline__ float rowmax32(const f32x16& p0, const f32x16& p1) {
    const float a0 = mx3(p0[0], p0[1], p0[2]), a1 = mx3(p0[3], p0[4], p0[5]), a2 = mx3(p0[6], p0[7], p0[8]), a3 = mx3(p0[9], p0[10], p0[11]), a4 = mx3(p0[12], p0[13], p0[14]);
    const float b0 = mx3(p1[0], p1[1], p1[2]), b1 = mx3(p1[3], p1[4], p1[5]), b2 = mx3(p1[6], p1[7], p1[8]), b3 = mx3(p1[9], p1[10], p1[11]), b4 = mx3(p1[12], p1[13], p1[14]);
    const float c0 = mx3(a0, a1, a2), c1 = mx3(a3, a4, p0[15]), c2 = mx3(b0, b1, b2), c3 = mx3(b3, b4, p1[15]);
    const float m = mx2(mx3(c0, c1, c2), c3);
    auto rr = __builtin_amdgcn_permlane32_swap(__float_as_uint(m), __float_as_uint(m), false, false);
    return mx2(__uint_as_float(rr[0]), __uint_as_float(rr[1]));
}
__device__ __forceinline__ void partialSM(f32x16& p0, f32x16& p1, const float rm, float& mhat, f32x16& negm, float& alpha) {
    alpha = 1.f;
    if (__builtin_expect(__any(rm > THR), 0)) {
        const float dl = fmaxf(rm, 0.f); mhat += dl;
#pragma unroll
        for (int r = 0; r < 16; ++r) { p0[r] -= dl; p1[r] -= dl; }
#pragma unroll
        for (int r = 0; r < 16; ++r) negm[r] = -mhat;
        asm volatile("" : "+v"(negm));
        alpha = __builtin_amdgcn_exp2f(-dl);
    }
}
__device__ __forceinline__ void finishSM(f32x16& p0, f32x16& p1, const float alpha, float& l_reg, bf16x8& pa0, bf16x8& pa1, bf16x8& pa2, bf16x8& pa3) {
#pragma unroll
    for (int r = 0; r < 16; ++r) { p0[r] = __builtin_amdgcn_exp2f(p0[r]); p1[r] = __builtin_amdgcn_exp2f(p1[r]); }
#if !LSUM_MFMA
    float ps = 0.f, pt = 0.f;
#pragma unroll
    for (int r = 0; r < 16; ++r) { ps += p0[r]; pt += p1[r]; }
    l_reg = l_reg * alpha + (ps + pt);
#endif
#define ATT_PK8(P, BASE, OUT) do { u32x4 w = {cvtpk(P[BASE + 0], P[BASE + 1]), cvtpk(P[BASE + 2], P[BASE + 3]), cvtpk(P[BASE + 4], P[BASE + 5]), cvtpk(P[BASE + 6], P[BASE + 7])}; OUT = __builtin_bit_cast(bf16x8, w); } while (0)
    ATT_PK8(p0, 0, pa0); ATT_PK8(p0, 8, pa1); ATT_PK8(p1, 0, pa2); ATT_PK8(p1, 8, pa3);
#undef ATT_PK8
}
template <int ROWB> __device__ __forceinline__ int kswz(int row, int cb) { return row * ROWB + (ROWB == 128 ? (cb ^ (((row >> 1) & 7) << 4)) : (cb ^ ((row & 15) << 4))); }
template <int NB, int ROWB, int CB0, int D00> __device__ __forceinline__ void kread(bf16x8 (&kf)[2 * NB], const LAS unsigned char* Kb, int r32, int hi) {
#pragma unroll
    for (int d = 0; d < NB; ++d) { const int cb = CB0 + ((D00 + d) * 16 + hi * 8) * 2;
        kf[2 * d] = *(const LAS bf16x8*)(Kb + kswz<ROWB>(r32, cb)); kf[2 * d + 1] = *(const LAS bf16x8*)(Kb + kswz<ROWB>(32 + r32, cb)); }
}
template <int NB, int D00> __device__ __forceinline__ void kmma(f32x16& p0, f32x16& p1, const bf16x8 (&kf)[2 * NB], const bf16x8* qr, const f32x16& negm) {
#pragma unroll
    for (int d = 0; d < NB; ++d) {
        if (D00 + d == 0) { p0 = __builtin_amdgcn_mfma_f32_32x32x16_bf16(kf[0], qr[0], negm, 0, 0, 0); p1 = __builtin_amdgcn_mfma_f32_32x32x16_bf16(kf[1], qr[0], negm, 0, 0, 0); }
        else { p0 = __builtin_amdgcn_mfma_f32_32x32x16_bf16(kf[2 * d], qr[D00 + d], p0, 0, 0, 0); p1 = __builtin_amdgcn_mfma_f32_32x32x16_bf16(kf[2 * d + 1], qr[D00 + d], p1, 0, 0, 0); } }
}
template <int NKS, int ROWB, int CB0> __device__ __forceinline__ void qkt2(f32x16& p0, f32x16& p1, const LAS unsigned char* Kb, const bf16x8* qr, const f32x16& negm, int r32, int hi) {
    constexpr int N1 = NKS > 4 ? 3 : NKS, N2 = NKS - N1;
    bf16x8 ka[2 * N1]; kread<N1, ROWB, CB0, 0>(ka, Kb, r32, hi);
    if constexpr (N2 > 0) { bf16x8 kb[2 * N2]; kread<N2, ROWB, CB0, N1>(kb, Kb, r32, hi);
        kmma<N1, 0>(p0, p1, ka, qr, negm); kmma<N2, N1>(p0, p1, kb, qr, negm); }
    else kmma<N1, 0>(p0, p1, ka, qr, negm);
}

template <int TYPE> struct Ring { static constexpr int KSLOT = TYPE == 1 ? 16384 : 8192, VSLOT = 8192, L_K = 0, L_V = 3 * KSLOT, L_WS = L_V + 4 * VSLOT, L_OST = L_WS + 2048; };
template <int TYPE, int CB0> __device__ __forceinline__ void flash_pass(const Tensors& Tn, LAS unsigned char* lds, const int tid, const int b, const int h, const bool lat, const int q0, const int wrow, const int var, const bf16x8* qr,
                                                                        f32x16 (&o)[2], float& l_out, float& m_out, LAS float* lw) {
    constexpr int NKS = TYPE == 0 ? 4 : (TYPE == 1 ? 6 : 2);
    constexpr int ROWB = TYPE == 1 ? 256 : 128;
    typedef Ring<TYPE> RG;
    const int lane = tid & 63, wid = __builtin_amdgcn_readfirstlane(tid >> 6), r32 = lane & 31, hi = lane >> 5;
    LAS float* al_l = (LAS float*)(lds + RG::L_WS) + wid * 64;
    const int kvh = h >> 2;
    const bf16* Kp = TYPE == 0 ? Tn.P + P_AK + kvh * 64 : (TYPE == 1 ? Tn.QKVM + 512 + h * 128 : Tn.P + P_DK + h * 64);
    const bf16* Vp = TYPE == 0 ? Tn.P + P_AV + kvh * 64 : (TYPE == 1 ? Tn.QKVM + 512 + h * 128 + 64 : Tn.P + P_DV + h * 64);
    constexpr int KPITCH = TYPE == 1 ? LDM : LDP;
    int kl0 = 0, nloc = 0;
    if (lat) { if (TYPE == 0) { kl0 = q0 - 128 < 0 ? 0 : q0 - 128; const int kl1 = q0 + 64 + 128 > T ? T : q0 + 64 + 128; nloc = (kl1 - kl0) >> 6; } else { kl0 = 0; nloc = T / 64; } }
    const int NT = 4 + nloc;
    const int crow0 = RL + b * LC, lrow0 = b * T + kl0;
#define ATT_TROW(i) ((var & 64) ? crow0 : ((i) < 4 ? crow0 + 64 * (i) : lrow0 + 64 * ((i) - 4)))
    const bf16* ksrc0; const bf16* ksrc1 = nullptr;
    if (TYPE != 1) { const int row = 8 * wid + (lane >> 3), c = (lane & 7) ^ ((row >> 1) & 7); ksrc0 = Kp + (size_t)row * KPITCH + c * 8; }
    else {
        { const int row = 8 * wid + (lane >> 4), c = (lane & 15) ^ (row & 15); ksrc0 = c < 8 ? Kp + (size_t)row * LDM + c * 8 : (c < 12 ? Tn.P + (size_t)row * LDP + P_KR + (c - 8) * 8 : Kp + (size_t)row * LDM); }
        { const int row = 8 * wid + 4 + (lane >> 4), c = (lane & 15) ^ (row & 15); ksrc1 = c < 8 ? Kp + (size_t)row * LDM + c * 8 : (c < 12 ? Tn.P + (size_t)row * LDP + P_KR + (c - 8) * 8 : Kp + (size_t)row * LDM); }
    }
    const bool k0p = TYPE == 1 && (((lane & 15) ^ ((8 * wid + (lane >> 4)) & 15)) >= 8) && (((lane & 15) ^ ((8 * wid + (lane >> 4)) & 15)) < 12);
    const bool k1p = TYPE == 1 && (((lane & 15) ^ ((8 * wid + 4 + (lane >> 4)) & 15)) >= 8) && (((lane & 15) ^ ((8 * wid + 4 + (lane >> 4)) & 15)) < 12);
    const bf16* vsrc = Vp + (size_t)(8 * wid + ((lane & 31) >> 2)) * KPITCH + (lane >> 5) * 32 + (lane & 3) * 8;
#define ATT_DMA_K(i, slot) do { if (var & 8) break; const int g_ = ATT_TROW((i) < NT ? (i) : NT - 1); \
        __builtin_amdgcn_global_load_lds((const unsigned*)(ksrc0 + (size_t)g_ * (k0p ? LDP : KPITCH)), (LAS unsigned*)(lds + RG::L_K + (slot) * RG::KSLOT + wid * (ROWB * 8)), 16, 0, 0); \
        if (TYPE == 1) __builtin_amdgcn_global_load_lds((const unsigned*)(ksrc1 + (size_t)g_ * (k1p ? LDP : KPITCH)), (LAS unsigned*)(lds + RG::L_K + (slot) * RG::KSLOT + wid * (ROWB * 8) + 1024), 16, 0, 0); } while (0)
#define ATT_DMA_V(i, slot) do { if (var & 8) break; const int g_ = ATT_TROW((i) < NT ? (i) : NT - 1); \
        __builtin_amdgcn_global_load_lds((const unsigned*)(vsrc + (size_t)g_ * KPITCH), (LAS unsigned*)(lds + RG::L_V + (slot) * RG::VSLOT + wid * 1024), 16, 0, 0); } while (0)
#define ATT_WAITBAR() do { if (var & 16) break; if (TYPE == 1) asm volatile("s_waitcnt vmcnt(3)" ::: "memory"); else asm volatile("s_waitcnt vmcnt(2)" ::: "memory"); __builtin_amdgcn_s_barrier(); asm volatile("" ::: "memory"); } while (0)
#define ATT_RESC(a) do { if (__any((a) < 1.f)) { if (hi == 0) al_l[r32] = (a); asm volatile("s_waitcnt lgkmcnt(0)" ::: "memory"); \
        _Pragma("unroll") for (int r = 0; r < 16; ++r) { const float f_ = al_l[crow(r, hi)]; o[0][r] *= f_; o[1][r] *= f_; if (LSUM_MFMA) lacc[r] *= f_; } } } while (0)
    const int qpos = q0 + wrow + r32;
#define ATT_MASK(P0, P1, i) do { if (TYPE == 0 && (i) >= 4 && (kl0 + 64 * ((i) - 4) - q0 <= -128 || kl0 + 64 * ((i) - 4) - q0 >= 128)) {     \
        const int kt0_ = kl0 + 64 * ((i) - 4) - qpos, lo_ = -128, hi_ = 128; \
        _Pragma("unroll") for (int r = 0; r < 16; ++r) { const int k0_ = kt0_ + crow(r, hi); P0[r] = (k0_ < lo_ || k0_ > hi_) ? -1e30f : P0[r]; P1[r] = (k0_ + 32 < lo_ || k0_ + 32 > hi_) ? -1e30f : P1[r]; } } } while (0)
    const int vb0 = (int)(uintptr_t)(lds + RG::L_V) + v_rd_base(lane);
    const LAS unsigned char* Kr = lds + RG::L_K;
    float mhat = 0.f, l_reg = 0.f; f32x16 negm = f32x16{}; f32x16 lacc = f32x16{};
    int sp = 2, sc = 0;
#define ATT_ROT() do { const int t_ = sp; sp = sc; sc = (sc == 2 ? 0 : sc + 1); (void)t_; } while (0)
#ifndef ATT_LAGSEL
#define ATT_LAGSEL 0
#endif
    const bool lag = ATT_STAGGER && (ATT_LAGSEL == 0 ? wid >= 4 : (ATT_LAGSEL == 1 ? (wid & 1) != 0 : ((wid >> 1) & 1) != 0));
    f32x16 p0 = f32x16{}, p1 = f32x16{}; bf16x8 pa0 = bf16x8{}, pa1 = bf16x8{}, pa2 = bf16x8{}, pa3 = bf16x8{};
#define ATT_SOFT(t, FIRST) do { ATT_MASK(p0, p1, t); float rm_ = rowmax32(p0, p1); float alpha_ = 1.f; \
        if (FIRST) { mhat = rm_; _Pragma("unroll") for (int r = 0; r < 16; ++r) { p0[r] -= rm_; p1[r] -= rm_; negm[r] = -rm_; } asm volatile("" : "+v"(negm)); } \
        else if (__builtin_expect(__any(rm_ > THR), 0)) { const float dl = fmaxf(rm_, 0.f); mhat += dl; \
            _Pragma("unroll") for (int r = 0; r < 16; ++r) { p0[r] -= dl; p1[r] -= dl; negm[r] = -mhat; } asm volatile("" : "+v"(negm)); \
            alpha_ = __builtin_amdgcn_exp2f(-dl); ATT_RESC(alpha_); } \
        finishSM(p0, p1, alpha_, l_reg, pa0, pa1, pa2, pa3); } while (0)
#define ATT_STEP(t) do { \
        if (lag || !ATT_LATE_DMA) { ATT_DMA_K((t) + 2, sp); ATT_DMA_V((t) + 1, ((t) + 1) & 3); } \
        { bf16x8 kf_[2 * NKS]; att::VFrag va_, vb_; const int vbt_ = vb0 + (((t) - 1) & 3) * RG::VSLOT; \
          kread<NKS, ROWB, CB0, 0>(kf_, Kr + sc * RG::KSLOT, r32, hi); vread<0>(va_, vbt_); \
          asm volatile("s_waitcnt lgkmcnt(0)" ::: "memory"); ATT_SBAR(); \
          kmma<NKS, 0>(p0, p1, kf_, qr, negm); ATT_SBAR(); \
          vread<1>(vb_, vbt_); ATT_SBAR(); \
          pv_mma(o[0], va_, pa0, pa1, pa2, pa3); if (LSUM_MFMA) lsum_mma(lacc, pa0, pa1, pa2, pa3); \
          asm volatile("s_waitcnt lgkmcnt(0)" ::: "memory"); ATT_SBAR(); \
          pv_mma(o[1], vb_, pa0, pa1, pa2, pa3); } \
        asm volatile("" : "+v"(p0), "+v"(p1), "+v"(o[0]), "+v"(o[1])); if (LSUM_MFMA) asm volatile("" : "+v"(lacc)); \
        if (lag) ATT_WAITBAR(); \
        if (!lag && ATT_LATE_DMA) { ATT_DMA_K((t) + 2, sp); ATT_DMA_V((t) + 1, ((t) + 1) & 3); }     \
        ATT_SOFT(t, false); \
        asm volatile("" : "+v"(pa0), "+v"(pa1), "+v"(pa2), "+v"(pa3), "+v"(l_reg)); \
        if (!lag) ATT_WAITBAR(); ATT_ROT(); } while (0)
    ATT_DMA_K(0, 0); ATT_DMA_V(0, 0); ATT_DMA_K(1, 1);
    asm volatile("s_waitcnt vmcnt(0)" ::: "memory"); __builtin_amdgcn_s_barrier(); asm volatile("" ::: "memory");
    { ATT_DMA_K(2, 2); ATT_DMA_V(1, 1);
      qkt2<NKS, ROWB, CB0>(p0, p1, Kr, qr, negm, r32, hi);
      asm volatile("" : "+v"(p0), "+v"(p1));
      if (lag) ATT_WAITBAR();
      ATT_SOFT(0, true);
      asm volatile("" : "+v"(pa0), "+v"(pa1), "+v"(pa2), "+v"(pa3), "+v"(l_reg));
      if (!lag) ATT_WAITBAR(); ATT_ROT(); }
    for (int j = 1; j < ((var & 32) ? ATT_XSTEPS : NT); ++j) ATT_STEP(j);
    pv_one<0>(o[0], vb0 + ((NT - 1) & 3) * RG::VSLOT, pa0, pa1, pa2, pa3); pv_one<1>(o[1], vb0 + ((NT - 1) & 3) * RG::VSLOT, pa0, pa1, pa2, pa3);
    if (LSUM_MFMA) lsum_mma(lacc, pa0, pa1, pa2, pa3);
    asm volatile("s_waitcnt vmcnt(0)" ::: "memory"); __builtin_amdgcn_s_barrier(); asm volatile("" ::: "memory");
#undef ATT_SOFT
#if LSUM_MFMA
    if (r32 == 0) {
#pragma unroll
        for (int r = 0; r < 16; ++r) lw[crow(r, hi)] = lacc[r]; }
    l_out = 0.f; m_out = mhat;
#else
    { auto rr = __builtin_amdgcn_permlane32_swap(__float_as_uint(l_reg), __float_as_uint(l_reg), false, false); l_reg = __uint_as_float(rr[0]) + __uint_as_float(rr[1]); }
    l_out = l_reg; m_out = mhat;
#endif
#undef ATT_TROW
#undef ATT_DMA_K
#undef ATT_DMA_V
#undef ATT_WAITBAR
#undef ATT_RESC
#undef ATT_MASK
#undef ATT_ROT
#undef ATT_STEP
}

template <int TYPE> __device__ __forceinline__ void unit(const Tensors& Tn, LAS unsigned char* lds, const int tid, const int b, const int h, const bool lat, const int q0, const int var) {
    constexpr int NKS = TYPE == 0 ? 4 : (TYPE == 1 ? 6 : 2);
    const int lane = tid & 63, wid = __builtin_amdgcn_readfirstlane(tid >> 6), r32 = lane & 31, hi = lane >> 5;
    typedef Ring<TYPE> RG;
    LAS float* wsf = (LAS float*)(lds + RG::L_WS) + wid * 64;
    const int hw = TYPE == 0 ? h * 4 + (wid & 3) : h, wrow = TYPE == 0 ? (wid >> 2) * 32 : wid * 32;
    const int qrow0 = (lat ? b * T + q0 : RL + b * LC + q0) + wrow;
    bf16x8 qr[TYPE == 2 ? 4 : NKS];
    { const bf16* qp = TYPE == 0 ? Tn.P + (size_t)(qrow0 + r32) * LDP + P_AQ + hw * 64 : (TYPE == 1 ? Tn.QKVM + (size_t)(qrow0 + r32) * LDM + h * 96 : Tn.P + (size_t)(qrow0 + r32) * LDP + P_DQ + h * 64);
#pragma unroll
      for (int d0 = 0; d0 < (TYPE == 2 ? 4 : NKS); ++d0) qr[d0] = *(const bf16x8*)(qp + d0 * 16 + hi * 8); }
    f32x16 oA[2] = {f32x16{}, f32x16{}}; float l0, m0;
    flash_pass<TYPE, 0>(Tn, lds, tid, b, hw, lat, q0, wrow, var, qr, oA, l0, m0, TYPE == 2 ? wsf + 32 : wsf);
    f32x16 oB[2] = {f32x16{}, f32x16{}}; float l1 = 1.f, m1 = 0.f;
    LAS float* stash = (LAS float*)(lds + RG::L_OST + wid * 8192);
    if (TYPE == 2) {
#pragma unroll
        for (int r = 0; r < 16; ++r) { stash[r * 64 + lane] = oA[0][r]; stash[(16 + r) * 64 + lane] = oA[1][r]; }
        flash_pass<TYPE, 64>(Tn, lds, tid, b, h, lat, q0, wrow, var, qr + 2, oB, l1, m1, wsf);
#pragma unroll
        for (int r = 0; r < 16; ++r) { oA[0][r] = stash[r * 64 + lane]; oA[1][r] = stash[(16 + r) * 64 + lane]; }
        asm volatile("s_waitcnt lgkmcnt(0)" ::: "memory");
    }
#if LSUM_MFMA
    asm volatile("s_waitcnt lgkmcnt(0)" ::: "memory");
    if (TYPE == 0 && hi == 0) wsf[r32] += __builtin_amdgcn_exp2f(Tn.sink[Tn.l * 8 + hw] * 1.4426950408889634f - m0);
#else
    if (TYPE == 0) l0 += __builtin_amdgcn_exp2f(Tn.sink[Tn.l * 8 + hw] * 1.4426950408889634f - m0);
    if (hi == 0) { wsf[r32] = l0; if (TYPE == 2) wsf[32 + r32] = l1; }
#endif
    asm volatile("s_waitcnt lgkmcnt(0)" ::: "memory");
    LAS bf16* stg = (LAS bf16*)(lds + RG::L_OST + wid * (TYPE == 2 ? 8192 : 4096));
    if (TYPE != 2) {
#pragma unroll
        for (int r = 0; r < 16; ++r) { const float rl = __builtin_amdgcn_rcpf(wsf[crow(r, hi)]); const int orow = crow(r, hi);
            stg[orow * 64 + r32] = (bf16)f2bf(oA[0][r] * rl); stg[orow * 64 + 32 + r32] = (bf16)f2bf(oA[1][r] * rl); }
    } else {
        const float g0 = Tn.dnorm[Tn.l * 64 + r32], g1 = Tn.dnorm[Tn.l * 64 + 32 + r32];
#pragma unroll
        for (int r = 0; r < 16; ++r) { const float rl0 = __builtin_amdgcn_rcpf(wsf[(LSUM_MFMA ? 32 : 0) + crow(r, hi)]), rl1 = Tn.lam * __builtin_amdgcn_rcpf(wsf[(LSUM_MFMA ? 0 : 32) + crow(r, hi)]);
            const float a0 = oA[0][r] * rl0 - oB[0][r] * rl1, a1 = oA[1][r] * rl0 - oB[1][r] * rl1;
            float ss = a0 * a0 + a1 * a1;
#pragma unroll
            for (int o_ = 1; o_ < 32; o_ <<= 1) ss += shx(ss, o_, lane);
            const float rs = (1.f - Tn.lam_init) * __builtin_amdgcn_rsqf(ss * (1.f / 64.f) + EPS); const int orow = crow(r, hi);
            stg[orow * 64 + r32] = (bf16)f2bf(a0 * rs * g0); stg[orow * 64 + 32 + r32] = (bf16)f2bf(a1 * rs * g1); }
    }
    asm volatile("s_waitcnt lgkmcnt(0)" ::: "memory");
    { bf16* Ow = Tn.O + (size_t)qrow0 * D + (TYPE == 0 ? hw * 64 : (TYPE == 1 ? 512 + h * 64 : 768 + h * 64));
#pragma unroll
      for (int i = 0; i < 4; ++i) { const int row = i * 8 + (lane >> 3), ch = lane & 7; st16(Ow + (size_t)row * D + ch * 8, *(const LAS u32x4*)(stg + row * 64 + ch * 8)); } }
    asm volatile("s_waitcnt lgkmcnt(0)" ::: "memory"); __builtin_amdgcn_s_barrier(); asm volatile("" ::: "memory");
}
}

__device__ __forceinline__ void attn_phase(Frame& F, const int l, const bool need_ctx) {
    att::Tensors Tn; Tn.P = F_P; Tn.QKVM = F_QKVM; Tn.O = F_O; Tn.sink = F_sink; Tn.dnorm = F_diff_norm; Tn.l = l;
    { float s1 = 0.f, s2 = 0.f;
      if (F.lane < 32) { s1 = F_lq1[l * 32 + F.lane] * F_lk1[l * 32 + F.lane]; s2 = F_lq2[l * 32 + F.lane] * F_lk2[l * 32 + F.lane]; }
      s1 = wave_sum(s1, F.lane); s2 = wave_sum(s2, F.lane);
      int ll_ = l; asm volatile("" : "+s"(ll_));
      const float li_ = ll_ == 0 ? 0.200000000f : (ll_ == 1 ? 0.355509068f : (ll_ == 2 ? 0.470713018f : 0.556058204f));
      const float lm_ = __expf(s1) - __expf(s2) + li_;
      Tn.lam_init = li_; Tn.lam = __builtin_bit_cast(float, __builtin_amdgcn_readfirstlane(__builtin_bit_cast(int, lm_))); }
    const int b = F.bid & 7, j = F.bid >> 3;
    if (F.G != 256) return;
    const int nu = (need_ctx && j < 16) ? 5 : 4;
#ifndef ATT_SPRIO
#define ATT_SPRIO 2
#endif
    if (ATT_SPRIO == 1 && F.wave >= 4) __builtin_amdgcn_s_setprio(1);
    if (ATT_SPRIO == 2 && F.wave < 4) __builtin_amdgcn_s_setprio(1);
    for (int u = 0; u < nu + ATT_EXTRA; ++u) {
        int type, h, q0; bool lat = true; const int var = u >= nu ? ATT_XVAR : 0;
        if (u >= nu) { type = ATT_EXTRA_TYPE; h = ATT_EXTRA_TYPE == 0 ? ((j >> 3) & 1) : (j >> 3); q0 = ATT_EXTRA_TYPE == 0 ? j * 64 : (j & 7) * 256; Tn.O = F_ACT; }
        else if (u == 0) { type = 2; h = j >> 3; q0 = (j & 7) * 256; }
        else if (u == 1) { type = 1; h = j >> 3; q0 = (j & 7) * 256; }
        else if (u < 4) { type = 0; h = u - 2; q0 = j * 64; }
        else { lat = false; q0 = 0; if (j < 8) { type = 0; h = j >> 2; q0 = (j & 3) * 64; } else if (j < 12) { type = 1; h = j - 8; } else { type = 2; h = j - 12; } }
        int t_ = F.tid; asm volatile("" : "+v"(t_));
        if (type == 0) att::unit<0>(Tn, F.lds, t_, b, h, lat, q0, var);
        else if (type == 1) att::unit<1>(Tn, F.lds, t_, b, h, lat, q0, var);
        else att::unit<2>(Tn, F.lds, t_, b, h, lat, q0, var);
    }
    if (ATT_SPRIO) __builtin_amdgcn_s_setprio(0);
}

enum { PH_P0 = 0, PH_L0 = 1, PH_PER_LAYER = 9, PH_FINAL = PH_L0 + DEPTH * PH_PER_LAYER, NPH = PH_FINAL + 1 };
enum { SP_NORM1 = 0, SP_INPROJ = 1, SP_UP = 2, SP_ATTN = 3, SP_OUT = 4, SP_NORM2 = 5, SP_TOPK = 6, SP_MOE1 = 7, SP_MOE2 = 8 };

#ifndef REPS_INIT
#define REPS_INIT {1, 1, 1, 1, 1, 1, 1, 1, 1}
#endif
#ifndef REP_P0
#define REP_P0 1
#endif
#ifndef REP_FINAL
#define REP_FINAL 1
#endif
#ifndef KROT_ON
#define KROT_ON 0
#endif
#ifndef PROBE_NOMMA
#define PROBE_NOMMA 0
#endif
#ifndef PHMASK
#define PHMASK 0x3ff
#endif
#define PHON(b) ((PHMASK >> (b)) & 1)
#define REPSEL(s) ((s) == 0 ? reps_sp[0] : (s) == 1 ? reps_sp[1] : (s) == 2 ? reps_sp[2] : (s) == 3 ? reps_sp[3] : (s) == 4 ? reps_sp[4] : (s) == 5 ? reps_sp[5] : (s) == 6 ? reps_sp[6] : (s) == 7 ? reps_sp[7] : reps_sp[8])
__global__ void __launch_bounds__(NWAVES * 64, 2) mk(Args args) {
    extern __shared__ __attribute__((aligned(16))) unsigned char lds_raw[];
    Frame F;
    F.lds = (LAS unsigned char*)lds_raw;
    F.tid = threadIdx.x; F.lane = F.tid & 63; F.wave = __builtin_amdgcn_readfirstlane(F.tid >> 6); F.bid = blockIdx.x; F.G = gridDim.x;
    const int wave_s = F.wave;
    F.in = (const float* const*)args.in; F.out = (GAS float*)args.out; F.ws = (GAS unsigned char*)args.ws;
    volatile LAS unsigned* MISC = (volatile LAS unsigned*)(F.lds + MISC_OFF);
    for (int u = F.tid; u < (LDS_BYTES - LDSCTL_OFF) / 4; u += NWAVES * 64) ((LAS unsigned*)(F.lds + LDSCTL_OFF))[u] = 0u;
    __syncthreads();
    XcdBarrier bar = xcd_barrier_post((unsigned*)(args.ws + WS_CTL) + CW_BAR + args.li * XCD_BAR_WORDS, MISC + 8);
    const int gx = F.bid & 7, gj = F.bid >> 3, gpx = F.G >> 3, krot = KROT_ON ? (gj & 7) + 3 * (gj >> 3) : 0;
    constexpr int reps_sp[9] = REPS_INIT;
    for (int ph = args.ph_lo; ph < args.ph_hi; ++ph) {
      const int nrep = ph == PH_P0 ? REP_P0 : (ph == PH_FINAL ? REP_FINAL : (REPSEL((ph - PH_L0) % PH_PER_LAYER)));
      for (int rep = 0; rep < nrep; ++rep) {
        const float keep = rep + 1 == nrep ? 1.f : 0.f;
        { unsigned char* w_ = args.ws; asm volatile("" : "+s"(w_)); F.ws = (GAS unsigned char*)w_; int z_ = 0; asm volatile("" : "+s"(z_)); F.in = (const float* const*)args.in + z_;
          int l_; asm volatile("v_mbcnt_lo_u32_b32 %0, -1, 0\n\tv_mbcnt_hi_u32_b32 %0, -1, %0" : "=v"(l_));
          int w_s = wave_s; asm volatile("" : "+s"(w_s)); F.lane = l_; F.wave = w_s; F.tid = w_s * 64 + l_; }
        if (ph == PH_P0) { if (PHON(9)) p0_phase(F); }
        else if (ph == PH_FINAL) { if (PHON(0)) norm_phase<1>(F, DEPTH, 2, RL, keep); }
        else {
            const int l = (ph - PH_L0) / PH_PER_LAYER, sp = (ph - PH_L0) % PH_PER_LAYER;
            const bool need_ctx = l < DEPTH - 1; const int rows_mix = need_ctx ? R : RL;
            const bf16* wl = F_WB + (size_t)l * W_LAYER;
            if (sp == SP_NORM1) { if (PHON(0)) norm_phase<1>(F, l, 0, R, keep); }
            else if (sp == SP_INPROJ && PHON(1)) {
                pg8::Gemm g{F_ACT, wl + W_IN, nullptr, 0, D, D}; OrderRows S{gx, gj, gpx, R / 288 / 8, LDP / 256, ((PROBE9 || EPI_PROBE) && rep + 1 < nrep) ? 1 : 0, krot, 288};
                EpiInProj<3, 3> E{F_P, F_ROPE, F_RSQ};
                pg8::gemm_phase288<false>(F.lds, F.tid, g, S, E);
                { const int nbusy = 8;
                  if (BG_PREP && l + 1 < DEPTH && rep + 1 == nrep && gj >= nbusy) prep_layer(F, l + 1, ((gx * (gpx - nbusy) + (gj - nbusy)) * NWAVES) + F.wave, 8 * (gpx - nbusy) * NWAVES); }
            } else if (sp == SP_UP && PHON(2)) {
                pg8::Gemm g{F_P + P_CQ, wl + W_UP, nullptr, 0, LDP, UPK}; OrderUp S{{gx, gj, gpx, R / 288 / 8, 4, 0, krot, 288}};
                EpiUp<3, 3> E{F_QKVM, F_ROPE, F_RSQ};
                pg8::gemm_phase288<false>(F.lds, F.tid, g, S, E);
            } else if (sp == SP_ATTN) { if (PHON(3)) attn_phase(F, l, need_ctx);
            } else if (sp == SP_OUT && PHON(4)) {
                pg8::Gemm g{F_O, wl + W_OUT, nullptr, 0, D, D};
                if (need_ctx) { OrderRows S{gx, gj, gpx, R / 288 / 8, 4, 0, krot, 288}; EpiOut<3, 3> E{(XT*)F_XB, F_MOD + (size_t)l * 9 * 6144, keep}; pg8::gemm_phase288<false>(F.lds, F.tid, g, S, E); }
                else { OrderRows S{gx, gj, gpx, RL / 256 / 8, 4, 0, krot, 256}; EpiOut<4> E{(XT*)F_XB, F_MOD + (size_t)l * 9 * 6144, keep}; pg8::gemm_phase<false, 4>(F.lds, F.tid, g, S, E); }
            } else if (sp == SP_NORM2) { if (PHON(5)) norm_phase<NORM2_NH>(F, l, 1, rows_mix, keep); }
            else if (sp == SP_TOPK) { if (PHON(6)) topk_phase(F, need_ctx ? 16 : 8);
#if MOE_PF
                { unsigned acc = 0;
                  for (int e2 = 0; e2 < 2; ++e2) { const int e = 2 * gx + e2;
                    const u32x4* p1 = (const u32x4*)(wl + W_GU + (size_t)e * 1024 * 1024); const u32x4* p2 = (const u32x4*)(wl + W_DN + (size_t)e * 1024 * 512);
#pragma unroll 4
                    for (int i = gj * 512 + F.tid; i < 131072; i += gpx * 512) acc ^= p1[i].x;
#pragma unroll 4
                    for (int i = gj * 512 + F.tid; i < 65536; i += gpx * 512) acc ^= p2[i].x; }
                  asm volatile("" :: "v"(acc)); }
#endif
            }
            else if (sp == SP_MOE1 && PHON(7)) {
                pg8::Gemm g{F_ACT, wl + W_GU, F_STOK, (size_t)1024 * 1024, D, D};
                if (need_ctx) { OrderMoe S{gx, gj, gpx, 8, 4, krot, 288}; EpiGU<3, 3> E{F_HID}; pg8::gemm_phase288<true>(F.lds, F.tid, g, S, E); }
                else { OrderMoe S{gx, gj, gpx, 8, 4, krot, 256}; EpiGU<4> E{F_HID}; pg8::gemm_phase<true, 4>(F.lds, F.tid, g, S, E); }
            } else if (sp == SP_MOE2 && PHON(8)) {
                pg8::Gemm g{F_HID, wl + W_DN, nullptr, (size_t)1024 * 512, DE, DE};
                if (need_ctx) { OrderMoe S{gx, gj, gpx, 8, 4, krot, 288}; EpiDown<3, 3> E{F_Y, F_SGATE}; pg8::gemm_phase288<false>(F.lds, F.tid, g, S, E); }
                else { OrderMoe S{gx, gj, gpx, 8, 4, krot, 256}; EpiDown<4> E{F_Y, F_SGATE}; pg8::gemm_phase<false, 4>(F.lds, F.tid, g, S, E); }
            }
        }
        if (ph + 1 < args.ph_hi || rep + 1 < nrep) { xcd_barrier(bar, F.tid);
#ifdef EXTRA_BAR
            xcd_barrier(bar, F.tid);
#endif
        }
      }
    }
}

extern "C" void kernel_launch(void* const* d_in, const int* in_sizes, int n_in, void* d_out, int out_size, void* d_ws, size_t ws_size, hipStream_t stream) {
    static int grid = 0;
    if (grid == 0) {
        if (n_in != 25 || ws_size < WS_END || out_size != RL * D) { fprintf(stderr, "kernel_launch: unexpected shapes (n_in %d, ws %zu < %zu, out %d)\n", n_in, ws_size, (size_t)WS_END, out_size); grid = -1; return; }
        int dev = 0, cus = 0, per_cu = 0;
        if (hipGetDevice(&dev) != hipSuccess || hipDeviceGetAttribute(&cus, hipDeviceAttributeMultiprocessorCount, dev) != hipSuccess) { grid = -1; return; }
        if (hipFuncSetAttribute((const void*)mk, hipFuncAttributeMaxDynamicSharedMemorySize, LDS_BYTES) != hipSuccess) { fprintf(stderr, "kernel_launch: hipFuncSetAttribute failed\n"); grid = -1; return; }
        if (hipOccupancyMaxActiveBlocksPerMultiprocessor(&per_cu, (const void*)mk, NWAVES * 64, LDS_BYTES) != hipSuccess || per_cu < 1) { fprintf(stderr, "kernel_launch: occupancy query says %d\n", per_cu); }
        (void)hipGetLastError();
        grid = cus;
        if (grid % 8 != 0) { fprintf(stderr, "kernel_launch: %d CUs, expected a multiple of 8\n", grid); grid = -1; return; }
    }
    if (grid < 0) return;
    (void)hipMemsetAsync((char*)d_ws + WS_CTL, 0, CTL_ZERO_BYTES, stream);
    Args a; memset(&a, 0, sizeof a);
    for (int i = 0; i < 25; ++i) a.in[i] = (const float*)d_in[i];
    a.out = (float*)d_out; a.ws = (unsigned char*)d_ws;
    a.ph_lo = 0; a.ph_hi = NPH; a.li = 0;
    hipLaunchKernelGGL(mk, dim3(grid), dim3(NWAVES * 64), LDS_BYTES, stream, a);
}
```
